# Optimizing an MI355X kernel written in HIP

```python
import math
import jax, jax.numpy as jnp
from jax import lax
import numpy as np


D_MODEL = 1024
BATCH = 16
SEQ = 2048
DEPTH = 2

CHUNK = 64
HEAD_DIM = 64
ROPE_THETA = 10000.0
EPS = 1e-6
D_FF = 2816
Q_BLOCK = 128
DSA_Q_BLOCK = 32
A_HEADS = D_MODEL // (4 * HEAD_DIM)
A_VDIM = 2 * HEAD_DIM
B_HEADS = D_MODEL // (2 * HEAD_DIM)
IDX_HEADS = 8
IDX_DIM = 32
TOPK_MAX = 256
C_HEADS = D_MODEL // HEAD_DIM
C_LEFT_CHUNKS = 8
MAX_REL = 256
REL_TABLE = MAX_REL + CHUNK

MIX_WIDTH = A_HEADS * A_VDIM + B_HEADS * HEAD_DIM
EVEN_SIZES = (2 * A_HEADS * HEAD_DIM, 2 * A_HEADS * HEAD_DIM, A_HEADS * A_VDIM,
              B_HEADS * HEAD_DIM, B_HEADS * HEAD_DIM, B_HEADS * HEAD_DIM,
              IDX_HEADS * IDX_DIM, IDX_DIM, IDX_HEADS)
EVEN_PROJ = sum(EVEN_SIZES)
EVEN_SPLITS = [sum(EVEN_SIZES[:i + 1]) for i in range(len(EVEN_SIZES) - 1)]

kernel_name = "hybrid_chunk_causal_diff_dsa_band"


def rmsnorm(x, g):
    xf = x.astype(jnp.float32)
    y = xf * lax.rsqrt(jnp.mean(xf * xf, axis=-1, keepdims=True) + EPS)
    return (y * g.astype(jnp.float32)).astype(x.dtype)


def rope_tables(seq, dim):
    inv = ROPE_THETA ** (-jnp.arange(0, dim, 2, dtype=jnp.float32) / dim)
    ang = jnp.arange(seq, dtype=jnp.float32)[:, None] * inv[None, :]
    return jnp.cos(ang), jnp.sin(ang)


def apply_rope(x, cos, sin):
    xf = x.astype(jnp.float32)
    x1, x2 = jnp.split(xf, 2, axis=-1)
    c = cos[:, None, :]
    s = sin[:, None, :]
    return jnp.concatenate([x1 * c - x2 * s, x2 * c + x1 * s], axis=-1).astype(x.dtype)


def masked_softmax(s, mask):
    return jax.nn.softmax(jnp.where(mask, s, -jnp.inf), axis=-1)


def swiglu(h, wg, wu, wd):
    return (jax.nn.silu(h @ wg) * (h @ wu)) @ wd


def diff_attention(q, k, v, lam, subln, lambda_init):
    B_, S_ = q.shape[0], q.shape[1]
    nb = S_ // Q_BLOCK
    qb = q.reshape(B_, nb, Q_BLOCK, A_HEADS, 2, HEAD_DIM).swapaxes(0, 1)
    kf = k.astype(jnp.float32)
    vf = v.astype(jnp.float32)
    kchunk = jnp.arange(S_) // CHUNK
    scale = HEAD_DIM ** -0.5

    def one_block(args):
        bi, qblk = args
        qpos = bi * Q_BLOCK + jnp.arange(Q_BLOCK)
        mask = kchunk[None, :] <= (qpos // CHUNK)[:, None]
        s = jnp.einsum('bqhcd,bkhcd->bhcqk', qblk.astype(jnp.float32), kf) * scale
        p = masked_softmax(s, mask)
        w = p[:, :, 0] - lam * p[:, :, 1]
        return jnp.einsum('bhqk,bkhe->bqhe', w, vf)

    o = lax.map(one_block, (jnp.arange(nb), qb))
    o = o.swapaxes(0, 1).reshape(B_, S_, A_HEADS, A_VDIM)
    o = rmsnorm(o, subln) * (1.0 - lambda_init)
    return o.reshape(B_, S_, A_HEADS * A_VDIM).astype(v.dtype)


def dsa_attention(q, k, v, qi, ki, wi, topk):
    B_, S_ = q.shape[0], q.shape[1]
    nb = S_ // DSA_Q_BLOCK
    qb = q.reshape(B_, nb, DSA_Q_BLOCK, B_HEADS, HEAD_DIM).swapaxes(0, 1)
    qib = qi.reshape(B_, nb, DSA_Q_BLOCK, IDX_HEADS, IDX_DIM).swapaxes(0, 1)
    wib = wi.reshape(B_, nb, DSA_Q_BLOCK, IDX_HEADS).swapaxes(0, 1)
    kf = k.astype(jnp.float32)
    vf = v.astype(jnp.float32)
    kif = ki.astype(jnp.float32)
    kchunk = jnp.arange(S_) // CHUNK
    scale = HEAD_DIM ** -0.5
    gather = jax.vmap(lambda kk, ii: kk[ii])

    def one_block(args):
        bi, qblk, qiblk, wiblk = args
        qpos = bi * DSA_Q_BLOCK + jnp.arange(DSA_Q_BLOCK)
        qchunk = qpos // CHUNK
        rel = jax.nn.relu(jnp.einsum('bqhd,bkd->bqhk', qiblk.astype(jnp.float32), kif))
        score = jnp.einsum('bqhk,bqh->bqk', rel, wiblk.astype(jnp.float32))
        mask = kchunk[None, :] <= qchunk[:, None]
        score = jnp.where(mask[None], score, -jnp.inf)
        _, idx = lax.top_k(score, topk)
        valid = (idx // CHUNK) <= qchunk[None, :, None]
        kg = gather(kf, idx)
        vg = gather(vf, idx)
        s = jnp.einsum('bqhd,bqkhd->bhqk', qblk.astype(jnp.float32), kg) * scale
        p = masked_softmax(s, valid[:, None])
        return jnp.einsum('bhqk,bqkhd->bqhd', p, vg)

    o = lax.map(one_block, (jnp.arange(nb), qb, qib, wib))
    return o.swapaxes(0, 1).reshape(B_, S_, B_HEADS * HEAD_DIM).astype(v.dtype)


def chunk_band_attention(q, k, v, rel_bias):
    B_, S_ = q.shape[0], q.shape[1]
    nc = S_ // CHUNK
    left = C_LEFT_CHUNKS * CHUNK
    band = left + CHUNK
    kp = jnp.pad(k.astype(jnp.float32), ((0, 0), (left, 0), (0, 0), (0, 0)))
    vp = jnp.pad(v.astype(jnp.float32), ((0, 0), (left, 0), (0, 0), (0, 0)))
    dist = left + jnp.arange(CHUNK)[:, None] - jnp.arange(band)[None, :]
    bias_idx = jnp.clip(dist, -(CHUNK - 1), MAX_REL) + (CHUNK - 1)
    bias = rel_bias.astype(jnp.float32)[:, bias_idx]
    qc = q.reshape(B_, nc, CHUNK, C_HEADS, HEAD_DIM).swapaxes(0, 1)
    scale = HEAD_DIM ** -0.5

    def one_chunk(args):
        ci, qblk = args
        kb = lax.dynamic_slice_in_dim(kp, ci * CHUNK, band, axis=1)
        vb = lax.dynamic_slice_in_dim(vp, ci * CHUNK, band, axis=1)
        valid = (ci * CHUNK - left + jnp.arange(band)) >= 0
        s = jnp.einsum('bqhd,bkhd->bhqk', qblk.astype(jnp.float32), kb) * scale + bias[None]
        p = masked_softmax(s, valid[None, None, None, :])
        return jnp.einsum('bhqk,bkhd->bqhd', p, vb)

    o = lax.map(one_chunk, (jnp.arange(nc), qc))
    return o.swapaxes(0, 1).reshape(B_, S_, C_HEADS * HEAD_DIM).astype(v.dtype)


def even_mixer(h, w_in, w_out, lam_p, subln, rope64, rope32, lambda_init, topk):
    B_, S_ = h.shape[0], h.shape[1]
    cos64, sin64 = rope64
    cos32, sin32 = rope32
    a_q, a_k, a_v, b_q, b_k, b_v, i_q, i_k, i_w = jnp.split(h @ w_in, EVEN_SPLITS, axis=-1)
    a_q = apply_rope(a_q.reshape(B_, S_, 2 * A_HEADS, HEAD_DIM), cos64, sin64).reshape(B_, S_, A_HEADS, 2, HEAD_DIM)
    a_k = apply_rope(a_k.reshape(B_, S_, 2 * A_HEADS, HEAD_DIM), cos64, sin64).reshape(B_, S_, A_HEADS, 2, HEAD_DIM)
    a_v = a_v.reshape(B_, S_, A_HEADS, A_VDIM)
    lp = lam_p.astype(jnp.float32)
    lam = jnp.exp(jnp.sum(lp[0] * lp[1])) - jnp.exp(jnp.sum(lp[2] * lp[3])) + lambda_init
    o_a = diff_attention(a_q, a_k, a_v, lam, subln, lambda_init)
    b_q = apply_rope(b_q.reshape(B_, S_, B_HEADS, HEAD_DIM), cos64, sin64)
    b_k = apply_rope(b_k.reshape(B_, S_, B_HEADS, HEAD_DIM), cos64, sin64)
    b_v = b_v.reshape(B_, S_, B_HEADS, HEAD_DIM)
    i_q = apply_rope(i_q.reshape(B_, S_, IDX_HEADS, IDX_DIM), cos32, sin32)
    i_k = apply_rope(i_k.reshape(B_, S_, 1, IDX_DIM), cos32, sin32)[:, :, 0]
    i_w = i_w * (IDX_HEADS ** -0.5 * IDX_DIM ** -0.5)
    o_b = dsa_attention(b_q, b_k, b_v, i_q, i_k, i_w, topk)
    return jnp.concatenate([o_a, o_b], axis=-1) @ w_out


def odd_mixer(h, w_in, w_out, rel_bias):
    B_, S_ = h.shape[0], h.shape[1]
    q, k, v = jnp.split(h @ w_in, 3, axis=-1)
    q = q.reshape(B_, S_, C_HEADS, HEAD_DIM)
    k = k.reshape(B_, S_, C_HEADS, HEAD_DIM)
    v = v.reshape(B_, S_, C_HEADS, HEAD_DIM)
    return chunk_band_attention(q, k, v, rel_bias) @ w_out


def setup_inputs(seed: int = 0) -> dict:
    key = jax.random.key(seed)
    ks = jax.random.split(key, 12)
    n_even = (DEPTH + 1) // 2
    n_odd = DEPTH // 2
    nrm = jax.random.normal
    f32 = jnp.float32
    return {
        "x": nrm(ks[0], (BATCH, SEQ, D_MODEL), f32),
        "norm_g": 1.0 + 0.01 * nrm(ks[1], (DEPTH, 6, D_MODEL), f32),
        "ffn_wg": nrm(ks[2], (DEPTH, 2, D_MODEL, D_FF), f32) * D_MODEL ** -0.5,
        "ffn_wu": nrm(ks[3], (DEPTH, 2, D_MODEL, D_FF), f32) * D_MODEL ** -0.5,
        "ffn_wd": nrm(ks[4], (DEPTH, 2, D_FF, D_MODEL), f32) * D_FF ** -0.5,
        "even_w_in": nrm(ks[5], (n_even, D_MODEL, EVEN_PROJ), f32) * D_MODEL ** -0.5,
        "even_w_out": nrm(ks[6], (n_even, MIX_WIDTH, D_MODEL), f32) * MIX_WIDTH ** -0.5,
        "even_lambda": 0.1 * nrm(ks[7], (n_even, 4, HEAD_DIM), f32),
        "even_subln": 1.0 + 0.01 * nrm(ks[8], (n_even, A_VDIM), f32),
        "odd_w_in": nrm(ks[9], (n_odd, D_MODEL, 3 * D_MODEL), f32) * D_MODEL ** -0.5,
        "odd_w_out": nrm(ks[10], (n_odd, D_MODEL, D_MODEL), f32) * D_MODEL ** -0.5,
        "odd_rel_bias": 0.1 * nrm(ks[11], (n_odd, C_HEADS, REL_TABLE), f32),
    }


def reference(x, norm_g, ffn_wg, ffn_wu, ffn_wd, even_w_in, even_w_out, even_lambda, even_subln,
              odd_w_in, odd_w_out, odd_rel_bias):
    S_ = x.shape[1]
    topk = min(TOPK_MAX, S_ // 4)
    rope64 = rope_tables(S_, HEAD_DIM)
    rope32 = rope_tables(S_, IDX_DIM)
    for l in range(DEPTH):
        g = norm_g[l]
        h = rmsnorm(x, g[0])
        x = x + 0.5 * rmsnorm(swiglu(h, ffn_wg[l, 0], ffn_wu[l, 0], ffn_wd[l, 0]), g[1])
        h = rmsnorm(x, g[2])
        if l % 2 == 0:
            e = l // 2
            lambda_init = 0.8 - 0.6 * math.exp(-0.3 * l)
            m = even_mixer(h, even_w_in[e], even_w_out[e], even_lambda[e], even_subln[e],
                           rope64, rope32, lambda_init, topk)
        else:
            o = l // 2
            m = odd_mixer(h, odd_w_in[o], odd_w_out[o], odd_rel_bias[o])
        x = x + rmsnorm(m.astype(x.dtype), g[3])
        h = rmsnorm(x, g[4])
        x = x + 0.5 * rmsnorm(swiglu(h, ffn_wg[l, 1], ffn_wu[l, 1], ffn_wd[l, 1]), g[5])
    return x
```

```cpp
#include <hip/hip_runtime.h>
#include <cstdio>
#include <cstdint>
namespace pg8 {
#define PG8_LAS __attribute__((address_space(3)))
typedef unsigned short bf16_t;
typedef short bf16x8 __attribute__((ext_vector_type(8)));
typedef float f32x4 __attribute__((ext_vector_type(4)));
typedef unsigned u32x4 __attribute__((ext_vector_type(4)));
constexpr int BM = 256, BK = 64, HALF = 128, HTB = HALF * BK * 2  , STAGE_BYTES = 8 * HTB, NXCD = 8, WGM = 8;

__host__ __device__ __forceinline__ int lds_byte(int r, int c) { const int st = (r >> 4) * 2 + (c >> 5), rr = r & 15, cc = c & 31, ob = rr * 64 + cc * 2; return st * 1024 + (ob ^ (((ob >> 9) & 1) << 5)); }
__host__ __device__ __forceinline__ void stage_rc(int b, int& R, int& C) { const int st = b / 1024, sb = b % 1024, swz = sb ^ (((sb >> 9) & 1) << 5); R = (st >> 1) * 16 + swz / 64; C = (st & 1) * 32 + (swz % 64) / 2; }
__host__ __device__ __forceinline__ int perm32(int rho) { const int n = rho >> 4, i = rho & 15; return 8 * (i >> 2) + 4 * n + (i & 3); }

struct Unit { int pm, pn; };
struct Gemm { const bf16_t* A; const bf16_t* Bt; int M, N, K; };

struct StaticOrder {
    int nM, nN, nwg, G, c;
    __host__ __device__ void init(int M, int N, int G_, int c_) { nM = M / BM; nN = N / BM; nwg = nM * nN; G = G_; c = c_; }
    __host__ __device__ bool next(int i, Unit& u) const {
        const long L = (long)i * G + c; if (L >= nwg) return false;
        int wgid = (int)L; { const int q = nwg / NXCD, r = nwg % NXCD, xcd = wgid % NXCD, off = wgid / NXCD; wgid = (xcd < r ? xcd * (q + 1) : r * (q + 1) + (xcd - r) * q) + off; }
        const int nig = WGM * nN, gid = wgid / nig, fm = gid * WGM, gsz = (nM - fm) < WGM ? (nM - fm) : WGM;
        u.pm = fm + ((wgid % nig) % gsz); u.pn = (wgid % nig) / gsz; return true;
    }
    __device__ __forceinline__ void a_ready(const Unit&) const {}
    __device__ __forceinline__ void done(const Unit&) const {}
};

__device__ __forceinline__ unsigned cvt_pk_bf16(float lo, float hi) { unsigned r; asm volatile("v_cvt_pk_bf16_f32 %0, %1, %2" : "=v"(r) : "v"(lo), "v"(hi)); return r; }
typedef float f32x2 __attribute__((ext_vector_type(2)));
__device__ __forceinline__ f32x2 gelu_pk(f32x2 v) {
    const f32x2 av = __builtin_elementwise_abs(v), d = av * 0.2316418882f + 1.0f;
    f32x2 t; t.x = __builtin_amdgcn_rcpf(d.x); t.y = __builtin_amdgcn_rcpf(d.y);
    f32x2 q = t * 0.5307027145f + (-0.7265760135f); q = q * t + 0.7107068705f; q = q * t + (-0.142248368f); q = q * t + 0.127414796f; q = q * t;
    const f32x2 s = (v * v) * (-0.72134752044f);
    f32x2 e; e.x = __builtin_amdgcn_exp2f(s.x); e.y = __builtin_amdgcn_exp2f(s.y);
    const f32x2 m = v * (q * e), r = v - m;
    f32x2 o; o.x = v.x < 0.f ? m.x : r.x; o.y = v.y < 0.f ? m.y : r.y; return o;
}

template <int ACT  > struct EpiBf16 {
    static constexpr bool PERM = true, AFTER_DRAIN = false; static_assert(ACT == 0 || ACT == 1, "EpiBf16: ACT is 0 (none) or 1 (gelu_pk)");
    bf16_t* O; int ldc; const float* bias; int split_cols; size_t split_stride; float scale0;
    __device__ __forceinline__ void operator()(const f32x4 (&acc)[2][2][4][2], const Unit& u, int wr, int wc, int fr, int fq) const {
        const int row0 = u.pm * BM + wr * 64 + fr; int colt = u.pn * BM; bf16_t* base = O;
        float sc = 1.f; if (split_cols) { const int t = colt / split_cols; base += (size_t)t * split_stride; colt -= t * split_cols; if (t == 0) sc = scale0; }
        const int col0 = colt + wc * 32 + 8 * fq, bcol0 = u.pn * BM + wc * 32 + 8 * fq;
        f32x4 bv[2][2];
#pragma unroll
        for (int bj = 0; bj < 2; ++bj)
#pragma unroll
            for (int n = 0; n < 2; ++n) bv[bj][n] = bias ? *(const f32x4*)(bias + bcol0 + bj * HALF + 4 * n) : (f32x4){0.f, 0.f, 0.f, 0.f};
#pragma unroll
        for (int ai = 0; ai < 2; ++ai)
#pragma unroll
            for (int m = 0; m < 4; ++m) { bf16_t* rowp = base + (size_t)(row0 + ai * HALF + m * 16) * ldc + col0;
#pragma unroll
                for (int bj = 0; bj < 2; ++bj) { f32x4 v0 = acc[ai][bj][m][0] + bv[bj][0], v1 = acc[ai][bj][m][1] + bv[bj][1];
                    if (ACT == 1) { f32x2 a = gelu_pk((f32x2){v0[0], v0[1]}), b = gelu_pk((f32x2){v0[2], v0[3]}), c = gelu_pk((f32x2){v1[0], v1[1]}), d = gelu_pk((f32x2){v1[2], v1[3]});
                        v0 = (f32x4){a.x, a.y, b.x, b.y}; v1 = (f32x4){c.x, c.y, d.x, d.y}; }
                    v0 = v0 * sc; v1 = v1 * sc; u32x4 w; w.x = cvt_pk_bf16(v0[0], v0[1]); w.y = cvt_pk_bf16(v0[2], v0[3]); w.z = cvt_pk_bf16(v1[0], v1[1]); w.w = cvt_pk_bf16(v1[2], v1[3]);
                    *(u32x4*)(rowp + bj * HALF) = w; } }
    }
};

struct PanelStats {
    unsigned* xbuf;
    unsigned* cnt;
    unsigned* tmo;
    int ntn; float eps;
    unsigned code;
    __device__ __forceinline__ bool run(const f32x4 (&v)[2][2][4][2], const Unit& u, int wr, int wc, int fr, int fq, PG8_LAS unsigned char* lds, int wid, int lane) const {
        typedef float f32x2v __attribute__((ext_vector_type(2)));
        PG8_LAS f32x2v* P = (PG8_LAS f32x2v*)lds;
        PG8_LAS f32x2v* S = (PG8_LAS f32x2v*)(lds + 8192);
        PG8_LAS unsigned* flag = (PG8_LAS unsigned*)(lds + 8192 + 2048);
#pragma unroll
        for (int ai = 0; ai < 2; ++ai)
#pragma unroll
            for (int m = 0; m < 4; ++m) {
                float s = 0.f;
#pragma unroll
                for (int bj = 0; bj < 2; ++bj)
#pragma unroll
                    for (int n = 0; n < 2; ++n) { const f32x4 x = v[ai][bj][m][n]; s += (x[0] + x[1]) + (x[2] + x[3]); }
                s += __shfl_xor(s, 16); s += __shfl_xor(s, 32);
                const float mw = s * (1.0f / 64.0f); float q = 0.f;
#pragma unroll
                for (int bj = 0; bj < 2; ++bj)
#pragma unroll
                    for (int n = 0; n < 2; ++n) { const f32x4 d = v[ai][bj][m][n] - mw; q += (d[0] * d[0] + d[1] * d[1]) + (d[2] * d[2] + d[3] * d[3]); }
                q += __shfl_xor(q, 16); q += __shfl_xor(q, 32);
                if (fq == 0) P[(ai * HALF + wr * 64 + m * 16 + fr) * 4 + wc] = (f32x2v){mw, q};
            }
        asm volatile("s_waitcnt lgkmcnt(0)" ::: "memory"); __builtin_amdgcn_s_barrier(); asm volatile("" ::: "memory");
#if defined(BROKEN_EXCHANGE_NO_WAIT)
#warning BROKEN CONTROL BUILD: the row-statistics exchange does not wait; results are wrong by design
        if (blockIdx.x >= 64) { const long long t0_ = clock64(); while (clock64() - t0_ < 60000) __builtin_amdgcn_s_sleep(8); }
#endif
        const int row = wid * 32 + (lane & 31);
        if (lane < 32) {
            const f32x2v a = P[row * 4 + 0], b = P[row * 4 + 1], c = P[row * 4 + 2], d = P[row * 4 + 3];
            const float mt = (a.x + b.x + c.x + d.x) * 0.25f;
            const float da = a.x - mt, db = b.x - mt, dc = c.x - mt, dd = d.x - mt;
            const float m2 = (a.y + b.y) + (c.y + d.y) + 64.0f * ((da * da + db * db) + (dc * dc + dd * dd));
            unsigned long long* slot = (unsigned long long*)xbuf + ((size_t)(u.pm * BM + row) * 4 + u.pn);
            __hip_atomic_store(slot, ((unsigned long long)__float_as_uint(m2) << 32) | __float_as_uint(mt), __ATOMIC_RELAXED, __HIP_MEMORY_SCOPE_AGENT);
        }
        asm volatile("s_waitcnt vmcnt(0)" ::: "memory");
        if (lane == 0) __hip_atomic_fetch_add(cnt + 64 * u.pm, 1u, __ATOMIC_RELAXED, __HIP_MEMORY_SCOPE_AGENT);
        if (wid == 0) {
            bool dead = false; const unsigned long long t0 = __builtin_amdgcn_s_memrealtime(); const unsigned want = 8u * (unsigned)ntn;
            for (;;) {
#if defined(BROKEN_EXCHANGE_NO_WAIT)
                break;
#endif
                if ((unsigned)__builtin_amdgcn_readfirstlane(__hip_atomic_load(cnt + 64 * u.pm, __ATOMIC_RELAXED, __HIP_MEMORY_SCOPE_AGENT)) >= want) break;
                if (__builtin_amdgcn_s_memrealtime() - t0 > 2000000ull) {
                    if (lane == 0) { unsigned expect = 0u; __hip_atomic_compare_exchange_strong(tmo + 1, &expect, code | (unsigned)(u.pm & 0xff), __ATOMIC_RELAXED, __ATOMIC_RELAXED, __HIP_MEMORY_SCOPE_AGENT);
                                     __hip_atomic_store(tmo, 1u, __ATOMIC_RELAXED, __HIP_MEMORY_SCOPE_AGENT); }
                    dead = true; break; }
                __builtin_amdgcn_s_sleep(2);
            }
            __builtin_amdgcn_fence(__ATOMIC_ACQUIRE, "agent");
            if (lane == 0) flag[0] = dead ? 1u : 0u;
        }
        asm volatile("s_waitcnt vmcnt(0) lgkmcnt(0)" ::: "memory"); __builtin_amdgcn_s_barrier(); asm volatile("" ::: "memory");
        const bool bad = flag[0] != 0u;
        if (lane < 32) {
            const unsigned long long* slot = (const unsigned long long*)xbuf + (size_t)(u.pm * BM + row) * 4; float mt[4], m2[4]; float ms = 0.f;
#pragma unroll
            for (int t = 0; t < 4; ++t) { if (t < ntn) { const unsigned long long w = __hip_atomic_load(slot + t, __ATOMIC_RELAXED, __HIP_MEMORY_SCOPE_AGENT); mt[t] = __uint_as_float((unsigned)w); m2[t] = __uint_as_float((unsigned)(w >> 32)); } else { mt[t] = 0.f; m2[t] = 0.f; } ms += mt[t]; }
            const float mean = ms / (float)ntn; float q = 0.f;
#pragma unroll
            for (int t = 0; t < 4; ++t) if (t < ntn) { const float dm = mt[t] - mean; q += m2[t] + 256.0f * dm * dm; }
            S[row] = (f32x2v){mean, 1.0f / sqrtf(q / (256.0f * (float)ntn) + eps)};
        }
        asm volatile("s_waitcnt lgkmcnt(0)" ::: "memory"); __builtin_amdgcn_s_barrier(); asm volatile("" ::: "memory");
        return bad;
    }
};
struct EpiLnRes {
    static constexpr bool PERM = false, AFTER_DRAIN = true;
    const float* base; float* out; int ldc; const float* bias; PanelStats st; unsigned poison;
    __device__ __forceinline__ void fused(f32x4 (&acc)[2][2][4][2], const Unit& u, int wr, int wc, int fr, int fq, PG8_LAS unsigned char* lds, int wid, int lane) const {
        typedef float f32x2v __attribute__((ext_vector_type(2)));
        const PG8_LAS f32x2v* S = (const PG8_LAS f32x2v*)(lds + 8192);
        const int col0 = u.pn * BM + wc * 32 + 4 * fq;
#pragma unroll
        for (int bj = 0; bj < 2; ++bj)
#pragma unroll
            for (int n = 0; n < 2; ++n) { const f32x4 bv = bias ? *(const f32x4*)(bias + col0 + bj * HALF + n * 16) : (f32x4){0.f, 0.f, 0.f, 0.f};
#pragma unroll
                for (int ai = 0; ai < 2; ++ai)
#pragma unroll
                    for (int m = 0; m < 4; ++m) acc[ai][bj][m][n] += bv; }
        f32x4 pre[4][2][2];
#pragma unroll
        for (int m = 0; m < 4; ++m) { const size_t off = (size_t)(u.pm * BM + wr * 64 + m * 16 + fr) * ldc + col0;
#pragma unroll
            for (int bj = 0; bj < 2; ++bj)
#pragma unroll
                for (int n = 0; n < 2; ++n) pre[m][bj][n] = *(const f32x4*)(base + off + bj * HALF + n * 16); }
        const bool bad = st.run(acc, u, wr, wc, fr, fq, lds, wid, lane) || poison != 0u;
        const float qnan = __builtin_nanf("");
#pragma unroll
        for (int ai = 0; ai < 2; ++ai)
#pragma unroll
            for (int m = 0; m < 4; ++m) { const int r = ai * HALF + wr * 64 + m * 16 + fr; const f32x2v sr = S[r]; const size_t off = (size_t)(u.pm * BM + r) * ldc + col0;
#pragma unroll
                for (int bj = 0; bj < 2; ++bj)
#pragma unroll
                    for (int n = 0; n < 2; ++n) { const f32x4 bs = ai == 0 ? pre[m][bj][n] : *(const f32x4*)(base + off + bj * HALF + n * 16); f32x4 o = bs + (acc[ai][bj][m][n] - sr.x) * sr.y;
                        if (bad) o = (f32x4){qnan, qnan, qnan, qnan}; *(f32x4*)(out + off + bj * HALF + n * 16) = o; }
                if (m & 1) asm volatile("" ::: "memory"); }
    }
};
struct EpiLnResLn {
    static constexpr bool PERM = false, AFTER_DRAIN = true;
    const float* base; float* out; bf16_t* xn; int ldc; const float* bias; PanelStats st1, st2; unsigned poison;
    __device__ __forceinline__ void fused(f32x4 (&acc)[2][2][4][2], const Unit& u, int wr, int wc, int fr, int fq, PG8_LAS unsigned char* lds, int wid, int lane) const {
        typedef float f32x2v __attribute__((ext_vector_type(2))); typedef unsigned u32x2v __attribute__((ext_vector_type(2)));
        const PG8_LAS f32x2v* S = (const PG8_LAS f32x2v*)(lds + 8192);
        const int col0 = u.pn * BM + wc * 32 + 4 * fq;
#pragma unroll
        for (int bj = 0; bj < 2; ++bj)
#pragma unroll
            for (int n = 0; n < 2; ++n) { const f32x4 bv = bias ? *(const f32x4*)(bias + col0 + bj * HALF + n * 16) : (f32x4){0.f, 0.f, 0.f, 0.f};
#pragma unroll
                for (int ai = 0; ai < 2; ++ai)
#pragma unroll
                    for (int m = 0; m < 4; ++m) acc[ai][bj][m][n] += bv; }
        bool bad = st1.run(acc, u, wr, wc, fr, fq, lds, wid, lane) || poison != 0u;
        const float qnan = __builtin_nanf("");
#pragma unroll
        for (int ai = 0; ai < 2; ++ai)
#pragma unroll
            for (int m = 0; m < 4; ++m) { const int r = ai * HALF + wr * 64 + m * 16 + fr; const f32x2v sr = S[r]; const size_t off = (size_t)(u.pm * BM + r) * ldc + col0;
#pragma unroll
                for (int bj = 0; bj < 2; ++bj)
#pragma unroll
                    for (int n = 0; n < 2; ++n) { const f32x4 bs = *(const f32x4*)(base + off + bj * HALF + n * 16); acc[ai][bj][m][n] = bs + (acc[ai][bj][m][n] - sr.x) * sr.y; }
                asm volatile("" : "+v"(acc[ai][0][m][0]), "+v"(acc[ai][0][m][1]), "+v"(acc[ai][1][m][0]), "+v"(acc[ai][1][m][1]));
                if (m & 1) asm volatile("" ::: "memory"); }
        const bool bad1 = bad;
        bad = st2.run(acc, u, wr, wc, fr, fq, lds, wid, lane) || bad;
#pragma unroll
        for (int ai = 0; ai < 2; ++ai)
#pragma unroll
            for (int m = 0; m < 4; ++m) { const int r = ai * HALF + wr * 64 + m * 16 + fr; const f32x2v sr = S[r]; const size_t off = (size_t)(u.pm * BM + r) * ldc + col0;
#pragma unroll
                for (int bj = 0; bj < 2; ++bj)
#pragma unroll
                    for (int n = 0; n < 2; ++n) { const f32x4 x1 = acc[ai][bj][m][n]; *(f32x4*)(out + off + bj * HALF + n * 16) = bad1 ? (f32x4){qnan, qnan, qnan, qnan} : x1;
                        const f32x4 o = (x1 - sr.x) * sr.y; u32x2v w; w.x = cvt_pk_bf16(o[0], o[1]); w.y = cvt_pk_bf16(o[2], o[3]);
                        if (bad) { w.x = 0x7fc07fc0u; w.y = 0x7fc07fc0u; } *(u32x2v*)(xn + off + bj * HALF + n * 16) = w; }
                asm volatile("" ::: "memory"); }
    }
};

template <class Epi, class Sched, bool ALIGN_EPI = false, bool SP2 = false>
__device__ __forceinline__ void gemm_phase(PG8_LAS unsigned char* lds, const Gemm g, const Sched& S, const Epi& E) {
    int tid_ = threadIdx.x; asm volatile("" : "+v"(tid_));
    const int tid = tid_, wid = __builtin_amdgcn_readfirstlane(tid >> 6), lane = tid & 63, wr = wid >> 2, wc = wid & 3, fr = lane & 15, fq = lane >> 4;
    const int K = g.K, nt = K / BK;
    unsigned voffA[2], voffB[2];
#pragma unroll
    for (int i = 0; i < 2; ++i) { int R, C; stage_rc(tid * 16 + i * 8192, R, C); const int Rb = Epi::PERM ? ((R & ~31) + perm32(R & 31)) : R;
        voffA[i] = (unsigned)(R * K + C) * 2u; voffB[i] = (unsigned)(Rb * K + C) * 2u; }
    const size_t kstep = (size_t)(BK * 2);
    const size_t hstep = (size_t)HALF * K * 2;
    const size_t tstep = 2 * hstep;
    const unsigned ldsw = (unsigned)wid * 1024u;
    const int aoff = lds_byte(wr * 64 + fr, fq * 8), boff = lds_byte(wc * 32 + fr, fq * 8);
#define PG8_SA(b, h) (((b) * 2 + (h)) * HTB)
#define PG8_SB(b, h) ((4 + (b) * 2 + (h)) * HTB)
#define PG8_STAGE(bufoff, gbase, voff) do { _Pragma("unroll") for (int _i = 0; _i < 2; ++_i) \
        __builtin_amdgcn_global_load_lds((const unsigned*)((const char*)(gbase) + (voff)[_i]), (PG8_LAS unsigned*)(lds + (bufoff) + ldsw + _i * 8192), 16, 0, 0); } while (0)
#define PG8_LDA(dst, b, h) do { _Pragma("unroll") for (int m = 0; m < 4; ++m) _Pragma("unroll") for (int k = 0; k < 2; ++k) dst[m][k] = *(const PG8_LAS bf16x8*)(lds + PG8_SA(b, h) + aoff + m * 2048 + k * 1024); } while (0)
#define PG8_LDB(dst, b, h) do { _Pragma("unroll") for (int n = 0; n < 2; ++n) _Pragma("unroll") for (int k = 0; k < 2; ++k) dst[n][k] = *(const PG8_LAS bf16x8*)(lds + PG8_SB(b, h) + boff + n * 2048 + k * 1024); } while (0)
#define PG8_MMA(ai, bj, At, Bt) do { __builtin_amdgcn_s_setprio(1); _Pragma("unroll") for (int m = 0; m < 4; ++m) _Pragma("unroll") for (int n = 0; n < 2; ++n) _Pragma("unroll") for (int k = 0; k < 2; ++k) \
        acc[ai][bj][m][n] = __builtin_amdgcn_mfma_f32_16x16x32_bf16(Bt[n][k], At[m][k], acc[ai][bj][m][n], 0, 0, 0); __builtin_amdgcn_s_setprio(0); } while (0)
#define PG8_WAIT_V(n) asm volatile("s_waitcnt vmcnt(" #n ")" ::: "memory")
#define PG8_WAIT_L(n) asm volatile("s_waitcnt lgkmcnt(" #n ")" ::: "memory")
#define PG8_BAR __builtin_amdgcn_s_barrier()
#define PG8_SCHED __builtin_amdgcn_sched_barrier(0)
    Unit cur, nxt; int ui = 0;
    if (!S.next(0, cur)) return;
    f32x4 acc[2][2][4][2];
#pragma unroll
    for (int a = 0; a < 2; ++a)
#pragma unroll
        for (int b = 0; b < 2; ++b)
#pragma unroll
            for (int m = 0; m < 4; ++m)
#pragma unroll
                for (int n = 0; n < 2; ++n) acc[a][b][m][n] = (f32x4){0.f, 0.f, 0.f, 0.f};
    bf16x8 At[4][2], B0[2][2], B1[2][2];
    const char* cA = (const char*)g.A + (size_t)cur.pm * tstep; const char* cB = (const char*)g.Bt + (size_t)cur.pn * tstep;
    S.a_ready(cur);
    if constexpr (SP2) {
        PG8_STAGE(PG8_SB(0, 0), cB, voffB); PG8_STAGE(PG8_SB(0, 1), cB + hstep, voffB); PG8_STAGE(PG8_SA(0, 0), cA, voffA); PG8_STAGE(PG8_SA(0, 1), cA + hstep, voffA);
        if (wr == 1) PG8_BAR;
        PG8_WAIT_V(2); PG8_BAR;
        PG8_STAGE(PG8_SB(1, 0), cB + kstep, voffB); PG8_STAGE(PG8_SA(1, 0), cA + kstep, voffA); PG8_STAGE(PG8_SB(1, 1), cB + hstep + kstep, voffB);
        PG8_WAIT_V(6); PG8_BAR;
    } else {
        PG8_STAGE(PG8_SB(0, 0), cB, voffB); PG8_STAGE(PG8_SA(0, 0), cA, voffA); PG8_STAGE(PG8_SB(0, 1), cB + hstep, voffB); PG8_STAGE(PG8_SA(0, 1), cA + hstep, voffA);
        if (wr == 1) PG8_BAR;
        PG8_WAIT_V(4); PG8_BAR;
        PG8_STAGE(PG8_SB(1, 0), cB + kstep, voffB); PG8_STAGE(PG8_SA(1, 0), cA + kstep, voffA); PG8_STAGE(PG8_SB(1, 1), cB + hstep + kstep, voffB);
        PG8_WAIT_V(6); PG8_BAR;
    }
    for (;;) {
        const bool has_next = S.next(ui + 1, nxt);
        const char* nA = has_next ? (const char*)g.A + (size_t)nxt.pm * tstep : cA; const char* nB = has_next ? (const char*)g.Bt + (size_t)nxt.pn * tstep : cB;
        for (int t = 0; t < nt; t += 2) {
            const bool last = (t == nt - 2);
            const char* a1 = cA + (size_t)(t + 1) * kstep;
            const char* a2 = last ? nA : cA + (size_t)(t + 2) * kstep; const char* b2 = last ? nB : cB + (size_t)(t + 2) * kstep;
            const char* a3 = a2 + kstep; const char* b3 = b2 + kstep;
            if (last && has_next) S.a_ready(nxt);
            if constexpr (SP2) {
            PG8_LDB(B0, 0, 0); PG8_LDB(B1, 0, 1); PG8_SCHED; PG8_LDA(At, 0, 0); PG8_STAGE(PG8_SA(1, 1), a1 + hstep, voffA);
            PG8_WAIT_V(8); PG8_WAIT_L(0); PG8_BAR; PG8_MMA(0, 0, At, B0); PG8_MMA(0, 1, At, B1); PG8_BAR; PG8_SCHED;
            PG8_LDA(At, 0, 1); PG8_STAGE(PG8_SB(0, 0), b2, voffB); PG8_STAGE(PG8_SB(0, 1), b2 + hstep, voffB); PG8_STAGE(PG8_SA(0, 0), a2, voffA);
            PG8_WAIT_V(8); PG8_WAIT_L(0); PG8_BAR; PG8_MMA(1, 0, At, B0); PG8_MMA(1, 1, At, B1); PG8_BAR; PG8_SCHED;
            PG8_LDB(B0, 1, 0); PG8_LDB(B1, 1, 1); PG8_SCHED; PG8_LDA(At, 1, 0); PG8_STAGE(PG8_SA(0, 1), a2 + hstep, voffA);
            PG8_WAIT_V(8); PG8_WAIT_L(0); PG8_BAR; PG8_MMA(0, 0, At, B0); PG8_MMA(0, 1, At, B1); PG8_BAR; PG8_SCHED;
            PG8_LDA(At, 1, 1); PG8_STAGE(PG8_SB(1, 0), b3, voffB); PG8_STAGE(PG8_SB(1, 1), b3 + hstep, voffB); PG8_STAGE(PG8_SA(1, 0), a3, voffA);
            PG8_WAIT_V(8); PG8_WAIT_L(0); PG8_BAR; PG8_MMA(1, 0, At, B0); PG8_MMA(1, 1, At, B1); PG8_BAR; PG8_SCHED;
            } else {
            PG8_LDB(B0, 0, 0); PG8_SCHED; PG8_LDA(At, 0, 0); PG8_STAGE(PG8_SA(1, 1), a1 + hstep, voffA);
            PG8_WAIT_L(8); PG8_BAR; PG8_WAIT_L(0); PG8_MMA(0, 0, At, B0); PG8_BAR; PG8_SCHED;
            PG8_LDB(B1, 0, 1); PG8_STAGE(PG8_SB(0, 0), b2, voffB);
            PG8_BAR; PG8_WAIT_L(0); PG8_MMA(0, 1, At, B1); PG8_BAR;
            PG8_LDA(At, 0, 1); PG8_STAGE(PG8_SA(0, 0), a2, voffA);
            PG8_BAR; PG8_WAIT_L(0); PG8_MMA(1, 0, At, B0); PG8_BAR; PG8_SCHED;
            PG8_STAGE(PG8_SB(0, 1), b2 + hstep, voffB);
            PG8_WAIT_V(6); PG8_BAR; PG8_MMA(1, 1, At, B1); PG8_BAR;
            PG8_LDB(B0, 1, 0); PG8_SCHED; PG8_LDA(At, 1, 0); PG8_STAGE(PG8_SA(0, 1), a2 + hstep, voffA);
            PG8_WAIT_L(8); PG8_BAR; PG8_WAIT_L(0); PG8_MMA(0, 0, At, B0); PG8_BAR; PG8_SCHED;
            PG8_LDB(B1, 1, 1); PG8_STAGE(PG8_SB(1, 0), b3, voffB);
            PG8_BAR; PG8_WAIT_L(0); PG8_MMA(0, 1, At, B1); PG8_BAR;
            PG8_LDA(At, 1, 1); PG8_STAGE(PG8_SA(1, 0), a3, voffA);
            PG8_BAR; PG8_WAIT_L(0); PG8_MMA(1, 0, At, B0); PG8_BAR; PG8_SCHED;
            PG8_STAGE(PG8_SB(1, 1), b3 + hstep, voffB);
            PG8_WAIT_V(6); PG8_BAR; PG8_MMA(1, 1, At, B1); PG8_BAR;
            }
        }
        if constexpr (ALIGN_EPI) { if (wr == 0) PG8_BAR; }
        if constexpr (!Epi::AFTER_DRAIN) { E(acc, cur, wr, wc, fr, fq); S.done(cur); }
        if (!has_next) break;
#pragma unroll
        for (int a = 0; a < 2; ++a)
#pragma unroll
            for (int b = 0; b < 2; ++b)
#pragma unroll
                for (int m = 0; m < 4; ++m)
#pragma unroll
                    for (int n = 0; n < 2; ++n) acc[a][b][m][n] = (f32x4){0.f, 0.f, 0.f, 0.f};
        cur = nxt; cA = nA; cB = nB; ++ui;
        if constexpr (ALIGN_EPI) { if (wr == 1) PG8_BAR; }
    }
    PG8_WAIT_V(0);
    if constexpr (!ALIGN_EPI) { if (wr == 0) PG8_BAR; }
    PG8_BAR;
    if constexpr (Epi::AFTER_DRAIN) { E.fused(acc, cur, wr, wc, fr, fq, lds, wid, lane); S.done(cur); }
#undef PG8_SA
#undef PG8_SB
#undef PG8_STAGE
#undef PG8_LDA
#undef PG8_LDB
#undef PG8_MMA
#undef PG8_WAIT_V
#undef PG8_WAIT_L
#undef PG8_BAR
#undef PG8_SCHED
}
}

constexpr int NB = 16, SEQ = 2048, DM = 1024, FF = 2816, MROWS = NB * SEQ;
constexpr int NGU = 2 * FF;
constexpr int NEV = 3584;
constexpr int NOD = 3072;
constexpr float RMS_EPS = 1e-6f;
constexpr float LOG2E = 1.4426950408889634f;
constexpr float QSCALE = 0.125f * LOG2E;

namespace epi {
using namespace pg8;
__device__ __forceinline__ unsigned pkbf(float lo, float hi) {
    typedef float f2_t __attribute__((ext_vector_type(2))); typedef __bf16 b2_t __attribute__((ext_vector_type(2)));
    f2_t v = {lo, hi}; b2_t b = __builtin_convertvector(v, b2_t); return __builtin_bit_cast(unsigned, b); }
__device__ __forceinline__ u32x4 pk8(const f32x4& a, const f32x4& b) { u32x4 w; w.x = pkbf(a[0], a[1]); w.y = pkbf(a[2], a[3]); w.z = pkbf(b[0], b[1]); w.w = pkbf(b[2], b[3]); return w; }

struct EpiSwiGLU {
    static constexpr bool PERM = true, AFTER_DRAIN = false;
    bf16_t* H; const float* rs;
    __device__ __forceinline__ void operator()(const f32x4 (&acc)[2][2][4][2], const Unit& u, int wr, int wc, int fr, int fq) const {
        const int row0 = u.pm * BM + wr * 64 + fr, col0 = u.pn * 128 + wc * 32 + 8 * fq;
#pragma unroll
        for (int ai = 0; ai < 2; ++ai)
#pragma unroll
            for (int m = 0; m < 4; ++m) {
                const int row = row0 + ai * HALF + m * 16; const float s = rs[row];
                f32x4 h[2];
#pragma unroll
                for (int n = 0; n < 2; ++n)
#pragma unroll
                    for (int j = 0; j < 4; ++j) { const float g = acc[ai][0][m][n][j] * s, uu = acc[ai][1][m][n][j] * s;
                        const float e = __builtin_amdgcn_exp2f(-LOG2E * g); h[n][j] = (g * uu) * __builtin_amdgcn_rcpf(1.0f + e); }
                *(u32x4*)(H + (size_t)row * FF + col0) = pk8(h[0], h[1]);
            }
    }
};
struct EpiF32 {
    static constexpr bool PERM = false, AFTER_DRAIN = false;
    float* Y; int ldc;
    __device__ __forceinline__ void operator()(const f32x4 (&acc)[2][2][4][2], const Unit& u, int wr, int wc, int fr, int fq) const {
        const int row0 = u.pm * BM + wr * 64 + fr, col0 = u.pn * BM + wc * 32 + 4 * fq;
#pragma unroll
        for (int ai = 0; ai < 2; ++ai)
#pragma unroll
            for (int m = 0; m < 4; ++m) { float* rowp = Y + (size_t)(row0 + ai * HALF + m * 16) * ldc + col0;
#pragma unroll
                for (int bj = 0; bj < 2; ++bj)
#pragma unroll
                    for (int n = 0; n < 2; ++n) *(f32x4*)(rowp + bj * HALF + n * 16) = acc[ai][bj][m][n]; }
    }
};
struct EpiProjOdd {
    static constexpr bool PERM = true, AFTER_DRAIN = false;
    bf16_t* Q; const float* rs;
    __device__ __forceinline__ void operator()(const f32x4 (&acc)[2][2][4][2], const Unit& u, int wr, int wc, int fr, int fq) const {
        const int t = u.pn >> 2; bf16_t* base = Q + (size_t)t * ((size_t)MROWS * DM); const float sc = t == 0 ? QSCALE : 1.f;
        const int row0 = u.pm * BM + wr * 64 + fr, col0 = (u.pn & 3) * BM + wc * 32 + 8 * fq;
#pragma unroll
        for (int ai = 0; ai < 2; ++ai)
#pragma unroll
            for (int m = 0; m < 4; ++m) { const int row = row0 + ai * HALF + m * 16; const float s = rs[row] * sc;
#pragma unroll
                for (int bj = 0; bj < 2; ++bj) *(u32x4*)(base + (size_t)row * DM + col0 + bj * HALF) = pk8(acc[ai][bj][m][0] * s, acc[ai][bj][m][1] * s); }
    }
};
struct EpiProjEven {
    static constexpr bool PERM = true, AFTER_DRAIN = false;
    bf16_t *R1, *IQ, *IK; float* IW; const float* rs;
    const float *c64, *s64, *c32, *s32;
    __device__ __forceinline__ void operator()(const f32x4 (&acc)[2][2][4][2], const Unit& u, int wr, int wc, int fr, int fq) const {
        const int pn = u.pn, row0 = u.pm * BM + wr * 64 + fr;
        if (pn == 4 || pn == 5 || pn == 10 || pn == 11) {
            bf16_t* base = R1 + (size_t)(pn >> 1) * ((size_t)MROWS * 512); const int col0 = (pn & 1) * BM + wc * 32 + 8 * fq;
#pragma unroll
            for (int ai = 0; ai < 2; ++ai)
#pragma unroll
                for (int m = 0; m < 4; ++m) { const int row = row0 + ai * HALF + m * 16; const float s = rs[row];
#pragma unroll
                    for (int bj = 0; bj < 2; ++bj) *(u32x4*)(base + (size_t)row * 512 + col0 + bj * HALF) = pk8(acc[ai][bj][m][0] * s, acc[ai][bj][m][1] * s); }
        } else if (pn < 12) {
            bf16_t* base = R1 + (size_t)(pn >> 1) * ((size_t)MROWS * 512);
            const float sc = (pn < 2 || pn == 6 || pn == 7) ? QSCALE : 1.f;
            const int head = 4 * (pn & 1) + wc, d0 = 8 * fq;
#pragma unroll
            for (int ai = 0; ai < 2; ++ai)
#pragma unroll
                for (int m = 0; m < 4; ++m) { const int row = row0 + ai * HALF + m * 16, pos = row & (SEQ - 1); const float s = rs[row] * sc;
                    f32x4 o1[2], o2[2];
#pragma unroll
                    for (int n = 0; n < 2; ++n) { const f32x4 cc = *(const f32x4*)(c64 + pos * 32 + d0 + 4 * n), ss = *(const f32x4*)(s64 + pos * 32 + d0 + 4 * n);
                        const f32x4 x1 = acc[ai][0][m][n] * s, x2 = acc[ai][1][m][n] * s; o1[n] = x1 * cc - x2 * ss; o2[n] = x2 * cc + x1 * ss; }
                    bf16_t* dst = base + (size_t)row * 512 + head * 64 + d0;
                    *(u32x4*)dst = pk8(o1[0], o1[1]); *(u32x4*)(dst + 32) = pk8(o2[0], o2[1]); }
        } else if (pn == 12) {
            const int head = 2 * wc + (fq >> 1), d0 = 8 * (fq & 1);
#pragma unroll
            for (int ai = 0; ai < 2; ++ai)
#pragma unroll
                for (int m = 0; m < 4; ++m) { const int row = row0 + ai * HALF + m * 16, pos = row & (SEQ - 1); const float s = rs[row];
                    f32x4 o1[2], o2[2];
#pragma unroll
                    for (int n = 0; n < 2; ++n) { const f32x4 cc = *(const f32x4*)(c32 + pos * 16 + d0 + 4 * n), ss = *(const f32x4*)(s32 + pos * 16 + d0 + 4 * n);
                        const f32x4 x1 = acc[ai][0][m][n] * s, x2 = acc[ai][1][m][n] * s; o1[n] = x1 * cc - x2 * ss; o2[n] = x2 * cc + x1 * ss; }
                    bf16_t* dst = IQ + (size_t)row * 256 + head * 32 + d0;
                    *(u32x4*)dst = pk8(o1[0], o1[1]); *(u32x4*)(dst + 16) = pk8(o2[0], o2[1]); }
        } else {
            if (wc == 0 && fq < 2) {
                const int d0 = 8 * fq;
#pragma unroll
                for (int ai = 0; ai < 2; ++ai)
#pragma unroll
                    for (int m = 0; m < 4; ++m) { const int row = row0 + ai * HALF + m * 16, pos = row & (SEQ - 1); const float s = rs[row];
                        f32x4 o1[2], o2[2];
#pragma unroll
                        for (int n = 0; n < 2; ++n) { const f32x4 cc = *(const f32x4*)(c32 + pos * 16 + d0 + 4 * n), ss = *(const f32x4*)(s32 + pos * 16 + d0 + 4 * n);
                            const f32x4 x1 = acc[ai][0][m][n] * s, x2 = acc[ai][1][m][n] * s; o1[n] = x1 * cc - x2 * ss; o2[n] = x2 * cc + x1 * ss; }
                        bf16_t* dst = IK + (size_t)row * 32 + d0;
                        *(u32x4*)dst = pk8(o1[0], o1[1]); *(u32x4*)(dst + 16) = pk8(o2[0], o2[1]); }
            } else if (wc == 0 && fq == 2) {
#pragma unroll
                for (int ai = 0; ai < 2; ++ai)
#pragma unroll
                    for (int m = 0; m < 4; ++m) { const int row = row0 + ai * HALF + m * 16; const float s = rs[row] * 0.0625f;
                        *(f32x4*)(IW + (size_t)row * 8) = acc[ai][0][m][0] * s; *(f32x4*)(IW + (size_t)row * 8 + 4) = acc[ai][0][m][1] * s; }
            }
        }
    }
};
}

namespace att {
#define ALAS __attribute__((address_space(3)))
typedef unsigned short bf16_t;
typedef short bf16x8 __attribute__((ext_vector_type(8)));
typedef short s16x4 __attribute__((ext_vector_type(4)));
typedef float f32x16 __attribute__((ext_vector_type(16)));
typedef float f32x4 __attribute__((ext_vector_type(4)));
typedef unsigned u32x4 __attribute__((ext_vector_type(4)));
typedef short v4i16_t __attribute__((ext_vector_type(4)));
__device__ __forceinline__ int crow(int r, int hi) { return (r & 3) + 8 * (r >> 2) + 4 * hi; }
__device__ __forceinline__ unsigned cvtpk(float lo, float hi) { typedef float f2_t __attribute__((ext_vector_type(2))); typedef __bf16 b2_t __attribute__((ext_vector_type(2)));
    f2_t v = {lo, hi}; b2_t b = __builtin_convertvector(v, b2_t); return __builtin_bit_cast(unsigned, b); }
__device__ __forceinline__ s16x4 vtr(const ALAS unsigned char* p) { return __builtin_bit_cast(s16x4, __builtin_amdgcn_ds_read_tr16_b64_v4i16((ALAS v4i16_t*)p)); }
__device__ __forceinline__ float halfswap_max(float m) { auto rr = __builtin_amdgcn_permlane32_swap(__float_as_uint(m), __float_as_uint(m), false, false); return fmaxf(__uint_as_float(rr[0]), __uint_as_float(rr[1])); }
__device__ __forceinline__ float halfswap_sum(float m) { auto rr = __builtin_amdgcn_permlane32_swap(__float_as_uint(m), __float_as_uint(m), false, false); return __uint_as_float(rr[0]) + __uint_as_float(rr[1]); }

template <int DV> struct Lds {
    static constexpr int KB = 8192, VB = DV * 128;
    static constexpr int OFF_K = 0, OFF_V = 2 * KB, OFF_WSF = OFF_V + 2 * VB, OFF_BT = OFF_WSF + 8 * 256, OFF_OST = OFF_BT + 2048, OST_W = 32 * DV * 2, TOTAL = OFF_OST + 8 * OST_W;
};

template <int DV, int MODE, int THR>
__device__ __forceinline__ void attn_core(f32x16 (&o)[DV / 32], ALAS unsigned char* lds,
                                          const bf16_t* Qw, int ldq, const bf16_t* Kh, int ldk, const bf16_t* Vh, int ldv,
                                          int T0, int T1, int tw0, int tw1,
                                          const unsigned long long* maskrow, int qpos, int qchunk) {
    typedef Lds<DV> L; constexpr int NDB = DV / 32, NVL = DV / 64;
    int tid = threadIdx.x; asm volatile("" : "+v"(tid));
    const int lane = tid & 63, r32 = lane & 31, hi = lane >> 5; const int wid = __builtin_amdgcn_readfirstlane(tid >> 6);
    ALAS float* wsf = (ALAS float*)(lds + L::OFF_WSF) + wid * 64;
    const ALAS float* btab = (const ALAS float*)(lds + L::OFF_BT);
    bf16x8 qr[4];
#pragma unroll
    for (int d0 = 0; d0 < 4; ++d0) qr[d0] = *(const bf16x8*)(Qw + (size_t)r32 * ldq + d0 * 16 + hi * 8);
    const int skey = tid >> 3, sch = tid & 7;
    const bf16_t* kg = Kh + (size_t)skey * ldk + sch * 8; const bf16_t* vg = Vh + (size_t)skey * ldv + sch * 8;
    const int koff = sch * 1024 + skey * 16; int voff[NVL];
#pragma unroll
    for (int i = 0; i < NVL; ++i) { const int c2 = sch + 8 * i; voff[i] = (c2 >> 2) * 4096 + skey * 64 + (c2 & 3) * 16; }
    u32x4 kreg, vreg[NVL];
#define ATT_LOADT(t) do { kreg = *(const u32x4*)(kg + (size_t)(t) * 64 * ldk); _Pragma("unroll") for (int i_ = 0; i_ < NVL; ++i_) vreg[i_] = *(const u32x4*)(vg + (size_t)(t) * 64 * ldv + 64 * i_); } while (0)
#define ATT_WRITET(buf) do { *(ALAS u32x4*)(lds + L::OFF_K + (buf) * L::KB + koff) = kreg; _Pragma("unroll") for (int i_ = 0; i_ < NVL; ++i_) *(ALAS u32x4*)(lds + L::OFF_V + (buf) * L::VB + voff[i_]) = vreg[i_]; } while (0)
    float m_run = -1e30f, l_part = 0.f;
#pragma unroll
    for (int d0 = 0; d0 < NDB; ++d0) o[d0] = f32x16{};
    unsigned long long mw = 0ull;
    if (MODE == 1) mw = maskrow[tw0];
    ATT_LOADT(T0); ATT_WRITET(0); __syncthreads();
    for (int t = T0; t < T1; ++t) {
        const int cur = (t - T0) & 1; const bool more = (t + 1 < T1);
        if (more) ATT_LOADT(t + 1);
        if (t >= tw0 && t < tw1) {
            unsigned long long mwn = 0ull;
            if (MODE == 1) { if (t + 1 < tw1) mwn = maskrow[t + 1]; }
            f32x16 p0, p1;
            if (MODE == 2) {
                const int jrel = qchunk - t;
                if (jrel >= 5) { const float bc = btab[319];
#pragma unroll
                    for (int r = 0; r < 16; ++r) { p0[r] = bc; p1[r] = bc; } }
                else { const int base = qpos - 64 * t;
#pragma unroll
                    for (int r = 0; r < 16; ++r) { const int d = base - crow(r, hi); const int i0 = (d < 256 ? d : 256) + 63, i1 = (d - 32 < 256 ? d - 32 : 256) + 63; p0[r] = btab[i0]; p1[r] = btab[i1]; } }
            } else { p0 = f32x16{}; p1 = f32x16{}; }
            const ALAS unsigned char* kb = lds + L::OFF_K + cur * L::KB + hi * 1024 + r32 * 16;
#pragma unroll
            for (int d0 = 0; d0 < 4; ++d0) { const bf16x8 b0 = *(const ALAS bf16x8*)(kb + d0 * 2048), b1 = *(const ALAS bf16x8*)(kb + d0 * 2048 + 512);
                p0 = __builtin_amdgcn_mfma_f32_32x32x16_bf16(b0, qr[d0], p0, 0, 0, 0); p1 = __builtin_amdgcn_mfma_f32_32x32x16_bf16(b1, qr[d0], p1, 0, 0, 0); }
            if (MODE == 1) { const unsigned w0 = (unsigned)mw >> (4 * hi), w1 = (unsigned)(mw >> 32) >> (4 * hi);
#pragma unroll
                for (int r = 0; r < 16; ++r) { const unsigned bit = 1u << ((r & 3) + 8 * (r >> 2)); p0[r] = (w0 & bit) ? p0[r] : -INFINITY; p1[r] = (w1 & bit) ? p1[r] : -INFINITY; }
                mw = mwn; }
            float mx = fmaxf(p0[0], p1[0]);
#pragma unroll
            for (int r = 1; r < 16; ++r) mx = fmaxf(mx, fmaxf(p0[r], p1[r]));
            mx = halfswap_max(mx);
            if (__any(mx > m_run + (float)THR)) {
                const float mnew = fmaxf(m_run, mx); const float f = __builtin_amdgcn_exp2f(m_run - mnew);
                l_part *= f; m_run = mnew; if (hi == 0) wsf[r32] = f;
#pragma unroll
                for (int r = 0; r < 16; ++r) { const float fr_ = wsf[crow(r, hi)];
#pragma unroll
                    for (int d0 = 0; d0 < NDB; ++d0) o[d0][r] *= fr_; }
            }
            float sacc = 0.f;
#pragma unroll
            for (int r = 0; r < 16; ++r) { p0[r] = __builtin_amdgcn_exp2f(p0[r] - m_run); p1[r] = __builtin_amdgcn_exp2f(p1[r] - m_run); sacc += p0[r] + p1[r]; }
            l_part += sacc;
            u32x4 pw[4];
#pragma unroll
            for (int k = 0; k < 2; ++k)
#pragma unroll
                for (int j = 0; j < 4; ++j) { pw[k][j] = cvtpk(p0[8 * k + 2 * j], p0[8 * k + 2 * j + 1]); pw[2 + k][j] = cvtpk(p1[8 * k + 2 * j], p1[8 * k + 2 * j + 1]); }
            const ALAS unsigned char* vb = lds + L::OFF_V + cur * L::VB + ((lane >> 4) & 1) * 32 + (lane & 3) * 8 + (4 * hi + ((lane & 15) >> 2)) * 64;
#pragma unroll
            for (int d0 = 0; d0 < NDB; ++d0)
#pragma unroll
                for (int ks = 0; ks < 4; ++ks) { const s16x4 lo = vtr(vb + d0 * 4096 + ks * 1024), up = vtr(vb + d0 * 4096 + ks * 1024 + 512);
                    const bf16x8 vf = (bf16x8){lo[0], lo[1], lo[2], lo[3], up[0], up[1], up[2], up[3]};
                    o[d0] = __builtin_amdgcn_mfma_f32_32x32x16_bf16(__builtin_bit_cast(bf16x8, pw[ks]), vf, o[d0], 0, 0, 0); }
        }
        if (more) ATT_WRITET(cur ^ 1);
        __syncthreads();
    }
#undef ATT_LOADT
#undef ATT_WRITET
    const float l = halfswap_sum(l_part);
    if (hi == 0) wsf[32 + r32] = l;
#pragma unroll
    for (int r = 0; r < 16; ++r) { const float rl = 1.0f / wsf[32 + crow(r, hi)];
#pragma unroll
        for (int d0 = 0; d0 < NDB; ++d0) o[d0][r] *= rl; }
}

template <int DV>
__device__ __forceinline__ void store_o(const f32x16 (&o)[DV / 32], ALAS unsigned char* lds, bf16_t* dst, int ldo) {
    typedef Lds<DV> L; constexpr int NDB = DV / 32, CPR = DV / 8, RPI = 64 / CPR;
    int tid = threadIdx.x; asm volatile("" : "+v"(tid));
    const int lane = tid & 63, r32 = lane & 31, hi = lane >> 5; const int wid = __builtin_amdgcn_readfirstlane(tid >> 6);
    ALAS bf16_t* stg = (ALAS bf16_t*)(lds + L::OFF_OST + wid * L::OST_W);
#pragma unroll
    for (int r = 0; r < 16; ++r) { const int orow = crow(r, hi);
#pragma unroll
        for (int d0 = 0; d0 < NDB; ++d0) stg[orow * DV + d0 * 32 + r32] = (bf16_t)(cvtpk(o[d0][r], 0.f) & 0xffffu); }
#pragma unroll
    for (int i = 0; i < 32 / RPI; ++i) { const int row = i * RPI + lane / CPR, ch = lane % CPR; const u32x4 v = *(const ALAS u32x4*)(stg + row * DV + ch * 8); *(u32x4*)(dst + (size_t)row * ldo + ch * 8) = v; }
}
}
#define GAS __attribute__((address_space(1)))
#define LAS __attribute__((address_space(3)))
typedef unsigned short bf16;
typedef unsigned v4u __attribute__((ext_vector_type(4)));
typedef float f32x4 __attribute__((ext_vector_type(4)));
typedef short bf16x8 __attribute__((ext_vector_type(8)));
typedef GAS unsigned gu32;
typedef GAS unsigned long long gu64;
#define RLX_AGENT __ATOMIC_RELAXED, __HIP_MEMORY_SCOPE_AGENT
#define LDS_WAIT() asm volatile("s_waitcnt lgkmcnt(0)" ::: "memory")
#define VM_WAIT() asm volatile("s_waitcnt vmcnt(0)" ::: "memory")
__device__ __forceinline__ unsigned long long rt() { return __builtin_amdgcn_s_memrealtime(); }
__device__ __forceinline__ unsigned f2bf(float f) { unsigned u = __builtin_bit_cast(unsigned, f); return (u + 0x7fffu + ((u >> 16) & 1u)) >> 16; }
__device__ __forceinline__ unsigned pk2(float lo, float hi) { return f2bf(lo) | (f2bf(hi) << 16); }

#define XB_TMO      128
#define XB_XCNT(j)  (256  + 64 * (j))
#define XB_XSUB(j)  (1280 + 64 * (j))
#define XB_XGEN(j)  (2304 + 64 * (j))
#define XB_TOP      3328
#define XB_TOPGEN   3392
#define XCD_BAR_WORDS 3456
#define XB_SPIN_CAP (1u << 18)

__device__ __forceinline__ unsigned xb_ld(unsigned* p)              { return __hip_atomic_load(p, __ATOMIC_RELAXED, __HIP_MEMORY_SCOPE_AGENT); }
__device__ __forceinline__ unsigned xb_add(unsigned* p, unsigned v) { return __hip_atomic_fetch_add(p, v, __ATOMIC_RELAXED, __HIP_MEMORY_SCOPE_AGENT); }
__device__ __forceinline__ unsigned xb_xcc_id() { return (unsigned)__builtin_amdgcn_s_getreg((3 << 11) | 20) & 0xFu; }
#define XB_SPIN(cond, bar) do { unsigned _sp = 0; while (cond) { __builtin_amdgcn_s_sleep(1); \
    if ((++_sp & 255u) == 0u) { if (xb_ld(&(bar)[XB_TMO])) break; if (_sp > XB_SPIN_CAP) { atomicAdd(&(bar)[XB_TMO], 1u); break; } } } } while (0)

struct XcdBarrier {
    unsigned* bar; unsigned x;
    volatile LAS unsigned* st;
};

__device__ __forceinline__ XcdBarrier xcd_barrier_post(unsigned* bar, volatile LAS unsigned* st) {
    XcdBarrier b; b.bar = bar; b.x = xb_xcc_id(); b.st = st;
    if (threadIdx.x == 0) (void)xb_add(&bar[XB_XCNT(b.x)], 1u);
    return b;
}
__device__ __forceinline__ void xcd_barrier_complete(unsigned* bar, unsigned x, unsigned& nloc, unsigned& nx) {
    const unsigned G = gridDim.x * gridDim.y * gridDim.z;
    unsigned sum, cnt, mine, sp = 0u;
    for (;;) {
        sum = 0u; cnt = 0u; mine = 0u;
#pragma unroll
        for (unsigned j = 0; j < 16; ++j) { const unsigned c = xb_ld(&bar[XB_XCNT(j)]); sum += c; cnt += (c > 0u) ? 1u : 0u; mine = (j == x) ? c : mine; }
        if (sum == G) break;
        __builtin_amdgcn_s_sleep(1);
        if ((++sp & 255u) == 0u) { if (xb_ld(&bar[XB_TMO])) break; if (sp > XB_SPIN_CAP) { atomicAdd(&bar[XB_TMO], 1u); break; } }
    }
    nloc = mine > 0u ? mine : 1u; nx = cnt > 0u ? cnt : 1u;
}

__device__ __forceinline__ void xcd_barrier(const XcdBarrier& b) {
    asm volatile("s_waitcnt vmcnt(0)" ::: "memory");
    __syncthreads();
    if (threadIdx.x == 0) {
        unsigned* bar = b.bar;
        __builtin_amdgcn_s_waitcnt(0);
        unsigned nloc = b.st[0], nx = b.st[1];
        if (nloc == 0u) { xcd_barrier_complete(bar, b.x, nloc, nx); b.st[0] = nloc; b.st[1] = nx; }
        const unsigned old = xb_add(&bar[XB_XSUB(b.x)], 1u);
        const unsigned gen = old / nloc;
        if (old + 1u == (gen + 1u) * nloc) {
            __builtin_amdgcn_fence(__ATOMIC_RELEASE, "agent");
            asm volatile("s_waitcnt vmcnt(0)" ::: "memory");
            const unsigned og = xb_add(&bar[XB_TOP], 1u);
            const unsigned tg = og / nx;
            if (og + 1u == (tg + 1u) * nx) xb_add(&bar[XB_TOPGEN], 1u);
            else XB_SPIN(xb_ld(&bar[XB_TOPGEN]) == tg, bar);
            __builtin_amdgcn_fence(__ATOMIC_ACQUIRE, "agent");
            xb_add(&bar[XB_XGEN(b.x)], 1u);
            asm volatile("s_waitcnt vmcnt(0)" ::: "memory");
        } else {
            XB_SPIN(xb_ld(&bar[XB_XGEN(b.x)]) == gen, bar);
            __builtin_amdgcn_fence(__ATOMIC_ACQUIRE, "agent");
            asm volatile("s_waitcnt vmcnt(0)" ::: "memory");
        }
    }
    __syncthreads();
}

constexpr int NWAVES = 8;
constexpr size_t MiB = 1u << 20;
constexpr size_t WS_CTL = 0, CTL_ZERO_BYTES = 1 * MiB;
constexpr size_t WS_C64 = 1 * MiB, WS_S64 = WS_C64 + 256 * 1024, WS_C32 = WS_C64 + 512 * 1024, WS_S32 = WS_C64 + 640 * 1024, WS_RS = WS_C64 + 768 * 1024;
constexpr size_t WS_WGU = 2 * MiB, WGU_BYTES = (size_t)NGU * DM * 2;
constexpr size_t WS_WD = 46 * MiB, WD_BYTES = (size_t)DM * FF * 2;
constexpr size_t WS_WIN0 = 68 * MiB, WS_WOUT0 = 75 * MiB, WS_WIN1 = 77 * MiB, WS_WOUT1 = 83 * MiB;
constexpr size_t WS_MASK = 85 * MiB;
constexpr size_t WS_XB = 93 * MiB;
constexpr size_t WS_R1 = 157 * MiB;
constexpr size_t WS_Y = 381 * MiB;
constexpr size_t WS_END = 509 * MiB;
static_assert(WS_WGU + 4 * WGU_BYTES <= WS_WD && WS_WD + 4 * WD_BYTES <= WS_WIN0 && WS_WIN0 + (size_t)NEV * DM * 2 <= WS_WOUT0 && WS_WIN1 + (size_t)NOD * DM * 2 <= WS_WOUT1, "weight map");
static_assert(WS_R1 + (size_t)MROWS * FF * 2 <= WS_Y && WS_R1 + 211 * MiB <= WS_Y, "R1 map");
constexpr int CW_BAR = 4096;
constexpr int RING_BYTES = 131072, LDSCTL_OFF = RING_BYTES, MISC_OFF = LDSCTL_OFF + 320, LDS_BYTES = 147456;

struct Frame {
    LAS unsigned char* lds; volatile LAS unsigned* MISC; gu32* ctl;
    int tid, lane, wave, vcu, G;
};

template <int X> __device__ __forceinline__ float swz_xor(float v) { return __int_as_float(__builtin_amdgcn_ds_swizzle(__float_as_int(v), (X << 10) | 0x1f)); }
__device__ __forceinline__ float sum32(float v) { v += swz_xor<1>(v); v += swz_xor<2>(v); v += swz_xor<4>(v); v += swz_xor<8>(v); v += swz_xor<16>(v); return v; }
__device__ __forceinline__ float wave_sum(float v) { return att::halfswap_sum(sum32(v)); }
struct MapGUHalf { int bj; __device__ __forceinline__ int src(int R) const { return R; } __device__ __forceinline__ int dst(int R) const { return 256 * (R >> 7) + 128 * bj + (R & 127); } };
struct MapId { __device__ __forceinline__ int src(int R) const { return R; } __device__ __forceinline__ int dst(int R) const { return R; } };
__device__ __forceinline__ int even_src(int R) {
    const int pn = R >> 8, bj = (R >> 7) & 1, jj = R & 127;
    if (pn < 4) return (pn < 2 ? 0 : 512) + (4 * (pn & 1) + (jj >> 5)) * 64 + 32 * bj + (jj & 31);
    if (pn < 6) return 1024 + 256 * (pn - 4) + 128 * bj + jj;
    if (pn < 10) return (pn < 8 ? 1536 : 2048) + (4 * (pn & 1) + (jj >> 5)) * 64 + 32 * bj + (jj & 31);
    if (pn < 12) return 2560 + 256 * (pn - 10) + 128 * bj + jj;
    if (pn == 12) return 3072 + (jj >> 4) * 32 + 16 * bj + (jj & 15);
    if (jj < 16) return 3328 + 16 * bj + jj;
    if (bj == 0 && jj < 24) return 3360 + (jj - 16);
    return -1;
}
struct MapEven { __device__ __forceinline__ int src(int R) const { return even_src(R); } __device__ __forceinline__ int dst(int R) const { return R; } };
template <class Map>
__device__ __forceinline__ void transpose_item(const Map& mp, const float* W, int ldw, int K, int nrows, bf16* WT, const float* g, LAS float* scr, int item, int lane) {
    const int nblk = nrows / 32, kb = item / nblk, nb = item % nblk, k0 = 64 * kb, n0 = 32 * nb;
    const int sc0 = mp.src(n0 + (lane & 31)); const float mul = sc0 >= 0 ? 1.f : 0.f; const float* src = W + (sc0 >= 0 ? sc0 : 0);
#pragma unroll 8
    for (int i = 0; i < 32; ++i) { const int kk = 2 * i + (lane >> 5); float v = src[(size_t)(k0 + kk) * ldw] * mul; if (g) v *= g[k0 + kk]; scr[kk * 33 + (lane & 31)] = v; }
    LDS_WAIT(); asm volatile("" ::: "memory");
    const int c = lane & 7;
#pragma unroll
    for (int j = 0; j < 4; ++j) { const int n = (lane >> 3) + 8 * j; const LAS float* s = scr + (8 * c) * 33 + n;
        v4u o; o.x = pk2(s[0 * 33], s[1 * 33]); o.y = pk2(s[2 * 33], s[3 * 33]); o.z = pk2(s[4 * 33], s[5 * 33]); o.w = pk2(s[6 * 33], s[7 * 33]);
        *(GAS v4u*)(WT + (size_t)mp.dst(n0 + n) * K + k0 + 8 * c) = o; }
    LDS_WAIT(); asm volatile("" ::: "memory");
}
__device__ __forceinline__ void sincos_d(double a, float& sn, float& cs) {
    const double k = __builtin_rint(a * 0.6366197723675814); const double y = a - k * 1.5707963267948966; const double y2 = y * y;
    const double s = y * (1.0 + y2 * (-1.0 / 6 + y2 * (1.0 / 120 + y2 * (-1.0 / 5040 + y2 * (1.0 / 362880 + y2 * (-1.0 / 39916800 + y2 * (1.0 / 6227020800.0)))))));
    const double c = 1.0 + y2 * (-0.5 + y2 * (1.0 / 24 + y2 * (-1.0 / 720 + y2 * (1.0 / 40320 + y2 * (-1.0 / 3628800 + y2 * (1.0 / 479001600.0 + y2 * (-1.0 / 87178291200.0)))))));
    const int q = (int)((long long)k & 3);
    const double ss = (q == 0) ? s : (q == 1) ? c : (q == 2) ? -s : -c, cc = (q == 0) ? c : (q == 1) ? -s : (q == 2) ? -c : s;
    sn = (float)ss; cs = (float)cc;
}
__device__ __forceinline__ void x_to_bf16_row(const float* xrow, bf16* xb, float* rs, int lane) {
    const GAS f32x4* xr = (const GAS f32x4*)xrow + lane; f32x4 v[4]; float s = 0.f;
#pragma unroll
    for (int j = 0; j < 4; ++j) { v[j] = xr[64 * j]; s += (v[j].x * v[j].x + v[j].y * v[j].y) + (v[j].z * v[j].z + v[j].w * v[j].w); }
    GAS unsigned long long* o8 = (GAS unsigned long long*)xb + lane;
#pragma unroll
    for (int j = 0; j < 4; ++j) o8[64 * j] = (unsigned long long)epi::pkbf(v[j].x, v[j].y) | ((unsigned long long)epi::pkbf(v[j].z, v[j].w) << 32);
    const float r = 1.0f / sqrtf(wave_sum(s) * (1.f / DM) + RMS_EPS); if (lane == 0) *rs = r;
}
__device__ __forceinline__ void thin_row(const float* yrow, const float* xirow, float* xorow, bf16* xb, const float* ga, float alpha, float* rs, int lane) {
    const GAS f32x4* yr = (const GAS f32x4*)yrow + lane; const GAS f32x4* xr = (const GAS f32x4*)xirow + lane; const GAS f32x4* gr = (const GAS f32x4*)ga + lane;
    f32x4 y[4], x[4]; float s = 0.f;
#pragma unroll
    for (int j = 0; j < 4; ++j) { y[j] = yr[64 * j]; x[j] = xr[64 * j]; s += (y[j].x * y[j].x + y[j].y * y[j].y) + (y[j].z * y[j].z + y[j].w * y[j].w); }
    const float r1 = alpha / sqrtf(wave_sum(s) * (1.f / DM) + RMS_EPS); float s2 = 0.f;
    GAS f32x4* xo = (GAS f32x4*)xorow + lane; GAS unsigned long long* o8 = (GAS unsigned long long*)xb + lane;
#pragma unroll
    for (int j = 0; j < 4; ++j) { const f32x4 g = gr[64 * j]; const f32x4 v = x[j] + y[j] * g * r1; s2 += (v.x * v.x + v.y * v.y) + (v.z * v.z + v.w * v.w); xo[64 * j] = v;
        o8[64 * j] = (unsigned long long)epi::pkbf(v.x, v.y) | ((unsigned long long)epi::pkbf(v.z, v.w) << 32); }
    const float r2 = 1.0f / sqrtf(wave_sum(s2) * (1.f / DM) + RMS_EPS); if (lane == 0) *rs = r2;
}

struct Ptrs {
    const float *x, *norm_g, *wg, *wu, *wd, *ewin, *ewout, *elam, *esub, *owin, *owout, *obias; float* out; unsigned char* ws;
};

__device__ __forceinline__ void p0_prologue(Frame& F0, const Ptrs& P) {
    struct { LAS unsigned char* lds; int tid, lane, wave, vcu, G; } F;
    { int t = threadIdx.x; asm volatile("" : "+v"(t)); F.lds = F0.lds; F.tid = t; F.lane = t & 63; F.wave = __builtin_amdgcn_readfirstlane(t >> 6); F.vcu = F0.vcu; F.G = F0.G; }
    LAS float* scr = (LAS float*)(F.lds + F.wave * 16384);
    const int gw = F.vcu * NWAVES + F.wave, NGW = F.G * NWAVES;
    constexpr int I_GH = (DM / 64) * (FF / 32), I_WD = (FF / 64) * (DM / 32), I_E = (DM / 64) * (NEV / 32), I_O = (DM / 64) * (DM / 32), I_OD = (DM / 64) * (NOD / 32);
    constexpr int NITEMS = 8 * I_GH + 4 * I_WD + I_E + I_O + I_OD + I_O;
    for (int it = gw; it < NITEMS; it += NGW) {
        int r = it;
        if (r < 8 * I_GH) { const int i8 = r / I_GH; r -= i8 * I_GH; const int i = i8 >> 1, bj = i8 & 1, l = i >> 1, f = i & 1;
            MapGUHalf mp{bj}; const float* W = (bj ? P.wu : P.wg) + (size_t)i * DM * FF;
            transpose_item(mp, W, FF, DM, FF, (bf16*)(P.ws + WS_WGU + i * WGU_BYTES), P.norm_g + (l * 6 + 4 * f) * DM, scr, r, F.lane); continue; }
        r -= 8 * I_GH;
        if (r < 4 * I_WD) { const int i = r / I_WD; r -= i * I_WD; MapId mp;
            transpose_item(mp, P.wd + (size_t)i * FF * DM, DM, FF, DM, (bf16*)(P.ws + WS_WD + i * WD_BYTES), nullptr, scr, r, F.lane); continue; }
        r -= 4 * I_WD;
        if (r < I_E) { MapEven mp; transpose_item(mp, P.ewin, 3368, DM, NEV, (bf16*)(P.ws + WS_WIN0), P.norm_g + (0 * 6 + 2) * DM, scr, r, F.lane); continue; }
        r -= I_E;
        if (r < I_O) { MapId mp; transpose_item(mp, P.ewout, DM, DM, DM, (bf16*)(P.ws + WS_WOUT0), nullptr, scr, r, F.lane); continue; }
        r -= I_O;
        if (r < I_OD) { MapId mp; transpose_item(mp, P.owin, NOD, DM, NOD, (bf16*)(P.ws + WS_WIN1), P.norm_g + (1 * 6 + 2) * DM, scr, r, F.lane); continue; }
        r -= I_OD;
        { MapId mp; transpose_item(mp, P.owout, DM, DM, DM, (bf16*)(P.ws + WS_WOUT1), nullptr, scr, r, F.lane); }
    }
    float* c64 = (float*)(P.ws + WS_C64); float* s64 = (float*)(P.ws + WS_S64); float* c32 = (float*)(P.ws + WS_C32); float* s32 = (float*)(P.ws + WS_S32);
    const int gt = F.vcu * (NWAVES * 64) + F.tid, NGT = F.G * NWAVES * 64;
    for (int e = gt; e < SEQ * 48; e += NGT) {
        const bool is64 = e < SEQ * 32; const int ee = is64 ? e : e - SEQ * 32; const int pos = is64 ? (ee >> 5) : (ee >> 4), i = is64 ? (ee & 31) : (ee & 15);
        const double rb = is64 ? 0.7498942093324559 : 0.5623413251903492; double inv = 1.0; for (int k = 0; k < i; ++k) inv *= rb;
        const float ang = (float)pos * (float)inv; float sn, cs; sincos_d((double)ang, sn, cs);
        if (is64) { c64[ee] = cs; s64[ee] = sn; } else { c32[ee] = cs; s32[ee] = sn; }
    }
    bf16* XB = (bf16*)(P.ws + WS_XB); float* RS = (float*)(P.ws + WS_RS);
    for (int m = gw; m < MROWS; m += NGW) x_to_bf16_row(P.x + (size_t)m * DM, XB + (size_t)m * DM, RS + m, F.lane);
}
__device__ __forceinline__ void thin_phase(Frame& F, const Ptrs& P, const float* xin, const float* ga, float alpha) {
    int t_ = threadIdx.x; asm volatile("" : "+v"(t_)); const int lane_ = t_ & 63, wave_ = __builtin_amdgcn_readfirstlane(t_ >> 6);
    const int gw = F.vcu * NWAVES + wave_, NGW = F.G * NWAVES;
    const float* Y = (const float*)(P.ws + WS_Y); bf16* XB = (bf16*)(P.ws + WS_XB); float* RS = (float*)(P.ws + WS_RS);
    for (int m = gw; m < MROWS; m += NGW) thin_row(Y + (size_t)m * DM, xin + (size_t)m * DM, P.out + (size_t)m * DM, XB + (size_t)m * DM, ga, alpha, RS + m, lane_);
}

__device__ __forceinline__ void indexer_unit(Frame& F, const Ptrs& P, int b, int blk) {
    typedef short bf16x8v __attribute__((ext_vector_type(8)));
    int tid = threadIdx.x; asm volatile("" : "+v"(tid));
    const int q0 = blk * 16, qc = q0 >> 6, n64 = qc + 1, nvis = n64 * 64; const int lane = tid & 63, wid = __builtin_amdgcn_readfirstlane(tid >> 6);
    unsigned long long* mrow = (unsigned long long*)(P.ws + WS_MASK) + ((size_t)(b * SEQ + q0)) * 32;
    if (n64 <= 4) {
        for (int i = tid; i < 16 * 32; i += NWAVES * 64) { const int w = i & 31; if (w < n64) mrow[i] = ~0ull; }
        return;
    }
    const bf16* IQ = (const bf16*)(P.ws + WS_R1 + 192 * MiB); const bf16* IK = (const bf16*)(P.ws + WS_R1 + 208 * MiB); const float* IW = (const float*)(P.ws + WS_R1 + 210 * MiB);
    LAS float* sc = (LAS float*)F.lds;
    {
        const int q = lane & 15, kg = lane >> 4; const size_t qrow = (size_t)(b * SEQ + q0 + q);
        bf16x8v iq[8]; float wi[8];
#pragma unroll
        for (int h = 0; h < 8; ++h) { iq[h] = *(const bf16x8v*)(IQ + qrow * 256 + h * 32 + 8 * kg); wi[h] = IW[qrow * 8 + h]; }
        for (int kt = wid; kt < nvis / 16; kt += NWAVES) {
            const bf16x8v a = *(const bf16x8v*)(IK + ((size_t)(b * SEQ + kt * 16 + q)) * 32 + 8 * kg);
            f32x4 acc = {0.f, 0.f, 0.f, 0.f};
#pragma unroll
            for (int h = 0; h < 8; ++h) { const f32x4 c = __builtin_amdgcn_mfma_f32_16x16x32_bf16(a, iq[h], (f32x4){0.f, 0.f, 0.f, 0.f}, 0, 0, 0);
#pragma unroll
                for (int j = 0; j < 4; ++j) acc[j] += wi[h] * fmaxf(c[j], 0.f); }
            const int col = (kt * 16 + kg * 4 + 4 * q) & 2047;
            *(LAS f32x4*)(sc + q * 2048 + col) = acc;
        }
    }
    __syncthreads();
#pragma unroll 1
    for (int rr = 0; rr < 2; ++rr) {
        const int q = 2 * wid + rr; const LAS float* row = sc + q * 2048;
        int n64l = n64; asm volatile("" : "+s"(n64l));
        unsigned u[32];
#pragma unroll
        for (int i = 0; i < 32; ++i) { const int e = i * 64 + lane; const unsigned bts = __float_as_uint(row[(e + 4 * q) & 2047]); const unsigned k = (bts & 0x80000000u) ? ~bts : (bts | 0x80000000u); u[i] = (i < n64l) ? k : 0u; }
        unsigned T = 0u;
#pragma unroll 1
        for (int bit = 31; bit >= 0; --bit) {
            const unsigned cand = T | (1u << bit); int cnt = 0;
#pragma unroll
            for (int g = 0; g < 4; ++g) if (n64l > 8 * g) {
#pragma unroll
                for (int i = 8 * g; i < 8 * g + 8; ++i) cnt += __popcll(__ballot(u[i] >= cand)); }
            if (cnt >= 256) T = cand;
        }
        int cgt = 0;
#pragma unroll
        for (int i = 0; i < 32; ++i) cgt += __popcll(__ballot(u[i] > T));
        const int need = 256 - cgt; int base = 0; unsigned T2 = T; asm volatile("" : "+s"(T2));
#pragma unroll
        for (int i = 0; i < 32; ++i) {
            const bool eq = (u[i] == T2), gt = (u[i] > T2); const unsigned long long em = __ballot(eq);
            const int rank = (int)__builtin_amdgcn_mbcnt_hi((unsigned)(em >> 32), __builtin_amdgcn_mbcnt_lo((unsigned)em, (unsigned)base));
            const unsigned long long w = __ballot(gt || (eq && rank < need)); base += __popcll(em);
            if (lane == 0) mrow[q * 32 + i] = w;
        }
    }
    __syncthreads();
}

__device__ __forceinline__ void a_unit(Frame& F, const Ptrs& P, int b, int h, int qb, float lam) {
    using namespace att; typedef Lds<128> L;
    const bf16_t* AQ = (const bf16_t*)(P.ws + WS_R1); const bf16_t* AK = (const bf16_t*)(P.ws + WS_R1 + 32 * MiB); const bf16_t* AV = (const bf16_t*)(P.ws + WS_R1 + 64 * MiB);
    int tid = threadIdx.x; asm volatile("" : "+v"(tid));
    const int lane = tid & 63, wid = __builtin_amdgcn_readfirstlane(tid >> 6), r32 = lane & 31; const size_t rowbase = (size_t)b * SEQ; const int q0 = qb * 256, qw = q0 + wid * 32, qc = qw >> 6;
    f32x4* stash = (f32x4*)(P.ws + WS_Y) + ((size_t)(blockIdx.x * NWAVES + wid) * 16) * 64 + lane;
    f32x16 o[4];
#pragma unroll 1
    for (int c = 0; c < 2; ++c) {
        const int g = 2 * h + c;
        attn_core<128, 0, 4>(o, F.lds, AQ + (rowbase + qw) * 512 + g * 64, 512, AK + rowbase * 512 + g * 64, 512, AV + rowbase * 512 + h * 128, 512, 0, (q0 >> 6) + 4, 0, qc + 1, nullptr, 0, 0);
        if (c == 0) {
            f32x4* sp = stash; asm volatile("" : "+v"(sp));
#pragma unroll
            for (int d0 = 0; d0 < 4; ++d0)
#pragma unroll
                for (int rq = 0; rq < 4; ++rq) sp[(d0 * 4 + rq) * 64] = (f32x4){o[d0][4 * rq], o[d0][4 * rq + 1], o[d0][4 * rq + 2], o[d0][4 * rq + 3]};
        }
    }
    {
        const f32x4* sp = stash; asm volatile("" : "+v"(sp));
#pragma unroll
        for (int d0 = 0; d0 < 4; ++d0)
#pragma unroll
            for (int rq = 0; rq < 4; ++rq) { const f32x4 a = sp[(d0 * 4 + rq) * 64];
#pragma unroll
                for (int j = 0; j < 4; ++j) o[d0][4 * rq + j] = a[j] - lam * o[d0][4 * rq + j]; }
    }
    float sl[4];
#pragma unroll
    for (int d0 = 0; d0 < 4; ++d0) sl[d0] = P.esub[32 * d0 + r32] * 0.8f;
#pragma unroll
    for (int r = 0; r < 16; ++r) { float s = 0.f;
#pragma unroll
        for (int d0 = 0; d0 < 4; ++d0) s += o[d0][r] * o[d0][r];
        s = sum32(s);
        const float rstd = 1.0f / sqrtf(s * (1.f / 128.f) + RMS_EPS);
#pragma unroll
        for (int d0 = 0; d0 < 4; ++d0) o[d0][r] *= rstd * sl[d0]; }
    store_o<128>(o, F.lds, (bf16_t*)(P.ws + WS_XB) + (rowbase + qw) * DM + h * 128, DM);
}
__device__ __forceinline__ void b_unit(Frame& F, const Ptrs& P, int b, int h, int qb) {
    using namespace att;
    const bf16_t* BQ = (const bf16_t*)(P.ws + WS_R1 + 96 * MiB); const bf16_t* BK = (const bf16_t*)(P.ws + WS_R1 + 128 * MiB); const bf16_t* BV = (const bf16_t*)(P.ws + WS_R1 + 160 * MiB);
    int tid = threadIdx.x; asm volatile("" : "+v"(tid));
    const int lane = tid & 63, wid = __builtin_amdgcn_readfirstlane(tid >> 6), r32 = lane & 31; const size_t rowbase = (size_t)b * SEQ; const int q0 = qb * 256, qw = q0 + wid * 32, qc = qw >> 6;
    const unsigned long long* mrow = (const unsigned long long*)(P.ws + WS_MASK) + (rowbase + qw + r32) * 32;
    f32x16 o[2];
    attn_core<64, 1, 4>(o, F.lds, BQ + (rowbase + qw) * 512 + h * 64, 512, BK + rowbase * 512 + h * 64, 512, BV + rowbase * 512 + h * 64, 512, 0, (q0 >> 6) + 4, 0, qc + 1, mrow, 0, 0);
    store_o<64>(o, F.lds, (bf16_t*)(P.ws + WS_XB) + (rowbase + qw) * DM + 512 + h * 64, DM);
}
__device__ __forceinline__ void c_unit(Frame& F, const Ptrs& P, int b, int h, int qb) {
    using namespace att; typedef Lds<64> L;
    const bf16_t* CQ = (const bf16_t*)(P.ws + WS_R1); const bf16_t* CK = (const bf16_t*)(P.ws + WS_R1 + 64 * MiB); const bf16_t* CV = (const bf16_t*)(P.ws + WS_R1 + 128 * MiB);
    int tid = threadIdx.x; asm volatile("" : "+v"(tid));
    const int lane = tid & 63, wid = __builtin_amdgcn_readfirstlane(tid >> 6), r32 = lane & 31; const size_t rowbase = (size_t)b * SEQ; const int q0 = qb * 256, qw = q0 + wid * 32, qc = qw >> 6;
    LAS float* bt = (LAS float*)(F.lds + L::OFF_BT);
    for (int i = tid; i < 320; i += NWAVES * 64) bt[i] = P.obias[h * 320 + i] * LOG2E;
    const int c0 = q0 >> 6, T0 = c0 - 8 > 0 ? c0 - 8 : 0, tw0 = qc - 8 > 0 ? qc - 8 : 0;
    f32x16 o[2];
    attn_core<64, 2, 4>(o, F.lds, CQ + (rowbase + qw) * DM + h * 64, DM, CK + rowbase * DM + h * 64, DM, CV + rowbase * DM + h * 64, DM, T0, c0 + 4, tw0, qc + 1, nullptr, qw + r32, qc);
    store_o<64>(o, F.lds, (bf16_t*)(P.ws + WS_XB) + (rowbase + qw) * DM + h * 64, DM);
}

#ifndef DBG_NO_IDX
#define DBG_NO_IDX 0
#endif
#ifndef DBG_NO_A
#define DBG_NO_A 0
#endif
#ifndef DBG_NO_B
#define DBG_NO_B 0
#endif
#ifndef DBG_STAGES
#define DBG_STAGES 99
#endif
struct Args { const float* in[12]; float* out; unsigned char* ws; };
__global__ void __launch_bounds__(NWAVES * 64, 2) fwd_kernel(Args args) {
    extern __shared__ __attribute__((aligned(16))) unsigned char lds[];
    Frame F;
    F.lds = (LAS unsigned char*)lds; F.MISC = (volatile LAS unsigned*)(F.lds + MISC_OFF);
    F.tid = threadIdx.x; F.lane = F.tid & 63; F.wave = __builtin_amdgcn_readfirstlane(F.tid >> 6);
    F.G = gridDim.x; { const int bx = blockIdx.x; F.vcu = (F.G % 8 == 0) ? (bx % 8) * (F.G / 8) + bx / 8 : bx; }
    Ptrs P; P.x = args.in[0]; P.norm_g = args.in[1]; P.wg = args.in[2]; P.wu = args.in[3]; P.wd = args.in[4]; P.ewin = args.in[5]; P.ewout = args.in[6]; P.elam = args.in[7]; P.esub = args.in[8];
    P.owin = args.in[9]; P.owout = args.in[10]; P.obias = args.in[11]; P.out = args.out; P.ws = args.ws;
    F.ctl = (gu32*)(P.ws + WS_CTL);
    for (int u = F.tid; u < (LDS_BYTES - LDSCTL_OFF) / 4; u += NWAVES * 64) ((LAS unsigned*)(F.lds + LDSCTL_OFF))[u] = 0u;
    __syncthreads();
    XcdBarrier bar = xcd_barrier_post((unsigned*)(F.ctl + CW_BAR), F.MISC + 8);
#define GRID_BAR() xcd_barrier(bar)
    bf16* XB = (bf16*)(P.ws + WS_XB); const float* RS = (const float*)(P.ws + WS_RS); bf16* HID = (bf16*)(P.ws + WS_R1); float* Y = (float*)(P.ws + WS_Y);

    p0_prologue(F, P); GRID_BAR();

#define FFN_PHASES(l, f, xin) do { \
        { pg8::Gemm g{XB, (const bf16*)(P.ws + WS_WGU + (2 * (l) + (f)) * WGU_BYTES), MROWS, NGU, DM}; pg8::StaticOrder S; S.init(MROWS, NGU, F.G, (int)blockIdx.x); \
          epi::EpiSwiGLU E{HID, RS}; pg8::gemm_phase<epi::EpiSwiGLU, pg8::StaticOrder, true, true>(F.lds, g, S, E); } \
        GRID_BAR(); \
        { pg8::Gemm g{HID, (const bf16*)(P.ws + WS_WD + (2 * (l) + (f)) * WD_BYTES), MROWS, DM, FF}; pg8::StaticOrder S; S.init(MROWS, DM, F.G, (int)blockIdx.x); \
          epi::EpiF32 E{Y, DM}; pg8::gemm_phase<epi::EpiF32, pg8::StaticOrder, true, true>(F.lds, g, S, E); } \
        GRID_BAR(); \
        thin_phase(F, P, (xin), P.norm_g + ((l) * 6 + 4 * (f) + 1) * DM, 0.5f); \
        GRID_BAR(); } while (0)

    FFN_PHASES(0, 0, P.x);
    if (DBG_STAGES >= 2) {
        { pg8::Gemm g{XB, (const bf16*)(P.ws + WS_WIN0), MROWS, NEV, DM}; pg8::StaticOrder S; S.init(MROWS, NEV, F.G, (int)blockIdx.x);
          unsigned char* r1 = P.ws + WS_R1;
          epi::EpiProjEven E{(bf16*)r1, (bf16*)(r1 + 192 * MiB), (bf16*)(r1 + 208 * MiB),
                             (float*)(r1 + 210 * MiB), RS, (const float*)(P.ws + WS_C64), (const float*)(P.ws + WS_S64), (const float*)(P.ws + WS_C32), (const float*)(P.ws + WS_S32)};
          pg8::gemm_phase<epi::EpiProjEven, pg8::StaticOrder, true, true>(F.lds, g, S, E); }
        GRID_BAR();
        for (int p = F.vcu; p < 1024; p += F.G) { const int b = p >> 6, j = p & 63;
#pragma unroll 1
            for (int k = 0; k < 2; ++k) { if (!DBG_NO_IDX) indexer_unit(F, P, b, k ? 127 - j : j); } }
        {
            float l01 = 0.f, l23 = 0.f;
            for (int i = 0; i < 64; ++i) { l01 += P.elam[i] * P.elam[64 + i]; l23 += P.elam[128 + i] * P.elam[192 + i]; }
            const float lam = expf(l01) - expf(l23) + 0.2f;
            for (int p = F.vcu; p < 256; p += F.G) { const int bh = p >> 2, s = p & 3;
#pragma unroll 1
                for (int k = 0; k < 2; ++k) { if (!DBG_NO_A) a_unit(F, P, bh >> 2, bh & 3, k ? 7 - s : s, lam); } }
        }
        GRID_BAR();
        for (int p = F.vcu; p < 512; p += F.G) { const int bh = p >> 2, s = p & 3;
#pragma unroll 1
            for (int k = 0; k < 2; ++k) { if (!DBG_NO_B) b_unit(F, P, bh >> 3, bh & 7, k ? 7 - s : s); } }
        GRID_BAR();
        { pg8::Gemm g{XB, (const bf16*)(P.ws + WS_WOUT0), MROWS, DM, DM}; pg8::StaticOrder S; S.init(MROWS, DM, F.G, (int)blockIdx.x);
          epi::EpiF32 E{Y, DM}; pg8::gemm_phase<epi::EpiF32, pg8::StaticOrder, true, true>(F.lds, g, S, E); }
        GRID_BAR();
        thin_phase(F, P, P.out, P.norm_g + (0 * 6 + 3) * DM, 1.0f);
        GRID_BAR();
    }
    if (DBG_STAGES >= 3) FFN_PHASES(0, 1, P.out);
    if (DBG_STAGES >= 4) FFN_PHASES(1, 0, P.out);
    if (DBG_STAGES >= 5) {
        { pg8::Gemm g{XB, (const bf16*)(P.ws + WS_WIN1), MROWS, NOD, DM}; pg8::StaticOrder S; S.init(MROWS, NOD, F.G, (int)blockIdx.x);
          unsigned char* r1 = P.ws + WS_R1; epi::EpiProjOdd E{(bf16*)r1, RS};
          pg8::gemm_phase<epi::EpiProjOdd, pg8::StaticOrder, true, true>(F.lds, g, S, E); }
        GRID_BAR();
        for (int p = F.vcu; p < 256; p += F.G) { const int b = p >> 4, h = p & 15;
#pragma unroll 1
            for (int qb = 0; qb < 8; ++qb) c_unit(F, P, b, h, qb); }
        GRID_BAR();
        { pg8::Gemm g{XB, (const bf16*)(P.ws + WS_WOUT1), MROWS, DM, DM}; pg8::StaticOrder S; S.init(MROWS, DM, F.G, (int)blockIdx.x);
          epi::EpiF32 E{Y, DM}; pg8::gemm_phase<epi::EpiF32, pg8::StaticOrder, true, true>(F.lds, g, S, E); }
        GRID_BAR();
        thin_phase(F, P, P.out, P.norm_g + (1 * 6 + 3) * DM, 1.0f);
        GRID_BAR();
    }
    if (DBG_STAGES >= 6) FFN_PHASES(1, 1, P.out);
}

extern "C" void kernel_launch(void* const* d_in, const int* in_sizes, int n_in, void* d_out, int out_size, void* d_ws, size_t ws_size, hipStream_t stream) {
    static int grid = 0;
    if (grid == 0) {
        if (n_in != 12 || in_sizes[0] != MROWS * DM || out_size != MROWS * DM || ws_size < WS_END) {
            fprintf(stderr, "kernel_launch: unexpected shapes / workspace (n_in %d, in0 %d, out %d, ws %zu, need %zu); nothing launched\n", n_in, n_in > 0 ? in_sizes[0] : -1, out_size, ws_size, (size_t)WS_END); grid = -1; return; }
        int dev = 0, cus = 0, per_cu = 0;
        if (hipGetDevice(&dev) != hipSuccess || hipDeviceGetAttribute(&cus, hipDeviceAttributeMultiprocessorCount, dev) != hipSuccess) { fprintf(stderr, "kernel_launch: device query failed\n"); grid = -1; return; }
        if (hipFuncSetAttribute((const void*)fwd_kernel, hipFuncAttributeMaxDynamicSharedMemorySize, LDS_BYTES) != hipSuccess) { fprintf(stderr, "kernel_launch: hipFuncSetAttribute failed\n"); grid = -1; return; }
        if (hipOccupancyMaxActiveBlocksPerMultiprocessor(&per_cu, (const void*)fwd_kernel, NWAVES * 64, LDS_BYTES) != hipSuccess || per_cu < 1)
            fprintf(stderr, "kernel_launch: note: occupancy query reports %d workgroups per CU\n", per_cu);
        (void)hipGetLastError();
        grid = cus;
    }
    if (grid < 0) return;
    if (hipMemsetAsync((char*)d_ws + WS_CTL, 0, CTL_ZERO_BYTES, stream) != hipSuccess) { fprintf(stderr, "kernel_launch: memset failed\n"); return; }
    Args a{};
    for (int i = 0; i < 12; ++i) a.in[i] = (const float*)d_in[i];
    a.out = (float*)d_out; a.ws = (unsigned char*)d_ws;
    hipLaunchKernelGGL(fwd_kernel, dim3(grid), dim3(NWAVES * 64), LDS_BYTES, stream, a);
    const hipError_t le = hipPeekAtLastError();
    if (le != hipSuccess) fprintf(stderr, "kernel_launch: launch failed: %s\n", hipGetErrorName(le));
}
```

```cpp
#include <hip/hip_runtime.h>
#include <cstdio>
#include <cstdint>
namespace pg8 {
#define PG8_LAS __attribute__((address_space(3)))
typedef unsigned short bf16_t;
typedef short bf16x8 __attribute__((ext_vector_type(8)));
typedef float f32x4 __attribute__((ext_vector_type(4)));
typedef unsigned u32x4 __attribute__((ext_vector_type(4)));
constexpr int BM = 256, BK = 64, HALF = 128, HTB = HALF * BK * 2  , STAGE_BYTES = 8 * HTB, NXCD = 8, WGM = 8;

__host__ __device__ __forceinline__ int lds_byte(int r, int c) { const int st = (r >> 4) * 2 + (c >> 5), rr = r & 15, cc = c & 31, ob = rr * 64 + cc * 2; return st * 1024 + (ob ^ (((ob >> 9) & 1) << 5)); }
__host__ __device__ __forceinline__ void stage_rc(int b, int& R, int& C) { const int st = b / 1024, sb = b % 1024, swz = sb ^ (((sb >> 9) & 1) << 5); R = (st >> 1) * 16 + swz / 64; C = (st & 1) * 32 + (swz % 64) / 2; }
__host__ __device__ __forceinline__ int perm32(int rho) { const int n = rho >> 4, i = rho & 15; return 8 * (i >> 2) + 4 * n + (i & 3); }

struct Unit { int pm, pn; };
struct Gemm { const bf16_t* A; const bf16_t* Bt; int M, N, K; };

struct StaticOrder {
    int nM, nN, nwg, G, c;
    __host__ __device__ void init(int M, int N, int G_, int c_) { nM = M / BM; nN = N / BM; nwg = nM * nN; G = G_; c = c_; }
    __host__ __device__ bool next(int i, Unit& u) const {
        const long L = (long)i * G + c; if (L >= nwg) return false;
        int wgid = (int)L; { const int q = nwg / NXCD, r = nwg % NXCD, xcd = wgid % NXCD, off = wgid / NXCD; wgid = (xcd < r ? xcd * (q + 1) : r * (q + 1) + (xcd - r) * q) + off; }
        const int nig = WGM * nN, gid = wgid / nig, fm = gid * WGM, gsz = (nM - fm) < WGM ? (nM - fm) : WGM;
        u.pm = fm + ((wgid % nig) % gsz); u.pn = (wgid % nig) / gsz; return true;
    }
    __device__ __forceinline__ void a_ready(const Unit&) const {}
    __device__ __forceinline__ void done(const Unit&) const {}
};

__device__ __forceinline__ unsigned cvt_pk_bf16(float lo, float hi) { unsigned r; asm volatile("v_cvt_pk_bf16_f32 %0, %1, %2" : "=v"(r) : "v"(lo), "v"(hi)); return r; }
typedef float f32x2 __attribute__((ext_vector_type(2)));
__device__ __forceinline__ f32x2 gelu_pk(f32x2 v) {
    const f32x2 av = __builtin_elementwise_abs(v), d = av * 0.2316418882f + 1.0f;
    f32x2 t; t.x = __builtin_amdgcn_rcpf(d.x); t.y = __builtin_amdgcn_rcpf(d.y);
    f32x2 q = t * 0.5307027145f + (-0.7265760135f); q = q * t + 0.7107068705f; q = q * t + (-0.142248368f); q = q * t + 0.127414796f; q = q * t;
    const f32x2 s = (v * v) * (-0.72134752044f);
    f32x2 e; e.x = __builtin_amdgcn_exp2f(s.x); e.y = __builtin_amdgcn_exp2f(s.y);
    const f32x2 m = v * (q * e), r = v - m;
    f32x2 o; o.x = v.x < 0.f ? m.x : r.x; o.y = v.y < 0.f ? m.y : r.y; return o;
}

template <int ACT  > struct EpiBf16 {
    static constexpr bool PERM = true, AFTER_DRAIN = false; static_assert(ACT == 0 || ACT == 1, "EpiBf16: ACT is 0 (none) or 1 (gelu_pk)");
    bf16_t* O; int ldc; const float* bias; int split_cols; size_t split_stride; float scale0;
    __device__ __forceinline__ void operator()(const f32x4 (&acc)[2][2][4][2], const Unit& u, int wr, int wc, int fr, int fq) const {
        const int row0 = u.pm * BM + wr * 64 + fr; int colt = u.pn * BM; bf16_t* base = O;
        float sc = 1.f; if (split_cols) { const int t = colt / split_cols; base += (size_t)t * split_stride; colt -= t * split_cols; if (t == 0) sc = scale0; }
        const int col0 = colt + wc * 32 + 8 * fq, bcol0 = u.pn * BM + wc * 32 + 8 * fq;
        f32x4 bv[2][2];
#pragma unroll
        for (int bj = 0; bj < 2; ++bj)
#pragma unroll
            for (int n = 0; n < 2; ++n) bv[bj][n] = bias ? *(const f32x4*)(bias + bcol0 + bj * HALF + 4 * n) : (f32x4){0.f, 0.f, 0.f, 0.f};
#pragma unroll
        for (int ai = 0; ai < 2; ++ai)
#pragma unroll
            for (int m = 0; m < 4; ++m) { bf16_t* rowp = base + (size_t)(row0 + ai * HALF + m * 16) * ldc + col0;
#pragma unroll
                for (int bj = 0; bj < 2; ++bj) { f32x4 v0 = acc[ai][bj][m][0] + bv[bj][0], v1 = acc[ai][bj][m][1] + bv[bj][1];
                    if (ACT == 1) { f32x2 a = gelu_pk((f32x2){v0[0], v0[1]}), b = gelu_pk((f32x2){v0[2], v0[3]}), c = gelu_pk((f32x2){v1[0], v1[1]}), d = gelu_pk((f32x2){v1[2], v1[3]});
                        v0 = (f32x4){a.x, a.y, b.x, b.y}; v1 = (f32x4){c.x, c.y, d.x, d.y}; }
                    v0 = v0 * sc; v1 = v1 * sc; u32x4 w; w.x = cvt_pk_bf16(v0[0], v0[1]); w.y = cvt_pk_bf16(v0[2], v0[3]); w.z = cvt_pk_bf16(v1[0], v1[1]); w.w = cvt_pk_bf16(v1[2], v1[3]);
                    *(u32x4*)(rowp + bj * HALF) = w; } }
    }
};

struct PanelStats {
    unsigned* xbuf;
    unsigned* cnt;
    unsigned* tmo;
    int ntn; float eps;
    unsigned code;
    __device__ __forceinline__ bool run(const f32x4 (&v)[2][2][4][2], const Unit& u, int wr, int wc, int fr, int fq, PG8_LAS unsigned char* lds, int wid, int lane) const {
        typedef float f32x2v __attribute__((ext_vector_type(2)));
        PG8_LAS f32x2v* P = (PG8_LAS f32x2v*)lds;
        PG8_LAS f32x2v* S = (PG8_LAS f32x2v*)(lds + 8192);
        PG8_LAS unsigned* flag = (PG8_LAS unsigned*)(lds + 8192 + 2048);
#pragma unroll
        for (int ai = 0; ai < 2; ++ai)
#pragma unroll
            for (int m = 0; m < 4; ++m) {
                float s = 0.f;
#pragma unroll
                for (int bj = 0; bj < 2; ++bj)
#pragma unroll
                    for (int n = 0; n < 2; ++n) { const f32x4 x = v[ai][bj][m][n]; s += (x[0] + x[1]) + (x[2] + x[3]); }
                s += __shfl_xor(s, 16); s += __shfl_xor(s, 32);
                const float mw = s * (1.0f / 64.0f); float q = 0.f;
#pragma unroll
                for (int bj = 0; bj < 2; ++bj)
#pragma unroll
                    for (int n = 0; n < 2; ++n) { const f32x4 d = v[ai][bj][m][n] - mw; q += (d[0] * d[0] + d[1] * d[1]) + (d[2] * d[2] + d[3] * d[3]); }
                q += __shfl_xor(q, 16); q += __shfl_xor(q, 32);
                if (fq == 0) P[(ai * HALF + wr * 64 + m * 16 + fr) * 4 + wc] = (f32x2v){mw, q};
            }
        asm volatile("s_waitcnt lgkmcnt(0)" ::: "memory"); __builtin_amdgcn_s_barrier(); asm volatile("" ::: "memory");
#if defined(BROKEN_EXCHANGE_NO_WAIT)
#warning BROKEN CONTROL BUILD: the row-statistics exchange does not wait; results are wrong by design
        if (blockIdx.x >= 64) { const long long t0_ = clock64(); while (clock64() - t0_ < 60000) __builtin_amdgcn_s_sleep(8); }
#endif
        const int row = wid * 32 + (lane & 31);
        if (lane < 32) {
            const f32x2v a = P[row * 4 + 0], b = P[row * 4 + 1], c = P[row * 4 + 2], d = P[row * 4 + 3];
            const float mt = (a.x + b.x + c.x + d.x) * 0.25f;
            const float da = a.x - mt, db = b.x - mt, dc = c.x - mt, dd = d.x - mt;
            const float m2 = (a.y + b.y) + (c.y + d.y) + 64.0f * ((da * da + db * db) + (dc * dc + dd * dd));
            unsigned long long* slot = (unsigned long long*)xbuf + ((size_t)(u.pm * BM + row) * 4 + u.pn);
            __hip_atomic_store(slot, ((unsigned long long)__float_as_uint(m2) << 32) | __float_as_uint(mt), __ATOMIC_RELAXED, __HIP_MEMORY_SCOPE_AGENT);
        }
        asm volatile("s_waitcnt vmcnt(0)" ::: "memory");
        if (lane == 0) __hip_atomic_fetch_add(cnt + 64 * u.pm, 1u, __ATOMIC_RELAXED, __HIP_MEMORY_SCOPE_AGENT);
        if (wid == 0) {
            bool dead = false; const unsigned long long t0 = __builtin_amdgcn_s_memrealtime(); const unsigned want = 8u * (unsigned)ntn;
            for (;;) {
#if defined(BROKEN_EXCHANGE_NO_WAIT)
                break;
#endif
                if ((unsigned)__builtin_amdgcn_readfirstlane(__hip_atomic_load(cnt + 64 * u.pm, __ATOMIC_RELAXED, __HIP_MEMORY_SCOPE_AGENT)) >= want) break;
                if (__builtin_amdgcn_s_memrealtime() - t0 > 2000000ull) {
                    if (lane == 0) { unsigned expect = 0u; __hip_atomic_compare_exchange_strong(tmo + 1, &expect, code | (unsigned)(u.pm & 0xff), __ATOMIC_RELAXED, __ATOMIC_RELAXED, __HIP_MEMORY_SCOPE_AGENT);
                                     __hip_atomic_store(tmo, 1u, __ATOMIC_RELAXED, __HIP_MEMORY_SCOPE_AGENT); }
                    dead = true; break; }
                __builtin_amdgcn_s_sleep(2);
            }
            __builtin_amdgcn_fence(__ATOMIC_ACQUIRE, "agent");
            if (lane == 0) flag[0] = dead ? 1u : 0u;
        }
        asm volatile("s_waitcnt vmcnt(0) lgkmcnt(0)" ::: "memory"); __builtin_amdgcn_s_barrier(); asm volatile("" ::: "memory");
        const bool bad = flag[0] != 0u;
        if (lane < 32) {
            const unsigned long long* slot = (const unsigned long long*)xbuf + (size_t)(u.pm * BM + row) * 4; float mt[4], m2[4]; float ms = 0.f;
#pragma unroll
            for (int t = 0; t < 4; ++t) { if (t < ntn) { const unsigned long long w = __hip_atomic_load(slot + t, __ATOMIC_RELAXED, __HIP_MEMORY_SCOPE_AGENT); mt[t] = __uint_as_float((unsigned)w); m2[t] = __uint_as_float((unsigned)(w >> 32)); } else { mt[t] = 0.f; m2[t] = 0.f; } ms += mt[t]; }
            const float mean = ms / (float)ntn; float q = 0.f;
#pragma unroll
            for (int t = 0; t < 4; ++t) if (t < ntn) { const float dm = mt[t] - mean; q += m2[t] + 256.0f * dm * dm; }
            S[row] = (f32x2v){mean, 1.0f / sqrtf(q / (256.0f * (float)ntn) + eps)};
        }
        asm volatile("s_waitcnt lgkmcnt(0)" ::: "memory"); __builtin_amdgcn_s_barrier(); asm volatile("" ::: "memory");
        return bad;
    }
};
struct EpiLnRes {
    static constexpr bool PERM = false, AFTER_DRAIN = true;
    const float* base; float* out; int ldc; const float* bias; PanelStats st; unsigned poison;
    __device__ __forceinline__ void fused(f32x4 (&acc)[2][2][4][2], const Unit& u, int wr, int wc, int fr, int fq, PG8_LAS unsigned char* lds, int wid, int lane) const {
        typedef float f32x2v __attribute__((ext_vector_type(2)));
        const PG8_LAS f32x2v* S = (const PG8_LAS f32x2v*)(lds + 8192);
        const int col0 = u.pn * BM + wc * 32 + 4 * fq;
#pragma unroll
        for (int bj = 0; bj < 2; ++bj)
#pragma unroll
            for (int n = 0; n < 2; ++n) { const f32x4 bv = bias ? *(const f32x4*)(bias + col0 + bj * HALF + n * 16) : (f32x4){0.f, 0.f, 0.f, 0.f};
#pragma unroll
                for (int ai = 0; ai < 2; ++ai)
#pragma unroll
                    for (int m = 0; m < 4; ++m) acc[ai][bj][m][n] += bv; }
        f32x4 pre[4][2][2];
#pragma unroll
        for (int m = 0; m < 4; ++m) { const size_t off = (size_t)(u.pm * BM + wr * 64 + m * 16 + fr) * ldc + col0;
#pragma unroll
            for (int bj = 0; bj < 2; ++bj)
#pragma unroll
                for (int n = 0; n < 2; ++n) pre[m][bj][n] = *(const f32x4*)(base + off + bj * HALF + n * 16); }
        const bool bad = st.run(acc, u, wr, wc, fr, fq, lds, wid, lane) || poison != 0u;
        const float qnan = __builtin_nanf("");
#pragma unroll
        for (int ai = 0; ai < 2; ++ai)
#pragma unroll
            for (int m = 0; m < 4; ++m) { const int r = ai * HALF + wr * 64 + m * 16 + fr; const f32x2v sr = S[r]; const size_t off = (size_t)(u.pm * BM + r) * ldc + col0;
#pragma unroll
                for (int bj = 0; bj < 2; ++bj)
#pragma unroll
                    for (int n = 0; n < 2; ++n) { const f32x4 bs = ai == 0 ? pre[m][bj][n] : *(const f32x4*)(base + off + bj * HALF + n * 16); f32x4 o = bs + (acc[ai][bj][m][n] - sr.x) * sr.y;
                        if (bad) o = (f32x4){qnan, qnan, qnan, qnan}; *(f32x4*)(out + off + bj * HALF + n * 16) = o; }
                if (m & 1) asm volatile("" ::: "memory"); }
    }
};
struct EpiLnResLn {
    static constexpr bool PERM = false, AFTER_DRAIN = true;
    const float* base; float* out; bf16_t* xn; int ldc; const float* bias; PanelStats st1, st2; unsigned poison;
    __device__ __forceinline__ void fused(f32x4 (&acc)[2][2][4][2], const Unit& u, int wr, int wc, int fr, int fq, PG8_LAS unsigned char* lds, int wid, int lane) const {
        typedef float f32x2v __attribute__((ext_vector_type(2))); typedef unsigned u32x2v __attribute__((ext_vector_type(2)));
        const PG8_LAS f32x2v* S = (const PG8_LAS f32x2v*)(lds + 8192);
        const int col0 = u.pn * BM + wc * 32 + 4 * fq;
#pragma unroll
        for (int bj = 0; bj < 2; ++bj)
#pragma unroll
            for (int n = 0; n < 2; ++n) { const f32x4 bv = bias ? *(const f32x4*)(bias + col0 + bj * HALF + n * 16) : (f32x4){0.f, 0.f, 0.f, 0.f};
#pragma unroll
                for (int ai = 0; ai < 2; ++ai)
#pragma unroll
                    for (int m = 0; m < 4; ++m) acc[ai][bj][m][n] += bv; }
        bool bad = st1.run(acc, u, wr, wc, fr, fq, lds, wid, lane) || poison != 0u;
        const float qnan = __builtin_nanf("");
#pragma unroll
        for (int ai = 0; ai < 2; ++ai)
#pragma unroll
            for (int m = 0; m < 4; ++m) { const int r = ai * HALF + wr * 64 + m * 16 + fr; const f32x2v sr = S[r]; const size_t off = (size_t)(u.pm * BM + r) * ldc + col0;
#pragma unroll
                for (int bj = 0; bj < 2; ++bj)
#pragma unroll
                    for (int n = 0; n < 2; ++n) { const f32x4 bs = *(const f32x4*)(base + off + bj * HALF + n * 16); acc[ai][bj][m][n] = bs + (acc[ai][bj][m][n] - sr.x) * sr.y; }
                asm volatile("" : "+v"(acc[ai][0][m][0]), "+v"(acc[ai][0][m][1]), "+v"(acc[ai][1][m][0]), "+v"(acc[ai][1][m][1]));
                if (m & 1) asm volatile("" ::: "memory"); }
        const bool bad1 = bad;
        bad = st2.run(acc, u, wr, wc, fr, fq, lds, wid, lane) || bad;
#pragma unroll
        for (int ai = 0; ai < 2; ++ai)
#pragma unroll
            for (int m = 0; m < 4; ++m) { const int r = ai * HALF + wr * 64 + m * 16 + fr; const f32x2v sr = S[r]; const size_t off = (size_t)(u.pm * BM + r) * ldc + col0;
#pragma unroll
                for (int bj = 0; bj < 2; ++bj)
#pragma unroll
                    for (int n = 0; n < 2; ++n) { const f32x4 x1 = acc[ai][bj][m][n]; *(f32x4*)(out + off + bj * HALF + n * 16) = bad1 ? (f32x4){qnan, qnan, qnan, qnan} : x1;
                        const f32x4 o = (x1 - sr.x) * sr.y; u32x2v w; w.x = cvt_pk_bf16(o[0], o[1]); w.y = cvt_pk_bf16(o[2], o[3]);
                        if (bad) { w.x = 0x7fc07fc0u; w.y = 0x7fc07fc0u; } *(u32x2v*)(xn + off + bj * HALF + n * 16) = w; }
                asm volatile("" ::: "memory"); }
    }
};

template <class Epi, class Sched, bool ALIGN_EPI = false, bool SP2 = false>
__device__ __forceinline__ void gemm_phase(PG8_LAS unsigned char* lds, const Gemm g, const Sched& S, const Epi& E) {
    int tid_ = threadIdx.x; asm volatile("" : "+v"(tid_));
    const int tid = tid_, wid = __builtin_amdgcn_readfirstlane(tid >> 6), lane = tid & 63, wr = wid >> 2, wc = wid & 3, fr = lane & 15, fq = lane >> 4;
    const int K = g.K, nt = K / BK;
    unsigned voffA[2], voffB[2];
#pragma unroll
    for (int i = 0; i < 2; ++i) { int R, C; stage_rc(tid * 16 + i * 8192, R, C); const int Rb = Epi::PERM ? ((R & ~31) + perm32(R & 31)) : R;
        voffA[i] = (unsigned)(R * K + C) * 2u; voffB[i] = (unsigned)(Rb * K + C) * 2u; }
    const size_t kstep = (size_t)(BK * 2);
    const size_t hstep = (size_t)HALF * K * 2;
    const size_t tstep = 2 * hstep;
    const unsigned ldsw = (unsigned)wid * 1024u;
    const int aoff = lds_byte(wr * 64 + fr, fq * 8), boff = lds_byte(wc * 32 + fr, fq * 8);
#define PG8_SA(b, h) (((b) * 2 + (h)) * HTB)
#define PG8_SB(b, h) ((4 + (b) * 2 + (h)) * HTB)
#define PG8_STAGE(bufoff, gbase, voff) do { _Pragma("unroll") for (int _i = 0; _i < 2; ++_i) \
        __builtin_amdgcn_global_load_lds((const unsigned*)((const char*)(gbase) + (voff)[_i]), (PG8_LAS unsigned*)(lds + (bufoff) + ldsw + _i * 8192), 16, 0, 0); } while (0)
#define PG8_LDA(dst, b, h) do { _Pragma("unroll") for (int m = 0; m < 4; ++m) _Pragma("unroll") for (int k = 0; k < 2; ++k) dst[m][k] = *(const PG8_LAS bf16x8*)(lds + PG8_SA(b, h) + aoff + m * 2048 + k * 1024); } while (0)
#define PG8_LDB(dst, b, h) do { _Pragma("unroll") for (int n = 0; n < 2; ++n) _Pragma("unroll") for (int k = 0; k < 2; ++k) dst[n][k] = *(const PG8_LAS bf16x8*)(lds + PG8_SB(b, h) + boff + n * 2048 + k * 1024); } while (0)
#define PG8_MMA(ai, bj, At, Bt) do { __builtin_amdgcn_s_setprio(1); _Pragma("unroll") for (int m = 0; m < 4; ++m) _Pragma("unroll") for (int n = 0; n < 2; ++n) _Pragma("unroll") for (int k = 0; k < 2; ++k) \
        acc[ai][bj][m][n] = __builtin_amdgcn_mfma_f32_16x16x32_bf16(Bt[n][k], At[m][k], acc[ai][bj][m][n], 0, 0, 0); __builtin_amdgcn_s_setprio(0); } while (0)
#define PG8_WAIT_V(n) asm volatile("s_waitcnt vmcnt(" #n ")" ::: "memory")
#define PG8_WAIT_L(n) asm volatile("s_waitcnt lgkmcnt(" #n ")" ::: "memory")
#define PG8_BAR __builtin_amdgcn_s_barrier()
#define PG8_SCHED __builtin_amdgcn_sched_barrier(0)
    Unit cur, nxt; int ui = 0;
    if (!S.next(0, cur)) return;
    f32x4 acc[2][2][4][2];
#pragma unroll
    for (int a = 0; a < 2; ++a)
#pragma unroll
        for (int b = 0; b < 2; ++b)
#pragma unroll
            for (int m = 0; m < 4; ++m)
#pragma unroll
                for (int n = 0; n < 2; ++n) acc[a][b][m][n] = (f32x4){0.f, 0.f, 0.f, 0.f};
    bf16x8 At[4][2], B0[2][2], B1[2][2];
    const char* cA = (const char*)g.A + (size_t)cur.pm * tstep; const char* cB = (const char*)g.Bt + (size_t)cur.pn * tstep;
    S.a_ready(cur);
    if constexpr (SP2) {
        PG8_STAGE(PG8_SB(0, 0), cB, voffB); PG8_STAGE(PG8_SB(0, 1), cB + hstep, voffB); PG8_STAGE(PG8_SA(0, 0), cA, voffA); PG8_STAGE(PG8_SA(0, 1), cA + hstep, voffA);
        if (wr == 1) PG8_BAR;
        PG8_WAIT_V(2); PG8_BAR;
        PG8_STAGE(PG8_SB(1, 0), cB + kstep, voffB); PG8_STAGE(PG8_SA(1, 0), cA + kstep, voffA); PG8_STAGE(PG8_SB(1, 1), cB + hstep + kstep, voffB);
        PG8_WAIT_V(6); PG8_BAR;
    } else {
        PG8_STAGE(PG8_SB(0, 0), cB, voffB); PG8_STAGE(PG8_SA(0, 0), cA, voffA); PG8_STAGE(PG8_SB(0, 1), cB + hstep, voffB); PG8_STAGE(PG8_SA(0, 1), cA + hstep, voffA);
        if (wr == 1) PG8_BAR;
        PG8_WAIT_V(4); PG8_BAR;
        PG8_STAGE(PG8_SB(1, 0), cB + kstep, voffB); PG8_STAGE(PG8_SA(1, 0), cA + kstep, voffA); PG8_STAGE(PG8_SB(1, 1), cB + hstep + kstep, voffB);
        PG8_WAIT_V(6); PG8_BAR;
    }
    for (;;) {
        const bool has_next = S.next(ui + 1, nxt);
        const char* nA = has_next ? (const char*)g.A + (size_t)nxt.pm * tstep : cA; const char* nB = has_next ? (const char*)g.Bt + (size_t)nxt.pn * tstep : cB;
        for (int t = 0; t < nt; t += 2) {
            const bool last = (t == nt - 2);
            const char* a1 = cA + (size_t)(t + 1) * kstep;
            const char* a2 = last ? nA : cA + (size_t)(t + 2) * kstep; const char* b2 = last ? nB : cB + (size_t)(t + 2) * kstep;
            const char* a3 = a2 + kstep; const char* b3 = b2 + kstep;
            if (last && has_next) S.a_ready(nxt);
            if constexpr (SP2) {
            PG8_LDB(B0, 0, 0); PG8_LDB(B1, 0, 1); PG8_SCHED; PG8_LDA(At, 0, 0); PG8_STAGE(PG8_SA(1, 1), a1 + hstep, voffA);
            PG8_WAIT_V(8); PG8_WAIT_L(0); PG8_BAR; PG8_MMA(0, 0, At, B0); PG8_MMA(0, 1, At, B1); PG8_BAR; PG8_SCHED;
            PG8_LDA(At, 0, 1); PG8_STAGE(PG8_SB(0, 0), b2, voffB); PG8_STAGE(PG8_SB(0, 1), b2 + hstep, voffB); PG8_STAGE(PG8_SA(0, 0), a2, voffA);
            PG8_WAIT_V(8); PG8_WAIT_L(0); PG8_BAR; PG8_MMA(1, 0, At, B0); PG8_MMA(1, 1, At, B1); PG8_BAR; PG8_SCHED;
            PG8_LDB(B0, 1, 0); PG8_LDB(B1, 1, 1); PG8_SCHED; PG8_LDA(At, 1, 0); PG8_STAGE(PG8_SA(0, 1), a2 + hstep, voffA);
            PG8_WAIT_V(8); PG8_WAIT_L(0); PG8_BAR; PG8_MMA(0, 0, At, B0); PG8_MMA(0, 1, At, B1); PG8_BAR; PG8_SCHED;
            PG8_LDA(At, 1, 1); PG8_STAGE(PG8_SB(1, 0), b3, voffB); PG8_STAGE(PG8_SB(1, 1), b3 + hstep, voffB); PG8_STAGE(PG8_SA(1, 0), a3, voffA);
            PG8_WAIT_V(8); PG8_WAIT_L(0); PG8_BAR; PG8_MMA(1, 0, At, B0); PG8_MMA(1, 1, At, B1); PG8_BAR; PG8_SCHED;
            } else {
            PG8_LDB(B0, 0, 0); PG8_SCHED; PG8_LDA(At, 0, 0); PG8_STAGE(PG8_SA(1, 1), a1 + hstep, voffA);
            PG8_WAIT_L(8); PG8_BAR; PG8_WAIT_L(0); PG8_MMA(0, 0, At, B0); PG8_BAR; PG8_SCHED;
            PG8_LDB(B1, 0, 1); PG8_STAGE(PG8_SB(0, 0), b2, voffB);
            PG8_BAR; PG8_WAIT_L(0); PG8_MMA(0, 1, At, B1); PG8_BAR;
            PG8_LDA(At, 0, 1); PG8_STAGE(PG8_SA(0, 0), a2, voffA);
            PG8_BAR; PG8_WAIT_L(0); PG8_MMA(1, 0, At, B0); PG8_BAR; PG8_SCHED;
            PG8_STAGE(PG8_SB(0, 1), b2 + hstep, voffB);
            PG8_WAIT_V(6); PG8_BAR; PG8_MMA(1, 1, At, B1); PG8_BAR;
            PG8_LDB(B0, 1, 0); PG8_SCHED; PG8_LDA(At, 1, 0); PG8_STAGE(PG8_SA(0, 1), a2 + hstep, voffA);
            PG8_WAIT_L(8); PG8_BAR; PG8_WAIT_L(0); PG8_MMA(0, 0, At, B0); PG8_BAR; PG8_SCHED;
            PG8_LDB(B1, 1, 1); PG8_STAGE(PG8_SB(1, 0), b3, voffB);
            PG8_BAR; PG8_WAIT_L(0); PG8_MMA(0, 1, At, B1); PG8_BAR;
            PG8_LDA(At, 1, 1); PG8_STAGE(PG8_SA(1, 0), a3, voffA);
            PG8_BAR; PG8_WAIT_L(0); PG8_MMA(1, 0, At, B0); PG8_BAR; PG8_SCHED;
            PG8_STAGE(PG8_SB(1, 1), b3 + hstep, voffB);
            PG8_WAIT_V(6); PG8_BAR; PG8_MMA(1, 1, At, B1); PG8_BAR;
            }
        }
        if constexpr (ALIGN_EPI) { if (wr == 0) PG8_BAR; }
        if constexpr (!Epi::AFTER_DRAIN) { E(acc, cur, wr, wc, fr, fq); S.done(cur); }
        if (!has_next) break;
#pragma unroll
        for (int a = 0; a < 2; ++a)
#pragma unroll
            for (int b = 0; b < 2; ++b)
#pragma unroll
                for (int m = 0; m < 4; ++m)
#pragma unroll
                    for (int n = 0; n < 2; ++n) acc[a][b][m][n] = (f32x4){0.f, 0.f, 0.f, 0.f};
        cur = nxt; cA = nA; cB = nB; ++ui;
        if constexpr (ALIGN_EPI) { if (wr == 1) PG8_BAR; }
    }
    PG8_WAIT_V(0);
    if constexpr (!ALIGN_EPI) { if (wr == 0) PG8_BAR; }
    PG8_BAR;
    if constexpr (Epi::AFTER_DRAIN) { E.fused(acc, cur, wr, wc, fr, fq, lds, wid, lane); S.done(cur); }
#undef PG8_SA
#undef PG8_SB
#undef PG8_STAGE
#undef PG8_LDA
#undef PG8_LDB
#undef PG8_MMA
#undef PG8_WAIT_V
#undef PG8_WAIT_L
#undef PG8_BAR
#undef PG8_SCHED
}
}

constexpr int NB = 16, SEQ = 2048, DM = 1024, FF = 2816, MROWS = NB * SEQ;
constexpr int NGU = 2 * FF;
constexpr int NEV = 3584;
constexpr int NOD = 3072;
constexpr float RMS_EPS = 1e-6f;
constexpr float LOG2E = 1.4426950408889634f;
constexpr float QSCALE = 0.125f * LOG2E;

namespace epi {
using namespace pg8;
__device__ __forceinline__ unsigned pkbf(float lo, float hi) {
    typedef float f2_t __attribute__((ext_vector_type(2))); typedef __bf16 b2_t __attribute__((ext_vector_type(2)));
    f2_t v = {lo, hi}; b2_t b = __builtin_convertvector(v, b2_t); return __builtin_bit_cast(unsigned, b); }
__device__ __forceinline__ u32x4 pk8(const f32x4& a, const f32x4& b) { u32x4 w; w.x = pkbf(a[0], a[1]); w.y = pkbf(a[2], a[3]); w.z = pkbf(b[0], b[1]); w.w = pkbf(b[2], b[3]); return w; }

struct EpiSwiGLU {
    static constexpr bool PERM = true, AFTER_DRAIN = false;
    bf16_t* H; const float* rs;
    __device__ __forceinline__ void operator()(const f32x4 (&acc)[2][2][4][2], const Unit& u, int wr, int wc, int fr, int fq) const {
        const int row0 = u.pm * BM + wr * 64 + fr, col0 = u.pn * 128 + wc * 32 + 8 * fq;
#pragma unroll
        for (int ai = 0; ai < 2; ++ai)
#pragma unroll
            for (int m = 0; m < 4; ++m) {
                const int row = row0 + ai * HALF + m * 16; const float s = rs[row];
                f32x4 h[2];
#pragma unroll
                for (int n = 0; n < 2; ++n)
#pragma unroll
                    for (int j = 0; j < 4; ++j) { const float g = acc[ai][0][m][n][j] * s, uu = acc[ai][1][m][n][j] * s;
                        const float e = __builtin_amdgcn_exp2f(-LOG2E * g); h[n][j] = (g * uu) * __builtin_amdgcn_rcpf(1.0f + e); }
                *(u32x4*)(H + (size_t)row * FF + col0) = pk8(h[0], h[1]);
            }
    }
};
struct EpiNull {
    static constexpr bool PERM = true, AFTER_DRAIN = false;
    __device__ __forceinline__ void operator()(const f32x4 (&acc)[2][2][4][2], const Unit& u, int wr, int wc, int fr, int fq) const {
#pragma unroll
        for (int ai = 0; ai < 2; ++ai)
#pragma unroll
            for (int bj = 0; bj < 2; ++bj)
#pragma unroll
                for (int m = 0; m < 4; ++m)
#pragma unroll
                    for (int n = 0; n < 2; ++n) asm volatile("" :: "v"(acc[ai][bj][m][n]));
    }
};
struct EpiBf16Y {
    static constexpr bool PERM = true, AFTER_DRAIN = false;
    bf16_t* Y;
    __device__ __forceinline__ void operator()(const f32x4 (&acc)[2][2][4][2], const Unit& u, int wr, int wc, int fr, int fq) const {
        const int row0 = u.pm * BM + wr * 64 + fr, col0 = u.pn * BM + wc * 32 + 8 * fq;
#pragma unroll
        for (int ai = 0; ai < 2; ++ai)
#pragma unroll
            for (int m = 0; m < 4; ++m) { bf16_t* rowp = Y + (size_t)(row0 + ai * HALF + m * 16) * DM + col0;
#pragma unroll
                for (int bj = 0; bj < 2; ++bj) *(u32x4*)(rowp + bj * HALF) = pk8(acc[ai][bj][m][0], acc[ai][bj][m][1]); }
    }
};
struct EpiF32 {
    static constexpr bool PERM = false, AFTER_DRAIN = false;
    float* Y; int ldc;
    __device__ __forceinline__ void operator()(const f32x4 (&acc)[2][2][4][2], const Unit& u, int wr, int wc, int fr, int fq) const {
        const int row0 = u.pm * BM + wr * 64 + fr, col0 = u.pn * BM + wc * 32 + 4 * fq;
#pragma unroll
        for (int ai = 0; ai < 2; ++ai)
#pragma unroll
            for (int m = 0; m < 4; ++m) { float* rowp = Y + (size_t)(row0 + ai * HALF + m * 16) * ldc + col0;
#pragma unroll
                for (int bj = 0; bj < 2; ++bj)
#pragma unroll
                    for (int n = 0; n < 2; ++n) *(f32x4*)(rowp + bj * HALF + n * 16) = acc[ai][bj][m][n]; }
    }
};
struct EpiProjOdd {
    static constexpr bool PERM = true, AFTER_DRAIN = false;
    bf16_t* Q; const float* rs;
    __device__ __forceinline__ void operator()(const f32x4 (&acc)[2][2][4][2], const Unit& u, int wr, int wc, int fr, int fq) const {
        const int t = u.pn >> 2; bf16_t* base = Q + (size_t)t * ((size_t)MROWS * DM); const float sc = t == 0 ? QSCALE : 1.f;
        const int row0 = u.pm * BM + wr * 64 + fr, col0 = (u.pn & 3) * BM + wc * 32 + 8 * fq;
#pragma unroll
        for (int ai = 0; ai < 2; ++ai)
#pragma unroll
            for (int m = 0; m < 4; ++m) { const int row = row0 + ai * HALF + m * 16; const float s = rs[row] * sc;
#pragma unroll
                for (int bj = 0; bj < 2; ++bj) *(u32x4*)(base + (size_t)row * DM + col0 + bj * HALF) = pk8(acc[ai][bj][m][0] * s, acc[ai][bj][m][1] * s); }
    }
};
struct EpiProjEven {
    static constexpr bool PERM = true, AFTER_DRAIN = false;
    bf16_t *R1, *IQ, *IK; float* IW; const float* rs;
    const float *c64, *s64, *c32, *s32;
    __device__ __forceinline__ void operator()(const f32x4 (&acc)[2][2][4][2], const Unit& u, int wr, int wc, int fr, int fq) const {
        const int pn = u.pn, row0 = u.pm * BM + wr * 64 + fr;
        if (pn == 4 || pn == 5 || pn == 10 || pn == 11) {
            bf16_t* base = R1 + (size_t)(pn >> 1) * ((size_t)MROWS * 512); const int col0 = (pn & 1) * BM + wc * 32 + 8 * fq;
#pragma unroll
            for (int ai = 0; ai < 2; ++ai)
#pragma unroll
                for (int m = 0; m < 4; ++m) { const int row = row0 + ai * HALF + m * 16; const float s = rs[row];
#pragma unroll
                    for (int bj = 0; bj < 2; ++bj) *(u32x4*)(base + (size_t)row * 512 + col0 + bj * HALF) = pk8(acc[ai][bj][m][0] * s, acc[ai][bj][m][1] * s); }
        } else if (pn < 12) {
            bf16_t* base = R1 + (size_t)(pn >> 1) * ((size_t)MROWS * 512);
            const float sc = (pn < 2 || pn == 6 || pn == 7) ? QSCALE : 1.f;
            const int head = 4 * (pn & 1) + wc, d0 = 8 * fq;
#pragma unroll
            for (int ai = 0; ai < 2; ++ai)
#pragma unroll
                for (int m = 0; m < 4; ++m) { const int row = row0 + ai * HALF + m * 16, pos = row & (SEQ - 1); const float s = rs[row] * sc;
                    f32x4 o1[2], o2[2];
#pragma unroll
                    for (int n = 0; n < 2; ++n) { const f32x4 cc = *(const f32x4*)(c64 + pos * 32 + d0 + 4 * n), ss = *(const f32x4*)(s64 + pos * 32 + d0 + 4 * n);
                        const f32x4 x1 = acc[ai][0][m][n] * s, x2 = acc[ai][1][m][n] * s; o1[n] = x1 * cc - x2 * ss; o2[n] = x2 * cc + x1 * ss; }
                    bf16_t* dst = base + (size_t)row * 512 + head * 64 + d0;
                    *(u32x4*)dst = pk8(o1[0], o1[1]); *(u32x4*)(dst + 32) = pk8(o2[0], o2[1]); }
        } else if (pn == 12) {
            const int head = 2 * wc + (fq >> 1), d0 = 8 * (fq & 1);
#pragma unroll
            for (int ai = 0; ai < 2; ++ai)
#pragma unroll
                for (int m = 0; m < 4; ++m) { const int row = row0 + ai * HALF + m * 16, pos = row & (SEQ - 1); const float s = rs[row];
                    f32x4 o1[2], o2[2];
#pragma unroll
                    for (int n = 0; n < 2; ++n) { const f32x4 cc = *(const f32x4*)(c32 + pos * 16 + d0 + 4 * n), ss = *(const f32x4*)(s32 + pos * 16 + d0 + 4 * n);
                        const f32x4 x1 = acc[ai][0][m][n] * s, x2 = acc[ai][1][m][n] * s; o1[n] = x1 * cc - x2 * ss; o2[n] = x2 * cc + x1 * ss; }
                    bf16_t* dst = IQ + (size_t)row * 256 + head * 32 + d0;
                    *(u32x4*)dst = pk8(o1[0], o1[1]); *(u32x4*)(dst + 16) = pk8(o2[0], o2[1]); }
        } else {
            if (wc == 0 && fq < 2) {
                const int d0 = 8 * fq;
#pragma unroll
                for (int ai = 0; ai < 2; ++ai)
#pragma unroll
                    for (int m = 0; m < 4; ++m) { const int row = row0 + ai * HALF + m * 16, pos = row & (SEQ - 1); const float s = rs[row];
                        f32x4 o1[2], o2[2];
#pragma unroll
                        for (int n = 0; n < 2; ++n) { const f32x4 cc = *(const f32x4*)(c32 + pos * 16 + d0 + 4 * n), ss = *(const f32x4*)(s32 + pos * 16 + d0 + 4 * n);
                            const f32x4 x1 = acc[ai][0][m][n] * s, x2 = acc[ai][1][m][n] * s; o1[n] = x1 * cc - x2 * ss; o2[n] = x2 * cc + x1 * ss; }
                        bf16_t* dst = IK + (size_t)row * 32 + d0;
                        *(u32x4*)dst = pk8(o1[0], o1[1]); *(u32x4*)(dst + 16) = pk8(o2[0], o2[1]); }
            } else if (wc == 0 && fq == 2) {
#pragma unroll
                for (int ai = 0; ai < 2; ++ai)
#pragma unroll
                    for (int m = 0; m < 4; ++m) { const int row = row0 + ai * HALF + m * 16; const float s = rs[row] * 0.0625f;
                        *(f32x4*)(IW + (size_t)row * 8) = acc[ai][0][m][0] * s; *(f32x4*)(IW + (size_t)row * 8 + 4) = acc[ai][0][m][1] * s; }
            }
        }
    }
};
}

namespace att {
#define ALAS __attribute__((address_space(3)))
typedef unsigned short bf16_t;
typedef short bf16x8 __attribute__((ext_vector_type(8)));
typedef short s16x4 __attribute__((ext_vector_type(4)));
typedef float f32x16 __attribute__((ext_vector_type(16)));
typedef float f32x4 __attribute__((ext_vector_type(4)));
typedef unsigned u32x4 __attribute__((ext_vector_type(4)));
typedef short v4i16_t __attribute__((ext_vector_type(4)));
__device__ __forceinline__ int crow(int r, int hi) { return (r & 3) + 8 * (r >> 2) + 4 * hi; }
__device__ __forceinline__ unsigned cvtpk(float lo, float hi) { typedef float f2_t __attribute__((ext_vector_type(2))); typedef __bf16 b2_t __attribute__((ext_vector_type(2)));
    f2_t v = {lo, hi}; b2_t b = __builtin_convertvector(v, b2_t); return __builtin_bit_cast(unsigned, b); }
__device__ __forceinline__ s16x4 vtr(const ALAS unsigned char* p) { return __builtin_bit_cast(s16x4, __builtin_amdgcn_ds_read_tr16_b64_v4i16((ALAS v4i16_t*)p)); }
__device__ __forceinline__ float halfswap_max(float m) { auto rr = __builtin_amdgcn_permlane32_swap(__float_as_uint(m), __float_as_uint(m), false, false); return fmaxf(__uint_as_float(rr[0]), __uint_as_float(rr[1])); }
__device__ __forceinline__ float halfswap_sum(float m) { auto rr = __builtin_amdgcn_permlane32_swap(__float_as_uint(m), __float_as_uint(m), false, false); return __uint_as_float(rr[0]) + __uint_as_float(rr[1]); }

template <int DV> struct Lds {
    static constexpr int KB = 8192, VB = DV * 128;
    static constexpr int OFF_K = 0, OFF_V = 2 * KB, OFF_WSF = OFF_V + 2 * VB, OFF_BT = OFF_WSF + 8 * 256, OFF_OST = OFF_BT + 2048, OST_W = 32 * DV * 2, TOTAL = OFF_OST + 8 * OST_W;
};

template <int DV, int MODE, int THR>
__device__ __forceinline__ void attn_core(f32x16 (&o)[DV / 32], ALAS unsigned char* lds,
                                          const bf16_t* Qw, int ldq, const bf16_t* Kh, int ldk, const bf16_t* Vh, int ldv,
                                          int T0, int T1, int tw0, int tw1,
                                          const unsigned long long* maskrow, int qpos, int qchunk) {
    typedef Lds<DV> L; constexpr int NDB = DV / 32, NVL = DV / 64;
    int tid = threadIdx.x; asm volatile("" : "+v"(tid));
    const int lane = tid & 63, r32 = lane & 31, hi = lane >> 5; const int wid = __builtin_amdgcn_readfirstlane(tid >> 6);
    ALAS float* wsf = (ALAS float*)(lds + L::OFF_WSF) + wid * 64;
    const ALAS float* btab = (const ALAS float*)(lds + L::OFF_BT);
    bf16x8 qr[4];
#pragma unroll
    for (int d0 = 0; d0 < 4; ++d0) qr[d0] = *(const bf16x8*)(Qw + (size_t)r32 * ldq + d0 * 16 + hi * 8);
    const int skey = tid >> 3, sch = tid & 7;
    const bf16_t* kg = Kh + (size_t)skey * ldk + sch * 8; const bf16_t* vg = Vh + (size_t)skey * ldv + sch * 8;
    const int koff = sch * 1024 + skey * 16; int voff[NVL];
#pragma unroll
    for (int i = 0; i < NVL; ++i) { const int c2 = sch + 8 * i; voff[i] = (c2 >> 2) * 4096 + skey * 64 + (c2 & 3) * 16; }
    u32x4 kreg, vreg[NVL];
#define ATT_LOADT(t) do { kreg = *(const u32x4*)(kg + (size_t)(t) * 64 * ldk); _Pragma("unroll") for (int i_ = 0; i_ < NVL; ++i_) vreg[i_] = *(const u32x4*)(vg + (size_t)(t) * 64 * ldv + 64 * i_); } while (0)
#define ATT_WRITET(buf) do { *(ALAS u32x4*)(lds + L::OFF_K + (buf) * L::KB + koff) = kreg; _Pragma("unroll") for (int i_ = 0; i_ < NVL; ++i_) *(ALAS u32x4*)(lds + L::OFF_V + (buf) * L::VB + voff[i_]) = vreg[i_]; } while (0)
    float m_run = -1e30f, l_part = 0.f;
#pragma unroll
    for (int d0 = 0; d0 < NDB; ++d0) o[d0] = f32x16{};
    unsigned long long mw = 0ull;
    if (MODE == 1) mw = maskrow[tw0];
    ATT_LOADT(T0); ATT_WRITET(0); __syncthreads();
    for (int t = T0; t < T1; ++t) {
        const int cur = (t - T0) & 1; const bool more = (t + 1 < T1);
        if (more) ATT_LOADT(t + 1);
        if (t >= tw0 && t < tw1) {
            unsigned long long mwn = 0ull;
            if (MODE == 1) { if (t + 1 < tw1) mwn = maskrow[t + 1]; }
            f32x16 p0, p1;
            if (MODE == 2) {
                const int jrel = qchunk - t;
                if (jrel >= 5) { const float bc = btab[319];
#pragma unroll
                    for (int r = 0; r < 16; ++r) { p0[r] = bc; p1[r] = bc; } }
                else { const int base = qpos - 64 * t;
#pragma unroll
                    for (int r = 0; r < 16; ++r) { const int d = base - crow(r, hi); const int i0 = (d < 256 ? d : 256) + 63, i1 = (d - 32 < 256 ? d - 32 : 256) + 63; p0[r] = btab[i0]; p1[r] = btab[i1]; } }
            } else { p0 = f32x16{}; p1 = f32x16{}; }
            const ALAS unsigned char* kb = lds + L::OFF_K + cur * L::KB + hi * 1024 + r32 * 16;
#pragma unroll
            for (int d0 = 0; d0 < 4; ++d0) { const bf16x8 b0 = *(const ALAS bf16x8*)(kb + d0 * 2048), b1 = *(const ALAS bf16x8*)(kb + d0 * 2048 + 512);
                p0 = __builtin_amdgcn_mfma_f32_32x32x16_bf16(b0, qr[d0], p0, 0, 0, 0); p1 = __builtin_amdgcn_mfma_f32_32x32x16_bf16(b1, qr[d0], p1, 0, 0, 0); }
            if (MODE == 1) { const unsigned w0 = (unsigned)mw >> (4 * hi), w1 = (unsigned)(mw >> 32) >> (4 * hi);
#pragma unroll
                for (int r = 0; r < 16; ++r) { const unsigned bit = 1u << ((r & 3) + 8 * (r >> 2)); p0[r] = (w0 & bit) ? p0[r] : -INFINITY; p1[r] = (w1 & bit) ? p1[r] : -INFINITY; }
                mw = mwn; }
            float mx = fmaxf(p0[0], p1[0]);
#pragma unroll
            for (int r = 1; r < 16; ++r) mx = fmaxf(mx, fmaxf(p0[r], p1[r]));
            mx = halfswap_max(mx);
            if (__any(mx > m_run + (float)THR)) {
                const float mnew = fmaxf(m_run, mx); const float f = __builtin_amdgcn_exp2f(m_run - mnew);
                l_part *= f; m_run = mnew; if (hi == 0) wsf[r32] = f;
#pragma unroll
                for (int r = 0; r < 16; ++r) { const float fr_ = wsf[crow(r, hi)];
#pragma unroll
                    for (int d0 = 0; d0 < NDB; ++d0) o[d0][r] *= fr_; }
            }
            float sacc = 0.f;
#pragma unroll
            for (int r = 0; r < 16; ++r) { p0[r] = __builtin_amdgcn_exp2f(p0[r] - m_run); p1[r] = __builtin_amdgcn_exp2f(p1[r] - m_run); sacc += p0[r] + p1[r]; }
            l_part += sacc;
            u32x4 pw[4];
#pragma unroll
            for (int k = 0; k < 2; ++k)
#pragma unroll
                for (int j = 0; j < 4; ++j) { pw[k][j] = cvtpk(p0[8 * k + 2 * j], p0[8 * k + 2 * j + 1]); pw[2 + k][j] = cvtpk(p1[8 * k + 2 * j], p1[8 * k + 2 * j + 1]); }
            const ALAS unsigned char* vb = lds + L::OFF_V + cur * L::VB + ((lane >> 4) & 1) * 32 + (lane & 3) * 8 + (4 * hi + ((lane & 15) >> 2)) * 64;
#pragma unroll
            for (int d0 = 0; d0 < NDB; ++d0)
#pragma unroll
                for (int ks = 0; ks < 4; ++ks) { const s16x4 lo = vtr(vb + d0 * 4096 + ks * 1024), up = vtr(vb + d0 * 4096 + ks * 1024 + 512);
                    const bf16x8 vf = (bf16x8){lo[0], lo[1], lo[2], lo[3], up[0], up[1], up[2], up[3]};
                    o[d0] = __builtin_amdgcn_mfma_f32_32x32x16_bf16(__builtin_bit_cast(bf16x8, pw[ks]), vf, o[d0], 0, 0, 0); }
        }
        if (more) ATT_WRITET(cur ^ 1);
        __syncthreads();
    }
#undef ATT_LOADT
#undef ATT_WRITET
    const float l = halfswap_sum(l_part);
    if (hi == 0) wsf[32 + r32] = l;
#pragma unroll
    for (int r = 0; r < 16; ++r) { const float rl = 1.0f / wsf[32 + crow(r, hi)];
#pragma unroll
        for (int d0 = 0; d0 < NDB; ++d0) o[d0][r] *= rl; }
}

template <int DV>
__device__ __forceinline__ void store_o(const f32x16 (&o)[DV / 32], ALAS unsigned char* lds, bf16_t* dst, int ldo) {
    typedef Lds<DV> L; constexpr int NDB = DV / 32, CPR = DV / 8, RPI = 64 / CPR;
    int tid = threadIdx.x; asm volatile("" : "+v"(tid));
    const int lane = tid & 63, r32 = lane & 31, hi = lane >> 5; const int wid = __builtin_amdgcn_readfirstlane(tid >> 6);
    ALAS bf16_t* stg = (ALAS bf16_t*)(lds + L::OFF_OST + wid * L::OST_W);
#pragma unroll
    for (int r = 0; r < 16; ++r) { const int orow = crow(r, hi);
#pragma unroll
        for (int d0 = 0; d0 < NDB; ++d0) stg[orow * DV + d0 * 32 + r32] = (bf16_t)(cvtpk(o[d0][r], 0.f) & 0xffffu); }
#pragma unroll
    for (int i = 0; i < 32 / RPI; ++i) { const int row = i * RPI + lane / CPR, ch = lane % CPR; const u32x4 v = *(const ALAS u32x4*)(stg + row * DV + ch * 8); *(u32x4*)(dst + (size_t)row * ldo + ch * 8) = v; }
}
}
#define GAS __attribute__((address_space(1)))
#define LAS __attribute__((address_space(3)))
typedef unsigned short bf16;
typedef unsigned v4u __attribute__((ext_vector_type(4)));
typedef float f32x4 __attribute__((ext_vector_type(4)));
typedef short bf16x8 __attribute__((ext_vector_type(8)));
typedef GAS unsigned gu32;
typedef GAS unsigned long long gu64;
#define RLX_AGENT __ATOMIC_RELAXED, __HIP_MEMORY_SCOPE_AGENT
#define LDS_WAIT() asm volatile("s_waitcnt lgkmcnt(0)" ::: "memory")
#define VM_WAIT() asm volatile("s_waitcnt vmcnt(0)" ::: "memory")
__device__ __forceinline__ unsigned long long rt() { return __builtin_amdgcn_s_memrealtime(); }
__device__ __forceinline__ unsigned f2bf(float f) { unsigned u = __builtin_bit_cast(unsigned, f); return (u + 0x7fffu + ((u >> 16) & 1u)) >> 16; }
__device__ __forceinline__ unsigned pk2(float lo, float hi) { return f2bf(lo) | (f2bf(hi) << 16); }

#define XB_TMO      128
#define XB_XCNT(j)  (256  + 64 * (j))
#define XB_XSUB(j)  (1280 + 64 * (j))
#define XB_XGEN(j)  (2304 + 64 * (j))
#define XB_TOP      3328
#define XB_TOPGEN   3392
#define XCD_BAR_WORDS 3456
#define XB_SPIN_CAP (1u << 18)

__device__ __forceinline__ unsigned xb_ld(unsigned* p)              { return __hip_atomic_load(p, __ATOMIC_RELAXED, __HIP_MEMORY_SCOPE_AGENT); }
__device__ __forceinline__ unsigned xb_add(unsigned* p, unsigned v) { return __hip_atomic_fetch_add(p, v, __ATOMIC_RELAXED, __HIP_MEMORY_SCOPE_AGENT); }
__device__ __forceinline__ unsigned xb_xcc_id() { return (unsigned)__builtin_amdgcn_s_getreg((3 << 11) | 20) & 0xFu; }
#define XB_SPIN(cond, bar) do { unsigned _sp = 0; while (cond) { __builtin_amdgcn_s_sleep(1); \
    if ((++_sp & 255u) == 0u) { if (xb_ld(&(bar)[XB_TMO])) break; if (_sp > XB_SPIN_CAP) { atomicAdd(&(bar)[XB_TMO], 1u); break; } } } } while (0)

struct XcdBarrier {
    unsigned* bar; unsigned x;
    volatile LAS unsigned* st;
};

__device__ __forceinline__ XcdBarrier xcd_barrier_post(unsigned* bar, volatile LAS unsigned* st) {
    XcdBarrier b; b.bar = bar; b.x = xb_xcc_id(); b.st = st;
    if (threadIdx.x == 0) (void)xb_add(&bar[XB_XCNT(b.x)], 1u);
    return b;
}
__device__ __forceinline__ void xcd_barrier_complete(unsigned* bar, unsigned x, unsigned& nloc, unsigned& nx) {
    const unsigned G = gridDim.x * gridDim.y * gridDim.z;
    unsigned sum, cnt, mine, sp = 0u;
    for (;;) {
        sum = 0u; cnt = 0u; mine = 0u;
#pragma unroll
        for (unsigned j = 0; j < 16; ++j) { const unsigned c = xb_ld(&bar[XB_XCNT(j)]); sum += c; cnt += (c > 0u) ? 1u : 0u; mine = (j == x) ? c : mine; }
        if (sum == G) break;
        __builtin_amdgcn_s_sleep(1);
        if ((++sp & 255u) == 0u) { if (xb_ld(&bar[XB_TMO])) break; if (sp > XB_SPIN_CAP) { atomicAdd(&bar[XB_TMO], 1u); break; } }
    }
    nloc = mine > 0u ? mine : 1u; nx = cnt > 0u ? cnt : 1u;
}

__device__ __forceinline__ void xcd_barrier(const XcdBarrier& b) {
    asm volatile("s_waitcnt vmcnt(0)" ::: "memory");
    __syncthreads();
    if (threadIdx.x == 0) {
        unsigned* bar = b.bar;
        __builtin_amdgcn_s_waitcnt(0);
        unsigned nloc = b.st[0], nx = b.st[1];
        if (nloc == 0u) { xcd_barrier_complete(bar, b.x, nloc, nx); b.st[0] = nloc; b.st[1] = nx; }
        const unsigned old = xb_add(&bar[XB_XSUB(b.x)], 1u);
        const unsigned gen = old / nloc;
        if (old + 1u == (gen + 1u) * nloc) {
            __builtin_amdgcn_fence(__ATOMIC_RELEASE, "agent");
            asm volatile("s_waitcnt vmcnt(0)" ::: "memory");
            const unsigned og = xb_add(&bar[XB_TOP], 1u);
            const unsigned tg = og / nx;
            if (og + 1u == (tg + 1u) * nx) xb_add(&bar[XB_TOPGEN], 1u);
            else XB_SPIN(xb_ld(&bar[XB_TOPGEN]) == tg, bar);
            __builtin_amdgcn_fence(__ATOMIC_ACQUIRE, "agent");
            xb_add(&bar[XB_XGEN(b.x)], 1u);
            asm volatile("s_waitcnt vmcnt(0)" ::: "memory");
        } else {
            XB_SPIN(xb_ld(&bar[XB_XGEN(b.x)]) == gen, bar);
            __builtin_amdgcn_fence(__ATOMIC_ACQUIRE, "agent");
            asm volatile("s_waitcnt vmcnt(0)" ::: "memory");
        }
    }
    __syncthreads();
}

constexpr int NWAVES = 8;
constexpr size_t MiB = 1u << 20;
constexpr size_t WS_CTL = 0, CTL_ZERO_BYTES = 1 * MiB;
constexpr size_t WS_C64 = 1 * MiB, WS_S64 = WS_C64 + 256 * 1024, WS_C32 = WS_C64 + 512 * 1024, WS_S32 = WS_C64 + 640 * 1024, WS_RS = WS_C64 + 768 * 1024;
constexpr size_t WS_WGU = 2 * MiB, WGU_BYTES = (size_t)NGU * DM * 2;
constexpr size_t WS_WD = 46 * MiB, WD_BYTES = (size_t)DM * FF * 2;
constexpr size_t WS_WIN0 = 68 * MiB, WS_WOUT0 = 75 * MiB, WS_WIN1 = 77 * MiB, WS_WOUT1 = 83 * MiB;
constexpr size_t WS_MASK = 85 * MiB;
constexpr size_t WS_XB = 93 * MiB;
constexpr size_t WS_R1 = 157 * MiB;
constexpr size_t WS_Y = 381 * MiB;
constexpr size_t WS_ATT = 445 * MiB;
constexpr size_t WS_END = 509 * MiB;
static_assert(WS_WGU + 4 * WGU_BYTES <= WS_WD && WS_WD + 4 * WD_BYTES <= WS_WIN0 && WS_WIN0 + (size_t)NEV * DM * 2 <= WS_WOUT0 && WS_WIN1 + (size_t)NOD * DM * 2 <= WS_WOUT1, "weight map");
static_assert(WS_R1 + (size_t)MROWS * FF * 2 <= WS_Y && WS_R1 + 211 * MiB <= WS_Y, "R1 map");
constexpr int CW_BAR = 4096;
constexpr int RING_BYTES = 131072, LDSCTL_OFF = RING_BYTES, MISC_OFF = LDSCTL_OFF + 320, LDS_BYTES = 147456;

struct Frame {
    LAS unsigned char* lds; volatile LAS unsigned* MISC; gu32* ctl;
    int tid, lane, wave, vcu, G;
};

template <int X> __device__ __forceinline__ float swz_xor(float v) { return __int_as_float(__builtin_amdgcn_ds_swizzle(__float_as_int(v), (X << 10) | 0x1f)); }
__device__ __forceinline__ float sum32(float v) { v += swz_xor<1>(v); v += swz_xor<2>(v); v += swz_xor<4>(v); v += swz_xor<8>(v); v += swz_xor<16>(v); return v; }
__device__ __forceinline__ float wave_sum(float v) { return att::halfswap_sum(sum32(v)); }
struct MapGUHalf { int bj; __device__ __forceinline__ int src(int R) const { return R; } __device__ __forceinline__ int dst(int R) const { return 256 * (R >> 7) + 128 * bj + (R & 127); } };
struct MapId { __device__ __forceinline__ int src(int R) const { return R; } __device__ __forceinline__ int dst(int R) const { return R; } };
__device__ __forceinline__ int even_src(int R) {
    const int pn = R >> 8, bj = (R >> 7) & 1, jj = R & 127;
    if (pn < 4) return (pn < 2 ? 0 : 512) + (4 * (pn & 1) + (jj >> 5)) * 64 + 32 * bj + (jj & 31);
    if (pn < 6) return 1024 + 256 * (pn - 4) + 128 * bj + jj;
    if (pn < 10) return (pn < 8 ? 1536 : 2048) + (4 * (pn & 1) + (jj >> 5)) * 64 + 32 * bj + (jj & 31);
    if (pn < 12) return 2560 + 256 * (pn - 10) + 128 * bj + jj;
    if (pn == 12) return 3072 + (jj >> 4) * 32 + 16 * bj + (jj & 15);
    if (jj < 16) return 3328 + 16 * bj + jj;
    if (bj == 0 && jj < 24) return 3360 + (jj - 16);
    return -1;
}
struct MapEven { __device__ __forceinline__ int src(int R) const { return even_src(R); } __device__ __forceinline__ int dst(int R) const { return R; } };
template <class Map>
__device__ __forceinline__ void transpose_item(const Map& mp, const float* W, int ldw, int K, int nrows, bf16* WT, const float* g, LAS float* scr, int item, int lane) {
    const int nblk = nrows / 32, kb = item / nblk, nb = item % nblk, k0 = 64 * kb, n0 = 32 * nb;
    const int sc0 = mp.src(n0 + (lane & 31)); const float mul = sc0 >= 0 ? 1.f : 0.f; const float* src = W + (sc0 >= 0 ? sc0 : 0);
#pragma unroll 8
    for (int i = 0; i < 32; ++i) { const int kk = 2 * i + (lane >> 5); float v = src[(size_t)(k0 + kk) * ldw] * mul; if (g) v *= g[k0 + kk]; scr[kk * 33 + (lane & 31)] = v; }
    LDS_WAIT(); asm volatile("" ::: "memory");
    const int c = lane & 7;
#pragma unroll
    for (int j = 0; j < 4; ++j) { const int n = (lane >> 3) + 8 * j; const LAS float* s = scr + (8 * c) * 33 + n;
        v4u o; o.x = pk2(s[0 * 33], s[1 * 33]); o.y = pk2(s[2 * 33], s[3 * 33]); o.z = pk2(s[4 * 33], s[5 * 33]); o.w = pk2(s[6 * 33], s[7 * 33]);
        *(GAS v4u*)(WT + (size_t)mp.dst(n0 + n) * K + k0 + 8 * c) = o; }
    LDS_WAIT(); asm volatile("" ::: "memory");
}
__device__ __forceinline__ void sincos_d(double a, float& sn, float& cs) {
    const double k = __builtin_rint(a * 0.6366197723675814); const double y = a - k * 1.5707963267948966; const double y2 = y * y;
    const double s = y * (1.0 + y2 * (-1.0 / 6 + y2 * (1.0 / 120 + y2 * (-1.0 / 5040 + y2 * (1.0 / 362880 + y2 * (-1.0 / 39916800 + y2 * (1.0 / 6227020800.0)))))));
    const double c = 1.0 + y2 * (-0.5 + y2 * (1.0 / 24 + y2 * (-1.0 / 720 + y2 * (1.0 / 40320 + y2 * (-1.0 / 3628800 + y2 * (1.0 / 479001600.0 + y2 * (-1.0 / 87178291200.0)))))));
    const int q = (int)((long long)k & 3);
    const double ss = (q == 0) ? s : (q == 1) ? c : (q == 2) ? -s : -c, cc = (q == 0) ? c : (q == 1) ? -s : (q == 2) ? -c : s;
    sn = (float)ss; cs = (float)cc;
}
__device__ __forceinline__ void x_to_bf16_row(const float* xrow, bf16* xb, float* rs, int lane) {
    const GAS f32x4* xr = (const GAS f32x4*)xrow + lane; f32x4 v[4]; float s = 0.f;
#pragma unroll
    for (int j = 0; j < 4; ++j) { v[j] = xr[64 * j]; s += (v[j].x * v[j].x + v[j].y * v[j].y) + (v[j].z * v[j].z + v[j].w * v[j].w); }
    GAS unsigned long long* o8 = (GAS unsigned long long*)xb + lane;
#pragma unroll
    for (int j = 0; j < 4; ++j) o8[64 * j] = (unsigned long long)epi::pkbf(v[j].x, v[j].y) | ((unsigned long long)epi::pkbf(v[j].z, v[j].w) << 32);
    const float r = 1.0f / sqrtf(wave_sum(s) * (1.f / DM) + RMS_EPS); if (lane == 0) *rs = r;
}
__device__ __forceinline__ void bf8_to_f32(const v4u& w, float (&f)[8]) {
#pragma unroll
    for (int i = 0; i < 4; ++i) { f[2 * i] = __uint_as_float(w[i] << 16); f[2 * i + 1] = __uint_as_float(w[i] & 0xffff0000u); } }
template <bool LAST>
__device__ __forceinline__ void thin_row(const bf16* yrow, bf16* xrow, float* outf, const float* ga, float alpha, float* rs, int lane) {
    float y[2][8], x[2][8]; float s = 0.f;
#pragma unroll
    for (int j = 0; j < 2; ++j) { const v4u yw = *((const GAS v4u*)yrow + lane + 64 * j), xw = *((const GAS v4u*)xrow + lane + 64 * j); bf8_to_f32(yw, y[j]); bf8_to_f32(xw, x[j]);
#pragma unroll
        for (int i = 0; i < 8; ++i) s += y[j][i] * y[j][i]; }
    const float r1 = alpha / sqrtf(wave_sum(s) * (1.f / DM) + RMS_EPS); float s2 = 0.f;
#pragma unroll
    for (int j = 0; j < 2; ++j) { const f32x4 g0 = *((const GAS f32x4*)ga + 2 * lane + 128 * j), g1 = *((const GAS f32x4*)ga + 2 * lane + 128 * j + 1);
#pragma unroll
        for (int i = 0; i < 8; ++i) { const float g = i < 4 ? g0[i & 3] : g1[i & 3]; x[j][i] += y[j][i] * g * r1; s2 += x[j][i] * x[j][i]; }
        if (LAST) { *((GAS f32x4*)outf + 2 * lane + 128 * j) = (f32x4){x[j][0], x[j][1], x[j][2], x[j][3]}; *((GAS f32x4*)outf + 2 * lane + 128 * j + 1) = (f32x4){x[j][4], x[j][5], x[j][6], x[j][7]}; }
        else { v4u o; o.x = epi::pkbf(x[j][0], x[j][1]); o.y = epi::pkbf(x[j][2], x[j][3]); o.z = epi::pkbf(x[j][4], x[j][5]); o.w = epi::pkbf(x[j][6], x[j][7]); *((GAS v4u*)xrow + lane + 64 * j) = o; } }
    if (!LAST) { const float r2 = 1.0f / sqrtf(wave_sum(s2) * (1.f / DM) + RMS_EPS); if (lane == 0) *rs = r2; }
}

struct Ptrs {
    const float *x, *norm_g, *wg, *wu, *wd, *ewin, *ewout, *elam, *esub, *owin, *owout, *obias; float* out; unsigned char* ws;
};

__device__ __forceinline__ void p0_prologue(Frame& F0, const Ptrs& P) {
    struct { LAS unsigned char* lds; int tid, lane, wave, vcu, G; } F;
    { int t = threadIdx.x; asm volatile("" : "+v"(t)); F.lds = F0.lds; F.tid = t; F.lane = t & 63; F.wave = __builtin_amdgcn_readfirstlane(t >> 6); F.vcu = F0.vcu; F.G = F0.G; }
    LAS float* scr = (LAS float*)(F.lds + F.wave * 16384);
    const int gw = F.vcu * NWAVES + F.wave, NGW = F.G * NWAVES;
    constexpr int I_GH = (DM / 64) * (FF / 32), I_WD = (FF / 64) * (DM / 32), I_E = (DM / 64) * (NEV / 32), I_O = (DM / 64) * (DM / 32), I_OD = (DM / 64) * (NOD / 32);
    constexpr int NITEMS = 8 * I_GH + 4 * I_WD + I_E + I_O + I_OD + I_O;
    for (int it = gw; it < NITEMS; it += NGW) {
        int r = it;
        if (r < 8 * I_GH) { const int i8 = r / I_GH; r -= i8 * I_GH; const int i = i8 >> 1, bj = i8 & 1, l = i >> 1, f = i & 1;
            MapGUHalf mp{bj}; const float* W = (bj ? P.wu : P.wg) + (size_t)i * DM * FF;
            transpose_item(mp, W, FF, DM, FF, (bf16*)(P.ws + WS_WGU + i * WGU_BYTES), P.norm_g + (l * 6 + 4 * f) * DM, scr, r, F.lane); continue; }
        r -= 8 * I_GH;
        if (r < 4 * I_WD) { const int i = r / I_WD; r -= i * I_WD; MapId mp;
            transpose_item(mp, P.wd + (size_t)i * FF * DM, DM, FF, DM, (bf16*)(P.ws + WS_WD + i * WD_BYTES), nullptr, scr, r, F.lane); continue; }
        r -= 4 * I_WD;
        if (r < I_E) { MapEven mp; transpose_item(mp, P.ewin, 3368, DM, NEV, (bf16*)(P.ws + WS_WIN0), P.norm_g + (0 * 6 + 2) * DM, scr, r, F.lane); continue; }
        r -= I_E;
        if (r < I_O) { MapId mp; transpose_item(mp, P.ewout, DM, DM, DM, (bf16*)(P.ws + WS_WOUT0), nullptr, scr, r, F.lane); continue; }
        r -= I_O;
        if (r < I_OD) { MapId mp; transpose_item(mp, P.owin, NOD, DM, NOD, (bf16*)(P.ws + WS_WIN1), P.norm_g + (1 * 6 + 2) * DM, scr, r, F.lane); continue; }
        r -= I_OD;
        { MapId mp; transpose_item(mp, P.owout, DM, DM, DM, (bf16*)(P.ws + WS_WOUT1), nullptr, scr, r, F.lane); }
    }
    float* c64 = (float*)(P.ws + WS_C64); float* s64 = (float*)(P.ws + WS_S64); float* c32 = (float*)(P.ws + WS_C32); float* s32 = (float*)(P.ws + WS_S32);
    const int gt = F.vcu * (NWAVES * 64) + F.tid, NGT = F.G * NWAVES * 64;
    for (int e = gt; e < SEQ * 48; e += NGT) {
        const bool is64 = e < SEQ * 32; const int ee = is64 ? e : e - SEQ * 32; const int pos = is64 ? (ee >> 5) : (ee >> 4), i = is64 ? (ee & 31) : (ee & 15);
        const double rb = is64 ? 0.7498942093324559 : 0.5623413251903492; double inv = 1.0; for (int k = 0; k < i; ++k) inv *= rb;
        const float ang = (float)pos * (float)inv; float sn, cs; sincos_d((double)ang, sn, cs);
        if (is64) { c64[ee] = cs; s64[ee] = sn; } else { c32[ee] = cs; s32[ee] = sn; }
    }
    bf16* XB = (bf16*)(P.ws + WS_XB); float* RS = (float*)(P.ws + WS_RS);
    for (int m = gw; m < MROWS; m += NGW) x_to_bf16_row(P.x + (size_t)m * DM, XB + (size_t)m * DM, RS + m, F.lane);
}
#ifndef PROBE_REP_IDXA
#define PROBE_REP_IDXA 1
#endif
#ifndef PROBE_REP_B
#define PROBE_REP_B 1
#endif
#ifndef PROBE_REP_C
#define PROBE_REP_C 1
#endif
#ifndef PROBE_REP_GU
#define PROBE_REP_GU 1
#endif
#ifndef PROBE_REP_DN
#define PROBE_REP_DN 1
#endif
#ifndef PROBE_NULL_GU
#define PROBE_NULL_GU 0
#endif
#ifndef PROBE_NULL_DN
#define PROBE_NULL_DN 0
#endif
#ifndef PROBE_REP_THIN
#define PROBE_REP_THIN 1
#endif
template <bool LAST>
__device__ __forceinline__ void thin_phase(Frame& F, const Ptrs& P, const float* ga, float alpha) {
    int t_ = threadIdx.x; asm volatile("" : "+v"(t_)); const int lane_ = t_ & 63, wave_ = __builtin_amdgcn_readfirstlane(t_ >> 6);
    const int gw = F.vcu * NWAVES + wave_, NGW = F.G * NWAVES;
    const bf16* Y = (const bf16*)(P.ws + WS_Y); bf16* XB = (bf16*)(P.ws + WS_XB); float* RS = (float*)(P.ws + WS_RS);
    for (int m = gw; m < MROWS; m += NGW) thin_row<LAST>(Y + (size_t)m * DM, XB + (size_t)m * DM, P.out + (size_t)m * DM, ga, alpha, RS + m, lane_);
}

__device__ __forceinline__ void indexer_unit(Frame& F, const Ptrs& P, int b, int blk) {
    typedef short bf16x8v __attribute__((ext_vector_type(8)));
    int tid = threadIdx.x; asm volatile("" : "+v"(tid));
    const int q0 = blk * 16, qc = q0 >> 6, n64 = qc + 1, nvis = n64 * 64; const int lane = tid & 63, wid = __builtin_amdgcn_readfirstlane(tid >> 6);
    unsigned long long* mrow = (unsigned long long*)(P.ws + WS_MASK) + ((size_t)(b * SEQ + q0)) * 32;
    if (n64 <= 4) {
        for (int i = tid; i < 16 * 32; i += NWAVES * 64) { const int w = i & 31; if (w < n64) mrow[i] = ~0ull; }
        return;
    }
    const bf16* IQ = (const bf16*)(P.ws + WS_R1 + 192 * MiB); const bf16* IK = (const bf16*)(P.ws + WS_R1 + 208 * MiB); const float* IW = (const float*)(P.ws + WS_R1 + 210 * MiB);
    LAS float* sc = (LAS float*)F.lds;
    {
        const int q = lane & 15, kg = lane >> 4; const size_t qrow = (size_t)(b * SEQ + q0 + q);
        bf16x8v iq[8]; float wi[8];
#pragma unroll
        for (int h = 0; h < 8; ++h) { iq[h] = *(const bf16x8v*)(IQ + qrow * 256 + h * 32 + 8 * kg); wi[h] = IW[qrow * 8 + h]; }
        for (int kt = wid; kt < nvis / 16; kt += NWAVES) {
            const bf16x8v a = *(const bf16x8v*)(IK + ((size_t)(b * SEQ + kt * 16 + q)) * 32 + 8 * kg);
            f32x4 acc = {0.f, 0.f, 0.f, 0.f};
#pragma unroll
            for (int h = 0; h < 8; ++h) { const f32x4 c = __builtin_amdgcn_mfma_f32_16x16x32_bf16(a, iq[h], (f32x4){0.f, 0.f, 0.f, 0.f}, 0, 0, 0);
#pragma unroll
                for (int j = 0; j < 4; ++j) acc[j] += wi[h] * fmaxf(c[j], 0.f); }
            const int col = (kt * 16 + kg * 4 + 4 * q) & 2047;
            *(LAS f32x4*)(sc + q * 2048 + col) = acc;
        }
    }
    __syncthreads();
#pragma unroll 1
    for (int rr = 0; rr < 2; ++rr) {
        const int q = 2 * wid + rr; const LAS float* row = sc + q * 2048;
        int n64l = n64; asm volatile("" : "+s"(n64l));
        unsigned u[32];
#pragma unroll
        for (int i = 0; i < 32; ++i) { const int e = i * 64 + lane; const unsigned bts = __float_as_uint(row[(e + 4 * q) & 2047]); const unsigned k = (bts & 0x80000000u) ? ~bts : (bts | 0x80000000u); u[i] = (i < n64l) ? k : 0u; }
        unsigned T = 0u;
#pragma unroll 1
        for (int bit = 31; bit >= 0; --bit) {
            const unsigned cand = T | (1u << bit); int cnt = 0;
#pragma unroll
            for (int g = 0; g < 4; ++g) if (n64l > 8 * g) {
#pragma unroll
                for (int i = 8 * g; i < 8 * g + 8; ++i) cnt += __popcll(__ballot(u[i] >= cand)); }
            if (cnt >= 256) T = cand;
        }
        int cgt = 0;
#pragma unroll
        for (int i = 0; i < 32; ++i) cgt += __popcll(__ballot(u[i] > T));
        const int need = 256 - cgt; int base = 0; unsigned T2 = T; asm volatile("" : "+s"(T2));
#pragma unroll
        for (int i = 0; i < 32; ++i) {
            const bool eq = (u[i] == T2), gt = (u[i] > T2); const unsigned long long em = __ballot(eq);
            const int rank = (int)__builtin_amdgcn_mbcnt_hi((unsigned)(em >> 32), __builtin_amdgcn_mbcnt_lo((unsigned)em, (unsigned)base));
            const unsigned long long w = __ballot(gt || (eq && rank < need)); base += __popcll(em);
            if (lane == 0) mrow[q * 32 + i] = w;
        }
    }
    __syncthreads();
}

__device__ __forceinline__ void a_unit(Frame& F, const Ptrs& P, int b, int h, int qb, float lam) {
    using namespace att; typedef Lds<128> L;
    const bf16_t* AQ = (const bf16_t*)(P.ws + WS_R1); const bf16_t* AK = (const bf16_t*)(P.ws + WS_R1 + 32 * MiB); const bf16_t* AV = (const bf16_t*)(P.ws + WS_R1 + 64 * MiB);
    int tid = threadIdx.x; asm volatile("" : "+v"(tid));
    const int lane = tid & 63, wid = __builtin_amdgcn_readfirstlane(tid >> 6), r32 = lane & 31; const size_t rowbase = (size_t)b * SEQ; const int q0 = qb * 256, qw = q0 + wid * 32, qc = qw >> 6;
    f32x4* stash = (f32x4*)(P.ws + WS_Y) + ((size_t)(blockIdx.x * NWAVES + wid) * 16) * 64 + lane;
    f32x16 o[4];
#pragma unroll 1
    for (int c = 0; c < 2; ++c) {
        const int g = 2 * h + c;
        attn_core<128, 0, 4>(o, F.lds, AQ + (rowbase + qw) * 512 + g * 64, 512, AK + rowbase * 512 + g * 64, 512, AV + rowbase * 512 + h * 128, 512, 0, (q0 >> 6) + 4, 0, qc + 1, nullptr, 0, 0);
        if (c == 0) {
            f32x4* sp = stash; asm volatile("" : "+v"(sp));
#pragma unroll
            for (int d0 = 0; d0 < 4; ++d0)
#pragma unroll
                for (int rq = 0; rq < 4; ++rq) sp[(d0 * 4 + rq) * 64] = (f32x4){o[d0][4 * rq], o[d0][4 * rq + 1], o[d0][4 * rq + 2], o[d0][4 * rq + 3]};
        }
    }
    {
        const f32x4* sp = stash; asm volatile("" : "+v"(sp));
#pragma unroll
        for (int d0 = 0; d0 < 4; ++d0)
#pragma unroll
            for (int rq = 0; rq < 4; ++rq) { const f32x4 a = sp[(d0 * 4 + rq) * 64];
#pragma unroll
                for (int j = 0; j < 4; ++j) o[d0][4 * rq + j] = a[j] - lam * o[d0][4 * rq + j]; }
    }
    float sl[4];
#pragma unroll
    for (int d0 = 0; d0 < 4; ++d0) sl[d0] = P.esub[32 * d0 + r32] * 0.8f;
#pragma unroll
    for (int r = 0; r < 16; ++r) { float s = 0.f;
#pragma unroll
        for (int d0 = 0; d0 < 4; ++d0) s += o[d0][r] * o[d0][r];
        s = sum32(s);
        const float rstd = 1.0f / sqrtf(s * (1.f / 128.f) + RMS_EPS);
#pragma unroll
        for (int d0 = 0; d0 < 4; ++d0) o[d0][r] *= rstd * sl[d0]; }
    store_o<128>(o, F.lds, (bf16_t*)(P.ws + WS_ATT) + (rowbase + qw) * DM + h * 128, DM);
}
__device__ __forceinline__ void b_unit(Frame& F, const Ptrs& P, int b, int h, int qb) {
    using namespace att;
    const bf16_t* BQ = (const bf16_t*)(P.ws + WS_R1 + 96 * MiB); const bf16_t* BK = (const bf16_t*)(P.ws + WS_R1 + 128 * MiB); const bf16_t* BV = (const bf16_t*)(P.ws + WS_R1 + 160 * MiB);
    int tid = threadIdx.x; asm volatile("" : "+v"(tid));
    const int lane = tid & 63, wid = __builtin_amdgcn_readfirstlane(tid >> 6), r32 = lane & 31; const size_t rowbase = (size_t)b * SEQ; const int q0 = qb * 256, qw = q0 + wid * 32, qc = qw >> 6;
    const unsigned long long* mrow = (const unsigned long long*)(P.ws + WS_MASK) + (rowbase + qw + r32) * 32;
    f32x16 o[2];
    attn_core<64, 1, 4>(o, F.lds, BQ + (rowbase + qw) * 512 + h * 64, 512, BK + rowbase * 512 + h * 64, 512, BV + rowbase * 512 + h * 64, 512, 0, (q0 >> 6) + 4, 0, qc + 1, mrow, 0, 0);
    store_o<64>(o, F.lds, (bf16_t*)(P.ws + WS_ATT) + (rowbase + qw) * DM + 512 + h * 64, DM);
}
__device__ __forceinline__ void c_unit(Frame& F, const Ptrs& P, int b, int h, int qb) {
    using namespace att; typedef Lds<64> L;
    const bf16_t* CQ = (const bf16_t*)(P.ws + WS_R1); const bf16_t* CK = (const bf16_t*)(P.ws + WS_R1 + 64 * MiB); const bf16_t* CV = (const bf16_t*)(P.ws + WS_R1 + 128 * MiB);
    int tid = threadIdx.x; asm volatile("" : "+v"(tid));
    const int lane = tid & 63, wid = __builtin_amdgcn_readfirstlane(tid >> 6), r32 = lane & 31; const size_t rowbase = (size_t)b * SEQ; const int q0 = qb * 256, qw = q0 + wid * 32, qc = qw >> 6;
    LAS float* bt = (LAS float*)(F.lds + L::OFF_BT);
    for (int i = tid; i < 320; i += NWAVES * 64) bt[i] = P.obias[h * 320 + i] * LOG2E;
    const int c0 = q0 >> 6, T0 = c0 - 8 > 0 ? c0 - 8 : 0, tw0 = qc - 8 > 0 ? qc - 8 : 0;
    f32x16 o[2];
    attn_core<64, 2, 4>(o, F.lds, CQ + (rowbase + qw) * DM + h * 64, DM, CK + rowbase * DM + h * 64, DM, CV + rowbase * DM + h * 64, DM, T0, c0 + 4, tw0, qc + 1, nullptr, qw + r32, qc);
    store_o<64>(o, F.lds, (bf16_t*)(P.ws + WS_ATT) + (rowbase + qw) * DM + h * 64, DM);
}

#ifndef DBG_NO_IDX
#define DBG_NO_IDX 0
#endif
#ifndef DBG_NO_A
#define DBG_NO_A 0
#endif
#ifndef DBG_NO_B
#define DBG_NO_B 0
#endif
#ifndef DBG_STAGES
#define DBG_STAGES 99
#endif
struct Args { const float* in[12]; float* out; unsigned char* ws; };
__global__ void __launch_bounds__(NWAVES * 64, 2) fwd_kernel(Args args) {
    extern __shared__ __attribute__((aligned(16))) unsigned char lds[];
    Frame F;
    F.lds = (LAS unsigned char*)lds; F.MISC = (volatile LAS unsigned*)(F.lds + MISC_OFF);
    F.tid = threadIdx.x; F.lane = F.tid & 63; F.wave = __builtin_amdgcn_readfirstlane(F.tid >> 6);
    F.G = gridDim.x; { const int bx = blockIdx.x; F.vcu = (F.G % 8 == 0) ? (bx % 8) * (F.G / 8) + bx / 8 : bx; }
    Ptrs P; P.x = args.in[0]; P.norm_g = args.in[1]; P.wg = args.in[2]; P.wu = args.in[3]; P.wd = args.in[4]; P.ewin = args.in[5]; P.ewout = args.in[6]; P.elam = args.in[7]; P.esub = args.in[8];
    P.owin = args.in[9]; P.owout = args.in[10]; P.obias = args.in[11]; P.out = args.out; P.ws = args.ws;
    F.ctl = (gu32*)(P.ws + WS_CTL);
    for (int u = F.tid; u < (LDS_BYTES - LDSCTL_OFF) / 4; u += NWAVES * 64) ((LAS unsigned*)(F.lds + LDSCTL_OFF))[u] = 0u;
    __syncthreads();
    XcdBarrier bar = xcd_barrier_post((unsigned*)(F.ctl + CW_BAR), F.MISC + 8);
#define GRID_BAR() xcd_barrier(bar)
    bf16* XB = (bf16*)(P.ws + WS_XB); const float* RS = (const float*)(P.ws + WS_RS); bf16* HID = (bf16*)(P.ws + WS_R1); bf16* Y = (bf16*)(P.ws + WS_Y); const bf16* ATT = (const bf16*)(P.ws + WS_ATT);

    p0_prologue(F, P); GRID_BAR();

#define FFN_PHASES(l, f, LAST_) do { \
        { pg8::Gemm g{XB, (const bf16*)(P.ws + WS_WGU + (2 * (l) + (f)) * WGU_BYTES), MROWS, NGU, DM}; pg8::StaticOrder S; S.init(MROWS, NGU, F.G, (int)blockIdx.x); \
          epi::EpiSwiGLU E{HID, RS}; for (int rep_ = 0; rep_ < PROBE_REP_GU; ++rep_) pg8::gemm_phase<epi::EpiSwiGLU, pg8::StaticOrder, true, true>(F.lds, g, S, E); \
          if (PROBE_NULL_GU) { epi::EpiNull EN; for (int rep_ = 0; rep_ < PROBE_NULL_GU; ++rep_) pg8::gemm_phase<epi::EpiNull, pg8::StaticOrder, true, true>(F.lds, g, S, EN); } } \
        GRID_BAR(); \
        { pg8::Gemm g{HID, (const bf16*)(P.ws + WS_WD + (2 * (l) + (f)) * WD_BYTES), MROWS, DM, FF}; pg8::StaticOrder S; S.init(MROWS, DM, F.G, (int)blockIdx.x); \
          epi::EpiBf16Y E{Y}; for (int rep_ = 0; rep_ < PROBE_REP_DN; ++rep_) pg8::gemm_phase<epi::EpiBf16Y, pg8::StaticOrder, true, true>(F.lds, g, S, E); \
          if (PROBE_NULL_DN) { epi::EpiNull EN; for (int rep_ = 0; rep_ < PROBE_NULL_DN; ++rep_) pg8::gemm_phase<epi::EpiNull, pg8::StaticOrder, true, true>(F.lds, g, S, EN); } } \
        GRID_BAR(); \
        thin_phase<LAST_>(F, P, P.norm_g + ((l) * 6 + 4 * (f) + 1) * DM, 0.5f); \
        if (!(LAST_)) GRID_BAR(); } while (0)

    FFN_PHASES(0, 0, false);
    if (DBG_STAGES >= 2) {
        { pg8::Gemm g{XB, (const bf16*)(P.ws + WS_WIN0), MROWS, NEV, DM}; pg8::StaticOrder S; S.init(MROWS, NEV, F.G, (int)blockIdx.x);
          unsigned char* r1 = P.ws + WS_R1;
          epi::EpiProjEven E{(bf16*)r1, (bf16*)(r1 + 192 * MiB), (bf16*)(r1 + 208 * MiB),
                             (float*)(r1 + 210 * MiB), RS, (const float*)(P.ws + WS_C64), (const float*)(P.ws + WS_S64), (const float*)(P.ws + WS_C32), (const float*)(P.ws + WS_S32)};
          pg8::gemm_phase<epi::EpiProjEven, pg8::StaticOrder, true, true>(F.lds, g, S, E); }
        GRID_BAR();
        for (int rep_ = 0; rep_ < PROBE_REP_IDXA; ++rep_)
        for (int p = F.vcu; p < 1024; p += F.G) { const int b = p >> 6, j = p & 63;
#pragma unroll 1
            for (int k = 0; k < 2; ++k) { if (!DBG_NO_IDX) indexer_unit(F, P, b, k ? 127 - j : j); } }
        {
            float l01 = 0.f, l23 = 0.f;
            for (int i = 0; i < 64; ++i) { l01 += P.elam[i] * P.elam[64 + i]; l23 += P.elam[128 + i] * P.elam[192 + i]; }
            const float lam = expf(l01) - expf(l23) + 0.2f;
            for (int rep_ = 0; rep_ < PROBE_REP_IDXA; ++rep_)
            for (int p = F.vcu; p < 256; p += F.G) { const int bh = p >> 2, s = p & 3;
#pragma unroll 1
                for (int k = 0; k < 2; ++k) { if (!DBG_NO_A) a_unit(F, P, bh >> 2, bh & 3, k ? 7 - s : s, lam); } }
        }
        GRID_BAR();
        for (int rep_ = 0; rep_ < PROBE_REP_B; ++rep_)
        for (int p = F.vcu; p < 512; p += F.G) { const int bh = p >> 2, s = p & 3;
#pragma unroll 1
            for (int k = 0; k < 2; ++k) { if (!DBG_NO_B) b_unit(F, P, bh >> 3, bh & 7, k ? 7 - s : s); } }
        GRID_BAR();
        { pg8::Gemm g{ATT, (const bf16*)(P.ws + WS_WOUT0), MROWS, DM, DM}; pg8::StaticOrder S; S.init(MROWS, DM, F.G, (int)blockIdx.x);
          epi::EpiBf16Y E{Y}; pg8::gemm_phase<epi::EpiBf16Y, pg8::StaticOrder, true, true>(F.lds, g, S, E); }
        GRID_BAR();
        thin_phase<false>(F, P, P.norm_g + (0 * 6 + 3) * DM, 1.0f);
        GRID_BAR();
    }
    if (DBG_STAGES >= 3) FFN_PHASES(0, 1, false);
    if (DBG_STAGES >= 4) FFN_PHASES(1, 0, false);
    if (DBG_STAGES >= 5) {
        { pg8::Gemm g{XB, (const bf16*)(P.ws + WS_WIN1), MROWS, NOD, DM}; pg8::StaticOrder S; S.init(MROWS, NOD, F.G, (int)blockIdx.x);
          unsigned char* r1 = P.ws + WS_R1; epi::EpiProjOdd E{(bf16*)r1, RS};
          pg8::gemm_phase<epi::EpiProjOdd, pg8::StaticOrder, true, true>(F.lds, g, S, E); }
        GRID_BAR();
        for (int rep_ = 0; rep_ < PROBE_REP_C; ++rep_)
        for (int p = F.vcu; p < 256; p += F.G) { const int b = p >> 4, h = p & 15;
#pragma unroll 1
            for (int qb = 0; qb < 8; ++qb) c_unit(F, P, b, h, qb); }
        GRID_BAR();
        { pg8::Gemm g{ATT, (const bf16*)(P.ws + WS_WOUT1), MROWS, DM, DM}; pg8::StaticOrder S; S.init(MROWS, DM, F.G, (int)blockIdx.x);
          epi::EpiBf16Y E{Y}; pg8::gemm_phase<epi::EpiBf16Y, pg8::StaticOrder, true, true>(F.lds, g, S, E); }
        GRID_BAR();
        thin_phase<false>(F, P, P.norm_g + (1 * 6 + 3) * DM, 1.0f);
        GRID_BAR();
    }
    if (DBG_STAGES >= 6) FFN_PHASES(1, 1, true);
}

extern "C" void kernel_launch(void* const* d_in, const int* in_sizes, int n_in, void* d_out, int out_size, void* d_ws, size_t ws_size, hipStream_t stream) {
    static int grid = 0;
    if (grid == 0) {
        if (n_in != 12 || in_sizes[0] != MROWS * DM || out_size != MROWS * DM || ws_size < WS_END) {
            fprintf(stderr, "kernel_launch: unexpected shapes / workspace (n_in %d, in0 %d, out %d, ws %zu, need %zu); nothing launched\n", n_in, n_in > 0 ? in_sizes[0] : -1, out_size, ws_size, (size_t)WS_END); grid = -1; return; }
        int dev = 0, cus = 0, per_cu = 0;
        if (hipGetDevice(&dev) != hipSuccess || hipDeviceGetAttribute(&cus, hipDeviceAttributeMultiprocessorCount, dev) != hipSuccess) { fprintf(stderr, "kernel_launch: device query failed\n"); grid = -1; return; }
        if (hipFuncSetAttribute((const void*)fwd_kernel, hipFuncAttributeMaxDynamicSharedMemorySize, LDS_BYTES) != hipSuccess) { fprintf(stderr, "kernel_launch: hipFuncSetAttribute failed\n"); grid = -1; return; }
        if (hipOccupancyMaxActiveBlocksPerMultiprocessor(&per_cu, (const void*)fwd_kernel, NWAVES * 64, LDS_BYTES) != hipSuccess || per_cu < 1)
            fprintf(stderr, "kernel_launch: note: occupancy query reports %d workgroups per CU\n", per_cu);
        (void)hipGetLastError();
        grid = cus;
    }
    if (grid < 0) return;
    if (hipMemsetAsync((char*)d_ws + WS_CTL, 0, CTL_ZERO_BYTES, stream) != hipSuccess) { fprintf(stderr, "kernel_launch: memset failed\n"); return; }
    Args a{};
    for (int i = 0; i < 12; ++i) a.in[i] = (const float*)d_in[i];
    a.out = (float*)d_out; a.ws = (unsigned char*)d_ws;
    hipLaunchKernelGGL(fwd_kernel, dim3(grid), dim3(NWAVES * 64), LDS_BYTES, stream, a);
    const hipError_t le = hipPeekAtLastError();
    if (le != hipSuccess) fprintf(stderr, "kernel_launch: launch failed: %s\n", hipGetErrorName(le));
}
```

```cpp
#include <hip/hip_runtime.h>
#include <cstdio>
#include <cstdint>
namespace pg8 {
#define PG8_LAS __attribute__((address_space(3)))
typedef unsigned short bf16_t;
typedef short bf16x8 __attribute__((ext_vector_type(8)));
typedef float f32x4 __attribute__((ext_vector_type(4)));
typedef unsigned u32x4 __attribute__((ext_vector_type(4)));
constexpr int BM = 256, BK = 64, HALF = 128, HTB = HALF * BK * 2  , STAGE_BYTES = 8 * HTB, NXCD = 8, WGM = 8;

__host__ __device__ __forceinline__ int lds_byte(int r, int c) { const int st = (r >> 4) * 2 + (c >> 5), rr = r & 15, cc = c & 31, ob = rr * 64 + cc * 2; return st * 1024 + (ob ^ (((ob >> 9) & 1) << 5)); }
__host__ __device__ __forceinline__ void stage_rc(int b, int& R, int& C) { const int st = b / 1024, sb = b % 1024, swz = sb ^ (((sb >> 9) & 1) << 5); R = (st >> 1) * 16 + swz / 64; C = (st & 1) * 32 + (swz % 64) / 2; }
__host__ __device__ __forceinline__ int perm32(int rho) { const int n = rho >> 4, i = rho & 15; return 8 * (i >> 2) + 4 * n + (i & 3); }

struct Unit { int pm, pn; };
struct Gemm { const bf16_t* A; const bf16_t* Bt; int M, N, K; };

struct StaticOrder {
    int nM, nN, nwg, G, c;
    __host__ __device__ void init(int M, int N, int G_, int c_) { nM = M / BM; nN = N / BM; nwg = nM * nN; G = G_; c = c_; }
    __host__ __device__ bool next(int i, Unit& u) const {
        const long L = (long)i * G + c; if (L >= nwg) return false;
        int wgid = (int)L; { const int q = nwg / NXCD, r = nwg % NXCD, xcd = wgid % NXCD, off = wgid / NXCD; wgid = (xcd < r ? xcd * (q + 1) : r * (q + 1) + (xcd - r) * q) + off; }
        const int nig = WGM * nN, gid = wgid / nig, fm = gid * WGM, gsz = (nM - fm) < WGM ? (nM - fm) : WGM;
        u.pm = fm + ((wgid % nig) % gsz); u.pn = (wgid % nig) / gsz; return true;
    }
    __device__ __forceinline__ void a_ready(const Unit&) const {}
    __device__ __forceinline__ void done(const Unit&) const {}
};

__device__ __forceinline__ unsigned cvt_pk_bf16(float lo, float hi) { unsigned r; asm volatile("v_cvt_pk_bf16_f32 %0, %1, %2" : "=v"(r) : "v"(lo), "v"(hi)); return r; }
typedef float f32x2 __attribute__((ext_vector_type(2)));
__device__ __forceinline__ f32x2 gelu_pk(f32x2 v) {
    const f32x2 av = __builtin_elementwise_abs(v), d = av * 0.2316418882f + 1.0f;
    f32x2 t; t.x = __builtin_amdgcn_rcpf(d.x); t.y = __builtin_amdgcn_rcpf(d.y);
    f32x2 q = t * 0.5307027145f + (-0.7265760135f); q = q * t + 0.7107068705f; q = q * t + (-0.142248368f); q = q * t + 0.127414796f; q = q * t;
    const f32x2 s = (v * v) * (-0.72134752044f);
    f32x2 e; e.x = __builtin_amdgcn_exp2f(s.x); e.y = __builtin_amdgcn_exp2f(s.y);
    const f32x2 m = v * (q * e), r = v - m;
    f32x2 o; o.x = v.x < 0.f ? m.x : r.x; o.y = v.y < 0.f ? m.y : r.y; return o;
}

template <int ACT  > struct EpiBf16 {
    static constexpr bool PERM = true, AFTER_DRAIN = false; static_assert(ACT == 0 || ACT == 1, "EpiBf16: ACT is 0 (none) or 1 (gelu_pk)");
    bf16_t* O; int ldc; const float* bias; int split_cols; size_t split_stride; float scale0;
    __device__ __forceinline__ void operator()(const f32x4 (&acc)[2][2][4][2], const Unit& u, int wr, int wc, int fr, int fq) const {
        const int row0 = u.pm * BM + wr * 64 + fr; int colt = u.pn * BM; bf16_t* base = O;
        float sc = 1.f; if (split_cols) { const int t = colt / split_cols; base += (size_t)t * split_stride; colt -= t * split_cols; if (t == 0) sc = scale0; }
        const int col0 = colt + wc * 32 + 8 * fq, bcol0 = u.pn * BM + wc * 32 + 8 * fq;
        f32x4 bv[2][2];
#pragma unroll
        for (int bj = 0; bj < 2; ++bj)
#pragma unroll
            for (int n = 0; n < 2; ++n) bv[bj][n] = bias ? *(const f32x4*)(bias + bcol0 + bj * HALF + 4 * n) : (f32x4){0.f, 0.f, 0.f, 0.f};
#pragma unroll
        for (int ai = 0; ai < 2; ++ai)
#pragma unroll
            for (int m = 0; m < 4; ++m) { bf16_t* rowp = base + (size_t)(row0 + ai * HALF + m * 16) * ldc + col0;
#pragma unroll
                for (int bj = 0; bj < 2; ++bj) { f32x4 v0 = acc[ai][bj][m][0] + bv[bj][0], v1 = acc[ai][bj][m][1] + bv[bj][1];
                    if (ACT == 1) { f32x2 a = gelu_pk((f32x2){v0[0], v0[1]}), b = gelu_pk((f32x2){v0[2], v0[3]}), c = gelu_pk((f32x2){v1[0], v1[1]}), d = gelu_pk((f32x2){v1[2], v1[3]});
                        v0 = (f32x4){a.x, a.y, b.x, b.y}; v1 = (f32x4){c.x, c.y, d.x, d.y}; }
                    v0 = v0 * sc; v1 = v1 * sc; u32x4 w; w.x = cvt_pk_bf16(v0[0], v0[1]); w.y = cvt_pk_bf16(v0[2], v0[3]); w.z = cvt_pk_bf16(v1[0], v1[1]); w.w = cvt_pk_bf16(v1[2], v1[3]);
                    *(u32x4*)(rowp + bj * HALF) = w; } }
    }
};

struct PanelStats {
    unsigned* xbuf;
    unsigned* cnt;
    unsigned* tmo;
    int ntn; float eps;
    unsigned code;
    __device__ __forceinline__ bool run(const f32x4 (&v)[2][2][4][2], const Unit& u, int wr, int wc, int fr, int fq, PG8_LAS unsigned char* lds, int wid, int lane) const {
        typedef float f32x2v __attribute__((ext_vector_type(2)));
        PG8_LAS f32x2v* P = (PG8_LAS f32x2v*)lds;
        PG8_LAS f32x2v* S = (PG8_LAS f32x2v*)(lds + 8192);
        PG8_LAS unsigned* flag = (PG8_LAS unsigned*)(lds + 8192 + 2048);
#pragma unroll
        for (int ai = 0; ai < 2; ++ai)
#pragma unroll
            for (int m = 0; m < 4; ++m) {
                float s = 0.f;
#pragma unroll
                for (int bj = 0; bj < 2; ++bj)
#pragma unroll
                    for (int n = 0; n < 2; ++n) { const f32x4 x = v[ai][bj][m][n]; s += (x[0] + x[1]) + (x[2] + x[3]); }
                s += __shfl_xor(s, 16); s += __shfl_xor(s, 32);
                const float mw = s * (1.0f / 64.0f); float q = 0.f;
#pragma unroll
                for (int bj = 0; bj < 2; ++bj)
#pragma unroll
                    for (int n = 0; n < 2; ++n) { const f32x4 d = v[ai][bj][m][n] - mw; q += (d[0] * d[0] + d[1] * d[1]) + (d[2] * d[2] + d[3] * d[3]); }
                q += __shfl_xor(q, 16); q += __shfl_xor(q, 32);
                if (fq == 0) P[(ai * HALF + wr * 64 + m * 16 + fr) * 4 + wc] = (f32x2v){mw, q};
            }
        asm volatile("s_waitcnt lgkmcnt(0)" ::: "memory"); __builtin_amdgcn_s_barrier(); asm volatile("" ::: "memory");
#if defined(BROKEN_EXCHANGE_NO_WAIT)
#warning BROKEN CONTROL BUILD: the row-statistics exchange does not wait; results are wrong by design
        if (blockIdx.x >= 64) { const long long t0_ = clock64(); while (clock64() - t0_ < 60000) __builtin_amdgcn_s_sleep(8); }
#endif
        const int row = wid * 32 + (lane & 31);
        if (lane < 32) {
            const f32x2v a = P[row * 4 + 0], b = P[row * 4 + 1], c = P[row * 4 + 2], d = P[row * 4 + 3];
            const float mt = (a.x + b.x + c.x + d.x) * 0.25f;
            const float da = a.x - mt, db = b.x - mt, dc = c.x - mt, dd = d.x - mt;
            const float m2 = (a.y + b.y) + (c.y + d.y) + 64.0f * ((da * da + db * db) + (dc * dc + dd * dd));
            unsigned long long* slot = (unsigned long long*)xbuf + ((size_t)(u.pm * BM + row) * 4 + u.pn);
            __hip_atomic_store(slot, ((unsigned long long)__float_as_uint(m2) << 32) | __float_as_uint(mt), __ATOMIC_RELAXED, __HIP_MEMORY_SCOPE_AGENT);
        }
        asm volatile("s_waitcnt vmcnt(0)" ::: "memory");
        if (lane == 0) __hip_atomic_fetch_add(cnt + 64 * u.pm, 1u, __ATOMIC_RELAXED, __HIP_MEMORY_SCOPE_AGENT);
        if (wid == 0) {
            bool dead = false; const unsigned long long t0 = __builtin_amdgcn_s_memrealtime(); const unsigned want = 8u * (unsigned)ntn;
            for (;;) {
#if defined(BROKEN_EXCHANGE_NO_WAIT)
                break;
#endif
                if ((unsigned)__builtin_amdgcn_readfirstlane(__hip_atomic_load(cnt + 64 * u.pm, __ATOMIC_RELAXED, __HIP_MEMORY_SCOPE_AGENT)) >= want) break;
                if (__builtin_amdgcn_s_memrealtime() - t0 > 2000000ull) {
                    if (lane == 0) { unsigned expect = 0u; __hip_atomic_compare_exchange_strong(tmo + 1, &expect, code | (unsigned)(u.pm & 0xff), __ATOMIC_RELAXED, __ATOMIC_RELAXED, __HIP_MEMORY_SCOPE_AGENT);
                                     __hip_atomic_store(tmo, 1u, __ATOMIC_RELAXED, __HIP_MEMORY_SCOPE_AGENT); }
                    dead = true; break; }
                __builtin_amdgcn_s_sleep(2);
            }
            __builtin_amdgcn_fence(__ATOMIC_ACQUIRE, "agent");
            if (lane == 0) flag[0] = dead ? 1u : 0u;
        }
        asm volatile("s_waitcnt vmcnt(0) lgkmcnt(0)" ::: "memory"); __builtin_amdgcn_s_barrier(); asm volatile("" ::: "memory");
        const bool bad = flag[0] != 0u;
        if (lane < 32) {
            const unsigned long long* slot = (const unsigned long long*)xbuf + (size_t)(u.pm * BM + row) * 4; float mt[4], m2[4]; float ms = 0.f;
#pragma unroll
            for (int t = 0; t < 4; ++t) { if (t < ntn) { const unsigned long long w = __hip_atomic_load(slot + t, __ATOMIC_RELAXED, __HIP_MEMORY_SCOPE_AGENT); mt[t] = __uint_as_float((unsigned)w); m2[t] = __uint_as_float((unsigned)(w >> 32)); } else { mt[t] = 0.f; m2[t] = 0.f; } ms += mt[t]; }
            const float mean = ms / (float)ntn; float q = 0.f;
#pragma unroll
            for (int t = 0; t < 4; ++t) if (t < ntn) { const float dm = mt[t] - mean; q += m2[t] + 256.0f * dm * dm; }
            S[row] = (f32x2v){mean, 1.0f / sqrtf(q / (256.0f * (float)ntn) + eps)};
        }
        asm volatile("s_waitcnt lgkmcnt(0)" ::: "memory"); __builtin_amdgcn_s_barrier(); asm volatile("" ::: "memory");
        return bad;
    }
};
struct EpiLnRes {
    static constexpr bool PERM = false, AFTER_DRAIN = true;
    const float* base; float* out; int ldc; const float* bias; PanelStats st; unsigned poison;
    __device__ __forceinline__ void fused(f32x4 (&acc)[2][2][4][2], const Unit& u, int wr, int wc, int fr, int fq, PG8_LAS unsigned char* lds, int wid, int lane) const {
        typedef float f32x2v __attribute__((ext_vector_type(2)));
        const PG8_LAS f32x2v* S = (const PG8_LAS f32x2v*)(lds + 8192);
        const int col0 = u.pn * BM + wc * 32 + 4 * fq;
#pragma unroll
        for (int bj = 0; bj < 2; ++bj)
#pragma unroll
            for (int n = 0; n < 2; ++n) { const f32x4 bv = bias ? *(const f32x4*)(bias + col0 + bj * HALF + n * 16) : (f32x4){0.f, 0.f, 0.f, 0.f};
#pragma unroll
                for (int ai = 0; ai < 2; ++ai)
#pragma unroll
                    for (int m = 0; m < 4; ++m) acc[ai][bj][m][n] += bv; }
        f32x4 pre[4][2][2];
#pragma unroll
        for (int m = 0; m < 4; ++m) { const size_t off = (size_t)(u.pm * BM + wr * 64 + m * 16 + fr) * ldc + col0;
#pragma unroll
            for (int bj = 0; bj < 2; ++bj)
#pragma unroll
                for (int n = 0; n < 2; ++n) pre[m][bj][n] = *(const f32x4*)(base + off + bj * HALF + n * 16); }
        const bool bad = st.run(acc, u, wr, wc, fr, fq, lds, wid, lane) || poison != 0u;
        const float qnan = __builtin_nanf("");
#pragma unroll
        for (int ai = 0; ai < 2; ++ai)
#pragma unroll
            for (int m = 0; m < 4; ++m) { const int r = ai * HALF + wr * 64 + m * 16 + fr; const f32x2v sr = S[r]; const size_t off = (size_t)(u.pm * BM + r) * ldc + col0;
#pragma unroll
                for (int bj = 0; bj < 2; ++bj)
#pragma unroll
                    for (int n = 0; n < 2; ++n) { const f32x4 bs = ai == 0 ? pre[m][bj][n] : *(const f32x4*)(base + off + bj * HALF + n * 16); f32x4 o = bs + (acc[ai][bj][m][n] - sr.x) * sr.y;
                        if (bad) o = (f32x4){qnan, qnan, qnan, qnan}; *(f32x4*)(out + off + bj * HALF + n * 16) = o; }
                if (m & 1) asm volatile("" ::: "memory"); }
    }
};
struct EpiLnResLn {
    static constexpr bool PERM = false, AFTER_DRAIN = true;
    const float* base; float* out; bf16_t* xn; int ldc; const float* bias; PanelStats st1, st2; unsigned poison;
    __device__ __forceinline__ void fused(f32x4 (&acc)[2][2][4][2], const Unit& u, int wr, int wc, int fr, int fq, PG8_LAS unsigned char* lds, int wid, int lane) const {
        typedef float f32x2v __attribute__((ext_vector_type(2))); typedef unsigned u32x2v __attribute__((ext_vector_type(2)));
        const PG8_LAS f32x2v* S = (const PG8_LAS f32x2v*)(lds + 8192);
        const int col0 = u.pn * BM + wc * 32 + 4 * fq;
#pragma unroll
        for (int bj = 0; bj < 2; ++bj)
#pragma unroll
            for (int n = 0; n < 2; ++n) { const f32x4 bv = bias ? *(const f32x4*)(bias + col0 + bj * HALF + n * 16) : (f32x4){0.f, 0.f, 0.f, 0.f};
#pragma unroll
                for (int ai = 0; ai < 2; ++ai)
#pragma unroll
                    for (int m = 0; m < 4; ++m) acc[ai][bj][m][n] += bv; }
        bool bad = st1.run(acc, u, wr, wc, fr, fq, lds, wid, lane) || poison != 0u;
        const float qnan = __builtin_nanf("");
#pragma unroll
        for (int ai = 0; ai < 2; ++ai)
#pragma unroll
            for (int m = 0; m < 4; ++m) { const int r = ai * HALF + wr * 64 + m * 16 + fr; const f32x2v sr = S[r]; const size_t off = (size_t)(u.pm * BM + r) * ldc + col0;
#pragma unroll
                for (int bj = 0; bj < 2; ++bj)
#pragma unroll
                    for (int n = 0; n < 2; ++n) { const f32x4 bs = *(const f32x4*)(base + off + bj * HALF + n * 16); acc[ai][bj][m][n] = bs + (acc[ai][bj][m][n] - sr.x) * sr.y; }
                asm volatile("" : "+v"(acc[ai][0][m][0]), "+v"(acc[ai][0][m][1]), "+v"(acc[ai][1][m][0]), "+v"(acc[ai][1][m][1]));
                if (m & 1) asm volatile("" ::: "memory"); }
        const bool bad1 = bad;
        bad = st2.run(acc, u, wr, wc, fr, fq, lds, wid, lane) || bad;
#pragma unroll
        for (int ai = 0; ai < 2; ++ai)
#pragma unroll
            for (int m = 0; m < 4; ++m) { const int r = ai * HALF + wr * 64 + m * 16 + fr; const f32x2v sr = S[r]; const size_t off = (size_t)(u.pm * BM + r) * ldc + col0;
#pragma unroll
                for (int bj = 0; bj < 2; ++bj)
#pragma unroll
                    for (int n = 0; n < 2; ++n) { const f32x4 x1 = acc[ai][bj][m][n]; *(f32x4*)(out + off + bj * HALF + n * 16) = bad1 ? (f32x4){qnan, qnan, qnan, qnan} : x1;
                        const f32x4 o = (x1 - sr.x) * sr.y; u32x2v w; w.x = cvt_pk_bf16(o[0], o[1]); w.y = cvt_pk_bf16(o[2], o[3]);
                        if (bad) { w.x = 0x7fc07fc0u; w.y = 0x7fc07fc0u; } *(u32x2v*)(xn + off + bj * HALF + n * 16) = w; }
                asm volatile("" ::: "memory"); }
    }
};

template <class Epi, class Sched, bool ALIGN_EPI = false, bool SP2 = false>
__device__ __forceinline__ void gemm_phase(PG8_LAS unsigned char* lds, const Gemm g, const Sched& S, const Epi& E) {
    int tid_ = threadIdx.x; asm volatile("" : "+v"(tid_));
    const int tid = tid_, wid = __builtin_amdgcn_readfirstlane(tid >> 6), lane = tid & 63, wr = wid >> 2, wc = wid & 3, fr = lane & 15, fq = lane >> 4;
    const int K = g.K, nt = K / BK;
    unsigned voffA[2], voffB[2];
#pragma unroll
    for (int i = 0; i < 2; ++i) { int R, C; stage_rc(tid * 16 + i * 8192, R, C); const int Rb = Epi::PERM ? ((R & ~31) + perm32(R & 31)) : R;
        voffA[i] = (unsigned)(R * K + C) * 2u; voffB[i] = (unsigned)(Rb * K + C) * 2u; }
    const size_t kstep = (size_t)(BK * 2);
    const size_t hstep = (size_t)HALF * K * 2;
    const size_t tstep = 2 * hstep;
    const unsigned ldsw = (unsigned)wid * 1024u;
    const int aoff = lds_byte(wr * 64 + fr, fq * 8), boff = lds_byte(wc * 32 + fr, fq * 8);
#define PG8_SA(b, h) (((b) * 2 + (h)) * HTB)
#define PG8_SB(b, h) ((4 + (b) * 2 + (h)) * HTB)
#define PG8_STAGE(bufoff, gbase, voff) do { _Pragma("unroll") for (int _i = 0; _i < 2; ++_i) \
        __builtin_amdgcn_global_load_lds((const unsigned*)((const char*)(gbase) + (voff)[_i]), (PG8_LAS unsigned*)(lds + (bufoff) + ldsw + _i * 8192), 16, 0, 0); } while (0)
#define PG8_LDA(dst, b, h) do { _Pragma("unroll") for (int m = 0; m < 4; ++m) _Pragma("unroll") for (int k = 0; k < 2; ++k) dst[m][k] = *(const PG8_LAS bf16x8*)(lds + PG8_SA(b, h) + aoff + m * 2048 + k * 1024); } while (0)
#define PG8_LDB(dst, b, h) do { _Pragma("unroll") for (int n = 0; n < 2; ++n) _Pragma("unroll") for (int k = 0; k < 2; ++k) dst[n][k] = *(const PG8_LAS bf16x8*)(lds + PG8_SB(b, h) + boff + n * 2048 + k * 1024); } while (0)
#define PG8_MMA(ai, bj, At, Bt) do { __builtin_amdgcn_s_setprio(1); _Pragma("unroll") for (int m = 0; m < 4; ++m) _Pragma("unroll") for (int n = 0; n < 2; ++n) _Pragma("unroll") for (int k = 0; k < 2; ++k) \
        acc[ai][bj][m][n] = __builtin_amdgcn_mfma_f32_16x16x32_bf16(Bt[n][k], At[m][k], acc[ai][bj][m][n], 0, 0, 0); __builtin_amdgcn_s_setprio(0); } while (0)
#define PG8_WAIT_V(n) asm volatile("s_waitcnt vmcnt(" #n ")" ::: "memory")
#define PG8_WAIT_L(n) asm volatile("s_waitcnt lgkmcnt(" #n ")" ::: "memory")
#define PG8_BAR __builtin_amdgcn_s_barrier()
#define PG8_SCHED __builtin_amdgcn_sched_barrier(0)
    Unit cur, nxt; int ui = 0;
    if (!S.next(0, cur)) return;
    f32x4 acc[2][2][4][2];
#pragma unroll
    for (int a = 0; a < 2; ++a)
#pragma unroll
        for (int b = 0; b < 2; ++b)
#pragma unroll
            for (int m = 0; m < 4; ++m)
#pragma unroll
                for (int n = 0; n < 2; ++n) acc[a][b][m][n] = (f32x4){0.f, 0.f, 0.f, 0.f};
    bf16x8 At[4][2], B0[2][2], B1[2][2];
    const char* cA = (const char*)g.A + (size_t)cur.pm * tstep; const char* cB = (const char*)g.Bt + (size_t)cur.pn * tstep;
    S.a_ready(cur);
    if constexpr (SP2) {
        PG8_STAGE(PG8_SB(0, 0), cB, voffB); PG8_STAGE(PG8_SB(0, 1), cB + hstep, voffB); PG8_STAGE(PG8_SA(0, 0), cA, voffA); PG8_STAGE(PG8_SA(0, 1), cA + hstep, voffA);
        if (wr == 1) PG8_BAR;
        PG8_WAIT_V(2); PG8_BAR;
        PG8_STAGE(PG8_SB(1, 0), cB + kstep, voffB); PG8_STAGE(PG8_SA(1, 0), cA + kstep, voffA); PG8_STAGE(PG8_SB(1, 1), cB + hstep + kstep, voffB);
        PG8_WAIT_V(6); PG8_BAR;
    } else {
        PG8_STAGE(PG8_SB(0, 0), cB, voffB); PG8_STAGE(PG8_SA(0, 0), cA, voffA); PG8_STAGE(PG8_SB(0, 1), cB + hstep, voffB); PG8_STAGE(PG8_SA(0, 1), cA + hstep, voffA);
        if (wr == 1) PG8_BAR;
        PG8_WAIT_V(4); PG8_BAR;
        PG8_STAGE(PG8_SB(1, 0), cB + kstep, voffB); PG8_STAGE(PG8_SA(1, 0), cA + kstep, voffA); PG8_STAGE(PG8_SB(1, 1), cB + hstep + kstep, voffB);
        PG8_WAIT_V(6); PG8_BAR;
    }
    for (;;) {
        const bool has_next = S.next(ui + 1, nxt);
        const char* nA = has_next ? (const char*)g.A + (size_t)nxt.pm * tstep : cA; const char* nB = has_next ? (const char*)g.Bt + (size_t)nxt.pn * tstep : cB;
        for (int t = 0; t < nt; t += 2) {
            const bool last = (t == nt - 2);
            const char* a1 = cA + (size_t)(t + 1) * kstep;
            const char* a2 = last ? nA : cA + (size_t)(t + 2) * kstep; const char* b2 = last ? nB : cB + (size_t)(t + 2) * kstep;
            const char* a3 = a2 + kstep; const char* b3 = b2 + kstep;
            if (last && has_next) S.a_ready(nxt);
            if constexpr (SP2) {
            PG8_LDB(B0, 0, 0); PG8_LDB(B1, 0, 1); PG8_SCHED; PG8_LDA(At, 0, 0); PG8_STAGE(PG8_SA(1, 1), a1 + hstep, voffA);
            PG8_WAIT_V(8); PG8_WAIT_L(0); PG8_BAR; PG8_MMA(0, 0, At, B0); PG8_MMA(0, 1, At, B1); PG8_BAR; PG8_SCHED;
            PG8_LDA(At, 0, 1); PG8_STAGE(PG8_SB(0, 0), b2, voffB); PG8_STAGE(PG8_SB(0, 1), b2 + hstep, voffB); PG8_STAGE(PG8_SA(0, 0), a2, voffA);
            PG8_WAIT_V(8); PG8_WAIT_L(0); PG8_BAR; PG8_MMA(1, 0, At, B0); PG8_MMA(1, 1, At, B1); PG8_BAR; PG8_SCHED;
            PG8_LDB(B0, 1, 0); PG8_LDB(B1, 1, 1); PG8_SCHED; PG8_LDA(At, 1, 0); PG8_STAGE(PG8_SA(0, 1), a2 + hstep, voffA);
            PG8_WAIT_V(8); PG8_WAIT_L(0); PG8_BAR; PG8_MMA(0, 0, At, B0); PG8_MMA(0, 1, At, B1); PG8_BAR; PG8_SCHED;
            PG8_LDA(At, 1, 1); PG8_STAGE(PG8_SB(1, 0), b3, voffB); PG8_STAGE(PG8_SB(1, 1), b3 + hstep, voffB); PG8_STAGE(PG8_SA(1, 0), a3, voffA);
            PG8_WAIT_V(8); PG8_WAIT_L(0); PG8_BAR; PG8_MMA(1, 0, At, B0); PG8_MMA(1, 1, At, B1); PG8_BAR; PG8_SCHED;
            } else {
            PG8_LDB(B0, 0, 0); PG8_SCHED; PG8_LDA(At, 0, 0); PG8_STAGE(PG8_SA(1, 1), a1 + hstep, voffA);
            PG8_WAIT_L(8); PG8_BAR; PG8_WAIT_L(0); PG8_MMA(0, 0, At, B0); PG8_BAR; PG8_SCHED;
            PG8_LDB(B1, 0, 1); PG8_STAGE(PG8_SB(0, 0), b2, voffB);
            PG8_BAR; PG8_WAIT_L(0); PG8_MMA(0, 1, At, B1); PG8_BAR;
            PG8_LDA(At, 0, 1); PG8_STAGE(PG8_SA(0, 0), a2, voffA);
            PG8_BAR; PG8_WAIT_L(0); PG8_MMA(1, 0, At, B0); PG8_BAR; PG8_SCHED;
            PG8_STAGE(PG8_SB(0, 1), b2 + hstep, voffB);
            PG8_WAIT_V(6); PG8_BAR; PG8_MMA(1, 1, At, B1); PG8_BAR;
            PG8_LDB(B0, 1, 0); PG8_SCHED; PG8_LDA(At, 1, 0); PG8_STAGE(PG8_SA(0, 1), a2 + hstep, voffA);
            PG8_WAIT_L(8); PG8_BAR; PG8_WAIT_L(0); PG8_MMA(0, 0, At, B0); PG8_BAR; PG8_SCHED;
            PG8_LDB(B1, 1, 1); PG8_STAGE(PG8_SB(1, 0), b3, voffB);
            PG8_BAR; PG8_WAIT_L(0); PG8_MMA(0, 1, At, B1); PG8_BAR;
            PG8_LDA(At, 1, 1); PG8_STAGE(PG8_SA(1, 0), a3, voffA);
            PG8_BAR; PG8_WAIT_L(0); PG8_MMA(1, 0, At, B0); PG8_BAR; PG8_SCHED;
            PG8_STAGE(PG8_SB(1, 1), b3 + hstep, voffB);
            PG8_WAIT_V(6); PG8_BAR; PG8_MMA(1, 1, At, B1); PG8_BAR;
            }
        }
        if constexpr (ALIGN_EPI) { if (wr == 0) PG8_BAR; }
        if constexpr (!Epi::AFTER_DRAIN) { E(acc, cur, wr, wc, fr, fq); S.done(cur); }
        if (!has_next) break;
#pragma unroll
        for (int a = 0; a < 2; ++a)
#pragma unroll
            for (int b = 0; b < 2; ++b)
#pragma unroll
                for (int m = 0; m < 4; ++m)
#pragma unroll
                    for (int n = 0; n < 2; ++n) acc[a][b][m][n] = (f32x4){0.f, 0.f, 0.f, 0.f};
        cur = nxt; cA = nA; cB = nB; ++ui;
        if constexpr (ALIGN_EPI) { if (wr == 1) PG8_BAR; }
    }
    PG8_WAIT_V(0);
    if constexpr (!ALIGN_EPI) { if (wr == 0) PG8_BAR; }
    PG8_BAR;
    if constexpr (Epi::AFTER_DRAIN) { E.fused(acc, cur, wr, wc, fr, fq, lds, wid, lane); S.done(cur); }
#undef PG8_SA
#undef PG8_SB
#undef PG8_STAGE
#undef PG8_LDA
#undef PG8_LDB
#undef PG8_MMA
#undef PG8_WAIT_V
#undef PG8_WAIT_L
#undef PG8_BAR
#undef PG8_SCHED
}
}

constexpr int NB = 16, SEQ = 2048, DM = 1024, FF = 2816, MROWS = NB * SEQ;
constexpr int NGU = 2 * FF;
constexpr int NEV = 3584;
constexpr int NOD = 3072;
constexpr float RMS_EPS = 1e-6f;
constexpr float LOG2E = 1.4426950408889634f;
constexpr float QSCALE = 0.125f * LOG2E;

namespace epi {
using namespace pg8;
__device__ __forceinline__ unsigned pkbf(float lo, float hi) {
    typedef float f2_t __attribute__((ext_vector_type(2))); typedef __bf16 b2_t __attribute__((ext_vector_type(2)));
    f2_t v = {lo, hi}; b2_t b = __builtin_convertvector(v, b2_t); return __builtin_bit_cast(unsigned, b); }
__device__ __forceinline__ u32x4 pk8(const f32x4& a, const f32x4& b) { u32x4 w; w.x = pkbf(a[0], a[1]); w.y = pkbf(a[2], a[3]); w.z = pkbf(b[0], b[1]); w.w = pkbf(b[2], b[3]); return w; }

struct EpiSwiGLU {
    static constexpr bool PERM = true, AFTER_DRAIN = false;
    bf16_t* H; const float* rs;
    __device__ __forceinline__ void operator()(const f32x4 (&acc)[2][2][4][2], const Unit& u, int wr, int wc, int fr, int fq) const {
        const int row0 = u.pm * BM + wr * 64 + fr, col0 = u.pn * 128 + wc * 32 + 8 * fq;
#pragma unroll
        for (int ai = 0; ai < 2; ++ai)
#pragma unroll
            for (int m = 0; m < 4; ++m) {
                const int row = row0 + ai * HALF + m * 16; const float s = rs[row];
                f32x4 h[2];
#pragma unroll
                for (int n = 0; n < 2; ++n)
#pragma unroll
                    for (int j = 0; j < 4; ++j) { const float g = acc[ai][0][m][n][j] * s, uu = acc[ai][1][m][n][j] * s;
                        const float e = __builtin_amdgcn_exp2f(-LOG2E * g); h[n][j] = (g * uu) * __builtin_amdgcn_rcpf(1.0f + e); }
                *(u32x4*)(H + (size_t)row * FF + col0) = pk8(h[0], h[1]);
            }
    }
};
struct EpiNull {
    static constexpr bool PERM = true, AFTER_DRAIN = false;
    __device__ __forceinline__ void operator()(const f32x4 (&acc)[2][2][4][2], const Unit& u, int wr, int wc, int fr, int fq) const {
#pragma unroll
        for (int ai = 0; ai < 2; ++ai)
#pragma unroll
            for (int bj = 0; bj < 2; ++bj)
#pragma unroll
                for (int m = 0; m < 4; ++m)
#pragma unroll
                    for (int n = 0; n < 2; ++n) asm volatile("" :: "v"(acc[ai][bj][m][n]));
    }
};
struct EpiBf16Y {
    static constexpr bool PERM = true, AFTER_DRAIN = false;
    bf16_t* Y;
    __device__ __forceinline__ void operator()(const f32x4 (&acc)[2][2][4][2], const Unit& u, int wr, int wc, int fr, int fq) const {
        const int row0 = u.pm * BM + wr * 64 + fr, col0 = u.pn * BM + wc * 32 + 8 * fq;
#pragma unroll
        for (int ai = 0; ai < 2; ++ai)
#pragma unroll
            for (int m = 0; m < 4; ++m) { bf16_t* rowp = Y + (size_t)(row0 + ai * HALF + m * 16) * DM + col0;
#pragma unroll
                for (int bj = 0; bj < 2; ++bj) *(u32x4*)(rowp + bj * HALF) = pk8(acc[ai][bj][m][0], acc[ai][bj][m][1]); }
    }
};
struct EpiF32 {
    static constexpr bool PERM = false, AFTER_DRAIN = false;
    float* Y; int ldc;
    __device__ __forceinline__ void operator()(const f32x4 (&acc)[2][2][4][2], const Unit& u, int wr, int wc, int fr, int fq) const {
        const int row0 = u.pm * BM + wr * 64 + fr, col0 = u.pn * BM + wc * 32 + 4 * fq;
#pragma unroll
        for (int ai = 0; ai < 2; ++ai)
#pragma unroll
            for (int m = 0; m < 4; ++m) { float* rowp = Y + (size_t)(row0 + ai * HALF + m * 16) * ldc + col0;
#pragma unroll
                for (int bj = 0; bj < 2; ++bj)
#pragma unroll
                    for (int n = 0; n < 2; ++n) *(f32x4*)(rowp + bj * HALF + n * 16) = acc[ai][bj][m][n]; }
    }
};
struct EpiProjOdd {
    static constexpr bool PERM = true, AFTER_DRAIN = false;
    bf16_t* Q; const float* rs;
    __device__ __forceinline__ void operator()(const f32x4 (&acc)[2][2][4][2], const Unit& u, int wr, int wc, int fr, int fq) const {
        const int t = u.pn >> 2; bf16_t* base = Q + (size_t)t * ((size_t)MROWS * DM); const float sc = t == 0 ? QSCALE : 1.f;
        const int row0 = u.pm * BM + wr * 64 + fr, col0 = (u.pn & 3) * BM + wc * 32 + 8 * fq;
#pragma unroll
        for (int ai = 0; ai < 2; ++ai)
#pragma unroll
            for (int m = 0; m < 4; ++m) { const int row = row0 + ai * HALF + m * 16; const float s = rs[row] * sc;
#pragma unroll
                for (int bj = 0; bj < 2; ++bj) *(u32x4*)(base + (size_t)row * DM + col0 + bj * HALF) = pk8(acc[ai][bj][m][0] * s, acc[ai][bj][m][1] * s); }
    }
};
struct EpiProjEven {
    static constexpr bool PERM = true, AFTER_DRAIN = false;
    bf16_t *R1, *IQ, *IK; float* IW; const float* rs;
    const float *c64, *s64, *c32, *s32;
    __device__ __forceinline__ void operator()(const f32x4 (&acc)[2][2][4][2], const Unit& u, int wr, int wc, int fr, int fq) const {
        const int pn = u.pn, row0 = u.pm * BM + wr * 64 + fr;
        if (pn == 4 || pn == 5 || pn == 10 || pn == 11) {
            bf16_t* base = R1 + (size_t)(pn >> 1) * ((size_t)MROWS * 512); const int col0 = (pn & 1) * BM + wc * 32 + 8 * fq;
#pragma unroll
            for (int ai = 0; ai < 2; ++ai)
#pragma unroll
                for (int m = 0; m < 4; ++m) { const int row = row0 + ai * HALF + m * 16; const float s = rs[row];
#pragma unroll
                    for (int bj = 0; bj < 2; ++bj) *(u32x4*)(base + (size_t)row * 512 + col0 + bj * HALF) = pk8(acc[ai][bj][m][0] * s, acc[ai][bj][m][1] * s); }
        } else if (pn < 12) {
            bf16_t* base = R1 + (size_t)(pn >> 1) * ((size_t)MROWS * 512);
            const float sc = (pn < 2 || pn == 6 || pn == 7) ? QSCALE : 1.f;
            const int head = 4 * (pn & 1) + wc, d0 = 8 * fq;
#pragma unroll
            for (int ai = 0; ai < 2; ++ai)
#pragma unroll
                for (int m = 0; m < 4; ++m) { const int row = row0 + ai * HALF + m * 16, pos = row & (SEQ - 1); const float s = rs[row] * sc;
                    f32x4 o1[2], o2[2];
#pragma unroll
                    for (int n = 0; n < 2; ++n) { const f32x4 cc = *(const f32x4*)(c64 + pos * 32 + d0 + 4 * n), ss = *(const f32x4*)(s64 + pos * 32 + d0 + 4 * n);
                        const f32x4 x1 = acc[ai][0][m][n] * s, x2 = acc[ai][1][m][n] * s; o1[n] = x1 * cc - x2 * ss; o2[n] = x2 * cc + x1 * ss; }
                    bf16_t* dst = base + (size_t)row * 512 + head * 64 + d0;
                    *(u32x4*)dst = pk8(o1[0], o1[1]); *(u32x4*)(dst + 32) = pk8(o2[0], o2[1]); }
        } else if (pn == 12) {
            const int head = 2 * wc + (fq >> 1), d0 = 8 * (fq & 1);
#pragma unroll
            for (int ai = 0; ai < 2; ++ai)
#pragma unroll
                for (int m = 0; m < 4; ++m) { const int row = row0 + ai * HALF + m * 16, pos = row & (SEQ - 1); const float s = rs[row];
                    f32x4 o1[2], o2[2];
#pragma unroll
                    for (int n = 0; n < 2; ++n) { const f32x4 cc = *(const f32x4*)(c32 + pos * 16 + d0 + 4 * n), ss = *(const f32x4*)(s32 + pos * 16 + d0 + 4 * n);
                        const f32x4 x1 = acc[ai][0][m][n] * s, x2 = acc[ai][1][m][n] * s; o1[n] = x1 * cc - x2 * ss; o2[n] = x2 * cc + x1 * ss; }
                    bf16_t* dst = IQ + (size_t)row * 256 + head * 32 + d0;
                    *(u32x4*)dst = pk8(o1[0], o1[1]); *(u32x4*)(dst + 16) = pk8(o2[0], o2[1]); }
        } else {
            if (wc == 0 && fq < 2) {
                const int d0 = 8 * fq;
#pragma unroll
                for (int ai = 0; ai < 2; ++ai)
#pragma unroll
                    for (int m = 0; m < 4; ++m) { const int row = row0 + ai * HALF + m * 16, pos = row & (SEQ - 1); const float s = rs[row];
                        f32x4 o1[2], o2[2];
#pragma unroll
                        for (int n = 0; n < 2; ++n) { const f32x4 cc = *(const f32x4*)(c32 + pos * 16 + d0 + 4 * n), ss = *(const f32x4*)(s32 + pos * 16 + d0 + 4 * n);
                            const f32x4 x1 = acc[ai][0][m][n] * s, x2 = acc[ai][1][m][n] * s; o1[n] = x1 * cc - x2 * ss; o2[n] = x2 * cc + x1 * ss; }
                        bf16_t* dst = IK + (size_t)row * 32 + d0;
                        *(u32x4*)dst = pk8(o1[0], o1[1]); *(u32x4*)(dst + 16) = pk8(o2[0], o2[1]); }
            } else if (wc == 0 && fq == 2) {
#pragma unroll
                for (int ai = 0; ai < 2; ++ai)
#pragma unroll
                    for (int m = 0; m < 4; ++m) { const int row = row0 + ai * HALF + m * 16; const float s = rs[row] * 0.0625f;
                        *(f32x4*)(IW + (size_t)row * 8) = acc[ai][0][m][0] * s; *(f32x4*)(IW + (size_t)row * 8 + 4) = acc[ai][0][m][1] * s; }
            }
        }
    }
};
}

namespace att {
#define ALAS __attribute__((address_space(3)))
typedef unsigned short bf16_t;
typedef short bf16x8 __attribute__((ext_vector_type(8)));
typedef short s16x4 __attribute__((ext_vector_type(4)));
typedef float f32x16 __attribute__((ext_vector_type(16)));
typedef float f32x4 __attribute__((ext_vector_type(4)));
typedef unsigned u32x4 __attribute__((ext_vector_type(4)));
typedef short v4i16_t __attribute__((ext_vector_type(4)));
__device__ __forceinline__ int crow(int r, int hi) { return (r & 3) + 8 * (r >> 2) + 4 * hi; }
__device__ __forceinline__ unsigned cvtpk(float lo, float hi) { typedef float f2_t __attribute__((ext_vector_type(2))); typedef __bf16 b2_t __attribute__((ext_vector_type(2)));
    f2_t v = {lo, hi}; b2_t b = __builtin_convertvector(v, b2_t); return __builtin_bit_cast(unsigned, b); }
__device__ __forceinline__ s16x4 vtr(const ALAS unsigned char* p) { return __builtin_bit_cast(s16x4, __builtin_amdgcn_ds_read_tr16_b64_v4i16((ALAS v4i16_t*)p)); }
__device__ __forceinline__ float halfswap_max(float m) { auto rr = __builtin_amdgcn_permlane32_swap(__float_as_uint(m), __float_as_uint(m), false, false); return fmaxf(__uint_as_float(rr[0]), __uint_as_float(rr[1])); }
__device__ __forceinline__ float halfswap_sum(float m) { auto rr = __builtin_amdgcn_permlane32_swap(__float_as_uint(m), __float_as_uint(m), false, false); return __uint_as_float(rr[0]) + __uint_as_float(rr[1]); }

template <int DV> struct Lds {
    static constexpr int R = (DV == 64) ? 4 : 3, D = R - 1;
    static constexpr int KB = 8192, VB = DV * 128;
    static constexpr int OFF_K = 0, OFF_V = R * KB, OFF_MW = OFF_V + R * VB, OFF_WSF = OFF_MW + 8 * R * 256, OFF_BT = OFF_WSF + 8 * 256, OFF_OST = OFF_BT + 3072, OST_W = 4096, TOTAL = OFF_OST + 8 * OST_W;
};
__device__ __forceinline__ void glds16(const void* gsrc, unsigned lds_dst) { unsigned keep;
    asm volatile("s_mov_b32 %0, m0\n\ts_mov_b32 m0, %2\n\ts_nop 0\n\tglobal_load_lds_dwordx4 %1, off\n\ts_mov_b32 m0, %0" : "=&s"(keep) : "v"(gsrc), "s"(lds_dst) : "memory"); }
__device__ __forceinline__ void glds4(const void* gsrc, unsigned lds_dst) { unsigned keep;
    asm volatile("s_mov_b32 %0, m0\n\ts_mov_b32 m0, %2\n\ts_nop 0\n\tglobal_load_lds_dword %1, off\n\ts_mov_b32 m0, %0" : "=&s"(keep) : "v"(gsrc), "s"(lds_dst) : "memory"); }

template <int DV, int MODE, int THR>
__device__ __forceinline__ void attn_core(f32x16 (&o)[DV / 32], ALAS unsigned char* lds,
                                          const bf16_t* Qw, int ldq, const bf16_t* Kh, int ldk, const bf16_t* Vh, int ldv,
                                          int T0, int T1, int tw0, int tw1,
                                          const unsigned long long* maskrow, int qpos, int qchunk, int att_probe_hotmask = -1, int att_probe_skip = 0) {
    typedef Lds<DV> L; constexpr int NDB = DV / 32, NVP = DV / 64, R = L::R, D = L::D, NDMA = 1 + NVP + (MODE == 1 ? 1 : 0);
    int tid = threadIdx.x; asm volatile("" : "+v"(tid));
    const int lane = tid & 63, r32 = lane & 31, hi = lane >> 5; const int wid = __builtin_amdgcn_readfirstlane(tid >> 6);
    ALAS float* wsf = (ALAS float*)(lds + L::OFF_WSF) + wid * 64;
    const ALAS float* btab = (const ALAS float*)(lds + L::OFF_BT);
    constexpr bool QLDS = (DV == 128);
    ALAS unsigned char* qst = lds + L::OFF_OST + wid * L::OST_W + lane * 16;
    bf16x8 qr[4];
#pragma unroll
    for (int d0 = 0; d0 < 4; ++d0) { qr[d0] = *(const bf16x8*)(Qw + (size_t)r32 * ldq + d0 * 16 + hi * 8); if (QLDS) *(ALAS bf16x8*)(qst + d0 * 1024) = qr[d0]; }
    const int krow = 8 * wid + (lane >> 3), kkey = krow ^ ((krow >> 3) & 1), kch = (lane & 7) ^ (kkey & 7);
    const bf16_t* ksrc = Kh + (size_t)kkey * ldk + kch * 8;
    const bf16_t* vsrc = Vh + (size_t)(16 * (wid & 3) + (lane >> 2)) * ldv + 32 * (wid >> 2) + 8 * (lane & 3);
    const unsigned* msrc = (const unsigned*)maskrow + hi;
    const unsigned lds0 = (unsigned)(__SIZE_TYPE__)lds;
    const unsigned kdst = lds0 + L::OFF_K + wid * 1024, vdst = lds0 + L::OFF_V + (wid >> 2) * 4096 + (wid & 3) * 1024, mdstb = lds0 + L::OFF_MW + wid * (R * 256);
    ALAS unsigned char* mdst = lds + L::OFF_MW + wid * (R * 256);
#define ATT_U(x) ((unsigned)__builtin_amdgcn_readfirstlane((int)(x)))
#define ATT_TT(t) (T0 + (((t) - T0) & att_probe_hotmask))
#define ATT_DMA_K(t, sl) glds16(ksrc + (size_t)ATT_TT(t) * 64 * ldk, ATT_U(kdst + (sl) * L::KB))
#define ATT_DMA_V(t, sl) do { glds16(vsrc + (size_t)ATT_TT(t) * 64 * ldv, ATT_U(vdst + (sl) * L::VB)); if (NVP == 2) glds16(vsrc + (size_t)ATT_TT(t) * 64 * ldv + 64, ATT_U(vdst + (sl) * L::VB + 8192)); \
                              if (MODE == 1) glds4(msrc + 2 * (t), ATT_U(mdstb + (sl) * 256)); } while (0)
    int kfo[4];
#pragma unroll
    for (int d0 = 0; d0 < 4; ++d0) kfo[d0] = (r32 ^ ((r32 >> 3) & 1)) * 128 + (((2 * d0 + hi) ^ (r32 & 7)) * 16);
#define ATT_QK(P0, P1, t, ks) do { \
        if (MODE == 2) { const int jrel_ = qchunk - (t); \
            if (jrel_ >= 5) { const float bc_ = btab[638]; _Pragma("unroll") for (int r = 0; r < 16; ++r) { P0[r] = bc_; P1[r] = bc_; } } \
            else { const ALAS float* bp_ = btab + (qpos - 64 * (t) + 63 - 4 * hi - 59); \
                _Pragma("unroll") for (int r = 0; r < 16; ++r) { P0[r] = bp_[59 - crow(r, 0)]; P1[r] = bp_[59 - 32 - crow(r, 0)]; } } \
        } else { P0 = f32x16{}; P1 = f32x16{}; } \
        const ALAS unsigned char* kb_ = lds + L::OFF_K + (ks) * L::KB; \
        _Pragma("unroll") for (int d0 = 0; d0 < 4; ++d0) { const bf16x8 b0_ = *(const ALAS bf16x8*)(kb_ + kfo[d0]), b1_ = *(const ALAS bf16x8*)(kb_ + kfo[d0] + 4096); \
            const bf16x8 q_ = QLDS ? *(const ALAS bf16x8*)(qst + d0 * 1024) : qr[d0]; \
            P0 = __builtin_amdgcn_mfma_f32_32x32x16_bf16(b0_, q_, P0, 0, 0, 0); P1 = __builtin_amdgcn_mfma_f32_32x32x16_bf16(b1_, q_, P1, 0, 0, 0); } } while (0)
    constexpr int NV = NDMA - 1;
#define ATT_CK(j) (((j) <= T0 + D) ? ((j) - T0) * NDMA + 1 : ((j) - 1 - T0) * NDMA + 2)
#define ATT_CV(j) (((j) < T0 + D) ? ((j) - T0 + 1) * NDMA : ((j) - T0) * NDMA + 2 + NV)
#define ATT_WAIT_BAR_N(n_) do { const int nn_ = (n_); \
        if (nn_ <= 0) asm volatile("s_waitcnt vmcnt(0) lgkmcnt(0)\n\ts_barrier" ::: "memory"); \
        else if (nn_ == 1) asm volatile("s_waitcnt vmcnt(1) lgkmcnt(0)\n\ts_barrier" ::: "memory"); \
        else if (nn_ == 2) asm volatile("s_waitcnt vmcnt(2) lgkmcnt(0)\n\ts_barrier" ::: "memory"); \
        else if (nn_ == 3) asm volatile("s_waitcnt vmcnt(3) lgkmcnt(0)\n\ts_barrier" ::: "memory"); \
        else if (nn_ == 4) asm volatile("s_waitcnt vmcnt(4) lgkmcnt(0)\n\ts_barrier" ::: "memory"); \
        else if (nn_ == 5) asm volatile("s_waitcnt vmcnt(5) lgkmcnt(0)\n\ts_barrier" ::: "memory"); \
        else if (nn_ == 6) asm volatile("s_waitcnt vmcnt(6) lgkmcnt(0)\n\ts_barrier" ::: "memory"); \
        else if (nn_ == 7) asm volatile("s_waitcnt vmcnt(7) lgkmcnt(0)\n\ts_barrier" ::: "memory"); \
        else asm volatile("s_waitcnt vmcnt(8) lgkmcnt(0)\n\ts_barrier" ::: "memory"); } while (0)
#define ATT_END_STEP(t) do { int need_ = 0; if ((t) + 2 < T1) need_ = ATT_CK((t) + 2); if ((t) + 1 < T1) { const int cv_ = ATT_CV((t) + 1); need_ = cv_ > need_ ? cv_ : need_; } \
        ATT_WAIT_BAR_N(need_ ? n_issued - need_ : 0); } while (0)
    int n_issued = 0;
    float m_run = -1e30f, l_part = 0.f;
#pragma unroll
    for (int d0 = 0; d0 < NDB; ++d0) o[d0] = f32x16{};
#pragma unroll
    for (int i = 0; i <= D; ++i) { if (T0 + i < T1) { ATT_DMA_K(T0 + i, i); n_issued += 1; } if (i < D && T0 + i < T1) { ATT_DMA_V(T0 + i, i); n_issued += NV; } }
    ATT_WAIT_BAR_N(n_issued - 1);
    f32x16 pc0, pc1, pn0, pn1;
    pc0 = f32x16{}; pc1 = f32x16{}; pn0 = f32x16{}; pn1 = f32x16{};
    if (tw0 == T0) { ATT_QK(pc0, pc1, T0, 0); }
    ATT_END_STEP(T0 - 1);
    int sk = 1 % R, sv = 0, si_k = 0, si_v = D % R;
    for (int t = T0; t < T1; ++t) {
        const bool steady = (t + 1 + D < T1);
        if (steady) { ATT_DMA_K(t + 1 + D, si_k); n_issued += 1; }
        if (t + D < T1) { ATT_DMA_V(t + D, si_v); n_issued += NV; }
        const bool act = (t >= tw0 && t < tw1), nxt = (t + 1 >= tw0 && t + 1 < tw1);
        if (nxt && !(att_probe_skip & 1)) { ATT_QK(pn0, pn1, t + 1, sk); }
        if (act && !(att_probe_skip & 2)) {
            if (MODE == 1) { const ALAS unsigned* mp = (const ALAS unsigned*)(mdst + sv * 256); const unsigned w0 = mp[r32] >> (4 * hi), w1 = mp[32 + r32] >> (4 * hi);
#pragma unroll
                for (int r = 0; r < 16; ++r) { const int sh = 31 - ((r & 3) + 8 * (r >> 2));
                    const unsigned m0 = (unsigned)(((int)(w0 << sh)) >> 31), m1 = (unsigned)(((int)(w1 << sh)) >> 31);
                    pc0[r] = __uint_as_float((__float_as_uint(pc0[r]) & m0) | (0xff800000u & ~m0)); pc1[r] = __uint_as_float((__float_as_uint(pc1[r]) & m1) | (0xff800000u & ~m1)); } }
            float mx = fmaxf(fmaxf(pc0[0], pc1[0]), pc0[1]);
#pragma unroll
            for (int r = 1; r < 16; ++r) mx = (r == 1) ? fmaxf(mx, pc1[1]) : fmaxf(fmaxf(mx, pc0[r]), pc1[r]);
            mx = halfswap_max(mx);
            if (__any(mx > m_run + (float)THR)) {
                const float mnew = fmaxf(m_run, mx); const float f = __builtin_amdgcn_exp2f(m_run - mnew);
                l_part *= f; m_run = mnew; if (hi == 0) wsf[r32] = f;
#pragma unroll
                for (int r = 0; r < 16; ++r) { const float fr_ = wsf[crow(r, hi)];
#pragma unroll
                    for (int d0 = 0; d0 < NDB; ++d0) o[d0][r] *= fr_; }
            }
            float sa = 0.f, sb = 0.f;
#pragma unroll
            for (int r = 0; r < 16; ++r) { pc0[r] = __builtin_amdgcn_exp2f(pc0[r] - m_run); pc1[r] = __builtin_amdgcn_exp2f(pc1[r] - m_run); sa += pc0[r]; sb += pc1[r]; }
            l_part += sa + sb;
            u32x4 pw[4];
#pragma unroll
            for (int k = 0; k < 2; ++k)
#pragma unroll
                for (int j = 0; j < 4; ++j) { pw[k][j] = cvtpk(pc0[8 * k + 2 * j], pc0[8 * k + 2 * j + 1]); pw[2 + k][j] = cvtpk(pc1[8 * k + 2 * j], pc1[8 * k + 2 * j + 1]); }
            const ALAS unsigned char* vb = lds + L::OFF_V + sv * L::VB + ((lane >> 4) & 1) * 32 + (lane & 3) * 8 + (4 * hi + ((lane & 15) >> 2)) * 64;
            if (!(att_probe_skip & 4))
#pragma unroll
            for (int d0 = 0; d0 < NDB; ++d0)
#pragma unroll
                for (int ks = 0; ks < 4; ++ks) { const s16x4 lo = vtr(vb + d0 * 4096 + ks * 1024), up = vtr(vb + d0 * 4096 + ks * 1024 + 512);
                    const bf16x8 vf = (bf16x8){lo[0], lo[1], lo[2], lo[3], up[0], up[1], up[2], up[3]};
                    o[d0] = __builtin_amdgcn_mfma_f32_32x32x16_bf16(__builtin_bit_cast(bf16x8, pw[ks]), vf, o[d0], 0, 0, 0); }
        }
        pc0 = pn0; pc1 = pn1;
        sk = (sk + 1 == R) ? 0 : sk + 1; sv = (sv + 1 == R) ? 0 : sv + 1; si_k = (si_k + 1 == R) ? 0 : si_k + 1; si_v = (si_v + 1 == R) ? 0 : si_v + 1;
        ATT_END_STEP(t);
    }
#undef ATT_U
#undef ATT_TT
#undef ATT_DMA_K
#undef ATT_DMA_V
#undef ATT_QK
#undef ATT_CK
#undef ATT_CV
#undef ATT_WAIT_BAR_N
#undef ATT_END_STEP
    const float l = halfswap_sum(l_part);
    if (hi == 0) wsf[32 + r32] = l;
#pragma unroll
    for (int r = 0; r < 16; ++r) { const float rl = 1.0f / wsf[32 + crow(r, hi)];
#pragma unroll
        for (int d0 = 0; d0 < NDB; ++d0) o[d0][r] *= rl; }
}

template <int DV>
__device__ __forceinline__ void store_o(const f32x16 (&o)[DV / 32], ALAS unsigned char* lds, bf16_t* dst, int ldo) {
    typedef Lds<DV> L;
    int tid = threadIdx.x; asm volatile("" : "+v"(tid));
    const int lane = tid & 63, r32 = lane & 31, hi = lane >> 5; const int wid = __builtin_amdgcn_readfirstlane(tid >> 6);
    ALAS bf16_t* stg = (ALAS bf16_t*)(lds + L::OFF_OST + wid * L::OST_W);
#pragma unroll
    for (int h = 0; h < DV / 64; ++h) {
#pragma unroll
        for (int r = 0; r < 16; ++r) { const int orow = crow(r, hi);
#pragma unroll
            for (int d0 = 0; d0 < 2; ++d0) stg[orow * 64 + d0 * 32 + r32] = (bf16_t)(cvtpk(o[2 * h + d0][r], 0.f) & 0xffffu); }
#pragma unroll
        for (int i = 0; i < 4; ++i) { const int row = i * 8 + (lane >> 3), ch = lane & 7; const u32x4 v = *(const ALAS u32x4*)(stg + row * 64 + ch * 8); *(u32x4*)(dst + (size_t)row * ldo + h * 64 + ch * 8) = v; }
    }
}
}
#define GAS __attribute__((address_space(1)))
#define LAS __attribute__((address_space(3)))
typedef unsigned short bf16;
typedef unsigned v4u __attribute__((ext_vector_type(4)));
typedef float f32x4 __attribute__((ext_vector_type(4)));
typedef short bf16x8 __attribute__((ext_vector_type(8)));
typedef GAS unsigned gu32;
typedef GAS unsigned long long gu64;
#define RLX_AGENT __ATOMIC_RELAXED, __HIP_MEMORY_SCOPE_AGENT
#define LDS_WAIT() asm volatile("s_waitcnt lgkmcnt(0)" ::: "memory")
#define VM_WAIT() asm volatile("s_waitcnt vmcnt(0)" ::: "memory")
__device__ __forceinline__ unsigned long long rt() { return __builtin_amdgcn_s_memrealtime(); }
__device__ __forceinline__ unsigned f2bf(float f) { unsigned u = __builtin_bit_cast(unsigned, f); return (u + 0x7fffu + ((u >> 16) & 1u)) >> 16; }
__device__ __forceinline__ unsigned pk2(float lo, float hi) { return f2bf(lo) | (f2bf(hi) << 16); }

#define XB_TMO      128
#define XB_XCNT(j)  (256  + 64 * (j))
#define XB_XSUB(j)  (1280 + 64 * (j))
#define XB_XGEN(j)  (2304 + 64 * (j))
#define XB_TOP      3328
#define XB_TOPGEN   3392
#define XCD_BAR_WORDS 3456
#define XB_SPIN_CAP (1u << 18)

__device__ __forceinline__ unsigned xb_ld(unsigned* p)              { return __hip_atomic_load(p, __ATOMIC_RELAXED, __HIP_MEMORY_SCOPE_AGENT); }
__device__ __forceinline__ unsigned xb_add(unsigned* p, unsigned v) { return __hip_atomic_fetch_add(p, v, __ATOMIC_RELAXED, __HIP_MEMORY_SCOPE_AGENT); }
__device__ __forceinline__ unsigned xb_xcc_id() { return (unsigned)__builtin_amdgcn_s_getreg((3 << 11) | 20) & 0xFu; }
#define XB_SPIN(cond, bar) do { unsigned _sp = 0; while (cond) { __builtin_amdgcn_s_sleep(1); \
    if ((++_sp & 255u) == 0u) { if (xb_ld(&(bar)[XB_TMO])) break; if (_sp > XB_SPIN_CAP) { atomicAdd(&(bar)[XB_TMO], 1u); break; } } } } while (0)

struct XcdBarrier {
    unsigned* bar; unsigned x;
    volatile LAS unsigned* st;
};

__device__ __forceinline__ XcdBarrier xcd_barrier_post(unsigned* bar, volatile LAS unsigned* st) {
    XcdBarrier b; b.bar = bar; b.x = xb_xcc_id(); b.st = st;
    if (threadIdx.x == 0) (void)xb_add(&bar[XB_XCNT(b.x)], 1u);
    return b;
}
__device__ __forceinline__ void xcd_barrier_complete(unsigned* bar, unsigned x, unsigned& nloc, unsigned& nx) {
    const unsigned G = gridDim.x * gridDim.y * gridDim.z;
    unsigned sum, cnt, mine, sp = 0u;
    for (;;) {
        sum = 0u; cnt = 0u; mine = 0u;
#pragma unroll
        for (unsigned j = 0; j < 16; ++j) { const unsigned c = xb_ld(&bar[XB_XCNT(j)]); sum += c; cnt += (c > 0u) ? 1u : 0u; mine = (j == x) ? c : mine; }
        if (sum == G) break;
        __builtin_amdgcn_s_sleep(1);
        if ((++sp & 255u) == 0u) { if (xb_ld(&bar[XB_TMO])) break; if (sp > XB_SPIN_CAP) { atomicAdd(&bar[XB_TMO], 1u); break; } }
    }
    nloc = mine > 0u ? mine : 1u; nx = cnt > 0u ? cnt : 1u;
}

__device__ __forceinline__ void xcd_barrier(const XcdBarrier& b) {
    asm volatile("s_waitcnt vmcnt(0)" ::: "memory");
    __syncthreads();
    if (threadIdx.x == 0) {
        unsigned* bar = b.bar;
        __builtin_amdgcn_s_waitcnt(0);
        unsigned nloc = b.st[0], nx = b.st[1];
        if (nloc == 0u) { xcd_barrier_complete(bar, b.x, nloc, nx); b.st[0] = nloc; b.st[1] = nx; }
        const unsigned old = xb_add(&bar[XB_XSUB(b.x)], 1u);
        const unsigned gen = old / nloc;
        if (old + 1u == (gen + 1u) * nloc) {
            __builtin_amdgcn_fence(__ATOMIC_RELEASE, "agent");
            asm volatile("s_waitcnt vmcnt(0)" ::: "memory");
            const unsigned og = xb_add(&bar[XB_TOP], 1u);
            const unsigned tg = og / nx;
            if (og + 1u == (tg + 1u) * nx) xb_add(&bar[XB_TOPGEN], 1u);
            else XB_SPIN(xb_ld(&bar[XB_TOPGEN]) == tg, bar);
            __builtin_amdgcn_fence(__ATOMIC_ACQUIRE, "agent");
            xb_add(&bar[XB_XGEN(b.x)], 1u);
            asm volatile("s_waitcnt vmcnt(0)" ::: "memory");
        } else {
            XB_SPIN(xb_ld(&bar[XB_XGEN(b.x)]) == gen, bar);
            __builtin_amdgcn_fence(__ATOMIC_ACQUIRE, "agent");
            asm volatile("s_waitcnt vmcnt(0)" ::: "memory");
        }
    }
    __syncthreads();
}

constexpr int NWAVES = 8;
constexpr size_t MiB = 1u << 20;
constexpr size_t WS_CTL = 0, CTL_ZERO_BYTES = 1 * MiB;
constexpr size_t WS_C64 = 1 * MiB, WS_S64 = WS_C64 + 256 * 1024, WS_C32 = WS_C64 + 512 * 1024, WS_S32 = WS_C64 + 640 * 1024, WS_RS = WS_C64 + 768 * 1024;
constexpr size_t WS_WGU = 2 * MiB, WGU_BYTES = (size_t)NGU * DM * 2;
constexpr size_t WS_WD = 46 * MiB, WD_BYTES = (size_t)DM * FF * 2;
constexpr size_t WS_WIN0 = 68 * MiB, WS_WOUT0 = 75 * MiB, WS_WIN1 = 77 * MiB, WS_WOUT1 = 83 * MiB;
constexpr size_t WS_MASK = 85 * MiB;
constexpr size_t WS_XB = 93 * MiB;
constexpr size_t WS_R1 = 157 * MiB;
constexpr size_t WS_Y = 381 * MiB;
constexpr size_t WS_ATT = 445 * MiB;
constexpr size_t WS_END = 509 * MiB;
static_assert(WS_WGU + 4 * WGU_BYTES <= WS_WD && WS_WD + 4 * WD_BYTES <= WS_WIN0 && WS_WIN0 + (size_t)NEV * DM * 2 <= WS_WOUT0 && WS_WIN1 + (size_t)NOD * DM * 2 <= WS_WOUT1, "weight map");
static_assert(WS_R1 + (size_t)MROWS * FF * 2 <= WS_Y && WS_R1 + 211 * MiB <= WS_Y, "R1 map");
constexpr int CW_BAR = 4096;
constexpr int RING_BYTES = 131072, LDSCTL_OFF = RING_BYTES, MISC_OFF = LDSCTL_OFF + 320, LDS_BYTES = 147456;

struct Frame {
    LAS unsigned char* lds; volatile LAS unsigned* MISC; gu32* ctl;
    int tid, lane, wave, vcu, G;
};

template <int X> __device__ __forceinline__ float swz_xor(float v) { return __int_as_float(__builtin_amdgcn_ds_swizzle(__float_as_int(v), (X << 10) | 0x1f)); }
__device__ __forceinline__ float sum32(float v) { v += swz_xor<1>(v); v += swz_xor<2>(v); v += swz_xor<4>(v); v += swz_xor<8>(v); v += swz_xor<16>(v); return v; }
__device__ __forceinline__ float wave_sum(float v) { return att::halfswap_sum(sum32(v)); }
struct MapGUHalf { int bj; __device__ __forceinline__ int src(int R) const { return R; } __device__ __forceinline__ int dst(int R) const { return 256 * (R >> 7) + 128 * bj + (R & 127); } };
struct MapId { __device__ __forceinline__ int src(int R) const { return R; } __device__ __forceinline__ int dst(int R) const { return R; } };
__device__ __forceinline__ int even_src(int R) {
    const int pn = R >> 8, bj = (R >> 7) & 1, jj = R & 127;
    if (pn < 4) return (pn < 2 ? 0 : 512) + (4 * (pn & 1) + (jj >> 5)) * 64 + 32 * bj + (jj & 31);
    if (pn < 6) return 1024 + 256 * (pn - 4) + 128 * bj + jj;
    if (pn < 10) return (pn < 8 ? 1536 : 2048) + (4 * (pn & 1) + (jj >> 5)) * 64 + 32 * bj + (jj & 31);
    if (pn < 12) return 2560 + 256 * (pn - 10) + 128 * bj + jj;
    if (pn == 12) return 3072 + (jj >> 4) * 32 + 16 * bj + (jj & 15);
    if (jj < 16) return 3328 + 16 * bj + jj;
    if (bj == 0 && jj < 24) return 3360 + (jj - 16);
    return -1;
}
struct MapEven { __device__ __forceinline__ int src(int R) const { return even_src(R); } __device__ __forceinline__ int dst(int R) const { return R; } };
template <class Map>
__device__ __forceinline__ void transpose_item(const Map& mp, const float* W, int ldw, int K, int nrows, bf16* WT, const float* g, LAS float* scr, int item, int lane) {
    const int nblk = nrows / 32, kb = item / nblk, nb = item % nblk, k0 = 64 * kb, n0 = 32 * nb;
    const int sc0 = mp.src(n0 + (lane & 31)); const float mul = sc0 >= 0 ? 1.f : 0.f; const float* src = W + (sc0 >= 0 ? sc0 : 0);
#pragma unroll 8
    for (int i = 0; i < 32; ++i) { const int kk = 2 * i + (lane >> 5); float v = src[(size_t)(k0 + kk) * ldw] * mul; if (g) v *= g[k0 + kk]; scr[kk * 33 + (lane & 31)] = v; }
    LDS_WAIT(); asm volatile("" ::: "memory");
    const int c = lane & 7;
#pragma unroll
    for (int j = 0; j < 4; ++j) { const int n = (lane >> 3) + 8 * j; const LAS float* s = scr + (8 * c) * 33 + n;
        v4u o; o.x = pk2(s[0 * 33], s[1 * 33]); o.y = pk2(s[2 * 33], s[3 * 33]); o.z = pk2(s[4 * 33], s[5 * 33]); o.w = pk2(s[6 * 33], s[7 * 33]);
        *(GAS v4u*)(WT + (size_t)mp.dst(n0 + n) * K + k0 + 8 * c) = o; }
    LDS_WAIT(); asm volatile("" ::: "memory");
}
__device__ __forceinline__ void sincos_d(double a, float& sn, float& cs) {
    const double k = __builtin_rint(a * 0.6366197723675814); const double y = a - k * 1.5707963267948966; const double y2 = y * y;
    const double s = y * (1.0 + y2 * (-1.0 / 6 + y2 * (1.0 / 120 + y2 * (-1.0 / 5040 + y2 * (1.0 / 362880 + y2 * (-1.0 / 39916800 + y2 * (1.0 / 6227020800.0)))))));
    const double c = 1.0 + y2 * (-0.5 + y2 * (1.0 / 24 + y2 * (-1.0 / 720 + y2 * (1.0 / 40320 + y2 * (-1.0 / 3628800 + y2 * (1.0 / 479001600.0 + y2 * (-1.0 / 87178291200.0)))))));
    const int q = (int)((long long)k & 3);
    const double ss = (q == 0) ? s : (q == 1) ? c : (q == 2) ? -s : -c, cc = (q == 0) ? c : (q == 1) ? -s : (q == 2) ? -c : s;
    sn = (float)ss; cs = (float)cc;
}
__device__ __forceinline__ void x_to_bf16_row(const float* xrow, bf16* xb, float* rs, int lane) {
    const GAS f32x4* xr = (const GAS f32x4*)xrow + lane; f32x4 v[4]; float s = 0.f;
#pragma unroll
    for (int j = 0; j < 4; ++j) { v[j] = xr[64 * j]; s += (v[j].x * v[j].x + v[j].y * v[j].y) + (v[j].z * v[j].z + v[j].w * v[j].w); }
    GAS unsigned long long* o8 = (GAS unsigned long long*)xb + lane;
#pragma unroll
    for (int j = 0; j < 4; ++j) o8[64 * j] = (unsigned long long)epi::pkbf(v[j].x, v[j].y) | ((unsigned long long)epi::pkbf(v[j].z, v[j].w) << 32);
    const float r = 1.0f / sqrtf(wave_sum(s) * (1.f / DM) + RMS_EPS); if (lane == 0) *rs = r;
}
__device__ __forceinline__ void bf8_to_f32(const v4u& w, float (&f)[8]) {
#pragma unroll
    for (int i = 0; i < 4; ++i) { f[2 * i] = __uint_as_float(w[i] << 16); f[2 * i + 1] = __uint_as_float(w[i] & 0xffff0000u); } }
template <bool LAST>
__device__ __forceinline__ void thin_row(const bf16* yrow, bf16* xrow, float* outf, const float* ga, float alpha, float* rs, int lane) {
    float y[2][8], x[2][8]; float s = 0.f;
#pragma unroll
    for (int j = 0; j < 2; ++j) { const v4u yw = *((const GAS v4u*)yrow + lane + 64 * j), xw = *((const GAS v4u*)xrow + lane + 64 * j); bf8_to_f32(yw, y[j]); bf8_to_f32(xw, x[j]);
#pragma unroll
        for (int i = 0; i < 8; ++i) s += y[j][i] * y[j][i]; }
    const float r1 = alpha / sqrtf(wave_sum(s) * (1.f / DM) + RMS_EPS); float s2 = 0.f;
#pragma unroll
    for (int j = 0; j < 2; ++j) { const f32x4 g0 = *((const GAS f32x4*)ga + 2 * lane + 128 * j), g1 = *((const GAS f32x4*)ga + 2 * lane + 128 * j + 1);
#pragma unroll
        for (int i = 0; i < 8; ++i) { const float g = i < 4 ? g0[i & 3] : g1[i & 3]; x[j][i] += y[j][i] * g * r1; s2 += x[j][i] * x[j][i]; }
        if (LAST) { *((GAS f32x4*)outf + 2 * lane + 128 * j) = (f32x4){x[j][0], x[j][1], x[j][2], x[j][3]}; *((GAS f32x4*)outf + 2 * lane + 128 * j + 1) = (f32x4){x[j][4], x[j][5], x[j][6], x[j][7]}; }
        else { v4u o; o.x = epi::pkbf(x[j][0], x[j][1]); o.y = epi::pkbf(x[j][2], x[j][3]); o.z = epi::pkbf(x[j][4], x[j][5]); o.w = epi::pkbf(x[j][6], x[j][7]); *((GAS v4u*)xrow + lane + 64 * j) = o; } }
    if (!LAST) { const float r2 = 1.0f / sqrtf(wave_sum(s2) * (1.f / DM) + RMS_EPS); if (lane == 0) *rs = r2; }
}

struct Ptrs {
    const float *x, *norm_g, *wg, *wu, *wd, *ewin, *ewout, *elam, *esub, *owin, *owout, *obias; float* out; unsigned char* ws;
};

__device__ __forceinline__ void p0_prologue(Frame& F0, const Ptrs& P) {
    struct { LAS unsigned char* lds; int tid, lane, wave, vcu, G; } F;
    { int t = threadIdx.x; asm volatile("" : "+v"(t)); F.lds = F0.lds; F.tid = t; F.lane = t & 63; F.wave = __builtin_amdgcn_readfirstlane(t >> 6); F.vcu = F0.vcu; F.G = F0.G; }
    LAS float* scr = (LAS float*)(F.lds + F.wave * 16384);
    const int gw = F.vcu * NWAVES + F.wave, NGW = F.G * NWAVES;
    constexpr int I_GH = (DM / 64) * (FF / 32), I_WD = (FF / 64) * (DM / 32), I_E = (DM / 64) * (NEV / 32), I_O = (DM / 64) * (DM / 32), I_OD = (DM / 64) * (NOD / 32);
    constexpr int NITEMS = 8 * I_GH + 4 * I_WD + I_E + I_O + I_OD + I_O;
    for (int it = gw; it < NITEMS; it += NGW) {
        int r = it;
        if (r < 8 * I_GH) { const int i8 = r / I_GH; r -= i8 * I_GH; const int i = i8 >> 1, bj = i8 & 1, l = i >> 1, f = i & 1;
            MapGUHalf mp{bj}; const float* W = (bj ? P.wu : P.wg) + (size_t)i * DM * FF;
            transpose_item(mp, W, FF, DM, FF, (bf16*)(P.ws + WS_WGU + i * WGU_BYTES), P.norm_g + (l * 6 + 4 * f) * DM, scr, r, F.lane); continue; }
        r -= 8 * I_GH;
        if (r < 4 * I_WD) { const int i = r / I_WD; r -= i * I_WD; MapId mp;
            transpose_item(mp, P.wd + (size_t)i * FF * DM, DM, FF, DM, (bf16*)(P.ws + WS_WD + i * WD_BYTES), nullptr, scr, r, F.lane); continue; }
        r -= 4 * I_WD;
        if (r < I_E) { MapEven mp; transpose_item(mp, P.ewin, 3368, DM, NEV, (bf16*)(P.ws + WS_WIN0), P.norm_g + (0 * 6 + 2) * DM, scr, r, F.lane); continue; }
        r -= I_E;
        if (r < I_O) { MapId mp; transpose_item(mp, P.ewout, DM, DM, DM, (bf16*)(P.ws + WS_WOUT0), nullptr, scr, r, F.lane); continue; }
        r -= I_O;
        if (r < I_OD) { MapId mp; transpose_item(mp, P.owin, NOD, DM, NOD, (bf16*)(P.ws + WS_WIN1), P.norm_g + (1 * 6 + 2) * DM, scr, r, F.lane); continue; }
        r -= I_OD;
        { MapId mp; transpose_item(mp, P.owout, DM, DM, DM, (bf16*)(P.ws + WS_WOUT1), nullptr, scr, r, F.lane); }
    }
    float* c64 = (float*)(P.ws + WS_C64); float* s64 = (float*)(P.ws + WS_S64); float* c32 = (float*)(P.ws + WS_C32); float* s32 = (float*)(P.ws + WS_S32);
    const int gt = F.vcu * (NWAVES * 64) + F.tid, NGT = F.G * NWAVES * 64;
    for (int e = gt; e < SEQ * 48; e += NGT) {
        const bool is64 = e < SEQ * 32; const int ee = is64 ? e : e - SEQ * 32; const int pos = is64 ? (ee >> 5) : (ee >> 4), i = is64 ? (ee & 31) : (ee & 15);
        const double rb = is64 ? 0.7498942093324559 : 0.5623413251903492; double inv = 1.0; for (int k = 0; k < i; ++k) inv *= rb;
        const float ang = (float)pos * (float)inv; float sn, cs; sincos_d((double)ang, sn, cs);
        if (is64) { c64[ee] = cs; s64[ee] = sn; } else { c32[ee] = cs; s32[ee] = sn; }
    }
    bf16* XB = (bf16*)(P.ws + WS_XB); float* RS = (float*)(P.ws + WS_RS);
    for (int m = gw; m < MROWS; m += NGW) x_to_bf16_row(P.x + (size_t)m * DM, XB + (size_t)m * DM, RS + m, F.lane);
}
#ifndef PROBE_REP_IDXA
#define PROBE_REP_IDXA 1
#endif
#ifndef PROBE_REP_B
#define PROBE_REP_B 1
#endif
#ifndef PROBE_REP_C
#define PROBE_REP_C 1
#endif
#ifndef PROBE_REP_GU
#define PROBE_REP_GU 1
#endif
#ifndef PROBE_REP_DN
#define PROBE_REP_DN 1
#endif
#ifndef PROBE_NULL_GU
#define PROBE_NULL_GU 0
#endif
#ifndef PROBE_NULL_DN
#define PROBE_NULL_DN 0
#endif
#ifndef PROBE_REP_IDX
#define PROBE_REP_IDX 1
#endif
#ifndef PROBE_B_SKIP
#define PROBE_B_SKIP 0
#endif
#ifndef PROBE_B_HOT
#define PROBE_B_HOT 0
#endif
#ifndef PROBE_REP_THIN
#define PROBE_REP_THIN 1
#endif
template <bool LAST>
__device__ __forceinline__ void thin_phase(Frame& F, const Ptrs& P, const float* ga, float alpha) {
    int t_ = threadIdx.x; asm volatile("" : "+v"(t_)); const int lane_ = t_ & 63, wave_ = __builtin_amdgcn_readfirstlane(t_ >> 6);
    const int gw = F.vcu * NWAVES + wave_, NGW = F.G * NWAVES;
    const bf16* Y = (const bf16*)(P.ws + WS_Y); bf16* XB = (bf16*)(P.ws + WS_XB); float* RS = (float*)(P.ws + WS_RS);
    for (int m = gw; m < MROWS; m += NGW) thin_row<LAST>(Y + (size_t)m * DM, XB + (size_t)m * DM, P.out + (size_t)m * DM, ga, alpha, RS + m, lane_);
}

__device__ __forceinline__ int wave_sum_i(int x) {
    x += __builtin_amdgcn_update_dpp(0, x, 0x111, 0xf, 0xf, true);
    x += __builtin_amdgcn_update_dpp(0, x, 0x112, 0xf, 0xf, true);
    x += __builtin_amdgcn_update_dpp(0, x, 0x114, 0xf, 0xf, true);
    x += __builtin_amdgcn_update_dpp(0, x, 0x118, 0xf, 0xf, true);
    return __builtin_amdgcn_readlane(x, 15) + __builtin_amdgcn_readlane(x, 31) + __builtin_amdgcn_readlane(x, 47) + __builtin_amdgcn_readlane(x, 63);
}
__device__ __forceinline__ void select_row(const unsigned (&u)[32], unsigned T, int cT, unsigned long long* mw, int lane) {
    if (cT == 256) {
#pragma unroll
        for (int i = 0; i < 32; ++i) { const unsigned long long w = __ballot(u[i] >= T); if (lane == 0) mw[i] = w; }
    } else {
        int cgt = 0;
#pragma unroll
        for (int i = 0; i < 32; ++i) cgt += __popcll(__ballot(u[i] > T));
        const int need = 256 - cgt; int base = 0; unsigned T2 = T; asm volatile("" : "+s"(T2));
#pragma unroll
        for (int i = 0; i < 32; ++i) {
            const bool eq = (u[i] == T2), gt = (u[i] > T2); const unsigned long long em = __ballot(eq);
            const int rank = (int)__builtin_amdgcn_mbcnt_hi((unsigned)(em >> 32), __builtin_amdgcn_mbcnt_lo((unsigned)em, (unsigned)base));
            const unsigned long long w = __ballot(gt || (eq && rank < need)); base += __popcll(em);
            if (lane == 0) mw[i] = w;
        }
    }
}
template <int VAR>
__device__ __forceinline__ void indexer_unit(Frame& F, const Ptrs& P, int b, int blk) {
    typedef short bf16x8v __attribute__((ext_vector_type(8)));
    int tid = threadIdx.x; asm volatile("" : "+v"(tid));
    const int q0 = blk * 16, qc = q0 >> 6, n64 = qc + 1, nvis = n64 * 64; const int lane = tid & 63, wid = __builtin_amdgcn_readfirstlane(tid >> 6);
    unsigned long long* mrow = (unsigned long long*)(P.ws + WS_MASK) + ((size_t)(b * SEQ + q0)) * 32;
    if (n64 <= 4) {
        for (int i = tid; i < 16 * 32; i += NWAVES * 64) { const int w = i & 31; if (w < n64) mrow[i] = ~0ull; }
        return;
    }
    const bf16* IQ = (const bf16*)(P.ws + WS_R1 + 192 * MiB); const bf16* IK = (const bf16*)(P.ws + WS_R1 + 208 * MiB); const float* IW = (const float*)(P.ws + WS_R1 + 210 * MiB);
    LAS float* sc = (LAS float*)F.lds;
    if (!(VAR & 1)) {
        const int q = lane & 15, kg = lane >> 4; const size_t qrow = (size_t)(b * SEQ + q0 + q);
        bf16x8v iq[8]; float wi[8];
#pragma unroll
        for (int h = 0; h < 8; ++h) { iq[h] = *(const bf16x8v*)(IQ + qrow * 256 + h * 32 + 8 * kg); wi[h] = IW[qrow * 8 + h]; }
        const int nt = (nvis / 16 - wid + NWAVES - 1) / NWAVES;
        const bf16* ikp = IK + ((size_t)(b * SEQ + wid * 16 + q)) * 32 + 8 * kg;
        bf16x8v af[16];
#pragma unroll
        for (int i = 0; i < 16; ++i) if (i < nt) af[i] = *(const bf16x8v*)(ikp + (size_t)i * (NWAVES * 16 * 32));
#pragma unroll
        for (int i = 0; i < 16; ++i) if (i < nt) {
            f32x4 acc = {0.f, 0.f, 0.f, 0.f};
#pragma unroll
            for (int h = 0; h < 8; ++h) { const f32x4 c = __builtin_amdgcn_mfma_f32_16x16x32_bf16(af[i], iq[h], (f32x4){0.f, 0.f, 0.f, 0.f}, 0, 0, 0);
#pragma unroll
                for (int j = 0; j < 4; ++j) acc[j] += wi[h] * fmaxf(c[j], 0.f); }
            const int col = ((wid + NWAVES * i) * 16 + kg * 4 + 4 * q) & 2047;
            *(LAS f32x4*)(sc + q * 2048 + col) = acc;
        }
    }
    __syncthreads();
    if (VAR != 7) {
        int n64l = n64; asm volatile("" : "+s"(n64l));
        unsigned ua[32], ub[32];
        { const int qa = 2 * wid, qb = 2 * wid + 1; const LAS float* ra = sc + qa * 2048; const LAS float* rb = sc + qb * 2048;
#pragma unroll
          for (int i = 0; i < 32; ++i) { const int e = i * 64 + lane;
              const unsigned ba = __float_as_uint(ra[(e + 4 * qa) & 2047]), bb = __float_as_uint(rb[(e + 4 * qb) & 2047]);
              const unsigned ka = (ba & 0x80000000u) ? ~ba : (ba | 0x80000000u), kb = (bb & 0x80000000u) ? ~bb : (bb | 0x80000000u);
              ua[i] = (i < n64l) ? ka : 0u; ub[i] = (i < n64l) ? kb : 0u; } }
        unsigned Ta = 0u, Tb = 0u; int cTa = nvis, cTb = nvis; bool da = false, db = false;
#pragma unroll 1
        for (int bit = (VAR & 2) ? -1 : 31; bit >= 0; --bit) {
            const unsigned ca = Ta | (1u << bit), cb = Tb | (1u << bit); int xa = 0, xb = 0;
#pragma unroll
            for (int g = 0; g < 4; ++g) if (n64l > 8 * g) {
#pragma unroll
                for (int i = 8 * g; i < 8 * g + 8; ++i) { xa += (ua[i] >= ca) ? 1 : 0; xb += (ub[i] >= cb) ? 1 : 0; } }
            const int na = wave_sum_i(xa), nb = wave_sum_i(xb);
            if (!da && na >= 256) { Ta = ca; cTa = na; if (na == 256) da = true; }
            if (!db && nb >= 256) { Tb = cb; cTb = nb; if (nb == 256) db = true; }
            if (da && db) break;
        }
        if (!(VAR & 4)) select_row(ua, (unsigned)__builtin_amdgcn_readfirstlane((int)Ta), __builtin_amdgcn_readfirstlane(cTa), mrow + (2 * wid) * 32, lane);
        if (!(VAR & 4)) select_row(ub, (unsigned)__builtin_amdgcn_readfirstlane((int)Tb), __builtin_amdgcn_readfirstlane(cTb), mrow + (2 * wid + 1) * 32, lane);
    }
    __syncthreads();
}

__device__ __forceinline__ void a_unit(Frame& F, const Ptrs& P, int b, int h, int qb, float lam) {
    using namespace att; typedef Lds<128> L;
    const bf16_t* AQ = (const bf16_t*)(P.ws + WS_R1); const bf16_t* AK = (const bf16_t*)(P.ws + WS_R1 + 32 * MiB); const bf16_t* AV = (const bf16_t*)(P.ws + WS_R1 + 64 * MiB);
    int tid = threadIdx.x; asm volatile("" : "+v"(tid));
    const int lane = tid & 63, wid = __builtin_amdgcn_readfirstlane(tid >> 6), r32 = lane & 31; const size_t rowbase = (size_t)b * SEQ; const int q0 = qb * 256, qw = q0 + wid * 32, qc = qw >> 6;
    f32x4* stash = (f32x4*)(P.ws + WS_Y) + ((size_t)(blockIdx.x * NWAVES + wid) * 16) * 64 + lane;
    f32x16 o[4];
#pragma unroll 1
    for (int c = 0; c < 2; ++c) {
        const int g = 2 * h + c;
        attn_core<128, 0, 4>(o, F.lds, AQ + (rowbase + qw) * 512 + g * 64, 512, AK + rowbase * 512 + g * 64, 512, AV + rowbase * 512 + h * 128, 512, 0, (q0 >> 6) + 4, 0, qc + 1, nullptr, 0, 0);
        if (c == 0) {
            f32x4* sp = stash; asm volatile("" : "+v"(sp));
#pragma unroll
            for (int d0 = 0; d0 < 4; ++d0)
#pragma unroll
                for (int rq = 0; rq < 4; ++rq) sp[(d0 * 4 + rq) * 64] = (f32x4){o[d0][4 * rq], o[d0][4 * rq + 1], o[d0][4 * rq + 2], o[d0][4 * rq + 3]};
        }
    }
    {
        const f32x4* sp = stash; asm volatile("" : "+v"(sp));
#pragma unroll
        for (int d0 = 0; d0 < 4; ++d0)
#pragma unroll
            for (int rq = 0; rq < 4; ++rq) { const f32x4 a = sp[(d0 * 4 + rq) * 64];
#pragma unroll
                for (int j = 0; j < 4; ++j) o[d0][4 * rq + j] = a[j] - lam * o[d0][4 * rq + j]; }
    }
    float sl[4];
#pragma unroll
    for (int d0 = 0; d0 < 4; ++d0) sl[d0] = P.esub[32 * d0 + r32] * 0.8f;
#pragma unroll
    for (int r = 0; r < 16; ++r) { float s = 0.f;
#pragma unroll
        for (int d0 = 0; d0 < 4; ++d0) s += o[d0][r] * o[d0][r];
        s = sum32(s);
        const float rstd = 1.0f / sqrtf(s * (1.f / 128.f) + RMS_EPS);
#pragma unroll
        for (int d0 = 0; d0 < 4; ++d0) o[d0][r] *= rstd * sl[d0]; }
    store_o<128>(o, F.lds, (bf16_t*)(P.ws + WS_ATT) + (rowbase + qw) * DM + h * 128, DM);
}
__device__ __forceinline__ void b_unit(Frame& F, const Ptrs& P, int b, int h, int qb, int hotmask = -1, int skip = 0) {
    using namespace att;
    const bf16_t* BQ = (const bf16_t*)(P.ws + WS_R1 + 96 * MiB); const bf16_t* BK = (const bf16_t*)(P.ws + WS_R1 + 128 * MiB); const bf16_t* BV = (const bf16_t*)(P.ws + WS_R1 + 160 * MiB);
    int tid = threadIdx.x; asm volatile("" : "+v"(tid));
    const int lane = tid & 63, wid = __builtin_amdgcn_readfirstlane(tid >> 6), r32 = lane & 31; const size_t rowbase = (size_t)b * SEQ; const int q0 = qb * 256, qw = q0 + wid * 32, qc = qw >> 6;
    const unsigned long long* mrow = (const unsigned long long*)(P.ws + WS_MASK) + (rowbase + qw + r32) * 32;
    f32x16 o[2];
    attn_core<64, 1, 4>(o, F.lds, BQ + (rowbase + qw) * 512 + h * 64, 512, BK + rowbase * 512 + h * 64, 512, BV + rowbase * 512 + h * 64, 512, 0, (q0 >> 6) + 4, 0, qc + 1, mrow, 0, 0, hotmask, skip);
    store_o<64>(o, F.lds, (bf16_t*)(P.ws + WS_ATT) + (rowbase + qw) * DM + 512 + h * 64, DM);
}
__device__ __forceinline__ void c_unit(Frame& F, const Ptrs& P, int b, int h, int qb) {
    using namespace att; typedef Lds<64> L;
    const bf16_t* CQ = (const bf16_t*)(P.ws + WS_R1); const bf16_t* CK = (const bf16_t*)(P.ws + WS_R1 + 64 * MiB); const bf16_t* CV = (const bf16_t*)(P.ws + WS_R1 + 128 * MiB);
    int tid = threadIdx.x; asm volatile("" : "+v"(tid));
    const int lane = tid & 63, wid = __builtin_amdgcn_readfirstlane(tid >> 6), r32 = lane & 31; const size_t rowbase = (size_t)b * SEQ; const int q0 = qb * 256, qw = q0 + wid * 32, qc = qw >> 6;
    LAS float* bt = (LAS float*)(F.lds + L::OFF_BT);
    for (int i = tid; i < 640; i += NWAVES * 64) bt[i] = P.obias[h * 320 + (i < 319 ? i : 319)] * LOG2E;
    const int c0 = q0 >> 6, T0 = c0 - 8 > 0 ? c0 - 8 : 0, tw0 = qc - 8 > 0 ? qc - 8 : 0;
    f32x16 o[2];
    attn_core<64, 2, 4>(o, F.lds, CQ + (rowbase + qw) * DM + h * 64, DM, CK + rowbase * DM + h * 64, DM, CV + rowbase * DM + h * 64, DM, T0, c0 + 4, tw0, qc + 1, nullptr, qw + r32, qc);
    store_o<64>(o, F.lds, (bf16_t*)(P.ws + WS_ATT) + (rowbase + qw) * DM + h * 64, DM);
}

#ifndef DBG_NO_IDX
#define DBG_NO_IDX 0
#endif
#ifndef DBG_NO_A
#define DBG_NO_A 0
#endif
#ifndef DBG_NO_B
#define DBG_NO_B 0
#endif
#ifndef DBG_STAGES
#define DBG_STAGES 99
#endif
struct Args { const float* in[12]; float* out; unsigned char* ws; };
__global__ void __launch_bounds__(NWAVES * 64, 2) fwd_kernel(Args args) {
    extern __shared__ __attribute__((aligned(16))) unsigned char lds[];
    Frame F;
    F.lds = (LAS unsigned char*)lds; F.MISC = (volatile LAS unsigned*)(F.lds + MISC_OFF);
    F.tid = threadIdx.x; F.lane = F.tid & 63; F.wave = __builtin_amdgcn_readfirstlane(F.tid >> 6);
    F.G = gridDim.x; { const int bx = blockIdx.x; F.vcu = (F.G % 8 == 0) ? (bx % 8) * (F.G / 8) + bx / 8 : bx; }
    Ptrs P; P.x = args.in[0]; P.norm_g = args.in[1]; P.wg = args.in[2]; P.wu = args.in[3]; P.wd = args.in[4]; P.ewin = args.in[5]; P.ewout = args.in[6]; P.elam = args.in[7]; P.esub = args.in[8];
    P.owin = args.in[9]; P.owout = args.in[10]; P.obias = args.in[11]; P.out = args.out; P.ws = args.ws;
    F.ctl = (gu32*)(P.ws + WS_CTL);
    for (int u = F.tid; u < (LDS_BYTES - LDSCTL_OFF) / 4; u += NWAVES * 64) ((LAS unsigned*)(F.lds + LDSCTL_OFF))[u] = 0u;
    __syncthreads();
    XcdBarrier bar = xcd_barrier_post((unsigned*)(F.ctl + CW_BAR), F.MISC + 8);
#define GRID_BAR() xcd_barrier(bar)
    bf16* XB = (bf16*)(P.ws + WS_XB); const float* RS = (const float*)(P.ws + WS_RS); bf16* HID = (bf16*)(P.ws + WS_R1); bf16* Y = (bf16*)(P.ws + WS_Y); const bf16* ATT = (const bf16*)(P.ws + WS_ATT);

    p0_prologue(F, P); GRID_BAR();

#define FFN_PHASES(l, f, LAST_) do { \
        { pg8::Gemm g{XB, (const bf16*)(P.ws + WS_WGU + (2 * (l) + (f)) * WGU_BYTES), MROWS, NGU, DM}; pg8::StaticOrder S; S.init(MROWS, NGU, F.G, (int)blockIdx.x); \
          epi::EpiSwiGLU E{HID, RS}; for (int rep_ = 0; rep_ < PROBE_REP_GU; ++rep_) pg8::gemm_phase<epi::EpiSwiGLU, pg8::StaticOrder, true, true>(F.lds, g, S, E); \
          if (PROBE_NULL_GU) { epi::EpiNull EN; for (int rep_ = 0; rep_ < PROBE_NULL_GU; ++rep_) pg8::gemm_phase<epi::EpiNull, pg8::StaticOrder, true, true>(F.lds, g, S, EN); } } \
        GRID_BAR(); \
        { pg8::Gemm g{HID, (const bf16*)(P.ws + WS_WD + (2 * (l) + (f)) * WD_BYTES), MROWS, DM, FF}; pg8::StaticOrder S; S.init(MROWS, DM, F.G, (int)blockIdx.x); \
          epi::EpiBf16Y E{Y}; for (int rep_ = 0; rep_ < PROBE_REP_DN; ++rep_) pg8::gemm_phase<epi::EpiBf16Y, pg8::StaticOrder, true, true>(F.lds, g, S, E); \
          if (PROBE_NULL_DN) { epi::EpiNull EN; for (int rep_ = 0; rep_ < PROBE_NULL_DN; ++rep_) pg8::gemm_phase<epi::EpiNull, pg8::StaticOrder, true, true>(F.lds, g, S, EN); } } \
        GRID_BAR(); \
        thin_phase<LAST_>(F, P, P.norm_g + ((l) * 6 + 4 * (f) + 1) * DM, 0.5f); \
        if (!(LAST_)) GRID_BAR(); } while (0)

    FFN_PHASES(0, 0, false);
    if (DBG_STAGES >= 2) {
        { pg8::Gemm g{XB, (const bf16*)(P.ws + WS_WIN0), MROWS, NEV, DM}; pg8::StaticOrder S; S.init(MROWS, NEV, F.G, (int)blockIdx.x);
          unsigned char* r1 = P.ws + WS_R1;
          epi::EpiProjEven E{(bf16*)r1, (bf16*)(r1 + 192 * MiB), (bf16*)(r1 + 208 * MiB),
                             (float*)(r1 + 210 * MiB), RS, (const float*)(P.ws + WS_C64), (const float*)(P.ws + WS_S64), (const float*)(P.ws + WS_C32), (const float*)(P.ws + WS_S32)};
          pg8::gemm_phase<epi::EpiProjEven, pg8::StaticOrder, true, true>(F.lds, g, S, E); }
        GRID_BAR();
#ifdef PROBE_IDX_VAR
        for (int p = F.vcu; p < 1024; p += F.G) { const int b = p >> 6, j = p & 63;
#pragma unroll 1
            for (int k = 0; k < 2; ++k) indexer_unit<PROBE_IDX_VAR>(F, P, b, k ? 127 - j : j); }
#endif
        for (int rep_ = 0; rep_ < PROBE_REP_IDXA * PROBE_REP_IDX; ++rep_)
        for (int p = F.vcu; p < 1024; p += F.G) { const int b = p >> 6, j = p & 63;
#pragma unroll 1
            for (int k = 0; k < 2; ++k) { if (!DBG_NO_IDX) indexer_unit<0>(F, P, b, k ? 127 - j : j); } }
        {
            float l01 = 0.f, l23 = 0.f;
            for (int i = 0; i < 64; ++i) { l01 += P.elam[i] * P.elam[64 + i]; l23 += P.elam[128 + i] * P.elam[192 + i]; }
            const float lam = expf(l01) - expf(l23) + 0.2f;
            for (int rep_ = 0; rep_ < PROBE_REP_IDXA; ++rep_)
            for (int p = F.vcu; p < 256; p += F.G) { const int bh = p >> 2, s = p & 3;
#pragma unroll 1
                for (int k = 0; k < 2; ++k) { if (!DBG_NO_A) a_unit(F, P, bh >> 2, bh & 3, k ? 7 - s : s, lam); } }
        }
        GRID_BAR();
        for (int rep_ = 0; rep_ < PROBE_REP_B; ++rep_)
        for (int p = F.vcu; p < 512; p += F.G) { const int bh = p >> 2, s = p & 3;
#pragma unroll 1
            for (int k = 0; k < 2; ++k) { if (!DBG_NO_B) b_unit(F, P, bh >> 3, bh & 7, k ? 7 - s : s, (PROBE_B_HOT && rep_ + 1 < PROBE_REP_B) ? 0 : -1, (rep_ + 1 < PROBE_REP_B) ? PROBE_B_SKIP : 0); } }
        GRID_BAR();
        { pg8::Gemm g{ATT, (const bf16*)(P.ws + WS_WOUT0), MROWS, DM, DM}; pg8::StaticOrder S; S.init(MROWS, DM, F.G, (int)blockIdx.x);
          epi::EpiBf16Y E{Y}; pg8::gemm_phase<epi::EpiBf16Y, pg8::StaticOrder, true, true>(F.lds, g, S, E); }
        GRID_BAR();
        thin_phase<false>(F, P, P.norm_g + (0 * 6 + 3) * DM, 1.0f);
        GRID_BAR();
    }
    if (DBG_STAGES >= 3) FFN_PHASES(0, 1, false);
    if (DBG_STAGES >= 4) FFN_PHASES(1, 0, false);
    if (DBG_STAGES >= 5) {
        { pg8::Gemm g{XB, (const bf16*)(P.ws + WS_WIN1), MROWS, NOD, DM}; pg8::StaticOrder S; S.init(MROWS, NOD, F.G, (int)blockIdx.x);
          unsigned char* r1 = P.ws + WS_R1; epi::EpiProjOdd E{(bf16*)r1, RS};
          pg8::gemm_phase<epi::EpiProjOdd, pg8::StaticOrder, true, true>(F.lds, g, S, E); }
        GRID_BAR();
        for (int rep_ = 0; rep_ < PROBE_REP_C; ++rep_)
        for (int p = F.vcu; p < 256; p += F.G) { const int b = p >> 4, h = p & 15;
#pragma unroll 1
            for (int qb = 0; qb < 8; ++qb) c_unit(F, P, b, h, qb); }
        GRID_BAR();
        { pg8::Gemm g{ATT, (const bf16*)(P.ws + WS_WOUT1), MROWS, DM, DM}; pg8::StaticOrder S; S.init(MROWS, DM, F.G, (int)blockIdx.x);
          epi::EpiBf16Y E{Y}; pg8::gemm_phase<epi::EpiBf16Y, pg8::StaticOrder, true, true>(F.lds, g, S, E); }
        GRID_BAR();
        thin_phase<false>(F, P, P.norm_g + (1 * 6 + 3) * DM, 1.0f);
        GRID_BAR();
    }
    if (DBG_STAGES >= 6) FFN_PHASES(1, 1, true);
}

extern "C" void kernel_launch(void* const* d_in, const int* in_sizes, int n_in, void* d_out, int out_size, void* d_ws, size_t ws_size, hipStream_t stream) {
    static int grid = 0;
    if (grid == 0) {
        if (n_in != 12 || in_sizes[0] != MROWS * DM || out_size != MROWS * DM || ws_size < WS_END) {
            fprintf(stderr, "kernel_launch: unexpected shapes / workspace (n_in %d, in0 %d, out %d, ws %zu, need %zu); nothing launched\n", n_in, n_in > 0 ? in_sizes[0] : -1, out_size, ws_size, (size_t)WS_END); grid = -1; return; }
        int dev = 0, cus = 0, per_cu = 0;
        if (hipGetDevice(&dev) != hipSuccess || hipDeviceGetAttribute(&cus, hipDeviceAttributeMultiprocessorCount, dev) != hipSuccess) { fprintf(stderr, "kernel_launch: device query failed\n"); grid = -1; return; }
        if (hipFuncSetAttribute((const void*)fwd_kernel, hipFuncAttributeMaxDynamicSharedMemorySize, LDS_BYTES) != hipSuccess) { fprintf(stderr, "kernel_launch: hipFuncSetAttribute failed\n"); grid = -1; return; }
        if (hipOccupancyMaxActiveBlocksPerMultiprocessor(&per_cu, (const void*)fwd_kernel, NWAVES * 64, LDS_BYTES) != hipSuccess || per_cu < 1)
            fprintf(stderr, "kernel_launch: note: occupancy query reports %d workgroups per CU\n", per_cu);
        (void)hipGetLastError();
        grid = cus;
    }
    if (grid < 0) return;
    if (hipMemsetAsync((char*)d_ws + WS_CTL, 0, CTL_ZERO_BYTES, stream) != hipSuccess) { fprintf(stderr, "kernel_launch: memset failed\n"); return; }
    Args a{};
    for (int i = 0; i < 12; ++i) a.in[i] = (const float*)d_in[i];
    a.out = (float*)d_out; a.ws = (unsigned char*)d_ws;
    hipLaunchKernelGGL(fwd_kernel, dim3(grid), dim3(NWAVES * 64), LDS_BYTES, stream, a);
    const hipError_t le = hipPeekAtLastError();
    if (le != hipSuccess) fprintf(stderr, "kernel_launch: launch failed: %s\n", hipGetErrorName(le));
}
```

```cpp
#include <hip/hip_runtime.h>
#include <cstdio>
#include <cstdint>
namespace pg8 {
#define PG8_LAS __attribute__((address_space(3)))
typedef unsigned short bf16_t;
typedef short bf16x8 __attribute__((ext_vector_type(8)));
typedef float f32x4 __attribute__((ext_vector_type(4)));
typedef unsigned u32x4 __attribute__((ext_vector_type(4)));
constexpr int BM = 256, BK = 64, HALF = 128, HTB = HALF * BK * 2  , STAGE_BYTES = 8 * HTB, NXCD = 8, WGM = 8;

__host__ __device__ __forceinline__ int lds_byte(int r, int c) { const int st = (r >> 4) * 2 + (c >> 5), rr = r & 15, cc = c & 31, ob = rr * 64 + cc * 2; return st * 1024 + (ob ^ (((ob >> 9) & 1) << 5)); }
__host__ __device__ __forceinline__ void stage_rc(int b, int& R, int& C) { const int st = b / 1024, sb = b % 1024, swz = sb ^ (((sb >> 9) & 1) << 5); R = (st >> 1) * 16 + swz / 64; C = (st & 1) * 32 + (swz % 64) / 2; }
__host__ __device__ __forceinline__ int perm32(int rho) { const int n = rho >> 4, i = rho & 15; return 8 * (i >> 2) + 4 * n + (i & 3); }

struct Unit { int pm, pn; };
struct Gemm { const bf16_t* A; const bf16_t* Bt; int M, N, K; };

struct StaticOrder {
    int nM, nN, nwg, G, c;
    __host__ __device__ void init(int M, int N, int G_, int c_) { nM = M / BM; nN = N / BM; nwg = nM * nN; G = G_; c = c_; }
    __host__ __device__ bool next(int i, Unit& u) const {
        const long L = (long)i * G + c; if (L >= nwg) return false;
        int wgid = (int)L; { const int q = nwg / NXCD, r = nwg % NXCD, xcd = wgid % NXCD, off = wgid / NXCD; wgid = (xcd < r ? xcd * (q + 1) : r * (q + 1) + (xcd - r) * q) + off; }
        const int nig = WGM * nN, gid = wgid / nig, fm = gid * WGM, gsz = (nM - fm) < WGM ? (nM - fm) : WGM;
        u.pm = fm + ((wgid % nig) % gsz); u.pn = (wgid % nig) / gsz; return true;
    }
    __device__ __forceinline__ void a_ready(const Unit&) const {}
    __device__ __forceinline__ void done(const Unit&) const {}
};

__device__ __forceinline__ unsigned cvt_pk_bf16(float lo, float hi) { unsigned r; asm volatile("v_cvt_pk_bf16_f32 %0, %1, %2" : "=v"(r) : "v"(lo), "v"(hi)); return r; }
typedef float f32x2 __attribute__((ext_vector_type(2)));
__device__ __forceinline__ f32x2 gelu_pk(f32x2 v) {
    const f32x2 av = __builtin_elementwise_abs(v), d = av * 0.2316418882f + 1.0f;
    f32x2 t; t.x = __builtin_amdgcn_rcpf(d.x); t.y = __builtin_amdgcn_rcpf(d.y);
    f32x2 q = t * 0.5307027145f + (-0.7265760135f); q = q * t + 0.7107068705f; q = q * t + (-0.142248368f); q = q * t + 0.127414796f; q = q * t;
    const f32x2 s = (v * v) * (-0.72134752044f);
    f32x2 e; e.x = __builtin_amdgcn_exp2f(s.x); e.y = __builtin_amdgcn_exp2f(s.y);
    const f32x2 m = v * (q * e), r = v - m;
    f32x2 o; o.x = v.x < 0.f ? m.x : r.x; o.y = v.y < 0.f ? m.y : r.y; return o;
}

template <int ACT  > struct EpiBf16 {
    static constexpr bool PERM = true, AFTER_DRAIN = false; static_assert(ACT == 0 || ACT == 1, "EpiBf16: ACT is 0 (none) or 1 (gelu_pk)");
    bf16_t* O; int ldc; const float* bias; int split_cols; size_t split_stride; float scale0;
    __device__ __forceinline__ void operator()(const f32x4 (&acc)[2][2][4][2], const Unit& u, int wr, int wc, int fr, int fq) const {
        const int row0 = u.pm * BM + wr * 64 + fr; int colt = u.pn * BM; bf16_t* base = O;
        float sc = 1.f; if (split_cols) { const int t = colt / split_cols; base += (size_t)t * split_stride; colt -= t * split_cols; if (t == 0) sc = scale0; }
        const int col0 = colt + wc * 32 + 8 * fq, bcol0 = u.pn * BM + wc * 32 + 8 * fq;
        f32x4 bv[2][2];
#pragma unroll
        for (int bj = 0; bj < 2; ++bj)
#pragma unroll
            for (int n = 0; n < 2; ++n) bv[bj][n] = bias ? *(const f32x4*)(bias + bcol0 + bj * HALF + 4 * n) : (f32x4){0.f, 0.f, 0.f, 0.f};
#pragma unroll
        for (int ai = 0; ai < 2; ++ai)
#pragma unroll
            for (int m = 0; m < 4; ++m) { bf16_t* rowp = base + (size_t)(row0 + ai * HALF + m * 16) * ldc + col0;
#pragma unroll
                for (int bj = 0; bj < 2; ++bj) { f32x4 v0 = acc[ai][bj][m][0] + bv[bj][0], v1 = acc[ai][bj][m][1] + bv[bj][1];
                    if (ACT == 1) { f32x2 a = gelu_pk((f32x2){v0[0], v0[1]}), b = gelu_pk((f32x2){v0[2], v0[3]}), c = gelu_pk((f32x2){v1[0], v1[1]}), d = gelu_pk((f32x2){v1[2], v1[3]});
                        v0 = (f32x4){a.x, a.y, b.x, b.y}; v1 = (f32x4){c.x, c.y, d.x, d.y}; }
                    v0 = v0 * sc; v1 = v1 * sc; u32x4 w; w.x = cvt_pk_bf16(v0[0], v0[1]); w.y = cvt_pk_bf16(v0[2], v0[3]); w.z = cvt_pk_bf16(v1[0], v1[1]); w.w = cvt_pk_bf16(v1[2], v1[3]);
                    *(u32x4*)(rowp + bj * HALF) = w; } }
    }
};

struct PanelStats {
    unsigned* xbuf;
    unsigned* cnt;
    unsigned* tmo;
    int ntn; float eps;
    unsigned code;
    __device__ __forceinline__ bool run(const f32x4 (&v)[2][2][4][2], const Unit& u, int wr, int wc, int fr, int fq, PG8_LAS unsigned char* lds, int wid, int lane) const {
        typedef float f32x2v __attribute__((ext_vector_type(2)));
        PG8_LAS f32x2v* P = (PG8_LAS f32x2v*)lds;
        PG8_LAS f32x2v* S = (PG8_LAS f32x2v*)(lds + 8192);
        PG8_LAS unsigned* flag = (PG8_LAS unsigned*)(lds + 8192 + 2048);
#pragma unroll
        for (int ai = 0; ai < 2; ++ai)
#pragma unroll
            for (int m = 0; m < 4; ++m) {
                float s = 0.f;
#pragma unroll
                for (int bj = 0; bj < 2; ++bj)
#pragma unroll
                    for (int n = 0; n < 2; ++n) { const f32x4 x = v[ai][bj][m][n]; s += (x[0] + x[1]) + (x[2] + x[3]); }
                s += __shfl_xor(s, 16); s += __shfl_xor(s, 32);
                const float mw = s * (1.0f / 64.0f); float q = 0.f;
#pragma unroll
                for (int bj = 0; bj < 2; ++bj)
#pragma unroll
                    for (int n = 0; n < 2; ++n) { const f32x4 d = v[ai][bj][m][n] - mw; q += (d[0] * d[0] + d[1] * d[1]) + (d[2] * d[2] + d[3] * d[3]); }
                q += __shfl_xor(q, 16); q += __shfl_xor(q, 32);
                if (fq == 0) P[(ai * HALF + wr * 64 + m * 16 + fr) * 4 + wc] = (f32x2v){mw, q};
            }
        asm volatile("s_waitcnt lgkmcnt(0)" ::: "memory"); __builtin_amdgcn_s_barrier(); asm volatile("" ::: "memory");
#if defined(BROKEN_EXCHANGE_NO_WAIT)
#warning BROKEN CONTROL BUILD: the row-statistics exchange does not wait; results are wrong by design
        if (blockIdx.x >= 64) { const long long t0_ = clock64(); while (clock64() - t0_ < 60000) __builtin_amdgcn_s_sleep(8); }
#endif
        const int row = wid * 32 + (lane & 31);
        if (lane < 32) {
            const f32x2v a = P[row * 4 + 0], b = P[row * 4 + 1], c = P[row * 4 + 2], d = P[row * 4 + 3];
            const float mt = (a.x + b.x + c.x + d.x) * 0.25f;
            const float da = a.x - mt, db = b.x - mt, dc = c.x - mt, dd = d.x - mt;
            const float m2 = (a.y + b.y) + (c.y + d.y) + 64.0f * ((da * da + db * db) + (dc * dc + dd * dd));
            unsigned long long* slot = (unsigned long long*)xbuf + ((size_t)(u.pm * BM + row) * 4 + u.pn);
            __hip_atomic_store(slot, ((unsigned long long)__float_as_uint(m2) << 32) | __float_as_uint(mt), __ATOMIC_RELAXED, __HIP_MEMORY_SCOPE_AGENT);
        }
        asm volatile("s_waitcnt vmcnt(0)" ::: "memory");
        if (lane == 0) __hip_atomic_fetch_add(cnt + 64 * u.pm, 1u, __ATOMIC_RELAXED, __HIP_MEMORY_SCOPE_AGENT);
        if (wid == 0) {
            bool dead = false; const unsigned long long t0 = __builtin_amdgcn_s_memrealtime(); const unsigned want = 8u * (unsigned)ntn;
            for (;;) {
#if defined(BROKEN_EXCHANGE_NO_WAIT)
                break;
#endif
                if ((unsigned)__builtin_amdgcn_readfirstlane(__hip_atomic_load(cnt + 64 * u.pm, __ATOMIC_RELAXED, __HIP_MEMORY_SCOPE_AGENT)) >= want) break;
                if (__builtin_amdgcn_s_memrealtime() - t0 > 2000000ull) {
                    if (lane == 0) { unsigned expect = 0u; __hip_atomic_compare_exchange_strong(tmo + 1, &expect, code | (unsigned)(u.pm & 0xff), __ATOMIC_RELAXED, __ATOMIC_RELAXED, __HIP_MEMORY_SCOPE_AGENT);
                                     __hip_atomic_store(tmo, 1u, __ATOMIC_RELAXED, __HIP_MEMORY_SCOPE_AGENT); }
                    dead = true; break; }
                __builtin_amdgcn_s_sleep(2);
            }
            __builtin_amdgcn_fence(__ATOMIC_ACQUIRE, "agent");
            if (lane == 0) flag[0] = dead ? 1u : 0u;
        }
        asm volatile("s_waitcnt vmcnt(0) lgkmcnt(0)" ::: "memory"); __builtin_amdgcn_s_barrier(); asm volatile("" ::: "memory");
        const bool bad = flag[0] != 0u;
        if (lane < 32) {
            const unsigned long long* slot = (const unsigned long long*)xbuf + (size_t)(u.pm * BM + row) * 4; float mt[4], m2[4]; float ms = 0.f;
#pragma unroll
            for (int t = 0; t < 4; ++t) { if (t < ntn) { const unsigned long long w = __hip_atomic_load(slot + t, __ATOMIC_RELAXED, __HIP_MEMORY_SCOPE_AGENT); mt[t] = __uint_as_float((unsigned)w); m2[t] = __uint_as_float((unsigned)(w >> 32)); } else { mt[t] = 0.f; m2[t] = 0.f; } ms += mt[t]; }
            const float mean = ms / (float)ntn; float q = 0.f;
#pragma unroll
            for (int t = 0; t < 4; ++t) if (t < ntn) { const float dm = mt[t] - mean; q += m2[t] + 256.0f * dm * dm; }
            S[row] = (f32x2v){mean, 1.0f / sqrtf(q / (256.0f * (float)ntn) + eps)};
        }
        asm volatile("s_waitcnt lgkmcnt(0)" ::: "memory"); __builtin_amdgcn_s_barrier(); asm volatile("" ::: "memory");
        return bad;
    }
};
struct EpiLnRes {
    static constexpr bool PERM = false, AFTER_DRAIN = true;
    const float* base; float* out; int ldc; const float* bias; PanelStats st; unsigned poison;
    __device__ __forceinline__ void fused(f32x4 (&acc)[2][2][4][2], const Unit& u, int wr, int wc, int fr, int fq, PG8_LAS unsigned char* lds, int wid, int lane) const {
        typedef float f32x2v __attribute__((ext_vector_type(2)));
        const PG8_LAS f32x2v* S = (const PG8_LAS f32x2v*)(lds + 8192);
        const int col0 = u.pn * BM + wc * 32 + 4 * fq;
#pragma unroll
        for (int bj = 0; bj < 2; ++bj)
#pragma unroll
            for (int n = 0; n < 2; ++n) { const f32x4 bv = bias ? *(const f32x4*)(bias + col0 + bj * HALF + n * 16) : (f32x4){0.f, 0.f, 0.f, 0.f};
#pragma unroll
                for (int ai = 0; ai < 2; ++ai)
#pragma unroll
                    for (int m = 0; m < 4; ++m) acc[ai][bj][m][n] += bv; }
        f32x4 pre[4][2][2];
#pragma unroll
        for (int m = 0; m < 4; ++m) { const size_t off = (size_t)(u.pm * BM + wr * 64 + m * 16 + fr) * ldc + col0;
#pragma unroll
            for (int bj = 0; bj < 2; ++bj)
#pragma unroll
                for (int n = 0; n < 2; ++n) pre[m][bj][n] = *(const f32x4*)(base + off + bj * HALF + n * 16); }
        const bool bad = st.run(acc, u, wr, wc, fr, fq, lds, wid, lane) || poison != 0u;
        const float qnan = __builtin_nanf("");
#pragma unroll
        for (int ai = 0; ai < 2; ++ai)
#pragma unroll
            for (int m = 0; m < 4; ++m) { const int r = ai * HALF + wr * 64 + m * 16 + fr; const f32x2v sr = S[r]; const size_t off = (size_t)(u.pm * BM + r) * ldc + col0;
#pragma unroll
                for (int bj = 0; bj < 2; ++bj)
#pragma unroll
                    for (int n = 0; n < 2; ++n) { const f32x4 bs = ai == 0 ? pre[m][bj][n] : *(const f32x4*)(base + off + bj * HALF + n * 16); f32x4 o = bs + (acc[ai][bj][m][n] - sr.x) * sr.y;
                        if (bad) o = (f32x4){qnan, qnan, qnan, qnan}; *(f32x4*)(out + off + bj * HALF + n * 16) = o; }
                if (m & 1) asm volatile("" ::: "memory"); }
    }
};
struct EpiLnResLn {
    static constexpr bool PERM = false, AFTER_DRAIN = true;
    const float* base; float* out; bf16_t* xn; int ldc; const float* bias; PanelStats st1, st2; unsigned poison;
    __device__ __forceinline__ void fused(f32x4 (&acc)[2][2][4][2], const Unit& u, int wr, int wc, int fr, int fq, PG8_LAS unsigned char* lds, int wid, int lane) const {
        typedef float f32x2v __attribute__((ext_vector_type(2))); typedef unsigned u32x2v __attribute__((ext_vector_type(2)));
        const PG8_LAS f32x2v* S = (const PG8_LAS f32x2v*)(lds + 8192);
        const int col0 = u.pn * BM + wc * 32 + 4 * fq;
#pragma unroll
        for (int bj = 0; bj < 2; ++bj)
#pragma unroll
            for (int n = 0; n < 2; ++n) { const f32x4 bv = bias ? *(const f32x4*)(bias + col0 + bj * HALF + n * 16) : (f32x4){0.f, 0.f, 0.f, 0.f};
#pragma unroll
                for (int ai = 0; ai < 2; ++ai)
#pragma unroll
                    for (int m = 0; m < 4; ++m) acc[ai][bj][m][n] += bv; }
        bool bad = st1.run(acc, u, wr, wc, fr, fq, lds, wid, lane) || poison != 0u;
        const float qnan = __builtin_nanf("");
#pragma unroll
        for (int ai = 0; ai < 2; ++ai)
#pragma unroll
            for (int m = 0; m < 4; ++m) { const int r = ai * HALF + wr * 64 + m * 16 + fr; const f32x2v sr = S[r]; const size_t off = (size_t)(u.pm * BM + r) * ldc + col0;
#pragma unroll
                for (int bj = 0; bj < 2; ++bj)
#pragma unroll
                    for (int n = 0; n < 2; ++n) { const f32x4 bs = *(const f32x4*)(base + off + bj * HALF + n * 16); acc[ai][bj][m][n] = bs + (acc[ai][bj][m][n] - sr.x) * sr.y; }
                asm volatile("" : "+v"(acc[ai][0][m][0]), "+v"(acc[ai][0][m][1]), "+v"(acc[ai][1][m][0]), "+v"(acc[ai][1][m][1]));
                if (m & 1) asm volatile("" ::: "memory"); }
        const bool bad1 = bad;
        bad = st2.run(acc, u, wr, wc, fr, fq, lds, wid, lane) || bad;
#pragma unroll
        for (int ai = 0; ai < 2; ++ai)
#pragma unroll
            for (int m = 0; m < 4; ++m) { const int r = ai * HALF + wr * 64 + m * 16 + fr; const f32x2v sr = S[r]; const size_t off = (size_t)(u.pm * BM + r) * ldc + col0;
#pragma unroll
                for (int bj = 0; bj < 2; ++bj)
#pragma unroll
                    for (int n = 0; n < 2; ++n) { const f32x4 x1 = acc[ai][bj][m][n]; *(f32x4*)(out + off + bj * HALF + n * 16) = bad1 ? (f32x4){qnan, qnan, qnan, qnan} : x1;
                        const f32x4 o = (x1 - sr.x) * sr.y; u32x2v w; w.x = cvt_pk_bf16(o[0], o[1]); w.y = cvt_pk_bf16(o[2], o[3]);
                        if (bad) { w.x = 0x7fc07fc0u; w.y = 0x7fc07fc0u; } *(u32x2v*)(xn + off + bj * HALF + n * 16) = w; }
                asm volatile("" ::: "memory"); }
    }
};

template <class Epi, class Sched, bool ALIGN_EPI = false, bool SP2 = false>
__device__ __forceinline__ void gemm_phase(PG8_LAS unsigned char* lds, const Gemm g, const Sched& S, const Epi& E) {
    int tid_ = threadIdx.x; asm volatile("" : "+v"(tid_));
    const int tid = tid_, wid = __builtin_amdgcn_readfirstlane(tid >> 6), lane = tid & 63, wr = wid >> 2, wc = wid & 3, fr = lane & 15, fq = lane >> 4;
    const int K = g.K, nt = K / BK;
    unsigned voffA[2], voffB[2];
#pragma unroll
    for (int i = 0; i < 2; ++i) { int R, C; stage_rc(tid * 16 + i * 8192, R, C); const int Rb = Epi::PERM ? ((R & ~31) + perm32(R & 31)) : R;
        voffA[i] = (unsigned)(R * K + C) * 2u; voffB[i] = (unsigned)(Rb * K + C) * 2u; }
    const size_t kstep = (size_t)(BK * 2);
    const size_t hstep = (size_t)HALF * K * 2;
    const size_t tstep = 2 * hstep;
    const unsigned ldsw = (unsigned)wid * 1024u;
    const int aoff = lds_byte(wr * 64 + fr, fq * 8), boff = lds_byte(wc * 32 + fr, fq * 8);
#define PG8_SA(b, h) (((b) * 2 + (h)) * HTB)
#define PG8_SB(b, h) ((4 + (b) * 2 + (h)) * HTB)
#define PG8_STAGE(bufoff, gbase, voff) do { _Pragma("unroll") for (int _i = 0; _i < 2; ++_i) \
        __builtin_amdgcn_global_load_lds((const unsigned*)((const char*)(gbase) + (voff)[_i]), (PG8_LAS unsigned*)(lds + (bufoff) + ldsw + _i * 8192), 16, 0, 0); } while (0)
#define PG8_LDA(dst, b, h) do { _Pragma("unroll") for (int m = 0; m < 4; ++m) _Pragma("unroll") for (int k = 0; k < 2; ++k) dst[m][k] = *(const PG8_LAS bf16x8*)(lds + PG8_SA(b, h) + aoff + m * 2048 + k * 1024); } while (0)
#define PG8_LDB(dst, b, h) do { _Pragma("unroll") for (int n = 0; n < 2; ++n) _Pragma("unroll") for (int k = 0; k < 2; ++k) dst[n][k] = *(const PG8_LAS bf16x8*)(lds + PG8_SB(b, h) + boff + n * 2048 + k * 1024); } while (0)
#define PG8_MMA(ai, bj, At, Bt) do { __builtin_amdgcn_s_setprio(1); _Pragma("unroll") for (int m = 0; m < 4; ++m) _Pragma("unroll") for (int n = 0; n < 2; ++n) _Pragma("unroll") for (int k = 0; k < 2; ++k) \
        acc[ai][bj][m][n] = __builtin_amdgcn_mfma_f32_16x16x32_bf16(Bt[n][k], At[m][k], acc[ai][bj][m][n], 0, 0, 0); __builtin_amdgcn_s_setprio(0); } while (0)
#define PG8_WAIT_V(n) asm volatile("s_waitcnt vmcnt(" #n ")" ::: "memory")
#define PG8_WAIT_L(n) asm volatile("s_waitcnt lgkmcnt(" #n ")" ::: "memory")
#define PG8_BAR __builtin_amdgcn_s_barrier()
#define PG8_SCHED __builtin_amdgcn_sched_barrier(0)
    Unit cur, nxt; int ui = 0;
    if (!S.next(0, cur)) return;
    f32x4 acc[2][2][4][2];
#pragma unroll
    for (int a = 0; a < 2; ++a)
#pragma unroll
        for (int b = 0; b < 2; ++b)
#pragma unroll
            for (int m = 0; m < 4; ++m)
#pragma unroll
                for (int n = 0; n < 2; ++n) acc[a][b][m][n] = (f32x4){0.f, 0.f, 0.f, 0.f};
    bf16x8 At[4][2], B0[2][2], B1[2][2];
    const char* cA = (const char*)g.A + (size_t)cur.pm * tstep; const char* cB = (const char*)g.Bt + (size_t)cur.pn * tstep;
    S.a_ready(cur);
    if constexpr (SP2) {
        PG8_STAGE(PG8_SB(0, 0), cB, voffB); PG8_STAGE(PG8_SB(0, 1), cB + hstep, voffB); PG8_STAGE(PG8_SA(0, 0), cA, voffA); PG8_STAGE(PG8_SA(0, 1), cA + hstep, voffA);
        if (wr == 1) PG8_BAR;
        PG8_WAIT_V(2); PG8_BAR;
        PG8_STAGE(PG8_SB(1, 0), cB + kstep, voffB); PG8_STAGE(PG8_SA(1, 0), cA + kstep, voffA); PG8_STAGE(PG8_SB(1, 1), cB + hstep + kstep, voffB);
        PG8_WAIT_V(6); PG8_BAR;
    } else {
        PG8_STAGE(PG8_SB(0, 0), cB, voffB); PG8_STAGE(PG8_SA(0, 0), cA, voffA); PG8_STAGE(PG8_SB(0, 1), cB + hstep, voffB); PG8_STAGE(PG8_SA(0, 1), cA + hstep, voffA);
        if (wr == 1) PG8_BAR;
        PG8_WAIT_V(4); PG8_BAR;
        PG8_STAGE(PG8_SB(1, 0), cB + kstep, voffB); PG8_STAGE(PG8_SA(1, 0), cA + kstep, voffA); PG8_STAGE(PG8_SB(1, 1), cB + hstep + kstep, voffB);
        PG8_WAIT_V(6); PG8_BAR;
    }
    for (;;) {
        const bool has_next = S.next(ui + 1, nxt);
        const char* nA = has_next ? (const char*)g.A + (size_t)nxt.pm * tstep : cA; const char* nB = has_next ? (const char*)g.Bt + (size_t)nxt.pn * tstep : cB;
        for (int t = 0; t < nt; t += 2) {
            const bool last = (t == nt - 2);
            const char* a1 = cA + (size_t)(t + 1) * kstep;
            const char* a2 = last ? nA : cA + (size_t)(t + 2) * kstep; const char* b2 = last ? nB : cB + (size_t)(t + 2) * kstep;
            const char* a3 = a2 + kstep; const char* b3 = b2 + kstep;
            if (last && has_next) S.a_ready(nxt);
            if constexpr (SP2) {
            PG8_LDB(B0, 0, 0); PG8_LDB(B1, 0, 1); PG8_SCHED; PG8_LDA(At, 0, 0); PG8_STAGE(PG8_SA(1, 1), a1 + hstep, voffA);
            PG8_WAIT_V(8); PG8_WAIT_L(0); PG8_BAR; PG8_MMA(0, 0, At, B0); PG8_MMA(0, 1, At, B1); PG8_BAR; PG8_SCHED;
            PG8_LDA(At, 0, 1); PG8_STAGE(PG8_SB(0, 0), b2, voffB); PG8_STAGE(PG8_SB(0, 1), b2 + hstep, voffB); PG8_STAGE(PG8_SA(0, 0), a2, voffA);
            PG8_WAIT_V(8); PG8_WAIT_L(0); PG8_BAR; PG8_MMA(1, 0, At, B0); PG8_MMA(1, 1, At, B1); PG8_BAR; PG8_SCHED;
            PG8_LDB(B0, 1, 0); PG8_LDB(B1, 1, 1); PG8_SCHED; PG8_LDA(At, 1, 0); PG8_STAGE(PG8_SA(0, 1), a2 + hstep, voffA);
            PG8_WAIT_V(8); PG8_WAIT_L(0); PG8_BAR; PG8_MMA(0, 0, At, B0); PG8_MMA(0, 1, At, B1); PG8_BAR; PG8_SCHED;
            PG8_LDA(At, 1, 1); PG8_STAGE(PG8_SB(1, 0), b3, voffB); PG8_STAGE(PG8_SB(1, 1), b3 + hstep, voffB); PG8_STAGE(PG8_SA(1, 0), a3, voffA);
            PG8_WAIT_V(8); PG8_WAIT_L(0); PG8_BAR; PG8_MMA(1, 0, At, B0); PG8_MMA(1, 1, At, B1); PG8_BAR; PG8_SCHED;
            } else {
            PG8_LDB(B0, 0, 0); PG8_SCHED; PG8_LDA(At, 0, 0); PG8_STAGE(PG8_SA(1, 1), a1 + hstep, voffA);
            PG8_WAIT_L(8); PG8_BAR; PG8_WAIT_L(0); PG8_MMA(0, 0, At, B0); PG8_BAR; PG8_SCHED;
            PG8_LDB(B1, 0, 1); PG8_STAGE(PG8_SB(0, 0), b2, voffB);
            PG8_BAR; PG8_WAIT_L(0); PG8_MMA(0, 1, At, B1); PG8_BAR;
            PG8_LDA(At, 0, 1); PG8_STAGE(PG8_SA(0, 0), a2, voffA);
            PG8_BAR; PG8_WAIT_L(0); PG8_MMA(1, 0, At, B0); PG8_BAR; PG8_SCHED;
            PG8_STAGE(PG8_SB(0, 1), b2 + hstep, voffB);
            PG8_WAIT_V(6); PG8_BAR; PG8_MMA(1, 1, At, B1); PG8_BAR;
            PG8_LDB(B0, 1, 0); PG8_SCHED; PG8_LDA(At, 1, 0); PG8_STAGE(PG8_SA(0, 1), a2 + hstep, voffA);
            PG8_WAIT_L(8); PG8_BAR; PG8_WAIT_L(0); PG8_MMA(0, 0, At, B0); PG8_BAR; PG8_SCHED;
            PG8_LDB(B1, 1, 1); PG8_STAGE(PG8_SB(1, 0), b3, voffB);
            PG8_BAR; PG8_WAIT_L(0); PG8_MMA(0, 1, At, B1); PG8_BAR;
            PG8_LDA(At, 1, 1); PG8_STAGE(PG8_SA(1, 0), a3, voffA);
            PG8_BAR; PG8_WAIT_L(0); PG8_MMA(1, 0, At, B0); PG8_BAR; PG8_SCHED;
            PG8_STAGE(PG8_SB(1, 1), b3 + hstep, voffB);
            PG8_WAIT_V(6); PG8_BAR; PG8_MMA(1, 1, At, B1); PG8_BAR;
            }
        }
        if constexpr (ALIGN_EPI) { if (wr == 0) PG8_BAR; }
        if constexpr (!Epi::AFTER_DRAIN) { E(acc, cur, wr, wc, fr, fq); S.done(cur); }
        if (!has_next) break;
#pragma unroll
        for (int a = 0; a < 2; ++a)
#pragma unroll
            for (int b = 0; b < 2; ++b)
#pragma unroll
                for (int m = 0; m < 4; ++m)
#pragma unroll
                    for (int n = 0; n < 2; ++n) acc[a][b][m][n] = (f32x4){0.f, 0.f, 0.f, 0.f};
        cur = nxt; cA = nA; cB = nB; ++ui;
        if constexpr (ALIGN_EPI) { if (wr == 1) PG8_BAR; }
    }
    PG8_WAIT_V(0);
    if constexpr (!ALIGN_EPI) { if (wr == 0) PG8_BAR; }
    PG8_BAR;
    if constexpr (Epi::AFTER_DRAIN) { E.fused(acc, cur, wr, wc, fr, fq, lds, wid, lane); S.done(cur); }
#undef PG8_SA
#undef PG8_SB
#undef PG8_STAGE
#undef PG8_LDA
#undef PG8_LDB
#undef PG8_MMA
#undef PG8_WAIT_V
#undef PG8_WAIT_L
#undef PG8_BAR
#undef PG8_SCHED
}
}

constexpr int NB = 16, SEQ = 2048, DM = 1024, FF = 2816, MROWS = NB * SEQ;
constexpr int NGU = 2 * FF;
constexpr int NEV = 3584;
constexpr int NOD = 3072;
constexpr float RMS_EPS = 1e-6f;
constexpr float LOG2E = 1.4426950408889634f;
constexpr float QSCALE = 0.125f * LOG2E;

namespace epi {
using namespace pg8;
__device__ __forceinline__ unsigned pkbf(float lo, float hi) {
    typedef float f2_t __attribute__((ext_vector_type(2))); typedef __bf16 b2_t __attribute__((ext_vector_type(2)));
    f2_t v = {lo, hi}; b2_t b = __builtin_convertvector(v, b2_t); return __builtin_bit_cast(unsigned, b); }
__device__ __forceinline__ float row_rs(const float* ssq, int row) { const f32x4 p = *(const f32x4*)(ssq + (size_t)row * 4); return __builtin_amdgcn_rsqf(((p[0] + p[1]) + (p[2] + p[3])) * (1.f / DM) + RMS_EPS); }
__device__ __forceinline__ float epi_sum4fq(float s) {
    s += __int_as_float(__builtin_amdgcn_ds_swizzle(__float_as_int(s), (16 << 10) | 0x1f));
    auto rr = __builtin_amdgcn_permlane32_swap(__float_as_uint(s), __float_as_uint(s), false, false); return __uint_as_float(rr[0]) + __uint_as_float(rr[1]); }
__device__ __forceinline__ u32x4 pk8(const f32x4& a, const f32x4& b) { u32x4 w; w.x = pkbf(a[0], a[1]); w.y = pkbf(a[2], a[3]); w.z = pkbf(b[0], b[1]); w.w = pkbf(b[2], b[3]); return w; }

template <int PVAR = 0>
struct EpiSwiGLUT {
    static constexpr bool PERM = true, AFTER_DRAIN = false;
    bf16_t* H; const float* rs;
    __device__ __forceinline__ void operator()(const f32x4 (&acc)[2][2][4][2], const Unit& u, int wr, int wc, int fr, int fq) const {
        typedef float f32x2 __attribute__((ext_vector_type(2)));
        const int row0 = u.pm * BM + wr * 64 + fr, col0 = u.pn * 128 + wc * 32 + 8 * fq;
        float v8[2][4];
#pragma unroll
        for (int ai = 0; ai < 2; ++ai)
#pragma unroll
            for (int m = 0; m < 4; ++m) { const f32x4 p = *(const f32x4*)(rs + (size_t)(row0 + ai * HALF + m * 16) * 4); v8[ai][m] = ((p[0] + p[1]) + (p[2] + p[3])) * (1.f / DM) + RMS_EPS; }
#pragma unroll
        for (int ai = 0; ai < 2; ++ai)
#pragma unroll
            for (int m = 0; m < 4; ++m) {
                const int row = row0 + ai * HALF + m * 16; const float v = v8[ai][m]; const float sp = -LOG2E * __builtin_amdgcn_rsqf(v);
                f32x4 h[2];
#pragma unroll
                for (int n = 0; n < 2; ++n)
#pragma unroll
                    for (int pr = 0; pr < 2; ++pr) { const f32x2 g2 = {acc[ai][0][m][n][2 * pr], acc[ai][0][m][n][2 * pr + 1]}, u2 = {acc[ai][1][m][n][2 * pr], acc[ai][1][m][n][2 * pr + 1]};
                        const f32x2 t2 = g2 * sp; f32x2 e2; e2.x = __builtin_amdgcn_exp2f(t2.x); e2.y = __builtin_amdgcn_exp2f(t2.y);
                        const f32x2 d2 = e2 * v + v; f32x2 r2; r2.x = __builtin_amdgcn_rcpf(d2.x); r2.y = __builtin_amdgcn_rcpf(d2.y);
                        const f32x2 h2 = (g2 * u2) * r2; h[n][2 * pr] = h2.x; h[n][2 * pr + 1] = h2.y; }
                if (PVAR == 1) { const u32x4 w_ = pk8(h[0], h[1]); asm volatile("" :: "v"(w_)); } else *(u32x4*)(H + (size_t)row * FF + col0) = pk8(h[0], h[1]);
            }
    }
};
typedef EpiSwiGLUT<0> EpiSwiGLU;
struct EpiNull {
    static constexpr bool PERM = true, AFTER_DRAIN = false;
    __device__ __forceinline__ void operator()(const f32x4 (&acc)[2][2][4][2], const Unit& u, int wr, int wc, int fr, int fq) const {
#pragma unroll
        for (int ai = 0; ai < 2; ++ai)
#pragma unroll
            for (int bj = 0; bj < 2; ++bj)
#pragma unroll
                for (int m = 0; m < 4; ++m)
#pragma unroll
                    for (int n = 0; n < 2; ++n) asm volatile("" :: "v"(acc[ai][bj][m][n]));
    }
};
struct EpiBf16Y {
    static constexpr bool PERM = true, AFTER_DRAIN = false;
    bf16_t* Y;
    __device__ __forceinline__ void operator()(const f32x4 (&acc)[2][2][4][2], const Unit& u, int wr, int wc, int fr, int fq) const {
        const int row0 = u.pm * BM + wr * 64 + fr, col0 = u.pn * BM + wc * 32 + 8 * fq;
#pragma unroll
        for (int ai = 0; ai < 2; ++ai)
#pragma unroll
            for (int m = 0; m < 4; ++m) { bf16_t* rowp = Y + (size_t)(row0 + ai * HALF + m * 16) * DM + col0;
#pragma unroll
                for (int bj = 0; bj < 2; ++bj) *(u32x4*)(rowp + bj * HALF) = pk8(acc[ai][bj][m][0], acc[ai][bj][m][1]); }
    }
};
template <bool LAST, int PVAR = 0>
struct EpiRmsRes {
    static constexpr bool PERM = true, AFTER_DRAIN = false;
    bf16_t* X; float* outf; const float* ga; float alpha; unsigned long long* gran; unsigned epoch; float* ssq2; unsigned* tmo; PG8_LAS unsigned char* xl;
    __device__ __forceinline__ void operator()(const f32x4 (&acc)[2][2][4][2], const Unit& u, int wr, int wc, int fr, int fq) const {
        int tid_ = threadIdx.x; asm volatile("" : "+v"(tid_)); const int wid = __builtin_amdgcn_readfirstlane(tid_ >> 6), lane = tid_ & 63;
        PG8_LAS float* P = (PG8_LAS float*)xl;
        PG8_LAS float* S = (PG8_LAS float*)(xl + 4096);
        const int col0 = u.pn * BM + wc * 32 + 8 * fq;
        u32x4 xw8[4][2];
#pragma unroll
        for (int m = 0; m < 4; ++m)
#pragma unroll
            for (int bj = 0; bj < 2; ++bj) xw8[m][bj] = *(const u32x4*)(X + (size_t)(u.pm * BM + wr * 64 + m * 16 + fr) * DM + col0 + bj * HALF);
#pragma unroll
        for (int ai = 0; ai < 2; ++ai)
#pragma unroll
            for (int m = 0; m < 4; ++m) { float s = 0.f;
#pragma unroll
                for (int bj = 0; bj < 2; ++bj)
#pragma unroll
                    for (int n = 0; n < 2; ++n) { const f32x4 v = acc[ai][bj][m][n]; s += (v[0] * v[0] + v[1] * v[1]) + (v[2] * v[2] + v[3] * v[3]); }
                s = epi_sum4fq(s);
                if (fq == 0) P[(ai * HALF + wr * 64 + m * 16 + fr) * 4 + wc] = s; }
        asm volatile("s_waitcnt lgkmcnt(0)" ::: "memory"); __builtin_amdgcn_s_barrier(); asm volatile("" ::: "memory");
        const int row = wid * 32 + (lane & 31);
        if (lane < 32) {
            const f32x4 p = *(const PG8_LAS f32x4*)(P + row * 4); const float mine = (p[0] + p[1]) + (p[2] + p[3]);
            unsigned long long* gr = gran + ((size_t)(u.pm * BM + row)) * 4;
            __hip_atomic_store(gr + u.pn, ((unsigned long long)epoch << 32) | (unsigned long long)__float_as_uint(mine), __ATOMIC_RELAXED, __HIP_MEMORY_SCOPE_AGENT);
            float t = 0.f; bool ok = false;
            for (unsigned spins = 0; spins < ((PVAR & 1) ? 0u : (1u << 18)); ++spins) {
                unsigned long long w[4]; bool all4 = true; t = 0.f;
#pragma unroll
                for (int k = 0; k < 4; ++k) { w[k] = __hip_atomic_load(gr + k, __ATOMIC_RELAXED, __HIP_MEMORY_SCOPE_AGENT); all4 = all4 && ((unsigned)(w[k] >> 32) == epoch); t += __uint_as_float((unsigned)w[k]); }
                if (__all(all4)) { ok = true; break; }
                __builtin_amdgcn_s_sleep(1);
            }
            if (PVAR & 1) { ok = true; t = 4.f * mine; }
            if (!ok && lane == 0) __hip_atomic_store(tmo, 1u, __ATOMIC_RELAXED, __HIP_MEMORY_SCOPE_AGENT);
            S[row] = alpha * __builtin_amdgcn_rsqf(t * (1.f / DM) + RMS_EPS);
        }
        asm volatile("s_waitcnt lgkmcnt(0)" ::: "memory"); __builtin_amdgcn_s_barrier(); asm volatile("" ::: "memory");
        if (PVAR & 2) return;
        f32x4 g[2][2];
#pragma unroll
        for (int bj = 0; bj < 2; ++bj)
#pragma unroll
            for (int n = 0; n < 2; ++n) g[bj][n] = *(const f32x4*)(ga + col0 + bj * HALF + 4 * n);
#pragma unroll
        for (int ai = 0; ai < 2; ++ai) {
            if (ai == 1) {
#pragma unroll
                for (int m = 0; m < 4; ++m)
#pragma unroll
                    for (int bj = 0; bj < 2; ++bj) xw8[m][bj] = *(const u32x4*)(X + (size_t)(u.pm * BM + HALF + wr * 64 + m * 16 + fr) * DM + col0 + bj * HALF);
            }
#pragma unroll
            for (int m = 0; m < 4; ++m) { const int rl = ai * HALF + wr * 64 + m * 16 + fr; const size_t off = (size_t)(u.pm * BM + rl) * DM + col0; const float sr = S[rl]; float q = 0.f;
#pragma unroll
                for (int bj = 0; bj < 2; ++bj) { const u32x4 xw = xw8[m][bj]; f32x4 xn[2];
#pragma unroll
                    for (int n = 0; n < 2; ++n) { const f32x4 xo = {__uint_as_float(xw[2 * n] << 16), __uint_as_float(xw[2 * n] & 0xffff0000u), __uint_as_float(xw[2 * n + 1] << 16), __uint_as_float(xw[2 * n + 1] & 0xffff0000u)};
                        xn[n] = xo + acc[ai][bj][m][n] * sr * g[bj][n]; q += (xn[n][0] * xn[n][0] + xn[n][1] * xn[n][1]) + (xn[n][2] * xn[n][2] + xn[n][3] * xn[n][3]); }
                    if (LAST) { *(f32x4*)(outf + off + bj * HALF) = xn[0]; *(f32x4*)(outf + off + bj * HALF + 4) = xn[1]; }
                    else *(u32x4*)(X + off + bj * HALF) = pk8(xn[0], xn[1]); }
                if (!LAST) { q = epi_sum4fq(q); if (fq == 0) P[rl * 4 + wc] = q; } } }
        if (!LAST) {
            asm volatile("s_waitcnt lgkmcnt(0)" ::: "memory"); __builtin_amdgcn_s_barrier(); asm volatile("" ::: "memory");
            if (lane < 32) { const f32x4 p = *(const PG8_LAS f32x4*)(P + row * 4); ssq2[((size_t)(u.pm * BM + row)) * 4 + u.pn] = (p[0] + p[1]) + (p[2] + p[3]); }
        }
    }
};
struct OneRound {
    StaticOrder base; int round;
    __device__ __forceinline__ bool next(int i, Unit& u) const { return i == 0 && base.next(round, u); }
    __device__ __forceinline__ void a_ready(const Unit&) const {}
    __device__ __forceinline__ void done(const Unit&) const {}
};
struct EpiF32 {
    static constexpr bool PERM = false, AFTER_DRAIN = false;
    float* Y; int ldc;
    __device__ __forceinline__ void operator()(const f32x4 (&acc)[2][2][4][2], const Unit& u, int wr, int wc, int fr, int fq) const {
        const int row0 = u.pm * BM + wr * 64 + fr, col0 = u.pn * BM + wc * 32 + 4 * fq;
#pragma unroll
        for (int ai = 0; ai < 2; ++ai)
#pragma unroll
            for (int m = 0; m < 4; ++m) { float* rowp = Y + (size_t)(row0 + ai * HALF + m * 16) * ldc + col0;
#pragma unroll
                for (int bj = 0; bj < 2; ++bj)
#pragma unroll
                    for (int n = 0; n < 2; ++n) *(f32x4*)(rowp + bj * HALF + n * 16) = acc[ai][bj][m][n]; }
    }
};
struct EpiProjOdd {
    static constexpr bool PERM = true, AFTER_DRAIN = false;
    bf16_t* Q; const float* rs;
    __device__ __forceinline__ void operator()(const f32x4 (&acc)[2][2][4][2], const Unit& u, int wr, int wc, int fr, int fq) const {
        const int t = u.pn >> 2; bf16_t* base = Q + (size_t)t * ((size_t)MROWS * DM); const float sc = t == 0 ? QSCALE : 1.f;
        const int row0 = u.pm * BM + wr * 64 + fr, col0 = (u.pn & 3) * BM + wc * 32 + 8 * fq;
        float sc8[2][4];
#pragma unroll
        for (int ai = 0; ai < 2; ++ai)
#pragma unroll
            for (int m = 0; m < 4; ++m) sc8[ai][m] = row_rs(rs, row0 + ai * HALF + m * 16);
#pragma unroll
        for (int ai = 0; ai < 2; ++ai)
#pragma unroll
            for (int m = 0; m < 4; ++m) { const int row = row0 + ai * HALF + m * 16; const float s = sc8[ai][m] * sc;
#pragma unroll
                for (int bj = 0; bj < 2; ++bj) *(u32x4*)(base + (size_t)row * DM + col0 + bj * HALF) = pk8(acc[ai][bj][m][0] * s, acc[ai][bj][m][1] * s); }
    }
};
struct EpiProjEven {
    static constexpr bool PERM = true, AFTER_DRAIN = false;
    bf16_t *R1, *IQ, *IK; float* IW; const float* rs;
    const float *c64, *s64, *c32, *s32;
    __device__ __forceinline__ void operator()(const f32x4 (&acc)[2][2][4][2], const Unit& u, int wr, int wc, int fr, int fq) const {
        const int pn = u.pn, row0 = u.pm * BM + wr * 64 + fr;
        float sc8[2][4];
#pragma unroll
        for (int ai = 0; ai < 2; ++ai)
#pragma unroll
            for (int m = 0; m < 4; ++m) sc8[ai][m] = row_rs(rs, row0 + ai * HALF + m * 16);
        if (pn == 4 || pn == 5 || pn == 10 || pn == 11) {
            bf16_t* base = R1 + (size_t)(pn >> 1) * ((size_t)MROWS * 512); const int col0 = (pn & 1) * BM + wc * 32 + 8 * fq;
#pragma unroll
            for (int ai = 0; ai < 2; ++ai)
#pragma unroll
                for (int m = 0; m < 4; ++m) { const int row = row0 + ai * HALF + m * 16; const float s = sc8[ai][m];
#pragma unroll
                    for (int bj = 0; bj < 2; ++bj) *(u32x4*)(base + (size_t)row * 512 + col0 + bj * HALF) = pk8(acc[ai][bj][m][0] * s, acc[ai][bj][m][1] * s); }
        } else if (pn < 12) {
            bf16_t* base = R1 + (size_t)(pn >> 1) * ((size_t)MROWS * 512);
            const float sc = (pn < 2 || pn == 6 || pn == 7) ? QSCALE : 1.f;
            const int head = 4 * (pn & 1) + wc, d0 = 8 * fq;
#pragma unroll
            for (int aim = 0; aim < 4; ++aim) { const int ai = aim >> 1;
                f32x4 ct[2][2], st[2][2];
#pragma unroll
                for (int mm = 0; mm < 2; ++mm) { const int pos = (row0 + ai * HALF + (2 * (aim & 1) + mm) * 16) & (SEQ - 1);
#pragma unroll
                    for (int n = 0; n < 2; ++n) { ct[mm][n] = *(const f32x4*)(c64 + pos * 32 + d0 + 4 * n); st[mm][n] = *(const f32x4*)(s64 + pos * 32 + d0 + 4 * n); } }
#pragma unroll
                for (int mm = 0; mm < 2; ++mm) { const int m = 2 * (aim & 1) + mm; const int row = row0 + ai * HALF + m * 16; const float s = sc8[ai][m] * sc;
                    f32x4 o1[2], o2[2];
#pragma unroll
                    for (int n = 0; n < 2; ++n) { const f32x4 cc = ct[mm][n], ss = st[mm][n];
                        const f32x4 x1 = acc[ai][0][m][n] * s, x2 = acc[ai][1][m][n] * s; o1[n] = x1 * cc - x2 * ss; o2[n] = x2 * cc + x1 * ss; }
                    bf16_t* dst = base + (size_t)row * 512 + head * 64 + d0;
                    *(u32x4*)dst = pk8(o1[0], o1[1]); *(u32x4*)(dst + 32) = pk8(o2[0], o2[1]); } }
        } else if (pn == 12) {
            const int head = 2 * wc + (fq >> 1), d0 = 8 * (fq & 1);
#pragma unroll
            for (int ai = 0; ai < 2; ++ai)
#pragma unroll
                for (int m = 0; m < 4; ++m) { const int row = row0 + ai * HALF + m * 16, pos = row & (SEQ - 1); const float s = sc8[ai][m];
                    f32x4 o1[2], o2[2];
#pragma unroll
                    for (int n = 0; n < 2; ++n) { const f32x4 cc = *(const f32x4*)(c32 + pos * 16 + d0 + 4 * n), ss = *(const f32x4*)(s32 + pos * 16 + d0 + 4 * n);
                        const f32x4 x1 = acc[ai][0][m][n] * s, x2 = acc[ai][1][m][n] * s; o1[n] = x1 * cc - x2 * ss; o2[n] = x2 * cc + x1 * ss; }
                    bf16_t* dst = IQ + (size_t)row * 256 + head * 32 + d0;
                    *(u32x4*)dst = pk8(o1[0], o1[1]); *(u32x4*)(dst + 16) = pk8(o2[0], o2[1]); }
        } else {
            if (wc == 0 && fq < 2) {
                const int d0 = 8 * fq;
#pragma unroll
                for (int ai = 0; ai < 2; ++ai)
#pragma unroll
                    for (int m = 0; m < 4; ++m) { const int row = row0 + ai * HALF + m * 16, pos = row & (SEQ - 1); const float s = sc8[ai][m];
                        f32x4 o1[2], o2[2];
#pragma unroll
                        for (int n = 0; n < 2; ++n) { const f32x4 cc = *(const f32x4*)(c32 + pos * 16 + d0 + 4 * n), ss = *(const f32x4*)(s32 + pos * 16 + d0 + 4 * n);
                            const f32x4 x1 = acc[ai][0][m][n] * s, x2 = acc[ai][1][m][n] * s; o1[n] = x1 * cc - x2 * ss; o2[n] = x2 * cc + x1 * ss; }
                        bf16_t* dst = IK + (size_t)row * 32 + d0;
                        *(u32x4*)dst = pk8(o1[0], o1[1]); *(u32x4*)(dst + 16) = pk8(o2[0], o2[1]); }
            } else if (wc == 0 && fq == 2) {
#pragma unroll
                for (int ai = 0; ai < 2; ++ai)
#pragma unroll
                    for (int m = 0; m < 4; ++m) { const int row = row0 + ai * HALF + m * 16; const float s = sc8[ai][m] * 0.0625f;
                        *(f32x4*)(IW + (size_t)row * 8) = acc[ai][0][m][0] * s; *(f32x4*)(IW + (size_t)row * 8 + 4) = acc[ai][0][m][1] * s; }
            }
        }
    }
};
}

namespace att {
#define ALAS __attribute__((address_space(3)))
typedef unsigned short bf16_t;
typedef short bf16x8 __attribute__((ext_vector_type(8)));
typedef short s16x4 __attribute__((ext_vector_type(4)));
typedef float f32x16 __attribute__((ext_vector_type(16)));
typedef float f32x4 __attribute__((ext_vector_type(4)));
typedef unsigned u32x4 __attribute__((ext_vector_type(4)));
typedef short v4i16_t __attribute__((ext_vector_type(4)));
__device__ __forceinline__ int crow(int r, int hi) { return (r & 3) + 8 * (r >> 2) + 4 * hi; }
__device__ __forceinline__ unsigned cvtpk(float lo, float hi) { typedef float f2_t __attribute__((ext_vector_type(2))); typedef __bf16 b2_t __attribute__((ext_vector_type(2)));
    f2_t v = {lo, hi}; b2_t b = __builtin_convertvector(v, b2_t); return __builtin_bit_cast(unsigned, b); }
__device__ __forceinline__ s16x4 vtr(const ALAS unsigned char* p) { return __builtin_bit_cast(s16x4, __builtin_amdgcn_ds_read_tr16_b64_v4i16((ALAS v4i16_t*)p)); }
__device__ __forceinline__ float halfswap_max(float m) { auto rr = __builtin_amdgcn_permlane32_swap(__float_as_uint(m), __float_as_uint(m), false, false); return fmaxf(__uint_as_float(rr[0]), __uint_as_float(rr[1])); }
__device__ __forceinline__ float halfswap_sum(float m) { auto rr = __builtin_amdgcn_permlane32_swap(__float_as_uint(m), __float_as_uint(m), false, false); return __uint_as_float(rr[0]) + __uint_as_float(rr[1]); }

template <int DV> struct Lds {
    static constexpr int R = (DV == 64) ? 4 : 3, D = R - 1;
    static constexpr int KB = 8192, VB = DV * 128;
    static constexpr int OFF_K = 0, OFF_V = R * KB, OFF_MW = OFF_V + R * VB, OFF_WSF = OFF_MW + 8 * R * 256, OFF_BT = OFF_WSF + 8 * 256, OFF_OST = OFF_BT + 3072, OST_W = 4096, TOTAL = OFF_OST + 8 * OST_W;
};
__device__ __forceinline__ void glds16(const void* gsrc, unsigned lds_dst) { unsigned keep;
    asm volatile("s_mov_b32 %0, m0\n\ts_mov_b32 m0, %2\n\ts_nop 0\n\tglobal_load_lds_dwordx4 %1, off\n\ts_mov_b32 m0, %0" : "=&s"(keep) : "v"(gsrc), "s"(lds_dst) : "memory"); }
__device__ __forceinline__ void glds4(const void* gsrc, unsigned lds_dst) { unsigned keep;
    asm volatile("s_mov_b32 %0, m0\n\ts_mov_b32 m0, %2\n\ts_nop 0\n\tglobal_load_lds_dword %1, off\n\ts_mov_b32 m0, %0" : "=&s"(keep) : "v"(gsrc), "s"(lds_dst) : "memory"); }

template <int DV, int MODE, int THR>
__device__ __forceinline__ void attn_core(f32x16 (&o)[DV / 32], ALAS unsigned char* lds,
                                          const bf16_t* Qw, int ldq, const bf16_t* Kh, int ldk, const bf16_t* Vh, int ldv,
                                          int T0, int T1, int tw0, int tw1,
                                          const unsigned long long* maskrow, int qpos, int qchunk, int att_probe_hotmask = -1, int att_probe_skip = 0) {
    typedef Lds<DV> L; constexpr int NDB = DV / 32, NVP = DV / 64, R = L::R, D = L::D, NDMA = 1 + NVP + (MODE == 1 ? 1 : 0);
    int tid = threadIdx.x; asm volatile("" : "+v"(tid));
    const int lane = tid & 63, r32 = lane & 31, hi = lane >> 5; const int wid = __builtin_amdgcn_readfirstlane(tid >> 6);
    ALAS float* wsf = (ALAS float*)(lds + L::OFF_WSF) + wid * 64;
    const ALAS float* btab = (const ALAS float*)(lds + L::OFF_BT);
    constexpr bool QLDS = (DV == 128);
    ALAS unsigned char* qst = lds + L::OFF_OST + wid * L::OST_W + lane * 16;
    bf16x8 qr[4];
#pragma unroll
    for (int d0 = 0; d0 < 4; ++d0) { qr[d0] = *(const bf16x8*)(Qw + (size_t)r32 * ldq + d0 * 16 + hi * 8); if (QLDS) *(ALAS bf16x8*)(qst + d0 * 1024) = qr[d0]; }
    const int krow = 8 * wid + (lane >> 3), kkey = krow ^ ((krow >> 3) & 1), kch = (lane & 7) ^ (kkey & 7);
    const bf16_t* ksrc = Kh + (size_t)kkey * ldk + kch * 8;
    const bf16_t* vsrc = Vh + (size_t)(16 * (wid & 3) + (lane >> 2)) * ldv + 32 * (wid >> 2) + 8 * (lane & 3);
    const unsigned* msrc = (const unsigned*)maskrow + hi;
    const unsigned lds0 = (unsigned)(__SIZE_TYPE__)lds;
    const unsigned kdst = lds0 + L::OFF_K + wid * 1024, vdst = lds0 + L::OFF_V + (wid >> 2) * 4096 + (wid & 3) * 1024, mdstb = lds0 + L::OFF_MW + wid * (R * 256);
    ALAS unsigned char* mdst = lds + L::OFF_MW + wid * (R * 256);
#define ATT_U(x) ((unsigned)__builtin_amdgcn_readfirstlane((int)(x)))
#define ATT_TT(t) (T0 + (((t) - T0) & att_probe_hotmask))
#define ATT_DMA_K(t, sl) glds16(ksrc + (size_t)ATT_TT(t) * 64 * ldk, ATT_U(kdst + (sl) * L::KB))
#define ATT_DMA_V(t, sl) do { glds16(vsrc + (size_t)ATT_TT(t) * 64 * ldv, ATT_U(vdst + (sl) * L::VB)); if (NVP == 2) glds16(vsrc + (size_t)ATT_TT(t) * 64 * ldv + 64, ATT_U(vdst + (sl) * L::VB + 8192)); \
                              if (MODE == 1) glds4(msrc + 2 * (t), ATT_U(mdstb + (sl) * 256)); } while (0)
    int kfo[4];
#pragma unroll
    for (int d0 = 0; d0 < 4; ++d0) kfo[d0] = (r32 ^ ((r32 >> 3) & 1)) * 128 + (((2 * d0 + hi) ^ (r32 & 7)) * 16);
#define ATT_QK(P0, P1, t, ks) do { \
        if (MODE == 2) { const int jrel_ = qchunk - (t); \
            if (jrel_ >= 5) { const float bc_ = btab[638]; _Pragma("unroll") for (int r = 0; r < 16; ++r) { P0[r] = bc_; P1[r] = bc_; } } \
            else { const ALAS float* bp_ = btab + (qpos - 64 * (t) + 63 - 4 * hi - 59); \
                _Pragma("unroll") for (int r = 0; r < 16; ++r) { P0[r] = bp_[59 - crow(r, 0)]; P1[r] = bp_[59 - 32 - crow(r, 0)]; } } \
        } else { P0 = f32x16{}; P1 = f32x16{}; } \
        const ALAS unsigned char* kb_ = lds + L::OFF_K + (ks) * L::KB; \
        _Pragma("unroll") for (int d0 = 0; d0 < 4; ++d0) { const bf16x8 b0_ = *(const ALAS bf16x8*)(kb_ + kfo[d0]), b1_ = *(const ALAS bf16x8*)(kb_ + kfo[d0] + 4096); \
            const bf16x8 q_ = QLDS ? *(const ALAS bf16x8*)(qst + d0 * 1024) : qr[d0]; \
            P0 = __builtin_amdgcn_mfma_f32_32x32x16_bf16(b0_, q_, P0, 0, 0, 0); P1 = __builtin_amdgcn_mfma_f32_32x32x16_bf16(b1_, q_, P1, 0, 0, 0); } } while (0)
#define ATT_QK_INIT(P0, P1, t) do { \
        if (MODE == 2) { const int jrel_ = qchunk - (t); \
            if (jrel_ >= 5) { const float bc_ = btab[638]; _Pragma("unroll") for (int r = 0; r < 16; ++r) { P0[r] = bc_; P1[r] = bc_; } } \
            else { const ALAS float* bp_ = btab + (qpos - 64 * (t) + 63 - 4 * hi - 59); \
                _Pragma("unroll") for (int r = 0; r < 16; ++r) { P0[r] = bp_[59 - crow(r, 0)]; P1[r] = bp_[59 - 32 - crow(r, 0)]; } } \
        } else { P0 = f32x16{}; P1 = f32x16{}; } } while (0)
#define ATT_QK_HALF(P0, P1, kb_, dlo) do { \
        _Pragma("unroll") for (int d0 = (dlo); d0 < (dlo) + 2; ++d0) { const bf16x8 b0_ = *(const ALAS bf16x8*)((kb_) + kfo[d0]), b1_ = *(const ALAS bf16x8*)((kb_) + kfo[d0] + 4096); \
            const bf16x8 q_ = QLDS ? *(const ALAS bf16x8*)(qst + d0 * 1024) : qr[d0]; \
            P0 = __builtin_amdgcn_mfma_f32_32x32x16_bf16(b0_, q_, P0, 0, 0, 0); P1 = __builtin_amdgcn_mfma_f32_32x32x16_bf16(b1_, q_, P1, 0, 0, 0); } } while (0)
    constexpr int NV = NDMA - 1;
#define ATT_CK(j) (((j) <= T0 + D) ? ((j) - T0) * NDMA + 1 : ((j) - 1 - T0) * NDMA + 2)
#define ATT_CV(j) (((j) < T0 + D) ? ((j) - T0 + 1) * NDMA : ((j) - T0) * NDMA + 2 + NV)
#define ATT_WAIT_BAR_N(n_) do { const int nn_ = (n_); \
        if (nn_ <= 0) asm volatile("s_waitcnt vmcnt(0) lgkmcnt(0)\n\ts_barrier" ::: "memory"); \
        else if (nn_ == 1) asm volatile("s_waitcnt vmcnt(1) lgkmcnt(0)\n\ts_barrier" ::: "memory"); \
        else if (nn_ == 2) asm volatile("s_waitcnt vmcnt(2) lgkmcnt(0)\n\ts_barrier" ::: "memory"); \
        else if (nn_ == 3) asm volatile("s_waitcnt vmcnt(3) lgkmcnt(0)\n\ts_barrier" ::: "memory"); \
        else if (nn_ == 4) asm volatile("s_waitcnt vmcnt(4) lgkmcnt(0)\n\ts_barrier" ::: "memory"); \
        else if (nn_ == 5) asm volatile("s_waitcnt vmcnt(5) lgkmcnt(0)\n\ts_barrier" ::: "memory"); \
        else if (nn_ == 6) asm volatile("s_waitcnt vmcnt(6) lgkmcnt(0)\n\ts_barrier" ::: "memory"); \
        else if (nn_ == 7) asm volatile("s_waitcnt vmcnt(7) lgkmcnt(0)\n\ts_barrier" ::: "memory"); \
        else asm volatile("s_waitcnt vmcnt(8) lgkmcnt(0)\n\ts_barrier" ::: "memory"); } while (0)
#define ATT_END_STEP(t) do { int need_ = 0; if ((t) + 2 < T1) need_ = ATT_CK((t) + 2); if ((t) + 1 < T1) { const int cv_ = ATT_CV((t) + 1); need_ = cv_ > need_ ? cv_ : need_; } \
        ATT_WAIT_BAR_N(need_ ? n_issued - need_ : 0); } while (0)
    int n_issued = 0;
    float m_run = -1e30f, l_part = 0.f;
#pragma unroll
    for (int d0 = 0; d0 < NDB; ++d0) o[d0] = f32x16{};
#pragma unroll
    for (int i = 0; i <= D; ++i) { if (T0 + i < T1) { ATT_DMA_K(T0 + i, i); n_issued += 1; } if (i < D && T0 + i < T1) { ATT_DMA_V(T0 + i, i); n_issued += NV; } }
    ATT_WAIT_BAR_N(n_issued - 1);
    f32x16 pc0, pc1, pn0, pn1;
    pc0 = f32x16{}; pc1 = f32x16{}; pn0 = f32x16{}; pn1 = f32x16{};
    if (tw0 == T0) { ATT_QK(pc0, pc1, T0, 0); }
    ATT_END_STEP(T0 - 1);
    int sk = 1 % R, sv = 0, si_k = 0, si_v = D % R;
    for (int t = T0; t < T1; ++t) {
        const bool steady = (t + 1 + D < T1);
        if (steady) { ATT_DMA_K(t + 1 + D, si_k); n_issued += 1; }
        if (t + D < T1) { ATT_DMA_V(t + D, si_v); n_issued += NV; }
        const bool act = (t >= tw0 && t < tw1), nxt = (t + 1 >= tw0 && t + 1 < tw1);
        if (nxt && !act) { ATT_QK(pn0, pn1, t + 1, sk); }
        if (act) {
            const ALAS unsigned char* kbn_ = lds + L::OFF_K + sk * L::KB;
            if (nxt) { ATT_QK_INIT(pn0, pn1, t + 1); ATT_QK_HALF(pn0, pn1, kbn_, 0); }
            if (MODE == 1) { const ALAS unsigned* mp = (const ALAS unsigned*)(mdst + sv * 256); const unsigned w0 = mp[r32] >> (4 * hi), w1 = mp[32 + r32] >> (4 * hi);
#pragma unroll
                for (int r = 0; r < 16; ++r) { const int sh = 31 - ((r & 3) + 8 * (r >> 2));
                    const unsigned m0 = (unsigned)(((int)(w0 << sh)) >> 31), m1 = (unsigned)(((int)(w1 << sh)) >> 31);
                    pc0[r] = __uint_as_float((__float_as_uint(pc0[r]) & m0) | (0xff800000u & ~m0)); pc1[r] = __uint_as_float((__float_as_uint(pc1[r]) & m1) | (0xff800000u & ~m1)); } }
            float mx = fmaxf(fmaxf(pc0[0], pc1[0]), pc0[1]);
#pragma unroll
            for (int r = 1; r < 16; ++r) mx = (r == 1) ? fmaxf(mx, pc1[1]) : fmaxf(fmaxf(mx, pc0[r]), pc1[r]);
            mx = halfswap_max(mx);
            if (__any(mx > m_run + (float)THR)) {
                const float mnew = fmaxf(m_run, mx); const float f = __builtin_amdgcn_exp2f(m_run - mnew);
                l_part *= f; m_run = mnew; if (hi == 0) wsf[r32] = f;
#pragma unroll
                for (int r = 0; r < 16; ++r) { const float fr_ = wsf[crow(r, hi)];
#pragma unroll
                    for (int d0 = 0; d0 < NDB; ++d0) o[d0][r] *= fr_; }
            }
            if (nxt) { ATT_QK_HALF(pn0, pn1, kbn_, 2); }
            float sa = 0.f, sb = 0.f;
#pragma unroll
            for (int r = 0; r < 16; ++r) { pc0[r] = __builtin_amdgcn_exp2f(pc0[r] - m_run); pc1[r] = __builtin_amdgcn_exp2f(pc1[r] - m_run); sa += pc0[r]; sb += pc1[r]; }
            l_part += sa + sb;
            u32x4 pw[4];
#pragma unroll
            for (int k = 0; k < 2; ++k)
#pragma unroll
                for (int j = 0; j < 4; ++j) { pw[k][j] = cvtpk(pc0[8 * k + 2 * j], pc0[8 * k + 2 * j + 1]); pw[2 + k][j] = cvtpk(pc1[8 * k + 2 * j], pc1[8 * k + 2 * j + 1]); }
            const ALAS unsigned char* vb = lds + L::OFF_V + sv * L::VB + ((lane >> 4) & 1) * 32 + (lane & 3) * 8 + (4 * hi + ((lane & 15) >> 2)) * 64;
#pragma unroll
            for (int d0 = 0; d0 < NDB; ++d0)
#pragma unroll
                for (int ks = 0; ks < 4; ++ks) { const s16x4 lo = vtr(vb + d0 * 4096 + ks * 1024), up = vtr(vb + d0 * 4096 + ks * 1024 + 512);
                    const bf16x8 vf = (bf16x8){lo[0], lo[1], lo[2], lo[3], up[0], up[1], up[2], up[3]};
                    o[d0] = __builtin_amdgcn_mfma_f32_32x32x16_bf16(__builtin_bit_cast(bf16x8, pw[ks]), vf, o[d0], 0, 0, 0); }
        }
        pc0 = pn0; pc1 = pn1;
        sk = (sk + 1 == R) ? 0 : sk + 1; sv = (sv + 1 == R) ? 0 : sv + 1; si_k = (si_k + 1 == R) ? 0 : si_k + 1; si_v = (si_v + 1 == R) ? 0 : si_v + 1;
        ATT_END_STEP(t);
    }
#undef ATT_U
#undef ATT_TT
#undef ATT_DMA_K
#undef ATT_DMA_V
#undef ATT_QK
#undef ATT_QK_INIT
#undef ATT_QK_HALF
#undef ATT_CK
#undef ATT_CV
#undef ATT_WAIT_BAR_N
#undef ATT_END_STEP
    const float l = halfswap_sum(l_part);
    if (hi == 0) wsf[32 + r32] = l;
#pragma unroll
    for (int r = 0; r < 16; ++r) { const float rl = 1.0f / wsf[32 + crow(r, hi)];
#pragma unroll
        for (int d0 = 0; d0 < NDB; ++d0) o[d0][r] *= rl; }
}

template <int DV>
__device__ __forceinline__ void store_o(const f32x16 (&o)[DV / 32], ALAS unsigned char* lds, bf16_t* dst, int ldo) {
    typedef Lds<DV> L;
    int tid = threadIdx.x; asm volatile("" : "+v"(tid));
    const int lane = tid & 63, r32 = lane & 31, hi = lane >> 5; const int wid = __builtin_amdgcn_readfirstlane(tid >> 6);
    ALAS bf16_t* stg = (ALAS bf16_t*)(lds + L::OFF_OST + wid * L::OST_W);
#pragma unroll
    for (int h = 0; h < DV / 64; ++h) {
#pragma unroll
        for (int r = 0; r < 16; ++r) { const int orow = crow(r, hi);
#pragma unroll
            for (int d0 = 0; d0 < 2; ++d0) stg[orow * 64 + d0 * 32 + r32] = (bf16_t)(cvtpk(o[2 * h + d0][r], 0.f) & 0xffffu); }
#pragma unroll
        for (int i = 0; i < 4; ++i) { const int row = i * 8 + (lane >> 3), ch = lane & 7; const u32x4 v = *(const ALAS u32x4*)(stg + row * 64 + ch * 8); *(u32x4*)(dst + (size_t)row * ldo + h * 64 + ch * 8) = v; }
    }
}
}
#define GAS __attribute__((address_space(1)))
#define LAS __attribute__((address_space(3)))
typedef unsigned short bf16;
typedef unsigned v4u __attribute__((ext_vector_type(4)));
typedef float f32x4 __attribute__((ext_vector_type(4)));
typedef short bf16x8 __attribute__((ext_vector_type(8)));
typedef GAS unsigned gu32;
typedef GAS unsigned long long gu64;
#define RLX_AGENT __ATOMIC_RELAXED, __HIP_MEMORY_SCOPE_AGENT
#define LDS_WAIT() asm volatile("s_waitcnt lgkmcnt(0)" ::: "memory")
#define VM_WAIT() asm volatile("s_waitcnt vmcnt(0)" ::: "memory")
__device__ __forceinline__ unsigned long long rt() { return __builtin_amdgcn_s_memrealtime(); }
__device__ __forceinline__ unsigned f2bf(float f) { unsigned u = __builtin_bit_cast(unsigned, f); return (u + 0x7fffu + ((u >> 16) & 1u)) >> 16; }
__device__ __forceinline__ unsigned pk2(float lo, float hi) { return f2bf(lo) | (f2bf(hi) << 16); }

#define XB_TMO      128
#define XB_XCNT(j)  (256  + 64 * (j))
#define XB_XSUB(j)  (1280 + 64 * (j))
#define XB_XGEN(j)  (2304 + 64 * (j))
#define XB_TOP      3328
#define XB_TOPGEN   3392
#define XCD_BAR_WORDS 3456
#define XB_SPIN_CAP (1u << 18)

__device__ __forceinline__ unsigned xb_ld(unsigned* p)              { return __hip_atomic_load(p, __ATOMIC_RELAXED, __HIP_MEMORY_SCOPE_AGENT); }
__device__ __forceinline__ unsigned xb_add(unsigned* p, unsigned v) { return __hip_atomic_fetch_add(p, v, __ATOMIC_RELAXED, __HIP_MEMORY_SCOPE_AGENT); }
__device__ __forceinline__ unsigned xb_xcc_id() { return (unsigned)__builtin_amdgcn_s_getreg((3 << 11) | 20) & 0xFu; }
#define XB_SPIN(cond, bar) do { unsigned _sp = 0; while (cond) { __builtin_amdgcn_s_sleep(1); \
    if ((++_sp & 255u) == 0u) { if (xb_ld(&(bar)[XB_TMO])) break; if (_sp > XB_SPIN_CAP) { atomicAdd(&(bar)[XB_TMO], 1u); break; } } } } while (0)

struct XcdBarrier {
    unsigned* bar; unsigned x;
    volatile LAS unsigned* st;
};

__device__ __forceinline__ XcdBarrier xcd_barrier_post(unsigned* bar, volatile LAS unsigned* st) {
    XcdBarrier b; b.bar = bar; b.x = xb_xcc_id(); b.st = st;
    if (threadIdx.x == 0) (void)xb_add(&bar[XB_XCNT(b.x)], 1u);
    return b;
}
__device__ __forceinline__ void xcd_barrier_complete(unsigned* bar, unsigned x, unsigned& nloc, unsigned& nx) {
    const unsigned G = gridDim.x * gridDim.y * gridDim.z;
    unsigned sum, cnt, mine, sp = 0u;
    for (;;) {
        sum = 0u; cnt = 0u; mine = 0u;
#pragma unroll
        for (unsigned j = 0; j < 16; ++j) { const unsigned c = xb_ld(&bar[XB_XCNT(j)]); sum += c; cnt += (c > 0u) ? 1u : 0u; mine = (j == x) ? c : mine; }
        if (sum == G) break;
        __builtin_amdgcn_s_sleep(1);
        if ((++sp & 255u) == 0u) { if (xb_ld(&bar[XB_TMO])) break; if (sp > XB_SPIN_CAP) { atomicAdd(&bar[XB_TMO], 1u); break; } }
    }
    nloc = mine > 0u ? mine : 1u; nx = cnt > 0u ? cnt : 1u;
}

__device__ __forceinline__ void xcd_barrier(const XcdBarrier& b) {
    asm volatile("s_waitcnt vmcnt(0)" ::: "memory");
    __syncthreads();
    if (threadIdx.x == 0) {
        unsigned* bar = b.bar;
        __builtin_amdgcn_s_waitcnt(0);
        unsigned nloc = b.st[0], nx = b.st[1];
        if (nloc == 0u) { xcd_barrier_complete(bar, b.x, nloc, nx); b.st[0] = nloc; b.st[1] = nx; }
        const unsigned old = xb_add(&bar[XB_XSUB(b.x)], 1u);
        const unsigned gen = old / nloc;
        if (old + 1u == (gen + 1u) * nloc) {
            __builtin_amdgcn_fence(__ATOMIC_RELEASE, "agent");
            asm volatile("s_waitcnt vmcnt(0)" ::: "memory");
            const unsigned og = xb_add(&bar[XB_TOP], 1u);
            const unsigned tg = og / nx;
            if (og + 1u == (tg + 1u) * nx) xb_add(&bar[XB_TOPGEN], 1u);
            else XB_SPIN(xb_ld(&bar[XB_TOPGEN]) == tg, bar);
            __builtin_amdgcn_fence(__ATOMIC_ACQUIRE, "agent");
            xb_add(&bar[XB_XGEN(b.x)], 1u);
            asm volatile("s_waitcnt vmcnt(0)" ::: "memory");
        } else {
            XB_SPIN(xb_ld(&bar[XB_XGEN(b.x)]) == gen, bar);
            __builtin_amdgcn_fence(__ATOMIC_ACQUIRE, "agent");
            asm volatile("s_waitcnt vmcnt(0)" ::: "memory");
        }
    }
    __syncthreads();
}

constexpr int NWAVES = 8;
constexpr size_t MiB = 1u << 20;
constexpr size_t WS_CTL = 0, CTL_ZERO_BYTES = 2 * MiB;
constexpr size_t WS_GRAN = 1 * MiB;
constexpr size_t WS_C64 = 381 * MiB + 42 * MiB, WS_S64 = WS_C64 + 256 * 1024, WS_C32 = WS_C64 + 512 * 1024, WS_S32 = WS_C64 + 640 * 1024, WS_RS = WS_C64 + 768 * 1024;
constexpr size_t WS_WGU = 2 * MiB, WGU_BYTES = (size_t)NGU * DM * 2;
constexpr size_t WS_WD = 46 * MiB, WD_BYTES = (size_t)DM * FF * 2;
constexpr size_t WS_WIN0 = 68 * MiB, WS_WOUT0 = 75 * MiB, WS_WIN1 = 77 * MiB, WS_WOUT1 = 83 * MiB;
constexpr size_t WS_MASK = 85 * MiB;
constexpr size_t WS_XB = 93 * MiB;
constexpr size_t WS_R1 = 157 * MiB;
constexpr size_t WS_Y = 381 * MiB;
constexpr size_t WS_SSQ1 = WS_Y + 40 * MiB, WS_SSQ2 = WS_Y + 41 * MiB;
constexpr size_t WS_ATT = 445 * MiB;
constexpr size_t WS_END = 509 * MiB;
static_assert(WS_WGU + 4 * WGU_BYTES <= WS_WD && WS_WD + 4 * WD_BYTES <= WS_WIN0 && WS_WIN0 + (size_t)NEV * DM * 2 <= WS_WOUT0 && WS_WIN1 + (size_t)NOD * DM * 2 <= WS_WOUT1, "weight map");
static_assert(WS_R1 + (size_t)MROWS * FF * 2 <= WS_Y && WS_R1 + 211 * MiB <= WS_Y, "R1 map");
constexpr int CW_BAR = 4096, CW_TMO = 0, CW_SEAM = 16384, SEAM_BANK = 128 * 64;
constexpr int FUSED_LDS_OFF = 131072 + 1024;
constexpr int RING_BYTES = 131072, LDSCTL_OFF = RING_BYTES, MISC_OFF = LDSCTL_OFF + 320, LDS_BYTES = 147456;

struct Frame {
    LAS unsigned char* lds; volatile LAS unsigned* MISC; gu32* ctl;
    int tid, lane, wave, vcu, G;
};

template <int X> __device__ __forceinline__ float swz_xor(float v) { return __int_as_float(__builtin_amdgcn_ds_swizzle(__float_as_int(v), (X << 10) | 0x1f)); }
__device__ __forceinline__ float sum32(float v) { v += swz_xor<1>(v); v += swz_xor<2>(v); v += swz_xor<4>(v); v += swz_xor<8>(v); v += swz_xor<16>(v); return v; }
__device__ __forceinline__ float wave_sum(float v) { return att::halfswap_sum(sum32(v)); }
struct MapGUHalf { int bj; __device__ __forceinline__ int src(int R) const { return R; } __device__ __forceinline__ int dst(int R) const { return 256 * (R >> 7) + 128 * bj + (R & 127); } };
struct MapId { __device__ __forceinline__ int src(int R) const { return R; } __device__ __forceinline__ int dst(int R) const { return R; } };
__device__ __forceinline__ int even_src(int R) {
    const int pn = R >> 8, bj = (R >> 7) & 1, jj = R & 127;
    if (pn < 4) return (pn < 2 ? 0 : 512) + (4 * (pn & 1) + (jj >> 5)) * 64 + 32 * bj + (jj & 31);
    if (pn < 6) return 1024 + 256 * (pn - 4) + 128 * bj + jj;
    if (pn < 10) return (pn < 8 ? 1536 : 2048) + (4 * (pn & 1) + (jj >> 5)) * 64 + 32 * bj + (jj & 31);
    if (pn < 12) return 2560 + 256 * (pn - 10) + 128 * bj + jj;
    if (pn == 12) return 3072 + (jj >> 4) * 32 + 16 * bj + (jj & 15);
    if (jj < 16) return 3328 + 16 * bj + jj;
    if (bj == 0 && jj < 24) return 3360 + (jj - 16);
    return -1;
}
struct MapEven { __device__ __forceinline__ int src(int R) const { return even_src(R); } __device__ __forceinline__ int dst(int R) const { return R; } };
template <class Map>
__device__ __forceinline__ void transpose_item(const Map& mp, const float* W, int ldw, int K, int nrows, bf16* WT, const float* g, LAS float* scr, int item, int lane) {
    const int nblk = nrows / 32, kb = item / nblk, nb = item % nblk, k0 = 64 * kb, n0 = 32 * nb;
    const int nl = 4 * (lane & 7), kl = lane >> 3;
    const int sc0 = mp.src(n0 + nl); const float mul = sc0 >= 0 ? 1.f : 0.f; const float* src = W + (sc0 >= 0 ? sc0 : 0) + (size_t)(k0 + kl) * ldw;
    f32x4 v[8];
#pragma unroll
    for (int i = 0; i < 8; ++i) v[i] = *(const GAS f32x4*)(src + (size_t)(8 * i) * ldw);
#pragma unroll
    for (int i = 0; i < 8; ++i) { const int kk = 8 * i + kl; const float gm = g ? g[k0 + kk] * mul : mul;
        scr[kk * 33 + nl] = v[i].x * gm; scr[kk * 33 + nl + 1] = v[i].y * gm; scr[kk * 33 + nl + 2] = v[i].z * gm; scr[kk * 33 + nl + 3] = v[i].w * gm; }
    LDS_WAIT(); asm volatile("" ::: "memory");
    const int c = lane & 7;
#pragma unroll
    for (int j = 0; j < 4; ++j) { const int n = (lane >> 3) + 8 * j; const LAS float* s = scr + (8 * c) * 33 + n;
        v4u o; o.x = pk2(s[0 * 33], s[1 * 33]); o.y = pk2(s[2 * 33], s[3 * 33]); o.z = pk2(s[4 * 33], s[5 * 33]); o.w = pk2(s[6 * 33], s[7 * 33]);
        *(GAS v4u*)(WT + (size_t)mp.dst(n0 + n) * K + k0 + 8 * c) = o; }
    LDS_WAIT(); asm volatile("" ::: "memory");
}
__device__ __forceinline__ void sincos_d(double a, float& sn, float& cs) {
    const double k = __builtin_rint(a * 0.6366197723675814); const double y = a - k * 1.5707963267948966; const double y2 = y * y;
    const double s = y * (1.0 + y2 * (-1.0 / 6 + y2 * (1.0 / 120 + y2 * (-1.0 / 5040 + y2 * (1.0 / 362880 + y2 * (-1.0 / 39916800 + y2 * (1.0 / 6227020800.0)))))));
    const double c = 1.0 + y2 * (-0.5 + y2 * (1.0 / 24 + y2 * (-1.0 / 720 + y2 * (1.0 / 40320 + y2 * (-1.0 / 3628800 + y2 * (1.0 / 479001600.0 + y2 * (-1.0 / 87178291200.0)))))));
    const int q = (int)((long long)k & 3);
    const double ss = (q == 0) ? s : (q == 1) ? c : (q == 2) ? -s : -c, cc = (q == 0) ? c : (q == 1) ? -s : (q == 2) ? -c : s;
    sn = (float)ss; cs = (float)cc;
}
__device__ __forceinline__ void x_to_bf16_rows4(const float* x, bf16* xb, float* ssq, int m, int dm, int lane) {
    f32x4 v[4][4]; float s[4];
#pragma unroll
    for (int r = 0; r < 4; ++r) { const GAS f32x4* xr = (const GAS f32x4*)(x + (size_t)(m + r * dm) * DM) + lane;
#pragma unroll
        for (int j = 0; j < 4; ++j) v[r][j] = xr[64 * j]; }
#pragma unroll
    for (int r = 0; r < 4; ++r) { s[r] = 0.f; GAS unsigned long long* o8 = (GAS unsigned long long*)(xb + (size_t)(m + r * dm) * DM) + lane;
#pragma unroll
        for (int j = 0; j < 4; ++j) { s[r] += (v[r][j].x * v[r][j].x + v[r][j].y * v[r][j].y) + (v[r][j].z * v[r][j].z + v[r][j].w * v[r][j].w);
            o8[64 * j] = (unsigned long long)epi::pkbf(v[r][j].x, v[r][j].y) | ((unsigned long long)epi::pkbf(v[r][j].z, v[r][j].w) << 32); } }
#pragma unroll
    for (int r = 0; r < 4; ++r) s[r] = sum32(s[r]);
#pragma unroll
    for (int r = 0; r < 4; ++r) { const float t = att::halfswap_sum(s[r]); if (lane == 0) *(f32x4*)(ssq + (size_t)(m + r * dm) * 4) = (f32x4){t, 0.f, 0.f, 0.f}; }
}
__device__ __forceinline__ void bf8_to_f32(const v4u& w, float (&f)[8]) {
#pragma unroll
    for (int i = 0; i < 4; ++i) { f[2 * i] = __uint_as_float(w[i] << 16); f[2 * i + 1] = __uint_as_float(w[i] & 0xffff0000u); } }
template <bool LAST>
__device__ __forceinline__ void thin_row(const bf16* yrow, bf16* xrow, float* outf, const float* ga, float alpha, float* rs, int lane) {
    float y[2][8], x[2][8]; float s = 0.f;
#pragma unroll
    for (int j = 0; j < 2; ++j) { const v4u yw = *((const GAS v4u*)yrow + lane + 64 * j), xw = *((const GAS v4u*)xrow + lane + 64 * j); bf8_to_f32(yw, y[j]); bf8_to_f32(xw, x[j]);
#pragma unroll
        for (int i = 0; i < 8; ++i) s += y[j][i] * y[j][i]; }
    const float r1 = alpha / sqrtf(wave_sum(s) * (1.f / DM) + RMS_EPS); float s2 = 0.f;
#pragma unroll
    for (int j = 0; j < 2; ++j) { const f32x4 g0 = *((const GAS f32x4*)ga + 2 * lane + 128 * j), g1 = *((const GAS f32x4*)ga + 2 * lane + 128 * j + 1);
#pragma unroll
        for (int i = 0; i < 8; ++i) { const float g = i < 4 ? g0[i & 3] : g1[i & 3]; x[j][i] += y[j][i] * g * r1; s2 += x[j][i] * x[j][i]; }
        if (LAST) { *((GAS f32x4*)outf + 2 * lane + 128 * j) = (f32x4){x[j][0], x[j][1], x[j][2], x[j][3]}; *((GAS f32x4*)outf + 2 * lane + 128 * j + 1) = (f32x4){x[j][4], x[j][5], x[j][6], x[j][7]}; }
        else { v4u o; o.x = epi::pkbf(x[j][0], x[j][1]); o.y = epi::pkbf(x[j][2], x[j][3]); o.z = epi::pkbf(x[j][4], x[j][5]); o.w = epi::pkbf(x[j][6], x[j][7]); *((GAS v4u*)xrow + lane + 64 * j) = o; } }
    if (!LAST) { const float r2 = 1.0f / sqrtf(wave_sum(s2) * (1.f / DM) + RMS_EPS); if (lane == 0) *rs = r2; }
}

struct Ptrs {
    const float *x, *norm_g, *wg, *wu, *wd, *ewin, *ewout, *elam, *esub, *owin, *owout, *obias; float* out; unsigned char* ws;
};

__device__ __forceinline__ void p0_prologue(Frame& F0, const Ptrs& P) {
    struct { LAS unsigned char* lds; int tid, lane, wave, vcu, G; } F;
    { int t = threadIdx.x; asm volatile("" : "+v"(t)); F.lds = F0.lds; F.tid = t; F.lane = t & 63; F.wave = __builtin_amdgcn_readfirstlane(t >> 6); F.vcu = F0.vcu; F.G = F0.G; }
    LAS float* scr = (LAS float*)(F.lds + F.wave * 16384);
    const int gw = F.vcu * NWAVES + F.wave, NGW = F.G * NWAVES;
    constexpr int I_GH = (DM / 64) * (FF / 32), I_WD = (FF / 64) * (DM / 32), I_E = (DM / 64) * (NEV / 32), I_O = (DM / 64) * (DM / 32), I_OD = (DM / 64) * (NOD / 32);
    constexpr int NITEMS = 8 * I_GH + 4 * I_WD + I_E + I_O + I_OD + I_O;
    for (int it = gw; it < NITEMS; it += NGW) {
        int r = it;
        if (r < 8 * I_GH) { const int i8 = r / I_GH; r -= i8 * I_GH; const int i = i8 >> 1, bj = i8 & 1, l = i >> 1, f = i & 1;
            MapGUHalf mp{bj}; const float* W = (bj ? P.wu : P.wg) + (size_t)i * DM * FF;
            transpose_item(mp, W, FF, DM, FF, (bf16*)(P.ws + WS_WGU + i * WGU_BYTES), P.norm_g + (l * 6 + 4 * f) * DM, scr, r, F.lane); continue; }
        r -= 8 * I_GH;
        if (r < 4 * I_WD) { const int i = r / I_WD; r -= i * I_WD; MapId mp;
            transpose_item(mp, P.wd + (size_t)i * FF * DM, DM, FF, DM, (bf16*)(P.ws + WS_WD + i * WD_BYTES), nullptr, scr, r, F.lane); continue; }
        r -= 4 * I_WD;
        if (r < I_E) { MapEven mp; transpose_item(mp, P.ewin, 3368, DM, NEV, (bf16*)(P.ws + WS_WIN0), P.norm_g + (0 * 6 + 2) * DM, scr, r, F.lane); continue; }
        r -= I_E;
        if (r < I_O) { MapId mp; transpose_item(mp, P.ewout, DM, DM, DM, (bf16*)(P.ws + WS_WOUT0), nullptr, scr, r, F.lane); continue; }
        r -= I_O;
        if (r < I_OD) { MapId mp; transpose_item(mp, P.owin, NOD, DM, NOD, (bf16*)(P.ws + WS_WIN1), P.norm_g + (1 * 6 + 2) * DM, scr, r, F.lane); continue; }
        r -= I_OD;
        { MapId mp; transpose_item(mp, P.owout, DM, DM, DM, (bf16*)(P.ws + WS_WOUT1), nullptr, scr, r, F.lane); }
    }
    float* c64 = (float*)(P.ws + WS_C64); float* s64 = (float*)(P.ws + WS_S64); float* c32 = (float*)(P.ws + WS_C32); float* s32 = (float*)(P.ws + WS_S32);
    const int gt = F.vcu * (NWAVES * 64) + F.tid, NGT = F.G * NWAVES * 64;
    for (int e = gt; e < SEQ * 48; e += NGT) {
        const bool is64 = e < SEQ * 32; const int ee = is64 ? e : e - SEQ * 32; const int pos = is64 ? (ee >> 5) : (ee >> 4), i = is64 ? (ee & 31) : (ee & 15);
        const double rb = is64 ? 0.7498942093324559 : 0.5623413251903492; double inv = 1.0; for (int k = 0; k < i; ++k) inv *= rb;
        const float ang = (float)pos * (float)inv; float sn, cs; sincos_d((double)ang, sn, cs);
        if (is64) { c64[ee] = cs; s64[ee] = sn; } else { c32[ee] = cs; s32[ee] = sn; }
    }
    bf16* XB = (bf16*)(P.ws + WS_XB); float* SSQ2 = (float*)(P.ws + WS_SSQ2);
    for (int m = gw; m < MROWS; m += 4 * NGW) x_to_bf16_rows4(P.x, XB, SSQ2, m, NGW, F.lane);
}
#ifndef PROBE_REP_IDXA
#define PROBE_REP_IDXA 1
#endif
#ifndef PROBE_REP_B
#define PROBE_REP_B 1
#endif
#ifndef PROBE_REP_C
#define PROBE_REP_C 1
#endif
#ifndef PROBE_REP_GU
#define PROBE_REP_GU 1
#endif
#ifndef PROBE_REP_DN
#define PROBE_REP_DN 1
#endif
#ifndef PROBE_NULL_GU
#define PROBE_NULL_GU 0
#endif
#ifndef PROBE_NULL_DN
#define PROBE_NULL_DN 0
#endif
#ifndef PROBE_REP_IDX
#define PROBE_REP_IDX 1
#endif
#ifndef PROBE_B_SKIP
#define PROBE_B_SKIP 0
#endif
#ifndef PROBE_B_HOT
#define PROBE_B_HOT 0
#endif
#ifndef PROBE_NOST_GU
#define PROBE_NOST_GU 0
#endif
#ifndef PROBE_FUSED_VAR
#define PROBE_FUSED_VAR 0
#endif
#ifndef PROBE_FUSED_DN
#define PROBE_FUSED_DN 0
#endif
#ifndef PROBE_REP_THIN
#define PROBE_REP_THIN 1
#endif
template <bool LAST>
__device__ __forceinline__ void thin_phase(Frame& F, const Ptrs& P, const float* ga, float alpha) {
    int t_ = threadIdx.x; asm volatile("" : "+v"(t_)); const int lane_ = t_ & 63, wave_ = __builtin_amdgcn_readfirstlane(t_ >> 6);
    const int gw = F.vcu * NWAVES + wave_, NGW = F.G * NWAVES;
    const bf16* Y = (const bf16*)(P.ws + WS_Y); bf16* XB = (bf16*)(P.ws + WS_XB); float* RS = (float*)(P.ws + WS_RS);
    for (int m = gw; m < MROWS; m += NGW) thin_row<LAST>(Y + (size_t)m * DM, XB + (size_t)m * DM, P.out + (size_t)m * DM, ga, alpha, RS + m, lane_);
}

__device__ __forceinline__ int wave_sum_i(int x) {
    x += __builtin_amdgcn_update_dpp(0, x, 0x111, 0xf, 0xf, true);
    x += __builtin_amdgcn_update_dpp(0, x, 0x112, 0xf, 0xf, true);
    x += __builtin_amdgcn_update_dpp(0, x, 0x114, 0xf, 0xf, true);
    x += __builtin_amdgcn_update_dpp(0, x, 0x118, 0xf, 0xf, true);
    return __builtin_amdgcn_readlane(x, 15) + __builtin_amdgcn_readlane(x, 31) + __builtin_amdgcn_readlane(x, 47) + __builtin_amdgcn_readlane(x, 63);
}
__device__ __forceinline__ void select_row(const unsigned (&u)[32], unsigned T, int cT, unsigned long long* mw, int lane) {
    if (cT == 256) {
#pragma unroll
        for (int i = 0; i < 32; ++i) { const unsigned long long w = __ballot(u[i] >= T); if (lane == 0) mw[i] = w; }
    } else {
        int cgt = 0;
#pragma unroll
        for (int i = 0; i < 32; ++i) cgt += __popcll(__ballot(u[i] > T));
        const int need = 256 - cgt; int base = 0; unsigned T2 = T; asm volatile("" : "+s"(T2));
#pragma unroll
        for (int i = 0; i < 32; ++i) {
            const bool eq = (u[i] == T2), gt = (u[i] > T2); const unsigned long long em = __ballot(eq);
            const int rank = (int)__builtin_amdgcn_mbcnt_hi((unsigned)(em >> 32), __builtin_amdgcn_mbcnt_lo((unsigned)em, (unsigned)base));
            const unsigned long long w = __ballot(gt || (eq && rank < need)); base += __popcll(em);
            if (lane == 0) mw[i] = w;
        }
    }
}
template <int VAR>
__device__ __forceinline__ void indexer_unit(Frame& F, const Ptrs& P, int b, int blk) {
    typedef short bf16x8v __attribute__((ext_vector_type(8)));
    int tid = threadIdx.x; asm volatile("" : "+v"(tid));
    const int q0 = blk * 16, qc = q0 >> 6, n64 = qc + 1, nvis = n64 * 64; const int lane = tid & 63, wid = __builtin_amdgcn_readfirstlane(tid >> 6);
    unsigned long long* mrow = (unsigned long long*)(P.ws + WS_MASK) + ((size_t)(b * SEQ + q0)) * 32;
    if (n64 <= 4) {
        for (int i = tid; i < 16 * 32; i += NWAVES * 64) { const int w = i & 31; if (w < n64) mrow[i] = ~0ull; }
        return;
    }
    const bf16* IQ = (const bf16*)(P.ws + WS_R1 + 192 * MiB); const bf16* IK = (const bf16*)(P.ws + WS_R1 + 208 * MiB); const float* IW = (const float*)(P.ws + WS_R1 + 210 * MiB);
    LAS float* sc = (LAS float*)F.lds;
    if (!(VAR & 1)) {
        const int q = lane & 15, kg = lane >> 4; const size_t qrow = (size_t)(b * SEQ + q0 + q);
        bf16x8v iq[8]; float wi[8];
#pragma unroll
        for (int h = 0; h < 8; ++h) { iq[h] = *(const bf16x8v*)(IQ + qrow * 256 + h * 32 + 8 * kg); wi[h] = IW[qrow * 8 + h]; }
        const int nt = (nvis / 16 - wid + NWAVES - 1) / NWAVES;
        const bf16* ikp = IK + ((size_t)(b * SEQ + wid * 16 + q)) * 32 + 8 * kg;
        bf16x8v af[16];
#pragma unroll
        for (int i = 0; i < 16; ++i) if (i < nt) af[i] = *(const bf16x8v*)(ikp + (size_t)i * (NWAVES * 16 * 32));
#pragma unroll
        for (int i = 0; i < 16; ++i) if (i < nt) {
            f32x4 acc = {0.f, 0.f, 0.f, 0.f};
#pragma unroll
            for (int h = 0; h < 8; ++h) { const f32x4 c = __builtin_amdgcn_mfma_f32_16x16x32_bf16(af[i], iq[h], (f32x4){0.f, 0.f, 0.f, 0.f}, 0, 0, 0);
#pragma unroll
                for (int j = 0; j < 4; ++j) acc[j] += wi[h] * fmaxf(c[j], 0.f); }
            const int col = ((wid + NWAVES * i) * 16 + kg * 4 + 4 * q) & 2047;
            *(LAS f32x4*)(sc + q * 2048 + col) = acc;
        }
    }
    __syncthreads();
    if (VAR != 7) {
        int n64l = n64; asm volatile("" : "+s"(n64l));
        unsigned ua[32], ub[32];
        { const int qa = 2 * wid, qb = 2 * wid + 1; const LAS float* ra = sc + qa * 2048; const LAS float* rb = sc + qb * 2048;
#pragma unroll
          for (int i = 0; i < 32; ++i) { const int e = i * 64 + lane;
              const unsigned ba = __float_as_uint(ra[(e + 4 * qa) & 2047]), bb = __float_as_uint(rb[(e + 4 * qb) & 2047]);
              const unsigned ka = (ba & 0x80000000u) ? ~ba : (ba | 0x80000000u), kb = (bb & 0x80000000u) ? ~bb : (bb | 0x80000000u);
              ua[i] = (i < n64l) ? ka : 0u; ub[i] = (i < n64l) ? kb : 0u; } }
        unsigned Ta = 0u, Tb = 0u; int cTa = nvis, cTb = nvis; bool da = false, db = false;
#pragma unroll 1
        for (int bit = (VAR & 2) ? -1 : 31; bit >= 0; --bit) {
            const unsigned ca = Ta | (1u << bit), cb = Tb | (1u << bit); int xa = 0, xb = 0;
#pragma unroll
            for (int g = 0; g < 4; ++g) if (n64l > 8 * g) {
#pragma unroll
                for (int i = 8 * g; i < 8 * g + 8; ++i) { xa += (ua[i] >= ca) ? 1 : 0; xb += (ub[i] >= cb) ? 1 : 0; } }
            const int na = wave_sum_i(xa), nb = wave_sum_i(xb);
            if (!da && na >= 256) { Ta = ca; cTa = na; if (na == 256) da = true; }
            if (!db && nb >= 256) { Tb = cb; cTb = nb; if (nb == 256) db = true; }
            if (da && db) break;
        }
        if (!(VAR & 4)) select_row(ua, (unsigned)__builtin_amdgcn_readfirstlane((int)Ta), __builtin_amdgcn_readfirstlane(cTa), mrow + (2 * wid) * 32, lane);
        if (!(VAR & 4)) select_row(ub, (unsigned)__builtin_amdgcn_readfirstlane((int)Tb), __builtin_amdgcn_readfirstlane(cTb), mrow + (2 * wid + 1) * 32, lane);
    }
    __syncthreads();
}

__device__ __forceinline__ void a_unit(Frame& F, const Ptrs& P, int b, int h, int qb, float lam) {
    using namespace att; typedef Lds<128> L;
    const bf16_t* AQ = (const bf16_t*)(P.ws + WS_R1); const bf16_t* AK = (const bf16_t*)(P.ws + WS_R1 + 32 * MiB); const bf16_t* AV = (const bf16_t*)(P.ws + WS_R1 + 64 * MiB);
    int tid = threadIdx.x; asm volatile("" : "+v"(tid));
    const int lane = tid & 63, wid = __builtin_amdgcn_readfirstlane(tid >> 6), r32 = lane & 31; const size_t rowbase = (size_t)b * SEQ; const int q0 = qb * 256, qw = q0 + wid * 32, qc = qw >> 6;
    f32x4* stash = (f32x4*)(P.ws + WS_Y) + ((size_t)(blockIdx.x * NWAVES + wid) * 16) * 64 + lane;
    f32x16 o[4];
#pragma unroll 1
    for (int c = 0; c < 2; ++c) {
        const int g = 2 * h + c;
        attn_core<128, 0, 4>(o, F.lds, AQ + (rowbase + qw) * 512 + g * 64, 512, AK + rowbase * 512 + g * 64, 512, AV + rowbase * 512 + h * 128, 512, 0, (q0 >> 6) + 4, 0, qc + 1, nullptr, 0, 0);
        if (c == 0) {
            f32x4* sp = stash; asm volatile("" : "+v"(sp));
#pragma unroll
            for (int d0 = 0; d0 < 4; ++d0)
#pragma unroll
                for (int rq = 0; rq < 4; ++rq) sp[(d0 * 4 + rq) * 64] = (f32x4){o[d0][4 * rq], o[d0][4 * rq + 1], o[d0][4 * rq + 2], o[d0][4 * rq + 3]};
        }
    }
    {
        const f32x4* sp = stash; asm volatile("" : "+v"(sp));
#pragma unroll
        for (int d0 = 0; d0 < 4; ++d0)
#pragma unroll
            for (int rq = 0; rq < 4; ++rq) { const f32x4 a = sp[(d0 * 4 + rq) * 64];
#pragma unroll
                for (int j = 0; j < 4; ++j) o[d0][4 * rq + j] = a[j] - lam * o[d0][4 * rq + j]; }
    }
    float sl[4];
#pragma unroll
    for (int d0 = 0; d0 < 4; ++d0) sl[d0] = P.esub[32 * d0 + r32] * 0.8f;
#pragma unroll
    for (int r = 0; r < 16; ++r) { float s = 0.f;
#pragma unroll
        for (int d0 = 0; d0 < 4; ++d0) s += o[d0][r] * o[d0][r];
        s = sum32(s);
        const float rstd = 1.0f / sqrtf(s * (1.f / 128.f) + RMS_EPS);
#pragma unroll
        for (int d0 = 0; d0 < 4; ++d0) o[d0][r] *= rstd * sl[d0]; }
    store_o<128>(o, F.lds, (bf16_t*)(P.ws + WS_ATT) + (rowbase + qw) * DM + h * 128, DM);
}
__device__ __forceinline__ void b_unit(Frame& F, const Ptrs& P, int b, int h, int qb, int hotmask = -1, int skip = 0) {
    using namespace att;
    const bf16_t* BQ = (const bf16_t*)(P.ws + WS_R1 + 96 * MiB); const bf16_t* BK = (const bf16_t*)(P.ws + WS_R1 + 128 * MiB); const bf16_t* BV = (const bf16_t*)(P.ws + WS_R1 + 160 * MiB);
    int tid = threadIdx.x; asm volatile("" : "+v"(tid));
    const int lane = tid & 63, wid = __builtin_amdgcn_readfirstlane(tid >> 6), r32 = lane & 31; const size_t rowbase = (size_t)b * SEQ; const int q0 = qb * 256, qw = q0 + wid * 32, qc = qw >> 6;
    const unsigned long long* mrow = (const unsigned long long*)(P.ws + WS_MASK) + (rowbase + qw + r32) * 32;
    f32x16 o[2];
    attn_core<64, 1, 4>(o, F.lds, BQ + (rowbase + qw) * 512 + h * 64, 512, BK + rowbase * 512 + h * 64, 512, BV + rowbase * 512 + h * 64, 512, 0, (q0 >> 6) + 4, 0, qc + 1, mrow, 0, 0, hotmask, skip);
    store_o<64>(o, F.lds, (bf16_t*)(P.ws + WS_ATT) + (rowbase + qw) * DM + 512 + h * 64, DM);
}
__device__ __forceinline__ void c_unit(Frame& F, const Ptrs& P, int b, int h, int qb) {
    using namespace att; typedef Lds<64> L;
    const bf16_t* CQ = (const bf16_t*)(P.ws + WS_R1); const bf16_t* CK = (const bf16_t*)(P.ws + WS_R1 + 64 * MiB); const bf16_t* CV = (const bf16_t*)(P.ws + WS_R1 + 128 * MiB);
    int tid = threadIdx.x; asm volatile("" : "+v"(tid));
    const int lane = tid & 63, wid = __builtin_amdgcn_readfirstlane(tid >> 6), r32 = lane & 31; const size_t rowbase = (size_t)b * SEQ; const int q0 = qb * 256, qw = q0 + wid * 32, qc = qw >> 6;
    LAS float* bt = (LAS float*)(F.lds + L::OFF_BT);
    for (int i = tid; i < 640; i += NWAVES * 64) bt[i] = P.obias[h * 320 + (i < 319 ? i : 319)] * LOG2E;
    const int c0 = q0 >> 6, T0 = c0 - 8 > 0 ? c0 - 8 : 0, tw0 = qc - 8 > 0 ? qc - 8 : 0;
    f32x16 o[2];
    attn_core<64, 2, 4>(o, F.lds, CQ + (rowbase + qw) * DM + h * 64, DM, CK + rowbase * DM + h * 64, DM, CV + rowbase * DM + h * 64, DM, T0, c0 + 4, tw0, qc + 1, nullptr, qw + r32, qc);
    store_o<64>(o, F.lds, (bf16_t*)(P.ws + WS_ATT) + (rowbase + qw) * DM + h * 64, DM);
}

#ifndef DBG_NO_IDX
#define DBG_NO_IDX 0
#endif
#ifndef DBG_NO_A
#define DBG_NO_A 0
#endif
#ifndef DBG_NO_B
#define DBG_NO_B 0
#endif
#ifndef DBG_STAGES
#define DBG_STAGES 99
#endif
struct Args { const float* in[12]; float* out; unsigned char* ws; };
__global__ void __launch_bounds__(NWAVES * 64, 2) fwd_kernel(Args args) {
    extern __shared__ __attribute__((aligned(16))) unsigned char lds[];
    Frame F;
    F.lds = (LAS unsigned char*)lds; F.MISC = (volatile LAS unsigned*)(F.lds + MISC_OFF);
    F.tid = threadIdx.x; F.lane = F.tid & 63; F.wave = __builtin_amdgcn_readfirstlane(F.tid >> 6);
    F.G = gridDim.x; { const int bx = blockIdx.x; F.vcu = (F.G % 8 == 0) ? (bx % 8) * (F.G / 8) + bx / 8 : bx; }
    Ptrs P; P.x = args.in[0]; P.norm_g = args.in[1]; P.wg = args.in[2]; P.wu = args.in[3]; P.wd = args.in[4]; P.ewin = args.in[5]; P.ewout = args.in[6]; P.elam = args.in[7]; P.esub = args.in[8];
    P.owin = args.in[9]; P.owout = args.in[10]; P.obias = args.in[11]; P.out = args.out; P.ws = args.ws;
    F.ctl = (gu32*)(P.ws + WS_CTL);
    for (int u = F.tid; u < (LDS_BYTES - LDSCTL_OFF) / 4; u += NWAVES * 64) ((LAS unsigned*)(F.lds + LDSCTL_OFF))[u] = 0u;
    __syncthreads();
    XcdBarrier bar = xcd_barrier_post((unsigned*)(F.ctl + CW_BAR), F.MISC + 8);
#define GRID_BAR() xcd_barrier(bar)
    bf16* XB = (bf16*)(P.ws + WS_XB); const float* RS = (const float*)(P.ws + WS_SSQ2); bf16* HID = (bf16*)(P.ws + WS_R1); bf16* Y = (bf16*)(P.ws + WS_Y); const bf16* ATT = (const bf16*)(P.ws + WS_ATT);

#ifdef PROBE_REP_PRO
    for (int rep_ = 1; rep_ < PROBE_REP_PRO; ++rep_) { p0_prologue(F, P); __syncthreads(); }
#endif
    p0_prologue(F, P); GRID_BAR();

#define FUSED_GEMM(Aop, Bop, Kdim, inst, gain, alpha_, LAST_) FUSED_GEMM_X(XB, (float*)(P.ws + WS_SSQ2), Aop, Bop, Kdim, inst, gain, alpha_, LAST_, 0)
#define FUSED_GEMM_X(Xp, SSQ2p, Aop, Bop, Kdim, inst, gain, alpha_, LAST_, PV_) do { \
        pg8::Gemm g{(Aop), (Bop), MROWS, DM, (Kdim)}; \
        epi::EpiRmsRes<LAST_, PV_> E{(Xp), P.out, (gain), (alpha_), (unsigned long long*)(P.ws + WS_GRAN), (unsigned)((inst) + 1), (SSQ2p), (unsigned*)(F.ctl + CW_TMO), F.lds + FUSED_LDS_OFF}; \
        pg8::StaticOrder S; S.init(MROWS, DM, F.G, (int)blockIdx.x); \
        pg8::gemm_phase<epi::EpiRmsRes<LAST_, PV_>, pg8::StaticOrder, true, true>(F.lds, g, S, E); } while (0)
#define FFN_PHASES(l, f, LAST_) do { \
        { pg8::Gemm g{XB, (const bf16*)(P.ws + WS_WGU + (2 * (l) + (f)) * WGU_BYTES), MROWS, NGU, DM}; pg8::StaticOrder S; S.init(MROWS, NGU, F.G, (int)blockIdx.x); \
          epi::EpiSwiGLU E{HID, RS}; for (int rep_ = 0; rep_ < PROBE_REP_GU; ++rep_) pg8::gemm_phase<epi::EpiSwiGLU, pg8::StaticOrder, true, true>(F.lds, g, S, E); \
          if (PROBE_NULL_GU) { epi::EpiNull EN; for (int rep_ = 0; rep_ < PROBE_NULL_GU; ++rep_) pg8::gemm_phase<epi::EpiNull, pg8::StaticOrder, true, true>(F.lds, g, S, EN); } \
          if (PROBE_NOST_GU) { epi::EpiSwiGLUT<1> EN{HID, RS}; pg8::gemm_phase<epi::EpiSwiGLUT<1>, pg8::StaticOrder, true, true>(F.lds, g, S, EN); } } \
        GRID_BAR(); \
        if (PROBE_FUSED_DN) { FUSED_GEMM_X((bf16*)(P.ws + WS_ATT), (float*)(P.ws + WS_SSQ1), HID, (const bf16*)(P.ws + WS_WD + (2 * (l) + (f)) * WD_BYTES), FF, 6 + 2 * (l) + (f), P.norm_g + ((l) * 6 + 4 * (f) + 1) * DM, 0.5f, false, PROBE_FUSED_VAR); GRID_BAR(); } \
        FUSED_GEMM(HID, (const bf16*)(P.ws + WS_WD + (2 * (l) + (f)) * WD_BYTES), FF, 3 * (l) + 2 * (f), P.norm_g + ((l) * 6 + 4 * (f) + 1) * DM, 0.5f, LAST_); \
        if (!(LAST_)) GRID_BAR(); } while (0)

    FFN_PHASES(0, 0, false);
    if (DBG_STAGES >= 2) {
        { pg8::Gemm g{XB, (const bf16*)(P.ws + WS_WIN0), MROWS, NEV, DM}; pg8::StaticOrder S; S.init(MROWS, NEV, F.G, (int)blockIdx.x);
          unsigned char* r1 = P.ws + WS_R1;
          epi::EpiProjEven E{(bf16*)r1, (bf16*)(r1 + 192 * MiB), (bf16*)(r1 + 208 * MiB),
                             (float*)(r1 + 210 * MiB), RS, (const float*)(P.ws + WS_C64), (const float*)(P.ws + WS_S64), (const float*)(P.ws + WS_C32), (const float*)(P.ws + WS_S32)};
          pg8::gemm_phase<epi::EpiProjEven, pg8::StaticOrder, true, true>(F.lds, g, S, E); }
        GRID_BAR();
#ifdef PROBE_IDX_VAR
        for (int p = F.vcu; p < 1024; p += F.G) { const int b = p >> 6, j = p & 63;
#pragma unroll 1
            for (int k = 0; k < 2; ++k) indexer_unit<PROBE_IDX_VAR>(F, P, b, k ? 127 - j : j); }
#endif
        for (int rep_ = 0; rep_ < PROBE_REP_IDXA * PROBE_REP_IDX; ++rep_)
        for (int p = F.vcu; p < 1024; p += F.G) { const int b = p >> 6, j = p & 63;
#pragma unroll 1
            for (int k = 0; k < 2; ++k) { if (!DBG_NO_IDX) indexer_unit<0>(F, P, b, k ? 127 - j : j); } }
        {
            float l01 = 0.f, l23 = 0.f;
            for (int i = 0; i < 64; ++i) { l01 += P.elam[i] * P.elam[64 + i]; l23 += P.elam[128 + i] * P.elam[192 + i]; }
            const float lam = expf(l01) - expf(l23) + 0.2f;
            for (int rep_ = 0; rep_ < PROBE_REP_IDXA; ++rep_)
            for (int p = F.vcu; p < 256; p += F.G) { const int bh = p >> 2, s = p & 3;
#pragma unroll 1
                for (int k = 0; k < 2; ++k) { if (!DBG_NO_A) a_unit(F, P, bh >> 2, bh & 3, k ? 7 - s : s, lam); } }
        }
        GRID_BAR();
        for (int rep_ = 0; rep_ < PROBE_REP_B; ++rep_)
        for (int p = F.vcu; p < 512; p += F.G) { const int bh = p >> 2, s = p & 3;
#pragma unroll 1
            for (int k = 0; k < 2; ++k) { if (!DBG_NO_B) b_unit(F, P, bh >> 3, bh & 7, k ? 7 - s : s, (PROBE_B_HOT && rep_ + 1 < PROBE_REP_B) ? 0 : -1, (rep_ + 1 < PROBE_REP_B) ? PROBE_B_SKIP : 0); } }
        GRID_BAR();
        FUSED_GEMM(ATT, (const bf16*)(P.ws + WS_WOUT0), DM, 3 * 0 + 1, P.norm_g + (0 * 6 + 3) * DM, 1.0f, false);
        GRID_BAR();
    }
    if (DBG_STAGES >= 3) FFN_PHASES(0, 1, false);
    if (DBG_STAGES >= 4) FFN_PHASES(1, 0, false);
    if (DBG_STAGES >= 5) {
        { pg8::Gemm g{XB, (const bf16*)(P.ws + WS_WIN1), MROWS, NOD, DM}; pg8::StaticOrder S; S.init(MROWS, NOD, F.G, (int)blockIdx.x);
          unsigned char* r1 = P.ws + WS_R1; epi::EpiProjOdd E{(bf16*)r1, RS};
          pg8::gemm_phase<epi::EpiProjOdd, pg8::StaticOrder, true, true>(F.lds, g, S, E); }
        GRID_BAR();
        for (int rep_ = 0; rep_ < PROBE_REP_C; ++rep_)
        for (int p = F.vcu; p < 256; p += F.G) { const int b = p >> 4, h = p & 15;
#pragma unroll 1
            for (int qb = 0; qb < 8; ++qb) c_unit(F, P, b, h, qb); }
        GRID_BAR();
        FUSED_GEMM(ATT, (const bf16*)(P.ws + WS_WOUT1), DM, 3 * 1 + 1, P.norm_g + (1 * 6 + 3) * DM, 1.0f, false);
        GRID_BAR();
    }
    if (DBG_STAGES >= 6) FFN_PHASES(1, 1, true);
}

extern "C" void kernel_launch(void* const* d_in, const int* in_sizes, int n_in, void* d_out, int out_size, void* d_ws, size_t ws_size, hipStream_t stream) {
    static int grid = 0;
    if (grid == 0) {
        if (n_in != 12 || in_sizes[0] != MROWS * DM || out_size != MROWS * DM || ws_size < WS_END) {
            fprintf(stderr, "kernel_launch: unexpected shapes / workspace (n_in %d, in0 %d, out %d, ws %zu, need %zu); nothing launched\n", n_in, n_in > 0 ? in_sizes[0] : -1, out_size, ws_size, (size_t)WS_END); grid = -1; return; }
        int dev = 0, cus = 0, per_cu = 0;
        if (hipGetDevice(&dev) != hipSuccess || hipDeviceGetAttribute(&cus, hipDeviceAttributeMultiprocessorCount, dev) != hipSuccess) { fprintf(stderr, "kernel_launch: device query failed\n"); grid = -1; return; }
        if (hipFuncSetAttribute((const void*)fwd_kernel, hipFuncAttributeMaxDynamicSharedMemorySize, LDS_BYTES) != hipSuccess) { fprintf(stderr, "kernel_launch: hipFuncSetAttribute failed\n"); grid = -1; return; }
        if (hipOccupancyMaxActiveBlocksPerMultiprocessor(&per_cu, (const void*)fwd_kernel, NWAVES * 64, LDS_BYTES) != hipSuccess || per_cu < 1)
            fprintf(stderr, "kernel_launch: note: occupancy query reports %d workgroups per CU\n", per_cu);
        (void)hipGetLastError();
        grid = cus;
        if (grid != 256) { fprintf(stderr, "kernel_launch: built for a 256-CU device (the fused epilogues pair workgroups by rounds of 256), found %d; nothing launched\n", cus); grid = -1; return; }
    }
    if (grid < 0) return;
    if (hipMemsetAsync((char*)d_ws + WS_CTL, 0, CTL_ZERO_BYTES, stream) != hipSuccess) { fprintf(stderr, "kernel_launch: memset failed\n"); return; }
    Args a{};
    for (int i = 0; i < 12; ++i) a.in[i] = (const float*)d_in[i];
    a.out = (float*)d_out; a.ws = (unsigned char*)d_ws;
    hipLaunchKernelGGL(fwd_kernel, dim3(grid), dim3(NWAVES * 64), LDS_BYTES, stream, a);
    const hipError_t le = hipPeekAtLastError();
    if (le != hipSuccess) fprintf(stderr, "kernel_launch: launch failed: %s\n", hipGetErrorName(le));
}
```

```cpp
#include <hip/hip_runtime.h>
#include <cstdio>
#include <cstdint>
namespace pg8 {
#define PG8_LAS __attribute__((address_space(3)))
typedef unsigned short bf16_t;
typedef short bf16x8 __attribute__((ext_vector_type(8)));
typedef float f32x4 __attribute__((ext_vector_type(4)));
typedef unsigned u32x4 __attribute__((ext_vector_type(4)));
constexpr int BM = 256, BK = 64, HALF = 128, HTB = HALF * BK * 2  , STAGE_BYTES = 8 * HTB, NXCD = 8, WGM = 8;

__host__ __device__ __forceinline__ int lds_byte(int r, int c) { const int st = (r >> 4) * 2 + (c >> 5), rr = r & 15, cc = c & 31, ob = rr * 64 + cc * 2; return st * 1024 + (ob ^ (((ob >> 9) & 1) << 5)); }
__host__ __device__ __forceinline__ void stage_rc(int b, int& R, int& C) { const int st = b / 1024, sb = b % 1024, swz = sb ^ (((sb >> 9) & 1) << 5); R = (st >> 1) * 16 + swz / 64; C = (st & 1) * 32 + (swz % 64) / 2; }
__host__ __device__ __forceinline__ int perm32(int rho) { const int n = rho >> 4, i = rho & 15; return 8 * (i >> 2) + 4 * n + (i & 3); }

struct Unit { int pm, pn; };
struct Gemm { const bf16_t* A; const bf16_t* Bt; int M, N, K; };

struct StaticOrder {
    int nM, nN, nwg, G, c;
    __host__ __device__ void init(int M, int N, int G_, int c_) { nM = M / BM; nN = N / BM; nwg = nM * nN; G = G_; c = c_; }
    __host__ __device__ bool next(int i, Unit& u) const {
        const long L = (long)i * G + c; if (L >= nwg) return false;
        int wgid = (int)L; { const int q = nwg / NXCD, r = nwg % NXCD, xcd = wgid % NXCD, off = wgid / NXCD; wgid = (xcd < r ? xcd * (q + 1) : r * (q + 1) + (xcd - r) * q) + off; }
        const int nig = WGM * nN, gid = wgid / nig, fm = gid * WGM, gsz = (nM - fm) < WGM ? (nM - fm) : WGM;
        u.pm = fm + ((wgid % nig) % gsz); u.pn = (wgid % nig) / gsz; return true;
    }
    __device__ __forceinline__ void a_ready(const Unit&) const {}
    __device__ __forceinline__ void done(const Unit&) const {}
};

__device__ __forceinline__ unsigned cvt_pk_bf16(float lo, float hi) { unsigned r; asm volatile("v_cvt_pk_bf16_f32 %0, %1, %2" : "=v"(r) : "v"(lo), "v"(hi)); return r; }
typedef float f32x2 __attribute__((ext_vector_type(2)));
__device__ __forceinline__ f32x2 gelu_pk(f32x2 v) {
    const f32x2 av = __builtin_elementwise_abs(v), d = av * 0.2316418882f + 1.0f;
    f32x2 t; t.x = __builtin_amdgcn_rcpf(d.x); t.y = __builtin_amdgcn_rcpf(d.y);
    f32x2 q = t * 0.5307027145f + (-0.7265760135f); q = q * t + 0.7107068705f; q = q * t + (-0.142248368f); q = q * t + 0.127414796f; q = q * t;
    const f32x2 s = (v * v) * (-0.72134752044f);
    f32x2 e; e.x = __builtin_amdgcn_exp2f(s.x); e.y = __builtin_amdgcn_exp2f(s.y);
    const f32x2 m = v * (q * e), r = v - m;
    f32x2 o; o.x = v.x < 0.f ? m.x : r.x; o.y = v.y < 0.f ? m.y : r.y; return o;
}

template <int ACT  > struct EpiBf16 {
    static constexpr bool PERM = true, AFTER_DRAIN = false; static_assert(ACT == 0 || ACT == 1, "EpiBf16: ACT is 0 (none) or 1 (gelu_pk)");
    bf16_t* O; int ldc; const float* bias; int split_cols; size_t split_stride; float scale0;
    __device__ __forceinline__ void operator()(const f32x4 (&acc)[2][2][4][2], const Unit& u, int wr, int wc, int fr, int fq) const {
        const int row0 = u.pm * BM + wr * 64 + fr; int colt = u.pn * BM; bf16_t* base = O;
        float sc = 1.f; if (split_cols) { const int t = colt / split_cols; base += (size_t)t * split_stride; colt -= t * split_cols; if (t == 0) sc = scale0; }
        const int col0 = colt + wc * 32 + 8 * fq, bcol0 = u.pn * BM + wc * 32 + 8 * fq;
        f32x4 bv[2][2];
#pragma unroll
        for (int bj = 0; bj < 2; ++bj)
#pragma unroll
            for (int n = 0; n < 2; ++n) bv[bj][n] = bias ? *(const f32x4*)(bias + bcol0 + bj * HALF + 4 * n) : (f32x4){0.f, 0.f, 0.f, 0.f};
#pragma unroll
        for (int ai = 0; ai < 2; ++ai)
#pragma unroll
            for (int m = 0; m < 4; ++m) { bf16_t* rowp = base + (size_t)(row0 + ai * HALF + m * 16) * ldc + col0;
#pragma unroll
                for (int bj = 0; bj < 2; ++bj) { f32x4 v0 = acc[ai][bj][m][0] + bv[bj][0], v1 = acc[ai][bj][m][1] + bv[bj][1];
                    if (ACT == 1) { f32x2 a = gelu_pk((f32x2){v0[0], v0[1]}), b = gelu_pk((f32x2){v0[2], v0[3]}), c = gelu_pk((f32x2){v1[0], v1[1]}), d = gelu_pk((f32x2){v1[2], v1[3]});
                        v0 = (f32x4){a.x, a.y, b.x, b.y}; v1 = (f32x4){c.x, c.y, d.x, d.y}; }
                    v0 = v0 * sc; v1 = v1 * sc; u32x4 w; w.x = cvt_pk_bf16(v0[0], v0[1]); w.y = cvt_pk_bf16(v0[2], v0[3]); w.z = cvt_pk_bf16(v1[0], v1[1]); w.w = cvt_pk_bf16(v1[2], v1[3]);
                    *(u32x4*)(rowp + bj * HALF) = w; } }
    }
};

struct PanelStats {
    unsigned* xbuf;
    unsigned* cnt;
    unsigned* tmo;
    int ntn; float eps;
    unsigned code;
    __device__ __forceinline__ bool run(const f32x4 (&v)[2][2][4][2], const Unit& u, int wr, int wc, int fr, int fq, PG8_LAS unsigned char* lds, int wid, int lane) const {
        typedef float f32x2v __attribute__((ext_vector_type(2)));
        PG8_LAS f32x2v* P = (PG8_LAS f32x2v*)lds;
        PG8_LAS f32x2v* S = (PG8_LAS f32x2v*)(lds + 8192);
        PG8_LAS unsigned* flag = (PG8_LAS unsigned*)(lds + 8192 + 2048);
#pragma unroll
        for (int ai = 0; ai < 2; ++ai)
#pragma unroll
            for (int m = 0; m < 4; ++m) {
                float s = 0.f;
#pragma unroll
                for (int bj = 0; bj < 2; ++bj)
#pragma unroll
                    for (int n = 0; n < 2; ++n) { const f32x4 x = v[ai][bj][m][n]; s += (x[0] + x[1]) + (x[2] + x[3]); }
                s += __shfl_xor(s, 16); s += __shfl_xor(s, 32);
                const float mw = s * (1.0f / 64.0f); float q = 0.f;
#pragma unroll
                for (int bj = 0; bj < 2; ++bj)
#pragma unroll
                    for (int n = 0; n < 2; ++n) { const f32x4 d = v[ai][bj][m][n] - mw; q += (d[0] * d[0] + d[1] * d[1]) + (d[2] * d[2] + d[3] * d[3]); }
                q += __shfl_xor(q, 16); q += __shfl_xor(q, 32);
                if (fq == 0) P[(ai * HALF + wr * 64 + m * 16 + fr) * 4 + wc] = (f32x2v){mw, q};
            }
        asm volatile("s_waitcnt lgkmcnt(0)" ::: "memory"); __builtin_amdgcn_s_barrier(); asm volatile("" ::: "memory");
#if defined(BROKEN_EXCHANGE_NO_WAIT)
#warning BROKEN CONTROL BUILD: the row-statistics exchange does not wait; results are wrong by design
        if (blockIdx.x >= 64) { const long long t0_ = clock64(); while (clock64() - t0_ < 60000) __builtin_amdgcn_s_sleep(8); }
#endif
        const int row = wid * 32 + (lane & 31);
        if (lane < 32) {
            const f32x2v a = P[row * 4 + 0], b = P[row * 4 + 1], c = P[row * 4 + 2], d = P[row * 4 + 3];
            const float mt = (a.x + b.x + c.x + d.x) * 0.25f;
            const float da = a.x - mt, db = b.x - mt, dc = c.x - mt, dd = d.x - mt;
            const float m2 = (a.y + b.y) + (c.y + d.y) + 64.0f * ((da * da + db * db) + (dc * dc + dd * dd));
            unsigned long long* slot = (unsigned long long*)xbuf + ((size_t)(u.pm * BM + row) * 4 + u.pn);
            __hip_atomic_store(slot, ((unsigned long long)__float_as_uint(m2) << 32) | __float_as_uint(mt), __ATOMIC_RELAXED, __HIP_MEMORY_SCOPE_AGENT);
        }
        asm volatile("s_waitcnt vmcnt(0)" ::: "memory");
        if (lane == 0) __hip_atomic_fetch_add(cnt + 64 * u.pm, 1u, __ATOMIC_RELAXED, __HIP_MEMORY_SCOPE_AGENT);
        if (wid == 0) {
            bool dead = false; const unsigned long long t0 = __builtin_amdgcn_s_memrealtime(); const unsigned want = 8u * (unsigned)ntn;
            for (;;) {
#if defined(BROKEN_EXCHANGE_NO_WAIT)
                break;
#endif
                if ((unsigned)__builtin_amdgcn_readfirstlane(__hip_atomic_load(cnt + 64 * u.pm, __ATOMIC_RELAXED, __HIP_MEMORY_SCOPE_AGENT)) >= want) break;
                if (__builtin_amdgcn_s_memrealtime() - t0 > 2000000ull) {
                    if (lane == 0) { unsigned expect = 0u; __hip_atomic_compare_exchange_strong(tmo + 1, &expect, code | (unsigned)(u.pm & 0xff), __ATOMIC_RELAXED, __ATOMIC_RELAXED, __HIP_MEMORY_SCOPE_AGENT);
                                     __hip_atomic_store(tmo, 1u, __ATOMIC_RELAXED, __HIP_MEMORY_SCOPE_AGENT); }
                    dead = true; break; }
                __builtin_amdgcn_s_sleep(2);
            }
            __builtin_amdgcn_fence(__ATOMIC_ACQUIRE, "agent");
            if (lane == 0) flag[0] = dead ? 1u : 0u;
        }
        asm volatile("s_waitcnt vmcnt(0) lgkmcnt(0)" ::: "memory"); __builtin_amdgcn_s_barrier(); asm volatile("" ::: "memory");
        const bool bad = flag[0] != 0u;
        if (lane < 32) {
            const unsigned long long* slot = (const unsigned long long*)xbuf + (size_t)(u.pm * BM + row) * 4; float mt[4], m2[4]; float ms = 0.f;
#pragma unroll
            for (int t = 0; t < 4; ++t) { if (t < ntn) { const unsigned long long w = __hip_atomic_load(slot + t, __ATOMIC_RELAXED, __HIP_MEMORY_SCOPE_AGENT); mt[t] = __uint_as_float((unsigned)w); m2[t] = __uint_as_float((unsigned)(w >> 32)); } else { mt[t] = 0.f; m2[t] = 0.f; } ms += mt[t]; }
            const float mean = ms / (float)ntn; float q = 0.f;
#pragma unroll
            for (int t = 0; t < 4; ++t) if (t < ntn) { const float dm = mt[t] - mean; q += m2[t] + 256.0f * dm * dm; }
            S[row] = (f32x2v){mean, 1.0f / sqrtf(q / (256.0f * (float)ntn) + eps)};
        }
        asm volatile("s_waitcnt lgkmcnt(0)" ::: "memory"); __builtin_amdgcn_s_barrier(); asm volatile("" ::: "memory");
        return bad;
    }
};
struct EpiLnRes {
    static constexpr bool PERM = false, AFTER_DRAIN = true;
    const float* base; float* out; int ldc; const float* bias; PanelStats st; unsigned poison;
    __device__ __forceinline__ void fused(f32x4 (&acc)[2][2][4][2], const Unit& u, int wr, int wc, int fr, int fq, PG8_LAS unsigned char* lds, int wid, int lane) const {
        typedef float f32x2v __attribute__((ext_vector_type(2)));
        const PG8_LAS f32x2v* S = (const PG8_LAS f32x2v*)(lds + 8192);
        const int col0 = u.pn * BM + wc * 32 + 4 * fq;
#pragma unroll
        for (int bj = 0; bj < 2; ++bj)
#pragma unroll
            for (int n = 0; n < 2; ++n) { const f32x4 bv = bias ? *(const f32x4*)(bias + col0 + bj * HALF + n * 16) : (f32x4){0.f, 0.f, 0.f, 0.f};
#pragma unroll
                for (int ai = 0; ai < 2; ++ai)
#pragma unroll
                    for (int m = 0; m < 4; ++m) acc[ai][bj][m][n] += bv; }
        f32x4 pre[4][2][2];
#pragma unroll
        for (int m = 0; m < 4; ++m) { const size_t off = (size_t)(u.pm * BM + wr * 64 + m * 16 + fr) * ldc + col0;
#pragma unroll
            for (int bj = 0; bj < 2; ++bj)
#pragma unroll
                for (int n = 0; n < 2; ++n) pre[m][bj][n] = *(const f32x4*)(base + off + bj * HALF + n * 16); }
        const bool bad = st.run(acc, u, wr, wc, fr, fq, lds, wid, lane) || poison != 0u;
        const float qnan = __builtin_nanf("");
#pragma unroll
        for (int ai = 0; ai < 2; ++ai)
#pragma unroll
            for (int m = 0; m < 4; ++m) { const int r = ai * HALF + wr * 64 + m * 16 + fr; const f32x2v sr = S[r]; const size_t off = (size_t)(u.pm * BM + r) * ldc + col0;
#pragma unroll
                for (int bj = 0; bj < 2; ++bj)
#pragma unroll
                    for (int n = 0; n < 2; ++n) { const f32x4 bs = ai == 0 ? pre[m][bj][n] : *(const f32x4*)(base + off + bj * HALF + n * 16); f32x4 o = bs + (acc[ai][bj][m][n] - sr.x) * sr.y;
                        if (bad) o = (f32x4){qnan, qnan, qnan, qnan}; *(f32x4*)(out + off + bj * HALF + n * 16) = o; }
                if (m & 1) asm volatile("" ::: "memory"); }
    }
};
struct EpiLnResLn {
    static constexpr bool PERM = false, AFTER_DRAIN = true;
    const float* base; float* out; bf16_t* xn; int ldc; const float* bias; PanelStats st1, st2; unsigned poison;
    __device__ __forceinline__ void fused(f32x4 (&acc)[2][2][4][2], const Unit& u, int wr, int wc, int fr, int fq, PG8_LAS unsigned char* lds, int wid, int lane) const {
        typedef float f32x2v __attribute__((ext_vector_type(2))); typedef unsigned u32x2v __attribute__((ext_vector_type(2)));
        const PG8_LAS f32x2v* S = (const PG8_LAS f32x2v*)(lds + 8192);
        const int col0 = u.pn * BM + wc * 32 + 4 * fq;
#pragma unroll
        for (int bj = 0; bj < 2; ++bj)
#pragma unroll
            for (int n = 0; n < 2; ++n) { const f32x4 bv = bias ? *(const f32x4*)(bias + col0 + bj * HALF + n * 16) : (f32x4){0.f, 0.f, 0.f, 0.f};
#pragma unroll
                for (int ai = 0; ai < 2; ++ai)
#pragma unroll
                    for (int m = 0; m < 4; ++m) acc[ai][bj][m][n] += bv; }
        bool bad = st1.run(acc, u, wr, wc, fr, fq, lds, wid, lane) || poison != 0u;
        const float qnan = __builtin_nanf("");
#pragma unroll
        for (int ai = 0; ai < 2; ++ai)
#pragma unroll
            for (int m = 0; m < 4; ++m) { const int r = ai * HALF + wr * 64 + m * 16 + fr; const f32x2v sr = S[r]; const size_t off = (size_t)(u.pm * BM + r) * ldc + col0;
#pragma unroll
                for (int bj = 0; bj < 2; ++bj)
#pragma unroll
                    for (int n = 0; n < 2; ++n) { const f32x4 bs = *(const f32x4*)(base + off + bj * HALF + n * 16); acc[ai][bj][m][n] = bs + (acc[ai][bj][m][n] - sr.x) * sr.y; }
                asm volatile("" : "+v"(acc[ai][0][m][0]), "+v"(acc[ai][0][m][1]), "+v"(acc[ai][1][m][0]), "+v"(acc[ai][1][m][1]));
                if (m & 1) asm volatile("" ::: "memory"); }
        const bool bad1 = bad;
        bad = st2.run(acc, u, wr, wc, fr, fq, lds, wid, lane) || bad;
#pragma unroll
        for (int ai = 0; ai < 2; ++ai)
#pragma unroll
            for (int m = 0; m < 4; ++m) { const int r = ai * HALF + wr * 64 + m * 16 + fr; const f32x2v sr = S[r]; const size_t off = (size_t)(u.pm * BM + r) * ldc + col0;
#pragma unroll
                for (int bj = 0; bj < 2; ++bj)
#pragma unroll
                    for (int n = 0; n < 2; ++n) { const f32x4 x1 = acc[ai][bj][m][n]; *(f32x4*)(out + off + bj * HALF + n * 16) = bad1 ? (f32x4){qnan, qnan, qnan, qnan} : x1;
                        const f32x4 o = (x1 - sr.x) * sr.y; u32x2v w; w.x = cvt_pk_bf16(o[0], o[1]); w.y = cvt_pk_bf16(o[2], o[3]);
                        if (bad) { w.x = 0x7fc07fc0u; w.y = 0x7fc07fc0u; } *(u32x2v*)(xn + off + bj * HALF + n * 16) = w; }
                asm volatile("" ::: "memory"); }
    }
};

template <class Epi, class Sched, bool ALIGN_EPI = false, bool SP2 = false>
__device__ __forceinline__ void gemm_phase(PG8_LAS unsigned char* lds, const Gemm g, const Sched& S, const Epi& E) {
    int tid_ = threadIdx.x; asm volatile("" : "+v"(tid_));
    const int tid = tid_, wid = __builtin_amdgcn_readfirstlane(tid >> 6), lane = tid & 63, wr = wid >> 2, wc = wid & 3, fr = lane & 15, fq = lane >> 4;
    const int K = g.K, nt = K / BK;
    unsigned voffA[2], voffB[2];
#pragma unroll
    for (int i = 0; i < 2; ++i) { int R, C; stage_rc(tid * 16 + i * 8192, R, C); const int Rb = Epi::PERM ? ((R & ~31) + perm32(R & 31)) : R;
        voffA[i] = (unsigned)(R * K + C) * 2u; voffB[i] = (unsigned)(Rb * K + C) * 2u; }
    const size_t kstep = (size_t)(BK * 2);
    const size_t hstep = (size_t)HALF * K * 2;
    const size_t tstep = 2 * hstep;
    const unsigned ldsw = (unsigned)wid * 1024u;
    const int aoff = lds_byte(wr * 64 + fr, fq * 8), boff = lds_byte(wc * 32 + fr, fq * 8);
#define PG8_SA(b, h) (((b) * 2 + (h)) * HTB)
#define PG8_SB(b, h) ((4 + (b) * 2 + (h)) * HTB)
#define PG8_STAGE(bufoff, gbase, voff) do { _Pragma("unroll") for (int _i = 0; _i < 2; ++_i) \
        __builtin_amdgcn_global_load_lds((const unsigned*)((const char*)(gbase) + (voff)[_i]), (PG8_LAS unsigned*)(lds + (bufoff) + ldsw + _i * 8192), 16, 0, 0); } while (0)
#define PG8_LDA(dst, b, h) do { _Pragma("unroll") for (int m = 0; m < 4; ++m) _Pragma("unroll") for (int k = 0; k < 2; ++k) dst[m][k] = *(const PG8_LAS bf16x8*)(lds + PG8_SA(b, h) + aoff + m * 2048 + k * 1024); } while (0)
#define PG8_LDB(dst, b, h) do { _Pragma("unroll") for (int n = 0; n < 2; ++n) _Pragma("unroll") for (int k = 0; k < 2; ++k) dst[n][k] = *(const PG8_LAS bf16x8*)(lds + PG8_SB(b, h) + boff + n * 2048 + k * 1024); } while (0)
#define PG8_MMA(ai, bj, At, Bt) do { __builtin_amdgcn_s_setprio(1); _Pragma("unroll") for (int m = 0; m < 4; ++m) _Pragma("unroll") for (int n = 0; n < 2; ++n) _Pragma("unroll") for (int k = 0; k < 2; ++k) \
        acc[ai][bj][m][n] = __builtin_amdgcn_mfma_f32_16x16x32_bf16(Bt[n][k], At[m][k], acc[ai][bj][m][n], 0, 0, 0); __builtin_amdgcn_s_setprio(0); } while (0)
#define PG8_WAIT_V(n) asm volatile("s_waitcnt vmcnt(" #n ")" ::: "memory")
#define PG8_WAIT_L(n) asm volatile("s_waitcnt lgkmcnt(" #n ")" ::: "memory")
#define PG8_BAR __builtin_amdgcn_s_barrier()
#define PG8_SCHED __builtin_amdgcn_sched_barrier(0)
    Unit cur, nxt; int ui = 0;
    if (!S.next(0, cur)) return;
    f32x4 acc[2][2][4][2];
#pragma unroll
    for (int a = 0; a < 2; ++a)
#pragma unroll
        for (int b = 0; b < 2; ++b)
#pragma unroll
            for (int m = 0; m < 4; ++m)
#pragma unroll
                for (int n = 0; n < 2; ++n) acc[a][b][m][n] = (f32x4){0.f, 0.f, 0.f, 0.f};
    bf16x8 At[4][2], B0[2][2], B1[2][2];
    const char* cA = (const char*)g.A + (size_t)cur.pm * tstep; const char* cB = (const char*)g.Bt + (size_t)cur.pn * tstep;
    S.a_ready(cur);
    if constexpr (SP2) {
        PG8_STAGE(PG8_SB(0, 0), cB, voffB); PG8_STAGE(PG8_SB(0, 1), cB + hstep, voffB); PG8_STAGE(PG8_SA(0, 0), cA, voffA); PG8_STAGE(PG8_SA(0, 1), cA + hstep, voffA);
        if (wr == 1) PG8_BAR;
        PG8_WAIT_V(2); PG8_BAR;
        PG8_STAGE(PG8_SB(1, 0), cB + kstep, voffB); PG8_STAGE(PG8_SA(1, 0), cA + kstep, voffA); PG8_STAGE(PG8_SB(1, 1), cB + hstep + kstep, voffB);
        PG8_WAIT_V(6); PG8_BAR;
    } else {
        PG8_STAGE(PG8_SB(0, 0), cB, voffB); PG8_STAGE(PG8_SA(0, 0), cA, voffA); PG8_STAGE(PG8_SB(0, 1), cB + hstep, voffB); PG8_STAGE(PG8_SA(0, 1), cA + hstep, voffA);
        if (wr == 1) PG8_BAR;
        PG8_WAIT_V(4); PG8_BAR;
        PG8_STAGE(PG8_SB(1, 0), cB + kstep, voffB); PG8_STAGE(PG8_SA(1, 0), cA + kstep, voffA); PG8_STAGE(PG8_SB(1, 1), cB + hstep + kstep, voffB);
        PG8_WAIT_V(6); PG8_BAR;
    }
    for (;;) {
        const bool has_next = S.next(ui + 1, nxt);
        const char* nA = has_next ? (const char*)g.A + (size_t)nxt.pm * tstep : cA; const char* nB = has_next ? (const char*)g.Bt + (size_t)nxt.pn * tstep : cB;
        for (int t = 0; t < nt; t += 2) {
            const bool last = (t == nt - 2);
            const char* a1 = cA + (size_t)(t + 1) * kstep;
            const char* a2 = last ? nA : cA + (size_t)(t + 2) * kstep; const char* b2 = last ? nB : cB + (size_t)(t + 2) * kstep;
            const char* a3 = a2 + kstep; const char* b3 = b2 + kstep;
            if (last && has_next) S.a_ready(nxt);
            if constexpr (SP2) {
            PG8_LDB(B0, 0, 0); PG8_LDB(B1, 0, 1); PG8_SCHED; PG8_LDA(At, 0, 0); PG8_STAGE(PG8_SA(1, 1), a1 + hstep, voffA);
            PG8_WAIT_V(8); PG8_WAIT_L(0); PG8_BAR; PG8_MMA(0, 0, At, B0); PG8_MMA(0, 1, At, B1); PG8_BAR; PG8_SCHED;
            PG8_LDA(At, 0, 1); PG8_STAGE(PG8_SB(0, 0), b2, voffB); PG8_STAGE(PG8_SB(0, 1), b2 + hstep, voffB); PG8_STAGE(PG8_SA(0, 0), a2, voffA);
            PG8_WAIT_V(8); PG8_WAIT_L(0); PG8_BAR; PG8_MMA(1, 0, At, B0); PG8_MMA(1, 1, At, B1); PG8_BAR; PG8_SCHED;
            PG8_LDB(B0, 1, 0); PG8_LDB(B1, 1, 1); PG8_SCHED; PG8_LDA(At, 1, 0); PG8_STAGE(PG8_SA(0, 1), a2 + hstep, voffA);
            PG8_WAIT_V(8); PG8_WAIT_L(0); PG8_BAR; PG8_MMA(0, 0, At, B0); PG8_MMA(0, 1, At, B1); PG8_BAR; PG8_SCHED;
            PG8_LDA(At, 1, 1); PG8_STAGE(PG8_SB(1, 0), b3, voffB); PG8_STAGE(PG8_SB(1, 1), b3 + hstep, voffB); PG8_STAGE(PG8_SA(1, 0), a3, voffA);
            PG8_WAIT_V(8); PG8_WAIT_L(0); PG8_BAR; PG8_MMA(1, 0, At, B0); PG8_MMA(1, 1, At, B1); PG8_BAR; PG8_SCHED;
            } else {
            PG8_LDB(B0, 0, 0); PG8_SCHED; PG8_LDA(At, 0, 0); PG8_STAGE(PG8_SA(1, 1), a1 + hstep, voffA);
            PG8_WAIT_L(8); PG8_BAR; PG8_WAIT_L(0); PG8_MMA(0, 0, At, B0); PG8_BAR; PG8_SCHED;
            PG8_LDB(B1, 0, 1); PG8_STAGE(PG8_SB(0, 0), b2, voffB);
            PG8_BAR; PG8_WAIT_L(0); PG8_MMA(0, 1, At, B1); PG8_BAR;
            PG8_LDA(At, 0, 1); PG8_STAGE(PG8_SA(0, 0), a2, voffA);
            PG8_BAR; PG8_WAIT_L(0); PG8_MMA(1, 0, At, B0); PG8_BAR; PG8_SCHED;
            PG8_STAGE(PG8_SB(0, 1), b2 + hstep, voffB);
            PG8_WAIT_V(6); PG8_BAR; PG8_MMA(1, 1, At, B1); PG8_BAR;
            PG8_LDB(B0, 1, 0); PG8_SCHED; PG8_LDA(At, 1, 0); PG8_STAGE(PG8_SA(0, 1), a2 + hstep, voffA);
            PG8_WAIT_L(8); PG8_BAR; PG8_WAIT_L(0); PG8_MMA(0, 0, At, B0); PG8_BAR; PG8_SCHED;
            PG8_LDB(B1, 1, 1); PG8_STAGE(PG8_SB(1, 0), b3, voffB);
            PG8_BAR; PG8_WAIT_L(0); PG8_MMA(0, 1, At, B1); PG8_BAR;
            PG8_LDA(At, 1, 1); PG8_STAGE(PG8_SA(1, 0), a3, voffA);
            PG8_BAR; PG8_WAIT_L(0); PG8_MMA(1, 0, At, B0); PG8_BAR; PG8_SCHED;
            PG8_STAGE(PG8_SB(1, 1), b3 + hstep, voffB);
            PG8_WAIT_V(6); PG8_BAR; PG8_MMA(1, 1, At, B1); PG8_BAR;
            }
        }
        if constexpr (ALIGN_EPI) { if (wr == 0) PG8_BAR; }
        if constexpr (!Epi::AFTER_DRAIN) { E(acc, cur, wr, wc, fr, fq); S.done(cur); }
        if (!has_next) break;
#pragma unroll
        for (int a = 0; a < 2; ++a)
#pragma unroll
            for (int b = 0; b < 2; ++b)
#pragma unroll
                for (int m = 0; m < 4; ++m)
#pragma unroll
                    for (int n = 0; n < 2; ++n) acc[a][b][m][n] = (f32x4){0.f, 0.f, 0.f, 0.f};
        cur = nxt; cA = nA; cB = nB; ++ui;
        if constexpr (ALIGN_EPI) { if (wr == 1) PG8_BAR; }
    }
    PG8_WAIT_V(0);
    if constexpr (!ALIGN_EPI) { if (wr == 0) PG8_BAR; }
    PG8_BAR;
    if constexpr (Epi::AFTER_DRAIN) { E.fused(acc, cur, wr, wc, fr, fq, lds, wid, lane); S.done(cur); }
#undef PG8_SA
#undef PG8_SB
#undef PG8_STAGE
#undef PG8_LDA
#undef PG8_LDB
#undef PG8_MMA
#undef PG8_WAIT_V
#undef PG8_WAIT_L
#undef PG8_BAR
#undef PG8_SCHED
}
}

constexpr int NB = 16, SEQ = 2048, DM = 1024, FF = 2816, MROWS = NB * SEQ;
constexpr int NGU = 2 * FF;
constexpr int NEV = 3584;
constexpr int NOD = 3072;
constexpr float RMS_EPS = 1e-6f;
constexpr float LOG2E = 1.4426950408889634f;
constexpr float QSCALE = 0.125f * LOG2E;

namespace epi {
using namespace pg8;
__device__ __forceinline__ unsigned pkbf(float lo, float hi) {
    typedef float f2_t __attribute__((ext_vector_type(2))); typedef __bf16 b2_t __attribute__((ext_vector_type(2)));
    f2_t v = {lo, hi}; b2_t b = __builtin_convertvector(v, b2_t); return __builtin_bit_cast(unsigned, b); }
__device__ __forceinline__ float row_rs(const float* ssq, int row) { const f32x4 p = *(const f32x4*)(ssq + (size_t)row * 4); return __builtin_amdgcn_rsqf(((p[0] + p[1]) + (p[2] + p[3])) * (1.f / DM) + RMS_EPS); }
__device__ __forceinline__ float epi_sum4fq(float s) {
    s += __int_as_float(__builtin_amdgcn_ds_swizzle(__float_as_int(s), (16 << 10) | 0x1f));
    auto rr = __builtin_amdgcn_permlane32_swap(__float_as_uint(s), __float_as_uint(s), false, false); return __uint_as_float(rr[0]) + __uint_as_float(rr[1]); }
__device__ __forceinline__ u32x4 pk8(const f32x4& a, const f32x4& b) { u32x4 w; w.x = pkbf(a[0], a[1]); w.y = pkbf(a[2], a[3]); w.z = pkbf(b[0], b[1]); w.w = pkbf(b[2], b[3]); return w; }

template <int PVAR = 0>
struct EpiSwiGLUT {
    static constexpr bool PERM = true, AFTER_DRAIN = false;
    bf16_t* H; const float* rs;
    __device__ __forceinline__ void operator()(const f32x4 (&acc)[2][2][4][2], const Unit& u, int wr, int wc, int fr, int fq) const {
        typedef float f32x2 __attribute__((ext_vector_type(2)));
        const int row0 = u.pm * BM + wr * 64 + fr, col0 = u.pn * 128 + wc * 32 + 8 * fq;
        float v8[2][4];
#pragma unroll
        for (int ai = 0; ai < 2; ++ai)
#pragma unroll
            for (int m = 0; m < 4; ++m) { const f32x4 p = *(const f32x4*)(rs + (size_t)(row0 + ai * HALF + m * 16) * 4); v8[ai][m] = ((p[0] + p[1]) + (p[2] + p[3])) * (1.f / DM) + RMS_EPS; }
#pragma unroll
        for (int ai = 0; ai < 2; ++ai)
#pragma unroll
            for (int m = 0; m < 4; ++m) {
                const int row = row0 + ai * HALF + m * 16; const float v = v8[ai][m]; const float sp = -LOG2E * __builtin_amdgcn_rsqf(v);
                f32x4 h[2];
#pragma unroll
                for (int n = 0; n < 2; ++n)
#pragma unroll
                    for (int pr = 0; pr < 2; ++pr) { const f32x2 g2 = {acc[ai][0][m][n][2 * pr], acc[ai][0][m][n][2 * pr + 1]}, u2 = {acc[ai][1][m][n][2 * pr], acc[ai][1][m][n][2 * pr + 1]};
                        const f32x2 t2 = g2 * sp; f32x2 e2; e2.x = __builtin_amdgcn_exp2f(t2.x); e2.y = __builtin_amdgcn_exp2f(t2.y);
                        const f32x2 d2 = e2 * v + v; f32x2 r2; r2.x = __builtin_amdgcn_rcpf(d2.x); r2.y = __builtin_amdgcn_rcpf(d2.y);
                        const f32x2 h2 = (g2 * u2) * r2; h[n][2 * pr] = h2.x; h[n][2 * pr + 1] = h2.y; }
                if (PVAR == 1) { const u32x4 w_ = pk8(h[0], h[1]); asm volatile("" :: "v"(w_)); } else *(u32x4*)(H + (size_t)row * FF + col0) = pk8(h[0], h[1]);
            }
    }
};
typedef EpiSwiGLUT<0> EpiSwiGLU;
struct EpiNull {
    static constexpr bool PERM = true, AFTER_DRAIN = false;
    __device__ __forceinline__ void operator()(const f32x4 (&acc)[2][2][4][2], const Unit& u, int wr, int wc, int fr, int fq) const {
#pragma unroll
        for (int ai = 0; ai < 2; ++ai)
#pragma unroll
            for (int bj = 0; bj < 2; ++bj)
#pragma unroll
                for (int m = 0; m < 4; ++m)
#pragma unroll
                    for (int n = 0; n < 2; ++n) asm volatile("" :: "v"(acc[ai][bj][m][n]));
    }
};
struct EpiBf16Y {
    static constexpr bool PERM = true, AFTER_DRAIN = false;
    bf16_t* Y;
    __device__ __forceinline__ void operator()(const f32x4 (&acc)[2][2][4][2], const Unit& u, int wr, int wc, int fr, int fq) const {
        const int row0 = u.pm * BM + wr * 64 + fr, col0 = u.pn * BM + wc * 32 + 8 * fq;
#pragma unroll
        for (int ai = 0; ai < 2; ++ai)
#pragma unroll
            for (int m = 0; m < 4; ++m) { bf16_t* rowp = Y + (size_t)(row0 + ai * HALF + m * 16) * DM + col0;
#pragma unroll
                for (int bj = 0; bj < 2; ++bj) *(u32x4*)(rowp + bj * HALF) = pk8(acc[ai][bj][m][0], acc[ai][bj][m][1]); }
    }
};
template <bool LAST, int PVAR = 0>
struct EpiRmsRes {
    static constexpr bool PERM = true, AFTER_DRAIN = false;
    bf16_t* X; float* outf; const float* ga; float alpha; unsigned long long* gran; unsigned epoch; float* ssq2; unsigned* tmo; PG8_LAS unsigned char* xl;
    __device__ __forceinline__ void operator()(const f32x4 (&acc)[2][2][4][2], const Unit& u, int wr, int wc, int fr, int fq) const {
        int tid_ = threadIdx.x; asm volatile("" : "+v"(tid_)); const int wid = __builtin_amdgcn_readfirstlane(tid_ >> 6), lane = tid_ & 63;
        PG8_LAS float* P = (PG8_LAS float*)xl;
        PG8_LAS float* S = (PG8_LAS float*)(xl + 4096);
        const int col0 = u.pn * BM + wc * 32 + 8 * fq;
        u32x4 xw8[4][2];
#pragma unroll
        for (int m = 0; m < 4; ++m)
#pragma unroll
            for (int bj = 0; bj < 2; ++bj) xw8[m][bj] = *(const u32x4*)(X + (size_t)(u.pm * BM + wr * 64 + m * 16 + fr) * DM + col0 + bj * HALF);
#pragma unroll
        for (int ai = 0; ai < 2; ++ai)
#pragma unroll
            for (int m = 0; m < 4; ++m) { float s = 0.f;
#pragma unroll
                for (int bj = 0; bj < 2; ++bj)
#pragma unroll
                    for (int n = 0; n < 2; ++n) { const f32x4 v = acc[ai][bj][m][n]; s += (v[0] * v[0] + v[1] * v[1]) + (v[2] * v[2] + v[3] * v[3]); }
                s = epi_sum4fq(s);
                if (fq == 0) P[(ai * HALF + wr * 64 + m * 16 + fr) * 4 + wc] = s; }
        asm volatile("s_waitcnt lgkmcnt(0)" ::: "memory"); __builtin_amdgcn_s_barrier(); asm volatile("" ::: "memory");
        const int row = wid * 32 + (lane & 31);
        if (lane < 32) {
            const f32x4 p = *(const PG8_LAS f32x4*)(P + row * 4); const float mine = (p[0] + p[1]) + (p[2] + p[3]);
            unsigned long long* gr = gran + ((size_t)(u.pm * BM + row)) * 4;
            __hip_atomic_store(gr + u.pn, ((unsigned long long)epoch << 32) | (unsigned long long)__float_as_uint(mine), __ATOMIC_RELAXED, __HIP_MEMORY_SCOPE_AGENT);
            float t = 0.f; bool ok = false;
            for (unsigned spins = 0; spins < ((PVAR & 1) ? 0u : (1u << 18)); ++spins) {
                unsigned long long w[4]; bool all4 = true; t = 0.f;
#pragma unroll
                for (int k = 0; k < 4; ++k) { w[k] = __hip_atomic_load(gr + k, __ATOMIC_RELAXED, __HIP_MEMORY_SCOPE_AGENT); all4 = all4 && ((unsigned)(w[k] >> 32) == epoch); t += __uint_as_float((unsigned)w[k]); }
                if (__all(all4)) { ok = true; break; }
                __builtin_amdgcn_s_sleep(1);
            }
            if (PVAR & 1) { ok = true; t = 4.f * mine; }
            if (!ok && lane == 0) __hip_atomic_store(tmo, 1u, __ATOMIC_RELAXED, __HIP_MEMORY_SCOPE_AGENT);
            S[row] = alpha * __builtin_amdgcn_rsqf(t * (1.f / DM) + RMS_EPS);
        }
        asm volatile("s_waitcnt lgkmcnt(0)" ::: "memory"); __builtin_amdgcn_s_barrier(); asm volatile("" ::: "memory");
        if (PVAR & 2) return;
        f32x4 g[2][2];
#pragma unroll
        for (int bj = 0; bj < 2; ++bj)
#pragma unroll
            for (int n = 0; n < 2; ++n) g[bj][n] = *(const f32x4*)(ga + col0 + bj * HALF + 4 * n);
#pragma unroll
        for (int ai = 0; ai < 2; ++ai) {
            if (ai == 1) {
#pragma unroll
                for (int m = 0; m < 4; ++m)
#pragma unroll
                    for (int bj = 0; bj < 2; ++bj) xw8[m][bj] = *(const u32x4*)(X + (size_t)(u.pm * BM + HALF + wr * 64 + m * 16 + fr) * DM + col0 + bj * HALF);
            }
#pragma unroll
            for (int m = 0; m < 4; ++m) { const int rl = ai * HALF + wr * 64 + m * 16 + fr; const size_t off = (size_t)(u.pm * BM + rl) * DM + col0; const float sr = S[rl]; float q = 0.f;
#pragma unroll
                for (int bj = 0; bj < 2; ++bj) { const u32x4 xw = xw8[m][bj]; f32x4 xn[2];
#pragma unroll
                    for (int n = 0; n < 2; ++n) { const f32x4 xo = {__uint_as_float(xw[2 * n] << 16), __uint_as_float(xw[2 * n] & 0xffff0000u), __uint_as_float(xw[2 * n + 1] << 16), __uint_as_float(xw[2 * n + 1] & 0xffff0000u)};
                        xn[n] = xo + acc[ai][bj][m][n] * sr * g[bj][n]; q += (xn[n][0] * xn[n][0] + xn[n][1] * xn[n][1]) + (xn[n][2] * xn[n][2] + xn[n][3] * xn[n][3]); }
                    if (LAST) { *(f32x4*)(outf + off + bj * HALF) = xn[0]; *(f32x4*)(outf + off + bj * HALF + 4) = xn[1]; }
                    else *(u32x4*)(X + off + bj * HALF) = pk8(xn[0], xn[1]); }
                if (!LAST) { q = epi_sum4fq(q); if (fq == 0) P[rl * 4 + wc] = q; } } }
        if (!LAST) {
            asm volatile("s_waitcnt lgkmcnt(0)" ::: "memory"); __builtin_amdgcn_s_barrier(); asm volatile("" ::: "memory");
            if (lane < 32) { const f32x4 p = *(const PG8_LAS f32x4*)(P + row * 4); ssq2[((size_t)(u.pm * BM + row)) * 4 + u.pn] = (p[0] + p[1]) + (p[2] + p[3]); }
        }
    }
};
struct HotOrder {
    int n, c;
    __device__ __forceinline__ bool next(int i, Unit& u) const { if (i >= n) return false; u.pm = c & 7; u.pn = (c >> 3) & 3; return true; }
    __device__ __forceinline__ void a_ready(const Unit&) const {}
    __device__ __forceinline__ void done(const Unit&) const {}
};
struct OneRound {
    StaticOrder base; int round;
    __device__ __forceinline__ bool next(int i, Unit& u) const { return i == 0 && base.next(round, u); }
    __device__ __forceinline__ void a_ready(const Unit&) const {}
    __device__ __forceinline__ void done(const Unit&) const {}
};
struct EpiF32 {
    static constexpr bool PERM = false, AFTER_DRAIN = false;
    float* Y; int ldc;
    __device__ __forceinline__ void operator()(const f32x4 (&acc)[2][2][4][2], const Unit& u, int wr, int wc, int fr, int fq) const {
        const int row0 = u.pm * BM + wr * 64 + fr, col0 = u.pn * BM + wc * 32 + 4 * fq;
#pragma unroll
        for (int ai = 0; ai < 2; ++ai)
#pragma unroll
            for (int m = 0; m < 4; ++m) { float* rowp = Y + (size_t)(row0 + ai * HALF + m * 16) * ldc + col0;
#pragma unroll
                for (int bj = 0; bj < 2; ++bj)
#pragma unroll
                    for (int n = 0; n < 2; ++n) *(f32x4*)(rowp + bj * HALF + n * 16) = acc[ai][bj][m][n]; }
    }
};
struct EpiProjOdd {
    static constexpr bool PERM = true, AFTER_DRAIN = false;
    bf16_t* Q; const float* rs;
    __device__ __forceinline__ void operator()(const f32x4 (&acc)[2][2][4][2], const Unit& u, int wr, int wc, int fr, int fq) const {
        const int t = u.pn >> 2; bf16_t* base = Q + (size_t)t * ((size_t)MROWS * DM); const float sc = t == 0 ? QSCALE : 1.f;
        const int row0 = u.pm * BM + wr * 64 + fr, col0 = (u.pn & 3) * BM + wc * 32 + 8 * fq;
        float sc8[2][4];
#pragma unroll
        for (int ai = 0; ai < 2; ++ai)
#pragma unroll
            for (int m = 0; m < 4; ++m) sc8[ai][m] = row_rs(rs, row0 + ai * HALF + m * 16);
#pragma unroll
        for (int ai = 0; ai < 2; ++ai)
#pragma unroll
            for (int m = 0; m < 4; ++m) { const int row = row0 + ai * HALF + m * 16; const float s = sc8[ai][m] * sc;
#pragma unroll
                for (int bj = 0; bj < 2; ++bj) *(u32x4*)(base + (size_t)row * DM + col0 + bj * HALF) = pk8(acc[ai][bj][m][0] * s, acc[ai][bj][m][1] * s); }
    }
};
struct EpiProjEven {
    static constexpr bool PERM = true, AFTER_DRAIN = false;
    bf16_t *R1, *IQ, *IK; float* IW; const float* rs;
    const float *c64, *s64, *c32, *s32;
    __device__ __forceinline__ void operator()(const f32x4 (&acc)[2][2][4][2], const Unit& u, int wr, int wc, int fr, int fq) const {
        const int pn = u.pn, row0 = u.pm * BM + wr * 64 + fr;
        float sc8[2][4];
#pragma unroll
        for (int ai = 0; ai < 2; ++ai)
#pragma unroll
            for (int m = 0; m < 4; ++m) sc8[ai][m] = row_rs(rs, row0 + ai * HALF + m * 16);
        if (pn == 4 || pn == 5 || pn == 10 || pn == 11) {
            bf16_t* base = R1 + (size_t)(pn >> 1) * ((size_t)MROWS * 512); const int col0 = (pn & 1) * BM + wc * 32 + 8 * fq;
#pragma unroll
            for (int ai = 0; ai < 2; ++ai)
#pragma unroll
                for (int m = 0; m < 4; ++m) { const int row = row0 + ai * HALF + m * 16; const float s = sc8[ai][m];
#pragma unroll
                    for (int bj = 0; bj < 2; ++bj) *(u32x4*)(base + (size_t)row * 512 + col0 + bj * HALF) = pk8(acc[ai][bj][m][0] * s, acc[ai][bj][m][1] * s); }
        } else if (pn < 12) {
            bf16_t* base = R1 + (size_t)(pn >> 1) * ((size_t)MROWS * 512);
            const float sc = (pn < 2 || pn == 6 || pn == 7) ? QSCALE : 1.f;
            const int head = 4 * (pn & 1) + wc, d0 = 8 * fq;
#pragma unroll
            for (int aim = 0; aim < 4; ++aim) { const int ai = aim >> 1;
                f32x4 ct[2][2], st[2][2];
#pragma unroll
                for (int mm = 0; mm < 2; ++mm) { const int pos = (row0 + ai * HALF + (2 * (aim & 1) + mm) * 16) & (SEQ - 1);
#pragma unroll
                    for (int n = 0; n < 2; ++n) { ct[mm][n] = *(const f32x4*)(c64 + pos * 32 + d0 + 4 * n); st[mm][n] = *(const f32x4*)(s64 + pos * 32 + d0 + 4 * n); } }
#pragma unroll
                for (int mm = 0; mm < 2; ++mm) { const int m = 2 * (aim & 1) + mm; const int row = row0 + ai * HALF + m * 16; const float s = sc8[ai][m] * sc;
                    f32x4 o1[2], o2[2];
#pragma unroll
                    for (int n = 0; n < 2; ++n) { const f32x4 cc = ct[mm][n], ss = st[mm][n];
                        const f32x4 x1 = acc[ai][0][m][n] * s, x2 = acc[ai][1][m][n] * s; o1[n] = x1 * cc - x2 * ss; o2[n] = x2 * cc + x1 * ss; }
                    bf16_t* dst = base + (size_t)row * 512 + head * 64 + d0;
                    *(u32x4*)dst = pk8(o1[0], o1[1]); *(u32x4*)(dst + 32) = pk8(o2[0], o2[1]); } }
        } else if (pn == 12) {
            const int head = 2 * wc + (fq >> 1), d0 = 8 * (fq & 1);
#pragma unroll
            for (int ai = 0; ai < 2; ++ai)
#pragma unroll
                for (int m = 0; m < 4; ++m) { const int row = row0 + ai * HALF + m * 16, pos = row & (SEQ - 1); const float s = sc8[ai][m];
                    f32x4 o1[2], o2[2];
#pragma unroll
                    for (int n = 0; n < 2; ++n) { const f32x4 cc = *(const f32x4*)(c32 + pos * 16 + d0 + 4 * n), ss = *(const f32x4*)(s32 + pos * 16 + d0 + 4 * n);
                        const f32x4 x1 = acc[ai][0][m][n] * s, x2 = acc[ai][1][m][n] * s; o1[n] = x1 * cc - x2 * ss; o2[n] = x2 * cc + x1 * ss; }
                    bf16_t* dst = IQ + (size_t)row * 256 + head * 32 + d0;
                    *(u32x4*)dst = pk8(o1[0], o1[1]); *(u32x4*)(dst + 16) = pk8(o2[0], o2[1]); }
        } else {
            if (wc == 0 && fq < 2) {
                const int d0 = 8 * fq;
#pragma unroll
                for (int ai = 0; ai < 2; ++ai)
#pragma unroll
                    for (int m = 0; m < 4; ++m) { const int row = row0 + ai * HALF + m * 16, pos = row & (SEQ - 1); const float s = sc8[ai][m];
                        f32x4 o1[2], o2[2];
#pragma unroll
                        for (int n = 0; n < 2; ++n) { const f32x4 cc = *(const f32x4*)(c32 + pos * 16 + d0 + 4 * n), ss = *(const f32x4*)(s32 + pos * 16 + d0 + 4 * n);
                            const f32x4 x1 = acc[ai][0][m][n] * s, x2 = acc[ai][1][m][n] * s; o1[n] = x1 * cc - x2 * ss; o2[n] = x2 * cc + x1 * ss; }
                        bf16_t* dst = IK + (size_t)row * 32 + d0;
                        *(u32x4*)dst = pk8(o1[0], o1[1]); *(u32x4*)(dst + 16) = pk8(o2[0], o2[1]); }
            } else if (wc == 0 && fq == 2) {
#pragma unroll
                for (int ai = 0; ai < 2; ++ai)
#pragma unroll
                    for (int m = 0; m < 4; ++m) { const int row = row0 + ai * HALF + m * 16; const float s = sc8[ai][m] * 0.0625f;
                        *(f32x4*)(IW + (size_t)row * 8) = acc[ai][0][m][0] * s; *(f32x4*)(IW + (size_t)row * 8 + 4) = acc[ai][0][m][1] * s; }
            }
        }
    }
};
}

namespace att {
#define ALAS __attribute__((address_space(3)))
typedef unsigned short bf16_t;
typedef short bf16x8 __attribute__((ext_vector_type(8)));
typedef short s16x4 __attribute__((ext_vector_type(4)));
typedef float f32x16 __attribute__((ext_vector_type(16)));
typedef float f32x4 __attribute__((ext_vector_type(4)));
typedef unsigned u32x4 __attribute__((ext_vector_type(4)));
typedef short v4i16_t __attribute__((ext_vector_type(4)));
__device__ __forceinline__ int crow(int r, int hi) { return (r & 3) + 8 * (r >> 2) + 4 * hi; }
__device__ __forceinline__ unsigned cvtpk(float lo, float hi) { typedef float f2_t __attribute__((ext_vector_type(2))); typedef __bf16 b2_t __attribute__((ext_vector_type(2)));
    f2_t v = {lo, hi}; b2_t b = __builtin_convertvector(v, b2_t); return __builtin_bit_cast(unsigned, b); }
__device__ __forceinline__ s16x4 vtr(const ALAS unsigned char* p) { return __builtin_bit_cast(s16x4, __builtin_amdgcn_ds_read_tr16_b64_v4i16((ALAS v4i16_t*)p)); }
__device__ __forceinline__ float halfswap_max(float m) { auto rr = __builtin_amdgcn_permlane32_swap(__float_as_uint(m), __float_as_uint(m), false, false); return fmaxf(__uint_as_float(rr[0]), __uint_as_float(rr[1])); }
__device__ __forceinline__ float halfswap_sum(float m) { auto rr = __builtin_amdgcn_permlane32_swap(__float_as_uint(m), __float_as_uint(m), false, false); return __uint_as_float(rr[0]) + __uint_as_float(rr[1]); }

template <int DV> struct Lds {
#ifndef ATT_R64
#define ATT_R64 4
#endif
    static constexpr int R = (DV == 64) ? ATT_R64 : 3, D = R - 1;
    static constexpr int KB = 8192, VB = DV * 128;
    static constexpr int OFF_K = 0, OFF_V = R * KB, OFF_MW = OFF_V + R * VB, OFF_WSF = OFF_MW + 8 * R * 256, OFF_BT = OFF_WSF + 8 * 256, OFF_OST = OFF_BT + 3072, OST_W = 4096, TOTAL = OFF_OST + 8 * OST_W;
};
__device__ __forceinline__ void glds16(const void* gsrc, unsigned lds_dst) { unsigned keep;
    asm volatile("s_mov_b32 %0, m0\n\ts_mov_b32 m0, %2\n\ts_nop 0\n\tglobal_load_lds_dwordx4 %1, off\n\ts_mov_b32 m0, %0" : "=&s"(keep) : "v"(gsrc), "s"(lds_dst) : "memory"); }
__device__ __forceinline__ void glds4(const void* gsrc, unsigned lds_dst) { unsigned keep;
    asm volatile("s_mov_b32 %0, m0\n\ts_mov_b32 m0, %2\n\ts_nop 0\n\tglobal_load_lds_dword %1, off\n\ts_mov_b32 m0, %0" : "=&s"(keep) : "v"(gsrc), "s"(lds_dst) : "memory"); }

template <int DV, int MODE, int THR>
__device__ __forceinline__ void attn_core(f32x16 (&o)[DV / 32], ALAS unsigned char* lds,
                                          const bf16_t* Qw, int ldq, const bf16_t* Kh, int ldk, const bf16_t* Vh, int ldv,
                                          int T0, int T1, int tw0, int tw1,
                                          const unsigned long long* maskrow, int qpos, int qchunk, int att_probe_hotmask = -1, int att_probe_skip = 0) {
    typedef Lds<DV> L; constexpr int NDB = DV / 32, NVP = DV / 64, R = L::R, D = L::D, NDMA = 1 + NVP + (MODE == 1 ? 1 : 0);
    int tid = threadIdx.x; asm volatile("" : "+v"(tid));
    const int lane = tid & 63, r32 = lane & 31, hi = lane >> 5; const int wid = __builtin_amdgcn_readfirstlane(tid >> 6);
    ALAS float* wsf = (ALAS float*)(lds + L::OFF_WSF) + wid * 64;
    const ALAS float* btab = (const ALAS float*)(lds + L::OFF_BT);
    constexpr bool QLDS = (DV == 128);
    ALAS unsigned char* qst = lds + L::OFF_OST + wid * L::OST_W + lane * 16;
    bf16x8 qr[4];
#pragma unroll
    for (int d0 = 0; d0 < 4; ++d0) { qr[d0] = *(const bf16x8*)(Qw + (size_t)r32 * ldq + d0 * 16 + hi * 8); if (QLDS) *(ALAS bf16x8*)(qst + d0 * 1024) = qr[d0]; }
    const int krow = 8 * wid + (lane >> 3), kkey = krow ^ ((krow >> 3) & 1), kch = (lane & 7) ^ (kkey & 7);
    const bf16_t* ksrc = Kh + (size_t)kkey * ldk + kch * 8;
    const bf16_t* vsrc = Vh + (size_t)(16 * (wid & 3) + (lane >> 2)) * ldv + 32 * (wid >> 2) + 8 * (lane & 3);
    const unsigned* msrc = (const unsigned*)maskrow + hi;
    const unsigned lds0 = (unsigned)(__SIZE_TYPE__)lds;
    const unsigned kdst = lds0 + L::OFF_K + wid * 1024, vdst = lds0 + L::OFF_V + (wid >> 2) * 4096 + (wid & 3) * 1024, mdstb = lds0 + L::OFF_MW + wid * (R * 256);
    ALAS unsigned char* mdst = lds + L::OFF_MW + wid * (R * 256);
#define ATT_U(x) ((unsigned)__builtin_amdgcn_readfirstlane((int)(x)))
#define ATT_TT(t) (T0 + (((t) - T0) & att_probe_hotmask))
#define ATT_DMA_K(t, sl) glds16(ksrc + (size_t)ATT_TT(t) * 64 * ldk, ATT_U(kdst + (sl) * L::KB))
#define ATT_DMA_V(t, sl) do { glds16(vsrc + (size_t)ATT_TT(t) * 64 * ldv, ATT_U(vdst + (sl) * L::VB)); if (NVP == 2) glds16(vsrc + (size_t)ATT_TT(t) * 64 * ldv + 64, ATT_U(vdst + (sl) * L::VB + 8192)); \
                              if (MODE == 1) glds4(msrc + 2 * (t), ATT_U(mdstb + (sl) * 256)); } while (0)
    int kfo[4];
#pragma unroll
    for (int d0 = 0; d0 < 4; ++d0) kfo[d0] = (r32 ^ ((r32 >> 3) & 1)) * 128 + (((2 * d0 + hi) ^ (r32 & 7)) * 16);
#define ATT_QK(P0, P1, t, ks) do { \
        if (MODE == 2) { const int jrel_ = qchunk - (t); \
            if (jrel_ >= 5) { const float bc_ = btab[638]; _Pragma("unroll") for (int r = 0; r < 16; ++r) { P0[r] = bc_; P1[r] = bc_; } } \
            else { const ALAS float* bp_ = btab + (qpos - 64 * (t) + 63 - 4 * hi - 59); \
                _Pragma("unroll") for (int r = 0; r < 16; ++r) { P0[r] = bp_[59 - crow(r, 0)]; P1[r] = bp_[59 - 32 - crow(r, 0)]; } } \
        } else { P0 = f32x16{}; P1 = f32x16{}; } \
        const ALAS unsigned char* kb_ = lds + L::OFF_K + (ks) * L::KB; \
        _Pragma("unroll") for (int d0 = 0; d0 < 4; ++d0) { const bf16x8 b0_ = *(const ALAS bf16x8*)(kb_ + kfo[d0]), b1_ = *(const ALAS bf16x8*)(kb_ + kfo[d0] + 4096); \
            const bf16x8 q_ = QLDS ? *(const ALAS bf16x8*)(qst + d0 * 1024) : qr[d0]; \
            P0 = __builtin_amdgcn_mfma_f32_32x32x16_bf16(b0_, q_, P0, 0, 0, 0); P1 = __builtin_amdgcn_mfma_f32_32x32x16_bf16(b1_, q_, P1, 0, 0, 0); } } while (0)
#define ATT_QK_INIT(P0, P1, t) do { \
        if (MODE == 2) { const int jrel_ = qchunk - (t); \
            if (jrel_ >= 5) { const float bc_ = btab[638]; _Pragma("unroll") for (int r = 0; r < 16; ++r) { P0[r] = bc_; P1[r] = bc_; } } \
            else { const ALAS float* bp_ = btab + (qpos - 64 * (t) + 63 - 4 * hi - 59); \
                _Pragma("unroll") for (int r = 0; r < 16; ++r) { P0[r] = bp_[59 - crow(r, 0)]; P1[r] = bp_[59 - 32 - crow(r, 0)]; } } \
        } else { P0 = f32x16{}; P1 = f32x16{}; } } while (0)
#define ATT_QK_HALF(P0, P1, kb_, dlo) do { \
        _Pragma("unroll") for (int d0 = (dlo); d0 < (dlo) + 2; ++d0) { const bf16x8 b0_ = *(const ALAS bf16x8*)((kb_) + kfo[d0]), b1_ = *(const ALAS bf16x8*)((kb_) + kfo[d0] + 4096); \
            const bf16x8 q_ = QLDS ? *(const ALAS bf16x8*)(qst + d0 * 1024) : qr[d0]; \
            P0 = __builtin_amdgcn_mfma_f32_32x32x16_bf16(b0_, q_, P0, 0, 0, 0); P1 = __builtin_amdgcn_mfma_f32_32x32x16_bf16(b1_, q_, P1, 0, 0, 0); } } while (0)
    constexpr int NV = NDMA - 1;
#define ATT_CK(j) (((j) <= T0 + D) ? ((j) - T0) * NDMA + 1 : ((j) - 1 - T0) * NDMA + 2)
#define ATT_CV(j) (((j) < T0 + D) ? ((j) - T0 + 1) * NDMA : ((j) - T0) * NDMA + 2 + NV)
#define ATT_WAIT_BAR_N(n_) do { const int nn_ = (n_); \
        if (nn_ <= 0) asm volatile("s_waitcnt vmcnt(0) lgkmcnt(0)\n\ts_barrier" ::: "memory"); \
        else if (nn_ == 1) asm volatile("s_waitcnt vmcnt(1) lgkmcnt(0)\n\ts_barrier" ::: "memory"); \
        else if (nn_ == 2) asm volatile("s_waitcnt vmcnt(2) lgkmcnt(0)\n\ts_barrier" ::: "memory"); \
        else if (nn_ == 3) asm volatile("s_waitcnt vmcnt(3) lgkmcnt(0)\n\ts_barrier" ::: "memory"); \
        else if (nn_ == 4) asm volatile("s_waitcnt vmcnt(4) lgkmcnt(0)\n\ts_barrier" ::: "memory"); \
        else if (nn_ == 5) asm volatile("s_waitcnt vmcnt(5) lgkmcnt(0)\n\ts_barrier" ::: "memory"); \
        else if (nn_ == 6) asm volatile("s_waitcnt vmcnt(6) lgkmcnt(0)\n\ts_barrier" ::: "memory"); \
        else if (nn_ == 7) asm volatile("s_waitcnt vmcnt(7) lgkmcnt(0)\n\ts_barrier" ::: "memory"); \
        else if (nn_ == 8) asm volatile("s_waitcnt vmcnt(8) lgkmcnt(0)\n\ts_barrier" ::: "memory"); \
        else if (nn_ == 9) asm volatile("s_waitcnt vmcnt(9) lgkmcnt(0)\n\ts_barrier" ::: "memory"); \
        else if (nn_ == 10) asm volatile("s_waitcnt vmcnt(10) lgkmcnt(0)\n\ts_barrier" ::: "memory"); \
        else if (nn_ == 11) asm volatile("s_waitcnt vmcnt(11) lgkmcnt(0)\n\ts_barrier" ::: "memory"); \
        else asm volatile("s_waitcnt vmcnt(12) lgkmcnt(0)\n\ts_barrier" ::: "memory"); } while (0)
#define ATT_END_STEP(t) do { int need_ = 0; if ((t) + 2 < T1) need_ = ATT_CK((t) + 2); if ((t) + 1 < T1) { const int cv_ = ATT_CV((t) + 1); need_ = cv_ > need_ ? cv_ : need_; } \
        ATT_WAIT_BAR_N(need_ ? n_issued - need_ : 0); } while (0)
    int n_issued = 0;
    float m_run = -1e30f, l_part = 0.f;
#pragma unroll
    for (int d0 = 0; d0 < NDB; ++d0) o[d0] = f32x16{};
#pragma unroll
    for (int i = 0; i <= D; ++i) { if (T0 + i < T1) { ATT_DMA_K(T0 + i, i); n_issued += 1; } if (i < D && T0 + i < T1) { ATT_DMA_V(T0 + i, i); n_issued += NV; } }
    ATT_WAIT_BAR_N(n_issued - 1);
    f32x16 pc0, pc1, pn0, pn1;
    pc0 = f32x16{}; pc1 = f32x16{}; pn0 = f32x16{}; pn1 = f32x16{};
    if (tw0 == T0) { ATT_QK(pc0, pc1, T0, 0); }
    ATT_END_STEP(T0 - 1);
    int sk = 1 % R, sv = 0, si_k = 0, si_v = D % R;
    for (int t = T0; t < T1; ++t) {
        const bool steady = (t + 1 + D < T1);
        if (steady) { ATT_DMA_K(t + 1 + D, si_k); n_issued += 1; }
        if (t + D < T1) { ATT_DMA_V(t + D, si_v); n_issued += NV; }
        const bool act = (t >= tw0 && t < tw1), nxt = (t + 1 >= tw0 && t + 1 < tw1);
        if (nxt && !act) { ATT_QK(pn0, pn1, t + 1, sk); }
        if (act) {
            const ALAS unsigned char* kbn_ = lds + L::OFF_K + sk * L::KB;
            if (nxt) { ATT_QK_INIT(pn0, pn1, t + 1); ATT_QK_HALF(pn0, pn1, kbn_, 0); }
            if (MODE == 1) { const ALAS unsigned* mp = (const ALAS unsigned*)(mdst + sv * 256); const unsigned w0 = mp[r32] >> (4 * hi), w1 = mp[32 + r32] >> (4 * hi);
#pragma unroll
                for (int r = 0; r < 16; ++r) { const int sh = 31 - ((r & 3) + 8 * (r >> 2));
                    const unsigned m0 = (unsigned)(((int)(w0 << sh)) >> 31), m1 = (unsigned)(((int)(w1 << sh)) >> 31);
                    pc0[r] = __uint_as_float((__float_as_uint(pc0[r]) & m0) | (0xff800000u & ~m0)); pc1[r] = __uint_as_float((__float_as_uint(pc1[r]) & m1) | (0xff800000u & ~m1)); } }
            float mx = fmaxf(fmaxf(pc0[0], pc1[0]), pc0[1]);
#pragma unroll
            for (int r = 1; r < 16; ++r) mx = (r == 1) ? fmaxf(mx, pc1[1]) : fmaxf(fmaxf(mx, pc0[r]), pc1[r]);
            mx = halfswap_max(mx);
            if (__any(mx > m_run + (float)THR)) {
                const float mnew = fmaxf(m_run, mx); const float f = __builtin_amdgcn_exp2f(m_run - mnew);
                l_part *= f; m_run = mnew; if (hi == 0) wsf[r32] = f;
#pragma unroll
                for (int r = 0; r < 16; ++r) { const float fr_ = wsf[crow(r, hi)];
#pragma unroll
                    for (int d0 = 0; d0 < NDB; ++d0) o[d0][r] *= fr_; }
            }
            if (nxt) { ATT_QK_HALF(pn0, pn1, kbn_, 2); }
            float sa = 0.f, sb = 0.f;
#pragma unroll
            for (int r = 0; r < 16; ++r) { pc0[r] = __builtin_amdgcn_exp2f(pc0[r] - m_run); pc1[r] = __builtin_amdgcn_exp2f(pc1[r] - m_run); sa += pc0[r]; sb += pc1[r]; }
            l_part += sa + sb;
            u32x4 pw[4];
#pragma unroll
            for (int k = 0; k < 2; ++k)
#pragma unroll
                for (int j = 0; j < 4; ++j) { pw[k][j] = cvtpk(pc0[8 * k + 2 * j], pc0[8 * k + 2 * j + 1]); pw[2 + k][j] = cvtpk(pc1[8 * k + 2 * j], pc1[8 * k + 2 * j + 1]); }
            const ALAS unsigned char* vb = lds + L::OFF_V + sv * L::VB + ((lane >> 4) & 1) * 32 + (lane & 3) * 8 + (4 * hi + ((lane & 15) >> 2)) * 64;
#pragma unroll
            for (int d0 = 0; d0 < NDB; ++d0)
#pragma unroll
                for (int ks = 0; ks < 4; ++ks) { const s16x4 lo = vtr(vb + d0 * 4096 + ks * 1024), up = vtr(vb + d0 * 4096 + ks * 1024 + 512);
                    const bf16x8 vf = (bf16x8){lo[0], lo[1], lo[2], lo[3], up[0], up[1], up[2], up[3]};
                    o[d0] = __builtin_amdgcn_mfma_f32_32x32x16_bf16(__builtin_bit_cast(bf16x8, pw[ks]), vf, o[d0], 0, 0, 0); }
        }
        pc0 = pn0; pc1 = pn1;
        sk = (sk + 1 == R) ? 0 : sk + 1; sv = (sv + 1 == R) ? 0 : sv + 1; si_k = (si_k + 1 == R) ? 0 : si_k + 1; si_v = (si_v + 1 == R) ? 0 : si_v + 1;
        ATT_END_STEP(t);
    }
#undef ATT_U
#undef ATT_TT
#undef ATT_DMA_K
#undef ATT_DMA_V
#undef ATT_QK
#undef ATT_QK_INIT
#undef ATT_QK_HALF
#undef ATT_CK
#undef ATT_CV
#undef ATT_WAIT_BAR_N
#undef ATT_END_STEP
    const float l = halfswap_sum(l_part);
    if (hi == 0) wsf[32 + r32] = l;
#pragma unroll
    for (int r = 0; r < 16; ++r) { const float rl = 1.0f / wsf[32 + crow(r, hi)];
#pragma unroll
        for (int d0 = 0; d0 < NDB; ++d0) o[d0][r] *= rl; }
}

template <int DV>
__device__ __forceinline__ void store_o(const f32x16 (&o)[DV / 32], ALAS unsigned char* lds, bf16_t* dst, int ldo) {
    typedef Lds<DV> L;
    int tid = threadIdx.x; asm volatile("" : "+v"(tid));
    const int lane = tid & 63, r32 = lane & 31, hi = lane >> 5; const int wid = __builtin_amdgcn_readfirstlane(tid >> 6);
    ALAS bf16_t* stg = (ALAS bf16_t*)(lds + L::OFF_OST + wid * L::OST_W);
#pragma unroll
    for (int h = 0; h < DV / 64; ++h) {
#pragma unroll
        for (int r = 0; r < 16; ++r) { const int orow = crow(r, hi);
#pragma unroll
            for (int d0 = 0; d0 < 2; ++d0) stg[orow * 64 + d0 * 32 + r32] = (bf16_t)(cvtpk(o[2 * h + d0][r], 0.f) & 0xffffu); }
#pragma unroll
        for (int i = 0; i < 4; ++i) { const int row = i * 8 + (lane >> 3), ch = lane & 7; const u32x4 v = *(const ALAS u32x4*)(stg + row * 64 + ch * 8); *(u32x4*)(dst + (size_t)row * ldo + h * 64 + ch * 8) = v; }
    }
}
}
#define GAS __attribute__((address_space(1)))
#define LAS __attribute__((address_space(3)))
typedef unsigned short bf16;
typedef unsigned v4u __attribute__((ext_vector_type(4)));
typedef float f32x4 __attribute__((ext_vector_type(4)));
typedef short bf16x8 __attribute__((ext_vector_type(8)));
typedef GAS unsigned gu32;
typedef GAS unsigned long long gu64;
#define RLX_AGENT __ATOMIC_RELAXED, __HIP_MEMORY_SCOPE_AGENT
#define LDS_WAIT() asm volatile("s_waitcnt lgkmcnt(0)" ::: "memory")
#define VM_WAIT() asm volatile("s_waitcnt vmcnt(0)" ::: "memory")
__device__ __forceinline__ unsigned long long rt() { return __builtin_amdgcn_s_memrealtime(); }
__device__ __forceinline__ unsigned f2bf(float f) { unsigned u = __builtin_bit_cast(unsigned, f); return (u + 0x7fffu + ((u >> 16) & 1u)) >> 16; }
__device__ __forceinline__ unsigned pk2(float lo, float hi) { return f2bf(lo) | (f2bf(hi) << 16); }

#define XB_TMO      128
#define XB_XCNT(j)  (256  + 64 * (j))
#define XB_XSUB(j)  (1280 + 64 * (j))
#define XB_XGEN(j)  (2304 + 64 * (j))
#define XB_TOP      3328
#define XB_TOPGEN   3392
#define XCD_BAR_WORDS 3456
#define XB_SPIN_CAP (1u << 18)

__device__ __forceinline__ unsigned xb_ld(unsigned* p)              { return __hip_atomic_load(p, __ATOMIC_RELAXED, __HIP_MEMORY_SCOPE_AGENT); }
__device__ __forceinline__ unsigned xb_add(unsigned* p, unsigned v) { return __hip_atomic_fetch_add(p, v, __ATOMIC_RELAXED, __HIP_MEMORY_SCOPE_AGENT); }
__device__ __forceinline__ unsigned xb_xcc_id() { return (unsigned)__builtin_amdgcn_s_getreg((3 << 11) | 20) & 0xFu; }
#define XB_SPIN(cond, bar) do { unsigned _sp = 0; while (cond) { __builtin_amdgcn_s_sleep(1); \
    if ((++_sp & 255u) == 0u) { if (xb_ld(&(bar)[XB_TMO])) break; if (_sp > XB_SPIN_CAP) { atomicAdd(&(bar)[XB_TMO], 1u); break; } } } } while (0)

struct XcdBarrier {
    unsigned* bar; unsigned x;
    volatile LAS unsigned* st;
};

__device__ __forceinline__ XcdBarrier xcd_barrier_post(unsigned* bar, volatile LAS unsigned* st) {
    XcdBarrier b; b.bar = bar; b.x = xb_xcc_id(); b.st = st;
    if (threadIdx.x == 0) (void)xb_add(&bar[XB_XCNT(b.x)], 1u);
    return b;
}
__device__ __forceinline__ void xcd_barrier_complete(unsigned* bar, unsigned x, unsigned& nloc, unsigned& nx) {
    const unsigned G = gridDim.x * gridDim.y * gridDim.z;
    unsigned sum, cnt, mine, sp = 0u;
    for (;;) {
        sum = 0u; cnt = 0u; mine = 0u;
#pragma unroll
        for (unsigned j = 0; j < 16; ++j) { const unsigned c = xb_ld(&bar[XB_XCNT(j)]); sum += c; cnt += (c > 0u) ? 1u : 0u; mine = (j == x) ? c : mine; }
        if (sum == G) break;
        __builtin_amdgcn_s_sleep(1);
        if ((++sp & 255u) == 0u) { if (xb_ld(&bar[XB_TMO])) break; if (sp > XB_SPIN_CAP) { atomicAdd(&bar[XB_TMO], 1u); break; } }
    }
    nloc = mine > 0u ? mine : 1u; nx = cnt > 0u ? cnt : 1u;
}

__device__ __forceinline__ void xcd_barrier(const XcdBarrier& b) {
    asm volatile("s_waitcnt vmcnt(0)" ::: "memory");
    __syncthreads();
    if (threadIdx.x == 0) {
        unsigned* bar = b.bar;
        __builtin_amdgcn_s_waitcnt(0);
        unsigned nloc = b.st[0], nx = b.st[1];
        if (nloc == 0u) { xcd_barrier_complete(bar, b.x, nloc, nx); b.st[0] = nloc; b.st[1] = nx; }
        const unsigned old = xb_add(&bar[XB_XSUB(b.x)], 1u);
        const unsigned gen = old / nloc;
        if (old + 1u == (gen + 1u) * nloc) {
            __builtin_amdgcn_fence(__ATOMIC_RELEASE, "agent");
            asm volatile("s_waitcnt vmcnt(0)" ::: "memory");
            const unsigned og = xb_add(&bar[XB_TOP], 1u);
            const unsigned tg = og / nx;
            if (og + 1u == (tg + 1u) * nx) xb_add(&bar[XB_TOPGEN], 1u);
            else XB_SPIN(xb_ld(&bar[XB_TOPGEN]) == tg, bar);
            __builtin_amdgcn_fence(__ATOMIC_ACQUIRE, "agent");
            xb_add(&bar[XB_XGEN(b.x)], 1u);
            asm volatile("s_waitcnt vmcnt(0)" ::: "memory");
        } else {
            XB_SPIN(xb_ld(&bar[XB_XGEN(b.x)]) == gen, bar);
            __builtin_amdgcn_fence(__ATOMIC_ACQUIRE, "agent");
            asm volatile("s_waitcnt vmcnt(0)" ::: "memory");
        }
    }
    __syncthreads();
}

constexpr int NWAVES = 8;
constexpr size_t MiB = 1u << 20;
constexpr size_t WS_CTL = 0, CTL_ZERO_BYTES = 2 * MiB;
constexpr size_t WS_GRAN = 1 * MiB;
constexpr size_t WS_C64 = 381 * MiB + 42 * MiB, WS_S64 = WS_C64 + 256 * 1024, WS_C32 = WS_C64 + 512 * 1024, WS_S32 = WS_C64 + 640 * 1024, WS_RS = WS_C64 + 768 * 1024;
constexpr size_t WS_WGU = 2 * MiB, WGU_BYTES = (size_t)NGU * DM * 2;
constexpr size_t WS_WD = 46 * MiB, WD_BYTES = (size_t)DM * FF * 2;
constexpr size_t WS_WIN0 = 68 * MiB, WS_WOUT0 = 75 * MiB, WS_WIN1 = 77 * MiB, WS_WOUT1 = 83 * MiB;
constexpr size_t WS_MASK = 85 * MiB;
constexpr size_t WS_XB = 93 * MiB;
constexpr size_t WS_R1 = 157 * MiB;
constexpr size_t WS_Y = 381 * MiB;
constexpr size_t WS_SSQ1 = WS_Y + 40 * MiB, WS_SSQ2 = WS_Y + 41 * MiB;
constexpr size_t WS_ATT = 445 * MiB;
constexpr size_t WS_END = 509 * MiB;
static_assert(WS_WGU + 4 * WGU_BYTES <= WS_WD && WS_WD + 4 * WD_BYTES <= WS_WIN0 && WS_WIN0 + (size_t)NEV * DM * 2 <= WS_WOUT0 && WS_WIN1 + (size_t)NOD * DM * 2 <= WS_WOUT1, "weight map");
static_assert(WS_R1 + (size_t)MROWS * FF * 2 <= WS_Y && WS_R1 + 211 * MiB <= WS_Y, "R1 map");
constexpr int CW_BAR = 4096, CW_TMO = 0, CW_SEAM = 16384, SEAM_BANK = 128 * 64;
constexpr int FUSED_LDS_OFF = 131072 + 1024;
constexpr int RING_BYTES = 131072, LDSCTL_OFF = RING_BYTES, MISC_OFF = LDSCTL_OFF + 320, LDS_BYTES = 147456;

struct Frame {
    LAS unsigned char* lds; volatile LAS unsigned* MISC; gu32* ctl;
    int tid, lane, wave, vcu, G;
};

template <int X> __device__ __forceinline__ float swz_xor(float v) { return __int_as_float(__builtin_amdgcn_ds_swizzle(__float_as_int(v), (X << 10) | 0x1f)); }
__device__ __forceinline__ float sum32(float v) { v += swz_xor<1>(v); v += swz_xor<2>(v); v += swz_xor<4>(v); v += swz_xor<8>(v); v += swz_xor<16>(v); return v; }
__device__ __forceinline__ float wave_sum(float v) { return att::halfswap_sum(sum32(v)); }
struct MapGUHalf { int bj; __device__ __forceinline__ int src(int R) const { return R; } __device__ __forceinline__ int dst(int R) const { return 256 * (R >> 7) + 128 * bj + (R & 127); } };
struct MapId { __device__ __forceinline__ int src(int R) const { return R; } __device__ __forceinline__ int dst(int R) const { return R; } };
__device__ __forceinline__ int even_src(int R) {
    const int pn = R >> 8, bj = (R >> 7) & 1, jj = R & 127;
    if (pn < 4) return (pn < 2 ? 0 : 512) + (4 * (pn & 1) + (jj >> 5)) * 64 + 32 * bj + (jj & 31);
    if (pn < 6) return 1024 + 256 * (pn - 4) + 128 * bj + jj;
    if (pn < 10) return (pn < 8 ? 1536 : 2048) + (4 * (pn & 1) + (jj >> 5)) * 64 + 32 * bj + (jj & 31);
    if (pn < 12) return 2560 + 256 * (pn - 10) + 128 * bj + jj;
    if (pn == 12) return 3072 + (jj >> 4) * 32 + 16 * bj + (jj & 15);
    if (jj < 16) return 3328 + 16 * bj + jj;
    if (bj == 0 && jj < 24) return 3360 + (jj - 16);
    return -1;
}
struct MapEven { __device__ __forceinline__ int src(int R) const { return even_src(R); } __device__ __forceinline__ int dst(int R) const { return R; } };
template <class Map>
__device__ __forceinline__ void transpose_item(const Map& mp, const float* W, int ldw, int K, int nrows, bf16* WT, const float* g, LAS float* scr, int item, int lane) {
    const int nblk = nrows / 32, kb = item / nblk, nb = item % nblk, k0 = 64 * kb, n0 = 32 * nb;
    const int nl = 4 * (lane & 7), kl = lane >> 3;
    const int sc0 = mp.src(n0 + nl); const float mul = sc0 >= 0 ? 1.f : 0.f; const float* src = W + (sc0 >= 0 ? sc0 : 0) + (size_t)(k0 + kl) * ldw;
    f32x4 v[8];
#pragma unroll
    for (int i = 0; i < 8; ++i) v[i] = *(const GAS f32x4*)(src + (size_t)(8 * i) * ldw);
#pragma unroll
    for (int i = 0; i < 8; ++i) { const int kk = 8 * i + kl; const float gm = g ? g[k0 + kk] * mul : mul;
        scr[kk * 33 + nl] = v[i].x * gm; scr[kk * 33 + nl + 1] = v[i].y * gm; scr[kk * 33 + nl + 2] = v[i].z * gm; scr[kk * 33 + nl + 3] = v[i].w * gm; }
    LDS_WAIT(); asm volatile("" ::: "memory");
    const int c = lane & 7;
#pragma unroll
    for (int j = 0; j < 4; ++j) { const int n = (lane >> 3) + 8 * j; const LAS float* s = scr + (8 * c) * 33 + n;
        v4u o; o.x = pk2(s[0 * 33], s[1 * 33]); o.y = pk2(s[2 * 33], s[3 * 33]); o.z = pk2(s[4 * 33], s[5 * 33]); o.w = pk2(s[6 * 33], s[7 * 33]);
        *(GAS v4u*)(WT + (size_t)mp.dst(n0 + n) * K + k0 + 8 * c) = o; }
    LDS_WAIT(); asm volatile("" ::: "memory");
}
__device__ __forceinline__ void sincos_d(double a, float& sn, float& cs) {
    const double k = __builtin_rint(a * 0.6366197723675814); const double y = a - k * 1.5707963267948966; const double y2 = y * y;
    const double s = y * (1.0 + y2 * (-1.0 / 6 + y2 * (1.0 / 120 + y2 * (-1.0 / 5040 + y2 * (1.0 / 362880 + y2 * (-1.0 / 39916800 + y2 * (1.0 / 6227020800.0)))))));
    const double c = 1.0 + y2 * (-0.5 + y2 * (1.0 / 24 + y2 * (-1.0 / 720 + y2 * (1.0 / 40320 + y2 * (-1.0 / 3628800 + y2 * (1.0 / 479001600.0 + y2 * (-1.0 / 87178291200.0)))))));
    const int q = (int)((long long)k & 3);
    const double ss = (q == 0) ? s : (q == 1) ? c : (q == 2) ? -s : -c, cc = (q == 0) ? c : (q == 1) ? -s : (q == 2) ? -c : s;
    sn = (float)ss; cs = (float)cc;
}
__device__ __forceinline__ void x_to_bf16_rows4(const float* x, bf16* xb, float* ssq, int m, int dm, int lane) {
    f32x4 v[4][4]; float s[4];
#pragma unroll
    for (int r = 0; r < 4; ++r) { const GAS f32x4* xr = (const GAS f32x4*)(x + (size_t)(m + r * dm) * DM) + lane;
#pragma unroll
        for (int j = 0; j < 4; ++j) v[r][j] = xr[64 * j]; }
#pragma unroll
    for (int r = 0; r < 4; ++r) { s[r] = 0.f; GAS unsigned long long* o8 = (GAS unsigned long long*)(xb + (size_t)(m + r * dm) * DM) + lane;
#pragma unroll
        for (int j = 0; j < 4; ++j) { s[r] += (v[r][j].x * v[r][j].x + v[r][j].y * v[r][j].y) + (v[r][j].z * v[r][j].z + v[r][j].w * v[r][j].w);
            o8[64 * j] = (unsigned long long)epi::pkbf(v[r][j].x, v[r][j].y) | ((unsigned long long)epi::pkbf(v[r][j].z, v[r][j].w) << 32); } }
#pragma unroll
    for (int r = 0; r < 4; ++r) s[r] = sum32(s[r]);
#pragma unroll
    for (int r = 0; r < 4; ++r) { const float t = att::halfswap_sum(s[r]); if (lane == 0) *(f32x4*)(ssq + (size_t)(m + r * dm) * 4) = (f32x4){t, 0.f, 0.f, 0.f}; }
}
__device__ __forceinline__ void bf8_to_f32(const v4u& w, float (&f)[8]) {
#pragma unroll
    for (int i = 0; i < 4; ++i) { f[2 * i] = __uint_as_float(w[i] << 16); f[2 * i + 1] = __uint_as_float(w[i] & 0xffff0000u); } }
template <bool LAST>
__device__ __forceinline__ void thin_row(const bf16* yrow, bf16* xrow, float* outf, const float* ga, float alpha, float* rs, int lane) {
    float y[2][8], x[2][8]; float s = 0.f;
#pragma unroll
    for (int j = 0; j < 2; ++j) { const v4u yw = *((const GAS v4u*)yrow + lane + 64 * j), xw = *((const GAS v4u*)xrow + lane + 64 * j); bf8_to_f32(yw, y[j]); bf8_to_f32(xw, x[j]);
#pragma unroll
        for (int i = 0; i < 8; ++i) s += y[j][i] * y[j][i]; }
    const float r1 = alpha / sqrtf(wave_sum(s) * (1.f / DM) + RMS_EPS); float s2 = 0.f;
#pragma unroll
    for (int j = 0; j < 2; ++j) { const f32x4 g0 = *((const GAS f32x4*)ga + 2 * lane + 128 * j), g1 = *((const GAS f32x4*)ga + 2 * lane + 128 * j + 1);
#pragma unroll
        for (int i = 0; i < 8; ++i) { const float g = i < 4 ? g0[i & 3] : g1[i & 3]; x[j][i] += y[j][i] * g * r1; s2 += x[j][i] * x[j][i]; }
        if (LAST) { *((GAS f32x4*)outf + 2 * lane + 128 * j) = (f32x4){x[j][0], x[j][1], x[j][2], x[j][3]}; *((GAS f32x4*)outf + 2 * lane + 128 * j + 1) = (f32x4){x[j][4], x[j][5], x[j][6], x[j][7]}; }
        else { v4u o; o.x = epi::pkbf(x[j][0], x[j][1]); o.y = epi::pkbf(x[j][2], x[j][3]); o.z = epi::pkbf(x[j][4], x[j][5]); o.w = epi::pkbf(x[j][6], x[j][7]); *((GAS v4u*)xrow + lane + 64 * j) = o; } }
    if (!LAST) { const float r2 = 1.0f / sqrtf(wave_sum(s2) * (1.f / DM) + RMS_EPS); if (lane == 0) *rs = r2; }
}

struct Ptrs {
    const float *x, *norm_g, *wg, *wu, *wd, *ewin, *ewout, *elam, *esub, *owin, *owout, *obias; float* out; unsigned char* ws;
};

__device__ __forceinline__ void p0_prologue(Frame& F0, const Ptrs& P) {
    struct { LAS unsigned char* lds; int tid, lane, wave, vcu, G; } F;
    { int t = threadIdx.x; asm volatile("" : "+v"(t)); F.lds = F0.lds; F.tid = t; F.lane = t & 63; F.wave = __builtin_amdgcn_readfirstlane(t >> 6); F.vcu = F0.vcu; F.G = F0.G; }
    LAS float* scr = (LAS float*)(F.lds + F.wave * 16384);
    const int gw = F.vcu * NWAVES + F.wave, NGW = F.G * NWAVES;
    constexpr int I_GH = (DM / 64) * (FF / 32), I_WD = (FF / 64) * (DM / 32), I_E = (DM / 64) * (NEV / 32), I_O = (DM / 64) * (DM / 32), I_OD = (DM / 64) * (NOD / 32);
    constexpr int NITEMS = 8 * I_GH + 4 * I_WD + I_E + I_O + I_OD + I_O;
    for (int it = gw; it < NITEMS; it += NGW) {
        int r = it;
        if (r < 8 * I_GH) { const int i8 = r / I_GH; r -= i8 * I_GH; const int i = i8 >> 1, bj = i8 & 1, l = i >> 1, f = i & 1;
            MapGUHalf mp{bj}; const float* W = (bj ? P.wu : P.wg) + (size_t)i * DM * FF;
            transpose_item(mp, W, FF, DM, FF, (bf16*)(P.ws + WS_WGU + i * WGU_BYTES), P.norm_g + (l * 6 + 4 * f) * DM, scr, r, F.lane); continue; }
        r -= 8 * I_GH;
        if (r < 4 * I_WD) { const int i = r / I_WD; r -= i * I_WD; MapId mp;
            transpose_item(mp, P.wd + (size_t)i * FF * DM, DM, FF, DM, (bf16*)(P.ws + WS_WD + i * WD_BYTES), nullptr, scr, r, F.lane); continue; }
        r -= 4 * I_WD;
        if (r < I_E) { MapEven mp; transpose_item(mp, P.ewin, 3368, DM, NEV, (bf16*)(P.ws + WS_WIN0), P.norm_g + (0 * 6 + 2) * DM, scr, r, F.lane); continue; }
        r -= I_E;
        if (r < I_O) { MapId mp; transpose_item(mp, P.ewout, DM, DM, DM, (bf16*)(P.ws + WS_WOUT0), nullptr, scr, r, F.lane); continue; }
        r -= I_O;
        if (r < I_OD) { MapId mp; transpose_item(mp, P.owin, NOD, DM, NOD, (bf16*)(P.ws + WS_WIN1), P.norm_g + (1 * 6 + 2) * DM, scr, r, F.lane); continue; }
        r -= I_OD;
        { MapId mp; transpose_item(mp, P.owout, DM, DM, DM, (bf16*)(P.ws + WS_WOUT1), nullptr, scr, r, F.lane); }
    }
    float* c64 = (float*)(P.ws + WS_C64); float* s64 = (float*)(P.ws + WS_S64); float* c32 = (float*)(P.ws + WS_C32); float* s32 = (float*)(P.ws + WS_S32);
    const int gt = F.vcu * (NWAVES * 64) + F.tid, NGT = F.G * NWAVES * 64;
    for (int e = gt; e < SEQ * 48; e += NGT) {
        const bool is64 = e < SEQ * 32; const int ee = is64 ? e : e - SEQ * 32; const int pos = is64 ? (ee >> 5) : (ee >> 4), i = is64 ? (ee & 31) : (ee & 15);
        const double rb = is64 ? 0.7498942093324559 : 0.5623413251903492; double inv = 1.0; for (int k = 0; k < i; ++k) inv *= rb;
        const float ang = (float)pos * (float)inv; float sn, cs; sincos_d((double)ang, sn, cs);
        if (is64) { c64[ee] = cs; s64[ee] = sn; } else { c32[ee] = cs; s32[ee] = sn; }
    }
    bf16* XB = (bf16*)(P.ws + WS_XB); float* SSQ2 = (float*)(P.ws + WS_SSQ2);
    for (int m = gw; m < MROWS; m += 4 * NGW) x_to_bf16_rows4(P.x, XB, SSQ2, m, NGW, F.lane);
}
#ifndef PROBE_REP_IDXA
#define PROBE_REP_IDXA 1
#endif
#ifndef PROBE_REP_B
#define PROBE_REP_B 1
#endif
#ifndef PROBE_REP_C
#define PROBE_REP_C 1
#endif
#ifndef PROBE_REP_GU
#define PROBE_REP_GU 1
#endif
#ifndef PROBE_REP_DN
#define PROBE_REP_DN 1
#endif
#ifndef PROBE_NULL_GU
#define PROBE_NULL_GU 0
#endif
#ifndef PROBE_NULL_DN
#define PROBE_NULL_DN 0
#endif
#ifndef PROBE_REP_IDX
#define PROBE_REP_IDX 1
#endif
#ifndef PROBE_B_SKIP
#define PROBE_B_SKIP 0
#endif
#ifndef PROBE_B_HOT
#define PROBE_B_HOT 0
#endif
#ifndef PROBE_CLK
#define PROBE_CLK 0
#endif
#ifndef PROBE_HOT_GU
#define PROBE_HOT_GU 0
#endif
#ifndef PROBE_NOST_GU
#define PROBE_NOST_GU 0
#endif
#ifndef PROBE_FUSED_VAR
#define PROBE_FUSED_VAR 0
#endif
#ifndef PROBE_FUSED_DN
#define PROBE_FUSED_DN 0
#endif
#ifndef PROBE_REP_THIN
#define PROBE_REP_THIN 1
#endif
template <bool LAST>
__device__ __forceinline__ void thin_phase(Frame& F, const Ptrs& P, const float* ga, float alpha) {
    int t_ = threadIdx.x; asm volatile("" : "+v"(t_)); const int lane_ = t_ & 63, wave_ = __builtin_amdgcn_readfirstlane(t_ >> 6);
    const int gw = F.vcu * NWAVES + wave_, NGW = F.G * NWAVES;
    const bf16* Y = (const bf16*)(P.ws + WS_Y); bf16* XB = (bf16*)(P.ws + WS_XB); float* RS = (float*)(P.ws + WS_RS);
    for (int m = gw; m < MROWS; m += NGW) thin_row<LAST>(Y + (size_t)m * DM, XB + (size_t)m * DM, P.out + (size_t)m * DM, ga, alpha, RS + m, lane_);
}

__device__ __forceinline__ int wave_sum_i(int x) {
    x += __builtin_amdgcn_update_dpp(0, x, 0x111, 0xf, 0xf, true);
    x += __builtin_amdgcn_update_dpp(0, x, 0x112, 0xf, 0xf, true);
    x += __builtin_amdgcn_update_dpp(0, x, 0x114, 0xf, 0xf, true);
    x += __builtin_amdgcn_update_dpp(0, x, 0x118, 0xf, 0xf, true);
    return __builtin_amdgcn_readlane(x, 15) + __builtin_amdgcn_readlane(x, 31) + __builtin_amdgcn_readlane(x, 47) + __builtin_amdgcn_readlane(x, 63);
}
__device__ __forceinline__ void select_row(const unsigned (&u)[32], unsigned T, int cT, LAS unsigned long long* mw, int lane) {
    if (cT == 256) {
#pragma unroll
        for (int i = 0; i < 32; ++i) { const unsigned long long w = __ballot(u[i] >= T); if (lane == 0) mw[i] = w; }
    } else {
        int cgt = 0;
#pragma unroll
        for (int i = 0; i < 32; ++i) cgt += __popcll(__ballot(u[i] > T));
        const int need = 256 - cgt; int base = 0; unsigned T2 = T; asm volatile("" : "+s"(T2));
#pragma unroll
        for (int i = 0; i < 32; ++i) {
            const bool eq = (u[i] == T2), gt = (u[i] > T2); const unsigned long long em = __ballot(eq);
            const int rank = (int)__builtin_amdgcn_mbcnt_hi((unsigned)(em >> 32), __builtin_amdgcn_mbcnt_lo((unsigned)em, (unsigned)base));
            const unsigned long long w = __ballot(gt || (eq && rank < need)); base += __popcll(em);
            if (lane == 0) mw[i] = w;
        }
    }
}
template <int VAR>
__device__ __forceinline__ void indexer_unit(Frame& F, const Ptrs& P, int b, int blk) {
    typedef short bf16x8v __attribute__((ext_vector_type(8)));
    int tid = threadIdx.x; asm volatile("" : "+v"(tid));
    const int q0 = blk * 16, qc = q0 >> 6, n64 = qc + 1, nvis = n64 * 64; const int lane = tid & 63, wid = __builtin_amdgcn_readfirstlane(tid >> 6);
    unsigned long long* mrow = (unsigned long long*)(P.ws + WS_MASK) + ((size_t)(b * SEQ + q0)) * 32;
    if (n64 <= 4) {
        for (int i = tid; i < 16 * 32; i += NWAVES * 64) { const int w = i & 31; if (w < n64) mrow[i] = ~0ull; }
        return;
    }
    const bf16* IQ = (const bf16*)(P.ws + WS_R1 + 192 * MiB); const bf16* IK = (const bf16*)(P.ws + WS_R1 + 208 * MiB); const float* IW = (const float*)(P.ws + WS_R1 + 210 * MiB);
    LAS float* sc = (LAS float*)F.lds;
    if (!(VAR & 1)) {
        const int q = lane & 15, kg = lane >> 4; const size_t qrow = (size_t)(b * SEQ + q0 + q);
        bf16x8v iq[8]; float wi[8];
#pragma unroll
        for (int h = 0; h < 8; ++h) { iq[h] = *(const bf16x8v*)(IQ + qrow * 256 + h * 32 + 8 * kg); wi[h] = IW[qrow * 8 + h]; }
        const int nt = (nvis / 16 - wid + NWAVES - 1) / NWAVES;
        const bf16* ikp = IK + ((size_t)(b * SEQ + wid * 16 + q)) * 32 + 8 * kg;
        bf16x8v af[16];
#pragma unroll
        for (int i = 0; i < 16; ++i) if (i < nt) af[i] = *(const bf16x8v*)(ikp + (size_t)i * (NWAVES * 16 * 32));
#pragma unroll
        for (int i = 0; i < 16; ++i) if (i < nt) {
            f32x4 acc = {0.f, 0.f, 0.f, 0.f};
#pragma unroll
            for (int h = 0; h < 8; ++h) { const f32x4 c = __builtin_amdgcn_mfma_f32_16x16x32_bf16(af[i], iq[h], (f32x4){0.f, 0.f, 0.f, 0.f}, 0, 0, 0);
#pragma unroll
                for (int j = 0; j < 4; ++j) acc[j] += wi[h] * fmaxf(c[j], 0.f); }
            const int col = ((wid + NWAVES * i) * 16 + kg * 4 + 4 * q) & 2047;
            *(LAS f32x4*)(sc + q * 2048 + col) = acc;
        }
    }
    __syncthreads();
    if (VAR != 7) {
        int n64l = n64; asm volatile("" : "+s"(n64l));
        unsigned ua[32], ub[32];
        { const int qa = 2 * wid, qb = 2 * wid + 1; const LAS float* ra = sc + qa * 2048; const LAS float* rb = sc + qb * 2048;
#pragma unroll
          for (int i = 0; i < 32; ++i) { const int e = i * 64 + lane;
              const unsigned ba = __float_as_uint(ra[(e + 4 * qa) & 2047]), bb = __float_as_uint(rb[(e + 4 * qb) & 2047]);
              const unsigned ka = (ba & 0x80000000u) ? ~ba : (ba | 0x80000000u), kb = (bb & 0x80000000u) ? ~bb : (bb | 0x80000000u);
              ua[i] = (i < n64l) ? ka : 0u; ub[i] = (i < n64l) ? kb : 0u; } }
        unsigned Ta = 0u, Tb = 0u; int cTa = nvis, cTb = nvis; bool da = false, db = false;
#pragma unroll 1
        for (int bit = (VAR & 2) ? -1 : 31; bit >= 0; --bit) {
            const unsigned ca = Ta | (1u << bit), cb = Tb | (1u << bit); int xa = 0, xb = 0;
#pragma unroll
            for (int g = 0; g < 4; ++g) if (n64l > 8 * g) {
#pragma unroll
                for (int i = 8 * g; i < 8 * g + 8; ++i) { xa += (ua[i] >= ca) ? 1 : 0; xb += (ub[i] >= cb) ? 1 : 0; } }
            const int na = wave_sum_i(xa), nb = wave_sum_i(xb);
            if (!da && na >= 256) { Ta = ca; cTa = na; if (na == 256) da = true; }
            if (!db && nb >= 256) { Tb = cb; cTb = nb; if (nb == 256) db = true; }
            if (da && db) break;
        }
        if (!(VAR & 4)) {
            LAS unsigned long long* stg = (LAS unsigned long long*)(sc + (2 * wid) * 2048);
            select_row(ua, (unsigned)__builtin_amdgcn_readfirstlane((int)Ta), __builtin_amdgcn_readfirstlane(cTa), stg, lane);
            select_row(ub, (unsigned)__builtin_amdgcn_readfirstlane((int)Tb), __builtin_amdgcn_readfirstlane(cTb), stg + 32, lane);
            mrow[(2 * wid) * 32 + lane] = stg[lane];
        }
    }
    __syncthreads();
}

__device__ __forceinline__ void a_unit(Frame& F, const Ptrs& P, int b, int h, int qb, float lam) {
    using namespace att; typedef Lds<128> L;
    const bf16_t* AQ = (const bf16_t*)(P.ws + WS_R1); const bf16_t* AK = (const bf16_t*)(P.ws + WS_R1 + 32 * MiB); const bf16_t* AV = (const bf16_t*)(P.ws + WS_R1 + 64 * MiB);
    int tid = threadIdx.x; asm volatile("" : "+v"(tid));
    const int lane = tid & 63, wid = __builtin_amdgcn_readfirstlane(tid >> 6), r32 = lane & 31; const size_t rowbase = (size_t)b * SEQ; const int q0 = qb * 256, qw = q0 + wid * 32, qc = qw >> 6;
    f32x4* stash = (f32x4*)(P.ws + WS_Y) + ((size_t)(blockIdx.x * NWAVES + wid) * 16) * 64 + lane;
    f32x16 o[4];
#pragma unroll 1
    for (int c = 0; c < 2; ++c) {
        const int g = 2 * h + c;
        attn_core<128, 0, 4>(o, F.lds, AQ + (rowbase + qw) * 512 + g * 64, 512, AK + rowbase * 512 + g * 64, 512, AV + rowbase * 512 + h * 128, 512, 0, (q0 >> 6) + 4, 0, qc + 1, nullptr, 0, 0);
        if (c == 0) {
            f32x4* sp = stash; asm volatile("" : "+v"(sp));
#pragma unroll
            for (int d0 = 0; d0 < 4; ++d0)
#pragma unroll
                for (int rq = 0; rq < 4; ++rq) sp[(d0 * 4 + rq) * 64] = (f32x4){o[d0][4 * rq], o[d0][4 * rq + 1], o[d0][4 * rq + 2], o[d0][4 * rq + 3]};
        }
    }
    {
        const f32x4* sp = stash; asm volatile("" : "+v"(sp));
#pragma unroll
        for (int d0 = 0; d0 < 4; ++d0)
#pragma unroll
            for (int rq = 0; rq < 4; ++rq) { const f32x4 a = sp[(d0 * 4 + rq) * 64];
#pragma unroll
                for (int j = 0; j < 4; ++j) o[d0][4 * rq + j] = a[j] - lam * o[d0][4 * rq + j]; }
    }
    float sl[4];
#pragma unroll
    for (int d0 = 0; d0 < 4; ++d0) sl[d0] = P.esub[32 * d0 + r32] * 0.8f;
#pragma unroll
    for (int r = 0; r < 16; ++r) { float s = 0.f;
#pragma unroll
        for (int d0 = 0; d0 < 4; ++d0) s += o[d0][r] * o[d0][r];
        s = sum32(s);
        const float rstd = 1.0f / sqrtf(s * (1.f / 128.f) + RMS_EPS);
#pragma unroll
        for (int d0 = 0; d0 < 4; ++d0) o[d0][r] *= rstd * sl[d0]; }
    store_o<128>(o, F.lds, (bf16_t*)(P.ws + WS_ATT) + (rowbase + qw) * DM + h * 128, DM);
}
__device__ __forceinline__ void b_unit(Frame& F, const Ptrs& P, int b, int h, int qb, int hotmask = -1, int skip = 0) {
    using namespace att;
    const bf16_t* BQ = (const bf16_t*)(P.ws + WS_R1 + 96 * MiB); const bf16_t* BK = (const bf16_t*)(P.ws + WS_R1 + 128 * MiB); const bf16_t* BV = (const bf16_t*)(P.ws + WS_R1 + 160 * MiB);
    int tid = threadIdx.x; asm volatile("" : "+v"(tid));
    const int lane = tid & 63, wid = __builtin_amdgcn_readfirstlane(tid >> 6), r32 = lane & 31; const size_t rowbase = (size_t)b * SEQ; const int q0 = qb * 256, qw = q0 + wid * 32, qc = qw >> 6;
    const unsigned long long* mrow = (const unsigned long long*)(P.ws + WS_MASK) + (rowbase + qw + r32) * 32;
    f32x16 o[2];
    attn_core<64, 1, 4>(o, F.lds, BQ + (rowbase + qw) * 512 + h * 64, 512, BK + rowbase * 512 + h * 64, 512, BV + rowbase * 512 + h * 64, 512, 0, (q0 >> 6) + 4, 0, qc + 1, mrow, 0, 0, hotmask, skip);
    store_o<64>(o, F.lds, (bf16_t*)(P.ws + WS_ATT) + (rowbase + qw) * DM + 512 + h * 64, DM);
}
__device__ __forceinline__ void c_unit(Frame& F, const Ptrs& P, int b, int h, int qb) {
    using namespace att; typedef Lds<64> L;
    const bf16_t* CQ = (const bf16_t*)(P.ws + WS_R1); const bf16_t* CK = (const bf16_t*)(P.ws + WS_R1 + 64 * MiB); const bf16_t* CV = (const bf16_t*)(P.ws + WS_R1 + 128 * MiB);
    int tid = threadIdx.x; asm volatile("" : "+v"(tid));
    const int lane = tid & 63, wid = __builtin_amdgcn_readfirstlane(tid >> 6), r32 = lane & 31; const size_t rowbase = (size_t)b * SEQ; const int q0 = qb * 256, qw = q0 + wid * 32, qc = qw >> 6;
    LAS float* bt = (LAS float*)(F.lds + L::OFF_BT);
    for (int i = tid; i < 640; i += NWAVES * 64) bt[i] = P.obias[h * 320 + (i < 319 ? i : 319)] * LOG2E;
    const int c0 = q0 >> 6, T0 = c0 - 8 > 0 ? c0 - 8 : 0, tw0 = qc - 8 > 0 ? qc - 8 : 0;
    f32x16 o[2];
    attn_core<64, 2, 4>(o, F.lds, CQ + (rowbase + qw) * DM + h * 64, DM, CK + rowbase * DM + h * 64, DM, CV + rowbase * DM + h * 64, DM, T0, c0 + 4, tw0, qc + 1, nullptr, qw + r32, qc);
    store_o<64>(o, F.lds, (bf16_t*)(P.ws + WS_ATT) + (rowbase + qw) * DM + h * 64, DM);
}

#ifndef DBG_NO_IDX
#define DBG_NO_IDX 0
#endif
#ifndef DBG_NO_A
#define DBG_NO_A 0
#endif
#ifndef DBG_NO_B
#define DBG_NO_B 0
#endif
#ifndef DBG_STAGES
#define DBG_STAGES 99
#endif
struct Args { const float* in[12]; float* out; unsigned char* ws; };
__global__ void __launch_bounds__(NWAVES * 64, 2) fwd_kernel(Args args) {
    extern __shared__ __attribute__((aligned(16))) unsigned char lds[];
    Frame F;
    F.lds = (LAS unsigned char*)lds; F.MISC = (volatile LAS unsigned*)(F.lds + MISC_OFF);
    F.tid = threadIdx.x; F.lane = F.tid & 63; F.wave = __builtin_amdgcn_readfirstlane(F.tid >> 6);
    F.G = gridDim.x; { const int bx = blockIdx.x; F.vcu = (F.G % 8 == 0) ? (bx % 8) * (F.G / 8) + bx / 8 : bx; }
    Ptrs P; P.x = args.in[0]; P.norm_g = args.in[1]; P.wg = args.in[2]; P.wu = args.in[3]; P.wd = args.in[4]; P.ewin = args.in[5]; P.ewout = args.in[6]; P.elam = args.in[7]; P.esub = args.in[8];
    P.owin = args.in[9]; P.owout = args.in[10]; P.obias = args.in[11]; P.out = args.out; P.ws = args.ws;
    F.ctl = (gu32*)(P.ws + WS_CTL);
    for (int u = F.tid; u < (LDS_BYTES - LDSCTL_OFF) / 4; u += NWAVES * 64) ((LAS unsigned*)(F.lds + LDSCTL_OFF))[u] = 0u;
    __syncthreads();
    XcdBarrier bar = xcd_barrier_post((unsigned*)(F.ctl + CW_BAR), F.MISC + 8);
#define GRID_BAR() xcd_barrier(bar)
    bf16* XB = (bf16*)(P.ws + WS_XB); const float* RS = (const float*)(P.ws + WS_SSQ2); bf16* HID = (bf16*)(P.ws + WS_R1); bf16* Y = (bf16*)(P.ws + WS_Y); const bf16* ATT = (const bf16*)(P.ws + WS_ATT);

#ifdef PROBE_REP_PRO
    for (int rep_ = 1; rep_ < PROBE_REP_PRO; ++rep_) { p0_prologue(F, P); __syncthreads(); }
#endif
    p0_prologue(F, P); GRID_BAR();

#define FUSED_GEMM(Aop, Bop, Kdim, inst, gain, alpha_, LAST_) FUSED_GEMM_X(XB, (float*)(P.ws + WS_SSQ2), Aop, Bop, Kdim, inst, gain, alpha_, LAST_, 0)
#define FUSED_GEMM_X(Xp, SSQ2p, Aop, Bop, Kdim, inst, gain, alpha_, LAST_, PV_) do { \
        pg8::Gemm g{(Aop), (Bop), MROWS, DM, (Kdim)}; \
        epi::EpiRmsRes<LAST_, PV_> E{(Xp), P.out, (gain), (alpha_), (unsigned long long*)(P.ws + WS_GRAN), (unsigned)((inst) + 1), (SSQ2p), (unsigned*)(F.ctl + CW_TMO), F.lds + FUSED_LDS_OFF}; \
        pg8::StaticOrder S; S.init(MROWS, DM, F.G, (int)blockIdx.x); \
        pg8::gemm_phase<epi::EpiRmsRes<LAST_, PV_>, pg8::StaticOrder, true, true>(F.lds, g, S, E); } while (0)
#define FFN_PHASES(l, f, LAST_) do { \
        { pg8::Gemm g{XB, (const bf16*)(P.ws + WS_WGU + (2 * (l) + (f)) * WGU_BYTES), MROWS, NGU, DM}; pg8::StaticOrder S; S.init(MROWS, NGU, F.G, (int)blockIdx.x); \
          epi::EpiSwiGLU E{HID, RS}; const unsigned long long pc0_ = PROBE_CLK ? __builtin_amdgcn_s_memtime() : 0ull; for (int rep_ = 0; rep_ < PROBE_REP_GU; ++rep_) pg8::gemm_phase<epi::EpiSwiGLU, pg8::StaticOrder, true, true>(F.lds, g, S, E); \
          if (PROBE_CLK) { const unsigned long long pc1_ = __builtin_amdgcn_s_memtime(); while (__builtin_amdgcn_s_memtime() - pc1_ < pc1_ - pc0_) __builtin_amdgcn_s_sleep(32); } \
          if (PROBE_NULL_GU) { epi::EpiNull EN; for (int rep_ = 0; rep_ < PROBE_NULL_GU; ++rep_) pg8::gemm_phase<epi::EpiNull, pg8::StaticOrder, true, true>(F.lds, g, S, EN); } \
          if (PROBE_HOT_GU) { epi::EpiNull EN; epi::HotOrder HS{11, (int)blockIdx.x}; pg8::gemm_phase<epi::EpiNull, epi::HotOrder, true, true>(F.lds, g, HS, EN); } \
          if (PROBE_NOST_GU) { epi::EpiSwiGLUT<1> EN{HID, RS}; pg8::gemm_phase<epi::EpiSwiGLUT<1>, pg8::StaticOrder, true, true>(F.lds, g, S, EN); } } \
        GRID_BAR(); \
        if (PROBE_FUSED_DN) { FUSED_GEMM_X((bf16*)(P.ws + WS_ATT), (float*)(P.ws + WS_SSQ1), HID, (const bf16*)(P.ws + WS_WD + (2 * (l) + (f)) * WD_BYTES), FF, 6 + 2 * (l) + (f), P.norm_g + ((l) * 6 + 4 * (f) + 1) * DM, 0.5f, false, PROBE_FUSED_VAR); GRID_BAR(); } \
        FUSED_GEMM(HID, (const bf16*)(P.ws + WS_WD + (2 * (l) + (f)) * WD_BYTES), FF, 3 * (l) + 2 * (f), P.norm_g + ((l) * 6 + 4 * (f) + 1) * DM, 0.5f, LAST_); \
        if (!(LAST_)) GRID_BAR(); } while (0)

    FFN_PHASES(0, 0, false);
    if (DBG_STAGES >= 2) {
        { pg8::Gemm g{XB, (const bf16*)(P.ws + WS_WIN0), MROWS, NEV, DM}; pg8::StaticOrder S; S.init(MROWS, NEV, F.G, (int)blockIdx.x);
          unsigned char* r1 = P.ws + WS_R1;
          epi::EpiProjEven E{(bf16*)r1, (bf16*)(r1 + 192 * MiB), (bf16*)(r1 + 208 * MiB),
                             (float*)(r1 + 210 * MiB), RS, (const float*)(P.ws + WS_C64), (const float*)(P.ws + WS_S64), (const float*)(P.ws + WS_C32), (const float*)(P.ws + WS_S32)};
          pg8::gemm_phase<epi::EpiProjEven, pg8::StaticOrder, true, true>(F.lds, g, S, E); }
        GRID_BAR();
#ifdef PROBE_IDX_VAR
        for (int p = F.vcu; p < 1024; p += F.G) { const int b = p >> 6, j = p & 63;
#pragma unroll 1
            for (int k = 0; k < 2; ++k) indexer_unit<PROBE_IDX_VAR>(F, P, b, k ? 127 - j : j); }
#endif
        for (int rep_ = 0; rep_ < PROBE_REP_IDXA * PROBE_REP_IDX; ++rep_)
        for (int p = F.vcu; p < 1024; p += F.G) { const int b = p >> 6, j = p & 63;
#pragma unroll 1
            for (int k = 0; k < 2; ++k) { if (!DBG_NO_IDX) indexer_unit<0>(F, P, b, k ? 127 - j : j); } }
        {
            float l01 = 0.f, l23 = 0.f;
            for (int i = 0; i < 64; ++i) { l01 += P.elam[i] * P.elam[64 + i]; l23 += P.elam[128 + i] * P.elam[192 + i]; }
            const float lam = expf(l01) - expf(l23) + 0.2f;
            for (int rep_ = 0; rep_ < PROBE_REP_IDXA; ++rep_)
            for (int p = F.vcu; p < 256; p += F.G) { const int bh = p >> 2, s = p & 3;
#pragma unroll 1
                for (int k = 0; k < 2; ++k) { if (!DBG_NO_A) a_unit(F, P, bh >> 2, bh & 3, k ? 7 - s : s, lam); } }
        }
        GRID_BAR();
        for (int rep_ = 0; rep_ < PROBE_REP_B; ++rep_)
        for (int p = F.vcu; p < 512; p += F.G) { const int bh = p >> 2, s = p & 3;
#pragma unroll 1
            for (int k = 0; k < 2; ++k) { if (!DBG_NO_B) b_unit(F, P, bh >> 3, bh & 7, k ? 7 - s : s, (PROBE_B_HOT && rep_ + 1 < PROBE_REP_B) ? 0 : -1, (rep_ + 1 < PROBE_REP_B) ? PROBE_B_SKIP : 0); } }
        GRID_BAR();
        FUSED_GEMM(ATT, (const bf16*)(P.ws + WS_WOUT0), DM, 3 * 0 + 1, P.norm_g + (0 * 6 + 3) * DM, 1.0f, false);
        GRID_BAR();
    }
    if (DBG_STAGES >= 3) FFN_PHASES(0, 1, false);
#ifdef PROBE_XBAR
    for (int i_ = 0; i_ < PROBE_XBAR; ++i_) GRID_BAR();
#endif
#ifdef PROBE_IDLE_CYC
    { const unsigned long long t0_ = __builtin_amdgcn_s_memtime(); while (__builtin_amdgcn_s_memtime() - t0_ < (unsigned long long)PROBE_IDLE_CYC) __builtin_amdgcn_s_sleep(32); }
#endif
#ifdef PROBE_IDLE_US
    { const unsigned long long t0_ = __builtin_amdgcn_s_memrealtime(); while (__builtin_amdgcn_s_memrealtime() - t0_ < 100ull * PROBE_IDLE_US) __builtin_amdgcn_s_sleep(32); }
#endif
    if (DBG_STAGES >= 4) FFN_PHASES(1, 0, false);
    if (DBG_STAGES >= 5) {
        { pg8::Gemm g{XB, (const bf16*)(P.ws + WS_WIN1), MROWS, NOD, DM}; pg8::StaticOrder S; S.init(MROWS, NOD, F.G, (int)blockIdx.x);
          unsigned char* r1 = P.ws + WS_R1; epi::EpiProjOdd E{(bf16*)r1, RS};
          pg8::gemm_phase<epi::EpiProjOdd, pg8::StaticOrder, true, true>(F.lds, g, S, E); }
        GRID_BAR();
        for (int rep_ = 0; rep_ < PROBE_REP_C; ++rep_)
        for (int p = F.vcu; p < 256; p += F.G) { const int b = p >> 4, h = p & 15;
#pragma unroll 1
            for (int qb = 0; qb < 8; ++qb) c_unit(F, P, b, h, qb); }
        GRID_BAR();
        FUSED_GEMM(ATT, (const bf16*)(P.ws + WS_WOUT1), DM, 3 * 1 + 1, P.norm_g + (1 * 6 + 3) * DM, 1.0f, false);
        GRID_BAR();
    }
    if (DBG_STAGES >= 6) FFN_PHASES(1, 1, true);
}

extern "C" void kernel_launch(void* const* d_in, const int* in_sizes, int n_in, void* d_out, int out_size, void* d_ws, size_t ws_size, hipStream_t stream) {
    static int grid = 0;
    if (grid == 0) {
        if (n_in != 12 || in_sizes[0] != MROWS * DM || out_size != MROWS * DM || ws_size < WS_END) {
            fprintf(stderr, "kernel_launch: unexpected shapes / workspace (n_in %d, in0 %d, out %d, ws %zu, need %zu); nothing launched\n", n_in, n_in > 0 ? in_sizes[0] : -1, out_size, ws_size, (size_t)WS_END); grid = -1; return; }
        int dev = 0, cus = 0, per_cu = 0;
        if (hipGetDevice(&dev) != hipSuccess || hipDeviceGetAttribute(&cus, hipDeviceAttributeMultiprocessorCount, dev) != hipSuccess) { fprintf(stderr, "kernel_launch: device query failed\n"); grid = -1; return; }
        if (hipFuncSetAttribute((const void*)fwd_kernel, hipFuncAttributeMaxDynamicSharedMemorySize, LDS_BYTES) != hipSuccess) { fprintf(stderr, "kernel_launch: hipFuncSetAttribute failed\n"); grid = -1; return; }
        if (hipOccupancyMaxActiveBlocksPerMultiprocessor(&per_cu, (const void*)fwd_kernel, NWAVES * 64, LDS_BYTES) != hipSuccess || per_cu < 1)
            fprintf(stderr, "kernel_launch: note: occupancy query reports %d workgroups per CU\n", per_cu);
        (void)hipGetLastError();
        grid = cus;
        if (grid != 256) { fprintf(stderr, "kernel_launch: built for a 256-CU device (the fused epilogues pair workgroups by rounds of 256), found %d; nothing launched\n", cus); grid = -1; return; }
    }
    if (grid < 0) return;
    if (hipMemsetAsync((char*)d_ws + WS_CTL, 0, CTL_ZERO_BYTES, stream) != hipSuccess) { fprintf(stderr, "kernel_launch: memset failed\n"); return; }
    Args a{};
    for (int i = 0; i < 12; ++i) a.in[i] = (const float*)d_in[i];
    a.out = (float*)d_out; a.ws = (unsigned char*)d_ws;
    hipLaunchKernelGGL(fwd_kernel, dim3(grid), dim3(NWAVES * 64), LDS_BYTES, stream, a);
    const hipError_t le = hipPeekAtLastError();
    if (le != hipSuccess) fprintf(stderr, "kernel_launch: launch failed: %s\n", hipGetErrorName(le));
}
```

```cpp
#include <hip/hip_runtime.h>
#include <cstdio>
#include <cstdint>
namespace pg8 {
#define PG8_LAS __attribute__((address_space(3)))
typedef unsigned short bf16_t;
typedef short bf16x8 __attribute__((ext_vector_type(8)));
typedef float f32x4 __attribute__((ext_vector_type(4)));
typedef unsigned u32x4 __attribute__((ext_vector_type(4)));
constexpr int BM = 256, BK = 64, HALF = 128, HTB = HALF * BK * 2  , STAGE_BYTES = 8 * HTB, NXCD = 8, WGM = 8;

__host__ __device__ __forceinline__ int lds_byte(int r, int c) { const int st = (r >> 4) * 2 + (c >> 5), rr = r & 15, cc = c & 31, ob = rr * 64 + cc * 2; return st * 1024 + (ob ^ (((ob >> 9) & 1) << 5)); }
__host__ __device__ __forceinline__ void stage_rc(int b, int& R, int& C) { const int st = b / 1024, sb = b % 1024, swz = sb ^ (((sb >> 9) & 1) << 5); R = (st >> 1) * 16 + swz / 64; C = (st & 1) * 32 + (swz % 64) / 2; }
__host__ __device__ __forceinline__ int perm32(int rho) { const int n = rho >> 4, i = rho & 15; return 8 * (i >> 2) + 4 * n + (i & 3); }

struct Unit { int pm, pn, idx; };
struct Gemm { const bf16_t* A; const bf16_t* Bt; int M, N, K; };

struct StaticOrder {
    int nM, nN, nwg, G, c;
    __host__ __device__ void init(int M, int N, int G_, int c_) { nM = M / BM; nN = N / BM; nwg = nM * nN; G = G_; c = c_; }
    __host__ __device__ bool next(int i, Unit& u) const {
        const long L = (long)i * G + c; if (L >= nwg) return false;
        int wgid = (int)L; { const int q = nwg / NXCD, r = nwg % NXCD, xcd = wgid % NXCD, off = wgid / NXCD; wgid = (xcd < r ? xcd * (q + 1) : r * (q + 1) + (xcd - r) * q) + off; }
        const int nig = WGM * nN, gid = wgid / nig, fm = gid * WGM, gsz = (nM - fm) < WGM ? (nM - fm) : WGM;
        u.pm = fm + ((wgid % nig) % gsz); u.pn = (wgid % nig) / gsz; return true;
    }
    __device__ __forceinline__ void a_ready(const Unit&) const {}
    __device__ __forceinline__ void done(const Unit&) const {}
};

__device__ __forceinline__ unsigned cvt_pk_bf16(float lo, float hi) { unsigned r; asm volatile("v_cvt_pk_bf16_f32 %0, %1, %2" : "=v"(r) : "v"(lo), "v"(hi)); return r; }
typedef float f32x2 __attribute__((ext_vector_type(2)));
__device__ __forceinline__ f32x2 gelu_pk(f32x2 v) {
    const f32x2 av = __builtin_elementwise_abs(v), d = av * 0.2316418882f + 1.0f;
    f32x2 t; t.x = __builtin_amdgcn_rcpf(d.x); t.y = __builtin_amdgcn_rcpf(d.y);
    f32x2 q = t * 0.5307027145f + (-0.7265760135f); q = q * t + 0.7107068705f; q = q * t + (-0.142248368f); q = q * t + 0.127414796f; q = q * t;
    const f32x2 s = (v * v) * (-0.72134752044f);
    f32x2 e; e.x = __builtin_amdgcn_exp2f(s.x); e.y = __builtin_amdgcn_exp2f(s.y);
    const f32x2 m = v * (q * e), r = v - m;
    f32x2 o; o.x = v.x < 0.f ? m.x : r.x; o.y = v.y < 0.f ? m.y : r.y; return o;
}

template <int ACT  > struct EpiBf16 {
    static constexpr bool PERM = true, AFTER_DRAIN = false; static_assert(ACT == 0 || ACT == 1, "EpiBf16: ACT is 0 (none) or 1 (gelu_pk)");
    bf16_t* O; int ldc; const float* bias; int split_cols; size_t split_stride; float scale0;
    __device__ __forceinline__ void operator()(const f32x4 (&acc)[2][2][4][2], const Unit& u, int wr, int wc, int fr, int fq) const {
        const int row0 = u.pm * BM + wr * 64 + fr; int colt = u.pn * BM; bf16_t* base = O;
        float sc = 1.f; if (split_cols) { const int t = colt / split_cols; base += (size_t)t * split_stride; colt -= t * split_cols; if (t == 0) sc = scale0; }
        const int col0 = colt + wc * 32 + 8 * fq, bcol0 = u.pn * BM + wc * 32 + 8 * fq;
        f32x4 bv[2][2];
#pragma unroll
        for (int bj = 0; bj < 2; ++bj)
#pragma unroll
            for (int n = 0; n < 2; ++n) bv[bj][n] = bias ? *(const f32x4*)(bias + bcol0 + bj * HALF + 4 * n) : (f32x4){0.f, 0.f, 0.f, 0.f};
#pragma unroll
        for (int ai = 0; ai < 2; ++ai)
#pragma unroll
            for (int m = 0; m < 4; ++m) { bf16_t* rowp = base + (size_t)(row0 + ai * HALF + m * 16) * ldc + col0;
#pragma unroll
                for (int bj = 0; bj < 2; ++bj) { f32x4 v0 = acc[ai][bj][m][0] + bv[bj][0], v1 = acc[ai][bj][m][1] + bv[bj][1];
                    if (ACT == 1) { f32x2 a = gelu_pk((f32x2){v0[0], v0[1]}), b = gelu_pk((f32x2){v0[2], v0[3]}), c = gelu_pk((f32x2){v1[0], v1[1]}), d = gelu_pk((f32x2){v1[2], v1[3]});
                        v0 = (f32x4){a.x, a.y, b.x, b.y}; v1 = (f32x4){c.x, c.y, d.x, d.y}; }
                    v0 = v0 * sc; v1 = v1 * sc; u32x4 w; w.x = cvt_pk_bf16(v0[0], v0[1]); w.y = cvt_pk_bf16(v0[2], v0[3]); w.z = cvt_pk_bf16(v1[0], v1[1]); w.w = cvt_pk_bf16(v1[2], v1[3]);
                    *(u32x4*)(rowp + bj * HALF) = w; } }
    }
};

struct PanelStats {
    unsigned* xbuf;
    unsigned* cnt;
    unsigned* tmo;
    int ntn; float eps;
    unsigned code;
    __device__ __forceinline__ bool run(const f32x4 (&v)[2][2][4][2], const Unit& u, int wr, int wc, int fr, int fq, PG8_LAS unsigned char* lds, int wid, int lane) const {
        typedef float f32x2v __attribute__((ext_vector_type(2)));
        PG8_LAS f32x2v* P = (PG8_LAS f32x2v*)lds;
        PG8_LAS f32x2v* S = (PG8_LAS f32x2v*)(lds + 8192);
        PG8_LAS unsigned* flag = (PG8_LAS unsigned*)(lds + 8192 + 2048);
#pragma unroll
        for (int ai = 0; ai < 2; ++ai)
#pragma unroll
            for (int m = 0; m < 4; ++m) {
                float s = 0.f;
#pragma unroll
                for (int bj = 0; bj < 2; ++bj)
#pragma unroll
                    for (int n = 0; n < 2; ++n) { const f32x4 x = v[ai][bj][m][n]; s += (x[0] + x[1]) + (x[2] + x[3]); }
                s += __shfl_xor(s, 16); s += __shfl_xor(s, 32);
                const float mw = s * (1.0f / 64.0f); float q = 0.f;
#pragma unroll
                for (int bj = 0; bj < 2; ++bj)
#pragma unroll
                    for (int n = 0; n < 2; ++n) { const f32x4 d = v[ai][bj][m][n] - mw; q += (d[0] * d[0] + d[1] * d[1]) + (d[2] * d[2] + d[3] * d[3]); }
                q += __shfl_xor(q, 16); q += __shfl_xor(q, 32);
                if (fq == 0) P[(ai * HALF + wr * 64 + m * 16 + fr) * 4 + wc] = (f32x2v){mw, q};
            }
        asm volatile("s_waitcnt lgkmcnt(0)" ::: "memory"); __builtin_amdgcn_s_barrier(); asm volatile("" ::: "memory");
#if defined(BROKEN_EXCHANGE_NO_WAIT)
#warning BROKEN CONTROL BUILD: the row-statistics exchange does not wait; results are wrong by design
        if (blockIdx.x >= 64) { const long long t0_ = clock64(); while (clock64() - t0_ < 60000) __builtin_amdgcn_s_sleep(8); }
#endif
        const int row = wid * 32 + (lane & 31);
        if (lane < 32) {
            const f32x2v a = P[row * 4 + 0], b = P[row * 4 + 1], c = P[row * 4 + 2], d = P[row * 4 + 3];
            const float mt = (a.x + b.x + c.x + d.x) * 0.25f;
            const float da = a.x - mt, db = b.x - mt, dc = c.x - mt, dd = d.x - mt;
            const float m2 = (a.y + b.y) + (c.y + d.y) + 64.0f * ((da * da + db * db) + (dc * dc + dd * dd));
            unsigned long long* slot = (unsigned long long*)xbuf + ((size_t)(u.pm * BM + row) * 4 + u.pn);
            __hip_atomic_store(slot, ((unsigned long long)__float_as_uint(m2) << 32) | __float_as_uint(mt), __ATOMIC_RELAXED, __HIP_MEMORY_SCOPE_AGENT);
        }
        asm volatile("s_waitcnt vmcnt(0)" ::: "memory");
        if (lane == 0) __hip_atomic_fetch_add(cnt + 64 * u.pm, 1u, __ATOMIC_RELAXED, __HIP_MEMORY_SCOPE_AGENT);
        if (wid == 0) {
            bool dead = false; const unsigned long long t0 = __builtin_amdgcn_s_memrealtime(); const unsigned want = 8u * (unsigned)ntn;
            for (;;) {
#if defined(BROKEN_EXCHANGE_NO_WAIT)
                break;
#endif
                if ((unsigned)__builtin_amdgcn_readfirstlane(__hip_atomic_load(cnt + 64 * u.pm, __ATOMIC_RELAXED, __HIP_MEMORY_SCOPE_AGENT)) >= want) break;
                if (__builtin_amdgcn_s_memrealtime() - t0 > 2000000ull) {
                    if (lane == 0) { unsigned expect = 0u; __hip_atomic_compare_exchange_strong(tmo + 1, &expect, code | (unsigned)(u.pm & 0xff), __ATOMIC_RELAXED, __ATOMIC_RELAXED, __HIP_MEMORY_SCOPE_AGENT);
                                     __hip_atomic_store(tmo, 1u, __ATOMIC_RELAXED, __HIP_MEMORY_SCOPE_AGENT); }
                    dead = true; break; }
                __builtin_amdgcn_s_sleep(2);
            }
            __builtin_amdgcn_fence(__ATOMIC_ACQUIRE, "agent");
            if (lane == 0) flag[0] = dead ? 1u : 0u;
        }
        asm volatile("s_waitcnt vmcnt(0) lgkmcnt(0)" ::: "memory"); __builtin_amdgcn_s_barrier(); asm volatile("" ::: "memory");
        const bool bad = flag[0] != 0u;
        if (lane < 32) {
            const unsigned long long* slot = (const unsigned long long*)xbuf + (size_t)(u.pm * BM + row) * 4; float mt[4], m2[4]; float ms = 0.f;
#pragma unroll
            for (int t = 0; t < 4; ++t) { if (t < ntn) { const unsigned long long w = __hip_atomic_load(slot + t, __ATOMIC_RELAXED, __HIP_MEMORY_SCOPE_AGENT); mt[t] = __uint_as_float((unsigned)w); m2[t] = __uint_as_float((unsigned)(w >> 32)); } else { mt[t] = 0.f; m2[t] = 0.f; } ms += mt[t]; }
            const float mean = ms / (float)ntn; float q = 0.f;
#pragma unroll
            for (int t = 0; t < 4; ++t) if (t < ntn) { const float dm = mt[t] - mean; q += m2[t] + 256.0f * dm * dm; }
            S[row] = (f32x2v){mean, 1.0f / sqrtf(q / (256.0f * (float)ntn) + eps)};
        }
        asm volatile("s_waitcnt lgkmcnt(0)" ::: "memory"); __builtin_amdgcn_s_barrier(); asm volatile("" ::: "memory");
        return bad;
    }
};
struct EpiLnRes {
    static constexpr bool PERM = false, AFTER_DRAIN = true;
    const float* base; float* out; int ldc; const float* bias; PanelStats st; unsigned poison;
    __device__ __forceinline__ void fused(f32x4 (&acc)[2][2][4][2], const Unit& u, int wr, int wc, int fr, int fq, PG8_LAS unsigned char* lds, int wid, int lane) const {
        typedef float f32x2v __attribute__((ext_vector_type(2)));
        const PG8_LAS f32x2v* S = (const PG8_LAS f32x2v*)(lds + 8192);
        const int col0 = u.pn * BM + wc * 32 + 4 * fq;
#pragma unroll
        for (int bj = 0; bj < 2; ++bj)
#pragma unroll
            for (int n = 0; n < 2; ++n) { const f32x4 bv = bias ? *(const f32x4*)(bias + col0 + bj * HALF + n * 16) : (f32x4){0.f, 0.f, 0.f, 0.f};
#pragma unroll
                for (int ai = 0; ai < 2; ++ai)
#pragma unroll
                    for (int m = 0; m < 4; ++m) acc[ai][bj][m][n] += bv; }
        f32x4 pre[4][2][2];
#pragma unroll
        for (int m = 0; m < 4; ++m) { const size_t off = (size_t)(u.pm * BM + wr * 64 + m * 16 + fr) * ldc + col0;
#pragma unroll
            for (int bj = 0; bj < 2; ++bj)
#pragma unroll
                for (int n = 0; n < 2; ++n) pre[m][bj][n] = *(const f32x4*)(base + off + bj * HALF + n * 16); }
        const bool bad = st.run(acc, u, wr, wc, fr, fq, lds, wid, lane) || poison != 0u;
        const float qnan = __builtin_nanf("");
#pragma unroll
        for (int ai = 0; ai < 2; ++ai)
#pragma unroll
            for (int m = 0; m < 4; ++m) { const int r = ai * HALF + wr * 64 + m * 16 + fr; const f32x2v sr = S[r]; const size_t off = (size_t)(u.pm * BM + r) * ldc + col0;
#pragma unroll
                for (int bj = 0; bj < 2; ++bj)
#pragma unroll
                    for (int n = 0; n < 2; ++n) { const f32x4 bs = ai == 0 ? pre[m][bj][n] : *(const f32x4*)(base + off + bj * HALF + n * 16); f32x4 o = bs + (acc[ai][bj][m][n] - sr.x) * sr.y;
                        if (bad) o = (f32x4){qnan, qnan, qnan, qnan}; *(f32x4*)(out + off + bj * HALF + n * 16) = o; }
                if (m & 1) asm volatile("" ::: "memory"); }
    }
};
struct EpiLnResLn {
    static constexpr bool PERM = false, AFTER_DRAIN = true;
    const float* base; float* out; bf16_t* xn; int ldc; const float* bias; PanelStats st1, st2; unsigned poison;
    __device__ __forceinline__ void fused(f32x4 (&acc)[2][2][4][2], const Unit& u, int wr, int wc, int fr, int fq, PG8_LAS unsigned char* lds, int wid, int lane) const {
        typedef float f32x2v __attribute__((ext_vector_type(2))); typedef unsigned u32x2v __attribute__((ext_vector_type(2)));
        const PG8_LAS f32x2v* S = (const PG8_LAS f32x2v*)(lds + 8192);
        const int col0 = u.pn * BM + wc * 32 + 4 * fq;
#pragma unroll
        for (int bj = 0; bj < 2; ++bj)
#pragma unroll
            for (int n = 0; n < 2; ++n) { const f32x4 bv = bias ? *(const f32x4*)(bias + col0 + bj * HALF + n * 16) : (f32x4){0.f, 0.f, 0.f, 0.f};
#pragma unroll
                for (int ai = 0; ai < 2; ++ai)
#pragma unroll
                    for (int m = 0; m < 4; ++m) acc[ai][bj][m][n] += bv; }
        bool bad = st1.run(acc, u, wr, wc, fr, fq, lds, wid, lane) || poison != 0u;
        const float qnan = __builtin_nanf("");
#pragma unroll
        for (int ai = 0; ai < 2; ++ai)
#pragma unroll
            for (int m = 0; m < 4; ++m) { const int r = ai * HALF + wr * 64 + m * 16 + fr; const f32x2v sr = S[r]; const size_t off = (size_t)(u.pm * BM + r) * ldc + col0;
#pragma unroll
                for (int bj = 0; bj < 2; ++bj)
#pragma unroll
                    for (int n = 0; n < 2; ++n) { const f32x4 bs = *(const f32x4*)(base + off + bj * HALF + n * 16); acc[ai][bj][m][n] = bs + (acc[ai][bj][m][n] - sr.x) * sr.y; }
                asm volatile("" : "+v"(acc[ai][0][m][0]), "+v"(acc[ai][0][m][1]), "+v"(acc[ai][1][m][0]), "+v"(acc[ai][1][m][1]));
                if (m & 1) asm volatile("" ::: "memory"); }
        const bool bad1 = bad;
        bad = st2.run(acc, u, wr, wc, fr, fq, lds, wid, lane) || bad;
#pragma unroll
        for (int ai = 0; ai < 2; ++ai)
#pragma unroll
            for (int m = 0; m < 4; ++m) { const int r = ai * HALF + wr * 64 + m * 16 + fr; const f32x2v sr = S[r]; const size_t off = (size_t)(u.pm * BM + r) * ldc + col0;
#pragma unroll
                for (int bj = 0; bj < 2; ++bj)
#pragma unroll
                    for (int n = 0; n < 2; ++n) { const f32x4 x1 = acc[ai][bj][m][n]; *(f32x4*)(out + off + bj * HALF + n * 16) = bad1 ? (f32x4){qnan, qnan, qnan, qnan} : x1;
                        const f32x4 o = (x1 - sr.x) * sr.y; u32x2v w; w.x = cvt_pk_bf16(o[0], o[1]); w.y = cvt_pk_bf16(o[2], o[3]);
                        if (bad) { w.x = 0x7fc07fc0u; w.y = 0x7fc07fc0u; } *(u32x2v*)(xn + off + bj * HALF + n * 16) = w; }
                asm volatile("" ::: "memory"); }
    }
};

template <class Epi, class Sched, bool ALIGN_EPI = false, bool SP2 = false>
__device__ __forceinline__ void gemm_phase(PG8_LAS unsigned char* lds, const Gemm g, const Sched& S, const Epi& E) {
    int tid_ = threadIdx.x; asm volatile("" : "+v"(tid_));
    const int tid = tid_, wid = __builtin_amdgcn_readfirstlane(tid >> 6), lane = tid & 63, wr = wid >> 2, wc = wid & 3, fr = lane & 15, fq = lane >> 4;
    const int K = g.K, nt = K / BK;
    unsigned voffA[2], voffB[2];
#pragma unroll
    for (int i = 0; i < 2; ++i) { int R, C; stage_rc(tid * 16 + i * 8192, R, C); const int Rb = Epi::PERM ? ((R & ~31) + perm32(R & 31)) : R;
        voffA[i] = (unsigned)(R * K + C) * 2u; voffB[i] = (unsigned)(Rb * K + C) * 2u; }
    const size_t kstep = (size_t)(BK * 2);
    const size_t hstep = (size_t)HALF * K * 2;
    const size_t tstep = 2 * hstep;
    const unsigned ldsw = (unsigned)wid * 1024u;
    const int aoff = lds_byte(wr * 64 + fr, fq * 8), boff = lds_byte(wc * 32 + fr, fq * 8);
#define PG8_SA(b, h) (((b) * 2 + (h)) * HTB)
#define PG8_SB(b, h) ((4 + (b) * 2 + (h)) * HTB)
#define PG8_STAGE(bufoff, gbase, voff) do { _Pragma("unroll") for (int _i = 0; _i < 2; ++_i) \
        __builtin_amdgcn_global_load_lds((const unsigned*)((const char*)(gbase) + (voff)[_i]), (PG8_LAS unsigned*)(lds + (bufoff) + ldsw + _i * 8192), 16, 0, 0); } while (0)
#define PG8_LDA(dst, b, h) do { _Pragma("unroll") for (int m = 0; m < 4; ++m) _Pragma("unroll") for (int k = 0; k < 2; ++k) dst[m][k] = *(const PG8_LAS bf16x8*)(lds + PG8_SA(b, h) + aoff + m * 2048 + k * 1024); } while (0)
#define PG8_LDB(dst, b, h) do { _Pragma("unroll") for (int n = 0; n < 2; ++n) _Pragma("unroll") for (int k = 0; k < 2; ++k) dst[n][k] = *(const PG8_LAS bf16x8*)(lds + PG8_SB(b, h) + boff + n * 2048 + k * 1024); } while (0)
#define PG8_MMA(ai, bj, At, Bt) do { __builtin_amdgcn_s_setprio(1); _Pragma("unroll") for (int m = 0; m < 4; ++m) _Pragma("unroll") for (int n = 0; n < 2; ++n) _Pragma("unroll") for (int k = 0; k < 2; ++k) \
        acc[ai][bj][m][n] = __builtin_amdgcn_mfma_f32_16x16x32_bf16(Bt[n][k], At[m][k], acc[ai][bj][m][n], 0, 0, 0); __builtin_amdgcn_s_setprio(0); } while (0)
#define PG8_WAIT_V(n) asm volatile("s_waitcnt vmcnt(" #n ")" ::: "memory")
#define PG8_WAIT_L(n) asm volatile("s_waitcnt lgkmcnt(" #n ")" ::: "memory")
#define PG8_BAR __builtin_amdgcn_s_barrier()
#define PG8_SCHED __builtin_amdgcn_sched_barrier(0)
    Unit cur, nxt; int ui = 0;
    if (!S.next(0, cur)) return;
    f32x4 acc[2][2][4][2];
#pragma unroll
    for (int a = 0; a < 2; ++a)
#pragma unroll
        for (int b = 0; b < 2; ++b)
#pragma unroll
            for (int m = 0; m < 4; ++m)
#pragma unroll
                for (int n = 0; n < 2; ++n) acc[a][b][m][n] = (f32x4){0.f, 0.f, 0.f, 0.f};
    bf16x8 At[4][2], B0[2][2], B1[2][2];
    const char* cA = (const char*)g.A + (size_t)cur.pm * tstep; const char* cB = (const char*)g.Bt + (size_t)cur.pn * tstep;
    S.a_ready(cur);
    if constexpr (SP2) {
        PG8_STAGE(PG8_SB(0, 0), cB, voffB); PG8_STAGE(PG8_SB(0, 1), cB + hstep, voffB); PG8_STAGE(PG8_SA(0, 0), cA, voffA); PG8_STAGE(PG8_SA(0, 1), cA + hstep, voffA);
        if (wr == 1) PG8_BAR;
        PG8_WAIT_V(2); PG8_BAR;
        PG8_STAGE(PG8_SB(1, 0), cB + kstep, voffB); PG8_STAGE(PG8_SA(1, 0), cA + kstep, voffA); PG8_STAGE(PG8_SB(1, 1), cB + hstep + kstep, voffB);
        PG8_WAIT_V(6); PG8_BAR;
    } else {
        PG8_STAGE(PG8_SB(0, 0), cB, voffB); PG8_STAGE(PG8_SA(0, 0), cA, voffA); PG8_STAGE(PG8_SB(0, 1), cB + hstep, voffB); PG8_STAGE(PG8_SA(0, 1), cA + hstep, voffA);
        if (wr == 1) PG8_BAR;
        PG8_WAIT_V(4); PG8_BAR;
        PG8_STAGE(PG8_SB(1, 0), cB + kstep, voffB); PG8_STAGE(PG8_SA(1, 0), cA + kstep, voffA); PG8_STAGE(PG8_SB(1, 1), cB + hstep + kstep, voffB);
        PG8_WAIT_V(6); PG8_BAR;
    }
    for (;;) {
        const bool has_next = S.next(ui + 1, nxt);
        const char* nA = has_next ? (const char*)g.A + (size_t)nxt.pm * tstep : cA; const char* nB = has_next ? (const char*)g.Bt + (size_t)nxt.pn * tstep : cB;
        for (int t = 0; t < nt; t += 2) {
            const bool last = (t == nt - 2);
            const char* a1 = cA + (size_t)(t + 1) * kstep;
            const char* a2 = last ? nA : cA + (size_t)(t + 2) * kstep; const char* b2 = last ? nB : cB + (size_t)(t + 2) * kstep;
            const char* a3 = a2 + kstep; const char* b3 = b2 + kstep;
            if (last && has_next) S.a_ready(nxt);
            if constexpr (SP2) {
            PG8_LDB(B0, 0, 0); PG8_LDB(B1, 0, 1); PG8_SCHED; PG8_LDA(At, 0, 0); PG8_STAGE(PG8_SA(1, 1), a1 + hstep, voffA);
            PG8_WAIT_V(8); PG8_WAIT_L(0); PG8_BAR; PG8_MMA(0, 0, At, B0); PG8_MMA(0, 1, At, B1); PG8_BAR; PG8_SCHED;
            PG8_LDA(At, 0, 1); PG8_STAGE(PG8_SB(0, 0), b2, voffB); PG8_STAGE(PG8_SB(0, 1), b2 + hstep, voffB); PG8_STAGE(PG8_SA(0, 0), a2, voffA);
            PG8_WAIT_V(8); PG8_WAIT_L(0); PG8_BAR; PG8_MMA(1, 0, At, B0); PG8_MMA(1, 1, At, B1); PG8_BAR; PG8_SCHED;
            PG8_LDB(B0, 1, 0); PG8_LDB(B1, 1, 1); PG8_SCHED; PG8_LDA(At, 1, 0); PG8_STAGE(PG8_SA(0, 1), a2 + hstep, voffA);
            PG8_WAIT_V(8); PG8_WAIT_L(0); PG8_BAR; PG8_MMA(0, 0, At, B0); PG8_MMA(0, 1, At, B1); PG8_BAR; PG8_SCHED;
            PG8_LDA(At, 1, 1); PG8_STAGE(PG8_SB(1, 0), b3, voffB); PG8_STAGE(PG8_SB(1, 1), b3 + hstep, voffB); PG8_STAGE(PG8_SA(1, 0), a3, voffA);
            PG8_WAIT_V(8); PG8_WAIT_L(0); PG8_BAR; PG8_MMA(1, 0, At, B0); PG8_MMA(1, 1, At, B1); PG8_BAR; PG8_SCHED;
            } else {
            PG8_LDB(B0, 0, 0); PG8_SCHED; PG8_LDA(At, 0, 0); PG8_STAGE(PG8_SA(1, 1), a1 + hstep, voffA);
            PG8_WAIT_L(8); PG8_BAR; PG8_WAIT_L(0); PG8_MMA(0, 0, At, B0); PG8_BAR; PG8_SCHED;
            PG8_LDB(B1, 0, 1); PG8_STAGE(PG8_SB(0, 0), b2, voffB);
            PG8_BAR; PG8_WAIT_L(0); PG8_MMA(0, 1, At, B1); PG8_BAR;
            PG8_LDA(At, 0, 1); PG8_STAGE(PG8_SA(0, 0), a2, voffA);
            PG8_BAR; PG8_WAIT_L(0); PG8_MMA(1, 0, At, B0); PG8_BAR; PG8_SCHED;
            PG8_STAGE(PG8_SB(0, 1), b2 + hstep, voffB);
            PG8_WAIT_V(6); PG8_BAR; PG8_MMA(1, 1, At, B1); PG8_BAR;
            PG8_LDB(B0, 1, 0); PG8_SCHED; PG8_LDA(At, 1, 0); PG8_STAGE(PG8_SA(0, 1), a2 + hstep, voffA);
            PG8_WAIT_L(8); PG8_BAR; PG8_WAIT_L(0); PG8_MMA(0, 0, At, B0); PG8_BAR; PG8_SCHED;
            PG8_LDB(B1, 1, 1); PG8_STAGE(PG8_SB(1, 0), b3, voffB);
            PG8_BAR; PG8_WAIT_L(0); PG8_MMA(0, 1, At, B1); PG8_BAR;
            PG8_LDA(At, 1, 1); PG8_STAGE(PG8_SA(1, 0), a3, voffA);
            PG8_BAR; PG8_WAIT_L(0); PG8_MMA(1, 0, At, B0); PG8_BAR; PG8_SCHED;
            PG8_STAGE(PG8_SB(1, 1), b3 + hstep, voffB);
            PG8_WAIT_V(6); PG8_BAR; PG8_MMA(1, 1, At, B1); PG8_BAR;
            }
        }
        if constexpr (ALIGN_EPI) { if (wr == 0) PG8_BAR; }
        if constexpr (!Epi::AFTER_DRAIN) { E(acc, cur, wr, wc, fr, fq); S.done(cur); }
        if (!has_next) break;
#pragma unroll
        for (int a = 0; a < 2; ++a)
#pragma unroll
            for (int b = 0; b < 2; ++b)
#pragma unroll
                for (int m = 0; m < 4; ++m)
#pragma unroll
                    for (int n = 0; n < 2; ++n) acc[a][b][m][n] = (f32x4){0.f, 0.f, 0.f, 0.f};
        cur = nxt; cA = nA; cB = nB; ++ui;
        if constexpr (ALIGN_EPI) { if (wr == 1) PG8_BAR; }
    }
    PG8_WAIT_V(0);
    if constexpr (!ALIGN_EPI) { if (wr == 0) PG8_BAR; }
    PG8_BAR;
    if constexpr (Epi::AFTER_DRAIN) { E.fused(acc, cur, wr, wc, fr, fq, lds, wid, lane); S.done(cur); }
#undef PG8_SA
#undef PG8_SB
#undef PG8_STAGE
#undef PG8_LDA
#undef PG8_LDB
#undef PG8_MMA
#undef PG8_WAIT_V
#undef PG8_WAIT_L
#undef PG8_BAR
#undef PG8_SCHED
}
}

constexpr int NB = 16, SEQ = 2048, DM = 1024, FF = 2816, MROWS = NB * SEQ;
constexpr int NGU = 2 * FF;
constexpr int NEV = 3584;
constexpr int NOD = 3072;
constexpr float RMS_EPS = 1e-6f;
constexpr float LOG2E = 1.4426950408889634f;
constexpr float QSCALE = 0.125f * LOG2E;

namespace epi {
using namespace pg8;
__device__ __forceinline__ unsigned pkbf(float lo, float hi) {
    typedef float f2_t __attribute__((ext_vector_type(2))); typedef __bf16 b2_t __attribute__((ext_vector_type(2)));
    f2_t v = {lo, hi}; b2_t b = __builtin_convertvector(v, b2_t); return __builtin_bit_cast(unsigned, b); }
__device__ __forceinline__ float row_rs(const float* ssq, int row) { const f32x4 p = *(const f32x4*)(ssq + (size_t)row * 4); return __builtin_amdgcn_rsqf(((p[0] + p[1]) + (p[2] + p[3])) * (1.f / DM) + RMS_EPS); }
__device__ __forceinline__ float epi_sum4fq(float s) {
    s += __int_as_float(__builtin_amdgcn_ds_swizzle(__float_as_int(s), (16 << 10) | 0x1f));
    auto rr = __builtin_amdgcn_permlane32_swap(__float_as_uint(s), __float_as_uint(s), false, false); return __uint_as_float(rr[0]) + __uint_as_float(rr[1]); }
__device__ __forceinline__ u32x4 pk8(const f32x4& a, const f32x4& b) { u32x4 w; w.x = pkbf(a[0], a[1]); w.y = pkbf(a[2], a[3]); w.z = pkbf(b[0], b[1]); w.w = pkbf(b[2], b[3]); return w; }

template <int PVAR = 0>
struct EpiSwiGLUT {
    static constexpr bool PERM = true, AFTER_DRAIN = false;
    bf16_t* H; const PG8_LAS float* tab;
    __device__ __forceinline__ void operator()(const f32x4 (&acc)[2][2][4][2], const Unit& u, int wr, int wc, int fr, int fq) const {
        typedef float f32x2 __attribute__((ext_vector_type(2)));
        const int row0 = u.pm * BM + wr * 64 + fr, col0 = u.pn * 128 + wc * 32 + 8 * fq;
        float v8[2][4];
#pragma unroll
        for (int ai = 0; ai < 2; ++ai)
#pragma unroll
            for (int m = 0; m < 4; ++m) v8[ai][m] = tab[u.idx * 256 + ai * HALF + wr * 64 + m * 16 + fr];
#pragma unroll
        for (int ai = 0; ai < 2; ++ai)
#pragma unroll
            for (int m = 0; m < 4; ++m) {
                const int row = row0 + ai * HALF + m * 16; const float v = v8[ai][m]; const float sp = -LOG2E * __builtin_amdgcn_rsqf(v);
                f32x4 h[2];
#pragma unroll
                for (int n = 0; n < 2; ++n)
#pragma unroll
                    for (int pr = 0; pr < 2; ++pr) { const f32x2 g2 = {acc[ai][0][m][n][2 * pr], acc[ai][0][m][n][2 * pr + 1]}, u2 = {acc[ai][1][m][n][2 * pr], acc[ai][1][m][n][2 * pr + 1]};
                        const f32x2 t2 = g2 * sp; f32x2 e2; e2.x = __builtin_amdgcn_exp2f(t2.x); e2.y = __builtin_amdgcn_exp2f(t2.y);
                        const f32x2 d2 = e2 * v + v; f32x2 r2; r2.x = __builtin_amdgcn_rcpf(d2.x); r2.y = __builtin_amdgcn_rcpf(d2.y);
                        const f32x2 h2 = (g2 * u2) * r2; h[n][2 * pr] = h2.x; h[n][2 * pr + 1] = h2.y; }
                if (PVAR == 1) { const u32x4 w_ = pk8(h[0], h[1]); asm volatile("" :: "v"(w_)); } else *(u32x4*)(H + (size_t)row * FF + col0) = pk8(h[0], h[1]);
            }
    }
};
typedef EpiSwiGLUT<0> EpiSwiGLU;
struct EpiNull {
    static constexpr bool PERM = true, AFTER_DRAIN = false;
    __device__ __forceinline__ void operator()(const f32x4 (&acc)[2][2][4][2], const Unit& u, int wr, int wc, int fr, int fq) const {
#pragma unroll
        for (int ai = 0; ai < 2; ++ai)
#pragma unroll
            for (int bj = 0; bj < 2; ++bj)
#pragma unroll
                for (int m = 0; m < 4; ++m)
#pragma unroll
                    for (int n = 0; n < 2; ++n) asm volatile("" :: "v"(acc[ai][bj][m][n]));
    }
};
struct EpiBf16Y {
    static constexpr bool PERM = true, AFTER_DRAIN = false;
    bf16_t* Y;
    __device__ __forceinline__ void operator()(const f32x4 (&acc)[2][2][4][2], const Unit& u, int wr, int wc, int fr, int fq) const {
        const int row0 = u.pm * BM + wr * 64 + fr, col0 = u.pn * BM + wc * 32 + 8 * fq;
#pragma unroll
        for (int ai = 0; ai < 2; ++ai)
#pragma unroll
            for (int m = 0; m < 4; ++m) { bf16_t* rowp = Y + (size_t)(row0 + ai * HALF + m * 16) * DM + col0;
#pragma unroll
                for (int bj = 0; bj < 2; ++bj) *(u32x4*)(rowp + bj * HALF) = pk8(acc[ai][bj][m][0], acc[ai][bj][m][1]); }
    }
};
template <bool LAST, int PVAR = 0>
struct EpiRmsRes {
    static constexpr bool PERM = true, AFTER_DRAIN = false;
    bf16_t* X; float* outf; const float* ga; float alpha; unsigned long long* gran; unsigned epoch; float* ssq2; unsigned* tmo; PG8_LAS unsigned char* xl;
    __device__ __forceinline__ void operator()(const f32x4 (&acc)[2][2][4][2], const Unit& u, int wr, int wc, int fr, int fq) const {
        int tid_ = threadIdx.x; asm volatile("" : "+v"(tid_)); const int wid = __builtin_amdgcn_readfirstlane(tid_ >> 6), lane = tid_ & 63;
        PG8_LAS float* P = (PG8_LAS float*)xl;
        PG8_LAS float* S = (PG8_LAS float*)(xl + 4096);
        const int col0 = u.pn * BM + wc * 32 + 8 * fq;
        u32x4 xw8[4][2];
#pragma unroll
        for (int m = 0; m < 4; ++m)
#pragma unroll
            for (int bj = 0; bj < 2; ++bj) xw8[m][bj] = *(const u32x4*)(X + (size_t)(u.pm * BM + wr * 64 + m * 16 + fr) * DM + col0 + bj * HALF);
#pragma unroll
        for (int ai = 0; ai < 2; ++ai)
#pragma unroll
            for (int m = 0; m < 4; ++m) { float s = 0.f;
#pragma unroll
                for (int bj = 0; bj < 2; ++bj)
#pragma unroll
                    for (int n = 0; n < 2; ++n) { const f32x4 v = acc[ai][bj][m][n]; s += (v[0] * v[0] + v[1] * v[1]) + (v[2] * v[2] + v[3] * v[3]); }
                s = epi_sum4fq(s);
                if (fq == 0) P[(ai * HALF + wr * 64 + m * 16 + fr) * 4 + wc] = s; }
        asm volatile("s_waitcnt lgkmcnt(0)" ::: "memory"); __builtin_amdgcn_s_barrier(); asm volatile("" ::: "memory");
        const int row = wid * 32 + (lane & 31);
        if (lane < 32) {
            const f32x4 p = *(const PG8_LAS f32x4*)(P + row * 4); const float mine = (p[0] + p[1]) + (p[2] + p[3]);
            unsigned long long* gr = gran + ((size_t)(u.pm * BM + row)) * 4;
            __hip_atomic_store(gr + u.pn, ((unsigned long long)epoch << 32) | (unsigned long long)__float_as_uint(mine), __ATOMIC_RELAXED, __HIP_MEMORY_SCOPE_AGENT);
            float t = 0.f; bool ok = false;
            for (unsigned spins = 0; spins < ((PVAR & 1) ? 0u : (1u << 18)); ++spins) {
                unsigned long long w[4]; bool all4 = true; t = 0.f;
#pragma unroll
                for (int k = 0; k < 4; ++k) { w[k] = __hip_atomic_load(gr + k, __ATOMIC_RELAXED, __HIP_MEMORY_SCOPE_AGENT); all4 = all4 && ((unsigned)(w[k] >> 32) == epoch); t += __uint_as_float((unsigned)w[k]); }
                if (__all(all4)) { ok = true; break; }
                __builtin_amdgcn_s_sleep(1);
            }
            if (PVAR & 1) { ok = true; t = 4.f * mine; }
            if (!ok && lane == 0) __hip_atomic_store(tmo, 1u, __ATOMIC_RELAXED, __HIP_MEMORY_SCOPE_AGENT);
            S[row] = alpha * __builtin_amdgcn_rsqf(t * (1.f / DM) + RMS_EPS);
        }
        asm volatile("s_waitcnt lgkmcnt(0)" ::: "memory"); __builtin_amdgcn_s_barrier(); asm volatile("" ::: "memory");
        if (PVAR & 2) return;
        f32x4 g[2][2];
#pragma unroll
        for (int bj = 0; bj < 2; ++bj)
#pragma unroll
            for (int n = 0; n < 2; ++n) g[bj][n] = *(const f32x4*)(ga + col0 + bj * HALF + 4 * n);
#pragma unroll
        for (int ai = 0; ai < 2; ++ai) {
            if (ai == 1) {
#pragma unroll
                for (int m = 0; m < 4; ++m)
#pragma unroll
                    for (int bj = 0; bj < 2; ++bj) xw8[m][bj] = *(const u32x4*)(X + (size_t)(u.pm * BM + HALF + wr * 64 + m * 16 + fr) * DM + col0 + bj * HALF);
            }
#pragma unroll
            for (int m = 0; m < 4; ++m) { const int rl = ai * HALF + wr * 64 + m * 16 + fr; const size_t off = (size_t)(u.pm * BM + rl) * DM + col0; const float sr = S[rl]; float q = 0.f;
#pragma unroll
                for (int bj = 0; bj < 2; ++bj) { const u32x4 xw = xw8[m][bj]; f32x4 xn[2];
#pragma unroll
                    for (int n = 0; n < 2; ++n) { const f32x4 xo = {__uint_as_float(xw[2 * n] << 16), __uint_as_float(xw[2 * n] & 0xffff0000u), __uint_as_float(xw[2 * n + 1] << 16), __uint_as_float(xw[2 * n + 1] & 0xffff0000u)};
                        xn[n] = xo + acc[ai][bj][m][n] * sr * g[bj][n]; q += (xn[n][0] * xn[n][0] + xn[n][1] * xn[n][1]) + (xn[n][2] * xn[n][2] + xn[n][3] * xn[n][3]); }
                    if (LAST) { *(f32x4*)(outf + off + bj * HALF) = xn[0]; *(f32x4*)(outf + off + bj * HALF + 4) = xn[1]; }
                    else *(u32x4*)(X + off + bj * HALF) = pk8(xn[0], xn[1]); }
                if (!LAST) { q = epi_sum4fq(q); if (fq == 0) P[rl * 4 + wc] = q; } } }
        if (!LAST) {
            asm volatile("s_waitcnt lgkmcnt(0)" ::: "memory"); __builtin_amdgcn_s_barrier(); asm volatile("" ::: "memory");
            if (lane < 32) { const f32x4 p = *(const PG8_LAS f32x4*)(P + row * 4); ssq2[((size_t)(u.pm * BM + row)) * 4 + u.pn] = (p[0] + p[1]) + (p[2] + p[3]); }
        }
    }
};
struct OrdOrder {
    StaticOrder base;
    __device__ __forceinline__ bool next(int i, Unit& u) const { const bool ok = base.next(i, u); u.idx = i; return ok; }
    __device__ __forceinline__ void a_ready(const Unit&) const {}
    __device__ __forceinline__ void done(const Unit&) const {}
};
__device__ __forceinline__ void rowstat_table(const OrdOrder& S, const float* ssq, PG8_LAS float* tab, int nunits) {
    int tid = threadIdx.x; asm volatile("" : "+v"(tid));
    for (int e = tid; e < nunits * 256; e += 512) { Unit u; S.next(e >> 8, u); const f32x4 p = *(const f32x4*)(ssq + (size_t)(u.pm * BM + (e & 255)) * 4); tab[e] = ((p[0] + p[1]) + (p[2] + p[3])) * (1.f / DM) + RMS_EPS; }
    __syncthreads();
}
struct HotOrder {
    int n, c;
    __device__ __forceinline__ bool next(int i, Unit& u) const { if (i >= n) return false; u.pm = c & 7; u.pn = (c >> 3) & 3; return true; }
    __device__ __forceinline__ void a_ready(const Unit&) const {}
    __device__ __forceinline__ void done(const Unit&) const {}
};
struct OneRound {
    StaticOrder base; int round;
    __device__ __forceinline__ bool next(int i, Unit& u) const { return i == 0 && base.next(round, u); }
    __device__ __forceinline__ void a_ready(const Unit&) const {}
    __device__ __forceinline__ void done(const Unit&) const {}
};
struct EpiF32 {
    static constexpr bool PERM = false, AFTER_DRAIN = false;
    float* Y; int ldc;
    __device__ __forceinline__ void operator()(const f32x4 (&acc)[2][2][4][2], const Unit& u, int wr, int wc, int fr, int fq) const {
        const int row0 = u.pm * BM + wr * 64 + fr, col0 = u.pn * BM + wc * 32 + 4 * fq;
#pragma unroll
        for (int ai = 0; ai < 2; ++ai)
#pragma unroll
            for (int m = 0; m < 4; ++m) { float* rowp = Y + (size_t)(row0 + ai * HALF + m * 16) * ldc + col0;
#pragma unroll
                for (int bj = 0; bj < 2; ++bj)
#pragma unroll
                    for (int n = 0; n < 2; ++n) *(f32x4*)(rowp + bj * HALF + n * 16) = acc[ai][bj][m][n]; }
    }
};
struct EpiProjOdd {
    static constexpr bool PERM = true, AFTER_DRAIN = false;
    bf16_t* Q; const PG8_LAS float* tab;
    __device__ __forceinline__ void operator()(const f32x4 (&acc)[2][2][4][2], const Unit& u, int wr, int wc, int fr, int fq) const {
        const int t = u.pn >> 2; bf16_t* base = Q + (size_t)t * ((size_t)MROWS * DM); const float sc = t == 0 ? QSCALE : 1.f;
        const int row0 = u.pm * BM + wr * 64 + fr, col0 = (u.pn & 3) * BM + wc * 32 + 8 * fq;
        float sc8[2][4];
#pragma unroll
        for (int ai = 0; ai < 2; ++ai)
#pragma unroll
            for (int m = 0; m < 4; ++m) sc8[ai][m] = __builtin_amdgcn_rsqf(tab[u.idx * 256 + ai * HALF + wr * 64 + m * 16 + fr]);
#pragma unroll
        for (int ai = 0; ai < 2; ++ai)
#pragma unroll
            for (int m = 0; m < 4; ++m) { const int row = row0 + ai * HALF + m * 16; const float s = sc8[ai][m] * sc;
#pragma unroll
                for (int bj = 0; bj < 2; ++bj) *(u32x4*)(base + (size_t)row * DM + col0 + bj * HALF) = pk8(acc[ai][bj][m][0] * s, acc[ai][bj][m][1] * s); }
    }
};
struct EpiProjEven {
    static constexpr bool PERM = true, AFTER_DRAIN = false;
    bf16_t *R1, *IQ, *IK; float* IW; const PG8_LAS float* tab;
    const float *c64, *s64, *c32, *s32;
    __device__ __forceinline__ void operator()(const f32x4 (&acc)[2][2][4][2], const Unit& u, int wr, int wc, int fr, int fq) const {
        const int pn = u.pn, row0 = u.pm * BM + wr * 64 + fr;
        float sc8[2][4];
#pragma unroll
        for (int ai = 0; ai < 2; ++ai)
#pragma unroll
            for (int m = 0; m < 4; ++m) sc8[ai][m] = __builtin_amdgcn_rsqf(tab[u.idx * 256 + ai * HALF + wr * 64 + m * 16 + fr]);
        if (pn == 4 || pn == 5 || pn == 10 || pn == 11) {
            bf16_t* base = R1 + (size_t)(pn >> 1) * ((size_t)MROWS * 512); const int col0 = (pn & 1) * BM + wc * 32 + 8 * fq;
#pragma unroll
            for (int ai = 0; ai < 2; ++ai)
#pragma unroll
                for (int m = 0; m < 4; ++m) { const int row = row0 + ai * HALF + m * 16; const float s = sc8[ai][m];
#pragma unroll
                    for (int bj = 0; bj < 2; ++bj) *(u32x4*)(base + (size_t)row * 512 + col0 + bj * HALF) = pk8(acc[ai][bj][m][0] * s, acc[ai][bj][m][1] * s); }
        } else if (pn < 12) {
            bf16_t* base = R1 + (size_t)(pn >> 1) * ((size_t)MROWS * 512);
            const float sc = (pn < 2 || pn == 6 || pn == 7) ? QSCALE : 1.f;
            const int head = 4 * (pn & 1) + wc, d0 = 8 * fq;
#pragma unroll
            for (int aim = 0; aim < 4; ++aim) { const int ai = aim >> 1;
                f32x4 ct[2][2], st[2][2];
#pragma unroll
                for (int mm = 0; mm < 2; ++mm) { const int pos = (row0 + ai * HALF + (2 * (aim & 1) + mm) * 16) & (SEQ - 1);
#pragma unroll
                    for (int n = 0; n < 2; ++n) { ct[mm][n] = *(const f32x4*)(c64 + pos * 32 + d0 + 4 * n); st[mm][n] = *(const f32x4*)(s64 + pos * 32 + d0 + 4 * n); } }
#pragma unroll
                for (int mm = 0; mm < 2; ++mm) { const int m = 2 * (aim & 1) + mm; const int row = row0 + ai * HALF + m * 16; const float s = sc8[ai][m] * sc;
                    f32x4 o1[2], o2[2];
#pragma unroll
                    for (int n = 0; n < 2; ++n) { const f32x4 cc = ct[mm][n], ss = st[mm][n];
                        const f32x4 x1 = acc[ai][0][m][n] * s, x2 = acc[ai][1][m][n] * s; o1[n] = x1 * cc - x2 * ss; o2[n] = x2 * cc + x1 * ss; }
                    bf16_t* dst = base + (size_t)row * 512 + head * 64 + d0;
                    *(u32x4*)dst = pk8(o1[0], o1[1]); *(u32x4*)(dst + 32) = pk8(o2[0], o2[1]); } }
        } else if (pn == 12) {
            const int head = 2 * wc + (fq >> 1), d0 = 8 * (fq & 1);
#pragma unroll
            for (int ai = 0; ai < 2; ++ai)
#pragma unroll
                for (int m = 0; m < 4; ++m) { const int row = row0 + ai * HALF + m * 16, pos = row & (SEQ - 1); const float s = sc8[ai][m];
                    f32x4 o1[2], o2[2];
#pragma unroll
                    for (int n = 0; n < 2; ++n) { const f32x4 cc = *(const f32x4*)(c32 + pos * 16 + d0 + 4 * n), ss = *(const f32x4*)(s32 + pos * 16 + d0 + 4 * n);
                        const f32x4 x1 = acc[ai][0][m][n] * s, x2 = acc[ai][1][m][n] * s; o1[n] = x1 * cc - x2 * ss; o2[n] = x2 * cc + x1 * ss; }
                    bf16_t* dst = IQ + (size_t)row * 256 + head * 32 + d0;
                    *(u32x4*)dst = pk8(o1[0], o1[1]); *(u32x4*)(dst + 16) = pk8(o2[0], o2[1]); }
        } else {
            if (wc == 0 && fq < 2) {
                const int d0 = 8 * fq;
#pragma unroll
                for (int ai = 0; ai < 2; ++ai)
#pragma unroll
                    for (int m = 0; m < 4; ++m) { const int row = row0 + ai * HALF + m * 16, pos = row & (SEQ - 1); const float s = sc8[ai][m];
                        f32x4 o1[2], o2[2];
#pragma unroll
                        for (int n = 0; n < 2; ++n) { const f32x4 cc = *(const f32x4*)(c32 + pos * 16 + d0 + 4 * n), ss = *(const f32x4*)(s32 + pos * 16 + d0 + 4 * n);
                            const f32x4 x1 = acc[ai][0][m][n] * s, x2 = acc[ai][1][m][n] * s; o1[n] = x1 * cc - x2 * ss; o2[n] = x2 * cc + x1 * ss; }
                        bf16_t* dst = IK + (size_t)row * 32 + d0;
                        *(u32x4*)dst = pk8(o1[0], o1[1]); *(u32x4*)(dst + 16) = pk8(o2[0], o2[1]); }
            } else if (wc == 0 && fq == 2) {
#pragma unroll
                for (int ai = 0; ai < 2; ++ai)
#pragma unroll
                    for (int m = 0; m < 4; ++m) { const int row = row0 + ai * HALF + m * 16; const float s = sc8[ai][m] * 0.0625f;
                        *(f32x4*)(IW + (size_t)row * 8) = acc[ai][0][m][0] * s; *(f32x4*)(IW + (size_t)row * 8 + 4) = acc[ai][0][m][1] * s; }
            }
        }
    }
};
}

namespace att {
#define ALAS __attribute__((address_space(3)))
typedef unsigned short bf16_t;
typedef short bf16x8 __attribute__((ext_vector_type(8)));
typedef short s16x4 __attribute__((ext_vector_type(4)));
typedef float f32x16 __attribute__((ext_vector_type(16)));
typedef float f32x4 __attribute__((ext_vector_type(4)));
typedef unsigned u32x4 __attribute__((ext_vector_type(4)));
typedef short v4i16_t __attribute__((ext_vector_type(4)));
__device__ __forceinline__ int crow(int r, int hi) { return (r & 3) + 8 * (r >> 2) + 4 * hi; }
__device__ __forceinline__ unsigned cvtpk(float lo, float hi) { typedef float f2_t __attribute__((ext_vector_type(2))); typedef __bf16 b2_t __attribute__((ext_vector_type(2)));
    f2_t v = {lo, hi}; b2_t b = __builtin_convertvector(v, b2_t); return __builtin_bit_cast(unsigned, b); }
__device__ __forceinline__ s16x4 vtr(const ALAS unsigned char* p) { return __builtin_bit_cast(s16x4, __builtin_amdgcn_ds_read_tr16_b64_v4i16((ALAS v4i16_t*)p)); }
__device__ __forceinline__ float halfswap_max(float m) { auto rr = __builtin_amdgcn_permlane32_swap(__float_as_uint(m), __float_as_uint(m), false, false); return fmaxf(__uint_as_float(rr[0]), __uint_as_float(rr[1])); }
__device__ __forceinline__ float halfswap_sum(float m) { auto rr = __builtin_amdgcn_permlane32_swap(__float_as_uint(m), __float_as_uint(m), false, false); return __uint_as_float(rr[0]) + __uint_as_float(rr[1]); }

template <int DV> struct Lds {
#ifndef ATT_QLDS128
#define ATT_QLDS128 0
#endif
#ifndef ATT_R64
#define ATT_R64 4
#endif
    static constexpr int R = (DV == 64) ? ATT_R64 : 3, D = R - 1;
    static constexpr int KB = 8192, VB = DV * 128;
    static constexpr int OFF_K = 0, OFF_V = R * KB, OFF_MW = OFF_V + R * VB, OFF_WSF = OFF_MW + 8 * R * 256, OFF_BT = OFF_WSF + 8 * 256, OFF_OST = OFF_BT + 3072, OST_W = 4096, TOTAL = OFF_OST + 8 * OST_W;
};
__device__ __forceinline__ void glds16(const void* gsrc, unsigned lds_dst) { unsigned keep;
    asm volatile("s_mov_b32 %0, m0\n\ts_mov_b32 m0, %2\n\ts_nop 0\n\tglobal_load_lds_dwordx4 %1, off\n\ts_mov_b32 m0, %0" : "=&s"(keep) : "v"(gsrc), "s"(lds_dst) : "memory"); }
__device__ __forceinline__ void glds4(const void* gsrc, unsigned lds_dst) { unsigned keep;
    asm volatile("s_mov_b32 %0, m0\n\ts_mov_b32 m0, %2\n\ts_nop 0\n\tglobal_load_lds_dword %1, off\n\ts_mov_b32 m0, %0" : "=&s"(keep) : "v"(gsrc), "s"(lds_dst) : "memory"); }

template <int DV, int MODE, int THR>
__device__ __forceinline__ void attn_core(f32x16 (&o)[DV / 32], ALAS unsigned char* lds,
                                          const bf16_t* Qw, int ldq, const bf16_t* Kh, int ldk, const bf16_t* Vh, int ldv,
                                          int T0, int T1, int tw0, int tw1,
                                          const unsigned long long* maskrow, int qpos, int qchunk, int att_probe_hotmask = -1, int att_probe_skip = 0,
                                          const bf16_t* nKh = nullptr, const bf16_t* nVh = nullptr, const unsigned long long* nmask = nullptr, int nT0 = 0, int nT1 = 0, int pre_in = 0, int* pre_out = nullptr) {
    typedef Lds<DV> L; constexpr int NDB = DV / 32, NVP = DV / 64, R = L::R, D = L::D, NDMA = 1 + NVP + (MODE == 1 ? 1 : 0);
    int tid = threadIdx.x; asm volatile("" : "+v"(tid));
    const int lane = tid & 63, r32 = lane & 31, hi = lane >> 5; const int wid = __builtin_amdgcn_readfirstlane(tid >> 6);
    ALAS float* wsf = (ALAS float*)(lds + L::OFF_WSF) + wid * 64;
    const ALAS float* btab = (const ALAS float*)(lds + L::OFF_BT);
    constexpr bool QLDS = (DV == 128 && ATT_QLDS128);
    ALAS unsigned char* qst = lds + L::OFF_OST + wid * L::OST_W + lane * 16;
    bf16x8 qr[4];
#pragma unroll
    for (int d0 = 0; d0 < 4; ++d0) { qr[d0] = *(const bf16x8*)(Qw + (size_t)r32 * ldq + d0 * 16 + hi * 8); if (QLDS) *(ALAS bf16x8*)(qst + d0 * 1024) = qr[d0]; }
    const int krow = 8 * wid + (lane >> 3), kkey = krow ^ ((krow >> 3) & 1), kch = (lane & 7) ^ (kkey & 7);
    const bf16_t* ksrc = Kh + (size_t)kkey * ldk + kch * 8;
    const bf16_t* vsrc = Vh + (size_t)(16 * (wid & 3) + (lane >> 2)) * ldv + 32 * (wid >> 2) + 8 * (lane & 3);
    const unsigned* msrc = (const unsigned*)maskrow + hi;
    const unsigned lds0 = (unsigned)(__SIZE_TYPE__)lds;
    const unsigned kdst = lds0 + L::OFF_K + wid * 1024, vdst = lds0 + L::OFF_V + (wid >> 2) * 4096 + (wid & 3) * 1024, mdstb = lds0 + L::OFF_MW + wid * (R * 256);
    ALAS unsigned char* mdst = lds + L::OFF_MW + wid * (R * 256);
#define ATT_U(x) ((unsigned)__builtin_amdgcn_readfirstlane((int)(x)))
#define ATT_TT(t) (T0 + (((t) - T0) & att_probe_hotmask))
#define ATT_DMA_K(t, sl) glds16(ksrc + (size_t)ATT_TT(t) * 64 * ldk, ATT_U(kdst + (sl) * L::KB))
#define ATT_DMA_V(t, sl) do { glds16(vsrc + (size_t)ATT_TT(t) * 64 * ldv, ATT_U(vdst + (sl) * L::VB)); if (NVP == 2) glds16(vsrc + (size_t)ATT_TT(t) * 64 * ldv + 64, ATT_U(vdst + (sl) * L::VB + 8192)); \
                              if (MODE == 1) glds4(msrc + 2 * (t), ATT_U(mdstb + (sl) * 256)); } while (0)
    int kfo[4];
#pragma unroll
    for (int d0 = 0; d0 < 4; ++d0) kfo[d0] = (r32 ^ ((r32 >> 3) & 1)) * 128 + (((2 * d0 + hi) ^ (r32 & 7)) * 16);
#define ATT_QK(P0, P1, t, ks) do { \
        if (MODE == 2) { const int jrel_ = qchunk - (t); \
            if (jrel_ >= 5) { const float bc_ = btab[638]; _Pragma("unroll") for (int r = 0; r < 16; ++r) { P0[r] = bc_; P1[r] = bc_; } } \
            else { const ALAS float* bp_ = btab + (qpos - 64 * (t) + 63 - 4 * hi - 59); \
                _Pragma("unroll") for (int r = 0; r < 16; ++r) { P0[r] = bp_[59 - crow(r, 0)]; P1[r] = bp_[59 - 32 - crow(r, 0)]; } } \
        } else { P0 = f32x16{}; P1 = f32x16{}; } \
        const ALAS unsigned char* kb_ = lds + L::OFF_K + (ks) * L::KB; \
        _Pragma("unroll") for (int d0 = 0; d0 < 4; ++d0) { const bf16x8 b0_ = *(const ALAS bf16x8*)(kb_ + kfo[d0]), b1_ = *(const ALAS bf16x8*)(kb_ + kfo[d0] + 4096); \
            const bf16x8 q_ = QLDS ? *(const ALAS bf16x8*)(qst + d0 * 1024) : qr[d0]; \
            P0 = __builtin_amdgcn_mfma_f32_32x32x16_bf16(b0_, q_, P0, 0, 0, 0); P1 = __builtin_amdgcn_mfma_f32_32x32x16_bf16(b1_, q_, P1, 0, 0, 0); } } while (0)
#define ATT_QK_INIT(P0, P1, t) do { \
        if (MODE == 2) { const int jrel_ = qchunk - (t); \
            if (jrel_ >= 5) { const float bc_ = btab[638]; _Pragma("unroll") for (int r = 0; r < 16; ++r) { P0[r] = bc_; P1[r] = bc_; } } \
            else { const ALAS float* bp_ = btab + (qpos - 64 * (t) + 63 - 4 * hi - 59); \
                _Pragma("unroll") for (int r = 0; r < 16; ++r) { P0[r] = bp_[59 - crow(r, 0)]; P1[r] = bp_[59 - 32 - crow(r, 0)]; } } \
        } else { P0 = f32x16{}; P1 = f32x16{}; } } while (0)
#define ATT_QK_HALF(P0, P1, kb_, dlo) do { \
        _Pragma("unroll") for (int d0 = (dlo); d0 < (dlo) + 2; ++d0) { const bf16x8 b0_ = *(const ALAS bf16x8*)((kb_) + kfo[d0]), b1_ = *(const ALAS bf16x8*)((kb_) + kfo[d0] + 4096); \
            const bf16x8 q_ = QLDS ? *(const ALAS bf16x8*)(qst + d0 * 1024) : qr[d0]; \
            P0 = __builtin_amdgcn_mfma_f32_32x32x16_bf16(b0_, q_, P0, 0, 0, 0); P1 = __builtin_amdgcn_mfma_f32_32x32x16_bf16(b1_, q_, P1, 0, 0, 0); } } while (0)
    constexpr int NV = NDMA - 1;
#define ATT_CK(j) (((j) <= T0 + D) ? ((j) - T0) * NDMA + 1 : ((j) - 1 - T0) * NDMA + 2)
#define ATT_CV(j) (((j) < T0 + D) ? ((j) - T0 + 1) * NDMA : ((j) - T0) * NDMA + 2 + NV)
#define ATT_WAIT_BAR_N(n_) do { const int nn_ = (n_); \
        if (nn_ <= 0) asm volatile("s_waitcnt vmcnt(0) lgkmcnt(0)\n\ts_barrier" ::: "memory"); \
        else if (nn_ == 1) asm volatile("s_waitcnt vmcnt(1) lgkmcnt(0)\n\ts_barrier" ::: "memory"); \
        else if (nn_ == 2) asm volatile("s_waitcnt vmcnt(2) lgkmcnt(0)\n\ts_barrier" ::: "memory"); \
        else if (nn_ == 3) asm volatile("s_waitcnt vmcnt(3) lgkmcnt(0)\n\ts_barrier" ::: "memory"); \
        else if (nn_ == 4) asm volatile("s_waitcnt vmcnt(4) lgkmcnt(0)\n\ts_barrier" ::: "memory"); \
        else if (nn_ == 5) asm volatile("s_waitcnt vmcnt(5) lgkmcnt(0)\n\ts_barrier" ::: "memory"); \
        else if (nn_ == 6) asm volatile("s_waitcnt vmcnt(6) lgkmcnt(0)\n\ts_barrier" ::: "memory"); \
        else if (nn_ == 7) asm volatile("s_waitcnt vmcnt(7) lgkmcnt(0)\n\ts_barrier" ::: "memory"); \
        else if (nn_ == 8) asm volatile("s_waitcnt vmcnt(8) lgkmcnt(0)\n\ts_barrier" ::: "memory"); \
        else if (nn_ == 9) asm volatile("s_waitcnt vmcnt(9) lgkmcnt(0)\n\ts_barrier" ::: "memory"); \
        else if (nn_ == 10) asm volatile("s_waitcnt vmcnt(10) lgkmcnt(0)\n\ts_barrier" ::: "memory"); \
        else if (nn_ == 11) asm volatile("s_waitcnt vmcnt(11) lgkmcnt(0)\n\ts_barrier" ::: "memory"); \
        else asm volatile("s_waitcnt vmcnt(12) lgkmcnt(0)\n\ts_barrier" ::: "memory"); } while (0)
#define ATT_END_STEP(t) do { int need_ = 0; if ((t) + 2 < T1) need_ = ATT_CK((t) + 2); if ((t) + 1 < T1) { const int cv_ = ATT_CV((t) + 1); need_ = cv_ > need_ ? cv_ : need_; } \
        ATT_WAIT_BAR_N(need_ ? n_issued - need_ : 0); } while (0)
    int n_issued = 0;
    float m_run = -1e30f, l_part = 0.f;
#pragma unroll
    for (int d0 = 0; d0 < NDB; ++d0) o[d0] = f32x16{};
    if (pre_in > 0) n_issued = pre_in;
    else {
#pragma unroll
        for (int i = 0; i <= D; ++i) { if (T0 + i < T1) { ATT_DMA_K(T0 + i, i); n_issued += 1; } if (i < D && T0 + i < T1) { ATT_DMA_V(T0 + i, i); n_issued += NV; } }
    }
    ATT_WAIT_BAR_N(n_issued - 1);
    f32x16 pc0, pc1, pn0, pn1;
    pc0 = f32x16{}; pc1 = f32x16{}; pn0 = f32x16{}; pn1 = f32x16{};
    if (tw0 == T0) { ATT_QK(pc0, pc1, T0, 0); }
    ATT_END_STEP(T0 - 1);
    int sk = 1 % R, sv = 0, si_k = 0, si_v = D % R;
    for (int t = T0; t < T1; ++t) {
        const bool steady = (t + 1 + D < T1);
        if (steady) { ATT_DMA_K(t + 1 + D, si_k); n_issued += 1; }
        if (t + D < T1) { ATT_DMA_V(t + D, si_v); n_issued += NV; }
        const bool act = (t >= tw0 && t < tw1), nxt = (t + 1 >= tw0 && t + 1 < tw1);
        if (nxt && !act) { ATT_QK(pn0, pn1, t + 1, sk); }
        if (act) {
            const ALAS unsigned char* kbn_ = lds + L::OFF_K + sk * L::KB;
            if (nxt) { ATT_QK_INIT(pn0, pn1, t + 1); ATT_QK_HALF(pn0, pn1, kbn_, 0); }
            if (MODE == 1) { const ALAS unsigned* mp = (const ALAS unsigned*)(mdst + sv * 256); const unsigned w0 = mp[r32] >> (4 * hi), w1 = mp[32 + r32] >> (4 * hi);
#pragma unroll
                for (int r = 0; r < 16; ++r) { const int sh = 31 - ((r & 3) + 8 * (r >> 2));
                    const unsigned m0 = (unsigned)(((int)(w0 << sh)) >> 31), m1 = (unsigned)(((int)(w1 << sh)) >> 31);
                    pc0[r] = __uint_as_float((__float_as_uint(pc0[r]) & m0) | (0xff800000u & ~m0)); pc1[r] = __uint_as_float((__float_as_uint(pc1[r]) & m1) | (0xff800000u & ~m1)); } }
            float mx = fmaxf(fmaxf(pc0[0], pc1[0]), pc0[1]);
#pragma unroll
            for (int r = 1; r < 16; ++r) mx = (r == 1) ? fmaxf(mx, pc1[1]) : fmaxf(fmaxf(mx, pc0[r]), pc1[r]);
            mx = halfswap_max(mx);
            if (__any(mx > m_run + (float)THR)) {
                const float mnew = fmaxf(m_run, mx); const float f = __builtin_amdgcn_exp2f(m_run - mnew);
                l_part *= f; m_run = mnew; if (hi == 0) wsf[r32] = f;
#pragma unroll
                for (int r = 0; r < 16; ++r) { const float fr_ = wsf[crow(r, hi)];
#pragma unroll
                    for (int d0 = 0; d0 < NDB; ++d0) o[d0][r] *= fr_; }
            }
            if (nxt) { ATT_QK_HALF(pn0, pn1, kbn_, 2); }
            float sa = 0.f, sb = 0.f;
#pragma unroll
            for (int r = 0; r < 16; ++r) { pc0[r] = __builtin_amdgcn_exp2f(pc0[r] - m_run); pc1[r] = __builtin_amdgcn_exp2f(pc1[r] - m_run); sa += pc0[r]; sb += pc1[r]; }
            l_part += sa + sb;
            u32x4 pw[4];
#pragma unroll
            for (int k = 0; k < 2; ++k)
#pragma unroll
                for (int j = 0; j < 4; ++j) { pw[k][j] = cvtpk(pc0[8 * k + 2 * j], pc0[8 * k + 2 * j + 1]); pw[2 + k][j] = cvtpk(pc1[8 * k + 2 * j], pc1[8 * k + 2 * j + 1]); }
            const ALAS unsigned char* vb = lds + L::OFF_V + sv * L::VB + ((lane >> 4) & 1) * 32 + (lane & 3) * 8 + (4 * hi + ((lane & 15) >> 2)) * 64;
#pragma unroll
            for (int d0 = 0; d0 < NDB; ++d0)
#pragma unroll
                for (int ks = 0; ks < 4; ++ks) { const s16x4 lo = vtr(vb + d0 * 4096 + ks * 1024), up = vtr(vb + d0 * 4096 + ks * 1024 + 512);
                    const bf16x8 vf = (bf16x8){lo[0], lo[1], lo[2], lo[3], up[0], up[1], up[2], up[3]};
                    o[d0] = __builtin_amdgcn_mfma_f32_32x32x16_bf16(__builtin_bit_cast(bf16x8, pw[ks]), vf, o[d0], 0, 0, 0); }
        }
        pc0 = pn0; pc1 = pn1;
        sk = (sk + 1 == R) ? 0 : sk + 1; sv = (sv + 1 == R) ? 0 : sv + 1; si_k = (si_k + 1 == R) ? 0 : si_k + 1; si_v = (si_v + 1 == R) ? 0 : si_v + 1;
        ATT_END_STEP(t);
    }
    if (pre_out) {
        int cnt_ = 0;
        if (nT1 > nT0) {
            const bf16_t* ksrc0_ = ksrc; const bf16_t* vsrc0_ = vsrc; const unsigned* msrc0_ = msrc;
            ksrc = ksrc0_ + (nKh - Kh); vsrc = vsrc0_ + (nVh - Vh); msrc = (const unsigned*)nmask + hi;
            { const int T0 = nT0, T1 = nT1;
#pragma unroll
              for (int i = 0; i <= D; ++i) { if (T0 + i < T1) { ATT_DMA_K(T0 + i, i); cnt_ += 1; } if (i < D && T0 + i < T1) { ATT_DMA_V(T0 + i, i); cnt_ += NV; } } }
            ksrc = ksrc0_; vsrc = vsrc0_; msrc = msrc0_;
        }
        *pre_out = cnt_;
    }
#undef ATT_U
#undef ATT_TT
#undef ATT_DMA_K
#undef ATT_DMA_V
#undef ATT_QK
#undef ATT_QK_INIT
#undef ATT_QK_HALF
#undef ATT_CK
#undef ATT_CV
#undef ATT_WAIT_BAR_N
#undef ATT_END_STEP
    const float l = halfswap_sum(l_part);
    if (hi == 0) wsf[32 + r32] = l;
#pragma unroll
    for (int r = 0; r < 16; ++r) { const float rl = 1.0f / wsf[32 + crow(r, hi)];
#pragma unroll
        for (int d0 = 0; d0 < NDB; ++d0) o[d0][r] *= rl; }
}

template <int DV>
__device__ __forceinline__ void store_o(const f32x16 (&o)[DV / 32], ALAS unsigned char* lds, bf16_t* dst, int ldo) {
    typedef Lds<DV> L;
    int tid = threadIdx.x; asm volatile("" : "+v"(tid));
    const int lane = tid & 63, r32 = lane & 31, hi = lane >> 5; const int wid = __builtin_amdgcn_readfirstlane(tid >> 6);
    ALAS bf16_t* stg = (ALAS bf16_t*)(lds + L::OFF_OST + wid * L::OST_W);
#pragma unroll
    for (int h = 0; h < DV / 64; ++h) {
#pragma unroll
        for (int r = 0; r < 16; ++r) { const int orow = crow(r, hi);
#pragma unroll
            for (int d0 = 0; d0 < 2; ++d0) stg[orow * 64 + d0 * 32 + r32] = (bf16_t)(cvtpk(o[2 * h + d0][r], 0.f) & 0xffffu); }
#pragma unroll
        for (int i = 0; i < 4; ++i) { const int row = i * 8 + (lane >> 3), ch = lane & 7; const u32x4 v = *(const ALAS u32x4*)(stg + row * 64 + ch * 8); *(u32x4*)(dst + (size_t)row * ldo + h * 64 + ch * 8) = v; }
    }
}
}
#define GAS __attribute__((address_space(1)))
#define LAS __attribute__((address_space(3)))
typedef unsigned short bf16;
typedef unsigned v4u __attribute__((ext_vector_type(4)));
typedef float f32x4 __attribute__((ext_vector_type(4)));
typedef short bf16x8 __attribute__((ext_vector_type(8)));
typedef GAS unsigned gu32;
typedef GAS unsigned long long gu64;
#define RLX_AGENT __ATOMIC_RELAXED, __HIP_MEMORY_SCOPE_AGENT
#define LDS_WAIT() asm volatile("s_waitcnt lgkmcnt(0)" ::: "memory")
#define VM_WAIT() asm volatile("s_waitcnt vmcnt(0)" ::: "memory")
__device__ __forceinline__ unsigned long long rt() { return __builtin_amdgcn_s_memrealtime(); }
__device__ __forceinline__ unsigned f2bf(float f) { unsigned u = __builtin_bit_cast(unsigned, f); return (u + 0x7fffu + ((u >> 16) & 1u)) >> 16; }
__device__ __forceinline__ unsigned pk2(float lo, float hi) { return f2bf(lo) | (f2bf(hi) << 16); }

#define XB_TMO      128
#define XB_XCNT(j)  (256  + 64 * (j))
#define XB_XSUB(j)  (1280 + 64 * (j))
#define XB_XGEN(j)  (2304 + 64 * (j))
#define XB_TOP      3328
#define XB_TOPGEN   3392
#define XCD_BAR_WORDS 3456
#define XB_SPIN_CAP (1u << 18)

__device__ __forceinline__ unsigned xb_ld(unsigned* p)              { return __hip_atomic_load(p, __ATOMIC_RELAXED, __HIP_MEMORY_SCOPE_AGENT); }
__device__ __forceinline__ unsigned xb_add(unsigned* p, unsigned v) { return __hip_atomic_fetch_add(p, v, __ATOMIC_RELAXED, __HIP_MEMORY_SCOPE_AGENT); }
__device__ __forceinline__ unsigned xb_xcc_id() { return (unsigned)__builtin_amdgcn_s_getreg((3 << 11) | 20) & 0xFu; }
#define XB_SPIN(cond, bar) do { unsigned _sp = 0; while (cond) { __builtin_amdgcn_s_sleep(1); \
    if ((++_sp & 255u) == 0u) { if (xb_ld(&(bar)[XB_TMO])) break; if (_sp > XB_SPIN_CAP) { atomicAdd(&(bar)[XB_TMO], 1u); break; } } } } while (0)

struct XcdBarrier {
    unsigned* bar; unsigned x;
    volatile LAS unsigned* st;
};

__device__ __forceinline__ XcdBarrier xcd_barrier_post(unsigned* bar, volatile LAS unsigned* st) {
    XcdBarrier b; b.bar = bar; b.x = xb_xcc_id(); b.st = st;
    if (threadIdx.x == 0) (void)xb_add(&bar[XB_XCNT(b.x)], 1u);
    return b;
}
__device__ __forceinline__ void xcd_barrier_complete(unsigned* bar, unsigned x, unsigned& nloc, unsigned& nx) {
    const unsigned G = gridDim.x * gridDim.y * gridDim.z;
    unsigned sum, cnt, mine, sp = 0u;
    for (;;) {
        sum = 0u; cnt = 0u; mine = 0u;
#pragma unroll
        for (unsigned j = 0; j < 16; ++j) { const unsigned c = xb_ld(&bar[XB_XCNT(j)]); sum += c; cnt += (c > 0u) ? 1u : 0u; mine = (j == x) ? c : mine; }
        if (sum == G) break;
        __builtin_amdgcn_s_sleep(1);
        if ((++sp & 255u) == 0u) { if (xb_ld(&bar[XB_TMO])) break; if (sp > XB_SPIN_CAP) { atomicAdd(&bar[XB_TMO], 1u); break; } }
    }
    nloc = mine > 0u ? mine : 1u; nx = cnt > 0u ? cnt : 1u;
}

__device__ __forceinline__ void xcd_barrier(const XcdBarrier& b) {
    asm volatile("s_waitcnt vmcnt(0)" ::: "memory");
    __syncthreads();
    if (threadIdx.x == 0) {
        unsigned* bar = b.bar;
        __builtin_amdgcn_s_waitcnt(0);
        unsigned nloc = b.st[0], nx = b.st[1];
        if (nloc == 0u) { xcd_barrier_complete(bar, b.x, nloc, nx); b.st[0] = nloc; b.st[1] = nx; }
        const unsigned old = xb_add(&bar[XB_XSUB(b.x)], 1u);
        const unsigned gen = old / nloc;
        if (old + 1u == (gen + 1u) * nloc) {
            __builtin_amdgcn_fence(__ATOMIC_RELEASE, "agent");
            asm volatile("s_waitcnt vmcnt(0)" ::: "memory");
            const unsigned og = xb_add(&bar[XB_TOP], 1u);
            const unsigned tg = og / nx;
            if (og + 1u == (tg + 1u) * nx) xb_add(&bar[XB_TOPGEN], 1u);
            else XB_SPIN(xb_ld(&bar[XB_TOPGEN]) == tg, bar);
            __builtin_amdgcn_fence(__ATOMIC_ACQUIRE, "agent");
            xb_add(&bar[XB_XGEN(b.x)], 1u);
            asm volatile("s_waitcnt vmcnt(0)" ::: "memory");
        } else {
            XB_SPIN(xb_ld(&bar[XB_XGEN(b.x)]) == gen, bar);
            __builtin_amdgcn_fence(__ATOMIC_ACQUIRE, "agent");
            asm volatile("s_waitcnt vmcnt(0)" ::: "memory");
        }
    }
    __syncthreads();
}

constexpr int NWAVES = 8;
constexpr size_t MiB = 1u << 20;
constexpr size_t WS_CTL = 0, CTL_ZERO_BYTES = 2 * MiB;
constexpr size_t WS_GRAN = 1 * MiB;
constexpr size_t WS_C64 = 381 * MiB + 42 * MiB, WS_S64 = WS_C64 + 256 * 1024, WS_C32 = WS_C64 + 512 * 1024, WS_S32 = WS_C64 + 640 * 1024, WS_RS = WS_C64 + 768 * 1024;
constexpr size_t WS_WGU = 2 * MiB, WGU_BYTES = (size_t)NGU * DM * 2;
constexpr size_t WS_WD = 46 * MiB, WD_BYTES = (size_t)DM * FF * 2;
constexpr size_t WS_WIN0 = 68 * MiB, WS_WOUT0 = 75 * MiB, WS_WIN1 = 77 * MiB, WS_WOUT1 = 83 * MiB;
constexpr size_t WS_MASK = 85 * MiB;
constexpr size_t WS_XB = 93 * MiB;
constexpr size_t WS_R1 = 157 * MiB;
constexpr size_t WS_Y = 381 * MiB;
constexpr size_t WS_SSQ1 = WS_Y + 40 * MiB, WS_SSQ2 = WS_Y + 41 * MiB;
constexpr size_t WS_ATT = 445 * MiB;
constexpr size_t WS_END = 509 * MiB;
static_assert(WS_WGU + 4 * WGU_BYTES <= WS_WD && WS_WD + 4 * WD_BYTES <= WS_WIN0 && WS_WIN0 + (size_t)NEV * DM * 2 <= WS_WOUT0 && WS_WIN1 + (size_t)NOD * DM * 2 <= WS_WOUT1, "weight map");
static_assert(WS_R1 + (size_t)MROWS * FF * 2 <= WS_Y && WS_R1 + 211 * MiB <= WS_Y, "R1 map");
constexpr int CW_BAR = 4096, CW_TMO = 0, CW_SEAM = 16384, SEAM_BANK = 128 * 64;
constexpr int FUSED_LDS_OFF = 131072 + 1024;
constexpr int RING_BYTES = 131072, LDSCTL_OFF = RING_BYTES, MISC_OFF = LDSCTL_OFF + 320, LDS_BYTES = 147456;

struct Frame {
    LAS unsigned char* lds; volatile LAS unsigned* MISC; gu32* ctl;
    int tid, lane, wave, vcu, G;
};

template <int X> __device__ __forceinline__ float swz_xor(float v) { return __int_as_float(__builtin_amdgcn_ds_swizzle(__float_as_int(v), (X << 10) | 0x1f)); }
__device__ __forceinline__ float sum32(float v) { v += swz_xor<1>(v); v += swz_xor<2>(v); v += swz_xor<4>(v); v += swz_xor<8>(v); v += swz_xor<16>(v); return v; }
__device__ __forceinline__ float wave_sum(float v) { return att::halfswap_sum(sum32(v)); }
struct MapGUHalf { int bj; __device__ __forceinline__ int src(int R) const { return R; } __device__ __forceinline__ int dst(int R) const { return 256 * (R >> 7) + 128 * bj + (R & 127); } };
struct MapId { __device__ __forceinline__ int src(int R) const { return R; } __device__ __forceinline__ int dst(int R) const { return R; } };
__device__ __forceinline__ int even_src(int R) {
    const int pn = R >> 8, bj = (R >> 7) & 1, jj = R & 127;
    if (pn < 4) return (pn < 2 ? 0 : 512) + (4 * (pn & 1) + (jj >> 5)) * 64 + 32 * bj + (jj & 31);
    if (pn < 6) return 1024 + 256 * (pn - 4) + 128 * bj + jj;
    if (pn < 10) return (pn < 8 ? 1536 : 2048) + (4 * (pn & 1) + (jj >> 5)) * 64 + 32 * bj + (jj & 31);
    if (pn < 12) return 2560 + 256 * (pn - 10) + 128 * bj + jj;
    if (pn == 12) return 3072 + (jj >> 4) * 32 + 16 * bj + (jj & 15);
    if (jj < 16) return 3328 + 16 * bj + jj;
    if (bj == 0 && jj < 24) return 3360 + (jj - 16);
    return -1;
}
struct MapEven { __device__ __forceinline__ int src(int R) const { return even_src(R); } __device__ __forceinline__ int dst(int R) const { return R; } };
template <class Map>
__device__ __forceinline__ void transpose_item(const Map& mp, const float* W, int ldw, int K, int nrows, bf16* WT, const float* g, LAS float* scr, int item, int lane) {
    const int nblk = nrows / 32, kb = item / nblk, nb = item % nblk, k0 = 64 * kb, n0 = 32 * nb;
    const int nl = 4 * (lane & 7), kl = lane >> 3;
    const int sc0 = mp.src(n0 + nl); const float mul = sc0 >= 0 ? 1.f : 0.f; const float* src = W + (sc0 >= 0 ? sc0 : 0) + (size_t)(k0 + kl) * ldw;
    f32x4 v[8];
#pragma unroll
    for (int i = 0; i < 8; ++i) v[i] = *(const GAS f32x4*)(src + (size_t)(8 * i) * ldw);
#pragma unroll
    for (int i = 0; i < 8; ++i) { const int kk = 8 * i + kl; const float gm = g ? g[k0 + kk] * mul : mul;
        scr[kk * 33 + nl] = v[i].x * gm; scr[kk * 33 + nl + 1] = v[i].y * gm; scr[kk * 33 + nl + 2] = v[i].z * gm; scr[kk * 33 + nl + 3] = v[i].w * gm; }
    LDS_WAIT(); asm volatile("" ::: "memory");
    const int c = lane & 7;
#pragma unroll
    for (int j = 0; j < 4; ++j) { const int n = (lane >> 3) + 8 * j; const LAS float* s = scr + (8 * c) * 33 + n;
        v4u o; o.x = pk2(s[0 * 33], s[1 * 33]); o.y = pk2(s[2 * 33], s[3 * 33]); o.z = pk2(s[4 * 33], s[5 * 33]); o.w = pk2(s[6 * 33], s[7 * 33]);
        *(GAS v4u*)(WT + (size_t)mp.dst(n0 + n) * K + k0 + 8 * c) = o; }
    LDS_WAIT(); asm volatile("" ::: "memory");
}
__device__ __forceinline__ void sincos_d(double a, float& sn, float& cs) {
    const double k = __builtin_rint(a * 0.6366197723675814); const double y = a - k * 1.5707963267948966; const double y2 = y * y;
    const double s = y * (1.0 + y2 * (-1.0 / 6 + y2 * (1.0 / 120 + y2 * (-1.0 / 5040 + y2 * (1.0 / 362880 + y2 * (-1.0 / 39916800 + y2 * (1.0 / 6227020800.0)))))));
    const double c = 1.0 + y2 * (-0.5 + y2 * (1.0 / 24 + y2 * (-1.0 / 720 + y2 * (1.0 / 40320 + y2 * (-1.0 / 3628800 + y2 * (1.0 / 479001600.0 + y2 * (-1.0 / 87178291200.0)))))));
    const int q = (int)((long long)k & 3);
    const double ss = (q == 0) ? s : (q == 1) ? c : (q == 2) ? -s : -c, cc = (q == 0) ? c : (q == 1) ? -s : (q == 2) ? -c : s;
    sn = (float)ss; cs = (float)cc;
}
__device__ __forceinline__ void x_to_bf16_rows4(const float* x, bf16* xb, float* ssq, int m, int dm, int lane) {
    f32x4 v[4][4]; float s[4];
#pragma unroll
    for (int r = 0; r < 4; ++r) { const GAS f32x4* xr = (const GAS f32x4*)(x + (size_t)(m + r * dm) * DM) + lane;
#pragma unroll
        for (int j = 0; j < 4; ++j) v[r][j] = xr[64 * j]; }
#pragma unroll
    for (int r = 0; r < 4; ++r) { s[r] = 0.f; GAS unsigned long long* o8 = (GAS unsigned long long*)(xb + (size_t)(m + r * dm) * DM) + lane;
#pragma unroll
        for (int j = 0; j < 4; ++j) { s[r] += (v[r][j].x * v[r][j].x + v[r][j].y * v[r][j].y) + (v[r][j].z * v[r][j].z + v[r][j].w * v[r][j].w);
            o8[64 * j] = (unsigned long long)epi::pkbf(v[r][j].x, v[r][j].y) | ((unsigned long long)epi::pkbf(v[r][j].z, v[r][j].w) << 32); } }
#pragma unroll
    for (int r = 0; r < 4; ++r) s[r] = sum32(s[r]);
#pragma unroll
    for (int r = 0; r < 4; ++r) { const float t = att::halfswap_sum(s[r]); if (lane == 0) *(f32x4*)(ssq + (size_t)(m + r * dm) * 4) = (f32x4){t, 0.f, 0.f, 0.f}; }
}
__device__ __forceinline__ void bf8_to_f32(const v4u& w, float (&f)[8]) {
#pragma unroll
    for (int i = 0; i < 4; ++i) { f[2 * i] = __uint_as_float(w[i] << 16); f[2 * i + 1] = __uint_as_float(w[i] & 0xffff0000u); } }
template <bool LAST>
__device__ __forceinline__ void thin_row(const bf16* yrow, bf16* xrow, float* outf, const float* ga, float alpha, float* rs, int lane) {
    float y[2][8], x[2][8]; float s = 0.f;
#pragma unroll
    for (int j = 0; j < 2; ++j) { const v4u yw = *((const GAS v4u*)yrow + lane + 64 * j), xw = *((const GAS v4u*)xrow + lane + 64 * j); bf8_to_f32(yw, y[j]); bf8_to_f32(xw, x[j]);
#pragma unroll
        for (int i = 0; i < 8; ++i) s += y[j][i] * y[j][i]; }
    const float r1 = alpha / sqrtf(wave_sum(s) * (1.f / DM) + RMS_EPS); float s2 = 0.f;
#pragma unroll
    for (int j = 0; j < 2; ++j) { const f32x4 g0 = *((const GAS f32x4*)ga + 2 * lane + 128 * j), g1 = *((const GAS f32x4*)ga + 2 * lane + 128 * j + 1);
#pragma unroll
        for (int i = 0; i < 8; ++i) { const float g = i < 4 ? g0[i & 3] : g1[i & 3]; x[j][i] += y[j][i] * g * r1; s2 += x[j][i] * x[j][i]; }
        if (LAST) { *((GAS f32x4*)outf + 2 * lane + 128 * j) = (f32x4){x[j][0], x[j][1], x[j][2], x[j][3]}; *((GAS f32x4*)outf + 2 * lane + 128 * j + 1) = (f32x4){x[j][4], x[j][5], x[j][6], x[j][7]}; }
        else { v4u o; o.x = epi::pkbf(x[j][0], x[j][1]); o.y = epi::pkbf(x[j][2], x[j][3]); o.z = epi::pkbf(x[j][4], x[j][5]); o.w = epi::pkbf(x[j][6], x[j][7]); *((GAS v4u*)xrow + lane + 64 * j) = o; } }
    if (!LAST) { const float r2 = 1.0f / sqrtf(wave_sum(s2) * (1.f / DM) + RMS_EPS); if (lane == 0) *rs = r2; }
}

struct Ptrs {
    const float *x, *norm_g, *wg, *wu, *wd, *ewin, *ewout, *elam, *esub, *owin, *owout, *obias; float* out; unsigned char* ws;
};

__device__ __forceinline__ void p0_prologue(Frame& F0, const Ptrs& P) {
    struct { LAS unsigned char* lds; int tid, lane, wave, vcu, G; } F;
    { int t = threadIdx.x; asm volatile("" : "+v"(t)); F.lds = F0.lds; F.tid = t; F.lane = t & 63; F.wave = __builtin_amdgcn_readfirstlane(t >> 6); F.vcu = F0.vcu; F.G = F0.G; }
    LAS float* scr = (LAS float*)(F.lds + F.wave * 16384);
    const int gw = F.vcu * NWAVES + F.wave, NGW = F.G * NWAVES;
    constexpr int I_GH = (DM / 64) * (FF / 32), I_WD = (FF / 64) * (DM / 32), I_E = (DM / 64) * (NEV / 32), I_O = (DM / 64) * (DM / 32), I_OD = (DM / 64) * (NOD / 32);
    constexpr int NITEMS = 8 * I_GH + 4 * I_WD + I_E + I_O + I_OD + I_O;
    for (int it = gw; it < NITEMS; it += NGW) {
        int r = it;
        if (r < 8 * I_GH) { const int i8 = r / I_GH; r -= i8 * I_GH; const int i = i8 >> 1, bj = i8 & 1, l = i >> 1, f = i & 1;
            MapGUHalf mp{bj}; const float* W = (bj ? P.wu : P.wg) + (size_t)i * DM * FF;
            transpose_item(mp, W, FF, DM, FF, (bf16*)(P.ws + WS_WGU + i * WGU_BYTES), P.norm_g + (l * 6 + 4 * f) * DM, scr, r, F.lane); continue; }
        r -= 8 * I_GH;
        if (r < 4 * I_WD) { const int i = r / I_WD; r -= i * I_WD; MapId mp;
            transpose_item(mp, P.wd + (size_t)i * FF * DM, DM, FF, DM, (bf16*)(P.ws + WS_WD + i * WD_BYTES), nullptr, scr, r, F.lane); continue; }
        r -= 4 * I_WD;
        if (r < I_E) { MapEven mp; transpose_item(mp, P.ewin, 3368, DM, NEV, (bf16*)(P.ws + WS_WIN0), P.norm_g + (0 * 6 + 2) * DM, scr, r, F.lane); continue; }
        r -= I_E;
        if (r < I_O) { MapId mp; transpose_item(mp, P.ewout, DM, DM, DM, (bf16*)(P.ws + WS_WOUT0), nullptr, scr, r, F.lane); continue; }
        r -= I_O;
        if (r < I_OD) { MapId mp; transpose_item(mp, P.owin, NOD, DM, NOD, (bf16*)(P.ws + WS_WIN1), P.norm_g + (1 * 6 + 2) * DM, scr, r, F.lane); continue; }
        r -= I_OD;
        { MapId mp; transpose_item(mp, P.owout, DM, DM, DM, (bf16*)(P.ws + WS_WOUT1), nullptr, scr, r, F.lane); }
    }
    float* c64 = (float*)(P.ws + WS_C64); float* s64 = (float*)(P.ws + WS_S64); float* c32 = (float*)(P.ws + WS_C32); float* s32 = (float*)(P.ws + WS_S32);
    const int gt = F.vcu * (NWAVES * 64) + F.tid, NGT = F.G * NWAVES * 64;
    for (int e = gt; e < SEQ * 48; e += NGT) {
        const bool is64 = e < SEQ * 32; const int ee = is64 ? e : e - SEQ * 32; const int pos = is64 ? (ee >> 5) : (ee >> 4), i = is64 ? (ee & 31) : (ee & 15);
        const double rb = is64 ? 0.7498942093324559 : 0.5623413251903492; double inv = 1.0; for (int k = 0; k < i; ++k) inv *= rb;
        const float ang = (float)pos * (float)inv; float sn, cs; sincos_d((double)ang, sn, cs);
        if (is64) { c64[ee] = cs; s64[ee] = sn; } else { c32[ee] = cs; s32[ee] = sn; }
    }
    bf16* XB = (bf16*)(P.ws + WS_XB); float* SSQ2 = (float*)(P.ws + WS_SSQ2);
    for (int m = gw; m < MROWS; m += 4 * NGW) x_to_bf16_rows4(P.x, XB, SSQ2, m, NGW, F.lane);
}
#ifndef PROBE_REP_IDXA
#define PROBE_REP_IDXA 1
#endif
#ifndef PROBE_REP_B
#define PROBE_REP_B 1
#endif
#ifndef PROBE_REP_C
#define PROBE_REP_C 1
#endif
#ifndef PROBE_REP_GU
#define PROBE_REP_GU 1
#endif
#ifndef PROBE_REP_DN
#define PROBE_REP_DN 1
#endif
#ifndef PROBE_NULL_GU
#define PROBE_NULL_GU 0
#endif
#ifndef PROBE_NULL_DN
#define PROBE_NULL_DN 0
#endif
#ifndef PROBE_REP_IDX
#define PROBE_REP_IDX 1
#endif
#ifndef PROBE_B_SKIP
#define PROBE_B_SKIP 0
#endif
#ifndef PROBE_B_HOT
#define PROBE_B_HOT 0
#endif
#ifndef PROBE_CLK
#define PROBE_CLK 0
#endif
#ifndef PROBE_HOT_GU
#define PROBE_HOT_GU 0
#endif
#ifndef PROBE_NOST_GU
#define PROBE_NOST_GU 0
#endif
#ifndef PROBE_FUSED_VAR
#define PROBE_FUSED_VAR 0
#endif
#ifndef PROBE_FUSED_DN
#define PROBE_FUSED_DN 0
#endif
#ifndef PROBE_REP_THIN
#define PROBE_REP_THIN 1
#endif
template <bool LAST>
__device__ __forceinline__ void thin_phase(Frame& F, const Ptrs& P, const float* ga, float alpha) {
    int t_ = threadIdx.x; asm volatile("" : "+v"(t_)); const int lane_ = t_ & 63, wave_ = __builtin_amdgcn_readfirstlane(t_ >> 6);
    const int gw = F.vcu * NWAVES + wave_, NGW = F.G * NWAVES;
    const bf16* Y = (const bf16*)(P.ws + WS_Y); bf16* XB = (bf16*)(P.ws + WS_XB); float* RS = (float*)(P.ws + WS_RS);
    for (int m = gw; m < MROWS; m += NGW) thin_row<LAST>(Y + (size_t)m * DM, XB + (size_t)m * DM, P.out + (size_t)m * DM, ga, alpha, RS + m, lane_);
}

__device__ __forceinline__ int wave_sum_i(int x) {
    x += __builtin_amdgcn_update_dpp(0, x, 0x111, 0xf, 0xf, true);
    x += __builtin_amdgcn_update_dpp(0, x, 0x112, 0xf, 0xf, true);
    x += __builtin_amdgcn_update_dpp(0, x, 0x114, 0xf, 0xf, true);
    x += __builtin_amdgcn_update_dpp(0, x, 0x118, 0xf, 0xf, true);
    return __builtin_amdgcn_readlane(x, 15) + __builtin_amdgcn_readlane(x, 31) + __builtin_amdgcn_readlane(x, 47) + __builtin_amdgcn_readlane(x, 63);
}
__device__ __forceinline__ void select_row(const unsigned (&u)[32], unsigned T, int cT, LAS unsigned long long* mw, int lane) {
    if (cT == 256) {
#pragma unroll
        for (int i = 0; i < 32; ++i) { const unsigned long long w = __ballot(u[i] >= T); if (lane == 0) mw[i] = w; }
    } else {
        int cgt = 0;
#pragma unroll
        for (int i = 0; i < 32; ++i) cgt += __popcll(__ballot(u[i] > T));
        const int need = 256 - cgt; int base = 0; unsigned T2 = T; asm volatile("" : "+s"(T2));
#pragma unroll
        for (int i = 0; i < 32; ++i) {
            const bool eq = (u[i] == T2), gt = (u[i] > T2); const unsigned long long em = __ballot(eq);
            const int rank = (int)__builtin_amdgcn_mbcnt_hi((unsigned)(em >> 32), __builtin_amdgcn_mbcnt_lo((unsigned)em, (unsigned)base));
            const unsigned long long w = __ballot(gt || (eq && rank < need)); base += __popcll(em);
            if (lane == 0) mw[i] = w;
        }
    }
}
template <int VAR>
__device__ __forceinline__ void indexer_unit(Frame& F, const Ptrs& P, int b, int blk) {
    typedef short bf16x8v __attribute__((ext_vector_type(8)));
    int tid = threadIdx.x; asm volatile("" : "+v"(tid));
    const int q0 = blk * 16, qc = q0 >> 6, n64 = qc + 1, nvis = n64 * 64; const int lane = tid & 63, wid = __builtin_amdgcn_readfirstlane(tid >> 6);
    unsigned long long* mrow = (unsigned long long*)(P.ws + WS_MASK) + ((size_t)(b * SEQ + q0)) * 32;
    if (n64 <= 4) {
        for (int i = tid; i < 16 * 32; i += NWAVES * 64) { const int w = i & 31; if (w < n64) mrow[i] = ~0ull; }
        return;
    }
    const bf16* IQ = (const bf16*)(P.ws + WS_R1 + 192 * MiB); const bf16* IK = (const bf16*)(P.ws + WS_R1 + 208 * MiB); const float* IW = (const float*)(P.ws + WS_R1 + 210 * MiB);
    LAS float* sc = (LAS float*)F.lds;
    if (!(VAR & 1)) {
        const int q = lane & 15, kg = lane >> 4; const size_t qrow = (size_t)(b * SEQ + q0 + q);
        bf16x8v iq[8]; float wi[8];
#pragma unroll
        for (int h = 0; h < 8; ++h) { iq[h] = *(const bf16x8v*)(IQ + qrow * 256 + h * 32 + 8 * kg); wi[h] = IW[qrow * 8 + h]; }
        const int nt = (nvis / 16 - wid + NWAVES - 1) / NWAVES;
        const bf16* ikp = IK + ((size_t)(b * SEQ + wid * 16 + q)) * 32 + 8 * kg;
        bf16x8v af[16];
#pragma unroll
        for (int i = 0; i < 16; ++i) if (i < nt) af[i] = *(const bf16x8v*)(ikp + (size_t)i * (NWAVES * 16 * 32));
#pragma unroll
        for (int i = 0; i < 16; ++i) if (i < nt) {
            f32x4 acc = {0.f, 0.f, 0.f, 0.f};
#pragma unroll
            for (int h = 0; h < 8; ++h) { const f32x4 c = __builtin_amdgcn_mfma_f32_16x16x32_bf16(af[i], iq[h], (f32x4){0.f, 0.f, 0.f, 0.f}, 0, 0, 0);
#pragma unroll
                for (int j = 0; j < 4; ++j) acc[j] += wi[h] * fmaxf(c[j], 0.f); }
            const int col = ((wid + NWAVES * i) * 16 + kg * 4 + 4 * q) & 2047;
            *(LAS f32x4*)(sc + q * 2048 + col) = acc;
        }
    }
    __syncthreads();
    if (VAR != 7) {
        int n64l = n64; asm volatile("" : "+s"(n64l));
        unsigned ua[32], ub[32];
        { const int qa = 2 * wid, qb = 2 * wid + 1; const LAS float* ra = sc + qa * 2048; const LAS float* rb = sc + qb * 2048;
#pragma unroll
          for (int i = 0; i < 32; ++i) { const int e = i * 64 + lane;
              const unsigned ba = __float_as_uint(ra[(e + 4 * qa) & 2047]), bb = __float_as_uint(rb[(e + 4 * qb) & 2047]);
              const unsigned ka = (ba & 0x80000000u) ? ~ba : (ba | 0x80000000u), kb = (bb & 0x80000000u) ? ~bb : (bb | 0x80000000u);
              ua[i] = (i < n64l) ? ka : 0u; ub[i] = (i < n64l) ? kb : 0u; } }
        unsigned Ta = 0u, Tb = 0u; int cTa = nvis, cTb = nvis; bool da = false, db = false;
#pragma unroll 1
        for (int bit = (VAR & 2) ? -1 : 31; bit >= 0; --bit) {
            const unsigned ca = Ta | (1u << bit), cb = Tb | (1u << bit); int xa = 0, xb = 0;
#pragma unroll
            for (int g = 0; g < 4; ++g) if (n64l > 8 * g) {
#pragma unroll
                for (int i = 8 * g; i < 8 * g + 8; ++i) { xa += (ua[i] >= ca) ? 1 : 0; xb += (ub[i] >= cb) ? 1 : 0; } }
            const int na = wave_sum_i(xa), nb = wave_sum_i(xb);
            if (!da && na >= 256) { Ta = ca; cTa = na; if (na == 256) da = true; }
            if (!db && nb >= 256) { Tb = cb; cTb = nb; if (nb == 256) db = true; }
            if (da && db) break;
        }
        if (!(VAR & 4)) {
            LAS unsigned long long* stg = (LAS unsigned long long*)(sc + (2 * wid) * 2048);
            select_row(ua, (unsigned)__builtin_amdgcn_readfirstlane((int)Ta), __builtin_amdgcn_readfirstlane(cTa), stg, lane);
            select_row(ub, (unsigned)__builtin_amdgcn_readfirstlane((int)Tb), __builtin_amdgcn_readfirstlane(cTb), stg + 32, lane);
            mrow[(2 * wid) * 32 + lane] = stg[lane];
        }
    }
    __syncthreads();
}

__device__ __forceinline__ void a_unit(Frame& F, const Ptrs& P, int b, int h, int qb, float lam) {
    using namespace att; typedef Lds<128> L;
    const bf16_t* AQ = (const bf16_t*)(P.ws + WS_R1); const bf16_t* AK = (const bf16_t*)(P.ws + WS_R1 + 32 * MiB); const bf16_t* AV = (const bf16_t*)(P.ws + WS_R1 + 64 * MiB);
    int tid = threadIdx.x; asm volatile("" : "+v"(tid));
    const int lane = tid & 63, wid = __builtin_amdgcn_readfirstlane(tid >> 6), r32 = lane & 31; const size_t rowbase = (size_t)b * SEQ; const int q0 = qb * 256, qw = q0 + wid * 32, qc = qw >> 6;
    f32x4* stash = (f32x4*)(P.ws + WS_Y) + ((size_t)(blockIdx.x * NWAVES + wid) * 16) * 64 + lane;
    f32x16 o[4];
#pragma unroll 1
    for (int c = 0; c < 2; ++c) {
        const int g = 2 * h + c;
        attn_core<128, 0, 4>(o, F.lds, AQ + (rowbase + qw) * 512 + g * 64, 512, AK + rowbase * 512 + g * 64, 512, AV + rowbase * 512 + h * 128, 512, 0, (q0 >> 6) + 4, 0, qc + 1, nullptr, 0, 0);
        if (c == 0) {
            f32x4* sp = stash; asm volatile("" : "+v"(sp));
#pragma unroll
            for (int d0 = 0; d0 < 4; ++d0)
#pragma unroll
                for (int rq = 0; rq < 4; ++rq) sp[(d0 * 4 + rq) * 64] = (f32x4){o[d0][4 * rq], o[d0][4 * rq + 1], o[d0][4 * rq + 2], o[d0][4 * rq + 3]};
        }
    }
    {
        const f32x4* sp = stash; asm volatile("" : "+v"(sp));
#pragma unroll
        for (int d0 = 0; d0 < 4; ++d0)
#pragma unroll
            for (int rq = 0; rq < 4; ++rq) { const f32x4 a = sp[(d0 * 4 + rq) * 64];
#pragma unroll
                for (int j = 0; j < 4; ++j) o[d0][4 * rq + j] = a[j] - lam * o[d0][4 * rq + j]; }
    }
    float sl[4];
#pragma unroll
    for (int d0 = 0; d0 < 4; ++d0) sl[d0] = P.esub[32 * d0 + r32] * 0.8f;
#pragma unroll
    for (int r = 0; r < 16; ++r) { float s = 0.f;
#pragma unroll
        for (int d0 = 0; d0 < 4; ++d0) s += o[d0][r] * o[d0][r];
        s = sum32(s);
        const float rstd = 1.0f / sqrtf(s * (1.f / 128.f) + RMS_EPS);
#pragma unroll
        for (int d0 = 0; d0 < 4; ++d0) o[d0][r] *= rstd * sl[d0]; }
    store_o<128>(o, F.lds, (bf16_t*)(P.ws + WS_ATT) + (rowbase + qw) * DM + h * 128, DM);
}
__device__ __forceinline__ void b_unit(Frame& F, const Ptrs& P, int b, int h, int qb, int hotmask, int skip, bool has_next, int nb, int nh, int nqb, int& pre) {
    using namespace att;
    const bf16_t* BQ = (const bf16_t*)(P.ws + WS_R1 + 96 * MiB); const bf16_t* BK = (const bf16_t*)(P.ws + WS_R1 + 128 * MiB); const bf16_t* BV = (const bf16_t*)(P.ws + WS_R1 + 160 * MiB);
    int tid = threadIdx.x; asm volatile("" : "+v"(tid));
    const int lane = tid & 63, wid = __builtin_amdgcn_readfirstlane(tid >> 6), r32 = lane & 31; const size_t rowbase = (size_t)b * SEQ; const int q0 = qb * 256, qw = q0 + wid * 32, qc = qw >> 6;
    const unsigned long long* mbase = (const unsigned long long*)(P.ws + WS_MASK);
    const unsigned long long* mrow = mbase + (rowbase + qw + r32) * 32;
    const size_t nrowbase = (size_t)nb * SEQ; const int nqw = nqb * 256 + wid * 32;
    f32x16 o[2]; int pre_out = 0;
    attn_core<64, 1, 4>(o, F.lds, BQ + (rowbase + qw) * 512 + h * 64, 512, BK + rowbase * 512 + h * 64, 512, BV + rowbase * 512 + h * 64, 512, 0, (q0 >> 6) + 4, 0, qc + 1, mrow, 0, 0, hotmask, skip,
                        BK + nrowbase * 512 + nh * 64, BV + nrowbase * 512 + nh * 64, mbase + (nrowbase + nqw + r32) * 32, 0, has_next ? (nqb * 4 + 4) : 0, pre, &pre_out);
    pre = pre_out;
    store_o<64>(o, F.lds, (bf16_t*)(P.ws + WS_ATT) + (rowbase + qw) * DM + 512 + h * 64, DM);
}
__device__ __forceinline__ void c_unit(Frame& F, const Ptrs& P, int b, int h, int qb, bool has_next, int& pre) {
    using namespace att; typedef Lds<64> L;
    const bf16_t* CQ = (const bf16_t*)(P.ws + WS_R1); const bf16_t* CK = (const bf16_t*)(P.ws + WS_R1 + 64 * MiB); const bf16_t* CV = (const bf16_t*)(P.ws + WS_R1 + 128 * MiB);
    int tid = threadIdx.x; asm volatile("" : "+v"(tid));
    const int lane = tid & 63, wid = __builtin_amdgcn_readfirstlane(tid >> 6), r32 = lane & 31; const size_t rowbase = (size_t)b * SEQ; const int q0 = qb * 256, qw = q0 + wid * 32, qc = qw >> 6;
    LAS float* bt = (LAS float*)(F.lds + L::OFF_BT);
    if (qb == 0) { for (int i = tid; i < 640; i += NWAVES * 64) bt[i] = P.obias[h * 320 + (i < 319 ? i : 319)] * LOG2E; }
    const int c0 = q0 >> 6, T0 = c0 - 8 > 0 ? c0 - 8 : 0, tw0 = qc - 8 > 0 ? qc - 8 : 0;
    const int nc0 = c0 + 4, nT0 = nc0 - 8 > 0 ? nc0 - 8 : 0;
    f32x16 o[2]; int pre_out = 0;
    attn_core<64, 2, 4>(o, F.lds, CQ + (rowbase + qw) * DM + h * 64, DM, CK + rowbase * DM + h * 64, DM, CV + rowbase * DM + h * 64, DM, T0, c0 + 4, tw0, qc + 1, nullptr, qw + r32, qc, -1, 0,
                        CK + rowbase * DM + h * 64, CV + rowbase * DM + h * 64, nullptr, nT0, has_next ? (nc0 + 4) : 0, pre, &pre_out);
    pre = pre_out;
    store_o<64>(o, F.lds, (bf16_t*)(P.ws + WS_ATT) + (rowbase + qw) * DM + h * 64, DM);
}

#ifndef DBG_NO_IDX
#define DBG_NO_IDX 0
#endif
#ifndef DBG_NO_A
#define DBG_NO_A 0
#endif
#ifndef DBG_NO_B
#define DBG_NO_B 0
#endif
#ifndef DBG_STAGES
#define DBG_STAGES 99
#endif
struct Args { const float* in[12]; float* out; unsigned char* ws; };
__global__ void __launch_bounds__(NWAVES * 64, 2) fwd_kernel(Args args) {
    extern __shared__ __attribute__((aligned(16))) unsigned char lds[];
    Frame F;
    F.lds = (LAS unsigned char*)lds; F.MISC = (volatile LAS unsigned*)(F.lds + MISC_OFF);
    F.tid = threadIdx.x; F.lane = F.tid & 63; F.wave = __builtin_amdgcn_readfirstlane(F.tid >> 6);
    F.G = gridDim.x; { const int bx = blockIdx.x; F.vcu = (F.G % 8 == 0) ? (bx % 8) * (F.G / 8) + bx / 8 : bx; }
    Ptrs P; P.x = args.in[0]; P.norm_g = args.in[1]; P.wg = args.in[2]; P.wu = args.in[3]; P.wd = args.in[4]; P.ewin = args.in[5]; P.ewout = args.in[6]; P.elam = args.in[7]; P.esub = args.in[8];
    P.owin = args.in[9]; P.owout = args.in[10]; P.obias = args.in[11]; P.out = args.out; P.ws = args.ws;
    F.ctl = (gu32*)(P.ws + WS_CTL);
    for (int u = F.tid; u < (LDS_BYTES - LDSCTL_OFF) / 4; u += NWAVES * 64) ((LAS unsigned*)(F.lds + LDSCTL_OFF))[u] = 0u;
    __syncthreads();
    XcdBarrier bar = xcd_barrier_post((unsigned*)(F.ctl + CW_BAR), F.MISC + 8);
#define GRID_BAR() xcd_barrier(bar)
    bf16* XB = (bf16*)(P.ws + WS_XB); const float* RS = (const float*)(P.ws + WS_SSQ2); bf16* HID = (bf16*)(P.ws + WS_R1); bf16* Y = (bf16*)(P.ws + WS_Y); const bf16* ATT = (const bf16*)(P.ws + WS_ATT);

#ifdef PROBE_REP_PRO
    for (int rep_ = 1; rep_ < PROBE_REP_PRO; ++rep_) { p0_prologue(F, P); __syncthreads(); }
#endif
    p0_prologue(F, P); GRID_BAR();

#define FUSED_GEMM(Aop, Bop, Kdim, inst, gain, alpha_, LAST_) FUSED_GEMM_X(XB, (float*)(P.ws + WS_SSQ2), Aop, Bop, Kdim, inst, gain, alpha_, LAST_, 0)
#define FUSED_GEMM_X(Xp, SSQ2p, Aop, Bop, Kdim, inst, gain, alpha_, LAST_, PV_) do { \
        pg8::Gemm g{(Aop), (Bop), MROWS, DM, (Kdim)}; \
        epi::EpiRmsRes<LAST_, PV_> E{(Xp), P.out, (gain), (alpha_), (unsigned long long*)(P.ws + WS_GRAN), (unsigned)((inst) + 1), (SSQ2p), (unsigned*)(F.ctl + CW_TMO), F.lds + FUSED_LDS_OFF}; \
        pg8::StaticOrder S; S.init(MROWS, DM, F.G, (int)blockIdx.x); \
        pg8::gemm_phase<epi::EpiRmsRes<LAST_, PV_>, pg8::StaticOrder, true, true>(F.lds, g, S, E); } while (0)
#define FFN_PHASES(l, f, LAST_) do { \
        { pg8::Gemm g{XB, (const bf16*)(P.ws + WS_WGU + (2 * (l) + (f)) * WGU_BYTES), MROWS, NGU, DM}; epi::OrdOrder S; S.base.init(MROWS, NGU, F.G, (int)blockIdx.x); \
          epi::rowstat_table(S, RS, (LAS float*)(F.lds + FUSED_LDS_OFF), 11); \
          epi::EpiSwiGLU E{HID, (const LAS float*)(F.lds + FUSED_LDS_OFF)}; const unsigned long long pc0_ = PROBE_CLK ? __builtin_amdgcn_s_memtime() : 0ull; for (int rep_ = 0; rep_ < PROBE_REP_GU; ++rep_) pg8::gemm_phase<epi::EpiSwiGLU, epi::OrdOrder, true, true>(F.lds, g, S, E); \
          if (PROBE_CLK) { const unsigned long long pc1_ = __builtin_amdgcn_s_memtime(); while (__builtin_amdgcn_s_memtime() - pc1_ < pc1_ - pc0_) __builtin_amdgcn_s_sleep(32); } \
          if (PROBE_NULL_GU) { epi::EpiNull EN; for (int rep_ = 0; rep_ < PROBE_NULL_GU; ++rep_) pg8::gemm_phase<epi::EpiNull, epi::OrdOrder, true, true>(F.lds, g, S, EN); } \
          if (PROBE_HOT_GU) { epi::EpiNull EN; epi::HotOrder HS{11, (int)blockIdx.x}; pg8::gemm_phase<epi::EpiNull, epi::HotOrder, true, true>(F.lds, g, HS, EN); } \
          if (PROBE_NOST_GU) { epi::EpiSwiGLUT<1> EN{HID, (const LAS float*)(F.lds + FUSED_LDS_OFF)}; pg8::gemm_phase<epi::EpiSwiGLUT<1>, epi::OrdOrder, true, true>(F.lds, g, S, EN); } } \
        GRID_BAR(); \
        if (PROBE_FUSED_DN) { FUSED_GEMM_X((bf16*)(P.ws + WS_ATT), (float*)(P.ws + WS_SSQ1), HID, (const bf16*)(P.ws + WS_WD + (2 * (l) + (f)) * WD_BYTES), FF, 6 + 2 * (l) + (f), P.norm_g + ((l) * 6 + 4 * (f) + 1) * DM, 0.5f, false, PROBE_FUSED_VAR); GRID_BAR(); } \
        FUSED_GEMM(HID, (const bf16*)(P.ws + WS_WD + (2 * (l) + (f)) * WD_BYTES), FF, 3 * (l) + 2 * (f), P.norm_g + ((l) * 6 + 4 * (f) + 1) * DM, 0.5f, LAST_); \
        if (!(LAST_)) GRID_BAR(); } while (0)

    FFN_PHASES(0, 0, false);
    if (DBG_STAGES >= 2) {
        { pg8::Gemm g{XB, (const bf16*)(P.ws + WS_WIN0), MROWS, NEV, DM}; epi::OrdOrder S; S.base.init(MROWS, NEV, F.G, (int)blockIdx.x);
          epi::rowstat_table(S, RS, (LAS float*)(F.lds + FUSED_LDS_OFF), NEV / 256 / 2);
          unsigned char* r1 = P.ws + WS_R1;
          epi::EpiProjEven E{(bf16*)r1, (bf16*)(r1 + 192 * MiB), (bf16*)(r1 + 208 * MiB),
                             (float*)(r1 + 210 * MiB), (const LAS float*)(F.lds + FUSED_LDS_OFF), (const float*)(P.ws + WS_C64), (const float*)(P.ws + WS_S64), (const float*)(P.ws + WS_C32), (const float*)(P.ws + WS_S32)};
          pg8::gemm_phase<epi::EpiProjEven, epi::OrdOrder, true, true>(F.lds, g, S, E); }
        GRID_BAR();
#ifdef PROBE_IDX_VAR
        for (int p = F.vcu; p < 1024; p += F.G) { const int b = p >> 6, j = p & 63;
#pragma unroll 1
            for (int k = 0; k < 2; ++k) indexer_unit<PROBE_IDX_VAR>(F, P, b, k ? 127 - j : j); }
#endif
        for (int rep_ = 0; rep_ < PROBE_REP_IDXA * PROBE_REP_IDX; ++rep_)
        for (int p = F.vcu; p < 1024; p += F.G) { const int b = p >> 6, j = p & 63;
#pragma unroll 1
            for (int k = 0; k < 2; ++k) { if (!DBG_NO_IDX) indexer_unit<0>(F, P, b, k ? 127 - j : j); } }
        {
            float l01 = 0.f, l23 = 0.f;
            for (int i = 0; i < 64; ++i) { l01 += P.elam[i] * P.elam[64 + i]; l23 += P.elam[128 + i] * P.elam[192 + i]; }
            const float lam = expf(l01) - expf(l23) + 0.2f;
            for (int rep_ = 0; rep_ < PROBE_REP_IDXA; ++rep_)
            for (int p = F.vcu; p < 256; p += F.G) { const int bh = p >> 2, s = p & 3;
#pragma unroll 1
                for (int k = 0; k < 2; ++k) { if (!DBG_NO_A) a_unit(F, P, bh >> 2, bh & 3, k ? 7 - s : s, lam); } }
        }
        GRID_BAR();
        for (int rep_ = 0; rep_ < PROBE_REP_B; ++rep_) {
            int pre_ = 0;
#pragma unroll 1
            for (int j = 0; j < 4; ++j) { const int p = F.vcu + 256 * (j >> 1), bh = p >> 2, s = p & 3, qb = (j & 1) ? 7 - s : s;
                const int jn = j + 1, pn = F.vcu + 256 * (jn >> 1), bhn = pn >> 2, sn = pn & 3, qbn = (jn & 1) ? 7 - sn : sn;
                if (!DBG_NO_B) b_unit(F, P, bh >> 3, bh & 7, qb, (PROBE_B_HOT && rep_ + 1 < PROBE_REP_B) ? 0 : -1, (rep_ + 1 < PROBE_REP_B) ? PROBE_B_SKIP : 0, jn < 4, bhn >> 3, bhn & 7, qbn, pre_); } }
        GRID_BAR();
        FUSED_GEMM(ATT, (const bf16*)(P.ws + WS_WOUT0), DM, 3 * 0 + 1, P.norm_g + (0 * 6 + 3) * DM, 1.0f, false);
        GRID_BAR();
    }
    if (DBG_STAGES >= 3) FFN_PHASES(0, 1, false);
#ifdef PROBE_XBAR
    for (int i_ = 0; i_ < PROBE_XBAR; ++i_) GRID_BAR();
#endif
#ifdef PROBE_IDLE_CYC
    { const unsigned long long t0_ = __builtin_amdgcn_s_memtime(); while (__builtin_amdgcn_s_memtime() - t0_ < (unsigned long long)PROBE_IDLE_CYC) __builtin_amdgcn_s_sleep(32); }
#endif
#ifdef PROBE_IDLE_US
    { const unsigned long long t0_ = __builtin_amdgcn_s_memrealtime(); while (__builtin_amdgcn_s_memrealtime() - t0_ < 100ull * PROBE_IDLE_US) __builtin_amdgcn_s_sleep(32); }
#endif
    if (DBG_STAGES >= 4) FFN_PHASES(1, 0, false);
    if (DBG_STAGES >= 5) {
        { pg8::Gemm g{XB, (const bf16*)(P.ws + WS_WIN1), MROWS, NOD, DM}; epi::OrdOrder S; S.base.init(MROWS, NOD, F.G, (int)blockIdx.x);
          epi::rowstat_table(S, RS, (LAS float*)(F.lds + FUSED_LDS_OFF), NOD / 256 / 2);
          unsigned char* r1 = P.ws + WS_R1; epi::EpiProjOdd E{(bf16*)r1, (const LAS float*)(F.lds + FUSED_LDS_OFF)};
          pg8::gemm_phase<epi::EpiProjOdd, epi::OrdOrder, true, true>(F.lds, g, S, E); }
        GRID_BAR();
        for (int rep_ = 0; rep_ < PROBE_REP_C; ++rep_) { const int p = F.vcu, b = p >> 4, h = p & 15; int pre_ = 0;
#pragma unroll 1
            for (int qb = 0; qb < 8; ++qb) c_unit(F, P, b, h, qb, qb < 7, pre_); }
        GRID_BAR();
        FUSED_GEMM(ATT, (const bf16*)(P.ws + WS_WOUT1), DM, 3 * 1 + 1, P.norm_g + (1 * 6 + 3) * DM, 1.0f, false);
        GRID_BAR();
    }
    if (DBG_STAGES >= 6) FFN_PHASES(1, 1, true);
}

extern "C" void kernel_launch(void* const* d_in, const int* in_sizes, int n_in, void* d_out, int out_size, void* d_ws, size_t ws_size, hipStream_t stream) {
    static int grid = 0;
    if (grid == 0) {
        if (n_in != 12 || in_sizes[0] != MROWS * DM || out_size != MROWS * DM || ws_size < WS_END) {
            fprintf(stderr, "kernel_launch: unexpected shapes / workspace (n_in %d, in0 %d, out %d, ws %zu, need %zu); nothing launched\n", n_in, n_in > 0 ? in_sizes[0] : -1, out_size, ws_size, (size_t)WS_END); grid = -1; return; }
        int dev = 0, cus = 0, per_cu = 0;
        if (hipGetDevice(&dev) != hipSuccess || hipDeviceGetAttribute(&cus, hipDeviceAttributeMultiprocessorCount, dev) != hipSuccess) { fprintf(stderr, "kernel_launch: device query failed\n"); grid = -1; return; }
        if (hipFuncSetAttribute((const void*)fwd_kernel, hipFuncAttributeMaxDynamicSharedMemorySize, LDS_BYTES) != hipSuccess) { fprintf(stderr, "kernel_launch: hipFuncSetAttribute failed\n"); grid = -1; return; }
        if (hipOccupancyMaxActiveBlocksPerMultiprocessor(&per_cu, (const void*)fwd_kernel, NWAVES * 64, LDS_BYTES) != hipSuccess || per_cu < 1)
            fprintf(stderr, "kernel_launch: note: occupancy query reports %d workgroups per CU\n", per_cu);
        (void)hipGetLastError();
        grid = cus;
        if (grid != 256) { fprintf(stderr, "kernel_launch: built for a 256-CU device (the fused epilogues pair workgroups by rounds of 256), found %d; nothing launched\n", cus); grid = -1; return; }
    }
    if (grid < 0) return;
    if (hipMemsetAsync((char*)d_ws + WS_CTL, 0, CTL_ZERO_BYTES, stream) != hipSuccess) { fprintf(stderr, "kernel_launch: memset failed\n"); return; }
    Args a{};
    for (int i = 0; i < 12; ++i) a.in[i] = (const float*)d_in[i];
    a.out = (float*)d_out; a.ws = (unsigned char*)d_ws;
    hipLaunchKernelGGL(fwd_kernel, dim3(grid), dim3(NWAVES * 64), LDS_BYTES, stream, a);
    const hipError_t le = hipPeekAtLastError();
    if (le != hipSuccess) fprintf(stderr, "kernel_launch: launch failed: %s\n", hipGetErrorName(le));
}
```

```cpp
#include <hip/hip_runtime.h>
#include <cstdio>
#include <cstdint>
namespace pg8 {
#define PG8_LAS __attribute__((address_space(3)))
typedef unsigned short bf16_t;
typedef short bf16x8 __attribute__((ext_vector_type(8)));
typedef float f32x4 __attribute__((ext_vector_type(4)));
typedef unsigned u32x4 __attribute__((ext_vector_type(4)));
constexpr int BM = 256, BK = 64, HALF = 128, HTB = HALF * BK * 2  , STAGE_BYTES = 8 * HTB, NXCD = 8, WGM = 8;

__host__ __device__ __forceinline__ int lds_byte(int r, int c) { const int st = (r >> 4) * 2 + (c >> 5), rr = r & 15, cc = c & 31, ob = rr * 64 + cc * 2; return st * 1024 + (ob ^ (((ob >> 9) & 1) << 5)); }
__host__ __device__ __forceinline__ void stage_rc(int b, int& R, int& C) { const int st = b / 1024, sb = b % 1024, swz = sb ^ (((sb >> 9) & 1) << 5); R = (st >> 1) * 16 + swz / 64; C = (st & 1) * 32 + (swz % 64) / 2; }
__host__ __device__ __forceinline__ int perm32(int rho) { const int n = rho >> 4, i = rho & 15; return 8 * (i >> 2) + 4 * n + (i & 3); }

struct Unit { int pm, pn, idx; };
struct Gemm { const bf16_t* A; const bf16_t* Bt; int M, N, K; };

struct StaticOrder {
    int nM, nN, nwg, G, c;
    __host__ __device__ void init(int M, int N, int G_, int c_) { nM = M / BM; nN = N / BM; nwg = nM * nN; G = G_; c = c_; }
    __host__ __device__ bool next(int i, Unit& u) const {
        const long L = (long)i * G + c; if (L >= nwg) return false;
        int wgid = (int)L; { const int q = nwg / NXCD, r = nwg % NXCD, xcd = wgid % NXCD, off = wgid / NXCD; wgid = (xcd < r ? xcd * (q + 1) : r * (q + 1) + (xcd - r) * q) + off; }
        const int nig = WGM * nN, gid = wgid / nig, fm = gid * WGM, gsz = (nM - fm) < WGM ? (nM - fm) : WGM;
        u.pm = fm + ((wgid % nig) % gsz); u.pn = (wgid % nig) / gsz; return true;
    }
    __device__ __forceinline__ void a_ready(const Unit&) const {}
    __device__ __forceinline__ void done(const Unit&) const {}
};

__device__ __forceinline__ unsigned cvt_pk_bf16(float lo, float hi) { unsigned r; asm volatile("v_cvt_pk_bf16_f32 %0, %1, %2" : "=v"(r) : "v"(lo), "v"(hi)); return r; }
typedef float f32x2 __attribute__((ext_vector_type(2)));
__device__ __forceinline__ f32x2 gelu_pk(f32x2 v) {
    const f32x2 av = __builtin_elementwise_abs(v), d = av * 0.2316418882f + 1.0f;
    f32x2 t; t.x = __builtin_amdgcn_rcpf(d.x); t.y = __builtin_amdgcn_rcpf(d.y);
    f32x2 q = t * 0.5307027145f + (-0.7265760135f); q = q * t + 0.7107068705f; q = q * t + (-0.142248368f); q = q * t + 0.127414796f; q = q * t;
    const f32x2 s = (v * v) * (-0.72134752044f);
    f32x2 e; e.x = __builtin_amdgcn_exp2f(s.x); e.y = __builtin_amdgcn_exp2f(s.y);
    const f32x2 m = v * (q * e), r = v - m;
    f32x2 o; o.x = v.x < 0.f ? m.x : r.x; o.y = v.y < 0.f ? m.y : r.y; return o;
}

template <int ACT  > struct EpiBf16 {
    static constexpr bool PERM = true, AFTER_DRAIN = false; static_assert(ACT == 0 || ACT == 1, "EpiBf16: ACT is 0 (none) or 1 (gelu_pk)");
    bf16_t* O; int ldc; const float* bias; int split_cols; size_t split_stride; float scale0;
    __device__ __forceinline__ void operator()(const f32x4 (&acc)[2][2][4][2], const Unit& u, int wr, int wc, int fr, int fq) const {
        const int row0 = u.pm * BM + wr * 64 + fr; int colt = u.pn * BM; bf16_t* base = O;
        float sc = 1.f; if (split_cols) { const int t = colt / split_cols; base += (size_t)t * split_stride; colt -= t * split_cols; if (t == 0) sc = scale0; }
        const int col0 = colt + wc * 32 + 8 * fq, bcol0 = u.pn * BM + wc * 32 + 8 * fq;
        f32x4 bv[2][2];
#pragma unroll
        for (int bj = 0; bj < 2; ++bj)
#pragma unroll
            for (int n = 0; n < 2; ++n) bv[bj][n] = bias ? *(const f32x4*)(bias + bcol0 + bj * HALF + 4 * n) : (f32x4){0.f, 0.f, 0.f, 0.f};
#pragma unroll
        for (int ai = 0; ai < 2; ++ai)
#pragma unroll
            for (int m = 0; m < 4; ++m) { bf16_t* rowp = base + (size_t)(row0 + ai * HALF + m * 16) * ldc + col0;
#pragma unroll
                for (int bj = 0; bj < 2; ++bj) { f32x4 v0 = acc[ai][bj][m][0] + bv[bj][0], v1 = acc[ai][bj][m][1] + bv[bj][1];
                    if (ACT == 1) { f32x2 a = gelu_pk((f32x2){v0[0], v0[1]}), b = gelu_pk((f32x2){v0[2], v0[3]}), c = gelu_pk((f32x2){v1[0], v1[1]}), d = gelu_pk((f32x2){v1[2], v1[3]});
                        v0 = (f32x4){a.x, a.y, b.x, b.y}; v1 = (f32x4){c.x, c.y, d.x, d.y}; }
                    v0 = v0 * sc; v1 = v1 * sc; u32x4 w; w.x = cvt_pk_bf16(v0[0], v0[1]); w.y = cvt_pk_bf16(v0[2], v0[3]); w.z = cvt_pk_bf16(v1[0], v1[1]); w.w = cvt_pk_bf16(v1[2], v1[3]);
                    *(u32x4*)(rowp + bj * HALF) = w; } }
    }
};

struct PanelStats {
    unsigned* xbuf;
    unsigned* cnt;
    unsigned* tmo;
    int ntn; float eps;
    unsigned code;
    __device__ __forceinline__ bool run(const f32x4 (&v)[2][2][4][2], const Unit& u, int wr, int wc, int fr, int fq, PG8_LAS unsigned char* lds, int wid, int lane) const {
        typedef float f32x2v __attribute__((ext_vector_type(2)));
        PG8_LAS f32x2v* P = (PG8_LAS f32x2v*)lds;
        PG8_LAS f32x2v* S = (PG8_LAS f32x2v*)(lds + 8192);
        PG8_LAS unsigned* flag = (PG8_LAS unsigned*)(lds + 8192 + 2048);
#pragma unroll
        for (int ai = 0; ai < 2; ++ai)
#pragma unroll
            for (int m = 0; m < 4; ++m) {
                float s = 0.f;
#pragma unroll
                for (int bj = 0; bj < 2; ++bj)
#pragma unroll
                    for (int n = 0; n < 2; ++n) { const f32x4 x = v[ai][bj][m][n]; s += (x[0] + x[1]) + (x[2] + x[3]); }
                s += __shfl_xor(s, 16); s += __shfl_xor(s, 32);
                const float mw = s * (1.0f / 64.0f); float q = 0.f;
#pragma unroll
                for (int bj = 0; bj < 2; ++bj)
#pragma unroll
                    for (int n = 0; n < 2; ++n) { const f32x4 d = v[ai][bj][m][n] - mw; q += (d[0] * d[0] + d[1] * d[1]) + (d[2] * d[2] + d[3] * d[3]); }
                q += __shfl_xor(q, 16); q += __shfl_xor(q, 32);
                if (fq == 0) P[(ai * HALF + wr * 64 + m * 16 + fr) * 4 + wc] = (f32x2v){mw, q};
            }
        asm volatile("s_waitcnt lgkmcnt(0)" ::: "memory"); __builtin_amdgcn_s_barrier(); asm volatile("" ::: "memory");
#if defined(BROKEN_EXCHANGE_NO_WAIT)
#warning BROKEN CONTROL BUILD: the row-statistics exchange does not wait; results are wrong by design
        if (blockIdx.x >= 64) { const long long t0_ = clock64(); while (clock64() - t0_ < 60000) __builtin_amdgcn_s_sleep(8); }
#endif
        const int row = wid * 32 + (lane & 31);
        if (lane < 32) {
            const f32x2v a = P[row * 4 + 0], b = P[row * 4 + 1], c = P[row * 4 + 2], d = P[row * 4 + 3];
            const float mt = (a.x + b.x + c.x + d.x) * 0.25f;
            const float da = a.x - mt, db = b.x - mt, dc = c.x - mt, dd = d.x - mt;
            const float m2 = (a.y + b.y) + (c.y + d.y) + 64.0f * ((da * da + db * db) + (dc * dc + dd * dd));
            unsigned long long* slot = (unsigned long long*)xbuf + ((size_t)(u.pm * BM + row) * 4 + u.pn);
            __hip_atomic_store(slot, ((unsigned long long)__float_as_uint(m2) << 32) | __float_as_uint(mt), __ATOMIC_RELAXED, __HIP_MEMORY_SCOPE_AGENT);
        }
        asm volatile("s_waitcnt vmcnt(0)" ::: "memory");
        if (lane == 0) __hip_atomic_fetch_add(cnt + 64 * u.pm, 1u, __ATOMIC_RELAXED, __HIP_MEMORY_SCOPE_AGENT);
        if (wid == 0) {
            bool dead = false; const unsigned long long t0 = __builtin_amdgcn_s_memrealtime(); const unsigned want = 8u * (unsigned)ntn;
            for (;;) {
#if defined(BROKEN_EXCHANGE_NO_WAIT)
                break;
#endif
                if ((unsigned)__builtin_amdgcn_readfirstlane(__hip_atomic_load(cnt + 64 * u.pm, __ATOMIC_RELAXED, __HIP_MEMORY_SCOPE_AGENT)) >= want) break;
                if (__builtin_amdgcn_s_memrealtime() - t0 > 2000000ull) {
                    if (lane == 0) { unsigned expect = 0u; __hip_atomic_compare_exchange_strong(tmo + 1, &expect, code | (unsigned)(u.pm & 0xff), __ATOMIC_RELAXED, __ATOMIC_RELAXED, __HIP_MEMORY_SCOPE_AGENT);
                                     __hip_atomic_store(tmo, 1u, __ATOMIC_RELAXED, __HIP_MEMORY_SCOPE_AGENT); }
                    dead = true; break; }
                __builtin_amdgcn_s_sleep(2);
            }
            __builtin_amdgcn_fence(__ATOMIC_ACQUIRE, "agent");
            if (lane == 0) flag[0] = dead ? 1u : 0u;
        }
        asm volatile("s_waitcnt vmcnt(0) lgkmcnt(0)" ::: "memory"); __builtin_amdgcn_s_barrier(); asm volatile("" ::: "memory");
        const bool bad = flag[0] != 0u;
        if (lane < 32) {
            const unsigned long long* slot = (const unsigned long long*)xbuf + (size_t)(u.pm * BM + row) * 4; float mt[4], m2[4]; float ms = 0.f;
#pragma unroll
            for (int t = 0; t < 4; ++t) { if (t < ntn) { const unsigned long long w = __hip_atomic_load(slot + t, __ATOMIC_RELAXED, __HIP_MEMORY_SCOPE_AGENT); mt[t] = __uint_as_float((unsigned)w); m2[t] = __uint_as_float((unsigned)(w >> 32)); } else { mt[t] = 0.f; m2[t] = 0.f; } ms += mt[t]; }
            const float mean = ms / (float)ntn; float q = 0.f;
#pragma unroll
            for (int t = 0; t < 4; ++t) if (t < ntn) { const float dm = mt[t] - mean; q += m2[t] + 256.0f * dm * dm; }
            S[row] = (f32x2v){mean, 1.0f / sqrtf(q / (256.0f * (float)ntn) + eps)};
        }
        asm volatile("s_waitcnt lgkmcnt(0)" ::: "memory"); __builtin_amdgcn_s_barrier(); asm volatile("" ::: "memory");
        return bad;
    }
};
struct EpiLnRes {
    static constexpr bool PERM = false, AFTER_DRAIN = true;
    const float* base; float* out; int ldc; const float* bias; PanelStats st; unsigned poison;
    __device__ __forceinline__ void fused(f32x4 (&acc)[2][2][4][2], const Unit& u, int wr, int wc, int fr, int fq, PG8_LAS unsigned char* lds, int wid, int lane) const {
        typedef float f32x2v __attribute__((ext_vector_type(2)));
        const PG8_LAS f32x2v* S = (const PG8_LAS f32x2v*)(lds + 8192);
        const int col0 = u.pn * BM + wc * 32 + 4 * fq;
#pragma unroll
        for (int bj = 0; bj < 2; ++bj)
#pragma unroll
            for (int n = 0; n < 2; ++n) { const f32x4 bv = bias ? *(const f32x4*)(bias + col0 + bj * HALF + n * 16) : (f32x4){0.f, 0.f, 0.f, 0.f};
#pragma unroll
                for (int ai = 0; ai < 2; ++ai)
#pragma unroll
                    for (int m = 0; m < 4; ++m) acc[ai][bj][m][n] += bv; }
        f32x4 pre[4][2][2];
#pragma unroll
        for (int m = 0; m < 4; ++m) { const size_t off = (size_t)(u.pm * BM + wr * 64 + m * 16 + fr) * ldc + col0;
#pragma unroll
            for (int bj = 0; bj < 2; ++bj)
#pragma unroll
                for (int n = 0; n < 2; ++n) pre[m][bj][n] = *(const f32x4*)(base + off + bj * HALF + n * 16); }
        const bool bad = st.run(acc, u, wr, wc, fr, fq, lds, wid, lane) || poison != 0u;
        const float qnan = __builtin_nanf("");
#pragma unroll
        for (int ai = 0; ai < 2; ++ai)
#pragma unroll
            for (int m = 0; m < 4; ++m) { const int r = ai * HALF + wr * 64 + m * 16 + fr; const f32x2v sr = S[r]; const size_t off = (size_t)(u.pm * BM + r) * ldc + col0;
#pragma unroll
                for (int bj = 0; bj < 2; ++bj)
#pragma unroll
                    for (int n = 0; n < 2; ++n) { const f32x4 bs = ai == 0 ? pre[m][bj][n] : *(const f32x4*)(base + off + bj * HALF + n * 16); f32x4 o = bs + (acc[ai][bj][m][n] - sr.x) * sr.y;
                        if (bad) o = (f32x4){qnan, qnan, qnan, qnan}; *(f32x4*)(out + off + bj * HALF + n * 16) = o; }
                if (m & 1) asm volatile("" ::: "memory"); }
    }
};
struct EpiLnResLn {
    static constexpr bool PERM = false, AFTER_DRAIN = true;
    const float* base; float* out; bf16_t* xn; int ldc; const float* bias; PanelStats st1, st2; unsigned poison;
    __device__ __forceinline__ void fused(f32x4 (&acc)[2][2][4][2], const Unit& u, int wr, int wc, int fr, int fq, PG8_LAS unsigned char* lds, int wid, int lane) const {
        typedef float f32x2v __attribute__((ext_vector_type(2))); typedef unsigned u32x2v __attribute__((ext_vector_type(2)));
        const PG8_LAS f32x2v* S = (const PG8_LAS f32x2v*)(lds + 8192);
        const int col0 = u.pn * BM + wc * 32 + 4 * fq;
#pragma unroll
        for (int bj = 0; bj < 2; ++bj)
#pragma unroll
            for (int n = 0; n < 2; ++n) { const f32x4 bv = bias ? *(const f32x4*)(bias + col0 + bj * HALF + n * 16) : (f32x4){0.f, 0.f, 0.f, 0.f};
#pragma unroll
                for (int ai = 0; ai < 2; ++ai)
#pragma unroll
                    for (int m = 0; m < 4; ++m) acc[ai][bj][m][n] += bv; }
        bool bad = st1.run(acc, u, wr, wc, fr, fq, lds, wid, lane) || poison != 0u;
        const float qnan = __builtin_nanf("");
#pragma unroll
        for (int ai = 0; ai < 2; ++ai)
#pragma unroll
            for (int m = 0; m < 4; ++m) { const int r = ai * HALF + wr * 64 + m * 16 + fr; const f32x2v sr = S[r]; const size_t off = (size_t)(u.pm * BM + r) * ldc + col0;
#pragma unroll
                for (int bj = 0; bj < 2; ++bj)
#pragma unroll
                    for (int n = 0; n < 2; ++n) { const f32x4 bs = *(const f32x4*)(base + off + bj * HALF + n * 16); acc[ai][bj][m][n] = bs + (acc[ai][bj][m][n] - sr.x) * sr.y; }
                asm volatile("" : "+v"(acc[ai][0][m][0]), "+v"(acc[ai][0][m][1]), "+v"(acc[ai][1][m][0]), "+v"(acc[ai][1][m][1]));
                if (m & 1) asm volatile("" ::: "memory"); }
        const bool bad1 = bad;
        bad = st2.run(acc, u, wr, wc, fr, fq, lds, wid, lane) || bad;
#pragma unroll
        for (int ai = 0; ai < 2; ++ai)
#pragma unroll
            for (int m = 0; m < 4; ++m) { const int r = ai * HALF + wr * 64 + m * 16 + fr; const f32x2v sr = S[r]; const size_t off = (size_t)(u.pm * BM + r) * ldc + col0;
#pragma unroll
                for (int bj = 0; bj < 2; ++bj)
#pragma unroll
                    for (int n = 0; n < 2; ++n) { const f32x4 x1 = acc[ai][bj][m][n]; *(f32x4*)(out + off + bj * HALF + n * 16) = bad1 ? (f32x4){qnan, qnan, qnan, qnan} : x1;
                        const f32x4 o = (x1 - sr.x) * sr.y; u32x2v w; w.x = cvt_pk_bf16(o[0], o[1]); w.y = cvt_pk_bf16(o[2], o[3]);
                        if (bad) { w.x = 0x7fc07fc0u; w.y = 0x7fc07fc0u; } *(u32x2v*)(xn + off + bj * HALF + n * 16) = w; }
                asm volatile("" ::: "memory"); }
    }
};

template <class Epi, class Sched, bool ALIGN_EPI = false, bool SP2 = false>
__device__ __forceinline__ void gemm_phase(PG8_LAS unsigned char* lds, const Gemm g, const Sched& S, const Epi& E) {
    int tid_ = threadIdx.x; asm volatile("" : "+v"(tid_));
    const int tid = tid_, wid = __builtin_amdgcn_readfirstlane(tid >> 6), lane = tid & 63, wr = wid >> 2, wc = wid & 3, fr = lane & 15, fq = lane >> 4;
    const int K = g.K, nt = K / BK;
    unsigned voffA[2], voffB[2];
#pragma unroll
    for (int i = 0; i < 2; ++i) { int R, C; stage_rc(tid * 16 + i * 8192, R, C); const int Rb = Epi::PERM ? ((R & ~31) + perm32(R & 31)) : R;
        voffA[i] = (unsigned)(R * K + C) * 2u; voffB[i] = (unsigned)(Rb * K + C) * 2u; }
    const size_t kstep = (size_t)(BK * 2);
    const size_t hstep = (size_t)HALF * K * 2;
    const size_t tstep = 2 * hstep;
    const unsigned ldsw = (unsigned)wid * 1024u;
    const int aoff = lds_byte(wr * 64 + fr, fq * 8), boff = lds_byte(wc * 32 + fr, fq * 8);
#define PG8_SA(b, h) (((b) * 2 + (h)) * HTB)
#define PG8_SB(b, h) ((4 + (b) * 2 + (h)) * HTB)
#define PG8_STAGE(bufoff, gbase, voff) do { _Pragma("unroll") for (int _i = 0; _i < 2; ++_i) \
        __builtin_amdgcn_global_load_lds((const unsigned*)((const char*)(gbase) + (voff)[_i]), (PG8_LAS unsigned*)(lds + (bufoff) + ldsw + _i * 8192), 16, 0, 0); } while (0)
#define PG8_LDA(dst, b, h) do { _Pragma("unroll") for (int m = 0; m < 4; ++m) _Pragma("unroll") for (int k = 0; k < 2; ++k) dst[m][k] = *(const PG8_LAS bf16x8*)(lds + PG8_SA(b, h) + aoff + m * 2048 + k * 1024); } while (0)
#define PG8_LDB(dst, b, h) do { _Pragma("unroll") for (int n = 0; n < 2; ++n) _Pragma("unroll") for (int k = 0; k < 2; ++k) dst[n][k] = *(const PG8_LAS bf16x8*)(lds + PG8_SB(b, h) + boff + n * 2048 + k * 1024); } while (0)
#define PG8_MMA(ai, bj, At, Bt) do { __builtin_amdgcn_s_setprio(1); _Pragma("unroll") for (int m = 0; m < 4; ++m) _Pragma("unroll") for (int n = 0; n < 2; ++n) _Pragma("unroll") for (int k = 0; k < 2; ++k) \
        acc[ai][bj][m][n] = __builtin_amdgcn_mfma_f32_16x16x32_bf16(Bt[n][k], At[m][k], acc[ai][bj][m][n], 0, 0, 0); __builtin_amdgcn_s_setprio(0); } while (0)
#define PG8_WAIT_V(n) asm volatile("s_waitcnt vmcnt(" #n ")" ::: "memory")
#define PG8_WAIT_L(n) asm volatile("s_waitcnt lgkmcnt(" #n ")" ::: "memory")
#define PG8_BAR __builtin_amdgcn_s_barrier()
#define PG8_SCHED __builtin_amdgcn_sched_barrier(0)
    Unit cur, nxt; int ui = 0;
    if (!S.next(0, cur)) return;
    f32x4 acc[2][2][4][2];
#pragma unroll
    for (int a = 0; a < 2; ++a)
#pragma unroll
        for (int b = 0; b < 2; ++b)
#pragma unroll
            for (int m = 0; m < 4; ++m)
#pragma unroll
                for (int n = 0; n < 2; ++n) acc[a][b][m][n] = (f32x4){0.f, 0.f, 0.f, 0.f};
    bf16x8 At[4][2], B0[2][2], B1[2][2];
    const char* cA = (const char*)g.A + (size_t)cur.pm * tstep; const char* cB = (const char*)g.Bt + (size_t)cur.pn * tstep;
    S.a_ready(cur);
    if constexpr (SP2) {
        PG8_STAGE(PG8_SB(0, 0), cB, voffB); PG8_STAGE(PG8_SB(0, 1), cB + hstep, voffB); PG8_STAGE(PG8_SA(0, 0), cA, voffA); PG8_STAGE(PG8_SA(0, 1), cA + hstep, voffA);
        if (wr == 1) PG8_BAR;
        PG8_WAIT_V(2); PG8_BAR;
        PG8_STAGE(PG8_SB(1, 0), cB + kstep, voffB); PG8_STAGE(PG8_SA(1, 0), cA + kstep, voffA); PG8_STAGE(PG8_SB(1, 1), cB + hstep + kstep, voffB);
        PG8_WAIT_V(6); PG8_BAR;
    } else {
        PG8_STAGE(PG8_SB(0, 0), cB, voffB); PG8_STAGE(PG8_SA(0, 0), cA, voffA); PG8_STAGE(PG8_SB(0, 1), cB + hstep, voffB); PG8_STAGE(PG8_SA(0, 1), cA + hstep, voffA);
        if (wr == 1) PG8_BAR;
        PG8_WAIT_V(4); PG8_BAR;
        PG8_STAGE(PG8_SB(1, 0), cB + kstep, voffB); PG8_STAGE(PG8_SA(1, 0), cA + kstep, voffA); PG8_STAGE(PG8_SB(1, 1), cB + hstep + kstep, voffB);
        PG8_WAIT_V(6); PG8_BAR;
    }
    for (;;) {
        const bool has_next = S.next(ui + 1, nxt);
        const char* nA = has_next ? (const char*)g.A + (size_t)nxt.pm * tstep : cA; const char* nB = has_next ? (const char*)g.Bt + (size_t)nxt.pn * tstep : cB;
        for (int t = 0; t < nt; t += 2) {
            const bool last = (t == nt - 2);
            const char* a1 = cA + (size_t)(t + 1) * kstep;
            const char* a2 = last ? nA : cA + (size_t)(t + 2) * kstep; const char* b2 = last ? nB : cB + (size_t)(t + 2) * kstep;
            const char* a3 = a2 + kstep; const char* b3 = b2 + kstep;
            if (last && has_next) S.a_ready(nxt);
            if constexpr (SP2) {
            PG8_LDB(B0, 0, 0); PG8_LDB(B1, 0, 1); PG8_SCHED; PG8_LDA(At, 0, 0); PG8_STAGE(PG8_SA(1, 1), a1 + hstep, voffA);
            PG8_WAIT_V(8); PG8_WAIT_L(0); PG8_BAR; PG8_MMA(0, 0, At, B0); PG8_MMA(0, 1, At, B1); PG8_BAR; PG8_SCHED;
            PG8_LDA(At, 0, 1); PG8_STAGE(PG8_SB(0, 0), b2, voffB); PG8_STAGE(PG8_SB(0, 1), b2 + hstep, voffB); PG8_STAGE(PG8_SA(0, 0), a2, voffA);
            PG8_WAIT_V(8); PG8_WAIT_L(0); PG8_BAR; PG8_MMA(1, 0, At, B0); PG8_MMA(1, 1, At, B1); PG8_BAR; PG8_SCHED;
            PG8_LDB(B0, 1, 0); PG8_LDB(B1, 1, 1); PG8_SCHED; PG8_LDA(At, 1, 0); PG8_STAGE(PG8_SA(0, 1), a2 + hstep, voffA);
            PG8_WAIT_V(8); PG8_WAIT_L(0); PG8_BAR; PG8_MMA(0, 0, At, B0); PG8_MMA(0, 1, At, B1); PG8_BAR; PG8_SCHED;
            PG8_LDA(At, 1, 1); PG8_STAGE(PG8_SB(1, 0), b3, voffB); PG8_STAGE(PG8_SB(1, 1), b3 + hstep, voffB); PG8_STAGE(PG8_SA(1, 0), a3, voffA);
            PG8_WAIT_V(8); PG8_WAIT_L(0); PG8_BAR; PG8_MMA(1, 0, At, B0); PG8_MMA(1, 1, At, B1); PG8_BAR; PG8_SCHED;
            } else {
            PG8_LDB(B0, 0, 0); PG8_SCHED; PG8_LDA(At, 0, 0); PG8_STAGE(PG8_SA(1, 1), a1 + hstep, voffA);
            PG8_WAIT_L(8); PG8_BAR; PG8_WAIT_L(0); PG8_MMA(0, 0, At, B0); PG8_BAR; PG8_SCHED;
            PG8_LDB(B1, 0, 1); PG8_STAGE(PG8_SB(0, 0), b2, voffB);
            PG8_BAR; PG8_WAIT_L(0); PG8_MMA(0, 1, At, B1); PG8_BAR;
            PG8_LDA(At, 0, 1); PG8_STAGE(PG8_SA(0, 0), a2, voffA);
            PG8_BAR; PG8_WAIT_L(0); PG8_MMA(1, 0, At, B0); PG8_BAR; PG8_SCHED;
            PG8_STAGE(PG8_SB(0, 1), b2 + hstep, voffB);
            PG8_WAIT_V(6); PG8_BAR; PG8_MMA(1, 1, At, B1); PG8_BAR;
            PG8_LDB(B0, 1, 0); PG8_SCHED; PG8_LDA(At, 1, 0); PG8_STAGE(PG8_SA(0, 1), a2 + hstep, voffA);
            PG8_WAIT_L(8); PG8_BAR; PG8_WAIT_L(0); PG8_MMA(0, 0, At, B0); PG8_BAR; PG8_SCHED;
            PG8_LDB(B1, 1, 1); PG8_STAGE(PG8_SB(1, 0), b3, voffB);
            PG8_BAR; PG8_WAIT_L(0); PG8_MMA(0, 1, At, B1); PG8_BAR;
            PG8_LDA(At, 1, 1); PG8_STAGE(PG8_SA(1, 0), a3, voffA);
            PG8_BAR; PG8_WAIT_L(0); PG8_MMA(1, 0, At, B0); PG8_BAR; PG8_SCHED;
            PG8_STAGE(PG8_SB(1, 1), b3 + hstep, voffB);
            PG8_WAIT_V(6); PG8_BAR; PG8_MMA(1, 1, At, B1); PG8_BAR;
            }
        }
        if constexpr (ALIGN_EPI) { if (wr == 0) PG8_BAR; }
        if constexpr (!Epi::AFTER_DRAIN) { E(acc, cur, wr, wc, fr, fq); S.done(cur); }
        if (!has_next) break;
#pragma unroll
        for (int a = 0; a < 2; ++a)
#pragma unroll
            for (int b = 0; b < 2; ++b)
#pragma unroll
                for (int m = 0; m < 4; ++m)
#pragma unroll
                    for (int n = 0; n < 2; ++n) acc[a][b][m][n] = (f32x4){0.f, 0.f, 0.f, 0.f};
        cur = nxt; cA = nA; cB = nB; ++ui;
        if constexpr (ALIGN_EPI) { if (wr == 1) PG8_BAR; }
    }
    PG8_WAIT_V(0);
    if constexpr (!ALIGN_EPI) { if (wr == 0) PG8_BAR; }
    PG8_BAR;
    if constexpr (Epi::AFTER_DRAIN) { E.fused(acc, cur, wr, wc, fr, fq, lds, wid, lane); S.done(cur); }
#undef PG8_SA
#undef PG8_SB
#undef PG8_STAGE
#undef PG8_LDA
#undef PG8_LDB
#undef PG8_MMA
#undef PG8_WAIT_V
#undef PG8_WAIT_L
#undef PG8_BAR
#undef PG8_SCHED
}
}

constexpr int NB = 16, SEQ = 2048, DM = 1024, FF = 2816, MROWS = NB * SEQ;
constexpr int NGU = 2 * FF;
constexpr int NEV = 3584;
constexpr int NOD = 3072;
constexpr float RMS_EPS = 1e-6f;
constexpr float LOG2E = 1.4426950408889634f;
constexpr float QSCALE = 0.125f * LOG2E;

namespace epi {
using namespace pg8;
__device__ __forceinline__ unsigned pkbf(float lo, float hi) {
    typedef float f2_t __attribute__((ext_vector_type(2))); typedef __bf16 b2_t __attribute__((ext_vector_type(2)));
    f2_t v = {lo, hi}; b2_t b = __builtin_convertvector(v, b2_t); return __builtin_bit_cast(unsigned, b); }
__device__ __forceinline__ float row_rs(const float* ssq, int row) { const f32x4 p = *(const f32x4*)(ssq + (size_t)row * 4); return __builtin_amdgcn_rsqf(((p[0] + p[1]) + (p[2] + p[3])) * (1.f / DM) + RMS_EPS); }
__device__ __forceinline__ float epi_sum4fq(float s) {
    s += __int_as_float(__builtin_amdgcn_ds_swizzle(__float_as_int(s), (16 << 10) | 0x1f));
    auto rr = __builtin_amdgcn_permlane32_swap(__float_as_uint(s), __float_as_uint(s), false, false); return __uint_as_float(rr[0]) + __uint_as_float(rr[1]); }
__device__ __forceinline__ u32x4 pk8(const f32x4& a, const f32x4& b) { u32x4 w; w.x = pkbf(a[0], a[1]); w.y = pkbf(a[2], a[3]); w.z = pkbf(b[0], b[1]); w.w = pkbf(b[2], b[3]); return w; }

template <int PVAR = 0>
struct EpiSwiGLUT {
    static constexpr bool PERM = true, AFTER_DRAIN = false;
    bf16_t* H; const PG8_LAS float* tab;
    __device__ __forceinline__ void operator()(const f32x4 (&acc)[2][2][4][2], const Unit& u, int wr, int wc, int fr, int fq) const {
        typedef float f32x2 __attribute__((ext_vector_type(2)));
        const int row0 = u.pm * BM + wr * 64 + fr, col0 = u.pn * 128 + wc * 32 + 8 * fq;
        float v8[2][4];
#pragma unroll
        for (int ai = 0; ai < 2; ++ai)
#pragma unroll
            for (int m = 0; m < 4; ++m) v8[ai][m] = tab[u.idx * 256 + ai * HALF + wr * 64 + m * 16 + fr];
#pragma unroll
        for (int ai = 0; ai < 2; ++ai)
#pragma unroll
            for (int m = 0; m < 4; ++m) {
                const int row = row0 + ai * HALF + m * 16; const float v = v8[ai][m]; const float sp = -LOG2E * __builtin_amdgcn_rsqf(v);
                f32x4 h[2];
#pragma unroll
                for (int n = 0; n < 2; ++n)
#pragma unroll
                    for (int pr = 0; pr < 2; ++pr) { const f32x2 g2 = {acc[ai][0][m][n][2 * pr], acc[ai][0][m][n][2 * pr + 1]}, u2 = {acc[ai][1][m][n][2 * pr], acc[ai][1][m][n][2 * pr + 1]};
                        const f32x2 t2 = g2 * sp; f32x2 e2; e2.x = __builtin_amdgcn_exp2f(t2.x); e2.y = __builtin_amdgcn_exp2f(t2.y);
                        const f32x2 d2 = e2 * v + v; f32x2 r2; r2.x = __builtin_amdgcn_rcpf(d2.x); r2.y = __builtin_amdgcn_rcpf(d2.y);
                        const f32x2 h2 = (g2 * u2) * r2; h[n][2 * pr] = h2.x; h[n][2 * pr + 1] = h2.y; }
                if (PVAR == 1) { const u32x4 w_ = pk8(h[0], h[1]); asm volatile("" :: "v"(w_)); } else *(u32x4*)(H + (size_t)row * FF + col0) = pk8(h[0], h[1]);
            }
    }
};
typedef EpiSwiGLUT<0> EpiSwiGLU;
struct EpiNull {
    static constexpr bool PERM = true, AFTER_DRAIN = false;
    __device__ __forceinline__ void operator()(const f32x4 (&acc)[2][2][4][2], const Unit& u, int wr, int wc, int fr, int fq) const {
#pragma unroll
        for (int ai = 0; ai < 2; ++ai)
#pragma unroll
            for (int bj = 0; bj < 2; ++bj)
#pragma unroll
                for (int m = 0; m < 4; ++m)
#pragma unroll
                    for (int n = 0; n < 2; ++n) asm volatile("" :: "v"(acc[ai][bj][m][n]));
    }
};
struct EpiBf16Y {
    static constexpr bool PERM = true, AFTER_DRAIN = false;
    bf16_t* Y;
    __device__ __forceinline__ void operator()(const f32x4 (&acc)[2][2][4][2], const Unit& u, int wr, int wc, int fr, int fq) const {
        const int row0 = u.pm * BM + wr * 64 + fr, col0 = u.pn * BM + wc * 32 + 8 * fq;
#pragma unroll
        for (int ai = 0; ai < 2; ++ai)
#pragma unroll
            for (int m = 0; m < 4; ++m) { bf16_t* rowp = Y + (size_t)(row0 + ai * HALF + m * 16) * DM + col0;
#pragma unroll
                for (int bj = 0; bj < 2; ++bj) *(u32x4*)(rowp + bj * HALF) = pk8(acc[ai][bj][m][0], acc[ai][bj][m][1]); }
    }
};
template <bool LAST, int PVAR = 0>
struct EpiRmsRes {
    static constexpr bool PERM = true, AFTER_DRAIN = false;
    bf16_t* X; float* outf; const float* ga; float alpha; unsigned long long* gran; unsigned epoch; float* ssq2; unsigned* tmo; PG8_LAS unsigned char* xl;
    __device__ __forceinline__ void operator()(const f32x4 (&acc)[2][2][4][2], const Unit& u, int wr, int wc, int fr, int fq) const {
        int tid_ = threadIdx.x; asm volatile("" : "+v"(tid_)); const int wid = __builtin_amdgcn_readfirstlane(tid_ >> 6), lane = tid_ & 63;
        PG8_LAS float* P = (PG8_LAS float*)xl;
        PG8_LAS float* S = (PG8_LAS float*)(xl + 4096);
        const int col0 = u.pn * BM + wc * 32 + 8 * fq;
        u32x4 xw8[4][2];
#pragma unroll
        for (int m = 0; m < 4; ++m)
#pragma unroll
            for (int bj = 0; bj < 2; ++bj) xw8[m][bj] = *(const u32x4*)(X + (size_t)(u.pm * BM + wr * 64 + m * 16 + fr) * DM + col0 + bj * HALF);
#pragma unroll
        for (int ai = 0; ai < 2; ++ai)
#pragma unroll
            for (int m = 0; m < 4; ++m) { float s = 0.f;
#pragma unroll
                for (int bj = 0; bj < 2; ++bj)
#pragma unroll
                    for (int n = 0; n < 2; ++n) { const f32x4 v = acc[ai][bj][m][n]; s += (v[0] * v[0] + v[1] * v[1]) + (v[2] * v[2] + v[3] * v[3]); }
                s = epi_sum4fq(s);
                if (fq == 0) P[(ai * HALF + wr * 64 + m * 16 + fr) * 4 + wc] = s; }
        asm volatile("s_waitcnt lgkmcnt(0)" ::: "memory"); __builtin_amdgcn_s_barrier(); asm volatile("" ::: "memory");
        const int row = wid * 32 + (lane & 31);
        if (lane < 32) {
            const f32x4 p = *(const PG8_LAS f32x4*)(P + row * 4); const float mine = (p[0] + p[1]) + (p[2] + p[3]);
            unsigned long long* gr = gran + ((size_t)(u.pm * BM + row)) * 4;
            __hip_atomic_store(gr + u.pn, ((unsigned long long)epoch << 32) | (unsigned long long)__float_as_uint(mine), __ATOMIC_RELAXED, __HIP_MEMORY_SCOPE_AGENT);
            float t = 0.f; bool ok = false;
            for (unsigned spins = 0; spins < ((PVAR & 1) ? 0u : (1u << 18)); ++spins) {
                unsigned long long w[4]; bool all4 = true; t = 0.f;
#pragma unroll
                for (int k = 0; k < 4; ++k) { w[k] = __hip_atomic_load(gr + k, __ATOMIC_RELAXED, __HIP_MEMORY_SCOPE_AGENT); all4 = all4 && ((unsigned)(w[k] >> 32) == epoch); t += __uint_as_float((unsigned)w[k]); }
                if (__all(all4)) { ok = true; break; }
                __builtin_amdgcn_s_sleep(1);
            }
            if (PVAR & 1) { ok = true; t = 4.f * mine; }
            if (!ok && lane == 0) __hip_atomic_store(tmo, 1u, __ATOMIC_RELAXED, __HIP_MEMORY_SCOPE_AGENT);
            S[row] = alpha * __builtin_amdgcn_rsqf(t * (1.f / DM) + RMS_EPS);
        }
        asm volatile("s_waitcnt lgkmcnt(0)" ::: "memory"); __builtin_amdgcn_s_barrier(); asm volatile("" ::: "memory");
        if (PVAR & 2) return;
        f32x4 g[2][2];
#pragma unroll
        for (int bj = 0; bj < 2; ++bj)
#pragma unroll
            for (int n = 0; n < 2; ++n) g[bj][n] = *(const f32x4*)(ga + col0 + bj * HALF + 4 * n);
#pragma unroll
        for (int ai = 0; ai < 2; ++ai) {
            if (ai == 1) {
#pragma unroll
                for (int m = 0; m < 4; ++m)
#pragma unroll
                    for (int bj = 0; bj < 2; ++bj) xw8[m][bj] = *(const u32x4*)(X + (size_t)(u.pm * BM + HALF + wr * 64 + m * 16 + fr) * DM + col0 + bj * HALF);
            }
#pragma unroll
            for (int m = 0; m < 4; ++m) { const int rl = ai * HALF + wr * 64 + m * 16 + fr; const size_t off = (size_t)(u.pm * BM + rl) * DM + col0; const float sr = S[rl]; float q = 0.f;
#pragma unroll
                for (int bj = 0; bj < 2; ++bj) { const u32x4 xw = xw8[m][bj]; f32x4 xn[2];
#pragma unroll
                    for (int n = 0; n < 2; ++n) { const f32x4 xo = {__uint_as_float(xw[2 * n] << 16), __uint_as_float(xw[2 * n] & 0xffff0000u), __uint_as_float(xw[2 * n + 1] << 16), __uint_as_float(xw[2 * n + 1] & 0xffff0000u)};
                        xn[n] = xo + acc[ai][bj][m][n] * sr * g[bj][n]; q += (xn[n][0] * xn[n][0] + xn[n][1] * xn[n][1]) + (xn[n][2] * xn[n][2] + xn[n][3] * xn[n][3]); }
                    if (LAST) { *(f32x4*)(outf + off + bj * HALF) = xn[0]; *(f32x4*)(outf + off + bj * HALF + 4) = xn[1]; }
                    else *(u32x4*)(X + off + bj * HALF) = pk8(xn[0], xn[1]); }
                if (!LAST) { q = epi_sum4fq(q); if (fq == 0) P[rl * 4 + wc] = q; } } }
        if (!LAST) {
            asm volatile("s_waitcnt lgkmcnt(0)" ::: "memory"); __builtin_amdgcn_s_barrier(); asm volatile("" ::: "memory");
            if (lane < 32) { const f32x4 p = *(const PG8_LAS f32x4*)(P + row * 4); ssq2[((size_t)(u.pm * BM + row)) * 4 + u.pn] = (p[0] + p[1]) + (p[2] + p[3]); }
        }
    }
};
struct OrdOrder {
    StaticOrder base;
    __device__ __forceinline__ bool next(int i, Unit& u) const { const bool ok = base.next(i, u); u.idx = i; return ok; }
    __device__ __forceinline__ void a_ready(const Unit&) const {}
    __device__ __forceinline__ void done(const Unit&) const {}
};
__device__ __forceinline__ void rowstat_table(const OrdOrder& S, const float* ssq, PG8_LAS float* tab, int nunits) {
    int tid = threadIdx.x; asm volatile("" : "+v"(tid));
    for (int e = tid; e < nunits * 256; e += 512) { Unit u; S.next(e >> 8, u); const f32x4 p = *(const f32x4*)(ssq + (size_t)(u.pm * BM + (e & 255)) * 4); tab[e] = ((p[0] + p[1]) + (p[2] + p[3])) * (1.f / DM) + RMS_EPS; }
    __syncthreads();
}
struct HotOrder {
    int n, c;
    __device__ __forceinline__ bool next(int i, Unit& u) const { if (i >= n) return false; u.pm = c & 7; u.pn = (c >> 3) & 3; return true; }
    __device__ __forceinline__ void a_ready(const Unit&) const {}
    __device__ __forceinline__ void done(const Unit&) const {}
};
struct OneRound {
    StaticOrder base; int round;
    __device__ __forceinline__ bool next(int i, Unit& u) const { return i == 0 && base.next(round, u); }
    __device__ __forceinline__ void a_ready(const Unit&) const {}
    __device__ __forceinline__ void done(const Unit&) const {}
};
struct EpiF32 {
    static constexpr bool PERM = false, AFTER_DRAIN = false;
    float* Y; int ldc;
    __device__ __forceinline__ void operator()(const f32x4 (&acc)[2][2][4][2], const Unit& u, int wr, int wc, int fr, int fq) const {
        const int row0 = u.pm * BM + wr * 64 + fr, col0 = u.pn * BM + wc * 32 + 4 * fq;
#pragma unroll
        for (int ai = 0; ai < 2; ++ai)
#pragma unroll
            for (int m = 0; m < 4; ++m) { float* rowp = Y + (size_t)(row0 + ai * HALF + m * 16) * ldc + col0;
#pragma unroll
                for (int bj = 0; bj < 2; ++bj)
#pragma unroll
                    for (int n = 0; n < 2; ++n) *(f32x4*)(rowp + bj * HALF + n * 16) = acc[ai][bj][m][n]; }
    }
};
struct EpiProjOdd {
    static constexpr bool PERM = true, AFTER_DRAIN = false;
    bf16_t* Q; const PG8_LAS float* tab;
    __device__ __forceinline__ void operator()(const f32x4 (&acc)[2][2][4][2], const Unit& u, int wr, int wc, int fr, int fq) const {
        const int t = u.pn >> 2; bf16_t* base = Q + (size_t)t * ((size_t)MROWS * DM); const float sc = t == 0 ? QSCALE : 1.f;
        const int row0 = u.pm * BM + wr * 64 + fr, col0 = (u.pn & 3) * BM + wc * 32 + 8 * fq;
        float sc8[2][4];
#pragma unroll
        for (int ai = 0; ai < 2; ++ai)
#pragma unroll
            for (int m = 0; m < 4; ++m) sc8[ai][m] = __builtin_amdgcn_rsqf(tab[u.idx * 256 + ai * HALF + wr * 64 + m * 16 + fr]);
#pragma unroll
        for (int ai = 0; ai < 2; ++ai)
#pragma unroll
            for (int m = 0; m < 4; ++m) { const int row = row0 + ai * HALF + m * 16; const float s = sc8[ai][m] * sc;
#pragma unroll
                for (int bj = 0; bj < 2; ++bj) *(u32x4*)(base + (size_t)row * DM + col0 + bj * HALF) = pk8(acc[ai][bj][m][0] * s, acc[ai][bj][m][1] * s); }
    }
};
struct EpiProjEven {
    static constexpr bool PERM = true, AFTER_DRAIN = false;
    bf16_t *R1, *IQ, *IK; float* IW; const PG8_LAS float* tab;
    const float *c64, *s64, *c32, *s32;
    __device__ __forceinline__ void operator()(const f32x4 (&acc)[2][2][4][2], const Unit& u, int wr, int wc, int fr, int fq) const {
        const int pn = u.pn, row0 = u.pm * BM + wr * 64 + fr;
        float sc8[2][4];
#pragma unroll
        for (int ai = 0; ai < 2; ++ai)
#pragma unroll
            for (int m = 0; m < 4; ++m) sc8[ai][m] = __builtin_amdgcn_rsqf(tab[u.idx * 256 + ai * HALF + wr * 64 + m * 16 + fr]);
        if (pn == 4 || pn == 5 || pn == 10 || pn == 11) {
            bf16_t* base = R1 + (size_t)(pn >> 1) * ((size_t)MROWS * 512); const int col0 = (pn & 1) * BM + wc * 32 + 8 * fq;
#pragma unroll
            for (int ai = 0; ai < 2; ++ai)
#pragma unroll
                for (int m = 0; m < 4; ++m) { const int row = row0 + ai * HALF + m * 16; const float s = sc8[ai][m];
#pragma unroll
                    for (int bj = 0; bj < 2; ++bj) *(u32x4*)(base + (size_t)row * 512 + col0 + bj * HALF) = pk8(acc[ai][bj][m][0] * s, acc[ai][bj][m][1] * s); }
        } else if (pn < 12) {
            bf16_t* base = R1 + (size_t)(pn >> 1) * ((size_t)MROWS * 512);
            const float sc = (pn < 2 || pn == 6 || pn == 7) ? QSCALE : 1.f;
            const int head = 4 * (pn & 1) + wc, d0 = 8 * fq;
#pragma unroll
            for (int aim = 0; aim < 4; ++aim) { const int ai = aim >> 1;
                f32x4 ct[2][2], st[2][2];
#pragma unroll
                for (int mm = 0; mm < 2; ++mm) { const int pos = (row0 + ai * HALF + (2 * (aim & 1) + mm) * 16) & (SEQ - 1);
#pragma unroll
                    for (int n = 0; n < 2; ++n) { ct[mm][n] = *(const f32x4*)(c64 + pos * 32 + d0 + 4 * n); st[mm][n] = *(const f32x4*)(s64 + pos * 32 + d0 + 4 * n); } }
#pragma unroll
                for (int mm = 0; mm < 2; ++mm) { const int m = 2 * (aim & 1) + mm; const int row = row0 + ai * HALF + m * 16; const float s = sc8[ai][m] * sc;
                    f32x4 o1[2], o2[2];
#pragma unroll
                    for (int n = 0; n < 2; ++n) { const f32x4 cc = ct[mm][n], ss = st[mm][n];
                        const f32x4 x1 = acc[ai][0][m][n] * s, x2 = acc[ai][1][m][n] * s; o1[n] = x1 * cc - x2 * ss; o2[n] = x2 * cc + x1 * ss; }
                    bf16_t* dst = base + (size_t)row * 512 + head * 64 + d0;
                    *(u32x4*)dst = pk8(o1[0], o1[1]); *(u32x4*)(dst + 32) = pk8(o2[0], o2[1]); } }
        } else if (pn == 12) {
            const int head = 2 * wc + (fq >> 1), d0 = 8 * (fq & 1);
#pragma unroll
            for (int ai = 0; ai < 2; ++ai)
#pragma unroll
                for (int m = 0; m < 4; ++m) { const int row = row0 + ai * HALF + m * 16, pos = row & (SEQ - 1); const float s = sc8[ai][m];
                    f32x4 o1[2], o2[2];
#pragma unroll
                    for (int n = 0; n < 2; ++n) { const f32x4 cc = *(const f32x4*)(c32 + pos * 16 + d0 + 4 * n), ss = *(const f32x4*)(s32 + pos * 16 + d0 + 4 * n);
                        const f32x4 x1 = acc[ai][0][m][n] * s, x2 = acc[ai][1][m][n] * s; o1[n] = x1 * cc - x2 * ss; o2[n] = x2 * cc + x1 * ss; }
                    bf16_t* dst = IQ + (size_t)row * 256 + head * 32 + d0;
                    *(u32x4*)dst = pk8(o1[0], o1[1]); *(u32x4*)(dst + 16) = pk8(o2[0], o2[1]); }
        } else {
            if (wc == 0 && fq < 2) {
                const int d0 = 8 * fq;
#pragma unroll
                for (int ai = 0; ai < 2; ++ai)
#pragma unroll
                    for (int m = 0; m < 4; ++m) { const int row = row0 + ai * HALF + m * 16, pos = row & (SEQ - 1); const float s = sc8[ai][m];
                        f32x4 o1[2], o2[2];
#pragma unroll
                        for (int n = 0; n < 2; ++n) { const f32x4 cc = *(const f32x4*)(c32 + pos * 16 + d0 + 4 * n), ss = *(const f32x4*)(s32 + pos * 16 + d0 + 4 * n);
                            const f32x4 x1 = acc[ai][0][m][n] * s, x2 = acc[ai][1][m][n] * s; o1[n] = x1 * cc - x2 * ss; o2[n] = x2 * cc + x1 * ss; }
                        bf16_t* dst = IK + (size_t)row * 32 + d0;
                        *(u32x4*)dst = pk8(o1[0], o1[1]); *(u32x4*)(dst + 16) = pk8(o2[0], o2[1]); }
            } else if (wc == 0 && fq == 2) {
#pragma unroll
                for (int ai = 0; ai < 2; ++ai)
#pragma unroll
                    for (int m = 0; m < 4; ++m) { const int row = row0 + ai * HALF + m * 16; const float s = sc8[ai][m] * 0.0625f;
                        *(f32x4*)(IW + (size_t)row * 8) = acc[ai][0][m][0] * s; *(f32x4*)(IW + (size_t)row * 8 + 4) = acc[ai][0][m][1] * s; }
            }
        }
    }
};
}

namespace att {
#define ALAS __attribute__((address_space(3)))
typedef unsigned short bf16_t;
typedef short bf16x8 __attribute__((ext_vector_type(8)));
typedef short s16x4 __attribute__((ext_vector_type(4)));
typedef float f32x16 __attribute__((ext_vector_type(16)));
typedef float f32x4 __attribute__((ext_vector_type(4)));
typedef unsigned u32x4 __attribute__((ext_vector_type(4)));
typedef short v4i16_t __attribute__((ext_vector_type(4)));
__device__ __forceinline__ int crow(int r, int hi) { return (r & 3) + 8 * (r >> 2) + 4 * hi; }
__device__ __forceinline__ unsigned cvtpk(float lo, float hi) { typedef float f2_t __attribute__((ext_vector_type(2))); typedef __bf16 b2_t __attribute__((ext_vector_type(2)));
    f2_t v = {lo, hi}; b2_t b = __builtin_convertvector(v, b2_t); return __builtin_bit_cast(unsigned, b); }
__device__ __forceinline__ s16x4 vtr(const ALAS unsigned char* p) { return __builtin_bit_cast(s16x4, __builtin_amdgcn_ds_read_tr16_b64_v4i16((ALAS v4i16_t*)p)); }
__device__ __forceinline__ float halfswap_max(float m) { auto rr = __builtin_amdgcn_permlane32_swap(__float_as_uint(m), __float_as_uint(m), false, false); return fmaxf(__uint_as_float(rr[0]), __uint_as_float(rr[1])); }
__device__ __forceinline__ float halfswap_sum(float m) { auto rr = __builtin_amdgcn_permlane32_swap(__float_as_uint(m), __float_as_uint(m), false, false); return __uint_as_float(rr[0]) + __uint_as_float(rr[1]); }

template <int DV> struct Lds {
#ifndef ATT_QLDS128
#define ATT_QLDS128 0
#endif
#ifndef ATT_R64
#define ATT_R64 4
#endif
    static constexpr int R = (DV == 64) ? ATT_R64 : 3, D = R - 1;
    static constexpr int KB = 8192, VB = DV * 128;
    static constexpr int OFF_K = 0, OFF_V = R * KB, OFF_MW = OFF_V + R * VB, OFF_WSF = OFF_MW + 8 * R * 256, OFF_BT = OFF_WSF + 8 * 256, OFF_OST = OFF_BT + 10240, OST_W = 4096, TOTAL = OFF_OST + 8 * OST_W;
};
__device__ __forceinline__ void glds16(const void* gsrc, unsigned lds_dst) { unsigned keep;
    asm volatile("s_mov_b32 %0, m0\n\ts_mov_b32 m0, %2\n\ts_nop 0\n\tglobal_load_lds_dwordx4 %1, off\n\ts_mov_b32 m0, %0" : "=&s"(keep) : "v"(gsrc), "s"(lds_dst) : "memory"); }
__device__ __forceinline__ void glds4(const void* gsrc, unsigned lds_dst) { unsigned keep;
    asm volatile("s_mov_b32 %0, m0\n\ts_mov_b32 m0, %2\n\ts_nop 0\n\tglobal_load_lds_dword %1, off\n\ts_mov_b32 m0, %0" : "=&s"(keep) : "v"(gsrc), "s"(lds_dst) : "memory"); }

template <int DV, int MODE, int THR>
__device__ __forceinline__ void attn_core(f32x16 (&o)[DV / 32], ALAS unsigned char* lds,
                                          const bf16_t* Qw, int ldq, const bf16_t* Kh, int ldk, const bf16_t* Vh, int ldv,
                                          int T0, int T1, int tw0, int tw1,
                                          const unsigned long long* maskrow, int qpos, int qchunk, int att_probe_hotmask = -1, int att_probe_skip = 0,
                                          const bf16_t* nKh = nullptr, const bf16_t* nVh = nullptr, const unsigned long long* nmask = nullptr, int nT0 = 0, int nT1 = 0, int pre_in = 0, int* pre_out = nullptr) {
    typedef Lds<DV> L; constexpr int NDB = DV / 32, NVP = DV / 64, R = L::R, D = L::D, NDMA = 1 + NVP + (MODE == 1 ? 1 : 0);
    int tid = threadIdx.x; asm volatile("" : "+v"(tid));
    const int lane = tid & 63, r32 = lane & 31, hi = lane >> 5; const int wid = __builtin_amdgcn_readfirstlane(tid >> 6);
    ALAS float* wsf = (ALAS float*)(lds + L::OFF_WSF) + wid * 64;
    const ALAS float* btab = (const ALAS float*)(lds + L::OFF_BT);
    constexpr bool QLDS = (DV == 128 && ATT_QLDS128);
    ALAS unsigned char* qst = lds + L::OFF_OST + wid * L::OST_W + lane * 16;
    bf16x8 qr[4];
#pragma unroll
    for (int d0 = 0; d0 < 4; ++d0) { qr[d0] = *(const bf16x8*)(Qw + (size_t)r32 * ldq + d0 * 16 + hi * 8); if (QLDS) *(ALAS bf16x8*)(qst + d0 * 1024) = qr[d0]; }
    const int krow = 8 * wid + (lane >> 3), kkey = krow ^ ((krow >> 3) & 1), kch = (lane & 7) ^ (kkey & 7);
    const bf16_t* ksrc = Kh + (size_t)kkey * ldk + kch * 8;
    const bf16_t* vsrc = Vh + (size_t)(16 * (wid & 3) + (lane >> 2)) * ldv + 32 * (wid >> 2) + 8 * (lane & 3);
    const unsigned* msrc = (const unsigned*)maskrow + hi;
    const unsigned lds0 = (unsigned)(__SIZE_TYPE__)lds;
    const unsigned kdst = lds0 + L::OFF_K + wid * 1024, vdst = lds0 + L::OFF_V + (wid >> 2) * 4096 + (wid & 3) * 1024, mdstb = lds0 + L::OFF_MW + wid * (R * 256);
    ALAS unsigned char* mdst = lds + L::OFF_MW + wid * (R * 256);
#define ATT_U(x) ((unsigned)__builtin_amdgcn_readfirstlane((int)(x)))
#define ATT_TT(t) (T0 + (((t) - T0) & att_probe_hotmask))
#define ATT_DMA_K(t, sl) glds16(ksrc + (size_t)ATT_TT(t) * 64 * ldk, ATT_U(kdst + (sl) * L::KB))
#define ATT_DMA_V(t, sl) do { glds16(vsrc + (size_t)ATT_TT(t) * 64 * ldv, ATT_U(vdst + (sl) * L::VB)); if (NVP == 2) glds16(vsrc + (size_t)ATT_TT(t) * 64 * ldv + 64, ATT_U(vdst + (sl) * L::VB + 8192)); \
                              if (MODE == 1) glds4(msrc + 2 * (t), ATT_U(mdstb + (sl) * 256)); } while (0)
    int kfo[4];
#pragma unroll
    for (int d0 = 0; d0 < 4; ++d0) kfo[d0] = (r32 ^ ((r32 >> 3) & 1)) * 128 + (((2 * d0 + hi) ^ (r32 & 7)) * 16);
#define ATT_QK(P0, P1, t, ks) do { \
        if (MODE == 2) { const int jrel_ = qchunk - (t); \
            if (jrel_ >= 5) { const float bc_ = btab[638]; _Pragma("unroll") for (int r = 0; r < 16; ++r) { P0[r] = bc_; P1[r] = bc_; } } \
            else { const int bq_ = qpos - 64 * (t) + 60 - 4 * hi, sh_ = bq_ & 3;     \
                const ALAS float* bp_ = btab + sh_ * 640 + (bq_ - sh_ - 56); \
                _Pragma("unroll") for (int g = 0; g < 4; ++g) { const f32x4 v0_ = *(const ALAS f32x4*)(bp_ + 56 - 8 * g), v1_ = *(const ALAS f32x4*)(bp_ + 24 - 8 * g); \
                    _Pragma("unroll") for (int j = 0; j < 4; ++j) { P0[4 * g + j] = v0_[3 - j]; P1[4 * g + j] = v1_[3 - j]; } } } \
        } else { P0 = f32x16{}; P1 = f32x16{}; } \
        const ALAS unsigned char* kb_ = lds + L::OFF_K + (ks) * L::KB; \
        _Pragma("unroll") for (int d0 = 0; d0 < 4; ++d0) { const bf16x8 b0_ = *(const ALAS bf16x8*)(kb_ + kfo[d0]), b1_ = *(const ALAS bf16x8*)(kb_ + kfo[d0] + 4096); \
            const bf16x8 q_ = QLDS ? *(const ALAS bf16x8*)(qst + d0 * 1024) : qr[d0]; \
            P0 = __builtin_amdgcn_mfma_f32_32x32x16_bf16(b0_, q_, P0, 0, 0, 0); P1 = __builtin_amdgcn_mfma_f32_32x32x16_bf16(b1_, q_, P1, 0, 0, 0); } } while (0)
#define ATT_QK_INIT(P0, P1, t) do { \
        if (MODE == 2) { const int jrel_ = qchunk - (t); \
            if (jrel_ >= 5) { const float bc_ = btab[638]; _Pragma("unroll") for (int r = 0; r < 16; ++r) { P0[r] = bc_; P1[r] = bc_; } } \
            else { const int bq_ = qpos - 64 * (t) + 60 - 4 * hi, sh_ = bq_ & 3;     \
                const ALAS float* bp_ = btab + sh_ * 640 + (bq_ - sh_ - 56); \
                _Pragma("unroll") for (int g = 0; g < 4; ++g) { const f32x4 v0_ = *(const ALAS f32x4*)(bp_ + 56 - 8 * g), v1_ = *(const ALAS f32x4*)(bp_ + 24 - 8 * g); \
                    _Pragma("unroll") for (int j = 0; j < 4; ++j) { P0[4 * g + j] = v0_[3 - j]; P1[4 * g + j] = v1_[3 - j]; } } } \
        } else { P0 = f32x16{}; P1 = f32x16{}; } } while (0)
#define ATT_QK_HALF(P0, P1, kb_, dlo) do { \
        _Pragma("unroll") for (int d0 = (dlo); d0 < (dlo) + 2; ++d0) { const bf16x8 b0_ = *(const ALAS bf16x8*)((kb_) + kfo[d0]), b1_ = *(const ALAS bf16x8*)((kb_) + kfo[d0] + 4096); \
            const bf16x8 q_ = QLDS ? *(const ALAS bf16x8*)(qst + d0 * 1024) : qr[d0]; \
            P0 = __builtin_amdgcn_mfma_f32_32x32x16_bf16(b0_, q_, P0, 0, 0, 0); P1 = __builtin_amdgcn_mfma_f32_32x32x16_bf16(b1_, q_, P1, 0, 0, 0); } } while (0)
    constexpr int NV = NDMA - 1;
#define ATT_CK(j) (((j) <= T0 + D) ? ((j) - T0) * NDMA + 1 : ((j) - 1 - T0) * NDMA + 2)
#define ATT_CV(j) (((j) < T0 + D) ? ((j) - T0 + 1) * NDMA : ((j) - T0) * NDMA + 2 + NV)
#define ATT_WAIT_BAR_N(n_) do { const int nn_ = (n_); \
        if (nn_ <= 0) asm volatile("s_waitcnt vmcnt(0) lgkmcnt(0)\n\ts_barrier" ::: "memory"); \
        else if (nn_ == 1) asm volatile("s_waitcnt vmcnt(1) lgkmcnt(0)\n\ts_barrier" ::: "memory"); \
        else if (nn_ == 2) asm volatile("s_waitcnt vmcnt(2) lgkmcnt(0)\n\ts_barrier" ::: "memory"); \
        else if (nn_ == 3) asm volatile("s_waitcnt vmcnt(3) lgkmcnt(0)\n\ts_barrier" ::: "memory"); \
        else if (nn_ == 4) asm volatile("s_waitcnt vmcnt(4) lgkmcnt(0)\n\ts_barrier" ::: "memory"); \
        else if (nn_ == 5) asm volatile("s_waitcnt vmcnt(5) lgkmcnt(0)\n\ts_barrier" ::: "memory"); \
        else if (nn_ == 6) asm volatile("s_waitcnt vmcnt(6) lgkmcnt(0)\n\ts_barrier" ::: "memory"); \
        else if (nn_ == 7) asm volatile("s_waitcnt vmcnt(7) lgkmcnt(0)\n\ts_barrier" ::: "memory"); \
        else if (nn_ == 8) asm volatile("s_waitcnt vmcnt(8) lgkmcnt(0)\n\ts_barrier" ::: "memory"); \
        else if (nn_ == 9) asm volatile("s_waitcnt vmcnt(9) lgkmcnt(0)\n\ts_barrier" ::: "memory"); \
        else if (nn_ == 10) asm volatile("s_waitcnt vmcnt(10) lgkmcnt(0)\n\ts_barrier" ::: "memory"); \
        else if (nn_ == 11) asm volatile("s_waitcnt vmcnt(11) lgkmcnt(0)\n\ts_barrier" ::: "memory"); \
        else asm volatile("s_waitcnt vmcnt(12) lgkmcnt(0)\n\ts_barrier" ::: "memory"); } while (0)
#define ATT_END_STEP(t) do { int need_ = 0; if ((t) + 2 < T1) need_ = ATT_CK((t) + 2); if ((t) + 1 < T1) { const int cv_ = ATT_CV((t) + 1); need_ = cv_ > need_ ? cv_ : need_; } \
        ATT_WAIT_BAR_N(need_ ? n_issued - need_ : 0); } while (0)
    int n_issued = 0;
#ifdef ATT_PRIO
    if (wid >= 4) __builtin_amdgcn_s_setprio(1);
#endif
    float m_run = -1e30f, l_part = 0.f;
#pragma unroll
    for (int d0 = 0; d0 < NDB; ++d0) o[d0] = f32x16{};
    if (pre_in > 0) n_issued = pre_in;
    else {
#pragma unroll
        for (int i = 0; i <= D; ++i) { if (T0 + i < T1) { ATT_DMA_K(T0 + i, i); n_issued += 1; } if (i < D && T0 + i < T1) { ATT_DMA_V(T0 + i, i); n_issued += NV; } }
    }
    ATT_WAIT_BAR_N(n_issued - 1);
    f32x16 pc0, pc1, pn0, pn1;
    pc0 = f32x16{}; pc1 = f32x16{}; pn0 = f32x16{}; pn1 = f32x16{};
    if (tw0 == T0) { ATT_QK(pc0, pc1, T0, 0); }
    ATT_END_STEP(T0 - 1);
    int sk = 1 % R, sv = 0, si_k = 0, si_v = D % R;
    for (int t = T0; t < T1; ++t) {
        const bool steady = (t + 1 + D < T1);
        if (steady) { ATT_DMA_K(t + 1 + D, si_k); n_issued += 1; }
        if (t + D < T1) { ATT_DMA_V(t + D, si_v); n_issued += NV; }
        const bool act = (t >= tw0 && t < tw1), nxt = (t + 1 >= tw0 && t + 1 < tw1);
        if (nxt && !act) { ATT_QK(pn0, pn1, t + 1, sk); }
        if (act) {
            const ALAS unsigned char* kbn_ = lds + L::OFF_K + sk * L::KB;
            if (nxt) { ATT_QK_INIT(pn0, pn1, t + 1); ATT_QK_HALF(pn0, pn1, kbn_, 0); }
            if (MODE == 1) { const ALAS unsigned* mp = (const ALAS unsigned*)(mdst + sv * 256); const unsigned w0 = mp[r32] >> (4 * hi), w1 = mp[32 + r32] >> (4 * hi);
#pragma unroll
                for (int r = 0; r < 16; ++r) { const int sh = 31 - ((r & 3) + 8 * (r >> 2));
                    const unsigned m0 = (unsigned)(((int)(w0 << sh)) >> 31), m1 = (unsigned)(((int)(w1 << sh)) >> 31);
                    pc0[r] = __uint_as_float((__float_as_uint(pc0[r]) & m0) | (0xff800000u & ~m0)); pc1[r] = __uint_as_float((__float_as_uint(pc1[r]) & m1) | (0xff800000u & ~m1)); } }
            float mx = fmaxf(fmaxf(pc0[0], pc1[0]), pc0[1]);
#pragma unroll
            for (int r = 1; r < 16; ++r) mx = (r == 1) ? fmaxf(mx, pc1[1]) : fmaxf(fmaxf(mx, pc0[r]), pc1[r]);
            mx = halfswap_max(mx);
            if (__any(mx > m_run + (float)THR)) {
                const float mnew = fmaxf(m_run, mx); const float f = __builtin_amdgcn_exp2f(m_run - mnew);
                l_part *= f; m_run = mnew; if (hi == 0) wsf[r32] = f;
#pragma unroll
                for (int r = 0; r < 16; ++r) { const float fr_ = wsf[crow(r, hi)];
#pragma unroll
                    for (int d0 = 0; d0 < NDB; ++d0) o[d0][r] *= fr_; }
            }
            if (nxt) { ATT_QK_HALF(pn0, pn1, kbn_, 2); }
            float sa = 0.f, sb = 0.f;
#pragma unroll
            for (int r = 0; r < 16; ++r) { pc0[r] = __builtin_amdgcn_exp2f(pc0[r] - m_run); pc1[r] = __builtin_amdgcn_exp2f(pc1[r] - m_run); sa += pc0[r]; sb += pc1[r]; }
            l_part += sa + sb;
            u32x4 pw[4];
#pragma unroll
            for (int k = 0; k < 2; ++k)
#pragma unroll
                for (int j = 0; j < 4; ++j) { pw[k][j] = cvtpk(pc0[8 * k + 2 * j], pc0[8 * k + 2 * j + 1]); pw[2 + k][j] = cvtpk(pc1[8 * k + 2 * j], pc1[8 * k + 2 * j + 1]); }
            const ALAS unsigned char* vb = lds + L::OFF_V + sv * L::VB + ((lane >> 4) & 1) * 32 + (lane & 3) * 8 + (4 * hi + ((lane & 15) >> 2)) * 64;
#pragma unroll
            for (int d0 = 0; d0 < NDB; ++d0)
#pragma unroll
                for (int ks = 0; ks < 4; ++ks) { const s16x4 lo = vtr(vb + d0 * 4096 + ks * 1024), up = vtr(vb + d0 * 4096 + ks * 1024 + 512);
                    const bf16x8 vf = (bf16x8){lo[0], lo[1], lo[2], lo[3], up[0], up[1], up[2], up[3]};
                    o[d0] = __builtin_amdgcn_mfma_f32_32x32x16_bf16(__builtin_bit_cast(bf16x8, pw[ks]), vf, o[d0], 0, 0, 0); }
        }
        pc0 = pn0; pc1 = pn1;
        sk = (sk + 1 == R) ? 0 : sk + 1; sv = (sv + 1 == R) ? 0 : sv + 1; si_k = (si_k + 1 == R) ? 0 : si_k + 1; si_v = (si_v + 1 == R) ? 0 : si_v + 1;
        ATT_END_STEP(t);
    }
    if (pre_out) {
        int cnt_ = 0;
        if (nT1 > nT0) {
            const bf16_t* ksrc0_ = ksrc; const bf16_t* vsrc0_ = vsrc; const unsigned* msrc0_ = msrc;
            ksrc = ksrc0_ + (nKh - Kh); vsrc = vsrc0_ + (nVh - Vh); msrc = (const unsigned*)nmask + hi;
            { const int T0 = nT0, T1 = nT1;
#pragma unroll
              for (int i = 0; i <= D; ++i) { if (T0 + i < T1) { ATT_DMA_K(T0 + i, i); cnt_ += 1; } if (i < D && T0 + i < T1) { ATT_DMA_V(T0 + i, i); cnt_ += NV; } } }
            ksrc = ksrc0_; vsrc = vsrc0_; msrc = msrc0_;
        }
        *pre_out = cnt_;
    }
#undef ATT_U
#undef ATT_TT
#undef ATT_DMA_K
#undef ATT_DMA_V
#undef ATT_QK
#undef ATT_QK_INIT
#undef ATT_QK_HALF
#undef ATT_CK
#undef ATT_CV
#undef ATT_WAIT_BAR_N
#undef ATT_END_STEP
#ifdef ATT_PRIO
    __builtin_amdgcn_s_setprio(0);
#endif
    const float l = halfswap_sum(l_part);
    if (hi == 0) wsf[32 + r32] = l;
#pragma unroll
    for (int r = 0; r < 16; ++r) { const float rl = 1.0f / wsf[32 + crow(r, hi)];
#pragma unroll
        for (int d0 = 0; d0 < NDB; ++d0) o[d0][r] *= rl; }
}

template <int DV>
__device__ __forceinline__ void store_o(const f32x16 (&o)[DV / 32], ALAS unsigned char* lds, bf16_t* dst, int ldo) {
    typedef Lds<DV> L;
    int tid = threadIdx.x; asm volatile("" : "+v"(tid));
    const int lane = tid & 63, r32 = lane & 31, hi = lane >> 5; const int wid = __builtin_amdgcn_readfirstlane(tid >> 6);
    ALAS bf16_t* stg = (ALAS bf16_t*)(lds + L::OFF_OST + wid * L::OST_W);
#pragma unroll
    for (int h = 0; h < DV / 64; ++h) {
#pragma unroll
        for (int r = 0; r < 16; ++r) { const int orow = crow(r, hi);
#pragma unroll
            for (int d0 = 0; d0 < 2; ++d0) stg[orow * 64 + d0 * 32 + r32] = (bf16_t)(cvtpk(o[2 * h + d0][r], 0.f) & 0xffffu); }
#pragma unroll
        for (int i = 0; i < 4; ++i) { const int row = i * 8 + (lane >> 3), ch = lane & 7; const u32x4 v = *(const ALAS u32x4*)(stg + row * 64 + ch * 8); *(u32x4*)(dst + (size_t)row * ldo + h * 64 + ch * 8) = v; }
    }
}
}
#define GAS __attribute__((address_space(1)))
#define LAS __attribute__((address_space(3)))
typedef unsigned short bf16;
typedef unsigned v4u __attribute__((ext_vector_type(4)));
typedef float f32x4 __attribute__((ext_vector_type(4)));
typedef short bf16x8 __attribute__((ext_vector_type(8)));
typedef GAS unsigned gu32;
typedef GAS unsigned long long gu64;
#define RLX_AGENT __ATOMIC_RELAXED, __HIP_MEMORY_SCOPE_AGENT
#define LDS_WAIT() asm volatile("s_waitcnt lgkmcnt(0)" ::: "memory")
#define VM_WAIT() asm volatile("s_waitcnt vmcnt(0)" ::: "memory")
__device__ __forceinline__ unsigned long long rt() { return __builtin_amdgcn_s_memrealtime(); }
__device__ __forceinline__ unsigned f2bf(float f) { unsigned u = __builtin_bit_cast(unsigned, f); return (u + 0x7fffu + ((u >> 16) & 1u)) >> 16; }
__device__ __forceinline__ unsigned pk2(float lo, float hi) { return f2bf(lo) | (f2bf(hi) << 16); }

#define XB_TMO      128
#define XB_XCNT(j)  (256  + 64 * (j))
#define XB_XSUB(j)  (1280 + 64 * (j))
#define XB_XGEN(j)  (2304 + 64 * (j))
#define XB_TOP      3328
#define XB_TOPGEN   3392
#define XCD_BAR_WORDS 3456
#define XB_SPIN_CAP (1u << 18)

__device__ __forceinline__ unsigned xb_ld(unsigned* p)              { return __hip_atomic_load(p, __ATOMIC_RELAXED, __HIP_MEMORY_SCOPE_AGENT); }
__device__ __forceinline__ unsigned xb_add(unsigned* p, unsigned v) { return __hip_atomic_fetch_add(p, v, __ATOMIC_RELAXED, __HIP_MEMORY_SCOPE_AGENT); }
__device__ __forceinline__ unsigned xb_xcc_id() { return (unsigned)__builtin_amdgcn_s_getreg((3 << 11) | 20) & 0xFu; }
#define XB_SPIN(cond, bar) do { unsigned _sp = 0; while (cond) { __builtin_amdgcn_s_sleep(1); \
    if ((++_sp & 255u) == 0u) { if (xb_ld(&(bar)[XB_TMO])) break; if (_sp > XB_SPIN_CAP) { atomicAdd(&(bar)[XB_TMO], 1u); break; } } } } while (0)

struct XcdBarrier {
    unsigned* bar; unsigned x;
    volatile LAS unsigned* st;
};

__device__ __forceinline__ XcdBarrier xcd_barrier_post(unsigned* bar, volatile LAS unsigned* st) {
    XcdBarrier b; b.bar = bar; b.x = xb_xcc_id(); b.st = st;
    if (threadIdx.x == 0) (void)xb_add(&bar[XB_XCNT(b.x)], 1u);
    return b;
}
__device__ __forceinline__ void xcd_barrier_complete(unsigned* bar, unsigned x, unsigned& nloc, unsigned& nx) {
    const unsigned G = gridDim.x * gridDim.y * gridDim.z;
    unsigned sum, cnt, mine, sp = 0u;
    for (;;) {
        sum = 0u; cnt = 0u; mine = 0u;
#pragma unroll
        for (unsigned j = 0; j < 16; ++j) { const unsigned c = xb_ld(&bar[XB_XCNT(j)]); sum += c; cnt += (c > 0u) ? 1u : 0u; mine = (j == x) ? c : mine; }
        if (sum == G) break;
        __builtin_amdgcn_s_sleep(1);
        if ((++sp & 255u) == 0u) { if (xb_ld(&bar[XB_TMO])) break; if (sp > XB_SPIN_CAP) { atomicAdd(&bar[XB_TMO], 1u); break; } }
    }
    nloc = mine > 0u ? mine : 1u; nx = cnt > 0u ? cnt : 1u;
}

__device__ __forceinline__ void xcd_barrier(const XcdBarrier& b) {
    asm volatile("s_waitcnt vmcnt(0)" ::: "memory");
    __syncthreads();
    if (threadIdx.x == 0) {
        unsigned* bar = b.bar;
        __builtin_amdgcn_s_waitcnt(0);
        unsigned nloc = b.st[0], nx = b.st[1];
        if (nloc == 0u) { xcd_barrier_complete(bar, b.x, nloc, nx); b.st[0] = nloc; b.st[1] = nx; }
        const unsigned old = xb_add(&bar[XB_XSUB(b.x)], 1u);
        const unsigned gen = old / nloc;
        if (old + 1u == (gen + 1u) * nloc) {
            __builtin_amdgcn_fence(__ATOMIC_RELEASE, "agent");
            asm volatile("s_waitcnt vmcnt(0)" ::: "memory");
            const unsigned og = xb_add(&bar[XB_TOP], 1u);
            const unsigned tg = og / nx;
            if (og + 1u == (tg + 1u) * nx) xb_add(&bar[XB_TOPGEN], 1u);
            else XB_SPIN(xb_ld(&bar[XB_TOPGEN]) == tg, bar);
            __builtin_amdgcn_fence(__ATOMIC_ACQUIRE, "agent");
            xb_add(&bar[XB_XGEN(b.x)], 1u);
            asm volatile("s_waitcnt vmcnt(0)" ::: "memory");
        } else {
            XB_SPIN(xb_ld(&bar[XB_XGEN(b.x)]) == gen, bar);
            __builtin_amdgcn_fence(__ATOMIC_ACQUIRE, "agent");
            asm volatile("s_waitcnt vmcnt(0)" ::: "memory");
        }
    }
    __syncthreads();
}

constexpr int NWAVES = 8;
constexpr size_t MiB = 1u << 20;
constexpr size_t WS_CTL = 0, CTL_ZERO_BYTES = 2 * MiB;
constexpr size_t WS_GRAN = 1 * MiB;
constexpr size_t WS_C64 = 381 * MiB + 42 * MiB, WS_S64 = WS_C64 + 256 * 1024, WS_C32 = WS_C64 + 512 * 1024, WS_S32 = WS_C64 + 640 * 1024, WS_RS = WS_C64 + 768 * 1024;
constexpr size_t WS_WGU = 2 * MiB, WGU_BYTES = (size_t)NGU * DM * 2;
constexpr size_t WS_WD = 46 * MiB, WD_BYTES = (size_t)DM * FF * 2;
constexpr size_t WS_WIN0 = 68 * MiB, WS_WOUT0 = 75 * MiB, WS_WIN1 = 77 * MiB, WS_WOUT1 = 83 * MiB;
constexpr size_t WS_MASK = 85 * MiB;
constexpr size_t WS_XB = 93 * MiB;
constexpr size_t WS_R1 = 157 * MiB;
constexpr size_t WS_Y = 381 * MiB;
constexpr size_t WS_SSQ1 = WS_Y + 40 * MiB, WS_SSQ2 = WS_Y + 41 * MiB;
constexpr size_t WS_ATT = 445 * MiB;
constexpr size_t WS_END = 509 * MiB;
static_assert(WS_WGU + 4 * WGU_BYTES <= WS_WD && WS_WD + 4 * WD_BYTES <= WS_WIN0 && WS_WIN0 + (size_t)NEV * DM * 2 <= WS_WOUT0 && WS_WIN1 + (size_t)NOD * DM * 2 <= WS_WOUT1, "weight map");
static_assert(WS_R1 + (size_t)MROWS * FF * 2 <= WS_Y && WS_R1 + 211 * MiB <= WS_Y, "R1 map");
constexpr int CW_BAR = 4096, CW_TMO = 0, CW_SEAM = 16384, SEAM_BANK = 128 * 64;
constexpr int FUSED_LDS_OFF = 131072 + 1024;
constexpr int RING_BYTES = 131072, LDSCTL_OFF = RING_BYTES, MISC_OFF = LDSCTL_OFF + 320, LDS_BYTES = 147456;

struct Frame {
    LAS unsigned char* lds; volatile LAS unsigned* MISC; gu32* ctl;
    int tid, lane, wave, vcu, G;
};

template <int X> __device__ __forceinline__ float swz_xor(float v) { return __int_as_float(__builtin_amdgcn_ds_swizzle(__float_as_int(v), (X << 10) | 0x1f)); }
__device__ __forceinline__ float sum32(float v) { v += swz_xor<1>(v); v += swz_xor<2>(v); v += swz_xor<4>(v); v += swz_xor<8>(v); v += swz_xor<16>(v); return v; }
__device__ __forceinline__ float wave_sum(float v) { return att::halfswap_sum(sum32(v)); }
struct MapGUHalf { int bj; __device__ __forceinline__ int src(int R) const { return R; } __device__ __forceinline__ int dst(int R) const { return 256 * (R >> 7) + 128 * bj + (R & 127); } };
struct MapId { __device__ __forceinline__ int src(int R) const { return R; } __device__ __forceinline__ int dst(int R) const { return R; } };
__device__ __forceinline__ int even_src(int R) {
    const int pn = R >> 8, bj = (R >> 7) & 1, jj = R & 127;
    if (pn < 4) return (pn < 2 ? 0 : 512) + (4 * (pn & 1) + (jj >> 5)) * 64 + 32 * bj + (jj & 31);
    if (pn < 6) return 1024 + 256 * (pn - 4) + 128 * bj + jj;
    if (pn < 10) return (pn < 8 ? 1536 : 2048) + (4 * (pn & 1) + (jj >> 5)) * 64 + 32 * bj + (jj & 31);
    if (pn < 12) return 2560 + 256 * (pn - 10) + 128 * bj + jj;
    if (pn == 12) return 3072 + (jj >> 4) * 32 + 16 * bj + (jj & 15);
    if (jj < 16) return 3328 + 16 * bj + jj;
    if (bj == 0 && jj < 24) return 3360 + (jj - 16);
    return -1;
}
struct MapEven { __device__ __forceinline__ int src(int R) const { return even_src(R); } __device__ __forceinline__ int dst(int R) const { return R; } };
template <class Map>
__device__ __forceinline__ void transpose_item(const Map& mp, const float* W, int ldw, int K, int nrows, bf16* WT, const float* g, LAS float* scr, int item, int lane) {
    const int nblk = nrows / 32, kb = item / nblk, nb = item % nblk, k0 = 64 * kb, n0 = 32 * nb;
    const int nl = 4 * (lane & 7), kl = lane >> 3;
    const int sc0 = mp.src(n0 + nl); const float mul = sc0 >= 0 ? 1.f : 0.f; const float* src = W + (sc0 >= 0 ? sc0 : 0) + (size_t)(k0 + kl) * ldw;
    f32x4 v[8];
#pragma unroll
    for (int i = 0; i < 8; ++i) v[i] = *(const GAS f32x4*)(src + (size_t)(8 * i) * ldw);
#pragma unroll
    for (int i = 0; i < 8; ++i) { const int kk = 8 * i + kl; const float gm = g ? g[k0 + kk] * mul : mul;
        scr[kk * 33 + nl] = v[i].x * gm; scr[kk * 33 + nl + 1] = v[i].y * gm; scr[kk * 33 + nl + 2] = v[i].z * gm; scr[kk * 33 + nl + 3] = v[i].w * gm; }
    LDS_WAIT(); asm volatile("" ::: "memory");
    const int c = lane & 7;
#pragma unroll
    for (int j = 0; j < 4; ++j) { const int n = (lane >> 3) + 8 * j; const LAS float* s = scr + (8 * c) * 33 + n;
        v4u o; o.x = pk2(s[0 * 33], s[1 * 33]); o.y = pk2(s[2 * 33], s[3 * 33]); o.z = pk2(s[4 * 33], s[5 * 33]); o.w = pk2(s[6 * 33], s[7 * 33]);
        *(GAS v4u*)(WT + (size_t)mp.dst(n0 + n) * K + k0 + 8 * c) = o; }
    LDS_WAIT(); asm volatile("" ::: "memory");
}
__device__ __forceinline__ void sincos_d(double a, float& sn, float& cs) {
    const double k = __builtin_rint(a * 0.6366197723675814); const double y = a - k * 1.5707963267948966; const double y2 = y * y;
    const double s = y * (1.0 + y2 * (-1.0 / 6 + y2 * (1.0 / 120 + y2 * (-1.0 / 5040 + y2 * (1.0 / 362880 + y2 * (-1.0 / 39916800 + y2 * (1.0 / 6227020800.0)))))));
    const double c = 1.0 + y2 * (-0.5 + y2 * (1.0 / 24 + y2 * (-1.0 / 720 + y2 * (1.0 / 40320 + y2 * (-1.0 / 3628800 + y2 * (1.0 / 479001600.0 + y2 * (-1.0 / 87178291200.0)))))));
    const int q = (int)((long long)k & 3);
    const double ss = (q == 0) ? s : (q == 1) ? c : (q == 2) ? -s : -c, cc = (q == 0) ? c : (q == 1) ? -s : (q == 2) ? -c : s;
    sn = (float)ss; cs = (float)cc;
}
__device__ __forceinline__ void x_to_bf16_rows4(const float* x, bf16* xb, float* ssq, int m, int dm, int lane) {
    f32x4 v[4][4]; float s[4];
#pragma unroll
    for (int r = 0; r < 4; ++r) { const GAS f32x4* xr = (const GAS f32x4*)(x + (size_t)(m + r * dm) * DM) + lane;
#pragma unroll
        for (int j = 0; j < 4; ++j) v[r][j] = xr[64 * j]; }
#pragma unroll
    for (int r = 0; r < 4; ++r) { s[r] = 0.f; GAS unsigned long long* o8 = (GAS unsigned long long*)(xb + (size_t)(m + r * dm) * DM) + lane;
#pragma unroll
        for (int j = 0; j < 4; ++j) { s[r] += (v[r][j].x * v[r][j].x + v[r][j].y * v[r][j].y) + (v[r][j].z * v[r][j].z + v[r][j].w * v[r][j].w);
            o8[64 * j] = (unsigned long long)epi::pkbf(v[r][j].x, v[r][j].y) | ((unsigned long long)epi::pkbf(v[r][j].z, v[r][j].w) << 32); } }
#pragma unroll
    for (int r = 0; r < 4; ++r) s[r] = sum32(s[r]);
#pragma unroll
    for (int r = 0; r < 4; ++r) { const float t = att::halfswap_sum(s[r]); if (lane == 0) *(f32x4*)(ssq + (size_t)(m + r * dm) * 4) = (f32x4){t, 0.f, 0.f, 0.f}; }
}
__device__ __forceinline__ void bf8_to_f32(const v4u& w, float (&f)[8]) {
#pragma unroll
    for (int i = 0; i < 4; ++i) { f[2 * i] = __uint_as_float(w[i] << 16); f[2 * i + 1] = __uint_as_float(w[i] & 0xffff0000u); } }
template <bool LAST>
__device__ __forceinline__ void thin_row(const bf16* yrow, bf16* xrow, float* outf, const float* ga, float alpha, float* rs, int lane) {
    float y[2][8], x[2][8]; float s = 0.f;
#pragma unroll
    for (int j = 0; j < 2; ++j) { const v4u yw = *((const GAS v4u*)yrow + lane + 64 * j), xw = *((const GAS v4u*)xrow + lane + 64 * j); bf8_to_f32(yw, y[j]); bf8_to_f32(xw, x[j]);
#pragma unroll
        for (int i = 0; i < 8; ++i) s += y[j][i] * y[j][i]; }
    const float r1 = alpha / sqrtf(wave_sum(s) * (1.f / DM) + RMS_EPS); float s2 = 0.f;
#pragma unroll
    for (int j = 0; j < 2; ++j) { const f32x4 g0 = *((const GAS f32x4*)ga + 2 * lane + 128 * j), g1 = *((const GAS f32x4*)ga + 2 * lane + 128 * j + 1);
#pragma unroll
        for (int i = 0; i < 8; ++i) { const float g = i < 4 ? g0[i & 3] : g1[i & 3]; x[j][i] += y[j][i] * g * r1; s2 += x[j][i] * x[j][i]; }
        if (LAST) { *((GAS f32x4*)outf + 2 * lane + 128 * j) = (f32x4){x[j][0], x[j][1], x[j][2], x[j][3]}; *((GAS f32x4*)outf + 2 * lane + 128 * j + 1) = (f32x4){x[j][4], x[j][5], x[j][6], x[j][7]}; }
        else { v4u o; o.x = epi::pkbf(x[j][0], x[j][1]); o.y = epi::pkbf(x[j][2], x[j][3]); o.z = epi::pkbf(x[j][4], x[j][5]); o.w = epi::pkbf(x[j][6], x[j][7]); *((GAS v4u*)xrow + lane + 64 * j) = o; } }
    if (!LAST) { const float r2 = 1.0f / sqrtf(wave_sum(s2) * (1.f / DM) + RMS_EPS); if (lane == 0) *rs = r2; }
}

struct Ptrs {
    const float *x, *norm_g, *wg, *wu, *wd, *ewin, *ewout, *elam, *esub, *owin, *owout, *obias; float* out; unsigned char* ws;
};

__device__ __forceinline__ void p0_prologue(Frame& F0, const Ptrs& P) {
    struct { LAS unsigned char* lds; int tid, lane, wave, vcu, G; } F;
    { int t = threadIdx.x; asm volatile("" : "+v"(t)); F.lds = F0.lds; F.tid = t; F.lane = t & 63; F.wave = __builtin_amdgcn_readfirstlane(t >> 6); F.vcu = F0.vcu; F.G = F0.G; }
    LAS float* scr = (LAS float*)(F.lds + F.wave * 16384);
    const int gw = F.vcu * NWAVES + F.wave, NGW = F.G * NWAVES;
    constexpr int I_GH = (DM / 64) * (FF / 32), I_WD = (FF / 64) * (DM / 32), I_E = (DM / 64) * (NEV / 32), I_O = (DM / 64) * (DM / 32), I_OD = (DM / 64) * (NOD / 32);
    constexpr int NITEMS = 8 * I_GH + 4 * I_WD + I_E + I_O + I_OD + I_O;
    for (int it = gw; it < NITEMS; it += NGW) {
        int r = it;
        if (r < 8 * I_GH) { const int i8 = r / I_GH; r -= i8 * I_GH; const int i = i8 >> 1, bj = i8 & 1, l = i >> 1, f = i & 1;
            MapGUHalf mp{bj}; const float* W = (bj ? P.wu : P.wg) + (size_t)i * DM * FF;
            transpose_item(mp, W, FF, DM, FF, (bf16*)(P.ws + WS_WGU + i * WGU_BYTES), P.norm_g + (l * 6 + 4 * f) * DM, scr, r, F.lane); continue; }
        r -= 8 * I_GH;
        if (r < 4 * I_WD) { const int i = r / I_WD; r -= i * I_WD; MapId mp;
            transpose_item(mp, P.wd + (size_t)i * FF * DM, DM, FF, DM, (bf16*)(P.ws + WS_WD + i * WD_BYTES), nullptr, scr, r, F.lane); continue; }
        r -= 4 * I_WD;
        if (r < I_E) { MapEven mp; transpose_item(mp, P.ewin, 3368, DM, NEV, (bf16*)(P.ws + WS_WIN0), P.norm_g + (0 * 6 + 2) * DM, scr, r, F.lane); continue; }
        r -= I_E;
        if (r < I_O) { MapId mp; transpose_item(mp, P.ewout, DM, DM, DM, (bf16*)(P.ws + WS_WOUT0), nullptr, scr, r, F.lane); continue; }
        r -= I_O;
        if (r < I_OD) { MapId mp; transpose_item(mp, P.owin, NOD, DM, NOD, (bf16*)(P.ws + WS_WIN1), P.norm_g + (1 * 6 + 2) * DM, scr, r, F.lane); continue; }
        r -= I_OD;
        { MapId mp; transpose_item(mp, P.owout, DM, DM, DM, (bf16*)(P.ws + WS_WOUT1), nullptr, scr, r, F.lane); }
    }
    float* c64 = (float*)(P.ws + WS_C64); float* s64 = (float*)(P.ws + WS_S64); float* c32 = (float*)(P.ws + WS_C32); float* s32 = (float*)(P.ws + WS_S32);
    const int gt = F.vcu * (NWAVES * 64) + F.tid, NGT = F.G * NWAVES * 64;
    for (int e = gt; e < SEQ * 48; e += NGT) {
        const bool is64 = e < SEQ * 32; const int ee = is64 ? e : e - SEQ * 32; const int pos = is64 ? (ee >> 5) : (ee >> 4), i = is64 ? (ee & 31) : (ee & 15);
        const double rb = is64 ? 0.7498942093324559 : 0.5623413251903492; double inv = 1.0; for (int k = 0; k < i; ++k) inv *= rb;
        const float ang = (float)pos * (float)inv; float sn, cs; sincos_d((double)ang, sn, cs);
        if (is64) { c64[ee] = cs; s64[ee] = sn; } else { c32[ee] = cs; s32[ee] = sn; }
    }
    bf16* XB = (bf16*)(P.ws + WS_XB); float* SSQ2 = (float*)(P.ws + WS_SSQ2);
    for (int m = gw; m < MROWS; m += 4 * NGW) x_to_bf16_rows4(P.x, XB, SSQ2, m, NGW, F.lane);
}
#ifndef ATT_THR
#define ATT_THR 4
#endif
#ifndef PROBE_REP_IDXA
#define PROBE_REP_IDXA 1
#endif
#ifndef PROBE_REP_B
#define PROBE_REP_B 1
#endif
#ifndef PROBE_REP_C
#define PROBE_REP_C 1
#endif
#ifndef PROBE_REP_GU
#define PROBE_REP_GU 1
#endif
#ifndef PROBE_REP_DN
#define PROBE_REP_DN 1
#endif
#ifndef PROBE_NULL_GU
#define PROBE_NULL_GU 0
#endif
#ifndef PROBE_NULL_DN
#define PROBE_NULL_DN 0
#endif
#ifndef PROBE_REP_IDX
#define PROBE_REP_IDX 1
#endif
#ifndef PROBE_B_SKIP
#define PROBE_B_SKIP 0
#endif
#ifndef PROBE_B_HOT
#define PROBE_B_HOT 0
#endif
#ifndef PROBE_CLK
#define PROBE_CLK 0
#endif
#ifndef PROBE_HOT_GU
#define PROBE_HOT_GU 0
#endif
#ifndef PROBE_NOST_GU
#define PROBE_NOST_GU 0
#endif
#ifndef PROBE_FUSED_VAR
#define PROBE_FUSED_VAR 0
#endif
#ifndef PROBE_FUSED_DN
#define PROBE_FUSED_DN 0
#endif
#ifndef PROBE_REP_THIN
#define PROBE_REP_THIN 1
#endif
template <bool LAST>
__device__ __forceinline__ void thin_phase(Frame& F, const Ptrs& P, const float* ga, float alpha) {
    int t_ = threadIdx.x; asm volatile("" : "+v"(t_)); const int lane_ = t_ & 63, wave_ = __builtin_amdgcn_readfirstlane(t_ >> 6);
    const int gw = F.vcu * NWAVES + wave_, NGW = F.G * NWAVES;
    const bf16* Y = (const bf16*)(P.ws + WS_Y); bf16* XB = (bf16*)(P.ws + WS_XB); float* RS = (float*)(P.ws + WS_RS);
    for (int m = gw; m < MROWS; m += NGW) thin_row<LAST>(Y + (size_t)m * DM, XB + (size_t)m * DM, P.out + (size_t)m * DM, ga, alpha, RS + m, lane_);
}

__device__ __forceinline__ int wave_sum_i(int x) {
    x += __builtin_amdgcn_update_dpp(0, x, 0x111, 0xf, 0xf, true);
    x += __builtin_amdgcn_update_dpp(0, x, 0x112, 0xf, 0xf, true);
    x += __builtin_amdgcn_update_dpp(0, x, 0x114, 0xf, 0xf, true);
    x += __builtin_amdgcn_update_dpp(0, x, 0x118, 0xf, 0xf, true);
    return __builtin_amdgcn_readlane(x, 15) + __builtin_amdgcn_readlane(x, 31) + __builtin_amdgcn_readlane(x, 47) + __builtin_amdgcn_readlane(x, 63);
}
__device__ __forceinline__ void select_row(const unsigned (&u)[32], unsigned T, int cT, LAS unsigned long long* mw, int lane) {
    if (cT == 256) {
#pragma unroll
        for (int i = 0; i < 32; ++i) { const unsigned long long w = __ballot(u[i] >= T); if (lane == 0) mw[i] = w; }
    } else {
        int cgt = 0;
#pragma unroll
        for (int i = 0; i < 32; ++i) cgt += __popcll(__ballot(u[i] > T));
        const int need = 256 - cgt; int base = 0; unsigned T2 = T; asm volatile("" : "+s"(T2));
#pragma unroll
        for (int i = 0; i < 32; ++i) {
            const bool eq = (u[i] == T2), gt = (u[i] > T2); const unsigned long long em = __ballot(eq);
            const int rank = (int)__builtin_amdgcn_mbcnt_hi((unsigned)(em >> 32), __builtin_amdgcn_mbcnt_lo((unsigned)em, (unsigned)base));
            const unsigned long long w = __ballot(gt || (eq && rank < need)); base += __popcll(em);
            if (lane == 0) mw[i] = w;
        }
    }
}
template <int VAR>
__device__ __forceinline__ void indexer_unit(Frame& F, const Ptrs& P, int b, int blk) {
    typedef short bf16x8v __attribute__((ext_vector_type(8)));
    int tid = threadIdx.x; asm volatile("" : "+v"(tid));
    const int q0 = blk * 16, qc = q0 >> 6, n64 = qc + 1, nvis = n64 * 64; const int lane = tid & 63, wid = __builtin_amdgcn_readfirstlane(tid >> 6);
    unsigned long long* mrow = (unsigned long long*)(P.ws + WS_MASK) + ((size_t)(b * SEQ + q0)) * 32;
    if (n64 <= 4) {
        for (int i = tid; i < 16 * 32; i += NWAVES * 64) { const int w = i & 31; if (w < n64) mrow[i] = ~0ull; }
        return;
    }
    const bf16* IQ = (const bf16*)(P.ws + WS_R1 + 192 * MiB); const bf16* IK = (const bf16*)(P.ws + WS_R1 + 208 * MiB); const float* IW = (const float*)(P.ws + WS_R1 + 210 * MiB);
    LAS float* sc = (LAS float*)F.lds;
    if (!(VAR & 1)) {
        const int q = lane & 15, kg = lane >> 4; const size_t qrow = (size_t)(b * SEQ + q0 + q);
        bf16x8v iq[8]; float wi[8];
#pragma unroll
        for (int h = 0; h < 8; ++h) { iq[h] = *(const bf16x8v*)(IQ + qrow * 256 + h * 32 + 8 * kg); wi[h] = IW[qrow * 8 + h]; }
        const int nt = (nvis / 16 - wid + NWAVES - 1) / NWAVES;
        const bf16* ikp = IK + ((size_t)(b * SEQ + wid * 16 + q)) * 32 + 8 * kg;
        bf16x8v af[16];
#pragma unroll
        for (int i = 0; i < 16; ++i) if (i < nt) af[i] = *(const bf16x8v*)(ikp + (size_t)i * (NWAVES * 16 * 32));
#pragma unroll
        for (int i = 0; i < 16; ++i) if (i < nt) {
            f32x4 acc = {0.f, 0.f, 0.f, 0.f};
#pragma unroll
            for (int h = 0; h < 8; ++h) { const f32x4 c = __builtin_amdgcn_mfma_f32_16x16x32_bf16(af[i], iq[h], (f32x4){0.f, 0.f, 0.f, 0.f}, 0, 0, 0);
#pragma unroll
                for (int j = 0; j < 4; ++j) acc[j] += wi[h] * fmaxf(c[j], 0.f); }
            const int col = ((wid + NWAVES * i) * 16 + kg * 4 + 4 * q) & 2047;
            *(LAS f32x4*)(sc + q * 2048 + col) = acc;
        }
    }
    __syncthreads();
    if (VAR != 7) {
        int n64l = n64; asm volatile("" : "+s"(n64l));
        unsigned ua[32], ub[32];
        { const int qa = 2 * wid, qb = 2 * wid + 1; const LAS float* ra = sc + qa * 2048; const LAS float* rb = sc + qb * 2048;
#pragma unroll
          for (int i = 0; i < 32; ++i) { const int e = i * 64 + lane;
              const unsigned ba = __float_as_uint(ra[(e + 4 * qa) & 2047]), bb = __float_as_uint(rb[(e + 4 * qb) & 2047]);
              const unsigned ka = (ba & 0x80000000u) ? ~ba : (ba | 0x80000000u), kb = (bb & 0x80000000u) ? ~bb : (bb | 0x80000000u);
              ua[i] = (i < n64l) ? ka : 0u; ub[i] = (i < n64l) ? kb : 0u; } }
        unsigned Ta = 0u, Tb = 0u; int cTa = nvis, cTb = nvis; bool da = false, db = false;
#pragma unroll 1
        for (int bit = (VAR & 2) ? -1 : 31; bit >= 0; --bit) {
            const unsigned ca = Ta | (1u << bit), cb = Tb | (1u << bit); int xa = 0, xb = 0;
#pragma unroll
            for (int g = 0; g < 4; ++g) if (n64l > 8 * g) {
#pragma unroll
                for (int i = 8 * g; i < 8 * g + 8; ++i) { xa += (ua[i] >= ca) ? 1 : 0; xb += (ub[i] >= cb) ? 1 : 0; } }
            const int na = wave_sum_i(xa), nb = wave_sum_i(xb);
            if (!da && na >= 256) { Ta = ca; cTa = na; if (na == 256) da = true; }
            if (!db && nb >= 256) { Tb = cb; cTb = nb; if (nb == 256) db = true; }
            if (da && db) break;
        }
        if (!(VAR & 4)) {
            LAS unsigned long long* stg = (LAS unsigned long long*)(sc + (2 * wid) * 2048);
            select_row(ua, (unsigned)__builtin_amdgcn_readfirstlane((int)Ta), __builtin_amdgcn_readfirstlane(cTa), stg, lane);
            select_row(ub, (unsigned)__builtin_amdgcn_readfirstlane((int)Tb), __builtin_amdgcn_readfirstlane(cTb), stg + 32, lane);
            mrow[(2 * wid) * 32 + lane] = stg[lane];
        }
    }
    __syncthreads();
}

typedef short idx_bf16x8 __attribute__((ext_vector_type(8)));
constexpr int IDX_NPRE = 6;
struct IdxRegs { idx_bf16x8 iq[8]; float wi[8]; idx_bf16x8 af[IDX_NPRE]; };
__device__ __forceinline__ void idx_load(IdxRegs& R, const Ptrs& P, int b, int blk, int lane, int wid) {
    const int q0 = blk * 16, n64 = (q0 >> 6) + 1, nvis = n64 * 64;
    const bf16* IQ = (const bf16*)(P.ws + WS_R1 + 192 * MiB); const bf16* IK = (const bf16*)(P.ws + WS_R1 + 208 * MiB); const float* IW = (const float*)(P.ws + WS_R1 + 210 * MiB);
    const int q = lane & 15, kg = lane >> 4; const size_t qrow = (size_t)(b * SEQ + q0 + q);
#pragma unroll
    for (int h = 0; h < 8; ++h) { R.iq[h] = *(const idx_bf16x8*)(IQ + qrow * 256 + h * 32 + 8 * kg); R.wi[h] = IW[qrow * 8 + h]; }
    const int nt = (nvis / 16 - wid + NWAVES - 1) / NWAVES;
    const bf16* ikp = IK + ((size_t)(b * SEQ + wid * 16 + q)) * 32 + 8 * kg;
#pragma unroll
    for (int i = 0; i < IDX_NPRE; ++i) { const int ii = i < nt ? i : nt - 1; R.af[i] = *(const idx_bf16x8*)(ikp + (size_t)ii * (NWAVES * 16 * 32)); }
}
__device__ __forceinline__ void idx_score(const IdxRegs& R, const Ptrs& P, LAS float* sc, int b, int blk, int lane, int wid) {
    const int q0 = blk * 16, n64 = (q0 >> 6) + 1, nvis = n64 * 64;
    if (n64 <= 4) return;
    const int q = lane & 15, kg = lane >> 4; const int nt = (nvis / 16 - wid + NWAVES - 1) / NWAVES;
    const bf16* ikp = (const bf16*)(P.ws + WS_R1 + 208 * MiB) + ((size_t)(b * SEQ + wid * 16 + q)) * 32 + 8 * kg;
    idx_bf16x8 ah[16 - IDX_NPRE];
#pragma unroll
    for (int i = 0; i < 16 - IDX_NPRE; ++i) { const int ii = IDX_NPRE + i < nt ? IDX_NPRE + i : nt - 1; ah[i] = *(const idx_bf16x8*)(ikp + (size_t)ii * (NWAVES * 16 * 32)); }
#pragma unroll
    for (int i = 0; i < 16; ++i) if (i < nt) {
        f32x4 acc = {0.f, 0.f, 0.f, 0.f}; const idx_bf16x8 a_ = i < IDX_NPRE ? R.af[i < IDX_NPRE ? i : 0] : ah[i >= IDX_NPRE ? i - IDX_NPRE : 0];
#pragma unroll
        for (int h = 0; h < 8; ++h) { const f32x4 c = __builtin_amdgcn_mfma_f32_16x16x32_bf16(a_, R.iq[h], (f32x4){0.f, 0.f, 0.f, 0.f}, 0, 0, 0);
#pragma unroll
            for (int j = 0; j < 4; ++j) acc[j] += R.wi[h] * fmaxf(c[j], 0.f); }
        const int col = ((wid + NWAVES * i) * 16 + kg * 4 + 4 * q) & 2047;
        *(LAS f32x4*)(sc + q * 2048 + col) = acc;
    }
}
__device__ __forceinline__ void idx_select(const Ptrs& P, LAS float* sc, int b, int blk, int tid, int lane, int wid) {
    const int q0 = blk * 16, n64 = (q0 >> 6) + 1, nvis = n64 * 64;
    unsigned long long* mrow = (unsigned long long*)(P.ws + WS_MASK) + ((size_t)(b * SEQ + q0)) * 32;
    if (n64 <= 4) {
        for (int i = tid; i < 16 * 32; i += NWAVES * 64) { const int w = i & 31; if (w < n64) mrow[i] = ~0ull; }
        return;
    }
    int n64l = n64; asm volatile("" : "+s"(n64l));
    unsigned ua[32], ub[32];
    { const int qa = 2 * wid, qb = 2 * wid + 1; const LAS float* ra = sc + qa * 2048; const LAS float* rb = sc + qb * 2048;
#pragma unroll
      for (int i = 0; i < 32; ++i) { const int e = i * 64 + lane;
          const unsigned ba = __float_as_uint(ra[(e + 4 * qa) & 2047]), bb = __float_as_uint(rb[(e + 4 * qb) & 2047]);
          const unsigned ka = (ba & 0x80000000u) ? ~ba : (ba | 0x80000000u), kb = (bb & 0x80000000u) ? ~bb : (bb | 0x80000000u);
          ua[i] = (i < n64l) ? ka : 0u; ub[i] = (i < n64l) ? kb : 0u; } }
    unsigned Ta = 0u, Tb = 0u; int cTa = nvis, cTb = nvis; bool da = false, db = false;
#pragma unroll 1
    for (int bit = 31; bit >= 0; --bit) {
        const unsigned ca = Ta | (1u << bit), cb = Tb | (1u << bit); int xa = 0, xb = 0;
#pragma unroll
        for (int g = 0; g < 4; ++g) if (n64l > 8 * g) {
#pragma unroll
            for (int i = 8 * g; i < 8 * g + 8; ++i) { xa += (ua[i] >= ca) ? 1 : 0; xb += (ub[i] >= cb) ? 1 : 0; } }
        const int na = wave_sum_i(xa), nb = wave_sum_i(xb);
        if (!da && na >= 256) { Ta = ca; cTa = na; if (na == 256) da = true; }
        if (!db && nb >= 256) { Tb = cb; cTb = nb; if (nb == 256) db = true; }
        if (da && db) break;
    }
    LAS unsigned long long* stg = (LAS unsigned long long*)(sc + (2 * wid) * 2048);
    select_row(ua, (unsigned)__builtin_amdgcn_readfirstlane((int)Ta), __builtin_amdgcn_readfirstlane(cTa), stg, lane);
    select_row(ub, (unsigned)__builtin_amdgcn_readfirstlane((int)Tb), __builtin_amdgcn_readfirstlane(cTb), stg + 32, lane);
    mrow[(2 * wid) * 32 + lane] = stg[lane];
}
__device__ __forceinline__ void indexer_phase(Frame& F, const Ptrs& P) {
    int tid = threadIdx.x; asm volatile("" : "+v"(tid));
    const int lane = tid & 63, wid = __builtin_amdgcn_readfirstlane(tid >> 6);
    LAS float* sc = (LAS float*)F.lds;
#define IDX_B(u) ((F.vcu + 256 * ((u) >> 1)) >> 6)
#define IDX_BLK(u) (((u) & 1) ? 127 - ((F.vcu + 256 * ((u) >> 1)) & 63) : ((F.vcu + 256 * ((u) >> 1)) & 63))
    IdxRegs RA, RB;
    idx_load(RA, P, IDX_B(0), IDX_BLK(0), lane, wid);
#pragma unroll 1
    for (int u = 0; u < 8; u += 2) {
        idx_score(RA, P, sc, IDX_B(u), IDX_BLK(u), lane, wid); __syncthreads();
        idx_load(RB, P, IDX_B(u + 1), IDX_BLK(u + 1), lane, wid);
        idx_select(P, sc, IDX_B(u), IDX_BLK(u), tid, lane, wid); __syncthreads();
        idx_score(RB, P, sc, IDX_B(u + 1), IDX_BLK(u + 1), lane, wid); __syncthreads();
        { const int un = u + 2 < 8 ? u + 2 : 7; idx_load(RA, P, IDX_B(un), IDX_BLK(un), lane, wid); }
        idx_select(P, sc, IDX_B(u + 1), IDX_BLK(u + 1), tid, lane, wid); __syncthreads();
    }
#undef IDX_B
#undef IDX_BLK
}

__device__ __forceinline__ void a_unit(Frame& F, const Ptrs& P, int b, int h, int qb, float lam) {
    using namespace att; typedef Lds<128> L;
    const bf16_t* AQ = (const bf16_t*)(P.ws + WS_R1); const bf16_t* AK = (const bf16_t*)(P.ws + WS_R1 + 32 * MiB); const bf16_t* AV = (const bf16_t*)(P.ws + WS_R1 + 64 * MiB);
    int tid = threadIdx.x; asm volatile("" : "+v"(tid));
    const int lane = tid & 63, wid = __builtin_amdgcn_readfirstlane(tid >> 6), r32 = lane & 31; const size_t rowbase = (size_t)b * SEQ; const int q0 = qb * 256, qw = q0 + wid * 32, qc = qw >> 6;
    f32x4* stash = (f32x4*)(P.ws + WS_Y) + ((size_t)(blockIdx.x * NWAVES + wid) * 16) * 64 + lane;
    f32x16 o[4];
#pragma unroll 1
    for (int c = 0; c < 2; ++c) {
        const int g = 2 * h + c;
        attn_core<128, 0, ATT_THR>(o, F.lds, AQ + (rowbase + qw) * 512 + g * 64, 512, AK + rowbase * 512 + g * 64, 512, AV + rowbase * 512 + h * 128, 512, 0, (q0 >> 6) + 4, 0, qc + 1, nullptr, 0, 0);
        if (c == 0) {
            f32x4* sp = stash; asm volatile("" : "+v"(sp));
#pragma unroll
            for (int d0 = 0; d0 < 4; ++d0)
#pragma unroll
                for (int rq = 0; rq < 4; ++rq) sp[(d0 * 4 + rq) * 64] = (f32x4){o[d0][4 * rq], o[d0][4 * rq + 1], o[d0][4 * rq + 2], o[d0][4 * rq + 3]};
        }
    }
    {
        const f32x4* sp = stash; asm volatile("" : "+v"(sp));
#pragma unroll
        for (int d0 = 0; d0 < 4; ++d0)
#pragma unroll
            for (int rq = 0; rq < 4; ++rq) { const f32x4 a = sp[(d0 * 4 + rq) * 64];
#pragma unroll
                for (int j = 0; j < 4; ++j) o[d0][4 * rq + j] = a[j] - lam * o[d0][4 * rq + j]; }
    }
    float sl[4];
#pragma unroll
    for (int d0 = 0; d0 < 4; ++d0) sl[d0] = P.esub[32 * d0 + r32] * 0.8f;
#pragma unroll
    for (int r = 0; r < 16; ++r) { float s = 0.f;
#pragma unroll
        for (int d0 = 0; d0 < 4; ++d0) s += o[d0][r] * o[d0][r];
        s = sum32(s);
        const float rstd = 1.0f / sqrtf(s * (1.f / 128.f) + RMS_EPS);
#pragma unroll
        for (int d0 = 0; d0 < 4; ++d0) o[d0][r] *= rstd * sl[d0]; }
    store_o<128>(o, F.lds, (bf16_t*)(P.ws + WS_ATT) + (rowbase + qw) * DM + h * 128, DM);
}
__device__ __forceinline__ void b_unit(Frame& F, const Ptrs& P, int b, int h, int qb, int hotmask, int skip, bool has_next, int nb, int nh, int nqb, int& pre) {
    using namespace att;
    const bf16_t* BQ = (const bf16_t*)(P.ws + WS_R1 + 96 * MiB); const bf16_t* BK = (const bf16_t*)(P.ws + WS_R1 + 128 * MiB); const bf16_t* BV = (const bf16_t*)(P.ws + WS_R1 + 160 * MiB);
    int tid = threadIdx.x; asm volatile("" : "+v"(tid));
    const int lane = tid & 63, wid = __builtin_amdgcn_readfirstlane(tid >> 6), r32 = lane & 31; const size_t rowbase = (size_t)b * SEQ; const int q0 = qb * 256, qw = q0 + wid * 32, qc = qw >> 6;
    const unsigned long long* mbase = (const unsigned long long*)(P.ws + WS_MASK);
    const unsigned long long* mrow = mbase + (rowbase + qw + r32) * 32;
    const size_t nrowbase = (size_t)nb * SEQ; const int nqw = nqb * 256 + wid * 32;
    f32x16 o[2]; int pre_out = 0;
    attn_core<64, 1, ATT_THR>(o, F.lds, BQ + (rowbase + qw) * 512 + h * 64, 512, BK + rowbase * 512 + h * 64, 512, BV + rowbase * 512 + h * 64, 512, 0, (q0 >> 6) + 4, 0, qc + 1, mrow, 0, 0, hotmask, skip,
                        BK + nrowbase * 512 + nh * 64, BV + nrowbase * 512 + nh * 64, mbase + (nrowbase + nqw + r32) * 32, 0, has_next ? (nqb * 4 + 4) : 0, pre, &pre_out);
    pre = pre_out;
    store_o<64>(o, F.lds, (bf16_t*)(P.ws + WS_ATT) + (rowbase + qw) * DM + 512 + h * 64, DM);
}
__device__ __forceinline__ void c_unit(Frame& F, const Ptrs& P, int b, int h, int qb, bool has_next, int& pre) {
    using namespace att; typedef Lds<64> L;
    const bf16_t* CQ = (const bf16_t*)(P.ws + WS_R1); const bf16_t* CK = (const bf16_t*)(P.ws + WS_R1 + 64 * MiB); const bf16_t* CV = (const bf16_t*)(P.ws + WS_R1 + 128 * MiB);
    int tid = threadIdx.x; asm volatile("" : "+v"(tid));
    const int lane = tid & 63, wid = __builtin_amdgcn_readfirstlane(tid >> 6), r32 = lane & 31; const size_t rowbase = (size_t)b * SEQ; const int q0 = qb * 256, qw = q0 + wid * 32, qc = qw >> 6;
    LAS float* bt = (LAS float*)(F.lds + L::OFF_BT);
    if (qb == 0) { for (int i = tid; i < 4 * 640; i += NWAVES * 64) { const int k = (i % 640) + (i / 640); bt[i] = P.obias[h * 320 + (k < 319 ? k : 319)] * LOG2E; } }
    const int c0 = q0 >> 6, T0 = c0 - 8 > 0 ? c0 - 8 : 0, tw0 = qc - 8 > 0 ? qc - 8 : 0;
    const int nc0 = c0 + 4, nT0 = nc0 - 8 > 0 ? nc0 - 8 : 0;
    f32x16 o[2]; int pre_out = 0;
    attn_core<64, 2, ATT_THR>(o, F.lds, CQ + (rowbase + qw) * DM + h * 64, DM, CK + rowbase * DM + h * 64, DM, CV + rowbase * DM + h * 64, DM, T0, c0 + 4, tw0, qc + 1, nullptr, qw + r32, qc, -1, 0,
                        CK + rowbase * DM + h * 64, CV + rowbase * DM + h * 64, nullptr, nT0, has_next ? (nc0 + 4) : 0, pre, &pre_out);
    pre = pre_out;
    store_o<64>(o, F.lds, (bf16_t*)(P.ws + WS_ATT) + (rowbase + qw) * DM + h * 64, DM);
}

#ifndef DBG_NO_IDX
#define DBG_NO_IDX 0
#endif
#ifndef DBG_NO_A
#define DBG_NO_A 0
#endif
#ifndef DBG_NO_B
#define DBG_NO_B 0
#endif
#ifndef DBG_STAGES
#define DBG_STAGES 99
#endif
struct Args { const float* in[12]; float* out; unsigned char* ws; };
__global__ void __launch_bounds__(NWAVES * 64, 2) fwd_kernel(Args args) {
    extern __shared__ __attribute__((aligned(16))) unsigned char lds[];
    Frame F;
    F.lds = (LAS unsigned char*)lds; F.MISC = (volatile LAS unsigned*)(F.lds + MISC_OFF);
    F.tid = threadIdx.x; F.lane = F.tid & 63; F.wave = __builtin_amdgcn_readfirstlane(F.tid >> 6);
    F.G = gridDim.x; { const int bx = blockIdx.x; F.vcu = (F.G % 8 == 0) ? (bx % 8) * (F.G / 8) + bx / 8 : bx; }
    Ptrs P; P.x = args.in[0]; P.norm_g = args.in[1]; P.wg = args.in[2]; P.wu = args.in[3]; P.wd = args.in[4]; P.ewin = args.in[5]; P.ewout = args.in[6]; P.elam = args.in[7]; P.esub = args.in[8];
    P.owin = args.in[9]; P.owout = args.in[10]; P.obias = args.in[11]; P.out = args.out; P.ws = args.ws;
    F.ctl = (gu32*)(P.ws + WS_CTL);
    for (int u = F.tid; u < (LDS_BYTES - LDSCTL_OFF) / 4; u += NWAVES * 64) ((LAS unsigned*)(F.lds + LDSCTL_OFF))[u] = 0u;
    __syncthreads();
    XcdBarrier bar = xcd_barrier_post((unsigned*)(F.ctl + CW_BAR), F.MISC + 8);
#define GRID_BAR() xcd_barrier(bar)
    bf16* XB = (bf16*)(P.ws + WS_XB); const float* RS = (const float*)(P.ws + WS_SSQ2); bf16* HID = (bf16*)(P.ws + WS_R1); bf16* Y = (bf16*)(P.ws + WS_Y); const bf16* ATT = (const bf16*)(P.ws + WS_ATT);

#ifdef PROBE_REP_PRO
    for (int rep_ = 1; rep_ < PROBE_REP_PRO; ++rep_) { p0_prologue(F, P); __syncthreads(); }
#endif
    p0_prologue(F, P); GRID_BAR();

#define FUSED_GEMM(Aop, Bop, Kdim, inst, gain, alpha_, LAST_) FUSED_GEMM_X(XB, (float*)(P.ws + WS_SSQ2), Aop, Bop, Kdim, inst, gain, alpha_, LAST_, 0)
#define FUSED_GEMM_X(Xp, SSQ2p, Aop, Bop, Kdim, inst, gain, alpha_, LAST_, PV_) do { \
        pg8::Gemm g{(Aop), (Bop), MROWS, DM, (Kdim)}; \
        epi::EpiRmsRes<LAST_, PV_> E{(Xp), P.out, (gain), (alpha_), (unsigned long long*)(P.ws + WS_GRAN), (unsigned)((inst) + 1), (SSQ2p), (unsigned*)(F.ctl + CW_TMO), F.lds + FUSED_LDS_OFF}; \
        pg8::StaticOrder S; S.init(MROWS, DM, F.G, (int)blockIdx.x); \
        pg8::gemm_phase<epi::EpiRmsRes<LAST_, PV_>, pg8::StaticOrder, true, true>(F.lds, g, S, E); } while (0)
#define FFN_PHASES(l, f, LAST_) do { \
        { pg8::Gemm g{XB, (const bf16*)(P.ws + WS_WGU + (2 * (l) + (f)) * WGU_BYTES), MROWS, NGU, DM}; epi::OrdOrder S; S.base.init(MROWS, NGU, F.G, (int)blockIdx.x); \
          epi::rowstat_table(S, RS, (LAS float*)(F.lds + FUSED_LDS_OFF), 11); \
          epi::EpiSwiGLU E{HID, (const LAS float*)(F.lds + FUSED_LDS_OFF)}; const unsigned long long pc0_ = PROBE_CLK ? __builtin_amdgcn_s_memtime() : 0ull; for (int rep_ = 0; rep_ < PROBE_REP_GU; ++rep_) pg8::gemm_phase<epi::EpiSwiGLU, epi::OrdOrder, true, true>(F.lds, g, S, E); \
          if (PROBE_CLK) { const unsigned long long pc1_ = __builtin_amdgcn_s_memtime(); while (__builtin_amdgcn_s_memtime() - pc1_ < pc1_ - pc0_) __builtin_amdgcn_s_sleep(32); } \
          if (PROBE_NULL_GU) { epi::EpiNull EN; for (int rep_ = 0; rep_ < PROBE_NULL_GU; ++rep_) pg8::gemm_phase<epi::EpiNull, epi::OrdOrder, true, true>(F.lds, g, S, EN); } \
          if (PROBE_HOT_GU) { epi::EpiNull EN; epi::HotOrder HS{11, (int)blockIdx.x}; pg8::gemm_phase<epi::EpiNull, epi::HotOrder, true, true>(F.lds, g, HS, EN); } \
          if (PROBE_NOST_GU) { epi::EpiSwiGLUT<1> EN{HID, (const LAS float*)(F.lds + FUSED_LDS_OFF)}; pg8::gemm_phase<epi::EpiSwiGLUT<1>, epi::OrdOrder, true, true>(F.lds, g, S, EN); } } \
        GRID_BAR(); \
        if (PROBE_FUSED_DN) { FUSED_GEMM_X((bf16*)(P.ws + WS_ATT), (float*)(P.ws + WS_SSQ1), HID, (const bf16*)(P.ws + WS_WD + (2 * (l) + (f)) * WD_BYTES), FF, 6 + 2 * (l) + (f), P.norm_g + ((l) * 6 + 4 * (f) + 1) * DM, 0.5f, false, PROBE_FUSED_VAR); GRID_BAR(); } \
        FUSED_GEMM(HID, (const bf16*)(P.ws + WS_WD + (2 * (l) + (f)) * WD_BYTES), FF, 3 * (l) + 2 * (f), P.norm_g + ((l) * 6 + 4 * (f) + 1) * DM, 0.5f, LAST_); \
        if (!(LAST_)) GRID_BAR(); } while (0)

    FFN_PHASES(0, 0, false);
    if (DBG_STAGES >= 2) {
        { pg8::Gemm g{XB, (const bf16*)(P.ws + WS_WIN0), MROWS, NEV, DM}; epi::OrdOrder S; S.base.init(MROWS, NEV, F.G, (int)blockIdx.x);
          epi::rowstat_table(S, RS, (LAS float*)(F.lds + FUSED_LDS_OFF), NEV / 256 / 2);
          unsigned char* r1 = P.ws + WS_R1;
          epi::EpiProjEven E{(bf16*)r1, (bf16*)(r1 + 192 * MiB), (bf16*)(r1 + 208 * MiB),
                             (float*)(r1 + 210 * MiB), (const LAS float*)(F.lds + FUSED_LDS_OFF), (const float*)(P.ws + WS_C64), (const float*)(P.ws + WS_S64), (const float*)(P.ws + WS_C32), (const float*)(P.ws + WS_S32)};
          pg8::gemm_phase<epi::EpiProjEven, epi::OrdOrder, true, true>(F.lds, g, S, E); }
        GRID_BAR();
#ifdef PROBE_IDX_VAR
        for (int vr_ = 0; vr_ < 4; ++vr_)
        for (int p = F.vcu; p < 1024; p += F.G) { const int b = p >> 6, j = p & 63;
#pragma unroll 1
            for (int k = 0; k < 2; ++k) indexer_unit<PROBE_IDX_VAR>(F, P, b, k ? 127 - j : j); }
#endif
        for (int rep_ = 0; rep_ < PROBE_REP_IDXA * PROBE_REP_IDX; ++rep_) { if (!DBG_NO_IDX) indexer_phase(F, P); }
        {
            float l01 = 0.f, l23 = 0.f;
            for (int i = 0; i < 64; ++i) { l01 += P.elam[i] * P.elam[64 + i]; l23 += P.elam[128 + i] * P.elam[192 + i]; }
            const float lam = expf(l01) - expf(l23) + 0.2f;
            for (int rep_ = 0; rep_ < PROBE_REP_IDXA; ++rep_)
            for (int p = F.vcu; p < 256; p += F.G) { const int bh = p >> 2, s = p & 3;
#pragma unroll 1
                for (int k = 0; k < 2; ++k) { if (!DBG_NO_A) a_unit(F, P, bh >> 2, bh & 3, k ? 7 - s : s, lam); } }
        }
        GRID_BAR();
        for (int rep_ = 0; rep_ < PROBE_REP_B; ++rep_) {
            int pre_ = 0;
#pragma unroll 1
            for (int j = 0; j < 4; ++j) { const int p = F.vcu + 256 * (j >> 1), bh = p >> 2, s = p & 3, qb = (j & 1) ? 7 - s : s;
                const int jn = j + 1, pn = F.vcu + 256 * (jn >> 1), bhn = pn >> 2, sn = pn & 3, qbn = (jn & 1) ? 7 - sn : sn;
                if (!DBG_NO_B) b_unit(F, P, bh >> 3, bh & 7, qb, (PROBE_B_HOT && rep_ + 1 < PROBE_REP_B) ? 0 : -1, (rep_ + 1 < PROBE_REP_B) ? PROBE_B_SKIP : 0, jn < 4, bhn >> 3, bhn & 7, qbn, pre_); } }
        GRID_BAR();
        FUSED_GEMM(ATT, (const bf16*)(P.ws + WS_WOUT0), DM, 3 * 0 + 1, P.norm_g + (0 * 6 + 3) * DM, 1.0f, false);
        GRID_BAR();
    }
    if (DBG_STAGES >= 3) FFN_PHASES(0, 1, false);
#ifdef PROBE_XBAR
    for (int i_ = 0; i_ < PROBE_XBAR; ++i_) GRID_BAR();
#endif
#ifdef PROBE_IDLE_CYC
    { const unsigned long long t0_ = __builtin_amdgcn_s_memtime(); while (__builtin_amdgcn_s_memtime() - t0_ < (unsigned long long)PROBE_IDLE_CYC) __builtin_amdgcn_s_sleep(32); }
#endif
#ifdef PROBE_IDLE_US
    { const unsigned long long t0_ = __builtin_amdgcn_s_memrealtime(); while (__builtin_amdgcn_s_memrealtime() - t0_ < 100ull * PROBE_IDLE_US) __builtin_amdgcn_s_sleep(32); }
#endif
    if (DBG_STAGES >= 4) FFN_PHASES(1, 0, false);
    if (DBG_STAGES >= 5) {
        { pg8::Gemm g{XB, (const bf16*)(P.ws + WS_WIN1), MROWS, NOD, DM}; epi::OrdOrder S; S.base.init(MROWS, NOD, F.G, (int)blockIdx.x);
          epi::rowstat_table(S, RS, (LAS float*)(F.lds + FUSED_LDS_OFF), NOD / 256 / 2);
          unsigned char* r1 = P.ws + WS_R1; epi::EpiProjOdd E{(bf16*)r1, (const LAS float*)(F.lds + FUSED_LDS_OFF)};
          pg8::gemm_phase<epi::EpiProjOdd, epi::OrdOrder, true, true>(F.lds, g, S, E); }
        GRID_BAR();
        for (int rep_ = 0; rep_ < PROBE_REP_C; ++rep_) { const int p = F.vcu, b = p >> 4, h = p & 15; int pre_ = 0;
#pragma unroll 1
            for (int qb = 0; qb < 8; ++qb) c_unit(F, P, b, h, qb, qb < 7, pre_); }
        GRID_BAR();
        FUSED_GEMM(ATT, (const bf16*)(P.ws + WS_WOUT1), DM, 3 * 1 + 1, P.norm_g + (1 * 6 + 3) * DM, 1.0f, false);
        GRID_BAR();
    }
    if (DBG_STAGES >= 6) FFN_PHASES(1, 1, true);
}

extern "C" void kernel_launch(void* const* d_in, const int* in_sizes, int n_in, void* d_out, int out_size, void* d_ws, size_t ws_size, hipStream_t stream) {
    static int grid = 0;
    if (grid == 0) {
        if (n_in != 12 || in_sizes[0] != MROWS * DM || out_size != MROWS * DM || ws_size < WS_END) {
            fprintf(stderr, "kernel_launch: unexpected shapes / workspace (n_in %d, in0 %d, out %d, ws %zu, need %zu); nothing launched\n", n_in, n_in > 0 ? in_sizes[0] : -1, out_size, ws_size, (size_t)WS_END); grid = -1; return; }
        int dev = 0, cus = 0, per_cu = 0;
        if (hipGetDevice(&dev) != hipSuccess || hipDeviceGetAttribute(&cus, hipDeviceAttributeMultiprocessorCount, dev) != hipSuccess) { fprintf(stderr, "kernel_launch: device query failed\n"); grid = -1; return; }
        if (hipFuncSetAttribute((const void*)fwd_kernel, hipFuncAttributeMaxDynamicSharedMemorySize, LDS_BYTES) != hipSuccess) { fprintf(stderr, "kernel_launch: hipFuncSetAttribute failed\n"); grid = -1; return; }
        if (hipOccupancyMaxActiveBlocksPerMultiprocessor(&per_cu, (const void*)fwd_kernel, NWAVES * 64, LDS_BYTES) != hipSuccess || per_cu < 1)
            fprintf(stderr, "kernel_launch: note: occupancy query reports %d workgroups per CU\n", per_cu);
        (void)hipGetLastError();
        grid = cus;
        if (grid != 256) { fprintf(stderr, "kernel_launch: built for a 256-CU device (the fused epilogues pair workgroups by rounds of 256), found %d; nothing launched\n", cus); grid = -1; return; }
    }
    if (grid < 0) return;
    if (hipMemsetAsync((char*)d_ws + WS_CTL, 0, CTL_ZERO_BYTES, stream) != hipSuccess) { fprintf(stderr, "kernel_launch: memset failed\n"); return; }
    Args a{};
    for (int i = 0; i < 12; ++i) a.in[i] = (const float*)d_in[i];
    a.out = (float*)d_out; a.ws = (unsigned char*)d_ws;
    hipLaunchKernelGGL(fwd_kernel, dim3(grid), dim3(NWAVES * 64), LDS_BYTES, stream, a);
    const hipError_t le = hipPeekAtLastError();
    if (le != hipSuccess) fprintf(stderr, "kernel_launch: launch failed: %s\n", hipGetErrorName(le));
}
```

```cpp
#include <hip/hip_runtime.h>
#include <cstdio>
#include <cstdint>
namespace pg8 {
#define PG8_LAS __attribute__((address_space(3)))
typedef unsigned short bf16_t;
typedef short bf16x8 __attribute__((ext_vector_type(8)));
typedef float f32x4 __attribute__((ext_vector_type(4)));
typedef unsigned u32x4 __attribute__((ext_vector_type(4)));
constexpr int BM = 256, BK = 64, HALF = 128, HTB = HALF * BK * 2  , STAGE_BYTES = 8 * HTB, NXCD = 8, WGM = 8;

__host__ __device__ __forceinline__ int lds_byte(int r, int c) { const int st = (r >> 4) * 2 + (c >> 5), rr = r & 15, cc = c & 31, ob = rr * 64 + cc * 2; return st * 1024 + (ob ^ (((ob >> 9) & 1) << 5)); }
__host__ __device__ __forceinline__ void stage_rc(int b, int& R, int& C) { const int st = b / 1024, sb = b % 1024, swz = sb ^ (((sb >> 9) & 1) << 5); R = (st >> 1) * 16 + swz / 64; C = (st & 1) * 32 + (swz % 64) / 2; }
__host__ __device__ __forceinline__ int perm32(int rho) { const int n = rho >> 4, i = rho & 15; return 8 * (i >> 2) + 4 * n + (i & 3); }

struct Unit { int pm, pn, idx; };
struct Gemm { const bf16_t* A; const bf16_t* Bt; int M, N, K; };

struct StaticOrder {
    int nM, nN, nwg, G, c;
    __host__ __device__ void init(int M, int N, int G_, int c_) { nM = M / BM; nN = N / BM; nwg = nM * nN; G = G_; c = c_; }
    __host__ __device__ bool next(int i, Unit& u) const {
        const long L = (long)i * G + c; if (L >= nwg) return false;
        int wgid = (int)L; { const int q = nwg / NXCD, r = nwg % NXCD, xcd = wgid % NXCD, off = wgid / NXCD; wgid = (xcd < r ? xcd * (q + 1) : r * (q + 1) + (xcd - r) * q) + off; }
        const int nig = WGM * nN, gid = wgid / nig, fm = gid * WGM, gsz = (nM - fm) < WGM ? (nM - fm) : WGM;
        u.pm = fm + ((wgid % nig) % gsz); u.pn = (wgid % nig) / gsz; return true;
    }
    __device__ __forceinline__ void a_ready(const Unit&) const {}
    __device__ __forceinline__ void done(const Unit&) const {}
};

__device__ __forceinline__ unsigned cvt_pk_bf16(float lo, float hi) { unsigned r; asm volatile("v_cvt_pk_bf16_f32 %0, %1, %2" : "=v"(r) : "v"(lo), "v"(hi)); return r; }
typedef float f32x2 __attribute__((ext_vector_type(2)));
__device__ __forceinline__ f32x2 gelu_pk(f32x2 v) {
    const f32x2 av = __builtin_elementwise_abs(v), d = av * 0.2316418882f + 1.0f;
    f32x2 t; t.x = __builtin_amdgcn_rcpf(d.x); t.y = __builtin_amdgcn_rcpf(d.y);
    f32x2 q = t * 0.5307027145f + (-0.7265760135f); q = q * t + 0.7107068705f; q = q * t + (-0.142248368f); q = q * t + 0.127414796f; q = q * t;
    const f32x2 s = (v * v) * (-0.72134752044f);
    f32x2 e; e.x = __builtin_amdgcn_exp2f(s.x); e.y = __builtin_amdgcn_exp2f(s.y);
    const f32x2 m = v * (q * e), r = v - m;
    f32x2 o; o.x = v.x < 0.f ? m.x : r.x; o.y = v.y < 0.f ? m.y : r.y; return o;
}

template <int ACT  > struct EpiBf16 {
    static constexpr bool PERM = true, AFTER_DRAIN = false; static_assert(ACT == 0 || ACT == 1, "EpiBf16: ACT is 0 (none) or 1 (gelu_pk)");
    bf16_t* O; int ldc; const float* bias; int split_cols; size_t split_stride; float scale0;
    __device__ __forceinline__ void operator()(const f32x4 (&acc)[2][2][4][2], const Unit& u, int wr, int wc, int fr, int fq) const {
        const int row0 = u.pm * BM + wr * 64 + fr; int colt = u.pn * BM; bf16_t* base = O;
        float sc = 1.f; if (split_cols) { const int t = colt / split_cols; base += (size_t)t * split_stride; colt -= t * split_cols; if (t == 0) sc = scale0; }
        const int col0 = colt + wc * 32 + 8 * fq, bcol0 = u.pn * BM + wc * 32 + 8 * fq;
        f32x4 bv[2][2];
#pragma unroll
        for (int bj = 0; bj < 2; ++bj)
#pragma unroll
            for (int n = 0; n < 2; ++n) bv[bj][n] = bias ? *(const f32x4*)(bias + bcol0 + bj * HALF + 4 * n) : (f32x4){0.f, 0.f, 0.f, 0.f};
#pragma unroll
        for (int ai = 0; ai < 2; ++ai)
#pragma unroll
            for (int m = 0; m < 4; ++m) { bf16_t* rowp = base + (size_t)(row0 + ai * HALF + m * 16) * ldc + col0;
#pragma unroll
                for (int bj = 0; bj < 2; ++bj) { f32x4 v0 = acc[ai][bj][m][0] + bv[bj][0], v1 = acc[ai][bj][m][1] + bv[bj][1];
                    if (ACT == 1) { f32x2 a = gelu_pk((f32x2){v0[0], v0[1]}), b = gelu_pk((f32x2){v0[2], v0[3]}), c = gelu_pk((f32x2){v1[0], v1[1]}), d = gelu_pk((f32x2){v1[2], v1[3]});
                        v0 = (f32x4){a.x, a.y, b.x, b.y}; v1 = (f32x4){c.x, c.y, d.x, d.y}; }
                    v0 = v0 * sc; v1 = v1 * sc; u32x4 w; w.x = cvt_pk_bf16(v0[0], v0[1]); w.y = cvt_pk_bf16(v0[2], v0[3]); w.z = cvt_pk_bf16(v1[0], v1[1]); w.w = cvt_pk_bf16(v1[2], v1[3]);
                    *(u32x4*)(rowp + bj * HALF) = w; } }
    }
};

struct PanelStats {
    unsigned* xbuf;
    unsigned* cnt;
    unsigned* tmo;
    int ntn; float eps;
    unsigned code;
    __device__ __forceinline__ bool run(const f32x4 (&v)[2][2][4][2], const Unit& u, int wr, int wc, int fr, int fq, PG8_LAS unsigned char* lds, int wid, int lane) const {
        typedef float f32x2v __attribute__((ext_vector_type(2)));
        PG8_LAS f32x2v* P = (PG8_LAS f32x2v*)lds;
        PG8_LAS f32x2v* S = (PG8_LAS f32x2v*)(lds + 8192);
        PG8_LAS unsigned* flag = (PG8_LAS unsigned*)(lds + 8192 + 2048);
#pragma unroll
        for (int ai = 0; ai < 2; ++ai)
#pragma unroll
            for (int m = 0; m < 4; ++m) {
                float s = 0.f;
#pragma unroll
                for (int bj = 0; bj < 2; ++bj)
#pragma unroll
                    for (int n = 0; n < 2; ++n) { const f32x4 x = v[ai][bj][m][n]; s += (x[0] + x[1]) + (x[2] + x[3]); }
                s += __shfl_xor(s, 16); s += __shfl_xor(s, 32);
                const float mw = s * (1.0f / 64.0f); float q = 0.f;
#pragma unroll
                for (int bj = 0; bj < 2; ++bj)
#pragma unroll
                    for (int n = 0; n < 2; ++n) { const f32x4 d = v[ai][bj][m][n] - mw; q += (d[0] * d[0] + d[1] * d[1]) + (d[2] * d[2] + d[3] * d[3]); }
                q += __shfl_xor(q, 16); q += __shfl_xor(q, 32);
                if (fq == 0) P[(ai * HALF + wr * 64 + m * 16 + fr) * 4 + wc] = (f32x2v){mw, q};
            }
        asm volatile("s_waitcnt lgkmcnt(0)" ::: "memory"); __builtin_amdgcn_s_barrier(); asm volatile("" ::: "memory");
#if defined(BROKEN_EXCHANGE_NO_WAIT)
#warning BROKEN CONTROL BUILD: the row-statistics exchange does not wait; results are wrong by design
        if (blockIdx.x >= 64) { const long long t0_ = clock64(); while (clock64() - t0_ < 60000) __builtin_amdgcn_s_sleep(8); }
#endif
        const int row = wid * 32 + (lane & 31);
        if (lane < 32) {
            const f32x2v a = P[row * 4 + 0], b = P[row * 4 + 1], c = P[row * 4 + 2], d = P[row * 4 + 3];
            const float mt = (a.x + b.x + c.x + d.x) * 0.25f;
            const float da = a.x - mt, db = b.x - mt, dc = c.x - mt, dd = d.x - mt;
            const float m2 = (a.y + b.y) + (c.y + d.y) + 64.0f * ((da * da + db * db) + (dc * dc + dd * dd));
            unsigned long long* slot = (unsigned long long*)xbuf + ((size_t)(u.pm * BM + row) * 4 + u.pn);
            __hip_atomic_store(slot, ((unsigned long long)__float_as_uint(m2) << 32) | __float_as_uint(mt), __ATOMIC_RELAXED, __HIP_MEMORY_SCOPE_AGENT);
        }
        asm volatile("s_waitcnt vmcnt(0)" ::: "memory");
        if (lane == 0) __hip_atomic_fetch_add(cnt + 64 * u.pm, 1u, __ATOMIC_RELAXED, __HIP_MEMORY_SCOPE_AGENT);
        if (wid == 0) {
            bool dead = false; const unsigned long long t0 = __builtin_amdgcn_s_memrealtime(); const unsigned want = 8u * (unsigned)ntn;
            for (;;) {
#if defined(BROKEN_EXCHANGE_NO_WAIT)
                break;
#endif
                if ((unsigned)__builtin_amdgcn_readfirstlane(__hip_atomic_load(cnt + 64 * u.pm, __ATOMIC_RELAXED, __HIP_MEMORY_SCOPE_AGENT)) >= want) break;
                if (__builtin_amdgcn_s_memrealtime() - t0 > 2000000ull) {
                    if (lane == 0) { unsigned expect = 0u; __hip_atomic_compare_exchange_strong(tmo + 1, &expect, code | (unsigned)(u.pm & 0xff), __ATOMIC_RELAXED, __ATOMIC_RELAXED, __HIP_MEMORY_SCOPE_AGENT);
                                     __hip_atomic_store(tmo, 1u, __ATOMIC_RELAXED, __HIP_MEMORY_SCOPE_AGENT); }
                    dead = true; break; }
                __builtin_amdgcn_s_sleep(2);
            }
            __builtin_amdgcn_fence(__ATOMIC_ACQUIRE, "agent");
            if (lane == 0) flag[0] = dead ? 1u : 0u;
        }
        asm volatile("s_waitcnt vmcnt(0) lgkmcnt(0)" ::: "memory"); __builtin_amdgcn_s_barrier(); asm volatile("" ::: "memory");
        const bool bad = flag[0] != 0u;
        if (lane < 32) {
            const unsigned long long* slot = (const unsigned long long*)xbuf + (size_t)(u.pm * BM + row) * 4; float mt[4], m2[4]; float ms = 0.f;
#pragma unroll
            for (int t = 0; t < 4; ++t) { if (t < ntn) { const unsigned long long w = __hip_atomic_load(slot + t, __ATOMIC_RELAXED, __HIP_MEMORY_SCOPE_AGENT); mt[t] = __uint_as_float((unsigned)w); m2[t] = __uint_as_float((unsigned)(w >> 32)); } else { mt[t] = 0.f; m2[t] = 0.f; } ms += mt[t]; }
            const float mean = ms / (float)ntn; float q = 0.f;
#pragma unroll
            for (int t = 0; t < 4; ++t) if (t < ntn) { const float dm = mt[t] - mean; q += m2[t] + 256.0f * dm * dm; }
            S[row] = (f32x2v){mean, 1.0f / sqrtf(q / (256.0f * (float)ntn) + eps)};
        }
        asm volatile("s_waitcnt lgkmcnt(0)" ::: "memory"); __builtin_amdgcn_s_barrier(); asm volatile("" ::: "memory");
        return bad;
    }
};
struct EpiLnRes {
    static constexpr bool PERM = false, AFTER_DRAIN = true;
    const float* base; float* out; int ldc; const float* bias; PanelStats st; unsigned poison;
    __device__ __forceinline__ void fused(f32x4 (&acc)[2][2][4][2], const Unit& u, int wr, int wc, int fr, int fq, PG8_LAS unsigned char* lds, int wid, int lane) const {
        typedef float f32x2v __attribute__((ext_vector_type(2)));
        const PG8_LAS f32x2v* S = (const PG8_LAS f32x2v*)(lds + 8192);
        const int col0 = u.pn * BM + wc * 32 + 4 * fq;
#pragma unroll
        for (int bj = 0; bj < 2; ++bj)
#pragma unroll
            for (int n = 0; n < 2; ++n) { const f32x4 bv = bias ? *(const f32x4*)(bias + col0 + bj * HALF + n * 16) : (f32x4){0.f, 0.f, 0.f, 0.f};
#pragma unroll
                for (int ai = 0; ai < 2; ++ai)
#pragma unroll
                    for (int m = 0; m < 4; ++m) acc[ai][bj][m][n] += bv; }
        f32x4 pre[4][2][2];
#pragma unroll
        for (int m = 0; m < 4; ++m) { const size_t off = (size_t)(u.pm * BM + wr * 64 + m * 16 + fr) * ldc + col0;
#pragma unroll
            for (int bj = 0; bj < 2; ++bj)
#pragma unroll
                for (int n = 0; n < 2; ++n) pre[m][bj][n] = *(const f32x4*)(base + off + bj * HALF + n * 16); }
        const bool bad = st.run(acc, u, wr, wc, fr, fq, lds, wid, lane) || poison != 0u;
        const float qnan = __builtin_nanf("");
#pragma unroll
        for (int ai = 0; ai < 2; ++ai)
#pragma unroll
            for (int m = 0; m < 4; ++m) { const int r = ai * HALF + wr * 64 + m * 16 + fr; const f32x2v sr = S[r]; const size_t off = (size_t)(u.pm * BM + r) * ldc + col0;
#pragma unroll
                for (int bj = 0; bj < 2; ++bj)
#pragma unroll
                    for (int n = 0; n < 2; ++n) { const f32x4 bs = ai == 0 ? pre[m][bj][n] : *(const f32x4*)(base + off + bj * HALF + n * 16); f32x4 o = bs + (acc[ai][bj][m][n] - sr.x) * sr.y;
                        if (bad) o = (f32x4){qnan, qnan, qnan, qnan}; *(f32x4*)(out + off + bj * HALF + n * 16) = o; }
                if (m & 1) asm volatile("" ::: "memory"); }
    }
};
struct EpiLnResLn {
    static constexpr bool PERM = false, AFTER_DRAIN = true;
    const float* base; float* out; bf16_t* xn; int ldc; const float* bias; PanelStats st1, st2; unsigned poison;
    __device__ __forceinline__ void fused(f32x4 (&acc)[2][2][4][2], const Unit& u, int wr, int wc, int fr, int fq, PG8_LAS unsigned char* lds, int wid, int lane) const {
        typedef float f32x2v __attribute__((ext_vector_type(2))); typedef unsigned u32x2v __attribute__((ext_vector_type(2)));
        const PG8_LAS f32x2v* S = (const PG8_LAS f32x2v*)(lds + 8192);
        const int col0 = u.pn * BM + wc * 32 + 4 * fq;
#pragma unroll
        for (int bj = 0; bj < 2; ++bj)
#pragma unroll
            for (int n = 0; n < 2; ++n) { const f32x4 bv = bias ? *(const f32x4*)(bias + col0 + bj * HALF + n * 16) : (f32x4){0.f, 0.f, 0.f, 0.f};
#pragma unroll
                for (int ai = 0; ai < 2; ++ai)
#pragma unroll
                    for (int m = 0; m < 4; ++m) acc[ai][bj][m][n] += bv; }
        bool bad = st1.run(acc, u, wr, wc, fr, fq, lds, wid, lane) || poison != 0u;
        const float qnan = __builtin_nanf("");
#pragma unroll
        for (int ai = 0; ai < 2; ++ai)
#pragma unroll
            for (int m = 0; m < 4; ++m) { const int r = ai * HALF + wr * 64 + m * 16 + fr; const f32x2v sr = S[r]; const size_t off = (size_t)(u.pm * BM + r) * ldc + col0;
#pragma unroll
                for (int bj = 0; bj < 2; ++bj)
#pragma unroll
                    for (int n = 0; n < 2; ++n) { const f32x4 bs = *(const f32x4*)(base + off + bj * HALF + n * 16); acc[ai][bj][m][n] = bs + (acc[ai][bj][m][n] - sr.x) * sr.y; }
                asm volatile("" : "+v"(acc[ai][0][m][0]), "+v"(acc[ai][0][m][1]), "+v"(acc[ai][1][m][0]), "+v"(acc[ai][1][m][1]));
                if (m & 1) asm volatile("" ::: "memory"); }
        const bool bad1 = bad;
        bad = st2.run(acc, u, wr, wc, fr, fq, lds, wid, lane) || bad;
#pragma unroll
        for (int ai = 0; ai < 2; ++ai)
#pragma unroll
            for (int m = 0; m < 4; ++m) { const int r = ai * HALF + wr * 64 + m * 16 + fr; const f32x2v sr = S[r]; const size_t off = (size_t)(u.pm * BM + r) * ldc + col0;
#pragma unroll
                for (int bj = 0; bj < 2; ++bj)
#pragma unroll
                    for (int n = 0; n < 2; ++n) { const f32x4 x1 = acc[ai][bj][m][n]; *(f32x4*)(out + off + bj * HALF + n * 16) = bad1 ? (f32x4){qnan, qnan, qnan, qnan} : x1;
                        const f32x4 o = (x1 - sr.x) * sr.y; u32x2v w; w.x = cvt_pk_bf16(o[0], o[1]); w.y = cvt_pk_bf16(o[2], o[3]);
                        if (bad) { w.x = 0x7fc07fc0u; w.y = 0x7fc07fc0u; } *(u32x2v*)(xn + off + bj * HALF + n * 16) = w; }
                asm volatile("" ::: "memory"); }
    }
};

template <class Epi, class Sched, bool ALIGN_EPI = false, bool SP2 = false>
__device__ __forceinline__ void gemm_phase(PG8_LAS unsigned char* lds, const Gemm g, const Sched& S, const Epi& E) {
    int tid_ = threadIdx.x; asm volatile("" : "+v"(tid_));
    const int tid = tid_, wid = __builtin_amdgcn_readfirstlane(tid >> 6), lane = tid & 63, wr = wid >> 2, wc = wid & 3, fr = lane & 15, fq = lane >> 4;
    const int K = g.K, nt = K / BK;
    unsigned voffA[2], voffB[2];
#pragma unroll
    for (int i = 0; i < 2; ++i) { int R, C; stage_rc(tid * 16 + i * 8192, R, C); const int Rb = Epi::PERM ? ((R & ~31) + perm32(R & 31)) : R;
        voffA[i] = (unsigned)(R * K + C) * 2u; voffB[i] = (unsigned)(Rb * K + C) * 2u; }
    const size_t kstep = (size_t)(BK * 2);
    const size_t hstep = (size_t)HALF * K * 2;
    const size_t tstep = 2 * hstep;
    const unsigned ldsw = (unsigned)wid * 1024u;
    const int aoff = lds_byte(wr * 64 + fr, fq * 8), boff = lds_byte(wc * 32 + fr, fq * 8);
#define PG8_SA(b, h) (((b) * 2 + (h)) * HTB)
#define PG8_SB(b, h) ((4 + (b) * 2 + (h)) * HTB)
#define PG8_STAGE(bufoff, gbase, voff) do { _Pragma("unroll") for (int _i = 0; _i < 2; ++_i) \
        __builtin_amdgcn_global_load_lds((const unsigned*)((const char*)(gbase) + (voff)[_i]), (PG8_LAS unsigned*)(lds + (bufoff) + ldsw + _i * 8192), 16, 0, 0); } while (0)
#define PG8_LDA(dst, b, h) do { _Pragma("unroll") for (int m = 0; m < 4; ++m) _Pragma("unroll") for (int k = 0; k < 2; ++k) dst[m][k] = *(const PG8_LAS bf16x8*)(lds + PG8_SA(b, h) + aoff + m * 2048 + k * 1024); } while (0)
#define PG8_LDB(dst, b, h) do { _Pragma("unroll") for (int n = 0; n < 2; ++n) _Pragma("unroll") for (int k = 0; k < 2; ++k) dst[n][k] = *(const PG8_LAS bf16x8*)(lds + PG8_SB(b, h) + boff + n * 2048 + k * 1024); } while (0)
#define PG8_MMA(ai, bj, At, Bt) do { __builtin_amdgcn_s_setprio(1); _Pragma("unroll") for (int m = 0; m < 4; ++m) _Pragma("unroll") for (int n = 0; n < 2; ++n) _Pragma("unroll") for (int k = 0; k < 2; ++k) \
        acc[ai][bj][m][n] = __builtin_amdgcn_mfma_f32_16x16x32_bf16(Bt[n][k], At[m][k], acc[ai][bj][m][n], 0, 0, 0); __builtin_amdgcn_s_setprio(0); } while (0)
#define PG8_WAIT_V(n) asm volatile("s_waitcnt vmcnt(" #n ")" ::: "memory")
#define PG8_WAIT_L(n) asm volatile("s_waitcnt lgkmcnt(" #n ")" ::: "memory")
#define PG8_BAR __builtin_amdgcn_s_barrier()
#define PG8_SCHED __builtin_amdgcn_sched_barrier(0)
    Unit cur, nxt; int ui = 0;
    if (!S.next(0, cur)) return;
    f32x4 acc[2][2][4][2];
#pragma unroll
    for (int a = 0; a < 2; ++a)
#pragma unroll
        for (int b = 0; b < 2; ++b)
#pragma unroll
            for (int m = 0; m < 4; ++m)
#pragma unroll
                for (int n = 0; n < 2; ++n) acc[a][b][m][n] = (f32x4){0.f, 0.f, 0.f, 0.f};
    bf16x8 At[4][2], B0[2][2], B1[2][2];
    const char* cA = (const char*)g.A + (size_t)cur.pm * tstep; const char* cB = (const char*)g.Bt + (size_t)cur.pn * tstep;
    S.a_ready(cur);
    if constexpr (SP2) {
        PG8_STAGE(PG8_SB(0, 0), cB, voffB); PG8_STAGE(PG8_SB(0, 1), cB + hstep, voffB); PG8_STAGE(PG8_SA(0, 0), cA, voffA); PG8_STAGE(PG8_SA(0, 1), cA + hstep, voffA);
        if (wr == 1) PG8_BAR;
        PG8_WAIT_V(2); PG8_BAR;
        PG8_STAGE(PG8_SB(1, 0), cB + kstep, voffB); PG8_STAGE(PG8_SA(1, 0), cA + kstep, voffA); PG8_STAGE(PG8_SB(1, 1), cB + hstep + kstep, voffB);
        PG8_WAIT_V(6); PG8_BAR;
    } else {
        PG8_STAGE(PG8_SB(0, 0), cB, voffB); PG8_STAGE(PG8_SA(0, 0), cA, voffA); PG8_STAGE(PG8_SB(0, 1), cB + hstep, voffB); PG8_STAGE(PG8_SA(0, 1), cA + hstep, voffA);
        if (wr == 1) PG8_BAR;
        PG8_WAIT_V(4); PG8_BAR;
        PG8_STAGE(PG8_SB(1, 0), cB + kstep, voffB); PG8_STAGE(PG8_SA(1, 0), cA + kstep, voffA); PG8_STAGE(PG8_SB(1, 1), cB + hstep + kstep, voffB);
        PG8_WAIT_V(6); PG8_BAR;
    }
    for (;;) {
        const bool has_next = S.next(ui + 1, nxt);
        const char* nA = has_next ? (const char*)g.A + (size_t)nxt.pm * tstep : cA; const char* nB = has_next ? (const char*)g.Bt + (size_t)nxt.pn * tstep : cB;
        for (int t = 0; t < nt; t += 2) {
            const bool last = (t == nt - 2);
            const char* a1 = cA + (size_t)(t + 1) * kstep;
            const char* a2 = last ? nA : cA + (size_t)(t + 2) * kstep; const char* b2 = last ? nB : cB + (size_t)(t + 2) * kstep;
            const char* a3 = a2 + kstep; const char* b3 = b2 + kstep;
            if (last && has_next) S.a_ready(nxt);
            if constexpr (SP2) {
            PG8_LDB(B0, 0, 0); PG8_LDB(B1, 0, 1); PG8_SCHED; PG8_LDA(At, 0, 0); PG8_STAGE(PG8_SA(1, 1), a1 + hstep, voffA);
            PG8_WAIT_V(8); PG8_WAIT_L(0); PG8_BAR; PG8_MMA(0, 0, At, B0); PG8_MMA(0, 1, At, B1); PG8_BAR; PG8_SCHED;
            PG8_LDA(At, 0, 1); PG8_STAGE(PG8_SB(0, 0), b2, voffB); PG8_STAGE(PG8_SB(0, 1), b2 + hstep, voffB); PG8_STAGE(PG8_SA(0, 0), a2, voffA);
            PG8_WAIT_V(8); PG8_WAIT_L(0); PG8_BAR; PG8_MMA(1, 0, At, B0); PG8_MMA(1, 1, At, B1); PG8_BAR; PG8_SCHED;
            PG8_LDB(B0, 1, 0); PG8_LDB(B1, 1, 1); PG8_SCHED; PG8_LDA(At, 1, 0); PG8_STAGE(PG8_SA(0, 1), a2 + hstep, voffA);
            PG8_WAIT_V(8); PG8_WAIT_L(0); PG8_BAR; PG8_MMA(0, 0, At, B0); PG8_MMA(0, 1, At, B1); PG8_BAR; PG8_SCHED;
            PG8_LDA(At, 1, 1); PG8_STAGE(PG8_SB(1, 0), b3, voffB); PG8_STAGE(PG8_SB(1, 1), b3 + hstep, voffB); PG8_STAGE(PG8_SA(1, 0), a3, voffA);
            PG8_WAIT_V(8); PG8_WAIT_L(0); PG8_BAR; PG8_MMA(1, 0, At, B0); PG8_MMA(1, 1, At, B1); PG8_BAR; PG8_SCHED;
            } else {
            PG8_LDB(B0, 0, 0); PG8_SCHED; PG8_LDA(At, 0, 0); PG8_STAGE(PG8_SA(1, 1), a1 + hstep, voffA);
            PG8_WAIT_L(8); PG8_BAR; PG8_WAIT_L(0); PG8_MMA(0, 0, At, B0); PG8_BAR; PG8_SCHED;
            PG8_LDB(B1, 0, 1); PG8_STAGE(PG8_SB(0, 0), b2, voffB);
            PG8_BAR; PG8_WAIT_L(0); PG8_MMA(0, 1, At, B1); PG8_BAR;
            PG8_LDA(At, 0, 1); PG8_STAGE(PG8_SA(0, 0), a2, voffA);
            PG8_BAR; PG8_WAIT_L(0); PG8_MMA(1, 0, At, B0); PG8_BAR; PG8_SCHED;
            PG8_STAGE(PG8_SB(0, 1), b2 + hstep, voffB);
            PG8_WAIT_V(6); PG8_BAR; PG8_MMA(1, 1, At, B1); PG8_BAR;
            PG8_LDB(B0, 1, 0); PG8_SCHED; PG8_LDA(At, 1, 0); PG8_STAGE(PG8_SA(0, 1), a2 + hstep, voffA);
            PG8_WAIT_L(8); PG8_BAR; PG8_WAIT_L(0); PG8_MMA(0, 0, At, B0); PG8_BAR; PG8_SCHED;
            PG8_LDB(B1, 1, 1); PG8_STAGE(PG8_SB(1, 0), b3, voffB);
            PG8_BAR; PG8_WAIT_L(0); PG8_MMA(0, 1, At, B1); PG8_BAR;
            PG8_LDA(At, 1, 1); PG8_STAGE(PG8_SA(1, 0), a3, voffA);
            PG8_BAR; PG8_WAIT_L(0); PG8_MMA(1, 0, At, B0); PG8_BAR; PG8_SCHED;
            PG8_STAGE(PG8_SB(1, 1), b3 + hstep, voffB);
            PG8_WAIT_V(6); PG8_BAR; PG8_MMA(1, 1, At, B1); PG8_BAR;
            }
        }
        if constexpr (ALIGN_EPI) { if (wr == 0) PG8_BAR; }
        if constexpr (!Epi::AFTER_DRAIN) { E(acc, cur, wr, wc, fr, fq); S.done(cur); }
        if (!has_next) break;
#pragma unroll
        for (int a = 0; a < 2; ++a)
#pragma unroll
            for (int b = 0; b < 2; ++b)
#pragma unroll
                for (int m = 0; m < 4; ++m)
#pragma unroll
                    for (int n = 0; n < 2; ++n) acc[a][b][m][n] = (f32x4){0.f, 0.f, 0.f, 0.f};
        cur = nxt; cA = nA; cB = nB; ++ui;
        if constexpr (ALIGN_EPI) { if (wr == 1) PG8_BAR; }
    }
    PG8_WAIT_V(0);
    if constexpr (!ALIGN_EPI) { if (wr == 0) PG8_BAR; }
    PG8_BAR;
    if constexpr (Epi::AFTER_DRAIN) { E.fused(acc, cur, wr, wc, fr, fq, lds, wid, lane); S.done(cur); }
#undef PG8_SA
#undef PG8_SB
#undef PG8_STAGE
#undef PG8_LDA
#undef PG8_LDB
#undef PG8_MMA
#undef PG8_WAIT_V
#undef PG8_WAIT_L
#undef PG8_BAR
#undef PG8_SCHED
}
}

constexpr int NB = 16, SEQ = 2048, DM = 1024, FF = 2816, MROWS = NB * SEQ;
constexpr int NGU = 2 * FF;
constexpr int NEV = 3584;
constexpr int NOD = 3072;
constexpr float RMS_EPS = 1e-6f;
constexpr float LOG2E = 1.4426950408889634f;
constexpr float QSCALE = 0.125f * LOG2E;

#ifndef EPI_ROPE_BATCH
#define EPI_ROPE_BATCH 2
#endif
namespace epi {
using namespace pg8;
__device__ __forceinline__ unsigned pkbf(float lo, float hi) {
    typedef float f2_t __attribute__((ext_vector_type(2))); typedef __bf16 b2_t __attribute__((ext_vector_type(2)));
    f2_t v = {lo, hi}; b2_t b = __builtin_convertvector(v, b2_t); return __builtin_bit_cast(unsigned, b); }
__device__ __forceinline__ float row_rs(const float* ssq, int row) { const f32x4 p = *(const f32x4*)(ssq + (size_t)row * 4); return __builtin_amdgcn_rsqf(((p[0] + p[1]) + (p[2] + p[3])) * (1.f / DM) + RMS_EPS); }
__device__ __forceinline__ float epi_sum4fq(float s) {
    s += __int_as_float(__builtin_amdgcn_ds_swizzle(__float_as_int(s), (16 << 10) | 0x1f));
    auto rr = __builtin_amdgcn_permlane32_swap(__float_as_uint(s), __float_as_uint(s), false, false); return __uint_as_float(rr[0]) + __uint_as_float(rr[1]); }
__device__ __forceinline__ u32x4 pk8(const f32x4& a, const f32x4& b) { u32x4 w; w.x = pkbf(a[0], a[1]); w.y = pkbf(a[2], a[3]); w.z = pkbf(b[0], b[1]); w.w = pkbf(b[2], b[3]); return w; }

template <int PVAR = 0>
struct EpiSwiGLUT {
    static constexpr bool PERM = true, AFTER_DRAIN = false;
    bf16_t* H; const PG8_LAS float* tab;
    __device__ __forceinline__ void operator()(const f32x4 (&acc)[2][2][4][2], const Unit& u, int wr, int wc, int fr, int fq) const {
        typedef float f32x2 __attribute__((ext_vector_type(2)));
        const int row0 = u.pm * BM + wr * 64 + fr, col0 = u.pn * 128 + wc * 32 + 8 * fq;
        float v8[2][4];
#pragma unroll
        for (int ai = 0; ai < 2; ++ai)
#pragma unroll
            for (int m = 0; m < 4; ++m) v8[ai][m] = tab[u.idx * 256 + ai * HALF + wr * 64 + m * 16 + fr];
#pragma unroll
        for (int ai = 0; ai < 2; ++ai)
#pragma unroll
            for (int m = 0; m < 4; ++m) {
                const int row = row0 + ai * HALF + m * 16; const float v = v8[ai][m]; const float sp = -LOG2E * __builtin_amdgcn_rsqf(v);
                f32x4 h[2];
#pragma unroll
                for (int n = 0; n < 2; ++n)
#pragma unroll
                    for (int pr = 0; pr < 2; ++pr) { const f32x2 g2 = {acc[ai][0][m][n][2 * pr], acc[ai][0][m][n][2 * pr + 1]}, u2 = {acc[ai][1][m][n][2 * pr], acc[ai][1][m][n][2 * pr + 1]};
                        const f32x2 t2 = g2 * sp; f32x2 e2; e2.x = __builtin_amdgcn_exp2f(t2.x); e2.y = __builtin_amdgcn_exp2f(t2.y);
                        const f32x2 d2 = e2 * v + v; f32x2 r2; r2.x = __builtin_amdgcn_rcpf(d2.x); r2.y = __builtin_amdgcn_rcpf(d2.y);
                        const f32x2 h2 = (g2 * u2) * r2; h[n][2 * pr] = h2.x; h[n][2 * pr + 1] = h2.y; }
                if (PVAR == 1) { const u32x4 w_ = pk8(h[0], h[1]); asm volatile("" :: "v"(w_)); } else {
#ifdef EPI_NT_HID
                    __builtin_nontemporal_store(pk8(h[0], h[1]), (u32x4*)(H + (size_t)row * FF + col0));
#else
                    *(u32x4*)(H + (size_t)row * FF + col0) = pk8(h[0], h[1]);
#endif
                }
            }
    }
};
typedef EpiSwiGLUT<0> EpiSwiGLU;
struct EpiNull {
    static constexpr bool PERM = true, AFTER_DRAIN = false;
    __device__ __forceinline__ void operator()(const f32x4 (&acc)[2][2][4][2], const Unit& u, int wr, int wc, int fr, int fq) const {
#pragma unroll
        for (int ai = 0; ai < 2; ++ai)
#pragma unroll
            for (int bj = 0; bj < 2; ++bj)
#pragma unroll
                for (int m = 0; m < 4; ++m)
#pragma unroll
                    for (int n = 0; n < 2; ++n) asm volatile("" :: "v"(acc[ai][bj][m][n]));
    }
};
struct EpiBf16Y {
    static constexpr bool PERM = true, AFTER_DRAIN = false;
    bf16_t* Y;
    __device__ __forceinline__ void operator()(const f32x4 (&acc)[2][2][4][2], const Unit& u, int wr, int wc, int fr, int fq) const {
        const int row0 = u.pm * BM + wr * 64 + fr, col0 = u.pn * BM + wc * 32 + 8 * fq;
#pragma unroll
        for (int ai = 0; ai < 2; ++ai)
#pragma unroll
            for (int m = 0; m < 4; ++m) { bf16_t* rowp = Y + (size_t)(row0 + ai * HALF + m * 16) * DM + col0;
#pragma unroll
                for (int bj = 0; bj < 2; ++bj) *(u32x4*)(rowp + bj * HALF) = pk8(acc[ai][bj][m][0], acc[ai][bj][m][1]); }
    }
};
template <bool LAST, int PVAR = 0>
struct EpiRmsRes {
    static constexpr bool PERM = true, AFTER_DRAIN = false;
    bf16_t* X; float* outf; const float* ga; float alpha; unsigned long long* gran; unsigned epoch; float* ssq2; unsigned* tmo; PG8_LAS unsigned char* xl;
    __device__ __forceinline__ void operator()(const f32x4 (&acc)[2][2][4][2], const Unit& u, int wr, int wc, int fr, int fq) const {
        int tid_ = threadIdx.x; asm volatile("" : "+v"(tid_)); const int wid = __builtin_amdgcn_readfirstlane(tid_ >> 6), lane = tid_ & 63;
        PG8_LAS float* P = (PG8_LAS float*)xl;
        PG8_LAS float* S = (PG8_LAS float*)(xl + 4096);
        const int col0 = u.pn * BM + wc * 32 + 8 * fq;
        u32x4 xw8[4][2];
#pragma unroll
        for (int m = 0; m < 4; ++m)
#pragma unroll
            for (int bj = 0; bj < 2; ++bj) xw8[m][bj] = *(const u32x4*)(X + (size_t)(u.pm * BM + wr * 64 + m * 16 + fr) * DM + col0 + bj * HALF);
#pragma unroll
        for (int ai = 0; ai < 2; ++ai)
#pragma unroll
            for (int m = 0; m < 4; ++m) { float s = 0.f;
#pragma unroll
                for (int bj = 0; bj < 2; ++bj)
#pragma unroll
                    for (int n = 0; n < 2; ++n) { const f32x4 v = acc[ai][bj][m][n]; s += (v[0] * v[0] + v[1] * v[1]) + (v[2] * v[2] + v[3] * v[3]); }
                s = epi_sum4fq(s);
                if (fq == 0) P[(ai * HALF + wr * 64 + m * 16 + fr) * 4 + wc] = s; }
        asm volatile("s_waitcnt lgkmcnt(0)" ::: "memory"); __builtin_amdgcn_s_barrier(); asm volatile("" ::: "memory");
        const int row = wid * 32 + (lane & 31);
        if (lane < 32) {
            const f32x4 p = *(const PG8_LAS f32x4*)(P + row * 4); const float mine = (p[0] + p[1]) + (p[2] + p[3]);
            unsigned long long* gr = gran + ((size_t)(u.pm * BM + row)) * 4;
            __hip_atomic_store(gr + u.pn, ((unsigned long long)epoch << 32) | (unsigned long long)__float_as_uint(mine), __ATOMIC_RELAXED, __HIP_MEMORY_SCOPE_AGENT);
            float t = 0.f; bool ok = false;
            for (unsigned spins = 0; spins < ((PVAR & 1) ? 0u : (1u << 18)); ++spins) {
                unsigned long long w[4]; bool all4 = true; t = 0.f;
#pragma unroll
                for (int k = 0; k < 4; ++k) { w[k] = __hip_atomic_load(gr + k, __ATOMIC_RELAXED, __HIP_MEMORY_SCOPE_AGENT); all4 = all4 && ((unsigned)(w[k] >> 32) == epoch); t += __uint_as_float((unsigned)w[k]); }
                if (__all(all4)) { ok = true; break; }
                __builtin_amdgcn_s_sleep(1);
            }
            if (PVAR & 1) { ok = true; t = 4.f * mine; }
            if (!ok && lane == 0) __hip_atomic_store(tmo, 1u, __ATOMIC_RELAXED, __HIP_MEMORY_SCOPE_AGENT);
            S[row] = alpha * __builtin_amdgcn_rsqf(t * (1.f / DM) + RMS_EPS);
        }
        asm volatile("s_waitcnt lgkmcnt(0)" ::: "memory"); __builtin_amdgcn_s_barrier(); asm volatile("" ::: "memory");
        if (PVAR & 2) return;
        f32x4 g[2][2];
#pragma unroll
        for (int bj = 0; bj < 2; ++bj)
#pragma unroll
            for (int n = 0; n < 2; ++n) g[bj][n] = *(const f32x4*)(ga + col0 + bj * HALF + 4 * n);
#pragma unroll
        for (int ai = 0; ai < 2; ++ai) {
            if (ai == 1) {
#pragma unroll
                for (int m = 0; m < 4; ++m)
#pragma unroll
                    for (int bj = 0; bj < 2; ++bj) xw8[m][bj] = *(const u32x4*)(X + (size_t)(u.pm * BM + HALF + wr * 64 + m * 16 + fr) * DM + col0 + bj * HALF);
            }
#pragma unroll
            for (int m = 0; m < 4; ++m) { const int rl = ai * HALF + wr * 64 + m * 16 + fr; const size_t off = (size_t)(u.pm * BM + rl) * DM + col0; const float sr = S[rl]; float q = 0.f;
#pragma unroll
                for (int bj = 0; bj < 2; ++bj) { const u32x4 xw = xw8[m][bj]; f32x4 xn[2];
#pragma unroll
                    for (int n = 0; n < 2; ++n) { const f32x4 xo = {__uint_as_float(xw[2 * n] << 16), __uint_as_float(xw[2 * n] & 0xffff0000u), __uint_as_float(xw[2 * n + 1] << 16), __uint_as_float(xw[2 * n + 1] & 0xffff0000u)};
                        xn[n] = xo + acc[ai][bj][m][n] * sr * g[bj][n]; q += (xn[n][0] * xn[n][0] + xn[n][1] * xn[n][1]) + (xn[n][2] * xn[n][2] + xn[n][3] * xn[n][3]); }
                    if (LAST) { *(f32x4*)(outf + off + bj * HALF) = xn[0]; *(f32x4*)(outf + off + bj * HALF + 4) = xn[1]; }
                    else *(u32x4*)(X + off + bj * HALF) = pk8(xn[0], xn[1]); }
                if (!LAST) { q = epi_sum4fq(q); if (fq == 0) P[rl * 4 + wc] = q; } } }
        if (!LAST) {
            asm volatile("s_waitcnt lgkmcnt(0)" ::: "memory"); __builtin_amdgcn_s_barrier(); asm volatile("" ::: "memory");
            if (lane < 32) { const f32x4 p = *(const PG8_LAS f32x4*)(P + row * 4); ssq2[((size_t)(u.pm * BM + row)) * 4 + u.pn] = (p[0] + p[1]) + (p[2] + p[3]); }
        }
    }
};
struct OrdOrder {
    StaticOrder base;
    __device__ __forceinline__ bool next(int i, Unit& u) const { const bool ok = base.next(i, u); u.idx = i; return ok; }
    __device__ __forceinline__ void a_ready(const Unit&) const {}
    __device__ __forceinline__ void done(const Unit&) const {}
};
__device__ __forceinline__ void rowstat_table(const OrdOrder& S, const float* ssq, PG8_LAS float* tab, int nunits) {
    int tid = threadIdx.x; asm volatile("" : "+v"(tid));
    for (int e = tid; e < nunits * 256; e += 512) { Unit u; S.next(e >> 8, u); const f32x4 p = *(const f32x4*)(ssq + (size_t)(u.pm * BM + (e & 255)) * 4); tab[e] = ((p[0] + p[1]) + (p[2] + p[3])) * (1.f / DM) + RMS_EPS; }
    __syncthreads();
}
struct HotOrder {
    int n, c;
    __device__ __forceinline__ bool next(int i, Unit& u) const { if (i >= n) return false; u.pm = c & 7; u.pn = (c >> 3) & 3; return true; }
    __device__ __forceinline__ void a_ready(const Unit&) const {}
    __device__ __forceinline__ void done(const Unit&) const {}
};
struct OneRound {
    StaticOrder base; int round;
    __device__ __forceinline__ bool next(int i, Unit& u) const { return i == 0 && base.next(round, u); }
    __device__ __forceinline__ void a_ready(const Unit&) const {}
    __device__ __forceinline__ void done(const Unit&) const {}
};
struct EpiF32 {
    static constexpr bool PERM = false, AFTER_DRAIN = false;
    float* Y; int ldc;
    __device__ __forceinline__ void operator()(const f32x4 (&acc)[2][2][4][2], const Unit& u, int wr, int wc, int fr, int fq) const {
        const int row0 = u.pm * BM + wr * 64 + fr, col0 = u.pn * BM + wc * 32 + 4 * fq;
#pragma unroll
        for (int ai = 0; ai < 2; ++ai)
#pragma unroll
            for (int m = 0; m < 4; ++m) { float* rowp = Y + (size_t)(row0 + ai * HALF + m * 16) * ldc + col0;
#pragma unroll
                for (int bj = 0; bj < 2; ++bj)
#pragma unroll
                    for (int n = 0; n < 2; ++n) *(f32x4*)(rowp + bj * HALF + n * 16) = acc[ai][bj][m][n]; }
    }
};
struct EpiProjOdd {
    static constexpr bool PERM = true, AFTER_DRAIN = false;
    bf16_t* Q; const PG8_LAS float* tab;
    __device__ __forceinline__ void operator()(const f32x4 (&acc)[2][2][4][2], const Unit& u, int wr, int wc, int fr, int fq) const {
        const int t = u.pn >> 2; bf16_t* base = Q + (size_t)t * ((size_t)MROWS * DM); const float sc = t == 0 ? QSCALE : 1.f;
        const int row0 = u.pm * BM + wr * 64 + fr, col0 = (u.pn & 3) * BM + wc * 32 + 8 * fq;
        float sc8[2][4];
#pragma unroll
        for (int ai = 0; ai < 2; ++ai)
#pragma unroll
            for (int m = 0; m < 4; ++m) sc8[ai][m] = __builtin_amdgcn_rsqf(tab[u.idx * 256 + ai * HALF + wr * 64 + m * 16 + fr]);
#pragma unroll
        for (int ai = 0; ai < 2; ++ai)
#pragma unroll
            for (int m = 0; m < 4; ++m) { const int row = row0 + ai * HALF + m * 16; const float s = sc8[ai][m] * sc;
#pragma unroll
                for (int bj = 0; bj < 2; ++bj) *(u32x4*)(base + (size_t)row * DM + col0 + bj * HALF) = pk8(acc[ai][bj][m][0] * s, acc[ai][bj][m][1] * s); }
    }
};
struct EpiProjEven {
    static constexpr bool PERM = true, AFTER_DRAIN = false;
    bf16_t *R1, *IQ, *IK; float* IW; const PG8_LAS float* tab;
    const unsigned* c64; const float *c32, *s32;
    __device__ __forceinline__ void operator()(const f32x4 (&acc)[2][2][4][2], const Unit& u, int wr, int wc, int fr, int fq) const {
        const int pn = u.pn, row0 = u.pm * BM + wr * 64 + fr;
        float sc8[2][4];
#pragma unroll
        for (int ai = 0; ai < 2; ++ai)
#pragma unroll
            for (int m = 0; m < 4; ++m) sc8[ai][m] = __builtin_amdgcn_rsqf(tab[u.idx * 256 + ai * HALF + wr * 64 + m * 16 + fr]);
        if (pn == 4 || pn == 5 || pn == 10 || pn == 11) {
            bf16_t* base = R1 + (size_t)(pn >> 1) * ((size_t)MROWS * 512); const int col0 = (pn & 1) * BM + wc * 32 + 8 * fq;
#pragma unroll
            for (int ai = 0; ai < 2; ++ai)
#pragma unroll
                for (int m = 0; m < 4; ++m) { const int row = row0 + ai * HALF + m * 16; const float s = sc8[ai][m];
#pragma unroll
                    for (int bj = 0; bj < 2; ++bj) *(u32x4*)(base + (size_t)row * 512 + col0 + bj * HALF) = pk8(acc[ai][bj][m][0] * s, acc[ai][bj][m][1] * s); }
        } else if (pn < 12) {
            bf16_t* base = R1 + (size_t)(pn >> 1) * ((size_t)MROWS * 512);
            const float sc = (pn < 2 || pn == 6 || pn == 7) ? QSCALE : 1.f;
            const int head = 4 * (pn & 1) + wc, d0 = 8 * fq;
#pragma unroll
            for (int ai = 0; ai < 2; ++ai) {
                u32x4 cs[4][2];
#pragma unroll
                for (int m = 0; m < 4; ++m) { const int pos = (row0 + ai * HALF + m * 16) & (SEQ - 1);
#pragma unroll
                    for (int n = 0; n < 2; ++n) cs[m][n] = *(const u32x4*)(c64 + pos * 32 + d0 + 4 * n); }
#pragma unroll
                for (int m = 0; m < 4; ++m) { const int row = row0 + ai * HALF + m * 16; const float s = sc8[ai][m] * sc;
                    f32x4 o1[2], o2[2];
#pragma unroll
                    for (int n = 0; n < 2; ++n) { f32x4 cc, ss;
#pragma unroll
                        for (int j = 0; j < 4; ++j) { typedef _Float16 h2_t __attribute__((ext_vector_type(2))); const unsigned w_ = cs[m][n][j];
                            const h2_t h = __builtin_bit_cast(h2_t, w_); cc[j] = (float)h.x * s; ss[j] = (float)h.y * s; }
                        const f32x4 x1 = acc[ai][0][m][n], x2 = acc[ai][1][m][n]; o1[n] = x1 * cc - x2 * ss; o2[n] = x2 * cc + x1 * ss; }
                    bf16_t* dst = base + (size_t)row * 512 + head * 64 + d0;
                    *(u32x4*)dst = pk8(o1[0], o1[1]); *(u32x4*)(dst + 32) = pk8(o2[0], o2[1]); } }
        } else if (pn == 12) {
            const int head = 2 * wc + (fq >> 1), d0 = 8 * (fq & 1);
#pragma unroll
            for (int ai = 0; ai < 2; ++ai)
#pragma unroll
                for (int m = 0; m < 4; ++m) { const int row = row0 + ai * HALF + m * 16, pos = row & (SEQ - 1); const float s = sc8[ai][m];
                    f32x4 o1[2], o2[2];
#pragma unroll
                    for (int n = 0; n < 2; ++n) { const f32x4 cc = *(const f32x4*)(c32 + pos * 16 + d0 + 4 * n), ss = *(const f32x4*)(s32 + pos * 16 + d0 + 4 * n);
                        const f32x4 x1 = acc[ai][0][m][n] * s, x2 = acc[ai][1][m][n] * s; o1[n] = x1 * cc - x2 * ss; o2[n] = x2 * cc + x1 * ss; }
                    bf16_t* dst = IQ + (size_t)row * 256 + head * 32 + d0;
                    *(u32x4*)dst = pk8(o1[0], o1[1]); *(u32x4*)(dst + 16) = pk8(o2[0], o2[1]); }
        } else {
            if (wc == 0 && fq < 2) {
                const int d0 = 8 * fq;
#pragma unroll
                for (int ai = 0; ai < 2; ++ai)
#pragma unroll
                    for (int m = 0; m < 4; ++m) { const int row = row0 + ai * HALF + m * 16, pos = row & (SEQ - 1); const float s = sc8[ai][m];
                        f32x4 o1[2], o2[2];
#pragma unroll
                        for (int n = 0; n < 2; ++n) { const f32x4 cc = *(const f32x4*)(c32 + pos * 16 + d0 + 4 * n), ss = *(const f32x4*)(s32 + pos * 16 + d0 + 4 * n);
                            const f32x4 x1 = acc[ai][0][m][n] * s, x2 = acc[ai][1][m][n] * s; o1[n] = x1 * cc - x2 * ss; o2[n] = x2 * cc + x1 * ss; }
                        bf16_t* dst = IK + (size_t)row * 32 + d0;
                        *(u32x4*)dst = pk8(o1[0], o1[1]); *(u32x4*)(dst + 16) = pk8(o2[0], o2[1]); }
            } else if (wc == 0 && fq == 2) {
#pragma unroll
                for (int ai = 0; ai < 2; ++ai)
#pragma unroll
                    for (int m = 0; m < 4; ++m) { const int row = row0 + ai * HALF + m * 16; const float s = sc8[ai][m] * 0.0625f;
                        *(f32x4*)(IW + (size_t)row * 8) = acc[ai][0][m][0] * s; *(f32x4*)(IW + (size_t)row * 8 + 4) = acc[ai][0][m][1] * s; }
            }
        }
    }
};
}

namespace att {
#define ALAS __attribute__((address_space(3)))
typedef unsigned short bf16_t;
typedef short bf16x8 __attribute__((ext_vector_type(8)));
typedef short s16x4 __attribute__((ext_vector_type(4)));
typedef float f32x16 __attribute__((ext_vector_type(16)));
typedef float f32x4 __attribute__((ext_vector_type(4)));
typedef unsigned u32x4 __attribute__((ext_vector_type(4)));
typedef short v4i16_t __attribute__((ext_vector_type(4)));
__device__ __forceinline__ int crow(int r, int hi) { return (r & 3) + 8 * (r >> 2) + 4 * hi; }
__device__ __forceinline__ unsigned cvtpk(float lo, float hi) { typedef float f2_t __attribute__((ext_vector_type(2))); typedef __bf16 b2_t __attribute__((ext_vector_type(2)));
    f2_t v = {lo, hi}; b2_t b = __builtin_convertvector(v, b2_t); return __builtin_bit_cast(unsigned, b); }
__device__ __forceinline__ s16x4 vtr(const ALAS unsigned char* p) { return __builtin_bit_cast(s16x4, __builtin_amdgcn_ds_read_tr16_b64_v4i16((ALAS v4i16_t*)p)); }
__device__ __forceinline__ float halfswap_max(float m) { auto rr = __builtin_amdgcn_permlane32_swap(__float_as_uint(m), __float_as_uint(m), false, false); return fmaxf(__uint_as_float(rr[0]), __uint_as_float(rr[1])); }
__device__ __forceinline__ float halfswap_sum(float m) { auto rr = __builtin_amdgcn_permlane32_swap(__float_as_uint(m), __float_as_uint(m), false, false); return __uint_as_float(rr[0]) + __uint_as_float(rr[1]); }

template <int DV> struct Lds {
#ifndef ATT_VPRE
#define ATT_VPRE 0
#endif
#ifndef ATT_KPRE2
#define ATT_KPRE2 0
#endif
#ifndef ATT_QLDS128
#define ATT_QLDS128 0
#endif
#ifndef ATT_R64
#define ATT_R64 4
#endif
    static constexpr int R = (DV == 64) ? ATT_R64 : 3, D = R - 1;
    static constexpr int KB = 8192, VB = DV * 128;
    static constexpr int OFF_K = 0, OFF_V = R * KB, OFF_MW = OFF_V + R * VB, OFF_WSF = OFF_MW + 8 * R * 256, OFF_BT = OFF_WSF + 8 * 256, OFF_OST = OFF_BT + 10240, OST_W = 4096, TOTAL = OFF_OST + 8 * OST_W;
};
__device__ __forceinline__ void glds16(const void* gsrc, unsigned lds_dst) { unsigned keep;
    asm volatile("s_mov_b32 %0, m0\n\ts_mov_b32 m0, %2\n\ts_nop 0\n\tglobal_load_lds_dwordx4 %1, off\n\ts_mov_b32 m0, %0" : "=&s"(keep) : "v"(gsrc), "s"(lds_dst) : "memory"); }
__device__ __forceinline__ void glds4(const void* gsrc, unsigned lds_dst) { unsigned keep;
    asm volatile("s_mov_b32 %0, m0\n\ts_mov_b32 m0, %2\n\ts_nop 0\n\tglobal_load_lds_dword %1, off\n\ts_mov_b32 m0, %0" : "=&s"(keep) : "v"(gsrc), "s"(lds_dst) : "memory"); }

template <int DV, int MODE, int THR>
__device__ __forceinline__ void attn_core(f32x16 (&o)[DV / 32], ALAS unsigned char* lds,
                                          const bf16_t* Qw, int ldq, const bf16_t* Kh, int ldk, const bf16_t* Vh, int ldv,
                                          int T0, int T1, int tw0, int tw1,
                                          const unsigned long long* maskrow, int qpos, int qchunk, int att_probe_hotmask = -1, int att_probe_skip = 0,
                                          const bf16_t* nKh = nullptr, const bf16_t* nVh = nullptr, const unsigned long long* nmask = nullptr, int nT0 = 0, int nT1 = 0, int pre_in = 0, int* pre_out = nullptr) {
    typedef Lds<DV> L; constexpr int NDB = DV / 32, NVP = DV / 64, R = L::R, D = L::D, NDMA = 1 + NVP + (MODE == 1 ? 1 : 0);
    int tid = threadIdx.x; asm volatile("" : "+v"(tid));
    const int lane = tid & 63, r32 = lane & 31, hi = lane >> 5; const int wid = __builtin_amdgcn_readfirstlane(tid >> 6);
    ALAS float* wsf = (ALAS float*)(lds + L::OFF_WSF) + wid * 64;
    const ALAS float* btab = (const ALAS float*)(lds + L::OFF_BT);
    constexpr bool QLDS = (DV == 128 && ATT_QLDS128);
    ALAS unsigned char* qst = lds + L::OFF_OST + wid * L::OST_W + lane * 16;
    bf16x8 qr[4];
#pragma unroll
    for (int d0 = 0; d0 < 4; ++d0) { qr[d0] = *(const bf16x8*)(Qw + (size_t)r32 * ldq + d0 * 16 + hi * 8); if (QLDS) *(ALAS bf16x8*)(qst + d0 * 1024) = qr[d0]; }
    const int krow = 8 * wid + (lane >> 3), kkey = krow ^ ((krow >> 3) & 1), kch = (lane & 7) ^ (kkey & 7);
    const bf16_t* ksrc = Kh + (size_t)kkey * ldk + kch * 8;
    const bf16_t* vsrc = Vh + (size_t)(16 * (wid & 3) + (lane >> 2)) * ldv + 32 * (wid >> 2) + 8 * (lane & 3);
    const unsigned* msrc = (const unsigned*)maskrow + hi;
    const unsigned lds0 = (unsigned)(__SIZE_TYPE__)lds;
    const unsigned kdst = lds0 + L::OFF_K + wid * 1024, vdst = lds0 + L::OFF_V + (wid >> 2) * 4096 + (wid & 3) * 1024, mdstb = lds0 + L::OFF_MW + wid * (R * 256);
    ALAS unsigned char* mdst = lds + L::OFF_MW + wid * (R * 256);
#define ATT_U(x) ((unsigned)__builtin_amdgcn_readfirstlane((int)(x)))
#define ATT_TT(t) (T0 + (((t) - T0) & att_probe_hotmask))
#define ATT_DMA_K(t, sl) glds16(ksrc + (size_t)ATT_TT(t) * 64 * ldk, ATT_U(kdst + (sl) * L::KB))
#define ATT_DMA_V(t, sl) do { glds16(vsrc + (size_t)ATT_TT(t) * 64 * ldv, ATT_U(vdst + (sl) * L::VB)); if (NVP == 2) glds16(vsrc + (size_t)ATT_TT(t) * 64 * ldv + 64, ATT_U(vdst + (sl) * L::VB + 8192)); \
                              if (MODE == 1) glds4(msrc + 2 * (t), ATT_U(mdstb + (sl) * 256)); } while (0)
    int kfo[4];
#pragma unroll
    for (int d0 = 0; d0 < 4; ++d0) kfo[d0] = (r32 ^ ((r32 >> 3) & 1)) * 128 + (((2 * d0 + hi) ^ (r32 & 7)) * 16);
#define ATT_QK(P0, P1, t, ks) do { \
        if (MODE == 2) { const int jrel_ = qchunk - (t); \
            if (jrel_ >= 5) { const float bc_ = btab[638]; _Pragma("unroll") for (int r = 0; r < 16; ++r) { P0[r] = bc_; P1[r] = bc_; } } \
            else { const int bq_ = qpos - 64 * (t) + 60 - 4 * hi, sh_ = bq_ & 3;     \
                const ALAS float* bp_ = btab + sh_ * 640 + (bq_ - sh_ - 56); \
                _Pragma("unroll") for (int g = 0; g < 4; ++g) { const f32x4 v0_ = *(const ALAS f32x4*)(bp_ + 56 - 8 * g), v1_ = *(const ALAS f32x4*)(bp_ + 24 - 8 * g); \
                    _Pragma("unroll") for (int j = 0; j < 4; ++j) { P0[4 * g + j] = v0_[3 - j]; P1[4 * g + j] = v1_[3 - j]; } } } \
        } else { P0 = f32x16{}; P1 = f32x16{}; } \
        const ALAS unsigned char* kb_ = lds + L::OFF_K + (ks) * L::KB; \
        _Pragma("unroll") for (int d0 = 0; d0 < 4; ++d0) { const bf16x8 b0_ = *(const ALAS bf16x8*)(kb_ + kfo[d0]), b1_ = *(const ALAS bf16x8*)(kb_ + kfo[d0] + 4096); \
            const bf16x8 q_ = QLDS ? *(const ALAS bf16x8*)(qst + d0 * 1024) : qr[d0]; \
            P0 = __builtin_amdgcn_mfma_f32_32x32x16_bf16(b0_, q_, P0, 0, 0, 0); P1 = __builtin_amdgcn_mfma_f32_32x32x16_bf16(b1_, q_, P1, 0, 0, 0); } } while (0)
#define ATT_QK_INIT(P0, P1, t) do { \
        if (MODE == 2) { const int jrel_ = qchunk - (t); \
            if (jrel_ >= 5) { const float bc_ = btab[638]; _Pragma("unroll") for (int r = 0; r < 16; ++r) { P0[r] = bc_; P1[r] = bc_; } } \
            else { const int bq_ = qpos - 64 * (t) + 60 - 4 * hi, sh_ = bq_ & 3;     \
                const ALAS float* bp_ = btab + sh_ * 640 + (bq_ - sh_ - 56); \
                _Pragma("unroll") for (int g = 0; g < 4; ++g) { const f32x4 v0_ = *(const ALAS f32x4*)(bp_ + 56 - 8 * g), v1_ = *(const ALAS f32x4*)(bp_ + 24 - 8 * g); \
                    _Pragma("unroll") for (int j = 0; j < 4; ++j) { P0[4 * g + j] = v0_[3 - j]; P1[4 * g + j] = v1_[3 - j]; } } } \
        } else { P0 = f32x16{}; P1 = f32x16{}; } } while (0)
#define ATT_QK_HALF(P0, P1, kb_, dlo) do { \
        _Pragma("unroll") for (int d0 = (dlo); d0 < (dlo) + 2; ++d0) { const bf16x8 b0_ = *(const ALAS bf16x8*)((kb_) + kfo[d0]), b1_ = *(const ALAS bf16x8*)((kb_) + kfo[d0] + 4096); \
            const bf16x8 q_ = QLDS ? *(const ALAS bf16x8*)(qst + d0 * 1024) : qr[d0]; \
            P0 = __builtin_amdgcn_mfma_f32_32x32x16_bf16(b0_, q_, P0, 0, 0, 0); P1 = __builtin_amdgcn_mfma_f32_32x32x16_bf16(b1_, q_, P1, 0, 0, 0); } } while (0)
    constexpr int NV = NDMA - 1;
#define ATT_CK(j) (((j) <= T0 + D) ? ((j) - T0) * NDMA + 1 : ((j) - 1 - T0) * NDMA + 2)
#define ATT_CV(j) (((j) < T0 + D) ? ((j) - T0 + 1) * NDMA : ((j) - T0) * NDMA + 2 + NV)
#define ATT_WAIT_BAR_N(n_) do { const int nn_ = (n_); \
        if (nn_ <= 0) asm volatile("s_waitcnt vmcnt(0) lgkmcnt(0)\n\ts_barrier" ::: "memory"); \
        else if (nn_ == 1) asm volatile("s_waitcnt vmcnt(1) lgkmcnt(0)\n\ts_barrier" ::: "memory"); \
        else if (nn_ == 2) asm volatile("s_waitcnt vmcnt(2) lgkmcnt(0)\n\ts_barrier" ::: "memory"); \
        else if (nn_ == 3) asm volatile("s_waitcnt vmcnt(3) lgkmcnt(0)\n\ts_barrier" ::: "memory"); \
        else if (nn_ == 4) asm volatile("s_waitcnt vmcnt(4) lgkmcnt(0)\n\ts_barrier" ::: "memory"); \
        else if (nn_ == 5) asm volatile("s_waitcnt vmcnt(5) lgkmcnt(0)\n\ts_barrier" ::: "memory"); \
        else if (nn_ == 6) asm volatile("s_waitcnt vmcnt(6) lgkmcnt(0)\n\ts_barrier" ::: "memory"); \
        else if (nn_ == 7) asm volatile("s_waitcnt vmcnt(7) lgkmcnt(0)\n\ts_barrier" ::: "memory"); \
        else if (nn_ == 8) asm volatile("s_waitcnt vmcnt(8) lgkmcnt(0)\n\ts_barrier" ::: "memory"); \
        else if (nn_ == 9) asm volatile("s_waitcnt vmcnt(9) lgkmcnt(0)\n\ts_barrier" ::: "memory"); \
        else if (nn_ == 10) asm volatile("s_waitcnt vmcnt(10) lgkmcnt(0)\n\ts_barrier" ::: "memory"); \
        else if (nn_ == 11) asm volatile("s_waitcnt vmcnt(11) lgkmcnt(0)\n\ts_barrier" ::: "memory"); \
        else asm volatile("s_waitcnt vmcnt(12) lgkmcnt(0)\n\ts_barrier" ::: "memory"); } while (0)
#define ATT_END_STEP(t) do { int need_ = 0; if ((t) + 2 < T1) need_ = ATT_CK((t) + 2); if ((t) + 1 < T1) { const int cv_ = ATT_CV((t) + 1); need_ = cv_ > need_ ? cv_ : need_; } \
        ATT_WAIT_BAR_N(need_ ? n_issued - need_ : 0); } while (0)
    int n_issued = 0;
#ifdef ATT_PRIO
    if (wid >= 4) __builtin_amdgcn_s_setprio(1);
#endif
    float m_run = -1e30f, l_part = 0.f;
#pragma unroll
    for (int d0 = 0; d0 < NDB; ++d0) o[d0] = f32x16{};
    if (pre_in > 0) n_issued = pre_in;
    else {
#pragma unroll
        for (int i = 0; i <= D; ++i) { if (T0 + i < T1) { ATT_DMA_K(T0 + i, i); n_issued += 1; } if (i < D && T0 + i < T1) { ATT_DMA_V(T0 + i, i); n_issued += NV; } }
    }
    ATT_WAIT_BAR_N(n_issued - 1);
    f32x16 pc0, pc1, pn0, pn1;
    pc0 = f32x16{}; pc1 = f32x16{}; pn0 = f32x16{}; pn1 = f32x16{};
    if (tw0 == T0) { ATT_QK(pc0, pc1, T0, 0); }
    ATT_END_STEP(T0 - 1);
    int sk = 1 % R, sv = 0, si_k = 0, si_v = D % R;
    for (int t = T0; t < T1; ++t) {
        const bool steady = (t + 1 + D < T1);
        if (steady) { ATT_DMA_K(t + 1 + D, si_k); n_issued += 1; }
        if (t + D < T1) { ATT_DMA_V(t + D, si_v); n_issued += NV; }
        const bool act = (t >= tw0 && t < tw1), nxt = (t + 1 >= tw0 && t + 1 < tw1);
        if (nxt && !act) { ATT_QK(pn0, pn1, t + 1, sk); }
        if (act) {
            const ALAS unsigned char* kbn_ = lds + L::OFF_K + sk * L::KB;
            constexpr bool KPRE2 = (DV == 64) && (ATT_KPRE2 != 0);
            bf16x8 kq0[KPRE2 ? 4 : 1], kq1[KPRE2 ? 4 : 1];
            if (KPRE2) { if (nxt) {
#pragma unroll
                for (int d0 = 0; d0 < 4; ++d0) { kq0[d0] = *(const ALAS bf16x8*)(kbn_ + kfo[d0]); kq1[d0] = *(const ALAS bf16x8*)(kbn_ + kfo[d0] + 4096); }
                ATT_QK_INIT(pn0, pn1, t + 1); }
                __builtin_amdgcn_sched_barrier(0);
            } else { if (nxt) { ATT_QK_INIT(pn0, pn1, t + 1); ATT_QK_HALF(pn0, pn1, kbn_, 0); } }
            if (MODE == 1) { const ALAS unsigned* mp = (const ALAS unsigned*)(mdst + sv * 256); const unsigned w0 = mp[r32] >> (4 * hi), w1 = mp[32 + r32] >> (4 * hi);
#pragma unroll
                for (int r = 0; r < 16; ++r) { const int sh = 31 - ((r & 3) + 8 * (r >> 2));
                    const unsigned m0 = (unsigned)(((int)(w0 << sh)) >> 31), m1 = (unsigned)(((int)(w1 << sh)) >> 31);
                    pc0[r] = __uint_as_float((__float_as_uint(pc0[r]) & m0) | (0xff800000u & ~m0)); pc1[r] = __uint_as_float((__float_as_uint(pc1[r]) & m1) | (0xff800000u & ~m1)); } }
            float mx = fmaxf(fmaxf(pc0[0], pc1[0]), pc0[1]);
#pragma unroll
            for (int r = 1; r < 16; ++r) mx = (r == 1) ? fmaxf(mx, pc1[1]) : fmaxf(fmaxf(mx, pc0[r]), pc1[r]);
            mx = halfswap_max(mx);
            if (__any(mx > m_run + (float)THR)) {
                const float mnew = fmaxf(m_run, mx); const float f = __builtin_amdgcn_exp2f(m_run - mnew);
                l_part *= f; m_run = mnew; if (hi == 0) wsf[r32] = f;
#pragma unroll
                for (int r = 0; r < 16; ++r) { const float fr_ = wsf[crow(r, hi)];
#pragma unroll
                    for (int d0 = 0; d0 < NDB; ++d0) o[d0][r] *= fr_; }
            }
            if (KPRE2) { if (nxt) {
#pragma unroll
                for (int d0 = 0; d0 < 4; ++d0) { pn0 = __builtin_amdgcn_mfma_f32_32x32x16_bf16(kq0[KPRE2 ? d0 : 0], qr[d0], pn0, 0, 0, 0); pn1 = __builtin_amdgcn_mfma_f32_32x32x16_bf16(kq1[KPRE2 ? d0 : 0], qr[d0], pn1, 0, 0, 0); } }
            } else { if (nxt) { ATT_QK_HALF(pn0, pn1, kbn_, 2); } }
            const ALAS unsigned char* vb = lds + L::OFF_V + sv * L::VB + ((lane >> 4) & 1) * 32 + (lane & 3) * 8 + (4 * hi + ((lane & 15) >> 2)) * 64;
            constexpr bool VPRE = (DV == 64) && (ATT_VPRE != 0);
            s16x4 vlo[VPRE ? 8 : 1], vup[VPRE ? 8 : 1];
            if (VPRE) {
#pragma unroll
                for (int i = 0; i < 8; ++i) { vlo[i] = vtr(vb + (i >> 2) * 4096 + (i & 3) * 1024); vup[i] = vtr(vb + (i >> 2) * 4096 + (i & 3) * 1024 + 512); }
                __builtin_amdgcn_sched_barrier(0);
            }
            float sa = 0.f, sb = 0.f;
#pragma unroll
            for (int r = 0; r < 16; ++r) { pc0[r] = __builtin_amdgcn_exp2f(pc0[r] - m_run); pc1[r] = __builtin_amdgcn_exp2f(pc1[r] - m_run); sa += pc0[r]; sb += pc1[r]; }
            l_part += sa + sb;
            u32x4 pw[4];
#pragma unroll
            for (int k = 0; k < 2; ++k)
#pragma unroll
                for (int j = 0; j < 4; ++j) { pw[k][j] = cvtpk(pc0[8 * k + 2 * j], pc0[8 * k + 2 * j + 1]); pw[2 + k][j] = cvtpk(pc1[8 * k + 2 * j], pc1[8 * k + 2 * j + 1]); }
#pragma unroll
            for (int d0 = 0; d0 < NDB; ++d0)
#pragma unroll
                for (int ks = 0; ks < 4; ++ks) { const s16x4 lo = VPRE ? vlo[VPRE ? d0 * 4 + ks : 0] : vtr(vb + d0 * 4096 + ks * 1024), up = VPRE ? vup[VPRE ? d0 * 4 + ks : 0] : vtr(vb + d0 * 4096 + ks * 1024 + 512);
                    const bf16x8 vf = (bf16x8){lo[0], lo[1], lo[2], lo[3], up[0], up[1], up[2], up[3]};
                    o[d0] = __builtin_amdgcn_mfma_f32_32x32x16_bf16(__builtin_bit_cast(bf16x8, pw[ks]), vf, o[d0], 0, 0, 0); }
        }
        pc0 = pn0; pc1 = pn1;
        sk = (sk + 1 == R) ? 0 : sk + 1; sv = (sv + 1 == R) ? 0 : sv + 1; si_k = (si_k + 1 == R) ? 0 : si_k + 1; si_v = (si_v + 1 == R) ? 0 : si_v + 1;
        ATT_END_STEP(t);
    }
    if (pre_out) {
        int cnt_ = 0;
        if (nT1 > nT0) {
            const bf16_t* ksrc0_ = ksrc; const bf16_t* vsrc0_ = vsrc; const unsigned* msrc0_ = msrc;
            ksrc = ksrc0_ + (nKh - Kh); vsrc = vsrc0_ + (nVh - Vh); msrc = (const unsigned*)nmask + hi;
            { const int T0 = nT0, T1 = nT1;
#pragma unroll
              for (int i = 0; i <= D; ++i) { if (T0 + i < T1) { ATT_DMA_K(T0 + i, i); cnt_ += 1; } if (i < D && T0 + i < T1) { ATT_DMA_V(T0 + i, i); cnt_ += NV; } } }
            ksrc = ksrc0_; vsrc = vsrc0_; msrc = msrc0_;
        }
        *pre_out = cnt_;
    }
#undef ATT_U
#undef ATT_TT
#undef ATT_DMA_K
#undef ATT_DMA_V
#undef ATT_QK
#undef ATT_QK_INIT
#undef ATT_QK_HALF
#undef ATT_CK
#undef ATT_CV
#undef ATT_WAIT_BAR_N
#undef ATT_END_STEP
#ifdef ATT_PRIO
    __builtin_amdgcn_s_setprio(0);
#endif
    const float l = halfswap_sum(l_part);
    if (hi == 0) wsf[32 + r32] = l;
#pragma unroll
    for (int r = 0; r < 16; ++r) { const float rl = 1.0f / wsf[32 + crow(r, hi)];
#pragma unroll
        for (int d0 = 0; d0 < NDB; ++d0) o[d0][r] *= rl; }
}

template <int DV>
__device__ __forceinline__ void store_o(const f32x16 (&o)[DV / 32], ALAS unsigned char* lds, bf16_t* dst, int ldo) {
    typedef Lds<DV> L;
    int tid = threadIdx.x; asm volatile("" : "+v"(tid));
    const int lane = tid & 63, r32 = lane & 31, hi = lane >> 5; const int wid = __builtin_amdgcn_readfirstlane(tid >> 6);
    ALAS bf16_t* stg = (ALAS bf16_t*)(lds + L::OFF_OST + wid * L::OST_W);
#pragma unroll
    for (int h = 0; h < DV / 64; ++h) {
#pragma unroll
        for (int r = 0; r < 16; ++r) { const int orow = crow(r, hi);
#pragma unroll
            for (int d0 = 0; d0 < 2; ++d0) stg[orow * 64 + d0 * 32 + r32] = (bf16_t)(cvtpk(o[2 * h + d0][r], 0.f) & 0xffffu); }
#pragma unroll
        for (int i = 0; i < 4; ++i) { const int row = i * 8 + (lane >> 3), ch = lane & 7; const u32x4 v = *(const ALAS u32x4*)(stg + row * 64 + ch * 8); *(u32x4*)(dst + (size_t)row * ldo + h * 64 + ch * 8) = v; }
    }
}
}
#define GAS __attribute__((address_space(1)))
#define LAS __attribute__((address_space(3)))
typedef unsigned short bf16;
typedef unsigned v4u __attribute__((ext_vector_type(4)));
typedef float f32x4 __attribute__((ext_vector_type(4)));
typedef short bf16x8 __attribute__((ext_vector_type(8)));
typedef GAS unsigned gu32;
typedef GAS unsigned long long gu64;
#define RLX_AGENT __ATOMIC_RELAXED, __HIP_MEMORY_SCOPE_AGENT
#define LDS_WAIT() asm volatile("s_waitcnt lgkmcnt(0)" ::: "memory")
#define VM_WAIT() asm volatile("s_waitcnt vmcnt(0)" ::: "memory")
__device__ __forceinline__ unsigned long long rt() { return __builtin_amdgcn_s_memrealtime(); }
__device__ __forceinline__ unsigned f2bf(float f) { unsigned u = __builtin_bit_cast(unsigned, f); return (u + 0x7fffu + ((u >> 16) & 1u)) >> 16; }
__device__ __forceinline__ unsigned pk2(float lo, float hi) { return f2bf(lo) | (f2bf(hi) << 16); }

#define XB_TMO      128
#define XB_XCNT(j)  (256  + 64 * (j))
#define XB_XSUB(j)  (1280 + 64 * (j))
#define XB_XGEN(j)  (2304 + 64 * (j))
#define XB_TOP      3328
#define XB_TOPGEN   3392
#define XCD_BAR_WORDS 3456
#define XB_SPIN_CAP (1u << 18)

__device__ __forceinline__ unsigned xb_ld(unsigned* p)              { return __hip_atomic_load(p, __ATOMIC_RELAXED, __HIP_MEMORY_SCOPE_AGENT); }
__device__ __forceinline__ unsigned xb_add(unsigned* p, unsigned v) { return __hip_atomic_fetch_add(p, v, __ATOMIC_RELAXED, __HIP_MEMORY_SCOPE_AGENT); }
__device__ __forceinline__ unsigned xb_xcc_id() { return (unsigned)__builtin_amdgcn_s_getreg((3 << 11) | 20) & 0xFu; }
#define XB_SPIN(cond, bar) do { unsigned _sp = 0; while (cond) { __builtin_amdgcn_s_sleep(1); \
    if ((++_sp & 255u) == 0u) { if (xb_ld(&(bar)[XB_TMO])) break; if (_sp > XB_SPIN_CAP) { atomicAdd(&(bar)[XB_TMO], 1u); break; } } } } while (0)

struct XcdBarrier {
    unsigned* bar; unsigned x;
    volatile LAS unsigned* st;
};

__device__ __forceinline__ XcdBarrier xcd_barrier_post(unsigned* bar, volatile LAS unsigned* st) {
    XcdBarrier b; b.bar = bar; b.x = xb_xcc_id(); b.st = st;
    if (threadIdx.x == 0) (void)xb_add(&bar[XB_XCNT(b.x)], 1u);
    return b;
}
__device__ __forceinline__ void xcd_barrier_complete(unsigned* bar, unsigned x, unsigned& nloc, unsigned& nx) {
    const unsigned G = gridDim.x * gridDim.y * gridDim.z;
    unsigned sum, cnt, mine, sp = 0u;
    for (;;) {
        sum = 0u; cnt = 0u; mine = 0u;
#pragma unroll
        for (unsigned j = 0; j < 16; ++j) { const unsigned c = xb_ld(&bar[XB_XCNT(j)]); sum += c; cnt += (c > 0u) ? 1u : 0u; mine = (j == x) ? c : mine; }
        if (sum == G) break;
        __builtin_amdgcn_s_sleep(1);
        if ((++sp & 255u) == 0u) { if (xb_ld(&bar[XB_TMO])) break; if (sp > XB_SPIN_CAP) { atomicAdd(&bar[XB_TMO], 1u); break; } }
    }
    nloc = mine > 0u ? mine : 1u; nx = cnt > 0u ? cnt : 1u;
}

__device__ __forceinline__ void xcd_barrier(const XcdBarrier& b) {
    asm volatile("s_waitcnt vmcnt(0)" ::: "memory");
    __syncthreads();
    if (threadIdx.x == 0) {
        unsigned* bar = b.bar;
        __builtin_amdgcn_s_waitcnt(0);
        unsigned nloc = b.st[0], nx = b.st[1];
        if (nloc == 0u) { xcd_barrier_complete(bar, b.x, nloc, nx); b.st[0] = nloc; b.st[1] = nx; }
        const unsigned old = xb_add(&bar[XB_XSUB(b.x)], 1u);
        const unsigned gen = old / nloc;
        if (old + 1u == (gen + 1u) * nloc) {
            __builtin_amdgcn_fence(__ATOMIC_RELEASE, "agent");
            asm volatile("s_waitcnt vmcnt(0)" ::: "memory");
            const unsigned og = xb_add(&bar[XB_TOP], 1u);
            const unsigned tg = og / nx;
            if (og + 1u == (tg + 1u) * nx) xb_add(&bar[XB_TOPGEN], 1u);
            else XB_SPIN(xb_ld(&bar[XB_TOPGEN]) == tg, bar);
            __builtin_amdgcn_fence(__ATOMIC_ACQUIRE, "agent");
            xb_add(&bar[XB_XGEN(b.x)], 1u);
            asm volatile("s_waitcnt vmcnt(0)" ::: "memory");
        } else {
            XB_SPIN(xb_ld(&bar[XB_XGEN(b.x)]) == gen, bar);
            __builtin_amdgcn_fence(__ATOMIC_ACQUIRE, "agent");
            asm volatile("s_waitcnt vmcnt(0)" ::: "memory");
        }
    }
    __syncthreads();
}

constexpr int NWAVES = 8;
constexpr size_t MiB = 1u << 20;
constexpr size_t WS_CTL = 0, CTL_ZERO_BYTES = 2 * MiB;
constexpr size_t WS_GRAN = 1 * MiB;
constexpr size_t WS_C64 = 381 * MiB + 42 * MiB, WS_S64 = WS_C64 + 256 * 1024, WS_C32 = WS_C64 + 512 * 1024, WS_S32 = WS_C64 + 640 * 1024, WS_RS = WS_C64 + 768 * 1024;
constexpr size_t WS_WGU = 2 * MiB, WGU_BYTES = (size_t)NGU * DM * 2;
constexpr size_t WS_WD = 46 * MiB, WD_BYTES = (size_t)DM * FF * 2;
constexpr size_t WS_WIN0 = 68 * MiB, WS_WOUT0 = 75 * MiB, WS_WIN1 = 77 * MiB, WS_WOUT1 = 83 * MiB;
constexpr size_t WS_MASK = 85 * MiB;
constexpr size_t WS_XB = 93 * MiB;
constexpr size_t WS_R1 = 157 * MiB;
constexpr size_t WS_Y = 381 * MiB;
constexpr size_t WS_SSQ1 = WS_Y + 40 * MiB, WS_SSQ2 = WS_Y + 41 * MiB;
constexpr size_t WS_ATT = 445 * MiB;
constexpr size_t WS_END = 509 * MiB;
static_assert(WS_WGU + 4 * WGU_BYTES <= WS_WD && WS_WD + 4 * WD_BYTES <= WS_WIN0 && WS_WIN0 + (size_t)NEV * DM * 2 <= WS_WOUT0 && WS_WIN1 + (size_t)NOD * DM * 2 <= WS_WOUT1, "weight map");
static_assert(WS_R1 + (size_t)MROWS * FF * 2 <= WS_Y && WS_R1 + 211 * MiB <= WS_Y, "R1 map");
constexpr int CW_BAR = 4096, CW_TMO = 0, CW_SEAM = 16384, SEAM_BANK = 128 * 64;
constexpr int FUSED_LDS_OFF = 131072 + 1024;
constexpr int RING_BYTES = 131072, LDSCTL_OFF = RING_BYTES, MISC_OFF = LDSCTL_OFF + 320, LDS_BYTES = 147456;

struct Frame {
    LAS unsigned char* lds; volatile LAS unsigned* MISC; gu32* ctl;
    int tid, lane, wave, vcu, G;
};

template <int X> __device__ __forceinline__ float swz_xor(float v) { return __int_as_float(__builtin_amdgcn_ds_swizzle(__float_as_int(v), (X << 10) | 0x1f)); }
__device__ __forceinline__ float sum32(float v) { v += swz_xor<1>(v); v += swz_xor<2>(v); v += swz_xor<4>(v); v += swz_xor<8>(v); v += swz_xor<16>(v); return v; }
__device__ __forceinline__ float wave_sum(float v) { return att::halfswap_sum(sum32(v)); }
struct MapGUHalf { int bj; __device__ __forceinline__ int src(int R) const { return R; } __device__ __forceinline__ int dst(int R) const { return 256 * (R >> 7) + 128 * bj + (R & 127); } };
struct MapId { __device__ __forceinline__ int src(int R) const { return R; } __device__ __forceinline__ int dst(int R) const { return R; } };
__device__ __forceinline__ int even_src(int R) {
    const int pn = R >> 8, bj = (R >> 7) & 1, jj = R & 127;
    if (pn < 4) return (pn < 2 ? 0 : 512) + (4 * (pn & 1) + (jj >> 5)) * 64 + 32 * bj + (jj & 31);
    if (pn < 6) return 1024 + 256 * (pn - 4) + 128 * bj + jj;
    if (pn < 10) return (pn < 8 ? 1536 : 2048) + (4 * (pn & 1) + (jj >> 5)) * 64 + 32 * bj + (jj & 31);
    if (pn < 12) return 2560 + 256 * (pn - 10) + 128 * bj + jj;
    if (pn == 12) return 3072 + (jj >> 4) * 32 + 16 * bj + (jj & 15);
    if (jj < 16) return 3328 + 16 * bj + jj;
    if (bj == 0 && jj < 24) return 3360 + (jj - 16);
    return -1;
}
struct MapEven { __device__ __forceinline__ int src(int R) const { return even_src(R); } __device__ __forceinline__ int dst(int R) const { return R; } };
template <class Map>
__device__ __forceinline__ void transpose_item(const Map& mp, const float* W, int ldw, int K, int nrows, bf16* WT, const float* g, LAS float* scr, int item, int lane) {
    const int nblk = nrows / 32, kb = item / nblk, nb = item % nblk, k0 = 64 * kb, n0 = 32 * nb;
    const int nl = 4 * (lane & 7), kl = lane >> 3;
    const int sc0 = mp.src(n0 + nl); const float mul = sc0 >= 0 ? 1.f : 0.f; const float* src = W + (sc0 >= 0 ? sc0 : 0) + (size_t)(k0 + kl) * ldw;
    f32x4 v[8];
#pragma unroll
    for (int i = 0; i < 8; ++i) v[i] = *(const GAS f32x4*)(src + (size_t)(8 * i) * ldw);
#pragma unroll
    for (int i = 0; i < 8; ++i) { const int kk = 8 * i + kl; const float gm = g ? g[k0 + kk] * mul : mul;
        scr[kk * 33 + nl] = v[i].x * gm; scr[kk * 33 + nl + 1] = v[i].y * gm; scr[kk * 33 + nl + 2] = v[i].z * gm; scr[kk * 33 + nl + 3] = v[i].w * gm; }
    LDS_WAIT(); asm volatile("" ::: "memory");
    const int c = lane & 7;
#pragma unroll
    for (int j = 0; j < 4; ++j) { const int n = (lane >> 3) + 8 * j; const LAS float* s = scr + (8 * c) * 33 + n;
        v4u o; o.x = pk2(s[0 * 33], s[1 * 33]); o.y = pk2(s[2 * 33], s[3 * 33]); o.z = pk2(s[4 * 33], s[5 * 33]); o.w = pk2(s[6 * 33], s[7 * 33]);
        *(GAS v4u*)(WT + (size_t)mp.dst(n0 + n) * K + k0 + 8 * c) = o; }
    LDS_WAIT(); asm volatile("" ::: "memory");
}
__device__ __forceinline__ void sincos_d(double a, float& sn, float& cs) {
    const double k = __builtin_rint(a * 0.6366197723675814); const double y = a - k * 1.5707963267948966; const double y2 = y * y;
    const double s = y * (1.0 + y2 * (-1.0 / 6 + y2 * (1.0 / 120 + y2 * (-1.0 / 5040 + y2 * (1.0 / 362880 + y2 * (-1.0 / 39916800 + y2 * (1.0 / 6227020800.0)))))));
    const double c = 1.0 + y2 * (-0.5 + y2 * (1.0 / 24 + y2 * (-1.0 / 720 + y2 * (1.0 / 40320 + y2 * (-1.0 / 3628800 + y2 * (1.0 / 479001600.0 + y2 * (-1.0 / 87178291200.0)))))));
    const int q = (int)((long long)k & 3);
    const double ss = (q == 0) ? s : (q == 1) ? c : (q == 2) ? -s : -c, cc = (q == 0) ? c : (q == 1) ? -s : (q == 2) ? -c : s;
    sn = (float)ss; cs = (float)cc;
}
__device__ __forceinline__ void x_to_bf16_rows4(const float* x, bf16* xb, float* ssq, int m, int dm, int lane) {
    f32x4 v[4][4]; float s[4];
#pragma unroll
    for (int r = 0; r < 4; ++r) { const GAS f32x4* xr = (const GAS f32x4*)(x + (size_t)(m + r * dm) * DM) + lane;
#pragma unroll
        for (int j = 0; j < 4; ++j) v[r][j] = xr[64 * j]; }
#pragma unroll
    for (int r = 0; r < 4; ++r) { s[r] = 0.f; GAS unsigned long long* o8 = (GAS unsigned long long*)(xb + (size_t)(m + r * dm) * DM) + lane;
#pragma unroll
        for (int j = 0; j < 4; ++j) { s[r] += (v[r][j].x * v[r][j].x + v[r][j].y * v[r][j].y) + (v[r][j].z * v[r][j].z + v[r][j].w * v[r][j].w);
            o8[64 * j] = (unsigned long long)epi::pkbf(v[r][j].x, v[r][j].y) | ((unsigned long long)epi::pkbf(v[r][j].z, v[r][j].w) << 32); } }
#pragma unroll
    for (int r = 0; r < 4; ++r) s[r] = sum32(s[r]);
#pragma unroll
    for (int r = 0; r < 4; ++r) { const float t = att::halfswap_sum(s[r]); if (lane == 0) *(f32x4*)(ssq + (size_t)(m + r * dm) * 4) = (f32x4){t, 0.f, 0.f, 0.f}; }
}
__device__ __forceinline__ void bf8_to_f32(const v4u& w, float (&f)[8]) {
#pragma unroll
    for (int i = 0; i < 4; ++i) { f[2 * i] = __uint_as_float(w[i] << 16); f[2 * i + 1] = __uint_as_float(w[i] & 0xffff0000u); } }
template <bool LAST>
__device__ __forceinline__ void thin_row(const bf16* yrow, bf16* xrow, float* outf, const float* ga, float alpha, float* rs, int lane) {
    float y[2][8], x[2][8]; float s = 0.f;
#pragma unroll
    for (int j = 0; j < 2; ++j) { const v4u yw = *((const GAS v4u*)yrow + lane + 64 * j), xw = *((const GAS v4u*)xrow + lane + 64 * j); bf8_to_f32(yw, y[j]); bf8_to_f32(xw, x[j]);
#pragma unroll
        for (int i = 0; i < 8; ++i) s += y[j][i] * y[j][i]; }
    const float r1 = alpha / sqrtf(wave_sum(s) * (1.f / DM) + RMS_EPS); float s2 = 0.f;
#pragma unroll
    for (int j = 0; j < 2; ++j) { const f32x4 g0 = *((const GAS f32x4*)ga + 2 * lane + 128 * j), g1 = *((const GAS f32x4*)ga + 2 * lane + 128 * j + 1);
#pragma unroll
        for (int i = 0; i < 8; ++i) { const float g = i < 4 ? g0[i & 3] : g1[i & 3]; x[j][i] += y[j][i] * g * r1; s2 += x[j][i] * x[j][i]; }
        if (LAST) { *((GAS f32x4*)outf + 2 * lane + 128 * j) = (f32x4){x[j][0], x[j][1], x[j][2], x[j][3]}; *((GAS f32x4*)outf + 2 * lane + 128 * j + 1) = (f32x4){x[j][4], x[j][5], x[j][6], x[j][7]}; }
        else { v4u o; o.x = epi::pkbf(x[j][0], x[j][1]); o.y = epi::pkbf(x[j][2], x[j][3]); o.z = epi::pkbf(x[j][4], x[j][5]); o.w = epi::pkbf(x[j][6], x[j][7]); *((GAS v4u*)xrow + lane + 64 * j) = o; } }
    if (!LAST) { const float r2 = 1.0f / sqrtf(wave_sum(s2) * (1.f / DM) + RMS_EPS); if (lane == 0) *rs = r2; }
}

struct Ptrs {
    const float *x, *norm_g, *wg, *wu, *wd, *ewin, *ewout, *elam, *esub, *owin, *owout, *obias; float* out; unsigned char* ws;
};

__device__ __forceinline__ void p0_prologue(Frame& F0, const Ptrs& P) {
    struct { LAS unsigned char* lds; int tid, lane, wave, vcu, G; } F;
    { int t = threadIdx.x; asm volatile("" : "+v"(t)); F.lds = F0.lds; F.tid = t; F.lane = t & 63; F.wave = __builtin_amdgcn_readfirstlane(t >> 6); F.vcu = F0.vcu; F.G = F0.G; }
    LAS float* scr = (LAS float*)(F.lds + F.wave * 16384);
    const int gw = F.vcu * NWAVES + F.wave, NGW = F.G * NWAVES;
    constexpr int I_GH = (DM / 64) * (FF / 32), I_WD = (FF / 64) * (DM / 32), I_E = (DM / 64) * (NEV / 32), I_O = (DM / 64) * (DM / 32), I_OD = (DM / 64) * (NOD / 32);
    constexpr int NITEMS = 8 * I_GH + 4 * I_WD + I_E + I_O + I_OD + I_O;
    for (int it = gw; it < NITEMS; it += NGW) {
        int r = it;
        if (r < 8 * I_GH) { const int i8 = r / I_GH; r -= i8 * I_GH; const int i = i8 >> 1, bj = i8 & 1, l = i >> 1, f = i & 1;
            MapGUHalf mp{bj}; const float* W = (bj ? P.wu : P.wg) + (size_t)i * DM * FF;
            transpose_item(mp, W, FF, DM, FF, (bf16*)(P.ws + WS_WGU + i * WGU_BYTES), P.norm_g + (l * 6 + 4 * f) * DM, scr, r, F.lane); continue; }
        r -= 8 * I_GH;
        if (r < 4 * I_WD) { const int i = r / I_WD; r -= i * I_WD; MapId mp;
            transpose_item(mp, P.wd + (size_t)i * FF * DM, DM, FF, DM, (bf16*)(P.ws + WS_WD + i * WD_BYTES), nullptr, scr, r, F.lane); continue; }
        r -= 4 * I_WD;
        if (r < I_E) { MapEven mp; transpose_item(mp, P.ewin, 3368, DM, NEV, (bf16*)(P.ws + WS_WIN0), P.norm_g + (0 * 6 + 2) * DM, scr, r, F.lane); continue; }
        r -= I_E;
        if (r < I_O) { MapId mp; transpose_item(mp, P.ewout, DM, DM, DM, (bf16*)(P.ws + WS_WOUT0), nullptr, scr, r, F.lane); continue; }
        r -= I_O;
        if (r < I_OD) { MapId mp; transpose_item(mp, P.owin, NOD, DM, NOD, (bf16*)(P.ws + WS_WIN1), P.norm_g + (1 * 6 + 2) * DM, scr, r, F.lane); continue; }
        r -= I_OD;
        { MapId mp; transpose_item(mp, P.owout, DM, DM, DM, (bf16*)(P.ws + WS_WOUT1), nullptr, scr, r, F.lane); }
    }
    float* c64 = (float*)(P.ws + WS_C64); float* s64 = (float*)(P.ws + WS_S64); float* c32 = (float*)(P.ws + WS_C32); float* s32 = (float*)(P.ws + WS_S32);
    const int gt = F.vcu * (NWAVES * 64) + F.tid, NGT = F.G * NWAVES * 64;
    for (int e = gt; e < SEQ * 48; e += NGT) {
        const bool is64 = e < SEQ * 32; const int ee = is64 ? e : e - SEQ * 32; const int pos = is64 ? (ee >> 5) : (ee >> 4), i = is64 ? (ee & 31) : (ee & 15);
        const double rb = is64 ? 0.7498942093324559 : 0.5623413251903492; double inv = 1.0; for (int k = 0; k < i; ++k) inv *= rb;
        const float ang = (float)pos * (float)inv; float sn, cs; sincos_d((double)ang, sn, cs);
        if (is64) { typedef _Float16 h2_t __attribute__((ext_vector_type(2))); h2_t h; h.x = (_Float16)cs; h.y = (_Float16)sn; ((unsigned*)c64)[ee] = __builtin_bit_cast(unsigned, h); } else { c32[ee] = cs; s32[ee] = sn; }
    }
    bf16* XB = (bf16*)(P.ws + WS_XB); float* SSQ2 = (float*)(P.ws + WS_SSQ2);
    for (int m = gw; m < MROWS; m += 4 * NGW) x_to_bf16_rows4(P.x, XB, SSQ2, m, NGW, F.lane);
}
#ifndef ATT_THR
#define ATT_THR 4
#endif
#ifndef PROBE_REP_WIN
#define PROBE_REP_WIN 1
#endif
#ifndef GU_STAGGER_US
#define GU_STAGGER_US 0
#endif
#ifndef PROBE_REP_IDXA
#define PROBE_REP_IDXA 1
#endif
#ifndef PROBE_REP_B
#define PROBE_REP_B 1
#endif
#ifndef PROBE_REP_C
#define PROBE_REP_C 1
#endif
#ifndef PROBE_REP_GU
#define PROBE_REP_GU 1
#endif
#ifndef PROBE_REP_DN
#define PROBE_REP_DN 1
#endif
#ifndef PROBE_NULL_GU
#define PROBE_NULL_GU 0
#endif
#ifndef PROBE_NULL_DN
#define PROBE_NULL_DN 0
#endif
#ifndef PROBE_REP_IDX
#define PROBE_REP_IDX 1
#endif
#ifndef PROBE_B_SKIP
#define PROBE_B_SKIP 0
#endif
#ifndef PROBE_B_HOT
#define PROBE_B_HOT 0
#endif
#ifndef PROBE_CLK
#define PROBE_CLK 0
#endif
#ifndef PROBE_HOT_GU
#define PROBE_HOT_GU 0
#endif
#ifndef PROBE_NOST_GU
#define PROBE_NOST_GU 0
#endif
#ifndef PROBE_FUSED_VAR
#define PROBE_FUSED_VAR 0
#endif
#ifndef PROBE_FUSED_DN
#define PROBE_FUSED_DN 0
#endif
#ifndef PROBE_REP_THIN
#define PROBE_REP_THIN 1
#endif
template <bool LAST>
__device__ __forceinline__ void thin_phase(Frame& F, const Ptrs& P, const float* ga, float alpha) {
    int t_ = threadIdx.x; asm volatile("" : "+v"(t_)); const int lane_ = t_ & 63, wave_ = __builtin_amdgcn_readfirstlane(t_ >> 6);
    const int gw = F.vcu * NWAVES + wave_, NGW = F.G * NWAVES;
    const bf16* Y = (const bf16*)(P.ws + WS_Y); bf16* XB = (bf16*)(P.ws + WS_XB); float* RS = (float*)(P.ws + WS_RS);
    for (int m = gw; m < MROWS; m += NGW) thin_row<LAST>(Y + (size_t)m * DM, XB + (size_t)m * DM, P.out + (size_t)m * DM, ga, alpha, RS + m, lane_);
}

__device__ __forceinline__ int wave_sum_i(int x) {
    x += __builtin_amdgcn_update_dpp(0, x, 0x111, 0xf, 0xf, true);
    x += __builtin_amdgcn_update_dpp(0, x, 0x112, 0xf, 0xf, true);
    x += __builtin_amdgcn_update_dpp(0, x, 0x114, 0xf, 0xf, true);
    x += __builtin_amdgcn_update_dpp(0, x, 0x118, 0xf, 0xf, true);
    return __builtin_amdgcn_readlane(x, 15) + __builtin_amdgcn_readlane(x, 31) + __builtin_amdgcn_readlane(x, 47) + __builtin_amdgcn_readlane(x, 63);
}
__device__ __forceinline__ void select_row(const unsigned (&u)[32], unsigned T, int cT, LAS unsigned long long* mw, int lane) {
    if (cT == 256) {
#pragma unroll
        for (int i = 0; i < 32; ++i) { const unsigned long long w = __ballot(u[i] >= T); if (lane == 0) mw[i] = w; }
    } else {
        int cgt = 0;
#pragma unroll
        for (int i = 0; i < 32; ++i) cgt += __popcll(__ballot(u[i] > T));
        const int need = 256 - cgt; int base = 0; unsigned T2 = T; asm volatile("" : "+s"(T2));
#pragma unroll
        for (int i = 0; i < 32; ++i) {
            const bool eq = (u[i] == T2), gt = (u[i] > T2); const unsigned long long em = __ballot(eq);
            const int rank = (int)__builtin_amdgcn_mbcnt_hi((unsigned)(em >> 32), __builtin_amdgcn_mbcnt_lo((unsigned)em, (unsigned)base));
            const unsigned long long w = __ballot(gt || (eq && rank < need)); base += __popcll(em);
            if (lane == 0) mw[i] = w;
        }
    }
}
template <int VAR>
__device__ __forceinline__ void indexer_unit(Frame& F, const Ptrs& P, int b, int blk) {
    typedef short bf16x8v __attribute__((ext_vector_type(8)));
    int tid = threadIdx.x; asm volatile("" : "+v"(tid));
    const int q0 = blk * 16, qc = q0 >> 6, n64 = qc + 1, nvis = n64 * 64; const int lane = tid & 63, wid = __builtin_amdgcn_readfirstlane(tid >> 6);
    unsigned long long* mrow = (unsigned long long*)(P.ws + WS_MASK) + ((size_t)(b * SEQ + q0)) * 32;
    if (n64 <= 4) {
        for (int i = tid; i < 16 * 32; i += NWAVES * 64) { const int w = i & 31; if (w < n64) mrow[i] = ~0ull; }
        return;
    }
    const bf16* IQ = (const bf16*)(P.ws + WS_R1 + 192 * MiB); const bf16* IK = (const bf16*)(P.ws + WS_R1 + 208 * MiB); const float* IW = (const float*)(P.ws + WS_R1 + 210 * MiB);
    LAS float* sc = (LAS float*)F.lds;
    if (!(VAR & 1)) {
        const int q = lane & 15, kg = lane >> 4; const size_t qrow = (size_t)(b * SEQ + q0 + q);
        bf16x8v iq[8]; float wi[8];
#pragma unroll
        for (int h = 0; h < 8; ++h) { iq[h] = *(const bf16x8v*)(IQ + qrow * 256 + h * 32 + 8 * kg); wi[h] = IW[qrow * 8 + h]; }
        const int nt = (nvis / 16 - wid + NWAVES - 1) / NWAVES;
        const bf16* ikp = IK + ((size_t)(b * SEQ + wid * 16 + q)) * 32 + 8 * kg;
        bf16x8v af[16];
#pragma unroll
        for (int i = 0; i < 16; ++i) if (i < nt) af[i] = *(const bf16x8v*)(ikp + (size_t)i * (NWAVES * 16 * 32));
#pragma unroll
        for (int i = 0; i < 16; ++i) if (i < nt) {
            f32x4 acc = {0.f, 0.f, 0.f, 0.f};
#pragma unroll
            for (int h = 0; h < 8; ++h) { const f32x4 c = __builtin_amdgcn_mfma_f32_16x16x32_bf16(af[i], iq[h], (f32x4){0.f, 0.f, 0.f, 0.f}, 0, 0, 0);
#pragma unroll
                for (int j = 0; j < 4; ++j) acc[j] += wi[h] * fmaxf(c[j], 0.f); }
            const int col = ((wid + NWAVES * i) * 16 + kg * 4 + 4 * q) & 2047;
            *(LAS f32x4*)(sc + q * 2048 + col) = acc;
        }
    }
    __syncthreads();
    if (VAR != 7) {
        int n64l = n64; asm volatile("" : "+s"(n64l));
        unsigned ua[32], ub[32];
        { const int qa = 2 * wid, qb = 2 * wid + 1; const LAS float* ra = sc + qa * 2048; const LAS float* rb = sc + qb * 2048;
#pragma unroll
          for (int i = 0; i < 32; ++i) { const int e = i * 64 + lane;
              const unsigned ba = __float_as_uint(ra[(e + 4 * qa) & 2047]), bb = __float_as_uint(rb[(e + 4 * qb) & 2047]);
              const unsigned ka = (ba & 0x80000000u) ? ~ba : (ba | 0x80000000u), kb = (bb & 0x80000000u) ? ~bb : (bb | 0x80000000u);
              ua[i] = (i < n64l) ? ka : 0u; ub[i] = (i < n64l) ? kb : 0u; } }
        unsigned Ta = 0u, Tb = 0u; int cTa = nvis, cTb = nvis; bool da = false, db = false;
#pragma unroll 1
        for (int bit = (VAR & 2) ? -1 : 31; bit >= 0; --bit) {
            const unsigned ca = Ta | (1u << bit), cb = Tb | (1u << bit); int xa = 0, xb = 0;
#pragma unroll
            for (int g = 0; g < 4; ++g) if (n64l > 8 * g) {
#pragma unroll
                for (int i = 8 * g; i < 8 * g + 8; ++i) { xa += (ua[i] >= ca) ? 1 : 0; xb += (ub[i] >= cb) ? 1 : 0; } }
            const int na = wave_sum_i(xa), nb = wave_sum_i(xb);
            if (!da && na >= 256) { Ta = ca; cTa = na; if (na == 256) da = true; }
            if (!db && nb >= 256) { Tb = cb; cTb = nb; if (nb == 256) db = true; }
            if (da && db) break;
        }
        if (!(VAR & 4)) {
            LAS unsigned long long* stg = (LAS unsigned long long*)(sc + (2 * wid) * 2048);
            select_row(ua, (unsigned)__builtin_amdgcn_readfirstlane((int)Ta), __builtin_amdgcn_readfirstlane(cTa), stg, lane);
            select_row(ub, (unsigned)__builtin_amdgcn_readfirstlane((int)Tb), __builtin_amdgcn_readfirstlane(cTb), stg + 32, lane);
            mrow[(2 * wid) * 32 + lane] = stg[lane];
        }
    }
    __syncthreads();
}

typedef short idx_bf16x8 __attribute__((ext_vector_type(8)));
constexpr int IDX_NPRE = 6;
struct IdxRegs { idx_bf16x8 iq[8]; float wi[8]; idx_bf16x8 af[IDX_NPRE]; };
__device__ __forceinline__ void idx_load(IdxRegs& R, const Ptrs& P, int b, int blk, int lane, int wid) {
    const int q0 = blk * 16, n64 = (q0 >> 6) + 1, nvis = n64 * 64;
    const bf16* IQ = (const bf16*)(P.ws + WS_R1 + 192 * MiB); const bf16* IK = (const bf16*)(P.ws + WS_R1 + 208 * MiB); const float* IW = (const float*)(P.ws + WS_R1 + 210 * MiB);
    const int q = lane & 15, kg = lane >> 4; const size_t qrow = (size_t)(b * SEQ + q0 + q);
#pragma unroll
    for (int h = 0; h < 8; ++h) { R.iq[h] = *(const idx_bf16x8*)(IQ + qrow * 256 + h * 32 + 8 * kg); R.wi[h] = IW[qrow * 8 + h]; }
    const int nt = (nvis / 16 - wid + NWAVES - 1) / NWAVES;
    const bf16* ikp = IK + ((size_t)(b * SEQ + wid * 16 + q)) * 32 + 8 * kg;
#pragma unroll
    for (int i = 0; i < IDX_NPRE; ++i) { const int ii = i < nt ? i : nt - 1; R.af[i] = *(const idx_bf16x8*)(ikp + (size_t)ii * (NWAVES * 16 * 32)); }
}
__device__ __forceinline__ void idx_score(const IdxRegs& R, const Ptrs& P, LAS float* sc, int b, int blk, int lane, int wid) {
    const int q0 = blk * 16, n64 = (q0 >> 6) + 1, nvis = n64 * 64;
    if (n64 <= 4) return;
    const int q = lane & 15, kg = lane >> 4; const int nt = (nvis / 16 - wid + NWAVES - 1) / NWAVES;
    const bf16* ikp = (const bf16*)(P.ws + WS_R1 + 208 * MiB) + ((size_t)(b * SEQ + wid * 16 + q)) * 32 + 8 * kg;
    idx_bf16x8 ah[16 - IDX_NPRE];
#pragma unroll
    for (int i = 0; i < 16 - IDX_NPRE; ++i) { const int ii = IDX_NPRE + i < nt ? IDX_NPRE + i : nt - 1; ah[i] = *(const idx_bf16x8*)(ikp + (size_t)ii * (NWAVES * 16 * 32)); }
#pragma unroll
    for (int i = 0; i < 16; ++i) if (i < nt) {
        f32x4 acc = {0.f, 0.f, 0.f, 0.f}; const idx_bf16x8 a_ = i < IDX_NPRE ? R.af[i < IDX_NPRE ? i : 0] : ah[i >= IDX_NPRE ? i - IDX_NPRE : 0];
#pragma unroll
        for (int h = 0; h < 8; ++h) { const f32x4 c = __builtin_amdgcn_mfma_f32_16x16x32_bf16(a_, R.iq[h], (f32x4){0.f, 0.f, 0.f, 0.f}, 0, 0, 0);
#pragma unroll
            for (int j = 0; j < 4; ++j) acc[j] += R.wi[h] * fmaxf(c[j], 0.f); }
        const int col = ((wid + NWAVES * i) * 16 + kg * 4 + 4 * q) & 2047;
        *(LAS f32x4*)(sc + q * 2048 + col) = acc;
    }
}
__device__ __forceinline__ void idx_select(const Ptrs& P, LAS float* sc, int b, int blk, int tid, int lane, int wid) {
    const int q0 = blk * 16, n64 = (q0 >> 6) + 1, nvis = n64 * 64;
    unsigned long long* mrow = (unsigned long long*)(P.ws + WS_MASK) + ((size_t)(b * SEQ + q0)) * 32;
    if (n64 <= 4) {
        for (int i = tid; i < 16 * 32; i += NWAVES * 64) { const int w = i & 31; if (w < n64) mrow[i] = ~0ull; }
        return;
    }
    int n64l = n64; asm volatile("" : "+s"(n64l));
    unsigned ua[32], ub[32];
    { const int qa = 2 * wid, qb = 2 * wid + 1; const LAS float* ra = sc + qa * 2048; const LAS float* rb = sc + qb * 2048;
#pragma unroll
      for (int i = 0; i < 32; ++i) { const int e = i * 64 + lane;
          const unsigned ba = __float_as_uint(ra[(e + 4 * qa) & 2047]), bb = __float_as_uint(rb[(e + 4 * qb) & 2047]);
          const unsigned ka = (ba & 0x80000000u) ? ~ba : (ba | 0x80000000u), kb = (bb & 0x80000000u) ? ~bb : (bb | 0x80000000u);
          ua[i] = (i < n64l) ? ka : 0u; ub[i] = (i < n64l) ? kb : 0u; } }
    unsigned Ta = 0u, Tb = 0u; int cTa = nvis, cTb = nvis; bool da = false, db = false;
#pragma unroll 1
    for (int bit = 31; bit >= 0; --bit) {
        const unsigned ca = Ta | (1u << bit), cb = Tb | (1u << bit); int xa = 0, xb = 0;
#pragma unroll
        for (int g = 0; g < 4; ++g) if (n64l > 8 * g) {
#pragma unroll
            for (int i = 8 * g; i < 8 * g + 8; ++i) { xa += (ua[i] >= ca) ? 1 : 0; xb += (ub[i] >= cb) ? 1 : 0; } }
        const int na = wave_sum_i(xa), nb = wave_sum_i(xb);
        if (!da && na >= 256) { Ta = ca; cTa = na; if (na == 256) da = true; }
        if (!db && nb >= 256) { Tb = cb; cTb = nb; if (nb == 256) db = true; }
        if (da && db) break;
    }
    LAS unsigned long long* stg = (LAS unsigned long long*)(sc + (2 * wid) * 2048);
    select_row(ua, (unsigned)__builtin_amdgcn_readfirstlane((int)Ta), __builtin_amdgcn_readfirstlane(cTa), stg, lane);
    select_row(ub, (unsigned)__builtin_amdgcn_readfirstlane((int)Tb), __builtin_amdgcn_readfirstlane(cTb), stg + 32, lane);
    mrow[(2 * wid) * 32 + lane] = stg[lane];
}
__device__ __forceinline__ void indexer_phase(Frame& F, const Ptrs& P) {
    int tid = threadIdx.x; asm volatile("" : "+v"(tid));
    const int lane = tid & 63, wid = __builtin_amdgcn_readfirstlane(tid >> 6);
    LAS float* sc = (LAS float*)F.lds;
#define IDX_B(u) ((F.vcu + 256 * ((u) >> 1)) >> 6)
#define IDX_BLK(u) (((u) & 1) ? 127 - ((F.vcu + 256 * ((u) >> 1)) & 63) : ((F.vcu + 256 * ((u) >> 1)) & 63))
    IdxRegs RA, RB;
    idx_load(RA, P, IDX_B(0), IDX_BLK(0), lane, wid);
#pragma unroll 1
    for (int u = 0; u < 8; u += 2) {
        idx_score(RA, P, sc, IDX_B(u), IDX_BLK(u), lane, wid); __syncthreads();
        idx_load(RB, P, IDX_B(u + 1), IDX_BLK(u + 1), lane, wid);
        idx_select(P, sc, IDX_B(u), IDX_BLK(u), tid, lane, wid); __syncthreads();
        idx_score(RB, P, sc, IDX_B(u + 1), IDX_BLK(u + 1), lane, wid); __syncthreads();
        { const int un = u + 2 < 8 ? u + 2 : 7; idx_load(RA, P, IDX_B(un), IDX_BLK(un), lane, wid); }
        idx_select(P, sc, IDX_B(u + 1), IDX_BLK(u + 1), tid, lane, wid); __syncthreads();
    }
#undef IDX_B
#undef IDX_BLK
}

__device__ __forceinline__ void a_unit(Frame& F, const Ptrs& P, int b, int h, int qb, float lam) {
    using namespace att; typedef Lds<128> L;
    const bf16_t* AQ = (const bf16_t*)(P.ws + WS_R1); const bf16_t* AK = (const bf16_t*)(P.ws + WS_R1 + 32 * MiB); const bf16_t* AV = (const bf16_t*)(P.ws + WS_R1 + 64 * MiB);
    int tid = threadIdx.x; asm volatile("" : "+v"(tid));
    const int lane = tid & 63, wid = __builtin_amdgcn_readfirstlane(tid >> 6), r32 = lane & 31; const size_t rowbase = (size_t)b * SEQ; const int q0 = qb * 256, qw = q0 + wid * 32, qc = qw >> 6;
    f32x4* stash = (f32x4*)(P.ws + WS_Y) + ((size_t)(blockIdx.x * NWAVES + wid) * 16) * 64 + lane;
    f32x16 o[4];
#pragma unroll 1
    for (int c = 0; c < 2; ++c) {
        const int g = 2 * h + c;
        attn_core<128, 0, ATT_THR>(o, F.lds, AQ + (rowbase + qw) * 512 + g * 64, 512, AK + rowbase * 512 + g * 64, 512, AV + rowbase * 512 + h * 128, 512, 0, (q0 >> 6) + 4, 0, qc + 1, nullptr, 0, 0);
        if (c == 0) {
            f32x4* sp = stash; asm volatile("" : "+v"(sp));
#pragma unroll
            for (int d0 = 0; d0 < 4; ++d0)
#pragma unroll
                for (int rq = 0; rq < 4; ++rq) sp[(d0 * 4 + rq) * 64] = (f32x4){o[d0][4 * rq], o[d0][4 * rq + 1], o[d0][4 * rq + 2], o[d0][4 * rq + 3]};
        }
    }
    {
        const f32x4* sp = stash; asm volatile("" : "+v"(sp));
#pragma unroll
        for (int d0 = 0; d0 < 4; ++d0)
#pragma unroll
            for (int rq = 0; rq < 4; ++rq) { const f32x4 a = sp[(d0 * 4 + rq) * 64];
#pragma unroll
                for (int j = 0; j < 4; ++j) o[d0][4 * rq + j] = a[j] - lam * o[d0][4 * rq + j]; }
    }
    float sl[4];
#pragma unroll
    for (int d0 = 0; d0 < 4; ++d0) sl[d0] = P.esub[32 * d0 + r32] * 0.8f;
#pragma unroll
    for (int r = 0; r < 16; ++r) { float s = 0.f;
#pragma unroll
        for (int d0 = 0; d0 < 4; ++d0) s += o[d0][r] * o[d0][r];
        s = sum32(s);
        const float rstd = 1.0f / sqrtf(s * (1.f / 128.f) + RMS_EPS);
#pragma unroll
        for (int d0 = 0; d0 < 4; ++d0) o[d0][r] *= rstd * sl[d0]; }
    store_o<128>(o, F.lds, (bf16_t*)(P.ws + WS_ATT) + (rowbase + qw) * DM + h * 128, DM);
}
__device__ __forceinline__ void b_unit(Frame& F, const Ptrs& P, int b, int h, int qb, int hotmask, int skip, bool has_next, int nb, int nh, int nqb, int& pre) {
    using namespace att;
    const bf16_t* BQ = (const bf16_t*)(P.ws + WS_R1 + 96 * MiB); const bf16_t* BK = (const bf16_t*)(P.ws + WS_R1 + 128 * MiB); const bf16_t* BV = (const bf16_t*)(P.ws + WS_R1 + 160 * MiB);
    int tid = threadIdx.x; asm volatile("" : "+v"(tid));
    const int lane = tid & 63, wid = __builtin_amdgcn_readfirstlane(tid >> 6), r32 = lane & 31; const size_t rowbase = (size_t)b * SEQ; const int q0 = qb * 256, qw = q0 + wid * 32, qc = qw >> 6;
    const unsigned long long* mbase = (const unsigned long long*)(P.ws + WS_MASK);
    const unsigned long long* mrow = mbase + (rowbase + qw + r32) * 32;
    const size_t nrowbase = (size_t)nb * SEQ; const int nqw = nqb * 256 + wid * 32;
    f32x16 o[2]; int pre_out = 0;
    attn_core<64, 1, ATT_THR>(o, F.lds, BQ + (rowbase + qw) * 512 + h * 64, 512, BK + rowbase * 512 + h * 64, 512, BV + rowbase * 512 + h * 64, 512, 0, (q0 >> 6) + 4, 0, qc + 1, mrow, 0, 0, hotmask, skip,
                        BK + nrowbase * 512 + nh * 64, BV + nrowbase * 512 + nh * 64, mbase + (nrowbase + nqw + r32) * 32, 0, has_next ? (nqb * 4 + 4) : 0, pre, &pre_out);
    pre = pre_out;
    store_o<64>(o, F.lds, (bf16_t*)(P.ws + WS_ATT) + (rowbase + qw) * DM + 512 + h * 64, DM);
}
__device__ __forceinline__ void c_unit(Frame& F, const Ptrs& P, int b, int h, int qb, bool has_next, int& pre) {
    using namespace att; typedef Lds<64> L;
    const bf16_t* CQ = (const bf16_t*)(P.ws + WS_R1); const bf16_t* CK = (const bf16_t*)(P.ws + WS_R1 + 64 * MiB); const bf16_t* CV = (const bf16_t*)(P.ws + WS_R1 + 128 * MiB);
    int tid = threadIdx.x; asm volatile("" : "+v"(tid));
    const int lane = tid & 63, wid = __builtin_amdgcn_readfirstlane(tid >> 6), r32 = lane & 31; const size_t rowbase = (size_t)b * SEQ; const int q0 = qb * 256, qw = q0 + wid * 32, qc = qw >> 6;
    LAS float* bt = (LAS float*)(F.lds + L::OFF_BT);
    if (qb == 0) { for (int i = tid; i < 4 * 640; i += NWAVES * 64) { const int k = (i % 640) + (i / 640); bt[i] = P.obias[h * 320 + (k < 319 ? k : 319)] * LOG2E; } }
    const int c0 = q0 >> 6, T0 = c0 - 8 > 0 ? c0 - 8 : 0, tw0 = qc - 8 > 0 ? qc - 8 : 0;
    const int nc0 = c0 + 4, nT0 = nc0 - 8 > 0 ? nc0 - 8 : 0;
    f32x16 o[2]; int pre_out = 0;
    attn_core<64, 2, ATT_THR>(o, F.lds, CQ + (rowbase + qw) * DM + h * 64, DM, CK + rowbase * DM + h * 64, DM, CV + rowbase * DM + h * 64, DM, T0, c0 + 4, tw0, qc + 1, nullptr, qw + r32, qc, -1, 0,
                        CK + rowbase * DM + h * 64, CV + rowbase * DM + h * 64, nullptr, nT0, has_next ? (nc0 + 4) : 0, pre, &pre_out);
    pre = pre_out;
    store_o<64>(o, F.lds, (bf16_t*)(P.ws + WS_ATT) + (rowbase + qw) * DM + h * 64, DM);
}

#ifndef DBG_NO_IDX
#define DBG_NO_IDX 0
#endif
#ifndef DBG_NO_A
#define DBG_NO_A 0
#endif
#ifndef DBG_NO_B
#define DBG_NO_B 0
#endif
#ifndef DBG_STAGES
#define DBG_STAGES 99
#endif
struct Args { const float* in[12]; float* out; unsigned char* ws; };
__global__ void __launch_bounds__(NWAVES * 64, 2) fwd_kernel(Args args) {
    extern __shared__ __attribute__((aligned(16))) unsigned char lds[];
    Frame F;
    F.lds = (LAS unsigned char*)lds; F.MISC = (volatile LAS unsigned*)(F.lds + MISC_OFF);
    F.tid = threadIdx.x; F.lane = F.tid & 63; F.wave = __builtin_amdgcn_readfirstlane(F.tid >> 6);
    F.G = gridDim.x; { const int bx = blockIdx.x; F.vcu = (F.G % 8 == 0) ? (bx % 8) * (F.G / 8) + bx / 8 : bx; }
    Ptrs P; P.x = args.in[0]; P.norm_g = args.in[1]; P.wg = args.in[2]; P.wu = args.in[3]; P.wd = args.in[4]; P.ewin = args.in[5]; P.ewout = args.in[6]; P.elam = args.in[7]; P.esub = args.in[8];
    P.owin = args.in[9]; P.owout = args.in[10]; P.obias = args.in[11]; P.out = args.out; P.ws = args.ws;
    F.ctl = (gu32*)(P.ws + WS_CTL);
    for (int u = F.tid; u < (LDS_BYTES - LDSCTL_OFF) / 4; u += NWAVES * 64) ((LAS unsigned*)(F.lds + LDSCTL_OFF))[u] = 0u;
    __syncthreads();
    XcdBarrier bar = xcd_barrier_post((unsigned*)(F.ctl + CW_BAR), F.MISC + 8);
#define GRID_BAR() xcd_barrier(bar)
    bf16* XB = (bf16*)(P.ws + WS_XB); const float* RS = (const float*)(P.ws + WS_SSQ2); bf16* HID = (bf16*)(P.ws + WS_R1); bf16* Y = (bf16*)(P.ws + WS_Y); const bf16* ATT = (const bf16*)(P.ws + WS_ATT);

#ifdef PROBE_REP_PRO
    for (int rep_ = 1; rep_ < PROBE_REP_PRO; ++rep_) { p0_prologue(F, P); __syncthreads(); }
#endif
    p0_prologue(F, P); GRID_BAR();

#define FUSED_GEMM(Aop, Bop, Kdim, inst, gain, alpha_, LAST_) FUSED_GEMM_X(XB, (float*)(P.ws + WS_SSQ2), Aop, Bop, Kdim, inst, gain, alpha_, LAST_, 0)
#define FUSED_GEMM_X(Xp, SSQ2p, Aop, Bop, Kdim, inst, gain, alpha_, LAST_, PV_) do { \
        pg8::Gemm g{(Aop), (Bop), MROWS, DM, (Kdim)}; \
        epi::EpiRmsRes<LAST_, PV_> E{(Xp), P.out, (gain), (alpha_), (unsigned long long*)(P.ws + WS_GRAN), (unsigned)((inst) + 1), (SSQ2p), (unsigned*)(F.ctl + CW_TMO), F.lds + FUSED_LDS_OFF}; \
        pg8::StaticOrder S; S.init(MROWS, DM, F.G, (int)blockIdx.x); \
        pg8::gemm_phase<epi::EpiRmsRes<LAST_, PV_>, pg8::StaticOrder, true, true>(F.lds, g, S, E); } while (0)
#define FFN_PHASES(l, f, LAST_) do { \
        { pg8::Gemm g{XB, (const bf16*)(P.ws + WS_WGU + (2 * (l) + (f)) * WGU_BYTES), MROWS, NGU, DM}; epi::OrdOrder S; S.base.init(MROWS, NGU, F.G, (int)blockIdx.x); \
          epi::rowstat_table(S, RS, (LAS float*)(F.lds + FUSED_LDS_OFF), 11); \
          if (GU_STAGGER_US > 0 && ((blockIdx.x >> 3) & 1)) { const unsigned long long t0_ = __builtin_amdgcn_s_memrealtime(); while (__builtin_amdgcn_s_memrealtime() - t0_ < 100ull * GU_STAGGER_US) __builtin_amdgcn_s_sleep(16); } \
          epi::EpiSwiGLU E{HID, (const LAS float*)(F.lds + FUSED_LDS_OFF)}; const unsigned long long pc0_ = PROBE_CLK ? __builtin_amdgcn_s_memtime() : 0ull; for (int rep_ = 0; rep_ < PROBE_REP_GU; ++rep_) pg8::gemm_phase<epi::EpiSwiGLU, epi::OrdOrder, true, true>(F.lds, g, S, E); \
          if (PROBE_CLK) { const unsigned long long pc1_ = __builtin_amdgcn_s_memtime(); while (__builtin_amdgcn_s_memtime() - pc1_ < pc1_ - pc0_) __builtin_amdgcn_s_sleep(32); } \
          if (PROBE_NULL_GU) { epi::EpiNull EN; for (int rep_ = 0; rep_ < PROBE_NULL_GU; ++rep_) pg8::gemm_phase<epi::EpiNull, epi::OrdOrder, true, true>(F.lds, g, S, EN); } \
          if (PROBE_HOT_GU) { epi::EpiNull EN; epi::HotOrder HS{11, (int)blockIdx.x}; pg8::gemm_phase<epi::EpiNull, epi::HotOrder, true, true>(F.lds, g, HS, EN); } \
          if (PROBE_NOST_GU) { epi::EpiSwiGLUT<1> EN{HID, (const LAS float*)(F.lds + FUSED_LDS_OFF)}; pg8::gemm_phase<epi::EpiSwiGLUT<1>, epi::OrdOrder, true, true>(F.lds, g, S, EN); } } \
        GRID_BAR(); \
        if (PROBE_FUSED_DN) { FUSED_GEMM_X((bf16*)(P.ws + WS_ATT), (float*)(P.ws + WS_SSQ1), HID, (const bf16*)(P.ws + WS_WD + (2 * (l) + (f)) * WD_BYTES), FF, 6 + 2 * (l) + (f), P.norm_g + ((l) * 6 + 4 * (f) + 1) * DM, 0.5f, false, PROBE_FUSED_VAR); GRID_BAR(); } \
        FUSED_GEMM(HID, (const bf16*)(P.ws + WS_WD + (2 * (l) + (f)) * WD_BYTES), FF, 3 * (l) + 2 * (f), P.norm_g + ((l) * 6 + 4 * (f) + 1) * DM, 0.5f, LAST_); \
        if (!(LAST_)) GRID_BAR(); } while (0)

    FFN_PHASES(0, 0, false);
    if (DBG_STAGES >= 2) {
        { pg8::Gemm g{XB, (const bf16*)(P.ws + WS_WIN0), MROWS, NEV, DM}; epi::OrdOrder S; S.base.init(MROWS, NEV, F.G, (int)blockIdx.x);
          epi::rowstat_table(S, RS, (LAS float*)(F.lds + FUSED_LDS_OFF), NEV / 256 / 2);
          unsigned char* r1 = P.ws + WS_R1;
          epi::EpiProjEven E{(bf16*)r1, (bf16*)(r1 + 192 * MiB), (bf16*)(r1 + 208 * MiB),
                             (float*)(r1 + 210 * MiB), (const LAS float*)(F.lds + FUSED_LDS_OFF), (const unsigned*)(P.ws + WS_C64), (const float*)(P.ws + WS_C32), (const float*)(P.ws + WS_S32)};
          for (int rep_ = 0; rep_ < PROBE_REP_WIN; ++rep_) pg8::gemm_phase<epi::EpiProjEven, epi::OrdOrder, true, true>(F.lds, g, S, E); }
        GRID_BAR();
#ifdef PROBE_IDX_VAR
        for (int vr_ = 0; vr_ < 4; ++vr_)
        for (int p = F.vcu; p < 1024; p += F.G) { const int b = p >> 6, j = p & 63;
#pragma unroll 1
            for (int k = 0; k < 2; ++k) indexer_unit<PROBE_IDX_VAR>(F, P, b, k ? 127 - j : j); }
#endif
        for (int rep_ = 0; rep_ < PROBE_REP_IDXA * PROBE_REP_IDX; ++rep_) { if (!DBG_NO_IDX) indexer_phase(F, P); }
        {
            float l01 = 0.f, l23 = 0.f;
            for (int i = 0; i < 64; ++i) { l01 += P.elam[i] * P.elam[64 + i]; l23 += P.elam[128 + i] * P.elam[192 + i]; }
            const float lam = expf(l01) - expf(l23) + 0.2f;
            for (int rep_ = 0; rep_ < PROBE_REP_IDXA; ++rep_)
            for (int p = F.vcu; p < 256; p += F.G) { const int bh = p >> 2, s = p & 3;
#pragma unroll 1
                for (int k = 0; k < 2; ++k) { if (!DBG_NO_A) a_unit(F, P, bh >> 2, bh & 3, k ? 7 - s : s, lam); } }
        }
        GRID_BAR();
        for (int rep_ = 0; rep_ < PROBE_REP_B; ++rep_) {
            int pre_ = 0;
#pragma unroll 1
            for (int j = 0; j < 4; ++j) { const int p = F.vcu + 256 * (j >> 1), bh = p >> 2, s = p & 3, qb = (j & 1) ? 7 - s : s;
                const int jn = j + 1, pn = F.vcu + 256 * (jn >> 1), bhn = pn >> 2, sn = pn & 3, qbn = (jn & 1) ? 7 - sn : sn;
                if (!DBG_NO_B) b_unit(F, P, bh >> 3, bh & 7, qb, (PROBE_B_HOT && rep_ + 1 < PROBE_REP_B) ? 0 : -1, (rep_ + 1 < PROBE_REP_B) ? PROBE_B_SKIP : 0, jn < 4, bhn >> 3, bhn & 7, qbn, pre_); } }
        GRID_BAR();
        FUSED_GEMM(ATT, (const bf16*)(P.ws + WS_WOUT0), DM, 3 * 0 + 1, P.norm_g + (0 * 6 + 3) * DM, 1.0f, false);
        GRID_BAR();
    }
    if (DBG_STAGES >= 3) FFN_PHASES(0, 1, false);
#ifdef PROBE_XBAR
    for (int i_ = 0; i_ < PROBE_XBAR; ++i_) GRID_BAR();
#endif
#ifdef PROBE_IDLE_CYC
    { const unsigned long long t0_ = __builtin_amdgcn_s_memtime(); while (__builtin_amdgcn_s_memtime() - t0_ < (unsigned long long)PROBE_IDLE_CYC) __builtin_amdgcn_s_sleep(32); }
#endif
#ifdef PROBE_IDLE_US
    { const unsigned long long t0_ = __builtin_amdgcn_s_memrealtime(); while (__builtin_amdgcn_s_memrealtime() - t0_ < 100ull * PROBE_IDLE_US) __builtin_amdgcn_s_sleep(32); }
#endif
    if (DBG_STAGES >= 4) FFN_PHASES(1, 0, false);
    if (DBG_STAGES >= 5) {
        { pg8::Gemm g{XB, (const bf16*)(P.ws + WS_WIN1), MROWS, NOD, DM}; epi::OrdOrder S; S.base.init(MROWS, NOD, F.G, (int)blockIdx.x);
          epi::rowstat_table(S, RS, (LAS float*)(F.lds + FUSED_LDS_OFF), NOD / 256 / 2);
          unsigned char* r1 = P.ws + WS_R1; epi::EpiProjOdd E{(bf16*)r1, (const LAS float*)(F.lds + FUSED_LDS_OFF)};
          pg8::gemm_phase<epi::EpiProjOdd, epi::OrdOrder, true, true>(F.lds, g, S, E); }
        GRID_BAR();
        for (int rep_ = 0; rep_ < PROBE_REP_C; ++rep_) { const int p = F.vcu, b = p >> 4, h = p & 15; int pre_ = 0;
#pragma unroll 1
            for (int qb = 0; qb < 8; ++qb) c_unit(F, P, b, h, qb, qb < 7, pre_); }
        GRID_BAR();
        FUSED_GEMM(ATT, (const bf16*)(P.ws + WS_WOUT1), DM, 3 * 1 + 1, P.norm_g + (1 * 6 + 3) * DM, 1.0f, false);
        GRID_BAR();
    }
    if (DBG_STAGES >= 6) FFN_PHASES(1, 1, true);
}

extern "C" void kernel_launch(void* const* d_in, const int* in_sizes, int n_in, void* d_out, int out_size, void* d_ws, size_t ws_size, hipStream_t stream) {
    static int grid = 0;
    if (grid == 0) {
        if (n_in != 12 || in_sizes[0] != MROWS * DM || out_size != MROWS * DM || ws_size < WS_END) {
            fprintf(stderr, "kernel_launch: unexpected shapes / workspace (n_in %d, in0 %d, out %d, ws %zu, need %zu); nothing launched\n", n_in, n_in > 0 ? in_sizes[0] : -1, out_size, ws_size, (size_t)WS_END); grid = -1; return; }
        int dev = 0, cus = 0, per_cu = 0;
        if (hipGetDevice(&dev) != hipSuccess || hipDeviceGetAttribute(&cus, hipDeviceAttributeMultiprocessorCount, dev) != hipSuccess) { fprintf(stderr, "kernel_launch: device query failed\n"); grid = -1; return; }
        if (hipFuncSetAttribute((const void*)fwd_kernel, hipFuncAttributeMaxDynamicSharedMemorySize, LDS_BYTES) != hipSuccess) { fprintf(stderr, "kernel_launch: hipFuncSetAttribute failed\n"); grid = -1; return; }
        if (hipOccupancyMaxActiveBlocksPerMultiprocessor(&per_cu, (const void*)fwd_kernel, NWAVES * 64, LDS_BYTES) != hipSuccess || per_cu < 1)
            fprintf(stderr, "kernel_launch: note: occupancy query reports %d workgroups per CU\n", per_cu);
        (void)hipGetLastError();
        grid = cus;
        if (grid != 256) { fprintf(stderr, "kernel_launch: built for a 256-CU device (the fused epilogues pair workgroups by rounds of 256), found %d; nothing launched\n", cus); grid = -1; return; }
    }
    if (grid < 0) return;
    if (hipMemsetAsync((char*)d_ws + WS_CTL, 0, CTL_ZERO_BYTES, stream) != hipSuccess) { fprintf(stderr, "kernel_launch: memset failed\n"); return; }
    Args a{};
    for (int i = 0; i < 12; ++i) a.in[i] = (const float*)d_in[i];
    a.out = (float*)d_out; a.ws = (unsigned char*)d_ws;
    hipLaunchKernelGGL(fwd_kernel, dim3(grid), dim3(NWAVES * 64), LDS_BYTES, stream, a);
    const hipError_t le = hipPeekAtLastError();
    if (le != hipSuccess) fprintf(stderr, "kernel_launch: launch failed: %s\n", hipGetErrorName(le));
}
```

```cpp
#include <hip/hip_runtime.h>
#include <cstdio>
#include <cstdint>
#ifndef PG8_WGM
#define PG8_WGM 8
#endif
namespace pg8 {
#define PG8_LAS __attribute__((address_space(3)))
typedef unsigned short bf16_t;
typedef short bf16x8 __attribute__((ext_vector_type(8)));
typedef float f32x4 __attribute__((ext_vector_type(4)));
typedef unsigned u32x4 __attribute__((ext_vector_type(4)));
constexpr int BM = 256, BK = 64, HALF = 128, HTB = HALF * BK * 2  , STAGE_BYTES = 8 * HTB, NXCD = 8, WGM = PG8_WGM;

__host__ __device__ __forceinline__ int lds_byte(int r, int c) { const int st = (r >> 4) * 2 + (c >> 5), rr = r & 15, cc = c & 31, ob = rr * 64 + cc * 2; return st * 1024 + (ob ^ (((ob >> 9) & 1) << 5)); }
__host__ __device__ __forceinline__ void stage_rc(int b, int& R, int& C) { const int st = b / 1024, sb = b % 1024, swz = sb ^ (((sb >> 9) & 1) << 5); R = (st >> 1) * 16 + swz / 64; C = (st & 1) * 32 + (swz % 64) / 2; }
__host__ __device__ __forceinline__ int perm32(int rho) { const int n = rho >> 4, i = rho & 15; return 8 * (i >> 2) + 4 * n + (i & 3); }

struct Unit { int pm, pn, idx; };
struct Gemm { const bf16_t* A; const bf16_t* Bt; int M, N, K; };

struct StaticOrder {
    int nM, nN, nwg, G, c;
    __host__ __device__ void init(int M, int N, int G_, int c_) { nM = M / BM; nN = N / BM; nwg = nM * nN; G = G_; c = c_; }
    __host__ __device__ bool next(int i, Unit& u) const {
        const long L = (long)i * G + c; if (L >= nwg) return false;
        int wgid = (int)L; { const int q = nwg / NXCD, r = nwg % NXCD, xcd = wgid % NXCD, off = wgid / NXCD; wgid = (xcd < r ? xcd * (q + 1) : r * (q + 1) + (xcd - r) * q) + off; }
        const int nig = WGM * nN, gid = wgid / nig, fm = gid * WGM, gsz = (nM - fm) < WGM ? (nM - fm) : WGM;
        u.pm = fm + ((wgid % nig) % gsz); u.pn = (wgid % nig) / gsz; return true;
    }
    __device__ __forceinline__ void a_ready(const Unit&) const {}
    __device__ __forceinline__ void done(const Unit&) const {}
};

__device__ __forceinline__ unsigned cvt_pk_bf16(float lo, float hi) { unsigned r; asm volatile("v_cvt_pk_bf16_f32 %0, %1, %2" : "=v"(r) : "v"(lo), "v"(hi)); return r; }
typedef float f32x2 __attribute__((ext_vector_type(2)));
__device__ __forceinline__ f32x2 gelu_pk(f32x2 v) {
    const f32x2 av = __builtin_elementwise_abs(v), d = av * 0.2316418882f + 1.0f;
    f32x2 t; t.x = __builtin_amdgcn_rcpf(d.x); t.y = __builtin_amdgcn_rcpf(d.y);
    f32x2 q = t * 0.5307027145f + (-0.7265760135f); q = q * t + 0.7107068705f; q = q * t + (-0.142248368f); q = q * t + 0.127414796f; q = q * t;
    const f32x2 s = (v * v) * (-0.72134752044f);
    f32x2 e; e.x = __builtin_amdgcn_exp2f(s.x); e.y = __builtin_amdgcn_exp2f(s.y);
    const f32x2 m = v * (q * e), r = v - m;
    f32x2 o; o.x = v.x < 0.f ? m.x : r.x; o.y = v.y < 0.f ? m.y : r.y; return o;
}

template <int ACT  > struct EpiBf16 {
    static constexpr bool PERM = true, AFTER_DRAIN = false; static_assert(ACT == 0 || ACT == 1, "EpiBf16: ACT is 0 (none) or 1 (gelu_pk)");
    bf16_t* O; int ldc; const float* bias; int split_cols; size_t split_stride; float scale0;
    __device__ __forceinline__ void operator()(const f32x4 (&acc)[2][2][4][2], const Unit& u, int wr, int wc, int fr, int fq) const {
        const int row0 = u.pm * BM + wr * 64 + fr; int colt = u.pn * BM; bf16_t* base = O;
        float sc = 1.f; if (split_cols) { const int t = colt / split_cols; base += (size_t)t * split_stride; colt -= t * split_cols; if (t == 0) sc = scale0; }
        const int col0 = colt + wc * 32 + 8 * fq, bcol0 = u.pn * BM + wc * 32 + 8 * fq;
        f32x4 bv[2][2];
#pragma unroll
        for (int bj = 0; bj < 2; ++bj)
#pragma unroll
            for (int n = 0; n < 2; ++n) bv[bj][n] = bias ? *(const f32x4*)(bias + bcol0 + bj * HALF + 4 * n) : (f32x4){0.f, 0.f, 0.f, 0.f};
#pragma unroll
        for (int ai = 0; ai < 2; ++ai)
#pragma unroll
            for (int m = 0; m < 4; ++m) { bf16_t* rowp = base + (size_t)(row0 + ai * HALF + m * 16) * ldc + col0;
#pragma unroll
                for (int bj = 0; bj < 2; ++bj) { f32x4 v0 = acc[ai][bj][m][0] + bv[bj][0], v1 = acc[ai][bj][m][1] + bv[bj][1];
                    if (ACT == 1) { f32x2 a = gelu_pk((f32x2){v0[0], v0[1]}), b = gelu_pk((f32x2){v0[2], v0[3]}), c = gelu_pk((f32x2){v1[0], v1[1]}), d = gelu_pk((f32x2){v1[2], v1[3]});
                        v0 = (f32x4){a.x, a.y, b.x, b.y}; v1 = (f32x4){c.x, c.y, d.x, d.y}; }
                    v0 = v0 * sc; v1 = v1 * sc; u32x4 w; w.x = cvt_pk_bf16(v0[0], v0[1]); w.y = cvt_pk_bf16(v0[2], v0[3]); w.z = cvt_pk_bf16(v1[0], v1[1]); w.w = cvt_pk_bf16(v1[2], v1[3]);
                    *(u32x4*)(rowp + bj * HALF) = w; } }
    }
};

struct PanelStats {
    unsigned* xbuf;
    unsigned* cnt;
    unsigned* tmo;
    int ntn; float eps;
    unsigned code;
    __device__ __forceinline__ bool run(const f32x4 (&v)[2][2][4][2], const Unit& u, int wr, int wc, int fr, int fq, PG8_LAS unsigned char* lds, int wid, int lane) const {
        typedef float f32x2v __attribute__((ext_vector_type(2)));
        PG8_LAS f32x2v* P = (PG8_LAS f32x2v*)lds;
        PG8_LAS f32x2v* S = (PG8_LAS f32x2v*)(lds + 8192);
        PG8_LAS unsigned* flag = (PG8_LAS unsigned*)(lds + 8192 + 2048);
#pragma unroll
        for (int ai = 0; ai < 2; ++ai)
#pragma unroll
            for (int m = 0; m < 4; ++m) {
                float s = 0.f;
#pragma unroll
                for (int bj = 0; bj < 2; ++bj)
#pragma unroll
                    for (int n = 0; n < 2; ++n) { const f32x4 x = v[ai][bj][m][n]; s += (x[0] + x[1]) + (x[2] + x[3]); }
                s += __shfl_xor(s, 16); s += __shfl_xor(s, 32);
                const float mw = s * (1.0f / 64.0f); float q = 0.f;
#pragma unroll
                for (int bj = 0; bj < 2; ++bj)
#pragma unroll
                    for (int n = 0; n < 2; ++n) { const f32x4 d = v[ai][bj][m][n] - mw; q += (d[0] * d[0] + d[1] * d[1]) + (d[2] * d[2] + d[3] * d[3]); }
                q += __shfl_xor(q, 16); q += __shfl_xor(q, 32);
                if (fq == 0) P[(ai * HALF + wr * 64 + m * 16 + fr) * 4 + wc] = (f32x2v){mw, q};
            }
        asm volatile("s_waitcnt lgkmcnt(0)" ::: "memory"); __builtin_amdgcn_s_barrier(); asm volatile("" ::: "memory");
#if defined(BROKEN_EXCHANGE_NO_WAIT)
#warning BROKEN CONTROL BUILD: the row-statistics exchange does not wait; results are wrong by design
        if (blockIdx.x >= 64) { const long long t0_ = clock64(); while (clock64() - t0_ < 60000) __builtin_amdgcn_s_sleep(8); }
#endif
        const int row = wid * 32 + (lane & 31);
        if (lane < 32) {
            const f32x2v a = P[row * 4 + 0], b = P[row * 4 + 1], c = P[row * 4 + 2], d = P[row * 4 + 3];
            const float mt = (a.x + b.x + c.x + d.x) * 0.25f;
            const float da = a.x - mt, db = b.x - mt, dc = c.x - mt, dd = d.x - mt;
            const float m2 = (a.y + b.y) + (c.y + d.y) + 64.0f * ((da * da + db * db) + (dc * dc + dd * dd));
            unsigned long long* slot = (unsigned long long*)xbuf + ((size_t)(u.pm * BM + row) * 4 + u.pn);
            __hip_atomic_store(slot, ((unsigned long long)__float_as_uint(m2) << 32) | __float_as_uint(mt), __ATOMIC_RELAXED, __HIP_MEMORY_SCOPE_AGENT);
        }
        asm volatile("s_waitcnt vmcnt(0)" ::: "memory");
        if (lane == 0) __hip_atomic_fetch_add(cnt + 64 * u.pm, 1u, __ATOMIC_RELAXED, __HIP_MEMORY_SCOPE_AGENT);
        if (wid == 0) {
            bool dead = false; const unsigned long long t0 = __builtin_amdgcn_s_memrealtime(); const unsigned want = 8u * (unsigned)ntn;
            for (;;) {
#if defined(BROKEN_EXCHANGE_NO_WAIT)
                break;
#endif
                if ((unsigned)__builtin_amdgcn_readfirstlane(__hip_atomic_load(cnt + 64 * u.pm, __ATOMIC_RELAXED, __HIP_MEMORY_SCOPE_AGENT)) >= want) break;
                if (__builtin_amdgcn_s_memrealtime() - t0 > 2000000ull) {
                    if (lane == 0) { unsigned expect = 0u; __hip_atomic_compare_exchange_strong(tmo + 1, &expect, code | (unsigned)(u.pm & 0xff), __ATOMIC_RELAXED, __ATOMIC_RELAXED, __HIP_MEMORY_SCOPE_AGENT);
                                     __hip_atomic_store(tmo, 1u, __ATOMIC_RELAXED, __HIP_MEMORY_SCOPE_AGENT); }
                    dead = true; break; }
                __builtin_amdgcn_s_sleep(2);
            }
            __builtin_amdgcn_fence(__ATOMIC_ACQUIRE, "agent");
            if (lane == 0) flag[0] = dead ? 1u : 0u;
        }
        asm volatile("s_waitcnt vmcnt(0) lgkmcnt(0)" ::: "memory"); __builtin_amdgcn_s_barrier(); asm volatile("" ::: "memory");
        const bool bad = flag[0] != 0u;
        if (lane < 32) {
            const unsigned long long* slot = (const unsigned long long*)xbuf + (size_t)(u.pm * BM + row) * 4; float mt[4], m2[4]; float ms = 0.f;
#pragma unroll
            for (int t = 0; t < 4; ++t) { if (t < ntn) { const unsigned long long w = __hip_atomic_load(slot + t, __ATOMIC_RELAXED, __HIP_MEMORY_SCOPE_AGENT); mt[t] = __uint_as_float((unsigned)w); m2[t] = __uint_as_float((unsigned)(w >> 32)); } else { mt[t] = 0.f; m2[t] = 0.f; } ms += mt[t]; }
            const float mean = ms / (float)ntn; float q = 0.f;
#pragma unroll
            for (int t = 0; t < 4; ++t) if (t < ntn) { const float dm = mt[t] - mean; q += m2[t] + 256.0f * dm * dm; }
            S[row] = (f32x2v){mean, 1.0f / sqrtf(q / (256.0f * (float)ntn) + eps)};
        }
        asm volatile("s_waitcnt lgkmcnt(0)" ::: "memory"); __builtin_amdgcn_s_barrier(); asm volatile("" ::: "memory");
        return bad;
    }
};
struct EpiLnRes {
    static constexpr bool PERM = false, AFTER_DRAIN = true;
    const float* base; float* out; int ldc; const float* bias; PanelStats st; unsigned poison;
    __device__ __forceinline__ void fused(f32x4 (&acc)[2][2][4][2], const Unit& u, int wr, int wc, int fr, int fq, PG8_LAS unsigned char* lds, int wid, int lane) const {
        typedef float f32x2v __attribute__((ext_vector_type(2)));
        const PG8_LAS f32x2v* S = (const PG8_LAS f32x2v*)(lds + 8192);
        const int col0 = u.pn * BM + wc * 32 + 4 * fq;
#pragma unroll
        for (int bj = 0; bj < 2; ++bj)
#pragma unroll
            for (int n = 0; n < 2; ++n) { const f32x4 bv = bias ? *(const f32x4*)(bias + col0 + bj * HALF + n * 16) : (f32x4){0.f, 0.f, 0.f, 0.f};
#pragma unroll
                for (int ai = 0; ai < 2; ++ai)
#pragma unroll
                    for (int m = 0; m < 4; ++m) acc[ai][bj][m][n] += bv; }
        f32x4 pre[4][2][2];
#pragma unroll
        for (int m = 0; m < 4; ++m) { const size_t off = (size_t)(u.pm * BM + wr * 64 + m * 16 + fr) * ldc + col0;
#pragma unroll
            for (int bj = 0; bj < 2; ++bj)
#pragma unroll
                for (int n = 0; n < 2; ++n) pre[m][bj][n] = *(const f32x4*)(base + off + bj * HALF + n * 16); }
        const bool bad = st.run(acc, u, wr, wc, fr, fq, lds, wid, lane) || poison != 0u;
        const float qnan = __builtin_nanf("");
#pragma unroll
        for (int ai = 0; ai < 2; ++ai)
#pragma unroll
            for (int m = 0; m < 4; ++m) { const int r = ai * HALF + wr * 64 + m * 16 + fr; const f32x2v sr = S[r]; const size_t off = (size_t)(u.pm * BM + r) * ldc + col0;
#pragma unroll
                for (int bj = 0; bj < 2; ++bj)
#pragma unroll
                    for (int n = 0; n < 2; ++n) { const f32x4 bs = ai == 0 ? pre[m][bj][n] : *(const f32x4*)(base + off + bj * HALF + n * 16); f32x4 o = bs + (acc[ai][bj][m][n] - sr.x) * sr.y;
                        if (bad) o = (f32x4){qnan, qnan, qnan, qnan}; *(f32x4*)(out + off + bj * HALF + n * 16) = o; }
                if (m & 1) asm volatile("" ::: "memory"); }
    }
};
struct EpiLnResLn {
    static constexpr bool PERM = false, AFTER_DRAIN = true;
    const float* base; float* out; bf16_t* xn; int ldc; const float* bias; PanelStats st1, st2; unsigned poison;
    __device__ __forceinline__ void fused(f32x4 (&acc)[2][2][4][2], const Unit& u, int wr, int wc, int fr, int fq, PG8_LAS unsigned char* lds, int wid, int lane) const {
        typedef float f32x2v __attribute__((ext_vector_type(2))); typedef unsigned u32x2v __attribute__((ext_vector_type(2)));
        const PG8_LAS f32x2v* S = (const PG8_LAS f32x2v*)(lds + 8192);
        const int col0 = u.pn * BM + wc * 32 + 4 * fq;
#pragma unroll
        for (int bj = 0; bj < 2; ++bj)
#pragma unroll
            for (int n = 0; n < 2; ++n) { const f32x4 bv = bias ? *(const f32x4*)(bias + col0 + bj * HALF + n * 16) : (f32x4){0.f, 0.f, 0.f, 0.f};
#pragma unroll
                for (int ai = 0; ai < 2; ++ai)
#pragma unroll
                    for (int m = 0; m < 4; ++m) acc[ai][bj][m][n] += bv; }
        bool bad = st1.run(acc, u, wr, wc, fr, fq, lds, wid, lane) || poison != 0u;
        const float qnan = __builtin_nanf("");
#pragma unroll
        for (int ai = 0; ai < 2; ++ai)
#pragma unroll
            for (int m = 0; m < 4; ++m) { const int r = ai * HALF + wr * 64 + m * 16 + fr; const f32x2v sr = S[r]; const size_t off = (size_t)(u.pm * BM + r) * ldc + col0;
#pragma unroll
                for (int bj = 0; bj < 2; ++bj)
#pragma unroll
                    for (int n = 0; n < 2; ++n) { const f32x4 bs = *(const f32x4*)(base + off + bj * HALF + n * 16); acc[ai][bj][m][n] = bs + (acc[ai][bj][m][n] - sr.x) * sr.y; }
                asm volatile("" : "+v"(acc[ai][0][m][0]), "+v"(acc[ai][0][m][1]), "+v"(acc[ai][1][m][0]), "+v"(acc[ai][1][m][1]));
                if (m & 1) asm volatile("" ::: "memory"); }
        const bool bad1 = bad;
        bad = st2.run(acc, u, wr, wc, fr, fq, lds, wid, lane) || bad;
#pragma unroll
        for (int ai = 0; ai < 2; ++ai)
#pragma unroll
            for (int m = 0; m < 4; ++m) { const int r = ai * HALF + wr * 64 + m * 16 + fr; const f32x2v sr = S[r]; const size_t off = (size_t)(u.pm * BM + r) * ldc + col0;
#pragma unroll
                for (int bj = 0; bj < 2; ++bj)
#pragma unroll
                    for (int n = 0; n < 2; ++n) { const f32x4 x1 = acc[ai][bj][m][n]; *(f32x4*)(out + off + bj * HALF + n * 16) = bad1 ? (f32x4){qnan, qnan, qnan, qnan} : x1;
                        const f32x4 o = (x1 - sr.x) * sr.y; u32x2v w; w.x = cvt_pk_bf16(o[0], o[1]); w.y = cvt_pk_bf16(o[2], o[3]);
                        if (bad) { w.x = 0x7fc07fc0u; w.y = 0x7fc07fc0u; } *(u32x2v*)(xn + off + bj * HALF + n * 16) = w; }
                asm volatile("" ::: "memory"); }
    }
};

typedef unsigned pend4 __attribute__((ext_vector_type(4)));
#ifndef PG8_TAIL_ON
#define PG8_TAIL_ON 0
#endif
#ifndef PG8_NDEF
#define PG8_NDEF 4
#endif
template <class...> using pg8_void_t = void;
template <class E, class = void> struct EpiTail { static constexpr int value = 0; };
template <class E> struct EpiTail<E, pg8_void_t<decltype(E::TAIL_OPS)>> { static constexpr int value = E::TAIL_OPS; };
template <class E, class = void> struct EpiDefer { static constexpr bool value = false; };
template <class E> struct EpiDefer<E, pg8_void_t<decltype(E::DEFER)>> { static constexpr bool value = E::DEFER; };
template <class Epi, class Sched, bool ALIGN_EPI = false, bool SP2 = false>
__device__ __forceinline__ void gemm_phase(PG8_LAS unsigned char* lds, const Gemm g, const Sched& S, const Epi& E) {
    int tid_ = threadIdx.x; asm volatile("" : "+v"(tid_));
    const int tid = tid_, wid = __builtin_amdgcn_readfirstlane(tid >> 6), lane = tid & 63, wr = wid >> 2, wc = wid & 3, fr = lane & 15, fq = lane >> 4;
    const int K = g.K, nt = K / BK;
    unsigned voffA[2], voffB[2];
#pragma unroll
    for (int i = 0; i < 2; ++i) { int R, C; stage_rc(tid * 16 + i * 8192, R, C); const int Rb = Epi::PERM ? ((R & ~31) + perm32(R & 31)) : R;
        voffA[i] = (unsigned)(R * K + C) * 2u; voffB[i] = (unsigned)(Rb * K + C) * 2u; }
    const size_t kstep = (size_t)(BK * 2);
    const size_t hstep = (size_t)HALF * K * 2;
    const size_t tstep = 2 * hstep;
    const unsigned ldsw = (unsigned)wid * 1024u;
    const int aoff = lds_byte(wr * 64 + fr, fq * 8), boff = lds_byte(wc * 32 + fr, fq * 8);
#define PG8_SA(b, h) (((b) * 2 + (h)) * HTB)
#define PG8_SB(b, h) ((4 + (b) * 2 + (h)) * HTB)
#define PG8_STAGE(bufoff, gbase, voff) do { _Pragma("unroll") for (int _i = 0; _i < 2; ++_i) \
        __builtin_amdgcn_global_load_lds((const unsigned*)((const char*)(gbase) + (voff)[_i]), (PG8_LAS unsigned*)(lds + (bufoff) + ldsw + _i * 8192), 16, 0, 0); } while (0)
#define PG8_LDA(dst, b, h) do { _Pragma("unroll") for (int m = 0; m < 4; ++m) _Pragma("unroll") for (int k = 0; k < 2; ++k) dst[m][k] = *(const PG8_LAS bf16x8*)(lds + PG8_SA(b, h) + aoff + m * 2048 + k * 1024); } while (0)
#define PG8_LDB(dst, b, h) do { _Pragma("unroll") for (int n = 0; n < 2; ++n) _Pragma("unroll") for (int k = 0; k < 2; ++k) dst[n][k] = *(const PG8_LAS bf16x8*)(lds + PG8_SB(b, h) + boff + n * 2048 + k * 1024); } while (0)
#define PG8_MMA(ai, bj, At, Bt) do { __builtin_amdgcn_s_setprio(1); _Pragma("unroll") for (int m = 0; m < 4; ++m) _Pragma("unroll") for (int n = 0; n < 2; ++n) _Pragma("unroll") for (int k = 0; k < 2; ++k) \
        acc[ai][bj][m][n] = __builtin_amdgcn_mfma_f32_16x16x32_bf16(Bt[n][k], At[m][k], acc[ai][bj][m][n], 0, 0, 0); __builtin_amdgcn_s_setprio(0); } while (0)
#define PG8_WAIT_V(n) asm volatile("s_waitcnt vmcnt(" #n ")" ::: "memory")
#define PG8_WAIT_L(n) asm volatile("s_waitcnt lgkmcnt(" #n ")" ::: "memory")
#define PG8_WAIT_VT(relax) asm volatile("s_cmp_lg_u32 %0, 0\n\ts_cbranch_scc1 .Lpg8w%=\n\ts_waitcnt vmcnt(8)\n.Lpg8w%=:\n\ts_waitcnt vmcnt(16)" :: "s"(relax) : "memory", "scc")
#define PG8_BAR __builtin_amdgcn_s_barrier()
#define PG8_SCHED __builtin_amdgcn_sched_barrier(0)
    Unit cur, nxt; int ui = 0;
    if (!S.next(0, cur)) return;
    constexpr bool DEFER = EpiDefer<Epi>::value; constexpr int TAIL = PG8_TAIL_ON ? EpiTail<Epi>::value : 0; static_assert(TAIL == 0 || TAIL == 8, "PG8_WAIT_VT is written for 8 trailing operations");
    constexpr int NDEF = PG8_NDEF; pend4 pend[NDEF]; char* pptr = nullptr; bool have_pend = false;
    if constexpr (DEFER) {
#pragma unroll
        for (int j = 0; j < NDEF; ++j) pend[j] = (pend4){0u, 0u, 0u, 0u};
    }
    f32x4 acc[2][2][4][2];
#pragma unroll
    for (int a = 0; a < 2; ++a)
#pragma unroll
        for (int b = 0; b < 2; ++b)
#pragma unroll
            for (int m = 0; m < 4; ++m)
#pragma unroll
                for (int n = 0; n < 2; ++n) acc[a][b][m][n] = (f32x4){0.f, 0.f, 0.f, 0.f};
    bf16x8 At[4][2], B0[2][2], B1[2][2];
    const char* cA = (const char*)g.A + (size_t)cur.pm * tstep; const char* cB = (const char*)g.Bt + (size_t)cur.pn * tstep;
    S.a_ready(cur);
    if constexpr (SP2) {
        PG8_STAGE(PG8_SB(0, 0), cB, voffB); PG8_STAGE(PG8_SB(0, 1), cB + hstep, voffB); PG8_STAGE(PG8_SA(0, 0), cA, voffA); PG8_STAGE(PG8_SA(0, 1), cA + hstep, voffA);
        if (wr == 1) PG8_BAR;
        PG8_WAIT_V(2); PG8_BAR;
        PG8_STAGE(PG8_SB(1, 0), cB + kstep, voffB); PG8_STAGE(PG8_SA(1, 0), cA + kstep, voffA); PG8_STAGE(PG8_SB(1, 1), cB + hstep + kstep, voffB);
        PG8_WAIT_V(6); PG8_BAR;
    } else {
        PG8_STAGE(PG8_SB(0, 0), cB, voffB); PG8_STAGE(PG8_SA(0, 0), cA, voffA); PG8_STAGE(PG8_SB(0, 1), cB + hstep, voffB); PG8_STAGE(PG8_SA(0, 1), cA + hstep, voffA);
        if (wr == 1) PG8_BAR;
        PG8_WAIT_V(4); PG8_BAR;
        PG8_STAGE(PG8_SB(1, 0), cB + kstep, voffB); PG8_STAGE(PG8_SA(1, 0), cA + kstep, voffA); PG8_STAGE(PG8_SB(1, 1), cB + hstep + kstep, voffB);
        PG8_WAIT_V(6); PG8_BAR;
    }
    for (;;) {
        const bool has_next = S.next(ui + 1, nxt);
        const char* nA = has_next ? (const char*)g.A + (size_t)nxt.pm * tstep : cA; const char* nB = has_next ? (const char*)g.Bt + (size_t)nxt.pn * tstep : cB;
        for (int t = 0; t < nt; t += 2) {
            const bool last = (t == nt - 2);
            const char* a1 = cA + (size_t)(t + 1) * kstep;
            const int relax_ = __builtin_amdgcn_readfirstlane((t == 0 && ui > 0) ? 1 : 0);
            const char* a2 = last ? nA : cA + (size_t)(t + 2) * kstep; const char* b2 = last ? nB : cB + (size_t)(t + 2) * kstep;
            const char* a3 = a2 + kstep; const char* b3 = b2 + kstep;
            if (last && has_next) S.a_ready(nxt);
            if constexpr (SP2) {
            PG8_LDB(B0, 0, 0); PG8_LDB(B1, 0, 1); PG8_SCHED; PG8_LDA(At, 0, 0); PG8_STAGE(PG8_SA(1, 1), a1 + hstep, voffA);
            if constexpr (DEFER) {
                if (have_pend && t < 2 * NDEF) { const int j_ = 8 - NDEF + (t >> 1); *(pend4*)(pptr + (size_t)((j_ >> 2) * HALF + (j_ & 3) * 16) * Epi::DEFER_LD) = pend[0]; }
#pragma unroll
                for (int j = 0; j < NDEF - 1; ++j) pend[j] = pend[j + 1];
            }
            if constexpr (TAIL > 0) PG8_WAIT_VT(relax_); else PG8_WAIT_V(8);
            PG8_WAIT_L(0); PG8_BAR; PG8_MMA(0, 0, At, B0); PG8_MMA(0, 1, At, B1); PG8_BAR; PG8_SCHED;
            PG8_LDA(At, 0, 1); PG8_STAGE(PG8_SB(0, 0), b2, voffB); PG8_STAGE(PG8_SB(0, 1), b2 + hstep, voffB); PG8_STAGE(PG8_SA(0, 0), a2, voffA);
            if constexpr (TAIL > 0) PG8_WAIT_VT(relax_); else PG8_WAIT_V(8);
            PG8_WAIT_L(0); PG8_BAR; PG8_MMA(1, 0, At, B0); PG8_MMA(1, 1, At, B1); PG8_BAR; PG8_SCHED;
            PG8_LDB(B0, 1, 0); PG8_LDB(B1, 1, 1); PG8_SCHED; PG8_LDA(At, 1, 0); PG8_STAGE(PG8_SA(0, 1), a2 + hstep, voffA);
            PG8_WAIT_V(8); PG8_WAIT_L(0); PG8_BAR; PG8_MMA(0, 0, At, B0); PG8_MMA(0, 1, At, B1); PG8_BAR; PG8_SCHED;
            PG8_LDA(At, 1, 1); PG8_STAGE(PG8_SB(1, 0), b3, voffB); PG8_STAGE(PG8_SB(1, 1), b3 + hstep, voffB); PG8_STAGE(PG8_SA(1, 0), a3, voffA);
            PG8_WAIT_V(8); PG8_WAIT_L(0); PG8_BAR; PG8_MMA(1, 0, At, B0); PG8_MMA(1, 1, At, B1); PG8_BAR; PG8_SCHED;
            } else {
            PG8_LDB(B0, 0, 0); PG8_SCHED; PG8_LDA(At, 0, 0); PG8_STAGE(PG8_SA(1, 1), a1 + hstep, voffA);
            PG8_WAIT_L(8); PG8_BAR; PG8_WAIT_L(0); PG8_MMA(0, 0, At, B0); PG8_BAR; PG8_SCHED;
            PG8_LDB(B1, 0, 1); PG8_STAGE(PG8_SB(0, 0), b2, voffB);
            PG8_BAR; PG8_WAIT_L(0); PG8_MMA(0, 1, At, B1); PG8_BAR;
            PG8_LDA(At, 0, 1); PG8_STAGE(PG8_SA(0, 0), a2, voffA);
            PG8_BAR; PG8_WAIT_L(0); PG8_MMA(1, 0, At, B0); PG8_BAR; PG8_SCHED;
            PG8_STAGE(PG8_SB(0, 1), b2 + hstep, voffB);
            PG8_WAIT_V(6); PG8_BAR; PG8_MMA(1, 1, At, B1); PG8_BAR;
            PG8_LDB(B0, 1, 0); PG8_SCHED; PG8_LDA(At, 1, 0); PG8_STAGE(PG8_SA(0, 1), a2 + hstep, voffA);
            PG8_WAIT_L(8); PG8_BAR; PG8_WAIT_L(0); PG8_MMA(0, 0, At, B0); PG8_BAR; PG8_SCHED;
            PG8_LDB(B1, 1, 1); PG8_STAGE(PG8_SB(1, 0), b3, voffB);
            PG8_BAR; PG8_WAIT_L(0); PG8_MMA(0, 1, At, B1); PG8_BAR;
            PG8_LDA(At, 1, 1); PG8_STAGE(PG8_SA(1, 0), a3, voffA);
            PG8_BAR; PG8_WAIT_L(0); PG8_MMA(1, 0, At, B0); PG8_BAR; PG8_SCHED;
            PG8_STAGE(PG8_SB(1, 1), b3 + hstep, voffB);
            PG8_WAIT_V(6); PG8_BAR; PG8_MMA(1, 1, At, B1); PG8_BAR;
            }
        }
        if constexpr (ALIGN_EPI) { if (wr == 0) PG8_BAR; }
        if constexpr (DEFER) { E.compute(acc, cur, wr, wc, fr, fq, pend, pptr); have_pend = true; S.done(cur); } else
        if constexpr (!Epi::AFTER_DRAIN) { E(acc, cur, wr, wc, fr, fq); S.done(cur); }
        if (!has_next) break;
#pragma unroll
        for (int a = 0; a < 2; ++a)
#pragma unroll
            for (int b = 0; b < 2; ++b)
#pragma unroll
                for (int m = 0; m < 4; ++m)
#pragma unroll
                    for (int n = 0; n < 2; ++n) acc[a][b][m][n] = (f32x4){0.f, 0.f, 0.f, 0.f};
        cur = nxt; cA = nA; cB = nB; ++ui;
        if constexpr (ALIGN_EPI) { if (wr == 1) PG8_BAR; }
    }
    if constexpr (DEFER) {
#pragma unroll
        for (int j = 8 - NDEF; j < 8; ++j) *(pend4*)(pptr + (size_t)((j >> 2) * HALF + (j & 3) * 16) * Epi::DEFER_LD) = pend[j - (8 - NDEF)];
    }
    PG8_WAIT_V(0);
    if constexpr (!ALIGN_EPI) { if (wr == 0) PG8_BAR; }
    PG8_BAR;
    if constexpr (Epi::AFTER_DRAIN) { E.fused(acc, cur, wr, wc, fr, fq, lds, wid, lane); S.done(cur); }
#undef PG8_SA
#undef PG8_SB
#undef PG8_STAGE
#undef PG8_LDA
#undef PG8_LDB
#undef PG8_MMA
#undef PG8_WAIT_V
#undef PG8_WAIT_L
#undef PG8_WAIT_VT
#undef PG8_BAR
#undef PG8_SCHED
}
}

constexpr int NB = 16, SEQ = 2048, DM = 1024, FF = 2816, MROWS = NB * SEQ;
constexpr int NGU = 2 * FF;
constexpr int NEV = 3584;
constexpr int NOD = 3072;
constexpr float RMS_EPS = 1e-6f;
constexpr float LOG2E = 1.4426950408889634f;
constexpr float QSCALE = 0.125f * LOG2E;

#ifndef EPI_ROPE_BATCH
#define EPI_ROPE_BATCH 2
#endif
namespace epi {
using namespace pg8;
__device__ __forceinline__ unsigned pkbf(float lo, float hi) {
    typedef float f2_t __attribute__((ext_vector_type(2))); typedef __bf16 b2_t __attribute__((ext_vector_type(2)));
    f2_t v = {lo, hi}; b2_t b = __builtin_convertvector(v, b2_t); return __builtin_bit_cast(unsigned, b); }
__device__ __forceinline__ float row_rs(const float* ssq, int row) { const f32x4 p = *(const f32x4*)(ssq + (size_t)row * 4); return __builtin_amdgcn_rsqf(((p[0] + p[1]) + (p[2] + p[3])) * (1.f / DM) + RMS_EPS); }
__device__ __forceinline__ float epi_sum4fq(float s) {
    s += __int_as_float(__builtin_amdgcn_ds_swizzle(__float_as_int(s), (16 << 10) | 0x1f));
    auto rr = __builtin_amdgcn_permlane32_swap(__float_as_uint(s), __float_as_uint(s), false, false); return __uint_as_float(rr[0]) + __uint_as_float(rr[1]); }
#ifndef EPI_WT
#define EPI_WT 0
#endif
__device__ __forceinline__ void st16(void* p, const u32x4& v) {
#if EPI_WT
    asm volatile("s_nop 1\n\tglobal_store_dwordx4 %0, %1, off sc1" :: "v"(p), "v"(v) : "memory");
#else
    *(u32x4*)p = v;
#endif
}
__device__ __forceinline__ u32x4 pk8(const f32x4& a, const f32x4& b) { u32x4 w; w.x = pkbf(a[0], a[1]); w.y = pkbf(a[2], a[3]); w.z = pkbf(b[0], b[1]); w.w = pkbf(b[2], b[3]); return w; }

#ifndef EPI_DEFER_HID
#define EPI_DEFER_HID 0
#endif
template <int PVAR = 0>
struct EpiSwiGLUT {
    static constexpr bool PERM = true, AFTER_DRAIN = false;
    static constexpr int TAIL_OPS = (PVAR == 0) ? 8 : 0;
#if EPI_DEFER_HID
    static constexpr bool DEFER = (PVAR == 0); static constexpr size_t DEFER_LD = (size_t)FF * 2;
#endif
    bf16_t* H; const PG8_LAS float* tab;
    __device__ __forceinline__ void operator()(const f32x4 (&acc)[2][2][4][2], const Unit& u, int wr, int wc, int fr, int fq) const { pg8::pend4 pd[PG8_NDEF]; char* pp; run<false>(acc, u, wr, wc, fr, fq, pd, pp); }
    __device__ __forceinline__ void compute(const f32x4 (&acc)[2][2][4][2], const Unit& u, int wr, int wc, int fr, int fq, pg8::pend4 (&pd)[PG8_NDEF], char*& pp) const { run<true>(acc, u, wr, wc, fr, fq, pd, pp); }
    template <bool DEF>
    __device__ __forceinline__ void run(const f32x4 (&acc)[2][2][4][2], const Unit& u, int wr, int wc, int fr, int fq, pg8::pend4 (&pd)[PG8_NDEF], char*& pp) const {
        typedef float f32x2 __attribute__((ext_vector_type(2)));
        const int row0 = u.pm * BM + wr * 64 + fr, col0 = u.pn * 128 + wc * 32 + 8 * fq;
        if (DEF) pp = (char*)(H + (size_t)row0 * FF + col0);
        float v8[2][4];
#pragma unroll
        for (int ai = 0; ai < 2; ++ai)
#pragma unroll
            for (int m = 0; m < 4; ++m) v8[ai][m] = tab[u.idx * 256 + ai * HALF + wr * 64 + m * 16 + fr];
#pragma unroll
        for (int ai = 0; ai < 2; ++ai)
#pragma unroll
            for (int m = 0; m < 4; ++m) {
                const int row = row0 + ai * HALF + m * 16; const float v = v8[ai][m]; const float sp = -LOG2E * __builtin_amdgcn_rsqf(v);
                f32x4 h[2];
#pragma unroll
                for (int n = 0; n < 2; ++n)
#pragma unroll
                    for (int pr = 0; pr < 2; ++pr) { const f32x2 g2 = {acc[ai][0][m][n][2 * pr], acc[ai][0][m][n][2 * pr + 1]}, u2 = {acc[ai][1][m][n][2 * pr], acc[ai][1][m][n][2 * pr + 1]};
                        const f32x2 t2 = g2 * sp; f32x2 e2; e2.x = __builtin_amdgcn_exp2f(t2.x); e2.y = __builtin_amdgcn_exp2f(t2.y);
                        const f32x2 d2 = e2 * v + v; f32x2 r2; r2.x = __builtin_amdgcn_rcpf(d2.x); r2.y = __builtin_amdgcn_rcpf(d2.y);
                        const f32x2 h2 = (g2 * u2) * r2; h[n][2 * pr] = h2.x; h[n][2 * pr + 1] = h2.y; }
                if (DEF && ai * 4 + m >= 8 - PG8_NDEF) { const u32x4 w_ = pk8(h[0], h[1]); pd[ai * 4 + m - (8 - PG8_NDEF)] = (pg8::pend4){w_.x, w_.y, w_.z, w_.w}; } else
                if (PVAR == 1) { const u32x4 w_ = pk8(h[0], h[1]); asm volatile("" :: "v"(w_)); } else {
#ifdef EPI_NT_HID
                    __builtin_nontemporal_store(pk8(h[0], h[1]), (u32x4*)(H + (size_t)row * FF + col0));
#else
                    st16(H + (size_t)row * FF + col0, pk8(h[0], h[1]));
#endif
                }
            }
    }
};
typedef EpiSwiGLUT<0> EpiSwiGLU;
struct EpiNull {
    static constexpr bool PERM = true, AFTER_DRAIN = false;
    __device__ __forceinline__ void operator()(const f32x4 (&acc)[2][2][4][2], const Unit& u, int wr, int wc, int fr, int fq) const {
#pragma unroll
        for (int ai = 0; ai < 2; ++ai)
#pragma unroll
            for (int bj = 0; bj < 2; ++bj)
#pragma unroll
                for (int m = 0; m < 4; ++m)
#pragma unroll
                    for (int n = 0; n < 2; ++n) asm volatile("" :: "v"(acc[ai][bj][m][n]));
    }
};
struct EpiBf16Y {
    static constexpr bool PERM = true, AFTER_DRAIN = false;
    bf16_t* Y;
    __device__ __forceinline__ void operator()(const f32x4 (&acc)[2][2][4][2], const Unit& u, int wr, int wc, int fr, int fq) const {
        const int row0 = u.pm * BM + wr * 64 + fr, col0 = u.pn * BM + wc * 32 + 8 * fq;
#pragma unroll
        for (int ai = 0; ai < 2; ++ai)
#pragma unroll
            for (int m = 0; m < 4; ++m) { bf16_t* rowp = Y + (size_t)(row0 + ai * HALF + m * 16) * DM + col0;
#pragma unroll
                for (int bj = 0; bj < 2; ++bj) *(u32x4*)(rowp + bj * HALF) = pk8(acc[ai][bj][m][0], acc[ai][bj][m][1]); }
    }
};
#ifndef EPI_NT_OUT
#define EPI_NT_OUT 1
#endif
#ifndef EPI_GPRE
#define EPI_GPRE 1
#endif
#ifndef EPI_XPRE
#define EPI_XPRE 3
#endif
template <bool LAST, int PVAR = 0>
struct EpiRmsRes {
    static constexpr bool PERM = true, AFTER_DRAIN = false;
    bf16_t* X; float* outf; const float* ga; float alpha; unsigned long long* gran; unsigned epoch; float* ssq2; unsigned* tmo; PG8_LAS unsigned char* xl;
    __device__ __forceinline__ void operator()(const f32x4 (&acc)[2][2][4][2], const Unit& u, int wr, int wc, int fr, int fq) const {
        int tid_ = threadIdx.x; asm volatile("" : "+v"(tid_)); const int wid = __builtin_amdgcn_readfirstlane(tid_ >> 6), lane = tid_ & 63;
        PG8_LAS float* P = (PG8_LAS float*)xl;
        PG8_LAS float* S = (PG8_LAS float*)(xl + 4096);
        const int col0 = u.pn * BM + wc * 32 + 8 * fq;
        u32x4 xw8[4][2];
#pragma unroll
        for (int m = 0; m < 4; ++m)
#pragma unroll
            for (int bj = 0; bj < 2; ++bj) xw8[m][bj] = *(const u32x4*)(X + (size_t)(u.pm * BM + wr * 64 + m * 16 + fr) * DM + col0 + bj * HALF);
#if EPI_XPRE == 1 || EPI_XPRE == 2
        u32x4 xw9[4][2];
#endif
#if EPI_XPRE == 1
        f32x4 g[2][2];
#pragma unroll
        for (int bj = 0; bj < 2; ++bj)
#pragma unroll
            for (int n = 0; n < 2; ++n) g[bj][n] = *(const f32x4*)(ga + col0 + bj * HALF + 4 * n);
#endif
#pragma unroll
        for (int ai = 0; ai < 2; ++ai)
#pragma unroll
            for (int m = 0; m < 4; ++m) { float s = 0.f;
#pragma unroll
                for (int bj = 0; bj < 2; ++bj)
#pragma unroll
                    for (int n = 0; n < 2; ++n) { const f32x4 v = acc[ai][bj][m][n]; s += (v[0] * v[0] + v[1] * v[1]) + (v[2] * v[2] + v[3] * v[3]); }
                s = epi_sum4fq(s);
                if (fq == 0) P[(ai * HALF + wr * 64 + m * 16 + fr) * 4 + wc] = s; }
#if EPI_XPRE == 1 || EPI_XPRE == 2
#pragma unroll
        for (int m = 0; m < 4; ++m)
#pragma unroll
            for (int bj = 0; bj < 2; ++bj) xw9[m][bj] = *(const u32x4*)(X + (size_t)(u.pm * BM + HALF + wr * 64 + m * 16 + fr) * DM + col0 + bj * HALF);
#endif
        asm volatile("s_waitcnt lgkmcnt(0)" ::: "memory"); __builtin_amdgcn_s_barrier(); asm volatile("" ::: "memory");
#if EPI_GPRE
        f32x4 g[2][2];
#pragma unroll
        for (int bj = 0; bj < 2; ++bj)
#pragma unroll
            for (int n = 0; n < 2; ++n) g[bj][n] = *(const f32x4*)(ga + col0 + bj * HALF + 4 * n);
#endif
        const int row = wid * 32 + (lane & 31);
        if (lane < 32) {
            const f32x4 p = *(const PG8_LAS f32x4*)(P + row * 4); const float mine = (p[0] + p[1]) + (p[2] + p[3]);
            unsigned long long* gr = gran + ((size_t)(u.pm * BM + row)) * 4;
            __hip_atomic_store(gr + u.pn, ((unsigned long long)epoch << 32) | (unsigned long long)__float_as_uint(mine), __ATOMIC_RELAXED, __HIP_MEMORY_SCOPE_AGENT);
            float t = 0.f; bool ok = false;
            for (unsigned spins = 0; spins < ((PVAR & 1) ? 0u : (1u << 18)); ++spins) {
                unsigned long long w[4]; bool all4 = true; t = 0.f;
#pragma unroll
                for (int k = 0; k < 4; ++k) { w[k] = __hip_atomic_load(gr + k, __ATOMIC_RELAXED, __HIP_MEMORY_SCOPE_AGENT); all4 = all4 && ((unsigned)(w[k] >> 32) == epoch); t += __uint_as_float((unsigned)w[k]); }
                if (__all(all4)) { ok = true; break; }
                __builtin_amdgcn_s_sleep(1);
            }
            if (PVAR & 1) { ok = true; t = 4.f * mine; }
            if (!ok && lane == 0) __hip_atomic_store(tmo, 1u, __ATOMIC_RELAXED, __HIP_MEMORY_SCOPE_AGENT);
            S[row] = alpha * __builtin_amdgcn_rsqf(t * (1.f / DM) + RMS_EPS);
        }
        asm volatile("s_waitcnt lgkmcnt(0)" ::: "memory"); __builtin_amdgcn_s_barrier(); asm volatile("" ::: "memory");
        if (PVAR & 2) return;
#if EPI_XPRE != 1 && !EPI_GPRE
        f32x4 g[2][2];
#pragma unroll
        for (int bj = 0; bj < 2; ++bj)
#pragma unroll
            for (int n = 0; n < 2; ++n) g[bj][n] = *(const f32x4*)(ga + col0 + bj * HALF + 4 * n);
#endif
#pragma unroll
        for (int ai = 0; ai < 2; ++ai) {
            if (ai == 1) {
#pragma unroll
                for (int m = 0; m < 4; ++m)
#pragma unroll
                    for (int bj = 0; bj < 2; ++bj) {
#if EPI_XPRE == 1 || EPI_XPRE == 2
                        xw8[m][bj] = xw9[m][bj];
#elif EPI_XPRE == 3
#else
                        xw8[m][bj] = *(const u32x4*)(X + (size_t)(u.pm * BM + HALF + wr * 64 + m * 16 + fr) * DM + col0 + bj * HALF);
#endif
                    }
            }
#pragma unroll
            for (int m = 0; m < 4; ++m) { const int rl = ai * HALF + wr * 64 + m * 16 + fr; const size_t off = (size_t)(u.pm * BM + rl) * DM + col0; const float sr = S[rl]; float q = 0.f;
#pragma unroll
                for (int bj = 0; bj < 2; ++bj) { const u32x4 xw = xw8[m][bj]; f32x4 xn[2];
#pragma unroll
                    for (int n = 0; n < 2; ++n) { const f32x4 xo = {__uint_as_float(xw[2 * n] << 16), __uint_as_float(xw[2 * n] & 0xffff0000u), __uint_as_float(xw[2 * n + 1] << 16), __uint_as_float(xw[2 * n + 1] & 0xffff0000u)};
                        xn[n] = xo + acc[ai][bj][m][n] * sr * g[bj][n]; q += (xn[n][0] * xn[n][0] + xn[n][1] * xn[n][1]) + (xn[n][2] * xn[n][2] + xn[n][3] * xn[n][3]); }
#if EPI_XPRE == 3
                    if (ai == 0) xw8[m][bj] = *(const u32x4*)(X + (size_t)(u.pm * BM + HALF + wr * 64 + m * 16 + fr) * DM + col0 + bj * HALF);
#endif
                    if (LAST) {
#if EPI_NT_OUT
                        __builtin_nontemporal_store(xn[0], (f32x4*)(outf + off + bj * HALF)); __builtin_nontemporal_store(xn[1], (f32x4*)(outf + off + bj * HALF + 4));
#else
                        *(f32x4*)(outf + off + bj * HALF) = xn[0]; *(f32x4*)(outf + off + bj * HALF + 4) = xn[1];
#endif
                    }
                    else st16(X + off + bj * HALF, pk8(xn[0], xn[1])); }
                if (!LAST) { q = epi_sum4fq(q); if (fq == 0) P[rl * 4 + wc] = q; } } }
        if (!LAST) {
            asm volatile("s_waitcnt lgkmcnt(0)" ::: "memory"); __builtin_amdgcn_s_barrier(); asm volatile("" ::: "memory");
            if (lane < 32) { const f32x4 p = *(const PG8_LAS f32x4*)(P + row * 4); ssq2[((size_t)(u.pm * BM + row)) * 4 + u.pn] = (p[0] + p[1]) + (p[2] + p[3]); }
        }
    }
};
struct OrdOrder {
    StaticOrder base;
    __device__ __forceinline__ bool next(int i, Unit& u) const { const bool ok = base.next(i, u); u.idx = i; return ok; }
    __device__ __forceinline__ void a_ready(const Unit&) const {}
    __device__ __forceinline__ void done(const Unit&) const {}
};
__device__ __forceinline__ void rowstat_table(const OrdOrder& S, const float* ssq, PG8_LAS float* tab, int nunits) {
    int tid = threadIdx.x; asm volatile("" : "+v"(tid));
    for (int e = tid; e < nunits * 256; e += 512) { Unit u; S.next(e >> 8, u); const f32x4 p = *(const f32x4*)(ssq + (size_t)(u.pm * BM + (e & 255)) * 4); tab[e] = ((p[0] + p[1]) + (p[2] + p[3])) * (1.f / DM) + RMS_EPS; }
    __syncthreads();
}
struct HotOrder {
    int n, c;
    __device__ __forceinline__ bool next(int i, Unit& u) const { if (i >= n) return false; u.pm = c & 7; u.pn = (c >> 3) & 3; return true; }
    __device__ __forceinline__ void a_ready(const Unit&) const {}
    __device__ __forceinline__ void done(const Unit&) const {}
};
struct OneRound {
    StaticOrder base; int round;
    __device__ __forceinline__ bool next(int i, Unit& u) const { return i == 0 && base.next(round, u); }
    __device__ __forceinline__ void a_ready(const Unit&) const {}
    __device__ __forceinline__ void done(const Unit&) const {}
};
struct EpiF32 {
    static constexpr bool PERM = false, AFTER_DRAIN = false;
    float* Y; int ldc;
    __device__ __forceinline__ void operator()(const f32x4 (&acc)[2][2][4][2], const Unit& u, int wr, int wc, int fr, int fq) const {
        const int row0 = u.pm * BM + wr * 64 + fr, col0 = u.pn * BM + wc * 32 + 4 * fq;
#pragma unroll
        for (int ai = 0; ai < 2; ++ai)
#pragma unroll
            for (int m = 0; m < 4; ++m) { float* rowp = Y + (size_t)(row0 + ai * HALF + m * 16) * ldc + col0;
#pragma unroll
                for (int bj = 0; bj < 2; ++bj)
#pragma unroll
                    for (int n = 0; n < 2; ++n) *(f32x4*)(rowp + bj * HALF + n * 16) = acc[ai][bj][m][n]; }
    }
};
struct EpiProjOdd {
    static constexpr bool PERM = true, AFTER_DRAIN = false;
    bf16_t* Q; const PG8_LAS float* tab;
    __device__ __forceinline__ void operator()(const f32x4 (&acc)[2][2][4][2], const Unit& u, int wr, int wc, int fr, int fq) const {
        const int t = u.pn >> 2; bf16_t* base = Q + (size_t)t * ((size_t)MROWS * DM); const float sc = t == 0 ? QSCALE : 1.f;
        const int row0 = u.pm * BM + wr * 64 + fr, col0 = (u.pn & 3) * BM + wc * 32 + 8 * fq;
        float sc8[2][4];
#pragma unroll
        for (int ai = 0; ai < 2; ++ai)
#pragma unroll
            for (int m = 0; m < 4; ++m) sc8[ai][m] = __builtin_amdgcn_rsqf(tab[u.idx * 256 + ai * HALF + wr * 64 + m * 16 + fr]);
#pragma unroll
        for (int ai = 0; ai < 2; ++ai)
#pragma unroll
            for (int m = 0; m < 4; ++m) { const int row = row0 + ai * HALF + m * 16; const float s = sc8[ai][m] * sc;
#pragma unroll
                for (int bj = 0; bj < 2; ++bj) st16(base + (size_t)row * DM + col0 + bj * HALF, pk8(acc[ai][bj][m][0] * s, acc[ai][bj][m][1] * s)); }
    }
};
struct EpiProjEven {
    static constexpr bool PERM = true, AFTER_DRAIN = false;
    bf16_t *R1, *IQ, *IK; float* IW; const PG8_LAS float* tab;
    const unsigned* c64; const float *c32, *s32;
    __device__ __forceinline__ void operator()(const f32x4 (&acc)[2][2][4][2], const Unit& u, int wr, int wc, int fr, int fq) const {
        const int pn = u.pn, row0 = u.pm * BM + wr * 64 + fr;
        float sc8[2][4];
#pragma unroll
        for (int ai = 0; ai < 2; ++ai)
#pragma unroll
            for (int m = 0; m < 4; ++m) sc8[ai][m] = __builtin_amdgcn_rsqf(tab[u.idx * 256 + ai * HALF + wr * 64 + m * 16 + fr]);
        if (pn == 4 || pn == 5 || pn == 10 || pn == 11) {
            bf16_t* base = R1 + (size_t)(pn >> 1) * ((size_t)MROWS * 512); const int col0 = (pn & 1) * BM + wc * 32 + 8 * fq;
#pragma unroll
            for (int ai = 0; ai < 2; ++ai)
#pragma unroll
                for (int m = 0; m < 4; ++m) { const int row = row0 + ai * HALF + m * 16; const float s = sc8[ai][m];
#pragma unroll
                    for (int bj = 0; bj < 2; ++bj) st16(base + (size_t)row * 512 + col0 + bj * HALF, pk8(acc[ai][bj][m][0] * s, acc[ai][bj][m][1] * s)); }
        } else if (pn < 12) {
            bf16_t* base = R1 + (size_t)(pn >> 1) * ((size_t)MROWS * 512);
            const float sc = (pn < 2 || pn == 6 || pn == 7) ? QSCALE : 1.f;
            const int head = 4 * (pn & 1) + wc, d0 = 8 * fq;
            u32x4 cs[4][2];
#pragma unroll
            for (int m = 0; m < 4; ++m) { const int pos = (row0 + m * 16) & (SEQ - 1);
#pragma unroll
                for (int n = 0; n < 2; ++n) cs[m][n] = *(const u32x4*)(c64 + pos * 32 + d0 + 4 * n); }
#pragma unroll
            for (int ai = 0; ai < 2; ++ai) {
#pragma unroll
                for (int m = 0; m < 4; ++m) { const int row = row0 + ai * HALF + m * 16; const float s = sc8[ai][m] * sc;
                    f32x4 o1[2], o2[2];
#pragma unroll
                    for (int n = 0; n < 2; ++n) { f32x4 cc, ss;
#pragma unroll
                        for (int j = 0; j < 4; ++j) { typedef _Float16 h2_t __attribute__((ext_vector_type(2))); const unsigned w_ = cs[m][n][j];
                            const h2_t h = __builtin_bit_cast(h2_t, w_); cc[j] = (float)h.x * s; ss[j] = (float)h.y * s; }
                        const f32x4 x1 = acc[ai][0][m][n], x2 = acc[ai][1][m][n]; o1[n] = x1 * cc - x2 * ss; o2[n] = x2 * cc + x1 * ss; }
                    if (ai == 0) { const int pos1 = (row0 + HALF + m * 16) & (SEQ - 1);
#pragma unroll
                        for (int n = 0; n < 2; ++n) cs[m][n] = *(const u32x4*)(c64 + pos1 * 32 + d0 + 4 * n); }
                    bf16_t* dst = base + (size_t)row * 512 + head * 64 + d0;
                    st16(dst, pk8(o1[0], o1[1])); st16(dst + 32, pk8(o2[0], o2[1])); } }
        } else if (pn == 12) {
            const int head = 2 * wc + (fq >> 1), d0 = 8 * (fq & 1);
#pragma unroll
            for (int ai = 0; ai < 2; ++ai)
#pragma unroll
                for (int m = 0; m < 4; ++m) { const int row = row0 + ai * HALF + m * 16, pos = row & (SEQ - 1); const float s = sc8[ai][m];
                    f32x4 o1[2], o2[2];
#pragma unroll
                    for (int n = 0; n < 2; ++n) { const f32x4 cc = *(const f32x4*)(c32 + pos * 16 + d0 + 4 * n), ss = *(const f32x4*)(s32 + pos * 16 + d0 + 4 * n);
                        const f32x4 x1 = acc[ai][0][m][n] * s, x2 = acc[ai][1][m][n] * s; o1[n] = x1 * cc - x2 * ss; o2[n] = x2 * cc + x1 * ss; }
                    bf16_t* dst = IQ + (size_t)row * 256 + head * 32 + d0;
                    st16(dst, pk8(o1[0], o1[1])); st16(dst + 16, pk8(o2[0], o2[1])); }
        } else {
            if (wc == 0 && fq < 2) {
                const int d0 = 8 * fq;
#pragma unroll
                for (int ai = 0; ai < 2; ++ai)
#pragma unroll
                    for (int m = 0; m < 4; ++m) { const int row = row0 + ai * HALF + m * 16, pos = row & (SEQ - 1); const float s = sc8[ai][m];
                        f32x4 o1[2], o2[2];
#pragma unroll
                        for (int n = 0; n < 2; ++n) { const f32x4 cc = *(const f32x4*)(c32 + pos * 16 + d0 + 4 * n), ss = *(const f32x4*)(s32 + pos * 16 + d0 + 4 * n);
                            const f32x4 x1 = acc[ai][0][m][n] * s, x2 = acc[ai][1][m][n] * s; o1[n] = x1 * cc - x2 * ss; o2[n] = x2 * cc + x1 * ss; }
                        bf16_t* dst = IK + (size_t)row * 32 + d0;
                        st16(dst, pk8(o1[0], o1[1])); st16(dst + 16, pk8(o2[0], o2[1])); }
            } else if (wc == 0 && fq == 2) {
#pragma unroll
                for (int ai = 0; ai < 2; ++ai)
#pragma unroll
                    for (int m = 0; m < 4; ++m) { const int row = row0 + ai * HALF + m * 16; const float s = sc8[ai][m] * 0.0625f;
                        *(f32x4*)(IW + (size_t)row * 8) = acc[ai][0][m][0] * s; *(f32x4*)(IW + (size_t)row * 8 + 4) = acc[ai][0][m][1] * s; }
            }
        }
    }
};
}

namespace att {
#define ALAS __attribute__((address_space(3)))
typedef unsigned short bf16_t;
typedef short bf16x8 __attribute__((ext_vector_type(8)));
typedef short s16x4 __attribute__((ext_vector_type(4)));
typedef float f32x16 __attribute__((ext_vector_type(16)));
typedef float f32x4 __attribute__((ext_vector_type(4)));
typedef unsigned u32x4 __attribute__((ext_vector_type(4)));
typedef short v4i16_t __attribute__((ext_vector_type(4)));
__device__ __forceinline__ int crow(int r, int hi) { return (r & 3) + 8 * (r >> 2) + 4 * hi; }
__device__ __forceinline__ unsigned cvtpk(float lo, float hi) { typedef float f2_t __attribute__((ext_vector_type(2))); typedef __bf16 b2_t __attribute__((ext_vector_type(2)));
    f2_t v = {lo, hi}; b2_t b = __builtin_convertvector(v, b2_t); return __builtin_bit_cast(unsigned, b); }
__device__ __forceinline__ s16x4 vtr(const ALAS unsigned char* p) { return __builtin_bit_cast(s16x4, __builtin_amdgcn_ds_read_tr16_b64_v4i16((ALAS v4i16_t*)p)); }
__device__ __forceinline__ float halfswap_max(float m) { auto rr = __builtin_amdgcn_permlane32_swap(__float_as_uint(m), __float_as_uint(m), false, false); return fmaxf(__uint_as_float(rr[0]), __uint_as_float(rr[1])); }
__device__ __forceinline__ float halfswap_sum(float m) { auto rr = __builtin_amdgcn_permlane32_swap(__float_as_uint(m), __float_as_uint(m), false, false); return __uint_as_float(rr[0]) + __uint_as_float(rr[1]); }

#ifndef BT_STRIDE
#define BT_STRIDE 656
#endif
template <int DV> struct Lds {
#ifndef ATT_VPRE
#define ATT_VPRE 0
#endif
#ifndef ATT_KPRE2
#define ATT_KPRE2 0
#endif
#ifndef ATT_QLDS128
#define ATT_QLDS128 0
#endif
#ifndef ATT_R64
#define ATT_R64 4
#endif
    static constexpr int R = (DV == 64) ? ATT_R64 : 3, D = R - 1;
    static constexpr int KB = 8192, VB = DV * 128;
    static constexpr int OFF_K = 0, OFF_V = R * KB, OFF_MW = OFF_V + R * VB, OFF_WSF = OFF_MW + 8 * R * 256, OFF_BT = OFF_WSF + 8 * 256, OFF_OST = OFF_BT + 4 * BT_STRIDE * 4, OST_W = 4096, TOTAL = OFF_OST + 8 * OST_W;
};
__device__ __forceinline__ void glds16(const void* gsrc, unsigned lds_dst) { unsigned keep;
    asm volatile("s_mov_b32 %0, m0\n\ts_mov_b32 m0, %2\n\ts_nop 0\n\tglobal_load_lds_dwordx4 %1, off\n\ts_mov_b32 m0, %0" : "=&s"(keep) : "v"(gsrc), "s"(lds_dst) : "memory"); }
__device__ __forceinline__ void glds4(const void* gsrc, unsigned lds_dst) { unsigned keep;
    asm volatile("s_mov_b32 %0, m0\n\ts_mov_b32 m0, %2\n\ts_nop 0\n\tglobal_load_lds_dword %1, off\n\ts_mov_b32 m0, %0" : "=&s"(keep) : "v"(gsrc), "s"(lds_dst) : "memory"); }

template <int DV, int MODE, int THR>
__device__ __forceinline__ void attn_core(f32x16 (&o)[DV / 32], ALAS unsigned char* lds,
                                          const bf16_t* Qw, int ldq, const bf16_t* Kh, int ldk, const bf16_t* Vh, int ldv,
                                          int T0, int T1, int tw0, int tw1,
                                          const unsigned long long* maskrow, int qpos, int qchunk, int att_probe_hotmask = -1, int att_probe_skip = 0,
                                          const bf16_t* nKh = nullptr, const bf16_t* nVh = nullptr, const unsigned long long* nmask = nullptr, int nT0 = 0, int nT1 = 0, int pre_in = 0, int* pre_out = nullptr) {
    typedef Lds<DV> L; constexpr int NDB = DV / 32, NVP = DV / 64, R = L::R, D = L::D, NDMA = 1 + NVP + (MODE == 1 ? 1 : 0);
    int tid = threadIdx.x; asm volatile("" : "+v"(tid));
    const int lane = tid & 63, r32 = lane & 31, hi = lane >> 5; const int wid = __builtin_amdgcn_readfirstlane(tid >> 6);
    ALAS float* wsf = (ALAS float*)(lds + L::OFF_WSF) + wid * 64;
    const ALAS float* btab = (const ALAS float*)(lds + L::OFF_BT);
    constexpr bool QLDS = (DV == 128 && ATT_QLDS128);
    ALAS unsigned char* qst = lds + L::OFF_OST + wid * L::OST_W + lane * 16;
    bf16x8 qr[4];
#pragma unroll
    for (int d0 = 0; d0 < 4; ++d0) { qr[d0] = *(const bf16x8*)(Qw + (size_t)r32 * ldq + d0 * 16 + hi * 8); if (QLDS) *(ALAS bf16x8*)(qst + d0 * 1024) = qr[d0]; }
    const int krow = 8 * wid + (lane >> 3), kkey = krow ^ ((krow >> 3) & 1), kch = (lane & 7) ^ (kkey & 7);
    const bf16_t* ksrc = Kh + (size_t)kkey * ldk + kch * 8;
    const bf16_t* vsrc = Vh + (size_t)(16 * (wid & 3) + (lane >> 2)) * ldv + 32 * (wid >> 2) + 8 * (lane & 3);
    const unsigned* msrc = (const unsigned*)maskrow + hi;
    const unsigned lds0 = (unsigned)(__SIZE_TYPE__)lds;
    const unsigned kdst = lds0 + L::OFF_K + wid * 1024, vdst = lds0 + L::OFF_V + (wid >> 2) * 4096 + (wid & 3) * 1024, mdstb = lds0 + L::OFF_MW + wid * (R * 256);
    ALAS unsigned char* mdst = lds + L::OFF_MW + wid * (R * 256);
#define ATT_U(x) ((unsigned)__builtin_amdgcn_readfirstlane((int)(x)))
#define ATT_TT(t) (T0 + (((t) - T0) & att_probe_hotmask))
#define ATT_DMA_K(t, sl) glds16(ksrc + (size_t)ATT_TT(t) * 64 * ldk, ATT_U(kdst + (sl) * L::KB))
#define ATT_DMA_V(t, sl) do { glds16(vsrc + (size_t)ATT_TT(t) * 64 * ldv, ATT_U(vdst + (sl) * L::VB)); if (NVP == 2) glds16(vsrc + (size_t)ATT_TT(t) * 64 * ldv + 64, ATT_U(vdst + (sl) * L::VB + 8192)); \
                              if (MODE == 1) glds4(msrc + 2 * (t), ATT_U(mdstb + (sl) * 256)); } while (0)
    int kfo[4];
#pragma unroll
    for (int d0 = 0; d0 < 4; ++d0) kfo[d0] = (r32 ^ ((r32 >> 3) & 1)) * 128 + (((2 * d0 + hi) ^ (r32 & 7)) * 16);
#define ATT_QK(P0, P1, t, ks) do { \
        if (MODE == 2) { const int jrel_ = qchunk - (t); \
            if (jrel_ >= 5) { const float bc_ = btab[638]; _Pragma("unroll") for (int r = 0; r < 16; ++r) { P0[r] = bc_; P1[r] = bc_; } } \
            else { const int bq_ = qpos - 64 * (t) + 60 - 4 * hi, sh_ = bq_ & 3;     \
                const ALAS float* bp_ = btab + sh_ * 640 + (bq_ - sh_ - 56); \
                _Pragma("unroll") for (int g = 0; g < 4; ++g) { const f32x4 v0_ = *(const ALAS f32x4*)(bp_ + 56 - 8 * g), v1_ = *(const ALAS f32x4*)(bp_ + 24 - 8 * g); \
                    _Pragma("unroll") for (int j = 0; j < 4; ++j) { P0[4 * g + j] = v0_[3 - j]; P1[4 * g + j] = v1_[3 - j]; } } } \
        } else { P0 = f32x16{}; P1 = f32x16{}; } \
        const ALAS unsigned char* kb_ = lds + L::OFF_K + (ks) * L::KB; \
        _Pragma("unroll") for (int d0 = 0; d0 < 4; ++d0) { const bf16x8 b0_ = *(const ALAS bf16x8*)(kb_ + kfo[d0]), b1_ = *(const ALAS bf16x8*)(kb_ + kfo[d0] + 4096); \
            const bf16x8 q_ = QLDS ? *(const ALAS bf16x8*)(qst + d0 * 1024) : qr[d0]; \
            P0 = __builtin_amdgcn_mfma_f32_32x32x16_bf16(b0_, q_, P0, 0, 0, 0); P1 = __builtin_amdgcn_mfma_f32_32x32x16_bf16(b1_, q_, P1, 0, 0, 0); } } while (0)
#define ATT_QK_INIT(P0, P1, t) do { \
        if (MODE == 2) { const int jrel_ = qchunk - (t); \
            if (jrel_ >= 5) { const float bc_ = btab[638]; _Pragma("unroll") for (int r = 0; r < 16; ++r) { P0[r] = bc_; P1[r] = bc_; } } \
            else { const int bq_ = qpos - 64 * (t) + 60 - 4 * hi, sh_ = bq_ & 3;     \
                const ALAS float* bp_ = btab + sh_ * 640 + (bq_ - sh_ - 56); \
                _Pragma("unroll") for (int g = 0; g < 4; ++g) { const f32x4 v0_ = *(const ALAS f32x4*)(bp_ + 56 - 8 * g), v1_ = *(const ALAS f32x4*)(bp_ + 24 - 8 * g); \
                    _Pragma("unroll") for (int j = 0; j < 4; ++j) { P0[4 * g + j] = v0_[3 - j]; P1[4 * g + j] = v1_[3 - j]; } } } \
        } else { P0 = f32x16{}; P1 = f32x16{}; } } while (0)
#define ATT_QK_HALF(P0, P1, kb_, dlo) do { \
        _Pragma("unroll") for (int d0 = (dlo); d0 < (dlo) + 2; ++d0) { const bf16x8 b0_ = *(const ALAS bf16x8*)((kb_) + kfo[d0]), b1_ = *(const ALAS bf16x8*)((kb_) + kfo[d0] + 4096); \
            const bf16x8 q_ = QLDS ? *(const ALAS bf16x8*)(qst + d0 * 1024) : qr[d0]; \
            P0 = __builtin_amdgcn_mfma_f32_32x32x16_bf16(b0_, q_, P0, 0, 0, 0); P1 = __builtin_amdgcn_mfma_f32_32x32x16_bf16(b1_, q_, P1, 0, 0, 0); } } while (0)
    constexpr int NV = NDMA - 1;
#define ATT_CK(j) (((j) <= T0 + D) ? ((j) - T0) * NDMA + 1 : ((j) - 1 - T0) * NDMA + 2)
#define ATT_CV(j) (((j) < T0 + D) ? ((j) - T0 + 1) * NDMA : ((j) - T0) * NDMA + 2 + NV)
#define ATT_WAIT_BAR_N(n_) do { const int nn_ = (n_); \
        if (nn_ <= 0) asm volatile("s_waitcnt vmcnt(0) lgkmcnt(0)\n\ts_barrier" ::: "memory"); \
        else if (nn_ == 1) asm volatile("s_waitcnt vmcnt(1) lgkmcnt(0)\n\ts_barrier" ::: "memory"); \
        else if (nn_ == 2) asm volatile("s_waitcnt vmcnt(2) lgkmcnt(0)\n\ts_barrier" ::: "memory"); \
        else if (nn_ == 3) asm volatile("s_waitcnt vmcnt(3) lgkmcnt(0)\n\ts_barrier" ::: "memory"); \
        else if (nn_ == 4) asm volatile("s_waitcnt vmcnt(4) lgkmcnt(0)\n\ts_barrier" ::: "memory"); \
        else if (nn_ == 5) asm volatile("s_waitcnt vmcnt(5) lgkmcnt(0)\n\ts_barrier" ::: "memory"); \
        else if (nn_ == 6) asm volatile("s_waitcnt vmcnt(6) lgkmcnt(0)\n\ts_barrier" ::: "memory"); \
        else if (nn_ == 7) asm volatile("s_waitcnt vmcnt(7) lgkmcnt(0)\n\ts_barrier" ::: "memory"); \
        else if (nn_ == 8) asm volatile("s_waitcnt vmcnt(8) lgkmcnt(0)\n\ts_barrier" ::: "memory"); \
        else if (nn_ == 9) asm volatile("s_waitcnt vmcnt(9) lgkmcnt(0)\n\ts_barrier" ::: "memory"); \
        else if (nn_ == 10) asm volatile("s_waitcnt vmcnt(10) lgkmcnt(0)\n\ts_barrier" ::: "memory"); \
        else if (nn_ == 11) asm volatile("s_waitcnt vmcnt(11) lgkmcnt(0)\n\ts_barrier" ::: "memory"); \
        else asm volatile("s_waitcnt vmcnt(12) lgkmcnt(0)\n\ts_barrier" ::: "memory"); } while (0)
#define ATT_END_STEP(t) do { int need_ = 0; if ((t) + 2 < T1) need_ = ATT_CK((t) + 2); if ((t) + 1 < T1) { const int cv_ = ATT_CV((t) + 1); need_ = cv_ > need_ ? cv_ : need_; } \
        ATT_WAIT_BAR_N(need_ ? n_issued - need_ : 0); } while (0)
    int n_issued = 0;
#ifdef ATT_PRIO
    if (wid >= 4) __builtin_amdgcn_s_setprio(1);
#endif
    float m_run = -1e30f, l_part = 0.f;
#pragma unroll
    for (int d0 = 0; d0 < NDB; ++d0) o[d0] = f32x16{};
    if (pre_in > 0) n_issued = pre_in;
    else {
#pragma unroll
        for (int i = 0; i <= D; ++i) { if (T0 + i < T1) { ATT_DMA_K(T0 + i, i); n_issued += 1; } if (i < D && T0 + i < T1) { ATT_DMA_V(T0 + i, i); n_issued += NV; } }
    }
    ATT_WAIT_BAR_N(n_issued - 1);
    f32x16 pc0, pc1, pn0, pn1;
    pc0 = f32x16{}; pc1 = f32x16{}; pn0 = f32x16{}; pn1 = f32x16{};
    if (tw0 == T0) { ATT_QK(pc0, pc1, T0, 0); }
    ATT_END_STEP(T0 - 1);
    int sk = 1 % R, sv = 0, si_k = 0, si_v = D % R;
    for (int t = T0; t < T1; ++t) {
        const bool steady = (t + 1 + D < T1);
        if (steady) { ATT_DMA_K(t + 1 + D, si_k); n_issued += 1; }
        if (t + D < T1) { ATT_DMA_V(t + D, si_v); n_issued += NV; }
        const bool act = (t >= tw0 && t < tw1), nxt = (t + 1 >= tw0 && t + 1 < tw1);
        if (nxt && !act) { ATT_QK(pn0, pn1, t + 1, sk); }
        if (act) {
            const ALAS unsigned char* kbn_ = lds + L::OFF_K + sk * L::KB;
            constexpr bool KPRE2 = (DV == 64) && (ATT_KPRE2 != 0);
            bf16x8 kq0[KPRE2 ? 4 : 1], kq1[KPRE2 ? 4 : 1];
            if (KPRE2) { if (nxt) {
#pragma unroll
                for (int d0 = 0; d0 < 4; ++d0) { kq0[d0] = *(const ALAS bf16x8*)(kbn_ + kfo[d0]); kq1[d0] = *(const ALAS bf16x8*)(kbn_ + kfo[d0] + 4096); }
                ATT_QK_INIT(pn0, pn1, t + 1); }
                __builtin_amdgcn_sched_barrier(0);
            } else { if (nxt) { ATT_QK_INIT(pn0, pn1, t + 1); ATT_QK_HALF(pn0, pn1, kbn_, 0); } }
            if (MODE == 1) { const ALAS unsigned* mp = (const ALAS unsigned*)(mdst + sv * 256); const unsigned w0 = mp[r32] >> (4 * hi), w1 = mp[32 + r32] >> (4 * hi);
#pragma unroll
                for (int r = 0; r < 16; ++r) { const int sh = 31 - ((r & 3) + 8 * (r >> 2));
                    const unsigned m0 = (unsigned)(((int)(w0 << sh)) >> 31), m1 = (unsigned)(((int)(w1 << sh)) >> 31);
                    pc0[r] = __uint_as_float((__float_as_uint(pc0[r]) & m0) | (0xff800000u & ~m0)); pc1[r] = __uint_as_float((__float_as_uint(pc1[r]) & m1) | (0xff800000u & ~m1)); } }
            float mx = fmaxf(fmaxf(pc0[0], pc1[0]), pc0[1]);
#pragma unroll
            for (int r = 1; r < 16; ++r) mx = (r == 1) ? fmaxf(mx, pc1[1]) : fmaxf(fmaxf(mx, pc0[r]), pc1[r]);
            mx = halfswap_max(mx);
            if (__any(mx > m_run + (float)THR)) {
                const float mnew = fmaxf(m_run, mx); const float f = __builtin_amdgcn_exp2f(m_run - mnew);
                l_part *= f; m_run = mnew; if (hi == 0) wsf[r32] = f;
#pragma unroll
                for (int r = 0; r < 16; ++r) { const float fr_ = wsf[crow(r, hi)];
#pragma unroll
                    for (int d0 = 0; d0 < NDB; ++d0) o[d0][r] *= fr_; }
            }
            if (KPRE2) { if (nxt) {
#pragma unroll
                for (int d0 = 0; d0 < 4; ++d0) { pn0 = __builtin_amdgcn_mfma_f32_32x32x16_bf16(kq0[KPRE2 ? d0 : 0], qr[d0], pn0, 0, 0, 0); pn1 = __builtin_amdgcn_mfma_f32_32x32x16_bf16(kq1[KPRE2 ? d0 : 0], qr[d0], pn1, 0, 0, 0); } }
            } else { if (nxt) { ATT_QK_HALF(pn0, pn1, kbn_, 2); } }
            const ALAS unsigned char* vb = lds + L::OFF_V + sv * L::VB + ((lane >> 4) & 1) * 32 + (lane & 3) * 8 + (4 * hi + ((lane & 15) >> 2)) * 64;
            constexpr bool VPRE = (DV == 64) && (ATT_VPRE != 0);
            s16x4 vlo[VPRE ? 8 : 1], vup[VPRE ? 8 : 1];
            if (VPRE) {
#pragma unroll
                for (int i = 0; i < 8; ++i) { vlo[i] = vtr(vb + (i >> 2) * 4096 + (i & 3) * 1024); vup[i] = vtr(vb + (i >> 2) * 4096 + (i & 3) * 1024 + 512); }
                __builtin_amdgcn_sched_barrier(0);
            }
            float sa = 0.f, sb = 0.f;
#pragma unroll
            for (int r = 0; r < 16; ++r) { pc0[r] = __builtin_amdgcn_exp2f(pc0[r] - m_run); pc1[r] = __builtin_amdgcn_exp2f(pc1[r] - m_run); sa += pc0[r]; sb += pc1[r]; }
            l_part += sa + sb;
            u32x4 pw[4];
#pragma unroll
            for (int k = 0; k < 2; ++k)
#pragma unroll
                for (int j = 0; j < 4; ++j) { pw[k][j] = cvtpk(pc0[8 * k + 2 * j], pc0[8 * k + 2 * j + 1]); pw[2 + k][j] = cvtpk(pc1[8 * k + 2 * j], pc1[8 * k + 2 * j + 1]); }
#pragma unroll
            for (int d0 = 0; d0 < NDB; ++d0)
#pragma unroll
                for (int ks = 0; ks < 4; ++ks) { const s16x4 lo = VPRE ? vlo[VPRE ? d0 * 4 + ks : 0] : vtr(vb + d0 * 4096 + ks * 1024), up = VPRE ? vup[VPRE ? d0 * 4 + ks : 0] : vtr(vb + d0 * 4096 + ks * 1024 + 512);
                    const bf16x8 vf = (bf16x8){lo[0], lo[1], lo[2], lo[3], up[0], up[1], up[2], up[3]};
                    o[d0] = __builtin_amdgcn_mfma_f32_32x32x16_bf16(__builtin_bit_cast(bf16x8, pw[ks]), vf, o[d0], 0, 0, 0); }
        }
        pc0 = pn0; pc1 = pn1;
        sk = (sk + 1 == R) ? 0 : sk + 1; sv = (sv + 1 == R) ? 0 : sv + 1; si_k = (si_k + 1 == R) ? 0 : si_k + 1; si_v = (si_v + 1 == R) ? 0 : si_v + 1;
        ATT_END_STEP(t);
    }
    if (pre_out) {
        int cnt_ = 0;
        if (nT1 > nT0) {
            const bf16_t* ksrc0_ = ksrc; const bf16_t* vsrc0_ = vsrc; const unsigned* msrc0_ = msrc;
            ksrc = ksrc0_ + (nKh - Kh); vsrc = vsrc0_ + (nVh - Vh); msrc = (const unsigned*)nmask + hi;
            { const int T0 = nT0, T1 = nT1;
#pragma unroll
              for (int i = 0; i <= D; ++i) { if (T0 + i < T1) { ATT_DMA_K(T0 + i, i); cnt_ += 1; } if (i < D && T0 + i < T1) { ATT_DMA_V(T0 + i, i); cnt_ += NV; } } }
            ksrc = ksrc0_; vsrc = vsrc0_; msrc = msrc0_;
        }
        *pre_out = cnt_;
    }
#undef ATT_U
#undef ATT_TT
#undef ATT_DMA_K
#undef ATT_DMA_V
#undef ATT_QK
#undef ATT_QK_INIT
#undef ATT_QK_HALF
#undef ATT_CK
#undef ATT_CV
#undef ATT_WAIT_BAR_N
#undef ATT_END_STEP
#ifdef ATT_PRIO
    __builtin_amdgcn_s_setprio(0);
#endif
    const float l = halfswap_sum(l_part);
    if (hi == 0) wsf[32 + r32] = l;
#pragma unroll
    for (int r = 0; r < 16; ++r) { const float rl = 1.0f / wsf[32 + crow(r, hi)];
#pragma unroll
        for (int d0 = 0; d0 < NDB; ++d0) o[d0][r] *= rl; }
}

template <int MODE, int THR>
__device__ __forceinline__ void attn64p(f32x16 (&o)[2], ALAS unsigned char* lds, const bf16_t* Qw, int ld, const bf16_t* Kh, const bf16_t* Vh, int NT, const unsigned long long* maskrow, int tvis  ) {
    typedef Lds<64> L; constexpr int SLOTB = 8192; constexpr int NM = (MODE == 1) ? 1 : 0;
    int tid = threadIdx.x; asm volatile("" : "+v"(tid));
    const int lane = tid & 63, r32 = lane & 31, hi = lane >> 5; const int wid = __builtin_amdgcn_readfirstlane(tid >> 6);
    ALAS float* wsf = (ALAS float*)(lds + L::OFF_WSF) + wid * 64;
    const unsigned lds0 = (unsigned)(__SIZE_TYPE__)lds;
    const bf16_t* ksrc = Kh + (size_t)lane * ld + wid * 8;
    const bf16_t* vsrc = Vh + (size_t)(16 * (wid & 3) + (lane >> 2)) * ld + (wid >> 2) * 32 + (lane & 3) * 8;
    const unsigned* msrc = (const unsigned*)maskrow + hi;
    const unsigned kdst = lds0 + L::OFF_K + wid * 1024, vdst = lds0 + L::OFF_V + wid * 1024, mdstb = lds0 + L::OFF_MW + wid * (L::R * 256);
    const ALAS unsigned* mrd = (const ALAS unsigned*)(lds + L::OFF_MW + wid * (L::R * 256));
#define P64_U(x) ((unsigned)__builtin_amdgcn_readfirstlane((int)(x)))
#define P64_DMA_K(t, slot) glds16(ksrc + (size_t)(t) * 64 * ld, P64_U(kdst + (slot)))
#define P64_DMA_V(t, slot) glds16(vsrc + (size_t)(t) * 64 * ld, P64_U(vdst + (slot)))
#define P64_DMA_M(t, slot) do { if (MODE == 1) glds4(msrc + 2 * (t), P64_U(mdstb + ((slot) >> 5))); } while (0)
#define P64_SBAR() __builtin_amdgcn_sched_barrier(0)
#define P64_PIN(x) asm volatile("" : "+v"(x))
#define P64_MFMA(a, b, c) __builtin_amdgcn_mfma_f32_32x32x16_bf16(a, b, c, 0, 0, 0)
#define P64_WAIT_BAR(N) asm volatile("s_waitcnt vmcnt(" #N ") lgkmcnt(0)\n\ts_barrier" ::: "memory")
    const ALAS unsigned char* vp0 = lds + L::OFF_V + ((lane >> 4) & 1) * 32 + (lane & 3) * 8 + (4 * hi + ((lane & 15) >> 2)) * 64;
    const ALAS unsigned char* kp0 = lds + L::OFF_K + hi * 1024 + r32 * 16;
    bf16x8 qr[4];
#pragma unroll
    for (int d0 = 0; d0 < 4; ++d0) qr[d0] = *(const bf16x8*)(Qw + (size_t)r32 * ld + d0 * 16 + hi * 8);
    P64_DMA_K(0, 0); P64_DMA_M(0, 0); P64_DMA_V(0, 0); P64_DMA_K(1, SLOTB); P64_DMA_K(2, 2 * SLOTB); P64_DMA_M(1, SLOTB);
    float mhat = 0.f, l_reg = 0.f; o[0] = f32x16{}; o[1] = f32x16{};
    f32x16 zero16 = f32x16{}; P64_PIN(zero16);
    bool resc = false;
    f32x16 pA0, pA1, pB0, pB1; bf16x8 kf[8]; s16x4 vlo[8], vhi[8]; u32x4 pw0, pw1, pw2, pw3;
    int sl_prev = 0, sl_cur = 0, sl_next = SLOTB;
#define P64_KLOAD2(kp, d0) do { kf[2 * (d0)] = *(const ALAS bf16x8*)((kp) + (d0) * 2048); kf[2 * (d0) + 1] = *(const ALAS bf16x8*)((kp) + (d0) * 2048 + 512); } while (0)
#define P64_ROT() do { sl_prev = sl_cur; sl_cur = sl_next; sl_next = (sl_next == 2 * SLOTB) ? 0 : sl_next + SLOTB; } while (0)
#define P64_MX3(a, b, c) __builtin_fmaxf(__builtin_fmaxf((a), (b)), (c))
#define P64_ROWMAX(rm, p0, p1) do { float a_ = P64_MX3(p0[0], p0[1], p1[0]), b_ = P64_MX3(p0[2], p0[3], p1[1]); a_ = P64_MX3(a_, p1[2], p1[3]); \
        _Pragma("unroll") for (int r = 4; r < 16; r += 4) { a_ = P64_MX3(a_, p0[r], p0[r + 1]); b_ = P64_MX3(b_, p0[r + 2], p0[r + 3]); a_ = P64_MX3(a_, p1[r], p1[r + 1]); b_ = P64_MX3(b_, p1[r + 2], p1[r + 3]); } \
        rm = halfswap_max(__builtin_fmaxf(a_, b_)); } while (0)
#define P64_BITPOS(i) (((i) & 3) + 8 * ((i) >> 2))
#define P64_EX(v, w, i) ((MODE == 1) ? __uint_as_float(__float_as_uint(__builtin_amdgcn_exp2f((v) + nmh)) & (unsigned)(((int)((w) << (31 - P64_BITPOS(i)))) >> 31)) : __builtin_amdgcn_exp2f((v) + nmh))
#define P64_RESC() do { if (resc) { _Pragma("unroll") for (int d_ = 0; d_ < 2; ++d_) _Pragma("unroll") for (int r = 0; r < 16; ++r) o[d_][r] *= wsf[crow(r, hi)]; } } while (0)
    if (NM) { P64_WAIT_BAR(4); } else { P64_WAIT_BAR(3); }
    _Pragma("unroll") for (int d0 = 0; d0 < 4; ++d0) P64_KLOAD2(kp0, d0);
    unsigned wl = 0u, wh = 0u;
    if (MODE == 1) { wl = mrd[r32] >> (4 * hi); wh = mrd[32 + r32] >> (4 * hi); }
    pA0 = P64_MFMA(kf[0], qr[0], zero16); pA1 = P64_MFMA(kf[1], qr[0], zero16); pA0 = P64_MFMA(kf[2], qr[1], pA0); pA1 = P64_MFMA(kf[3], qr[1], pA1);
    pA0 = P64_MFMA(kf[4], qr[2], pA0); pA1 = P64_MFMA(kf[5], qr[2], pA1); pA0 = P64_MFMA(kf[6], qr[3], pA0); pA1 = P64_MFMA(kf[7], qr[3], pA1);
    { float rm; P64_ROWMAX(rm, pA0, pA1); mhat = rm; const float nmh = -mhat;
#pragma unroll
      for (int r = 0; r < 16; ++r) { pA0[r] = P64_EX(pA0[r], wl, r); pA1[r] = P64_EX(pA1[r], wh, r); } }
    P64_WAIT_BAR(0);
    P64_DMA_K(3, 0); P64_DMA_V(1, SLOTB); P64_DMA_M(2, 2 * SLOTB); P64_ROT();
    _Pragma("unroll") for (int d0 = 0; d0 < 4; ++d0) P64_KLOAD2(kp0 + sl_cur, d0);
    if (NM) { P64_WAIT_BAR(3); } else { P64_WAIT_BAR(2); }
#define P64_PKW(P, i) cvtpk(P[i], P[i + 1])
#define P64_PAF(k) __builtin_bit_cast(bf16x8, pw##k)
#define P64_VFR(i) (bf16x8){vlo[i][0], vlo[i][1], vlo[i][2], vlo[i][3], vhi[i][0], vhi[i][1], vhi[i][2], vhi[i][3]}
#define P64_VRD(i) do { vlo[i] = vtr(vp_ + (((i) >> 2) * 4096 + ((i) & 3) * 1024)); vhi[i] = vtr(vp_ + (((i) >> 2) * 4096 + ((i) & 3) * 1024 + 512)); } while (0)
#define P64_KRD(G, d0) do { if (G) { P64_KLOAD2(kp0 + sl_next, d0); P64_SBAR(); } } while (0)
#define P64_GAPA(MF, a0, a1, a2, a3, W0, W1, PW) do { MF; sacc += a0; sacc += a1; sacc += a2; sacc += a3; W0; W1; P64_PIN(PW); P64_PIN(sacc); P64_SBAR(); } while (0)
#define P64_GAPB(MF, X, W, i) do { MF; X[i] = P64_EX(X[i], W, i); X[i + 1] = P64_EX(X[i + 1], W, i + 1); X[i + 2] = P64_EX(X[i + 2], W, i + 2); X[i + 3] = P64_EX(X[i + 3], W, i + 3); P64_PIN(X); P64_SBAR(); } while (0)
#define P64_STEP(C0, C1, P0, P1, t, GK, GV, GM, GL) do { P64_SBAR(); \
    const ALAS unsigned char* vp_ = vp0 + sl_prev; \
    if (MODE == 1) { const ALAS unsigned* mp_ = mrd + (sl_cur >> 7); wl = mp_[r32] >> (4 * hi); wh = mp_[32 + r32] >> (4 * hi); if ((t) > tvis) { wl = 0u; wh = 0u; } }     \
    P64_VRD(0); P64_SBAR(); float sacc = P0[0] + P0[1]; \
                        P64_GAPA(C0 = P64_MFMA(kf[0], qr[0], zero16), P0[2], P0[3], P0[4], P0[5],     pw0[0] = P64_PKW(P0, 0),  pw0[1] = P64_PKW(P0, 2),  pw0); \
    P64_VRD(4); P64_SBAR(); P64_GAPA(C1 = P64_MFMA(kf[1], qr[0], zero16), P0[6], P0[7], P0[8], P0[9],     pw0[2] = P64_PKW(P0, 4),  pw0[3] = P64_PKW(P0, 6),  pw0); \
    P64_VRD(1); P64_SBAR(); P64_GAPA(C0 = P64_MFMA(kf[2], qr[1], C0),    P0[10], P0[11], P0[12], P0[13], pw1[0] = P64_PKW(P0, 8),  pw1[1] = P64_PKW(P0, 10), pw1); \
    P64_VRD(5); P64_SBAR(); P64_GAPA(C1 = P64_MFMA(kf[3], qr[1], C1),    P0[14], P0[15], P1[0], P1[1],   pw1[2] = P64_PKW(P0, 12), pw1[3] = P64_PKW(P0, 14), pw1); \
    P64_VRD(2); P64_SBAR(); P64_GAPA(C0 = P64_MFMA(kf[4], qr[2], C0),    P1[2], P1[3], P1[4], P1[5],     pw2[0] = P64_PKW(P1, 0),  pw2[1] = P64_PKW(P1, 2),  pw2); \
    P64_VRD(6); P64_SBAR(); P64_GAPA(C1 = P64_MFMA(kf[5], qr[2], C1),    P1[6], P1[7], P1[8], P1[9],     pw2[2] = P64_PKW(P1, 4),  pw2[3] = P64_PKW(P1, 6),  pw2); \
    P64_VRD(3); P64_SBAR(); P64_GAPA(C0 = P64_MFMA(kf[6], qr[3], C0),    P1[10], P1[11], P1[12], P1[13], pw3[0] = P64_PKW(P1, 8),  pw3[1] = P64_PKW(P1, 10), pw3); \
    P64_VRD(7); P64_SBAR(); P64_GAPA(C1 = P64_MFMA(kf[7], qr[3], C1),    P1[14], P1[15], 0.f, 0.f,       pw3[2] = P64_PKW(P1, 12), pw3[3] = P64_PKW(P1, 14), pw3); \
    l_reg += sacc; \
    if (GK) P64_DMA_K((t) + 3, sl_cur); if (GV) P64_DMA_V((t) + 1, sl_next); if (GM) P64_DMA_M((t) + 2, sl_prev); \
    { float rm_; P64_ROWMAX(rm_, C0, C1); rm_ -= mhat; resc = false; \
      if (__builtin_expect(__any(rm_ > (float)THR), 0)) { const float dl = __builtin_fmaxf(rm_, 0.f); mhat += dl; \
          const float f = __builtin_amdgcn_exp2f(-dl); l_reg *= f; if (hi == 0) wsf[r32] = f; resc = true; } } \
    const float nmh = -mhat; P64_SBAR(); \
    P64_GAPB(o[0] = P64_MFMA(P64_PAF(0), P64_VFR(0), o[0]), C0, wl, 0);              P64_GAPB(o[1] = P64_MFMA(P64_PAF(0), P64_VFR(4), o[1]), C0, wl, 4); \
    P64_KRD(GL, 0); P64_GAPB(o[0] = P64_MFMA(P64_PAF(1), P64_VFR(1), o[0]), C0, wl, 8);  P64_KRD(GL, 1); P64_GAPB(o[1] = P64_MFMA(P64_PAF(1), P64_VFR(5), o[1]), C0, wl, 12); \
    P64_KRD(GL, 2); P64_GAPB(o[0] = P64_MFMA(P64_PAF(2), P64_VFR(2), o[0]), C1, wh, 0);  P64_KRD(GL, 3); P64_GAPB(o[1] = P64_MFMA(P64_PAF(2), P64_VFR(6), o[1]), C1, wh, 4); \
    P64_GAPB(o[0] = P64_MFMA(P64_PAF(3), P64_VFR(3), o[0]), C1, wh, 8);              P64_GAPB(o[1] = P64_MFMA(P64_PAF(3), P64_VFR(7), o[1]), C1, wh, 12); \
    } while (0)
#define P64_WAIT_STEADY() do { if (NM) { P64_WAIT_BAR(3); } else { P64_WAIT_BAR(2); } } while (0)
#define P64_ENDW(tt) do { if ((tt) + 3 < NT) { P64_WAIT_STEADY(); } else if ((tt) + 2 < NT) { if (NM) { P64_WAIT_BAR(2); } else { P64_WAIT_BAR(1); } } else { P64_WAIT_BAR(0); } } while (0)
    int t = 1;
    for (; t + 5 < NT; t += 2) {
        P64_STEP(pB0, pB1, pA0, pA1, t, true, true, true, true);     P64_WAIT_STEADY(); P64_RESC(); P64_ROT();
        P64_STEP(pA0, pA1, pB0, pB1, t + 1, true, true, true, true); P64_WAIT_STEADY(); P64_RESC(); P64_ROT();
    }
    for (; t + 1 < NT; t += 2) {
        P64_STEP(pB0, pB1, pA0, pA1, t, (t + 3 < NT), (t + 1 < NT), (t + 2 < NT), (t + 1 < NT));         P64_ENDW(t);     P64_RESC(); P64_ROT();
        P64_STEP(pA0, pA1, pB0, pB1, t + 1, (t + 4 < NT), (t + 2 < NT), (t + 3 < NT), (t + 2 < NT));     P64_ENDW(t + 1); P64_RESC(); P64_ROT();
    }
    P64_STEP(pB0, pB1, pA0, pA1, NT - 1, false, false, false, false); P64_RESC();
    { float sacc = pB0[0] + pB0[1];
#pragma unroll
      for (int r = 2; r < 16; ++r) sacc += pB0[r];
#pragma unroll
      for (int r = 0; r < 16; ++r) sacc += pB1[r];
      l_reg += sacc;
      pw0 = (u32x4){P64_PKW(pB0, 0), P64_PKW(pB0, 2), P64_PKW(pB0, 4), P64_PKW(pB0, 6)}; pw1 = (u32x4){P64_PKW(pB0, 8), P64_PKW(pB0, 10), P64_PKW(pB0, 12), P64_PKW(pB0, 14)};
      pw2 = (u32x4){P64_PKW(pB1, 0), P64_PKW(pB1, 2), P64_PKW(pB1, 4), P64_PKW(pB1, 6)}; pw3 = (u32x4){P64_PKW(pB1, 8), P64_PKW(pB1, 10), P64_PKW(pB1, 12), P64_PKW(pB1, 14)};
      const ALAS unsigned char* vp_ = vp0 + sl_cur; _Pragma("unroll") for (int i = 0; i < 8; ++i) P64_VRD(i);
      o[0] = P64_MFMA(P64_PAF(0), P64_VFR(0), o[0]); o[1] = P64_MFMA(P64_PAF(0), P64_VFR(4), o[1]); o[0] = P64_MFMA(P64_PAF(1), P64_VFR(1), o[0]); o[1] = P64_MFMA(P64_PAF(1), P64_VFR(5), o[1]);
      o[0] = P64_MFMA(P64_PAF(2), P64_VFR(2), o[0]); o[1] = P64_MFMA(P64_PAF(2), P64_VFR(6), o[1]); o[0] = P64_MFMA(P64_PAF(3), P64_VFR(3), o[0]); o[1] = P64_MFMA(P64_PAF(3), P64_VFR(7), o[1]); }
    const float l = halfswap_sum(l_reg);
    if (hi == 0) wsf[32 + r32] = l; asm volatile("s_waitcnt lgkmcnt(0)" ::: "memory");
#pragma unroll
    for (int r = 0; r < 16; ++r) { const float rl = __builtin_amdgcn_rcpf(wsf[32 + crow(r, hi)]);
#pragma unroll
        for (int d0 = 0; d0 < 2; ++d0) o[d0][r] *= rl; }
    asm volatile("s_waitcnt lgkmcnt(0)\n\ts_barrier" ::: "memory");
#undef P64_U
#undef P64_DMA_K
#undef P64_DMA_V
#undef P64_DMA_M
#undef P64_SBAR
#undef P64_PIN
#undef P64_MFMA
#undef P64_WAIT_BAR
#undef P64_KLOAD2
#undef P64_ROT
#undef P64_MX3
#undef P64_ROWMAX
#undef P64_BITPOS
#undef P64_EX
#undef P64_RESC
#undef P64_PKW
#undef P64_PAF
#undef P64_VFR
#undef P64_VRD
#undef P64_KRD
#undef P64_GAPA
#undef P64_GAPB
#undef P64_STEP
#undef P64_WAIT_STEADY
#undef P64_ENDW
}

__device__ __forceinline__ float ex_masked(float x, unsigned w, int pos) { int m = __builtin_amdgcn_sbfe((int)w, (unsigned)pos, 1u); asm("" : "+v"(m)); return __uint_as_float(__float_as_uint(__builtin_amdgcn_exp2f(x)) & (unsigned)m); }
#ifndef C_FARFOLD
#define C_FARFOLD 0
#endif
#ifndef ATT_FOLD
#define ATT_FOLD 1
#endif
#ifndef C_BIASPRE
#define C_BIASPRE 0
#endif
template <int MODE, int THR>
__device__ __forceinline__ void attn64w(f32x16 (&o)[2], ALAS unsigned char* lds, const bf16_t* Qw, int ld, const bf16_t* Kh, const bf16_t* Vh, int T0, int T1, int tw0, int tw1, const unsigned long long* maskrow, int qpos,
                                        bool pre_in = false, bool has_next = false, const bf16_t* nKh = nullptr, const bf16_t* nVh = nullptr, const unsigned long long* nmask = nullptr, int nT0 = 0) {
    typedef Lds<64> L; constexpr int SLOTB = 8192; constexpr int NM = (MODE == 1) ? 1 : 0;
    constexpr bool FOLD = (MODE != 2) && (ATT_FOLD != 0);
    int tid = threadIdx.x; asm volatile("" : "+v"(tid));
    const int lane = tid & 63, r32 = lane & 31, hi = lane >> 5; const int wid = __builtin_amdgcn_readfirstlane(tid >> 6);
    ALAS float* wsf = (ALAS float*)(lds + L::OFF_WSF) + wid * 64;
    const ALAS float* btab = (const ALAS float*)(lds + L::OFF_BT);
    const unsigned lds0 = (unsigned)(__SIZE_TYPE__)lds;
    const bf16_t* ksrc = Kh + (size_t)lane * ld + wid * 8;
    const bf16_t* vsrc = Vh + (size_t)(16 * (wid & 3) + (lane >> 2)) * ld + (wid >> 2) * 32 + (lane & 3) * 8;
    const unsigned* msrc = (const unsigned*)maskrow + hi;
    const unsigned kdst = lds0 + L::OFF_K + wid * 1024, vdst = lds0 + L::OFF_V + wid * 1024, mdstb = lds0 + L::OFF_MW + wid * (L::R * 256);
    const ALAS unsigned* mrd = (const ALAS unsigned*)(lds + L::OFF_MW + wid * (L::R * 256));
#define W64_U(x) ((unsigned)__builtin_amdgcn_readfirstlane((int)(x)))
#define W64_DMA_K(t, slot) glds16(ksrc + (size_t)(t) * 64 * ld, W64_U(kdst + (slot)))
#define W64_DMA_V(t, slot) glds16(vsrc + (size_t)(t) * 64 * ld, W64_U(vdst + (slot)))
#define W64_DMA_M(t, slot) do { if (MODE == 1) glds4(msrc + 2 * (t), W64_U(mdstb + ((slot) >> 5))); } while (0)
#define W64_SBAR() __builtin_amdgcn_sched_barrier(0)
#define W64_PIN(x) asm volatile("" : "+v"(x))
#define W64_MFMA(a, b, c) __builtin_amdgcn_mfma_f32_32x32x16_bf16(a, b, c, 0, 0, 0)
#define W64_WAIT_BAR(N) asm volatile("s_waitcnt vmcnt(" #N ") lgkmcnt(0)\n\ts_barrier" ::: "memory")
    const ALAS unsigned char* vp0 = lds + L::OFF_V + ((lane >> 4) & 1) * 32 + (lane & 3) * 8 + (4 * hi + ((lane & 15) >> 2)) * 64;
    const ALAS unsigned char* kp0 = lds + L::OFF_K + hi * 1024 + r32 * 16;
    bf16x8 qr[4];
#pragma unroll
    for (int d0 = 0; d0 < 4; ++d0) qr[d0] = *(const bf16x8*)(Qw + (size_t)r32 * ld + d0 * 16 + hi * 8);
    if (!pre_in) { W64_DMA_K(T0, 0); W64_DMA_M(T0, 0); W64_DMA_V(T0, 0); W64_DMA_K(T0 + 1, SLOTB); W64_DMA_K(T0 + 2, 2 * SLOTB); W64_DMA_M(T0 + 1, SLOTB); }
    float mhat = 0.f, l_reg = 0.f; o[0] = f32x16{}; o[1] = f32x16{};
    f32x16 zero16 = f32x16{}; W64_PIN(zero16);
    bool resc = false;
    f32x16 pA0, pA1, pB0, pB1; bf16x8 kf[8]; s16x4 vlo[8], vhi[8]; u32x4 pw0, pw1, pw2, pw3;
    unsigned wl = 0u, wh = 0u;
    float bofs = 0.f;
    bool cin = false;
    int sl_prev = 0, sl_cur = 0, sl_next = SLOTB;
#define W64_KLOAD2(kp, d0) do { kf[2 * (d0)] = *(const ALAS bf16x8*)((kp) + (d0) * 2048); kf[2 * (d0) + 1] = *(const ALAS bf16x8*)((kp) + (d0) * 2048 + 512); } while (0)
#define W64_KLOAD_ALL(kp) do { _Pragma("unroll") for (int d0_ = 0; d0_ < 4; ++d0_) W64_KLOAD2(kp, d0_); } while (0)
#define W64_ROT() do { sl_prev = sl_cur; sl_cur = sl_next; sl_next = (sl_next == 2 * SLOTB) ? 0 : sl_next + SLOTB; } while (0)
#define W64_MX3(a, b, c) __builtin_fmaxf(__builtin_fmaxf((a), (b)), (c))
#define W64_ROWMAX(rm, p0, p1) do { float a_ = W64_MX3(p0[0], p0[1], p1[0]), b_ = W64_MX3(p0[2], p0[3], p1[1]); a_ = W64_MX3(a_, p1[2], p1[3]); \
        _Pragma("unroll") for (int r = 4; r < 16; r += 4) { a_ = W64_MX3(a_, p0[r], p0[r + 1]); b_ = W64_MX3(b_, p0[r + 2], p0[r + 3]); a_ = W64_MX3(a_, p1[r], p1[r + 1]); b_ = W64_MX3(b_, p1[r + 2], p1[r + 3]); } \
        rm = halfswap_max(__builtin_fmaxf(a_, b_)); } while (0)
#define W64_BITPOS(i) (((i) & 3) + 8 * ((i) >> 2))
#define W64_EX(v, w, i, FD) ((MODE == 1) ? ((FD) ? ex_masked((v), (w), W64_BITPOS(i)) : ex_masked((v) + nmh, (w), W64_BITPOS(i))) : ((FD) ? __builtin_amdgcn_exp2f(v) : __builtin_amdgcn_exp2f((v) + nmh)))
#define W64_RESC() do { if (resc) { _Pragma("unroll") for (int d_ = 0; d_ < 2; ++d_) _Pragma("unroll") for (int r = 0; r < 16; ++r) o[d_][r] *= wsf[crow(r, hi)]; } } while (0)
#define W64_CINIT(C0, C1, t) do { if (MODE == 2) { const int ub_ = 576 - qpos + 64 * (t) + 4 * hi, sh_ = ub_ & 3; const ALAS float* bp_ = btab + sh_ * BT_STRIDE + (ub_ - sh_); \
        _Pragma("unroll") for (int g = 0; g < 4; ++g) { const f32x4 v0_ = *(const ALAS f32x4*)(bp_ + 8 * g), v1_ = *(const ALAS f32x4*)(bp_ + 32 + 8 * g); \
            _Pragma("unroll") for (int j = 0; j < 4; ++j) { C0[4 * g + j] = v0_[j]; C1[4 * g + j] = v1_[j]; } } } else { C0 = zero16; C1 = zero16; } } while (0)
#define W64_MASKW(t) do { if (MODE == 1) { const ALAS unsigned* mp_ = mrd + (sl_cur >> 7); wl = mp_[r32] >> (4 * hi); wh = mp_[32 + r32] >> (4 * hi); } } while (0)
#define W64_PKW(P, i) cvtpk(P[i], P[i + 1])
#define W64_PAF(k) __builtin_bit_cast(bf16x8, pw##k)
#define W64_VFR(i) (bf16x8){vlo[i][0], vlo[i][1], vlo[i][2], vlo[i][3], vhi[i][0], vhi[i][1], vhi[i][2], vhi[i][3]}
#define W64_VRD(i) do { vlo[i] = vtr(vp_ + (((i) >> 2) * 4096 + ((i) & 3) * 1024)); vhi[i] = vtr(vp_ + (((i) >> 2) * 4096 + ((i) & 3) * 1024 + 512)); } while (0)
#define W64_KRD(G, d0) do { if (G) { W64_KLOAD2(kp0 + sl_next, d0); W64_SBAR(); } } while (0)
#define W64_GAPA(MF, a0, a1, a2, a3, W0, W1, PW) do { MF; sacc += a0; sacc += a1; sacc += a2; sacc += a3; W0; W1; W64_PIN(PW); W64_PIN(sacc); W64_SBAR(); } while (0)
#define W64_GAPB(MF, X, W, i, FD) do { MF; X[i] = W64_EX(X[i], W, i, FD); X[i + 1] = W64_EX(X[i + 1], W, i + 1, FD); X[i + 2] = W64_EX(X[i + 2], W, i + 2, FD); X[i + 3] = W64_EX(X[i + 3], W, i + 3, FD); W64_PIN(X); W64_SBAR(); } while (0)
#define W64_FIRST(C0, C1, N0, N1, t, GL, FARF) do { constexpr bool FD_ = FOLD || (FARF); W64_MASKW(t); if (MODE == 2 && (FARF)) { C0 = zero16; C1 = zero16; } else { W64_CINIT(C0, C1, t); } \
    C0 = W64_MFMA(kf[0], qr[0], C0); C1 = W64_MFMA(kf[1], qr[0], C1); C0 = W64_MFMA(kf[2], qr[1], C0); C1 = W64_MFMA(kf[3], qr[1], C1); \
    C0 = W64_MFMA(kf[4], qr[2], C0); C1 = W64_MFMA(kf[5], qr[2], C1); C0 = W64_MFMA(kf[6], qr[3], C0); C1 = W64_MFMA(kf[7], qr[3], C1); \
    if (GL) W64_KLOAD_ALL(kp0 + sl_next); \
    { float rm_; W64_ROWMAX(rm_, C0, C1); mhat = rm_; const float nmh = -mhat; \
      if (FD_) { _Pragma("unroll") for (int r = 0; r < 16; ++r) { C0[r] -= rm_; C1[r] -= rm_; } \
                 _Pragma("unroll") for (int r = 0; r < 16; ++r) zero16[r] = bofs + nmh; W64_PIN(zero16); } \
      _Pragma("unroll") for (int r = 0; r < 16; ++r) { C0[r] = W64_EX(C0[r], wl, r, FD_); C1[r] = W64_EX(C1[r], wh, r, FD_); } } \
    cin = false; if (MODE == 2 && C_BIASPRE && (GL)) { W64_CINIT(N0, N1, (t) + 1); cin = true; } } while (0)
#define W64_DRAIN(P0, P1, vs) do { float sacc = P0[0] + P0[1]; \
      _Pragma("unroll") for (int r = 2; r < 16; ++r) sacc += P0[r]; \
      _Pragma("unroll") for (int r = 0; r < 16; ++r) sacc += P1[r]; \
      l_reg += sacc; \
      pw0 = (u32x4){W64_PKW(P0, 0), W64_PKW(P0, 2), W64_PKW(P0, 4), W64_PKW(P0, 6)}; pw1 = (u32x4){W64_PKW(P0, 8), W64_PKW(P0, 10), W64_PKW(P0, 12), W64_PKW(P0, 14)}; \
      pw2 = (u32x4){W64_PKW(P1, 0), W64_PKW(P1, 2), W64_PKW(P1, 4), W64_PKW(P1, 6)}; pw3 = (u32x4){W64_PKW(P1, 8), W64_PKW(P1, 10), W64_PKW(P1, 12), W64_PKW(P1, 14)}; \
      const ALAS unsigned char* vp_ = vp0 + (vs); _Pragma("unroll") for (int i = 0; i < 8; ++i) W64_VRD(i); \
      o[0] = W64_MFMA(W64_PAF(0), W64_VFR(0), o[0]); o[1] = W64_MFMA(W64_PAF(0), W64_VFR(4), o[1]); o[0] = W64_MFMA(W64_PAF(1), W64_VFR(1), o[0]); o[1] = W64_MFMA(W64_PAF(1), W64_VFR(5), o[1]); \
      o[0] = W64_MFMA(W64_PAF(2), W64_VFR(2), o[0]); o[1] = W64_MFMA(W64_PAF(2), W64_VFR(6), o[1]); o[0] = W64_MFMA(W64_PAF(3), W64_VFR(3), o[0]); o[1] = W64_MFMA(W64_PAF(3), W64_VFR(7), o[1]); } while (0)
#define W64_FULL(C0, C1, P0, P1, t, GL, FARF) do { constexpr bool FD_ = FOLD || (FARF); W64_SBAR(); \
    const ALAS unsigned char* vp_ = vp0 + sl_prev; \
    W64_MASKW(t); if (MODE == 2 && (FARF)) { C0 = zero16; C1 = zero16; } else if (!(MODE == 2 && C_BIASPRE) || !cin) { W64_CINIT(C0, C1, t); } \
    W64_VRD(0); W64_SBAR(); float sacc = P0[0] + P0[1]; \
                        W64_GAPA(C0 = W64_MFMA(kf[0], qr[0], C0), P0[2], P0[3], P0[4], P0[5],     pw0[0] = W64_PKW(P0, 0),  pw0[1] = W64_PKW(P0, 2),  pw0); \
    W64_VRD(4); W64_SBAR(); W64_GAPA(C1 = W64_MFMA(kf[1], qr[0], C1), P0[6], P0[7], P0[8], P0[9],     pw0[2] = W64_PKW(P0, 4),  pw0[3] = W64_PKW(P0, 6),  pw0); \
    W64_VRD(1); W64_SBAR(); W64_GAPA(C0 = W64_MFMA(kf[2], qr[1], C0),    P0[10], P0[11], P0[12], P0[13], pw1[0] = W64_PKW(P0, 8),  pw1[1] = W64_PKW(P0, 10), pw1); \
    W64_VRD(5); W64_SBAR(); W64_GAPA(C1 = W64_MFMA(kf[3], qr[1], C1),    P0[14], P0[15], P1[0], P1[1],   pw1[2] = W64_PKW(P0, 12), pw1[3] = W64_PKW(P0, 14), pw1); \
    W64_VRD(2); W64_SBAR(); W64_GAPA(C0 = W64_MFMA(kf[4], qr[2], C0),    P1[2], P1[3], P1[4], P1[5],     pw2[0] = W64_PKW(P1, 0),  pw2[1] = W64_PKW(P1, 2),  pw2); \
    W64_VRD(6); W64_SBAR(); W64_GAPA(C1 = W64_MFMA(kf[5], qr[2], C1),    P1[6], P1[7], P1[8], P1[9],     pw2[2] = W64_PKW(P1, 4),  pw2[3] = W64_PKW(P1, 6),  pw2); \
    W64_VRD(3); W64_SBAR(); W64_GAPA(C0 = W64_MFMA(kf[6], qr[3], C0),    P1[10], P1[11], P1[12], P1[13], pw3[0] = W64_PKW(P1, 8),  pw3[1] = W64_PKW(P1, 10), pw3); \
    W64_VRD(7); W64_SBAR(); W64_GAPA(C1 = W64_MFMA(kf[7], qr[3], C1),    P1[14], P1[15], 0.f, 0.f,       pw3[2] = W64_PKW(P1, 12), pw3[3] = W64_PKW(P1, 14), pw3); \
    l_reg += sacc; \
    { float rm_; W64_ROWMAX(rm_, C0, C1); if (!FD_) rm_ -= mhat; \
      if (__builtin_expect(__any(rm_ > (float)THR), 0)) { const float dl = __builtin_fmaxf(rm_, 0.f); mhat += dl; \
          if (FD_) { _Pragma("unroll") for (int r = 0; r < 16; ++r) { C0[r] -= dl; C1[r] -= dl; } \
                     _Pragma("unroll") for (int r = 0; r < 16; ++r) zero16[r] = bofs - mhat; W64_PIN(zero16); } \
          const float f = __builtin_amdgcn_exp2f(-dl); l_reg *= f; if (hi == 0) wsf[r32] = f; resc = true; } } \
    const float nmh = -mhat; W64_SBAR(); \
    cin = false; if (MODE == 2 && C_BIASPRE && (GL)) { W64_CINIT(P0, P1, (t) + 1); cin = true; W64_SBAR(); }        \
    W64_GAPB(o[0] = W64_MFMA(W64_PAF(0), W64_VFR(0), o[0]), C0, wl, 0, FD_);              W64_GAPB(o[1] = W64_MFMA(W64_PAF(0), W64_VFR(4), o[1]), C0, wl, 4, FD_); \
    W64_KRD(GL, 0); W64_GAPB(o[0] = W64_MFMA(W64_PAF(1), W64_VFR(1), o[0]), C0, wl, 8, FD_);  W64_KRD(GL, 1); W64_GAPB(o[1] = W64_MFMA(W64_PAF(1), W64_VFR(5), o[1]), C0, wl, 12, FD_); \
    W64_KRD(GL, 2); W64_GAPB(o[0] = W64_MFMA(W64_PAF(2), W64_VFR(2), o[0]), C1, wh, 0, FD_);  W64_KRD(GL, 3); W64_GAPB(o[1] = W64_MFMA(W64_PAF(2), W64_VFR(6), o[1]), C1, wh, 4, FD_); \
    W64_GAPB(o[0] = W64_MFMA(W64_PAF(3), W64_VFR(3), o[0]), C1, wh, 8, FD_);              W64_GAPB(o[1] = W64_MFMA(W64_PAF(3), W64_VFR(7), o[1]), C1, wh, 12, FD_); \
    } while (0)
#define W64_ENDW(tt) do { if ((tt) + 3 < T1) { if (NM) { W64_WAIT_BAR(3); } else { W64_WAIT_BAR(2); } } else if ((tt) + 2 < T1) { if (NM) { W64_WAIT_BAR(2); } else { W64_WAIT_BAR(1); } } else { W64_WAIT_BAR(0); } } while (0)
#define W64_DMAS(t) do { if ((t) + 3 < T1) W64_DMA_K((t) + 3, sl_cur); if ((t) + 1 < T1) W64_DMA_V((t) + 1, sl_next); if ((t) + 2 < T1) W64_DMA_M((t) + 2, sl_prev); } while (0)
#define W64_END(t) do { W64_ENDW(t); W64_RESC(); W64_ROT(); } while (0)
    if (pre_in) { W64_WAIT_BAR(0); } else if (NM) { W64_WAIT_BAR(4); } else { W64_WAIT_BAR(3); }
    const int tf = (MODE == 2 && C_FARFOLD) ? tw1 - 5 : T0;
    if (MODE == 2 && C_FARFOLD) { bofs = btab[1];
#pragma unroll
        for (int r = 0; r < 16; ++r) zero16[r] = bofs;
        W64_PIN(zero16); }
    if (tw0 == T0) { W64_KLOAD_ALL(kp0); if (MODE == 2 && C_FARFOLD && T0 < tf) { W64_FIRST(pA0, pA1, pB0, pB1, T0, false, true); } else { W64_FIRST(pA0, pA1, pB0, pB1, T0, false, false); } }
    W64_WAIT_BAR(0);
    W64_DMA_K(T0 + 3, 0); W64_DMA_V(T0 + 1, SLOTB); W64_DMA_M(T0 + 2, 2 * SLOTB); W64_ROT();
    if (T0 + 1 >= tw0 && T0 + 1 < tw1) W64_KLOAD_ALL(kp0 + sl_cur);
    if (NM) { W64_WAIT_BAR(3); } else { W64_WAIT_BAR(2); }
    int t = T0 + 1;
#pragma unroll 1
    for (; t < tw0; ++t) { W64_DMAS(t); if (t + 1 == tw0) W64_KLOAD_ALL(kp0 + sl_next); W64_ENDW(t); W64_ROT(); }
    if (tw0 > T0) { W64_DMAS(t); if (MODE == 2 && C_FARFOLD && t < tf) { W64_FIRST(pA0, pA1, pB0, pB1, t, (t + 1 < tw1), true); } else { W64_FIRST(pA0, pA1, pB0, pB1, t, (t + 1 < tw1), false); } W64_ENDW(t); W64_ROT(); ++t; }
    if (MODE == 2 && C_FARFOLD) {
#pragma unroll 1
        for (; t + 1 < tf; t += 2) {
            W64_DMAS(t);     resc = false; W64_FULL(pB0, pB1, pA0, pA1, t, true, true);     W64_END(t);
            W64_DMAS(t + 1); resc = false; W64_FULL(pA0, pA1, pB0, pB1, t + 1, true, true); W64_END(t + 1);
        }
        if (t < tf) {
            W64_DMAS(t); resc = false; W64_FULL(pB0, pB1, pA0, pA1, t, true, true); W64_END(t); ++t;
            W64_DMAS(t); resc = false; W64_FULL(pA0, pA1, pB0, pB1, t, (t + 1 < tw1), false); W64_END(t); ++t;
        }
    }
#pragma unroll 1
    for (; t + 2 < tw1; t += 2) {
        W64_DMAS(t);     resc = false; W64_FULL(pB0, pB1, pA0, pA1, t, true, false);     W64_END(t);
        W64_DMAS(t + 1); resc = false; W64_FULL(pA0, pA1, pB0, pB1, t + 1, true, false); W64_END(t + 1);
    }
    bool lastB = false;
    if (t < tw1) { W64_DMAS(t); resc = false; W64_FULL(pB0, pB1, pA0, pA1, t, (t + 1 < tw1), false); W64_END(t); ++t; lastB = true; }
    if (t < tw1) { W64_DMAS(t); resc = false; W64_FULL(pA0, pA1, pB0, pB1, t, false, false); W64_END(t); ++t; lastB = false; }
    resc = false;
    if (t < T1) {
        W64_DMAS(t); if (lastB) { W64_DRAIN(pB0, pB1, sl_prev); } else { W64_DRAIN(pA0, pA1, sl_prev); } W64_ENDW(t); W64_ROT(); ++t;
#pragma unroll 1
        for (; t < T1; ++t) { W64_DMAS(t); W64_ENDW(t); W64_ROT(); }
    } else { if (lastB) { W64_DRAIN(pB0, pB1, sl_prev); } else { W64_DRAIN(pA0, pA1, sl_prev); } }
    asm volatile("s_waitcnt lgkmcnt(0)\n\ts_barrier" ::: "memory");
    if (has_next) {
        ksrc = nKh + (size_t)lane * ld + wid * 8; vsrc = nVh + (size_t)(16 * (wid & 3) + (lane >> 2)) * ld + (wid >> 2) * 32 + (lane & 3) * 8; msrc = (const unsigned*)nmask + hi;
        W64_DMA_K(nT0, 0); W64_DMA_M(nT0, 0); W64_DMA_V(nT0, 0); W64_DMA_K(nT0 + 1, SLOTB); W64_DMA_K(nT0 + 2, 2 * SLOTB); W64_DMA_M(nT0 + 1, SLOTB);
    }
    const float l = halfswap_sum(l_reg);
    if (hi == 0) wsf[32 + r32] = l; asm volatile("s_waitcnt lgkmcnt(0)" ::: "memory");
#pragma unroll
    for (int r = 0; r < 16; ++r) { const float rl = __builtin_amdgcn_rcpf(wsf[32 + crow(r, hi)]);
#pragma unroll
        for (int d0 = 0; d0 < 2; ++d0) o[d0][r] *= rl; }
#undef W64_U
#undef W64_DMA_K
#undef W64_DMA_V
#undef W64_DMA_M
#undef W64_SBAR
#undef W64_PIN
#undef W64_MFMA
#undef W64_WAIT_BAR
#undef W64_KLOAD2
#undef W64_KLOAD_ALL
#undef W64_ROT
#undef W64_MX3
#undef W64_ROWMAX
#undef W64_BITPOS
#undef W64_EX
#undef W64_RESC
#undef W64_CINIT
#undef W64_MASKW
#undef W64_PKW
#undef W64_PAF
#undef W64_VFR
#undef W64_VRD
#undef W64_KRD
#undef W64_GAPA
#undef W64_GAPB
#undef W64_FIRST
#undef W64_DRAIN
#undef W64_FULL
#undef W64_ENDW
#undef W64_DMAS
#undef W64_END
}

template <int THR>
__device__ __forceinline__ void attn128w(f32x16 (&o)[4], ALAS unsigned char* lds, const bf16_t* Qw, int ld, const bf16_t* Kh, const bf16_t* Vh, int T1, int tw1,
                                         bool pre_in = false, bool has_next = false, int kdelta = 0) {
    typedef Lds<128> L; constexpr int SLOTB = 8192;
    int tid = threadIdx.x; asm volatile("" : "+v"(tid));
    const int lane = tid & 63, r32 = lane & 31, hi = lane >> 5; const int wid = __builtin_amdgcn_readfirstlane(tid >> 6);
    ALAS float* wsf = (ALAS float*)(lds + L::OFF_WSF) + wid * 64;
    const unsigned lds0 = (unsigned)(__SIZE_TYPE__)lds;
    const bf16_t* ksrc = Kh + (size_t)lane * ld + wid * 8;
    const bf16_t* vsrc = Vh + (size_t)(16 * (wid & 3) + (lane >> 2)) * ld + (wid >> 2) * 32 + (lane & 3) * 8;
    const unsigned kdst = lds0 + L::OFF_K + wid * 1024, vdst = lds0 + L::OFF_V + wid * 1024;
#define X28_U(x) ((unsigned)__builtin_amdgcn_readfirstlane((int)(x)))
#define X28_DMA_K(t, slot) glds16(ksrc + (size_t)(t) * 64 * ld, X28_U(kdst + (slot)))
#define X28_DMA_V(t, slot) do { glds16(vsrc + (size_t)(t) * 64 * ld, X28_U(vdst + 2 * (slot))); glds16(vsrc + (size_t)(t) * 64 * ld + 64, X28_U(vdst + 2 * (slot) + 8192)); } while (0)
#define X28_SBAR() __builtin_amdgcn_sched_barrier(0)
#define X28_PIN(x) asm volatile("" : "+v"(x))
#define X28_MFMA(a, b, c) __builtin_amdgcn_mfma_f32_32x32x16_bf16(a, b, c, 0, 0, 0)
#define X28_WAIT_BAR(N) asm volatile("s_waitcnt vmcnt(" #N ") lgkmcnt(0)\n\ts_barrier" ::: "memory")
    const ALAS unsigned char* vp0 = lds + L::OFF_V + ((lane >> 4) & 1) * 32 + (lane & 3) * 8 + (4 * hi + ((lane & 15) >> 2)) * 64;
    const ALAS unsigned char* kp0 = lds + L::OFF_K + hi * 1024 + r32 * 16;
    bf16x8 qr[4];
#pragma unroll
    for (int d0 = 0; d0 < 4; ++d0) qr[d0] = *(const bf16x8*)(Qw + (size_t)r32 * ld + d0 * 16 + hi * 8);
    if (!pre_in) { X28_DMA_K(0, 0); X28_DMA_V(0, 0); X28_DMA_K(1, SLOTB); X28_DMA_K(2, 2 * SLOTB); }
    float mhat = 0.f, l_reg = 0.f;
#pragma unroll
    for (int d0 = 0; d0 < 4; ++d0) o[d0] = f32x16{};
    bool resc = false;
    f32x16 pA0, pA1, pB0, pB1; bf16x8 kf[8]; s16x4 vlo[8], vhi[8]; u32x4 pw0, pw1, pw2, pw3;
    int sl_prev = 0, sl_cur = 0, sl_next = SLOTB;
#define X28_KLOAD2(kp, d0) do { kf[2 * (d0)] = *(const ALAS bf16x8*)((kp) + (d0) * 2048); kf[2 * (d0) + 1] = *(const ALAS bf16x8*)((kp) + (d0) * 2048 + 512); } while (0)
#define X28_KLOAD_ALL(kp) do { _Pragma("unroll") for (int d0_ = 0; d0_ < 4; ++d0_) X28_KLOAD2(kp, d0_); } while (0)
#define X28_ROT() do { sl_prev = sl_cur; sl_cur = sl_next; sl_next = (sl_next == 2 * SLOTB) ? 0 : sl_next + SLOTB; } while (0)
#define X28_MX3(a, b, c) __builtin_fmaxf(__builtin_fmaxf((a), (b)), (c))
#define X28_ROWMAX(rm, p0, p1) do { float a_ = X28_MX3(p0[0], p0[1], p1[0]), b_ = X28_MX3(p0[2], p0[3], p1[1]); a_ = X28_MX3(a_, p1[2], p1[3]); \
        _Pragma("unroll") for (int r = 4; r < 16; r += 4) { a_ = X28_MX3(a_, p0[r], p0[r + 1]); b_ = X28_MX3(b_, p0[r + 2], p0[r + 3]); a_ = X28_MX3(a_, p1[r], p1[r + 1]); b_ = X28_MX3(b_, p1[r + 2], p1[r + 3]); } \
        rm = halfswap_max(__builtin_fmaxf(a_, b_)); } while (0)
#define X28_EX(v) __builtin_amdgcn_exp2f((v) + nmh)
#define X28_RESC() do { if (resc) { _Pragma("unroll") for (int d_ = 0; d_ < 4; ++d_) _Pragma("unroll") for (int r = 0; r < 16; ++r) o[d_][r] *= wsf[crow(r, hi)]; } } while (0)
#define X28_PKW(P, i) cvtpk(P[i], P[i + 1])
#define X28_PAF(k) __builtin_bit_cast(bf16x8, pw##k)
#define X28_VFR(i) (bf16x8){vlo[i][0], vlo[i][1], vlo[i][2], vlo[i][3], vhi[i][0], vhi[i][1], vhi[i][2], vhi[i][3]}
#define X28_VRDF(i, f) do { vlo[i] = vtr(vp_ + (((f) >> 2) * 4096 + ((f) & 3) * 1024)); vhi[i] = vtr(vp_ + (((f) >> 2) * 4096 + ((f) & 3) * 1024 + 512)); } while (0)
#define X28_KRD(G, d0) do { if (G) { X28_KLOAD2(kp0 + sl_next, d0); X28_SBAR(); } } while (0)
#define X28_GAPA(MF, a0, a1, a2, a3, W0, W1, PW) do { MF; sacc += a0; sacc += a1; sacc += a2; sacc += a3; W0; W1; X28_PIN(PW); X28_PIN(sacc); X28_SBAR(); } while (0)
#define X28_GAPB(MF, RI, RL, X, i) do { MF; if ((RL) >= 0) { X28_VRDF(RI, ((RL) < 0 ? 0 : (RL))); } X[i] = X28_EX(X[i]); X[i + 1] = X28_EX(X[i + 1]); X28_PIN(X); X28_SBAR(); } while (0)
#define X28_FIRST(C0, C1) do { \
    C0 = X28_MFMA(kf[0], qr[0], f32x16{}); C1 = X28_MFMA(kf[1], qr[0], f32x16{}); C0 = X28_MFMA(kf[2], qr[1], C0); C1 = X28_MFMA(kf[3], qr[1], C1); \
    C0 = X28_MFMA(kf[4], qr[2], C0); C1 = X28_MFMA(kf[5], qr[2], C1); C0 = X28_MFMA(kf[6], qr[3], C0); C1 = X28_MFMA(kf[7], qr[3], C1); \
    { float rm_; X28_ROWMAX(rm_, C0, C1); mhat = rm_; const float nmh = -mhat; \
      _Pragma("unroll") for (int r = 0; r < 16; ++r) { C0[r] = X28_EX(C0[r]); C1[r] = X28_EX(C1[r]); } } } while (0)
#define X28_DRAIN(P0, P1, vs) do { float sacc = P0[0] + P0[1]; \
      _Pragma("unroll") for (int r = 2; r < 16; ++r) sacc += P0[r]; \
      _Pragma("unroll") for (int r = 0; r < 16; ++r) sacc += P1[r]; \
      l_reg += sacc; \
      pw0 = (u32x4){X28_PKW(P0, 0), X28_PKW(P0, 2), X28_PKW(P0, 4), X28_PKW(P0, 6)}; pw1 = (u32x4){X28_PKW(P0, 8), X28_PKW(P0, 10), X28_PKW(P0, 12), X28_PKW(P0, 14)}; \
      pw2 = (u32x4){X28_PKW(P1, 0), X28_PKW(P1, 2), X28_PKW(P1, 4), X28_PKW(P1, 6)}; pw3 = (u32x4){X28_PKW(P1, 8), X28_PKW(P1, 10), X28_PKW(P1, 12), X28_PKW(P1, 14)}; \
      const ALAS unsigned char* vp_ = vp0 + 2 * (vs); \
      _Pragma("unroll") for (int hb = 0; hb < 2; ++hb) { _Pragma("unroll") for (int i = 0; i < 8; ++i) X28_VRDF(i, 8 * hb + i); \
        o[2 * hb] = X28_MFMA(X28_PAF(0), X28_VFR(0), o[2 * hb]); o[2 * hb + 1] = X28_MFMA(X28_PAF(0), X28_VFR(4), o[2 * hb + 1]); o[2 * hb] = X28_MFMA(X28_PAF(1), X28_VFR(1), o[2 * hb]); o[2 * hb + 1] = X28_MFMA(X28_PAF(1), X28_VFR(5), o[2 * hb + 1]); \
        o[2 * hb] = X28_MFMA(X28_PAF(2), X28_VFR(2), o[2 * hb]); o[2 * hb + 1] = X28_MFMA(X28_PAF(2), X28_VFR(6), o[2 * hb + 1]); o[2 * hb] = X28_MFMA(X28_PAF(3), X28_VFR(3), o[2 * hb]); o[2 * hb + 1] = X28_MFMA(X28_PAF(3), X28_VFR(7), o[2 * hb + 1]); } } while (0)
#define X28_FULL(C0, C1, P0, P1, GL) do { X28_SBAR(); \
    const ALAS unsigned char* vp_ = vp0 + 2 * sl_prev; \
    X28_VRDF(0, 0); X28_SBAR(); float sacc = P0[0] + P0[1]; \
                           X28_GAPA(C0 = X28_MFMA(kf[0], qr[0], f32x16{}), P0[2], P0[3], P0[4], P0[5],     pw0[0] = X28_PKW(P0, 0),  pw0[1] = X28_PKW(P0, 2),  pw0); \
    X28_VRDF(4, 4); X28_SBAR(); X28_GAPA(C1 = X28_MFMA(kf[1], qr[0], f32x16{}), P0[6], P0[7], P0[8], P0[9],     pw0[2] = X28_PKW(P0, 4),  pw0[3] = X28_PKW(P0, 6),  pw0); \
    X28_VRDF(1, 1); X28_SBAR(); X28_GAPA(C0 = X28_MFMA(kf[2], qr[1], C0),    P0[10], P0[11], P0[12], P0[13], pw1[0] = X28_PKW(P0, 8),  pw1[1] = X28_PKW(P0, 10), pw1); \
    X28_VRDF(5, 5); X28_SBAR(); X28_GAPA(C1 = X28_MFMA(kf[3], qr[1], C1),    P0[14], P0[15], P1[0], P1[1],   pw1[2] = X28_PKW(P0, 12), pw1[3] = X28_PKW(P0, 14), pw1); \
    X28_VRDF(2, 2); X28_SBAR(); X28_GAPA(C0 = X28_MFMA(kf[4], qr[2], C0),    P1[2], P1[3], P1[4], P1[5],     pw2[0] = X28_PKW(P1, 0),  pw2[1] = X28_PKW(P1, 2),  pw2); \
    X28_VRDF(6, 6); X28_SBAR(); X28_GAPA(C1 = X28_MFMA(kf[5], qr[2], C1),    P1[6], P1[7], P1[8], P1[9],     pw2[2] = X28_PKW(P1, 4),  pw2[3] = X28_PKW(P1, 6),  pw2); \
    X28_VRDF(3, 3); X28_SBAR(); X28_GAPA(C0 = X28_MFMA(kf[6], qr[3], C0),    P1[10], P1[11], P1[12], P1[13], pw3[0] = X28_PKW(P1, 8),  pw3[1] = X28_PKW(P1, 10), pw3); \
    X28_VRDF(7, 7); X28_SBAR(); X28_GAPA(C1 = X28_MFMA(kf[7], qr[3], C1),    P1[14], P1[15], 0.f, 0.f,       pw3[2] = X28_PKW(P1, 12), pw3[3] = X28_PKW(P1, 14), pw3); \
    l_reg += sacc; \
    { float rm_; X28_ROWMAX(rm_, C0, C1); rm_ -= mhat; \
      if (__builtin_expect(__any(rm_ > (float)THR), 0)) { const float dl = __builtin_fmaxf(rm_, 0.f); mhat += dl; \
          const float f = __builtin_amdgcn_exp2f(-dl); l_reg *= f; if (hi == 0) wsf[r32] = f; resc = true; } } \
    const float nmh = -mhat; X28_SBAR(); \
    X28_GAPB(o[0] = X28_MFMA(X28_PAF(0), X28_VFR(0), o[0]), 0, 8,  C0, 0);  X28_GAPB(o[1] = X28_MFMA(X28_PAF(0), X28_VFR(4), o[1]), 4, 12, C0, 2); \
    X28_KRD(GL, 0); X28_GAPB(o[0] = X28_MFMA(X28_PAF(1), X28_VFR(1), o[0]), 1, 9,  C0, 4);  X28_KRD(GL, 1); X28_GAPB(o[1] = X28_MFMA(X28_PAF(1), X28_VFR(5), o[1]), 5, 13, C0, 6); \
    X28_KRD(GL, 2); X28_GAPB(o[0] = X28_MFMA(X28_PAF(2), X28_VFR(2), o[0]), 2, 10, C0, 8);  X28_KRD(GL, 3); X28_GAPB(o[1] = X28_MFMA(X28_PAF(2), X28_VFR(6), o[1]), 6, 14, C0, 10); \
    X28_GAPB(o[0] = X28_MFMA(X28_PAF(3), X28_VFR(3), o[0]), 3, 11, C0, 12); X28_GAPB(o[1] = X28_MFMA(X28_PAF(3), X28_VFR(7), o[1]), 7, 15, C0, 14); \
    X28_GAPB(o[2] = X28_MFMA(X28_PAF(0), X28_VFR(0), o[2]), 0, -1, C1, 0);  X28_GAPB(o[3] = X28_MFMA(X28_PAF(0), X28_VFR(4), o[3]), 4, -1, C1, 2); \
    X28_GAPB(o[2] = X28_MFMA(X28_PAF(1), X28_VFR(1), o[2]), 1, -1, C1, 4);  X28_GAPB(o[3] = X28_MFMA(X28_PAF(1), X28_VFR(5), o[3]), 5, -1, C1, 6); \
    X28_GAPB(o[2] = X28_MFMA(X28_PAF(2), X28_VFR(2), o[2]), 2, -1, C1, 8);  X28_GAPB(o[3] = X28_MFMA(X28_PAF(2), X28_VFR(6), o[3]), 6, -1, C1, 10); \
    X28_GAPB(o[2] = X28_MFMA(X28_PAF(3), X28_VFR(3), o[2]), 3, -1, C1, 12); X28_GAPB(o[3] = X28_MFMA(X28_PAF(3), X28_VFR(7), o[3]), 7, -1, C1, 14); \
    } while (0)
#define X28_ENDW(tt) do { if ((tt) + 3 < T1) { X28_WAIT_BAR(3); } else if ((tt) + 2 < T1) { X28_WAIT_BAR(2); } else { X28_WAIT_BAR(0); } } while (0)
#define X28_DMAS(t) do { if ((t) + 3 < T1) X28_DMA_K((t) + 3, sl_cur); if ((t) + 1 < T1) X28_DMA_V((t) + 1, sl_next); } while (0)
#define X28_END(t) do { X28_ENDW(t); X28_RESC(); X28_ROT(); } while (0)
    if (pre_in) { X28_WAIT_BAR(0); } else { X28_WAIT_BAR(4); }
    X28_KLOAD_ALL(kp0); X28_FIRST(pA0, pA1);
    X28_WAIT_BAR(0);
    X28_DMA_K(3, 0); X28_DMA_V(1, SLOTB); X28_ROT();
    if (1 < tw1) X28_KLOAD_ALL(kp0 + sl_cur);
    X28_WAIT_BAR(3);
    int t = 1;
#pragma unroll 1
    for (; t + 2 < tw1; t += 2) {
        X28_DMAS(t);     resc = false; X28_FULL(pB0, pB1, pA0, pA1, true); X28_END(t);
        X28_DMAS(t + 1); resc = false; X28_FULL(pA0, pA1, pB0, pB1, true); X28_END(t + 1);
    }
    bool lastB = false;
    if (t < tw1) { X28_DMAS(t); resc = false; X28_FULL(pB0, pB1, pA0, pA1, (t + 1 < tw1)); X28_END(t); ++t; lastB = true; }
    if (t < tw1) { X28_DMAS(t); resc = false; X28_FULL(pA0, pA1, pB0, pB1, false); X28_END(t); ++t; lastB = false; }
    resc = false;
    if (t < T1) {
        X28_DMAS(t); if (lastB) { X28_DRAIN(pB0, pB1, sl_prev); } else { X28_DRAIN(pA0, pA1, sl_prev); } X28_ENDW(t); X28_ROT(); ++t;
#pragma unroll 1
        for (; t < T1; ++t) { X28_DMAS(t); X28_ENDW(t); X28_ROT(); }
    } else { if (lastB) { X28_DRAIN(pB0, pB1, sl_prev); } else { X28_DRAIN(pA0, pA1, sl_prev); } }
    asm volatile("s_waitcnt lgkmcnt(0)\n\ts_barrier" ::: "memory");
    if (has_next) {
        { int t2 = threadIdx.x; asm volatile("" : "+v"(t2)); const int l2 = t2 & 63;
          ksrc = Kh + kdelta + (size_t)l2 * ld + wid * 8; vsrc = Vh + (size_t)(16 * (wid & 3) + (l2 >> 2)) * ld + (wid >> 2) * 32 + (l2 & 3) * 8; }
        X28_DMA_K(0, 0); X28_DMA_V(0, 0); X28_DMA_K(1, SLOTB); X28_DMA_K(2, 2 * SLOTB);
    }
    const float l = halfswap_sum(l_reg);
    if (hi == 0) wsf[32 + r32] = l; asm volatile("s_waitcnt lgkmcnt(0)" ::: "memory");
#pragma unroll
    for (int r = 0; r < 16; ++r) { const float rl = __builtin_amdgcn_rcpf(wsf[32 + crow(r, hi)]);
#pragma unroll
        for (int d0 = 0; d0 < 4; ++d0) o[d0][r] *= rl; }
#undef X28_U
#undef X28_DMA_K
#undef X28_DMA_V
#undef X28_SBAR
#undef X28_PIN
#undef X28_MFMA
#undef X28_WAIT_BAR
#undef X28_KLOAD2
#undef X28_KLOAD_ALL
#undef X28_ROT
#undef X28_MX3
#undef X28_ROWMAX
#undef X28_EX
#undef X28_RESC
#undef X28_PKW
#undef X28_PAF
#undef X28_VFR
#undef X28_VRDF
#undef X28_KRD
#undef X28_GAPA
#undef X28_GAPB
#undef X28_FIRST
#undef X28_DRAIN
#undef X28_FULL
#undef X28_ENDW
#undef X28_DMAS
#undef X28_END
}

template <int DV>
__device__ __forceinline__ void store_o(const f32x16 (&o)[DV / 32], ALAS unsigned char* lds, bf16_t* dst, int ldo) {
    typedef Lds<DV> L;
    int tid = threadIdx.x; asm volatile("" : "+v"(tid));
    const int lane = tid & 63, r32 = lane & 31, hi = lane >> 5; const int wid = __builtin_amdgcn_readfirstlane(tid >> 6);
    ALAS bf16_t* stg = (ALAS bf16_t*)(lds + L::OFF_OST + wid * L::OST_W);
#pragma unroll
    for (int h = 0; h < DV / 64; ++h) {
#pragma unroll
        for (int r = 0; r < 16; ++r) { const int orow = crow(r, hi);
#pragma unroll
            for (int d0 = 0; d0 < 2; ++d0) stg[orow * 64 + d0 * 32 + r32] = (bf16_t)(cvtpk(o[2 * h + d0][r], 0.f) & 0xffffu); }
#pragma unroll
        for (int i = 0; i < 4; ++i) { const int row = i * 8 + (lane >> 3), ch = lane & 7; const u32x4 v = *(const ALAS u32x4*)(stg + row * 64 + ch * 8); *(u32x4*)(dst + (size_t)row * ldo + h * 64 + ch * 8) = v; }
    }
}
}
#define GAS __attribute__((address_space(1)))
#define LAS __attribute__((address_space(3)))
typedef unsigned short bf16;
typedef unsigned v4u __attribute__((ext_vector_type(4)));
typedef float f32x4 __attribute__((ext_vector_type(4)));
typedef short bf16x8 __attribute__((ext_vector_type(8)));
typedef GAS unsigned gu32;
typedef GAS unsigned long long gu64;
#define RLX_AGENT __ATOMIC_RELAXED, __HIP_MEMORY_SCOPE_AGENT
#define LDS_WAIT() asm volatile("s_waitcnt lgkmcnt(0)" ::: "memory")
#define VM_WAIT() asm volatile("s_waitcnt vmcnt(0)" ::: "memory")
__device__ __forceinline__ unsigned long long rt() { return __builtin_amdgcn_s_memrealtime(); }
__device__ __forceinline__ unsigned f2bf(float f) { unsigned u = __builtin_bit_cast(unsigned, f); return (u + 0x7fffu + ((u >> 16) & 1u)) >> 16; }
__device__ __forceinline__ unsigned pk2(float lo, float hi) { return f2bf(lo) | (f2bf(hi) << 16); }

#define XB_TMO      128
#define XB_XCNT(j)  (256  + 64 * (j))
#define XB_XSUB(j)  (1280 + 64 * (j))
#define XB_XGEN(j)  (2304 + 64 * (j))
#define XB_TOP      3328
#define XB_TOPGEN   3392
#define XCD_BAR_WORDS 3456
#define XB_SPIN_CAP (1u << 18)

__device__ __forceinline__ unsigned xb_ld(unsigned* p)              { return __hip_atomic_load(p, __ATOMIC_RELAXED, __HIP_MEMORY_SCOPE_AGENT); }
__device__ __forceinline__ unsigned xb_add(unsigned* p, unsigned v) { return __hip_atomic_fetch_add(p, v, __ATOMIC_RELAXED, __HIP_MEMORY_SCOPE_AGENT); }
__device__ __forceinline__ unsigned xb_xcc_id() { return (unsigned)__builtin_amdgcn_s_getreg((3 << 11) | 20) & 0xFu; }
#define XB_SPIN(cond, bar) do { unsigned _sp = 0; while (cond) { __builtin_amdgcn_s_sleep(1); \
    if ((++_sp & 255u) == 0u) { if (xb_ld(&(bar)[XB_TMO])) break; if (_sp > XB_SPIN_CAP) { atomicAdd(&(bar)[XB_TMO], 1u); break; } } } } while (0)

struct XcdBarrier {
    unsigned* bar; unsigned x;
    volatile LAS unsigned* st;
};

__device__ __forceinline__ XcdBarrier xcd_barrier_post(unsigned* bar, volatile LAS unsigned* st) {
    XcdBarrier b; b.bar = bar; b.x = xb_xcc_id(); b.st = st;
    if (threadIdx.x == 0) (void)xb_add(&bar[XB_XCNT(b.x)], 1u);
    return b;
}
__device__ __forceinline__ void xcd_barrier_complete(unsigned* bar, unsigned x, unsigned& nloc, unsigned& nx) {
    const unsigned G = gridDim.x * gridDim.y * gridDim.z;
    unsigned sum, cnt, mine, sp = 0u;
    for (;;) {
        sum = 0u; cnt = 0u; mine = 0u;
#pragma unroll
        for (unsigned j = 0; j < 16; ++j) { const unsigned c = xb_ld(&bar[XB_XCNT(j)]); sum += c; cnt += (c > 0u) ? 1u : 0u; mine = (j == x) ? c : mine; }
        if (sum == G) break;
        __builtin_amdgcn_s_sleep(1);
        if ((++sp & 255u) == 0u) { if (xb_ld(&bar[XB_TMO])) break; if (sp > XB_SPIN_CAP) { atomicAdd(&bar[XB_TMO], 1u); break; } }
    }
    nloc = mine > 0u ? mine : 1u; nx = cnt > 0u ? cnt : 1u;
}

__device__ __forceinline__ void xcd_barrier(const XcdBarrier& b) {
    asm volatile("s_waitcnt vmcnt(0)" ::: "memory");
    __syncthreads();
    if (threadIdx.x == 0) {
        unsigned* bar = b.bar;
        __builtin_amdgcn_s_waitcnt(0);
        unsigned nloc = b.st[0], nx = b.st[1];
        if (nloc == 0u) { xcd_barrier_complete(bar, b.x, nloc, nx); b.st[0] = nloc; b.st[1] = nx; }
        const unsigned old = xb_add(&bar[XB_XSUB(b.x)], 1u);
        const unsigned gen = old / nloc;
        if (old + 1u == (gen + 1u) * nloc) {
            __builtin_amdgcn_fence(__ATOMIC_RELEASE, "agent");
            asm volatile("s_waitcnt vmcnt(0)" ::: "memory");
            const unsigned og = xb_add(&bar[XB_TOP], 1u);
            const unsigned tg = og / nx;
            if (og + 1u == (tg + 1u) * nx) xb_add(&bar[XB_TOPGEN], 1u);
            else XB_SPIN(xb_ld(&bar[XB_TOPGEN]) == tg, bar);
            __builtin_amdgcn_fence(__ATOMIC_ACQUIRE, "agent");
            xb_add(&bar[XB_XGEN(b.x)], 1u);
            asm volatile("s_waitcnt vmcnt(0)" ::: "memory");
        } else {
            XB_SPIN(xb_ld(&bar[XB_XGEN(b.x)]) == gen, bar);
            __builtin_amdgcn_fence(__ATOMIC_ACQUIRE, "agent");
            asm volatile("s_waitcnt vmcnt(0)" ::: "memory");
        }
    }
    __syncthreads();
}

constexpr int NWAVES = 8;
constexpr size_t MiB = 1u << 20;
constexpr size_t WS_CTL = 0, CTL_ZERO_BYTES = 2 * MiB;
constexpr size_t WS_GRAN = 1 * MiB;
constexpr size_t WS_C64 = 381 * MiB + 42 * MiB, WS_S64 = WS_C64 + 256 * 1024, WS_C32 = WS_C64 + 512 * 1024, WS_S32 = WS_C64 + 640 * 1024, WS_RS = WS_C64 + 768 * 1024;
constexpr size_t WS_WGU = 2 * MiB, WGU_BYTES = (size_t)NGU * DM * 2;
constexpr size_t WS_WD = 46 * MiB, WD_BYTES = (size_t)DM * FF * 2;
constexpr size_t WS_WIN0 = 68 * MiB, WS_WOUT0 = 75 * MiB, WS_WIN1 = 77 * MiB, WS_WOUT1 = 83 * MiB;
constexpr size_t WS_MASK = 85 * MiB;
constexpr size_t WS_XB = 93 * MiB;
constexpr size_t WS_R1 = 157 * MiB;
constexpr size_t WS_Y = 381 * MiB;
constexpr size_t WS_SSQ1 = WS_Y + 40 * MiB, WS_SSQ2 = WS_Y + 41 * MiB;
constexpr size_t WS_ATT = 445 * MiB;
constexpr size_t WS_END = 509 * MiB;
static_assert(WS_WGU + 4 * WGU_BYTES <= WS_WD && WS_WD + 4 * WD_BYTES <= WS_WIN0 && WS_WIN0 + (size_t)NEV * DM * 2 <= WS_WOUT0 && WS_WIN1 + (size_t)NOD * DM * 2 <= WS_WOUT1, "weight map");
static_assert(WS_R1 + (size_t)MROWS * FF * 2 <= WS_Y && WS_R1 + 211 * MiB <= WS_Y, "R1 map");
constexpr int CW_BAR = 4096, CW_TMO = 0, CW_SEAM = 16384, SEAM_BANK = 128 * 64;
constexpr int FUSED_LDS_OFF = 131072 + 1024;
constexpr int RING_BYTES = 131072, LDSCTL_OFF = RING_BYTES, MISC_OFF = LDSCTL_OFF + 320, LDS_BYTES = 147456;

struct Frame {
    LAS unsigned char* lds; volatile LAS unsigned* MISC; gu32* ctl;
    int tid, lane, wave, vcu, G;
};

template <int X> __device__ __forceinline__ float swz_xor(float v) { return __int_as_float(__builtin_amdgcn_ds_swizzle(__float_as_int(v), (X << 10) | 0x1f)); }
__device__ __forceinline__ float sum32(float v) { v += swz_xor<1>(v); v += swz_xor<2>(v); v += swz_xor<4>(v); v += swz_xor<8>(v); v += swz_xor<16>(v); return v; }
__device__ __forceinline__ float wave_sum(float v) { return att::halfswap_sum(sum32(v)); }
struct MapGUHalf { int bj; __device__ __forceinline__ int src(int R) const { return R; } __device__ __forceinline__ int dst(int R) const { return 256 * (R >> 7) + 128 * bj + (R & 127); } };
struct MapId { __device__ __forceinline__ int src(int R) const { return R; } __device__ __forceinline__ int dst(int R) const { return R; } };
__device__ __forceinline__ int even_src(int R) {
    const int pn = R >> 8, bj = (R >> 7) & 1, jj = R & 127;
    if (pn < 4) return (pn < 2 ? 0 : 512) + (4 * (pn & 1) + (jj >> 5)) * 64 + 32 * bj + (jj & 31);
    if (pn < 6) return 1024 + 256 * (pn - 4) + 128 * bj + jj;
    if (pn < 10) return (pn < 8 ? 1536 : 2048) + (4 * (pn & 1) + (jj >> 5)) * 64 + 32 * bj + (jj & 31);
    if (pn < 12) return 2560 + 256 * (pn - 10) + 128 * bj + jj;
    if (pn == 12) return 3072 + (jj >> 4) * 32 + 16 * bj + (jj & 15);
    if (jj < 16) return 3328 + 16 * bj + jj;
    if (bj == 0 && jj < 24) return 3360 + (jj - 16);
    return -1;
}
struct MapEven { __device__ __forceinline__ int src(int R) const { return even_src(R); } __device__ __forceinline__ int dst(int R) const { return R; } };
#ifndef PRO_WIDE
#define PRO_WIDE 0
#endif
template <class Map>
__device__ __forceinline__ void transpose_item(const Map& mp, const float* W, int ldw, int K, int nrows, bf16* WT, const float* g, LAS float* scr, int item, int lane) {
#if PRO_WIDE
    const int nblk = nrows / 64, kb = item / nblk, nb = item % nblk, k0 = 64 * kb, n00 = 64 * nb;
    const int nl = 4 * (lane & 7), kl = lane >> 3;
    f32x4 v[2][8]; float mulh[2];
#pragma unroll
    for (int h = 0; h < 2; ++h) { const int sc0 = mp.src(n00 + 32 * h + nl); mulh[h] = sc0 >= 0 ? 1.f : 0.f; const float* src = W + (sc0 >= 0 ? sc0 : 0) + (size_t)(k0 + kl) * ldw;
#pragma unroll
        for (int i = 0; i < 8; ++i) v[h][i] = *(const GAS f32x4*)(src + (size_t)(8 * i) * ldw); }
#pragma unroll
    for (int h = 0; h < 2; ++h) { const int n0 = n00 + 32 * h; const float mul = mulh[h];
#pragma unroll
        for (int i = 0; i < 8; ++i) { const int kk = 8 * i + kl; const float gm = g ? g[k0 + kk] * mul : mul;
            scr[kk * 33 + nl] = v[h][i].x * gm; scr[kk * 33 + nl + 1] = v[h][i].y * gm; scr[kk * 33 + nl + 2] = v[h][i].z * gm; scr[kk * 33 + nl + 3] = v[h][i].w * gm; }
        LDS_WAIT(); asm volatile("" ::: "memory");
        const int c = lane & 7;
#pragma unroll
        for (int j = 0; j < 4; ++j) { const int n = (lane >> 3) + 8 * j; const LAS float* sp = scr + (8 * c) * 33 + n;
            v4u o; o.x = pk2(sp[0 * 33], sp[1 * 33]); o.y = pk2(sp[2 * 33], sp[3 * 33]); o.z = pk2(sp[4 * 33], sp[5 * 33]); o.w = pk2(sp[6 * 33], sp[7 * 33]);
            *(GAS v4u*)(WT + (size_t)mp.dst(n0 + n) * K + k0 + 8 * c) = o; }
        LDS_WAIT(); asm volatile("" ::: "memory"); }
#else
    const int nblk = nrows / 32, kb = item / nblk, nb = item % nblk, k0 = 64 * kb, n0 = 32 * nb;
    const int nl = 4 * (lane & 7), kl = lane >> 3;
    const int sc0 = mp.src(n0 + nl); const float mul = sc0 >= 0 ? 1.f : 0.f; const float* src = W + (sc0 >= 0 ? sc0 : 0) + (size_t)(k0 + kl) * ldw;
    f32x4 v[8];
#pragma unroll
    for (int i = 0; i < 8; ++i) v[i] = *(const GAS f32x4*)(src + (size_t)(8 * i) * ldw);
#pragma unroll
    for (int i = 0; i < 8; ++i) { const int kk = 8 * i + kl; const float gm = g ? g[k0 + kk] * mul : mul;
        scr[kk * 33 + nl] = v[i].x * gm; scr[kk * 33 + nl + 1] = v[i].y * gm; scr[kk * 33 + nl + 2] = v[i].z * gm; scr[kk * 33 + nl + 3] = v[i].w * gm; }
    LDS_WAIT(); asm volatile("" ::: "memory");
    const int c = lane & 7;
#pragma unroll
    for (int j = 0; j < 4; ++j) { const int n = (lane >> 3) + 8 * j; const LAS float* s = scr + (8 * c) * 33 + n;
        v4u o; o.x = pk2(s[0 * 33], s[1 * 33]); o.y = pk2(s[2 * 33], s[3 * 33]); o.z = pk2(s[4 * 33], s[5 * 33]); o.w = pk2(s[6 * 33], s[7 * 33]);
        *(GAS v4u*)(WT + (size_t)mp.dst(n0 + n) * K + k0 + 8 * c) = o; }
    LDS_WAIT(); asm volatile("" ::: "memory");
#endif
}
__device__ __forceinline__ void sincos_d(double a, float& sn, float& cs) {
    const double k = __builtin_rint(a * 0.6366197723675814); const double y = a - k * 1.5707963267948966; const double y2 = y * y;
    const double s = y * (1.0 + y2 * (-1.0 / 6 + y2 * (1.0 / 120 + y2 * (-1.0 / 5040 + y2 * (1.0 / 362880 + y2 * (-1.0 / 39916800 + y2 * (1.0 / 6227020800.0)))))));
    const double c = 1.0 + y2 * (-0.5 + y2 * (1.0 / 24 + y2 * (-1.0 / 720 + y2 * (1.0 / 40320 + y2 * (-1.0 / 3628800 + y2 * (1.0 / 479001600.0 + y2 * (-1.0 / 87178291200.0)))))));
    const int q = (int)((long long)k & 3);
    const double ss = (q == 0) ? s : (q == 1) ? c : (q == 2) ? -s : -c, cc = (q == 0) ? c : (q == 1) ? -s : (q == 2) ? -c : s;
    sn = (float)ss; cs = (float)cc;
}
__device__ __forceinline__ void x_to_bf16_rows4(const float* x, bf16* xb, float* ssq, int m, int dm, int lane) {
    f32x4 v[4][4]; float s[4];
#pragma unroll
    for (int r = 0; r < 4; ++r) { const GAS f32x4* xr = (const GAS f32x4*)(x + (size_t)(m + r * dm) * DM) + lane;
#pragma unroll
        for (int j = 0; j < 4; ++j) v[r][j] = xr[64 * j]; }
#pragma unroll
    for (int r = 0; r < 4; ++r) { s[r] = 0.f; GAS unsigned long long* o8 = (GAS unsigned long long*)(xb + (size_t)(m + r * dm) * DM) + lane;
#pragma unroll
        for (int j = 0; j < 4; ++j) { s[r] += (v[r][j].x * v[r][j].x + v[r][j].y * v[r][j].y) + (v[r][j].z * v[r][j].z + v[r][j].w * v[r][j].w);
            o8[64 * j] = (unsigned long long)epi::pkbf(v[r][j].x, v[r][j].y) | ((unsigned long long)epi::pkbf(v[r][j].z, v[r][j].w) << 32); } }
#pragma unroll
    for (int r = 0; r < 4; ++r) s[r] = sum32(s[r]);
#pragma unroll
    for (int r = 0; r < 4; ++r) { const float t = att::halfswap_sum(s[r]); if (lane == 0) *(f32x4*)(ssq + (size_t)(m + r * dm) * 4) = (f32x4){t, 0.f, 0.f, 0.f}; }
}
__device__ __forceinline__ void bf8_to_f32(const v4u& w, float (&f)[8]) {
#pragma unroll
    for (int i = 0; i < 4; ++i) { f[2 * i] = __uint_as_float(w[i] << 16); f[2 * i + 1] = __uint_as_float(w[i] & 0xffff0000u); } }
template <bool LAST>
__device__ __forceinline__ void thin_row(const bf16* yrow, bf16* xrow, float* outf, const float* ga, float alpha, float* rs, int lane) {
    float y[2][8], x[2][8]; float s = 0.f;
#pragma unroll
    for (int j = 0; j < 2; ++j) { const v4u yw = *((const GAS v4u*)yrow + lane + 64 * j), xw = *((const GAS v4u*)xrow + lane + 64 * j); bf8_to_f32(yw, y[j]); bf8_to_f32(xw, x[j]);
#pragma unroll
        for (int i = 0; i < 8; ++i) s += y[j][i] * y[j][i]; }
    const float r1 = alpha / sqrtf(wave_sum(s) * (1.f / DM) + RMS_EPS); float s2 = 0.f;
#pragma unroll
    for (int j = 0; j < 2; ++j) { const f32x4 g0 = *((const GAS f32x4*)ga + 2 * lane + 128 * j), g1 = *((const GAS f32x4*)ga + 2 * lane + 128 * j + 1);
#pragma unroll
        for (int i = 0; i < 8; ++i) { const float g = i < 4 ? g0[i & 3] : g1[i & 3]; x[j][i] += y[j][i] * g * r1; s2 += x[j][i] * x[j][i]; }
        if (LAST) { *((GAS f32x4*)outf + 2 * lane + 128 * j) = (f32x4){x[j][0], x[j][1], x[j][2], x[j][3]}; *((GAS f32x4*)outf + 2 * lane + 128 * j + 1) = (f32x4){x[j][4], x[j][5], x[j][6], x[j][7]}; }
        else { v4u o; o.x = epi::pkbf(x[j][0], x[j][1]); o.y = epi::pkbf(x[j][2], x[j][3]); o.z = epi::pkbf(x[j][4], x[j][5]); o.w = epi::pkbf(x[j][6], x[j][7]); *((GAS v4u*)xrow + lane + 64 * j) = o; } }
    if (!LAST) { const float r2 = 1.0f / sqrtf(wave_sum(s2) * (1.f / DM) + RMS_EPS); if (lane == 0) *rs = r2; }
}

struct Ptrs {
    const float *x, *norm_g, *wg, *wu, *wd, *ewin, *ewout, *elam, *esub, *owin, *owout, *obias; float* out; unsigned char* ws;
};

constexpr int PRO_NW = PRO_WIDE ? 64 : 32;
constexpr int I_GH = (DM / 64) * (FF / PRO_NW), I_WD = (FF / 64) * (DM / PRO_NW), I_E = (DM / 64) * (NEV / PRO_NW), I_O = (DM / 64) * (DM / PRO_NW), I_OD = (DM / 64) * (NOD / PRO_NW);
constexpr int IT_WGU = 0, IT_WD = 8 * I_GH, IT_WIN0 = IT_WD + 4 * I_WD, IT_WOUT0 = IT_WIN0 + I_E, IT_WIN1 = IT_WOUT0 + I_O, IT_WOUT1 = IT_WIN1 + I_OD, NITEMS = IT_WOUT1 + I_O;
__device__ __forceinline__ void convert_span(const Ptrs& P, LAS float* scr, int lane, int first, int count, int worker, int nworkers) {
    for (int it = first + worker; it < first + count; it += nworkers) {
        int r = it;
        if (r < IT_WD) { const int i8 = r / I_GH; r -= i8 * I_GH; const int i = i8 >> 1, bj = i8 & 1, l = i >> 1, f = i & 1;
            MapGUHalf mp{bj}; const float* W = (bj ? P.wu : P.wg) + (size_t)i * DM * FF;
            transpose_item(mp, W, FF, DM, FF, (bf16*)(P.ws + WS_WGU + i * WGU_BYTES), P.norm_g + (l * 6 + 4 * f) * DM, scr, r, lane); continue; }
        if (r < IT_WIN0) { r -= IT_WD; const int i = r / I_WD; r -= i * I_WD; MapId mp;
            transpose_item(mp, P.wd + (size_t)i * FF * DM, DM, FF, DM, (bf16*)(P.ws + WS_WD + i * WD_BYTES), nullptr, scr, r, lane); continue; }
        if (r < IT_WOUT0) { r -= IT_WIN0; MapEven mp; transpose_item(mp, P.ewin, 3368, DM, NEV, (bf16*)(P.ws + WS_WIN0), P.norm_g + (0 * 6 + 2) * DM, scr, r, lane); continue; }
        if (r < IT_WIN1) { r -= IT_WOUT0; MapId mp; transpose_item(mp, P.ewout, DM, DM, DM, (bf16*)(P.ws + WS_WOUT0), nullptr, scr, r, lane); continue; }
        if (r < IT_WOUT1) { r -= IT_WIN1; MapId mp; transpose_item(mp, P.owin, NOD, DM, NOD, (bf16*)(P.ws + WS_WIN1), P.norm_g + (1 * 6 + 2) * DM, scr, r, lane); continue; }
        { r -= IT_WOUT1; MapId mp; transpose_item(mp, P.owout, DM, DM, DM, (bf16*)(P.ws + WS_WOUT1), nullptr, scr, r, lane); }
    }
}
__device__ __forceinline__ void convert_slot(Frame& F, const Ptrs& P, int slot) {
    if (!((blockIdx.x >> 3) & 1)) return;
    int t = threadIdx.x; asm volatile("" : "+v"(t)); const int lane = t & 63, wave = __builtin_amdgcn_readfirstlane(t >> 6);
    LAS float* scr = (LAS float*)(F.lds + wave * 16384);
    const int worker = ((int)(blockIdx.x >> 4) * 8 + (int)(blockIdx.x & 7)) * NWAVES + wave, nworkers = (F.G / 2) * NWAVES;
    if (slot < 3) convert_span(P, scr, lane, IT_WGU + (2 * (slot + 1)) * I_GH, 2 * I_GH, worker, nworkers);
    convert_span(P, scr, lane, IT_WD + slot * I_WD, I_WD, worker, nworkers);
    if (slot == 0) { convert_span(P, scr, lane, IT_WIN0, I_E, worker, nworkers); convert_span(P, scr, lane, IT_WOUT0, I_O, worker, nworkers); }
    if (slot == 2) { convert_span(P, scr, lane, IT_WIN1, I_OD, worker, nworkers); convert_span(P, scr, lane, IT_WOUT1, I_O, worker, nworkers); }
    __syncthreads();
}
__device__ __forceinline__ void p0_prologue(Frame& F0, const Ptrs& P) {
    struct { LAS unsigned char* lds; int tid, lane, wave, vcu, G; } F;
    { int t = threadIdx.x; asm volatile("" : "+v"(t)); F.lds = F0.lds; F.tid = t; F.lane = t & 63; F.wave = __builtin_amdgcn_readfirstlane(t >> 6); F.vcu = F0.vcu; F.G = F0.G; }
    LAS float* scr = (LAS float*)(F.lds + F.wave * 16384);
    const int gw = F.vcu * NWAVES + F.wave, NGW = F.G * NWAVES;
    convert_span(P, scr, F.lane, 0, NITEMS, gw, NGW);
    float* c64 = (float*)(P.ws + WS_C64); float* s64 = (float*)(P.ws + WS_S64); float* c32 = (float*)(P.ws + WS_C32); float* s32 = (float*)(P.ws + WS_S32);
    const int gt = F.vcu * (NWAVES * 64) + F.tid, NGT = F.G * NWAVES * 64;
    for (int e = gt; e < SEQ * 48; e += NGT) {
        const bool is64 = e < SEQ * 32; const int ee = is64 ? e : e - SEQ * 32; const int pos = is64 ? (ee >> 5) : (ee >> 4), i = is64 ? (ee & 31) : (ee & 15);
        const double rb = is64 ? 0.7498942093324559 : 0.5623413251903492; double inv = 1.0; for (int k = 0; k < i; ++k) inv *= rb;
        const float ang = (float)pos * (float)inv; float sn, cs; sincos_d((double)ang, sn, cs);
        if (is64) { typedef _Float16 h2_t __attribute__((ext_vector_type(2))); h2_t h; h.x = (_Float16)cs; h.y = (_Float16)sn; ((unsigned*)c64)[ee] = __builtin_bit_cast(unsigned, h); } else { c32[ee] = cs; s32[ee] = sn; }
    }
    bf16* XB = (bf16*)(P.ws + WS_XB); float* SSQ2 = (float*)(P.ws + WS_SSQ2);
    for (int m = gw; m < MROWS; m += 4 * NGW) x_to_bf16_rows4(P.x, XB, SSQ2, m, NGW, F.lane);
}
#ifndef ATT_THR
#define ATT_THR 4
#endif
#ifndef GU_ALIGN
#define GU_ALIGN 1
#endif
#ifndef PROJ_ALIGN
#define PROJ_ALIGN 1
#endif
#ifndef A_PRE
#define A_PRE 1
#endif
#ifndef BC_PRE
#define BC_PRE 1
#endif
#ifndef A_PORT
#define A_PORT 1
#endif
#ifndef C_PORT
#define C_PORT 1
#endif
#ifndef B_PORT_MODE
#define B_PORT_MODE 1
#endif
#ifndef B_PORT
#define B_PORT 2
#endif
#ifndef PROBE_IDX_SKIP
#define PROBE_IDX_SKIP 0
#endif
#ifndef IDX_BSPLIT
#define IDX_BSPLIT 0
#endif
#ifndef IDX_SELBATCH
#define IDX_SELBATCH 1
#endif
#ifndef IDX_BATCH
#define IDX_BATCH 1
#endif
#ifndef IDX_SPLIT
#define IDX_SPLIT 0
#endif
#ifndef IDX_ASMRELU
#define IDX_ASMRELU 1
#endif
#ifndef IDX_MAXSKIP
#define IDX_MAXSKIP 0
#endif
#ifndef IDX_BCNT
#define IDX_BCNT 1
#endif
#ifndef PROBE_REP_WIN
#define PROBE_REP_WIN 1
#endif
#ifndef GU_STAGGER_US
#define GU_STAGGER_US 0
#endif
#ifndef PROBE_REP_IDXA
#define PROBE_REP_IDXA 1
#endif
#ifndef PROBE_REP_B
#define PROBE_REP_B 1
#endif
#ifndef PROBE_REP_C
#define PROBE_REP_C 1
#endif
#ifndef PROBE_REP_GU
#define PROBE_REP_GU 1
#endif
#ifndef PROBE_REP_DN
#define PROBE_REP_DN 1
#endif
#ifndef PROBE_NULL_GU
#define PROBE_NULL_GU 0
#endif
#ifndef PROBE_NULL_DN
#define PROBE_NULL_DN 0
#endif
#ifndef PROBE_REP_IDX
#define PROBE_REP_IDX 1
#endif
#ifndef PROBE_B_SKIP
#define PROBE_B_SKIP 0
#endif
#ifndef PROBE_B_HOT
#define PROBE_B_HOT 0
#endif
#ifndef PROBE_CLK
#define PROBE_CLK 0
#endif
#ifndef PROBE_HOT_GU
#define PROBE_HOT_GU 0
#endif
#ifndef PROBE_NOST_GU
#define PROBE_NOST_GU 0
#endif
#ifndef PROBE_FUSED_VAR
#define PROBE_FUSED_VAR 0
#endif
#ifndef PROBE_FUSED_DN
#define PROBE_FUSED_DN 0
#endif
#ifndef PROBE_REP_THIN
#define PROBE_REP_THIN 1
#endif
template <bool LAST>
__device__ __forceinline__ void thin_phase(Frame& F, const Ptrs& P, const float* ga, float alpha) {
    int t_ = threadIdx.x; asm volatile("" : "+v"(t_)); const int lane_ = t_ & 63, wave_ = __builtin_amdgcn_readfirstlane(t_ >> 6);
    const int gw = F.vcu * NWAVES + wave_, NGW = F.G * NWAVES;
    const bf16* Y = (const bf16*)(P.ws + WS_Y); bf16* XB = (bf16*)(P.ws + WS_XB); float* RS = (float*)(P.ws + WS_RS);
    for (int m = gw; m < MROWS; m += NGW) thin_row<LAST>(Y + (size_t)m * DM, XB + (size_t)m * DM, P.out + (size_t)m * DM, ga, alpha, RS + m, lane_);
}

__device__ __forceinline__ int wave_sum_i(int x) {
    x += __builtin_amdgcn_update_dpp(0, x, 0x111, 0xf, 0xf, true);
    x += __builtin_amdgcn_update_dpp(0, x, 0x112, 0xf, 0xf, true);
    x += __builtin_amdgcn_update_dpp(0, x, 0x114, 0xf, 0xf, true);
    x += __builtin_amdgcn_update_dpp(0, x, 0x118, 0xf, 0xf, true);
    return __builtin_amdgcn_readlane(x, 15) + __builtin_amdgcn_readlane(x, 31) + __builtin_amdgcn_readlane(x, 47) + __builtin_amdgcn_readlane(x, 63);
}
__device__ __forceinline__ unsigned wave_max_u(unsigned x) {
    x = max(x, (unsigned)__builtin_amdgcn_update_dpp(0, (int)x, 0x111, 0xf, 0xf, true));
    x = max(x, (unsigned)__builtin_amdgcn_update_dpp(0, (int)x, 0x112, 0xf, 0xf, true));
    x = max(x, (unsigned)__builtin_amdgcn_update_dpp(0, (int)x, 0x114, 0xf, 0xf, true));
    x = max(x, (unsigned)__builtin_amdgcn_update_dpp(0, (int)x, 0x118, 0xf, 0xf, true));
    return max(max((unsigned)__builtin_amdgcn_readlane((int)x, 15), (unsigned)__builtin_amdgcn_readlane((int)x, 31)), max((unsigned)__builtin_amdgcn_readlane((int)x, 47), (unsigned)__builtin_amdgcn_readlane((int)x, 63)));
}
__device__ __forceinline__ void select_row(const unsigned (&u)[32], unsigned T, int cT, LAS unsigned long long* mw, int lane) {
    if (cT == 256) {
#if IDX_SELBATCH
#pragma unroll
        for (int h = 0; h < 2; ++h) {
            unsigned long long w[16];
#pragma unroll
            for (int k = 0; k < 16; ++k) w[k] = __builtin_amdgcn_ballot_w64(u[16 * h + k] >= T);
            __builtin_amdgcn_sched_barrier(0);
            if (lane == 0) {
#pragma unroll
                for (int k = 0; k < 16; ++k) mw[16 * h + k] = w[k];
            }
            __builtin_amdgcn_sched_barrier(0);
        }
#else
#pragma unroll
        for (int i = 0; i < 32; ++i) { const unsigned long long w = __ballot(u[i] >= T); if (lane == 0) mw[i] = w; }
#endif
    } else {
        int cgt = 0;
#pragma unroll
        for (int i = 0; i < 32; ++i) cgt += __popcll(__ballot(u[i] > T));
        const int need = 256 - cgt; int base = 0; unsigned T2 = T; asm volatile("" : "+s"(T2));
#pragma unroll
        for (int i = 0; i < 32; ++i) {
            const bool eq = (u[i] == T2), gt = (u[i] > T2); const unsigned long long em = __ballot(eq);
            const int rank = (int)__builtin_amdgcn_mbcnt_hi((unsigned)(em >> 32), __builtin_amdgcn_mbcnt_lo((unsigned)em, (unsigned)base));
            const unsigned long long w = __ballot(gt || (eq && rank < need)); base += __popcll(em);
            if (lane == 0) mw[i] = w;
        }
    }
}
template <int VAR>
__device__ __forceinline__ void indexer_unit(Frame& F, const Ptrs& P, int b, int blk) {
    typedef short bf16x8v __attribute__((ext_vector_type(8)));
    int tid = threadIdx.x; asm volatile("" : "+v"(tid));
    const int q0 = blk * 16, qc = q0 >> 6, n64 = qc + 1, nvis = n64 * 64; const int lane = tid & 63, wid = __builtin_amdgcn_readfirstlane(tid >> 6);
    unsigned long long* mrow = (unsigned long long*)(P.ws + WS_MASK) + ((size_t)(b * SEQ + q0)) * 32;
    if (n64 <= 4) {
        for (int i = tid; i < 16 * 32; i += NWAVES * 64) { const int w = i & 31; if (w < n64) mrow[i] = ~0ull; }
        return;
    }
    const bf16* IQ = (const bf16*)(P.ws + WS_R1 + 192 * MiB); const bf16* IK = (const bf16*)(P.ws + WS_R1 + 208 * MiB); const float* IW = (const float*)(P.ws + WS_R1 + 210 * MiB);
    LAS float* sc = (LAS float*)F.lds;
    if (!(VAR & 1)) {
        const int q = lane & 15, kg = lane >> 4; const size_t qrow = (size_t)(b * SEQ + q0 + q);
        bf16x8v iq[8]; float wi[8];
#pragma unroll
        for (int h = 0; h < 8; ++h) { iq[h] = *(const bf16x8v*)(IQ + qrow * 256 + h * 32 + 8 * kg); wi[h] = IW[qrow * 8 + h]; }
        const int nt = (nvis / 16 - wid + NWAVES - 1) / NWAVES;
        const bf16* ikp = IK + ((size_t)(b * SEQ + wid * 16 + q)) * 32 + 8 * kg;
        bf16x8v af[16];
#pragma unroll
        for (int i = 0; i < 16; ++i) if (i < nt) af[i] = *(const bf16x8v*)(ikp + (size_t)i * (NWAVES * 16 * 32));
#pragma unroll
        for (int i = 0; i < 16; ++i) if (i < nt) {
            f32x4 acc = {0.f, 0.f, 0.f, 0.f};
#pragma unroll
            for (int h = 0; h < 8; ++h) { const f32x4 c = __builtin_amdgcn_mfma_f32_16x16x32_bf16(af[i], iq[h], (f32x4){0.f, 0.f, 0.f, 0.f}, 0, 0, 0);
#pragma unroll
                for (int j = 0; j < 4; ++j) acc[j] += wi[h] * fmaxf(c[j], 0.f); }
            const int col = ((wid + NWAVES * i) * 16 + kg * 4 + 4 * q) & 2047;
            *(LAS f32x4*)(sc + q * 2048 + col) = acc;
        }
    }
    __syncthreads();
    if (VAR != 7) {
        int n64l = n64; asm volatile("" : "+s"(n64l));
        unsigned ua[32], ub[32];
        { const int qa = 2 * wid, qb = 2 * wid + 1; const LAS float* ra = sc + qa * 2048; const LAS float* rb = sc + qb * 2048;
#pragma unroll
          for (int i = 0; i < 32; ++i) { const int e = i * 64 + lane;
              const unsigned ba = __float_as_uint(ra[(e + 4 * qa) & 2047]), bb = __float_as_uint(rb[(e + 4 * qb) & 2047]);
              const unsigned ka = (ba & 0x80000000u) ? ~ba : (ba | 0x80000000u), kb = (bb & 0x80000000u) ? ~bb : (bb | 0x80000000u);
              ua[i] = (i < n64l) ? ka : 0u; ub[i] = (i < n64l) ? kb : 0u; } }
        unsigned Ta = 0u, Tb = 0u; int cTa = nvis, cTb = nvis; bool da = false, db = false;
#pragma unroll 1
        for (int bit = (VAR & 2) ? -1 : 31; bit >= 0; --bit) {
            const unsigned ca = Ta | (1u << bit), cb = Tb | (1u << bit); int xa = 0, xb = 0;
#pragma unroll
            for (int g = 0; g < 4; ++g) if (n64l > 8 * g) {
#pragma unroll
                for (int i = 8 * g; i < 8 * g + 8; ++i) { xa += (ua[i] >= ca) ? 1 : 0; xb += (ub[i] >= cb) ? 1 : 0; } }
            const int na = wave_sum_i(xa), nb = wave_sum_i(xb);
            if (!da && na >= 256) { Ta = ca; cTa = na; if (na == 256) da = true; }
            if (!db && nb >= 256) { Tb = cb; cTb = nb; if (nb == 256) db = true; }
            if (da && db) break;
        }
        if (!(VAR & 4)) {
            LAS unsigned long long* stg = (LAS unsigned long long*)(sc + (2 * wid) * 2048);
            select_row(ua, (unsigned)__builtin_amdgcn_readfirstlane((int)Ta), __builtin_amdgcn_readfirstlane(cTa), stg, lane);
            select_row(ub, (unsigned)__builtin_amdgcn_readfirstlane((int)Tb), __builtin_amdgcn_readfirstlane(cTb), stg + 32, lane);
            mrow[(2 * wid) * 32 + lane] = stg[lane];
        }
    }
    __syncthreads();
}

typedef short idx_bf16x8 __attribute__((ext_vector_type(8)));
constexpr int IDX_NPRE = 6;
struct IdxRegs { idx_bf16x8 iq[8]; float wi[8]; idx_bf16x8 af[IDX_NPRE]; };
__device__ __forceinline__ void idx_load(IdxRegs& R, const Ptrs& P, int b, int blk, int lane, int wid) {
    const int q0 = blk * 16, n64 = (q0 >> 6) + 1, nvis = n64 * 64;
    const bf16* IQ = (const bf16*)(P.ws + WS_R1 + 192 * MiB); const bf16* IK = (const bf16*)(P.ws + WS_R1 + 208 * MiB); const float* IW = (const float*)(P.ws + WS_R1 + 210 * MiB);
    const int q = lane & 15, kg = lane >> 4; const size_t qrow = (size_t)(b * SEQ + q0 + q);
#pragma unroll
    for (int h = 0; h < 8; ++h) { R.iq[h] = *(const idx_bf16x8*)(IQ + qrow * 256 + h * 32 + 8 * kg); R.wi[h] = IW[qrow * 8 + h]; }
    const int nt = (nvis / 16 - wid + NWAVES - 1) / NWAVES;
    const bf16* ikp = IK + ((size_t)(b * SEQ + wid * 16 + q)) * 32 + 8 * kg;
#pragma unroll
    for (int i = 0; i < IDX_NPRE; ++i) { const int ii = i < nt ? i : nt - 1; R.af[i] = *(const idx_bf16x8*)(ikp + (size_t)ii * (NWAVES * 16 * 32)); }
}
__device__ __forceinline__ void idx_score(const IdxRegs& R, const Ptrs& P, LAS float* sc, int b, int blk, int lane, int wid) {
    const int q0 = blk * 16, n64 = (q0 >> 6) + 1, nvis = n64 * 64;
    if (n64 <= 4) return;
    const int q = lane & 15, kg = lane >> 4; const int nt = (nvis / 16 - wid + NWAVES - 1) / NWAVES;
    const bf16* ikp = (const bf16*)(P.ws + WS_R1 + 208 * MiB) + ((size_t)(b * SEQ + wid * 16 + q)) * 32 + 8 * kg;
    idx_bf16x8 ah[16 - IDX_NPRE];
#pragma unroll
    for (int i = 0; i < 16 - IDX_NPRE; ++i) { const int ii = IDX_NPRE + i < nt ? IDX_NPRE + i : nt - 1; ah[i] = *(const idx_bf16x8*)(ikp + (size_t)ii * (NWAVES * 16 * 32)); }
#pragma unroll
    for (int i = 0; i < 16; ++i) if (i < nt) {
        f32x4 acc = {0.f, 0.f, 0.f, 0.f}; const idx_bf16x8 a_ = i < IDX_NPRE ? R.af[i < IDX_NPRE ? i : 0] : ah[i >= IDX_NPRE ? i - IDX_NPRE : 0];
#pragma unroll
        for (int h = 0; h < 8; ++h) { const f32x4 c = __builtin_amdgcn_mfma_f32_16x16x32_bf16(a_, R.iq[h], (f32x4){0.f, 0.f, 0.f, 0.f}, 0, 0, 0);
#pragma unroll
            for (int j = 0; j < 4; ++j) { float rl_;
#if IDX_ASMRELU
                rl_ = __int_as_float(max(__float_as_int(c[j]), 0));
#else
                rl_ = fmaxf(c[j], 0.f);
#endif
                acc[j] += R.wi[h] * rl_; } }
        const int col = ((wid + NWAVES * i) * 16 + kg * 4 + 4 * q) & 2047;
        *(LAS f32x4*)(sc + q * 2048 + col) = acc;
    }
}
__device__ __forceinline__ void idx_select(const Ptrs& P, LAS float* sc, int b, int blk, int tid, int lane, int wid, int skip = 0) {
    const int q0 = blk * 16, n64 = (q0 >> 6) + 1, nvis = n64 * 64;
    unsigned long long* mrow = (unsigned long long*)(P.ws + WS_MASK) + ((size_t)(b * SEQ + q0)) * 32;
    if (n64 <= 4) {
        for (int i = tid; i < 16 * 32; i += NWAVES * 64) { const int w = i & 31; if (w < n64) mrow[i] = ~0ull; }
        return;
    }
    int n64l = n64; asm volatile("" : "+s"(n64l));
    unsigned ua[32], ub[32];
    { const int qa = 2 * wid, qb = 2 * wid + 1; const LAS float* ra = sc + qa * 2048; const LAS float* rb = sc + qb * 2048;
#pragma unroll
      for (int i = 0; i < 32; ++i) { const int e = i * 64 + lane;
          const unsigned ba = __float_as_uint(ra[(e + 4 * qa) & 2047]), bb = __float_as_uint(rb[(e + 4 * qb) & 2047]);
          const unsigned ka = (ba & 0x80000000u) ? ~ba : (ba | 0x80000000u), kb = (bb & 0x80000000u) ? ~bb : (bb | 0x80000000u);
          ua[i] = (i < n64l) ? ka : 0u; ub[i] = (i < n64l) ? kb : 0u; } }
    unsigned Ta = 0u, Tb = 0u; int cTa = nvis, cTb = nvis; bool da = false, db = false;
#if IDX_MAXSKIP
    unsigned Ma, Mb;
    { unsigned xa = 0u, xb = 0u;
#pragma unroll
      for (int i = 0; i < 32; ++i) { xa = max(xa, ua[i]); xb = max(xb, ub[i]); }
      Ma = wave_max_u(xa); Mb = wave_max_u(xb); }
#endif
#pragma unroll 1
    for (int bit = (skip & 2) ? -1 : 31; bit >= 0; --bit) {
        const unsigned ca = Ta | (1u << bit), cb = Tb | (1u << bit);
#if IDX_MAXSKIP
        if ((da || ca > Ma) && (db || cb > Mb)) continue;
#endif
#if IDX_BCNT
        int na = 0, nb = 0;
#if IDX_SPLIT
        int xa = 0, xb = 0;
#pragma unroll
        for (int g = 0; g < 4; ++g) if (n64l > 8 * g) {
#pragma unroll
            for (int i = 8 * g; i < 8 * g + 8; ++i) {
                if (i % IDX_SPLIT == 0) { xa += (ua[i] >= ca) ? 1 : 0; xb += (ub[i] >= cb) ? 1 : 0; }
                else { na += __builtin_popcountll(__builtin_amdgcn_ballot_w64(ua[i] >= ca)); nb += __builtin_popcountll(__builtin_amdgcn_ballot_w64(ub[i] >= cb)); } } }
        { const int x2 = wave_sum_i(xa + (xb << 16)); na += x2 & 0xffff; nb += x2 >> 16; }
#elif IDX_BATCH
#if IDX_BSPLIT
        int xa = 0, xb = 0;
#endif
#pragma unroll
        for (int g = 0; g < 4; ++g) if (n64l > 8 * g) {
            unsigned long long ma[8], mb[8];
#pragma unroll
            for (int k = 0; k < 8; ++k) {
#if IDX_BSPLIT
                if (k % IDX_BSPLIT == 0) { xa += (ua[8 * g + k] >= ca) ? 1 : 0; xb += (ub[8 * g + k] >= cb) ? 1 : 0; ma[k] = 0ull; mb[k] = 0ull; continue; }
#endif
                ma[k] = __builtin_amdgcn_ballot_w64(ua[8 * g + k] >= ca); mb[k] = __builtin_amdgcn_ballot_w64(ub[8 * g + k] >= cb); }
            __builtin_amdgcn_sched_barrier(0);
#pragma unroll
            for (int k = 0; k < 8; ++k) {
#if IDX_BSPLIT
                if (k % IDX_BSPLIT == 0) continue;
#endif
                na += __builtin_popcountll(ma[k]); nb += __builtin_popcountll(mb[k]); }
            __builtin_amdgcn_sched_barrier(0);
        }
#if IDX_BSPLIT
        { const int x2 = wave_sum_i(xa + (xb << 16)); na += x2 & 0xffff; nb += x2 >> 16; }
#endif
#else
#pragma unroll
        for (int g = 0; g < 4; ++g) if (n64l > 8 * g) {
#pragma unroll
            for (int i = 8 * g; i < 8 * g + 8; ++i) { na += __builtin_popcountll(__builtin_amdgcn_ballot_w64(ua[i] >= ca)); nb += __builtin_popcountll(__builtin_amdgcn_ballot_w64(ub[i] >= cb)); } }
#endif
#else
        int xa = 0, xb = 0;
#pragma unroll
        for (int g = 0; g < 4; ++g) if (n64l > 8 * g) {
#pragma unroll
            for (int i = 8 * g; i < 8 * g + 8; ++i) { xa += (ua[i] >= ca) ? 1 : 0; xb += (ub[i] >= cb) ? 1 : 0; } }
        const int na = wave_sum_i(xa), nb = wave_sum_i(xb);
#endif
        if (!da && na >= 256) { Ta = ca; cTa = na; if (na == 256) da = true; }
        if (!db && nb >= 256) { Tb = cb; cTb = nb; if (nb == 256) db = true; }
        if (da && db) break;
    }
    LAS unsigned long long* stg = (LAS unsigned long long*)(sc + (2 * wid) * 2048);
    if (skip & 4) return;
    select_row(ua, (unsigned)__builtin_amdgcn_readfirstlane((int)Ta), __builtin_amdgcn_readfirstlane(cTa), stg, lane);
    select_row(ub, (unsigned)__builtin_amdgcn_readfirstlane((int)Tb), __builtin_amdgcn_readfirstlane(cTb), stg + 32, lane);
    mrow[(2 * wid) * 32 + lane] = stg[lane];
}
__device__ __forceinline__ void indexer_phase(Frame& F, const Ptrs& P, int skip = 0) {
    int tid = threadIdx.x; asm volatile("" : "+v"(tid));
    const int lane = tid & 63, wid = __builtin_amdgcn_readfirstlane(tid >> 6);
    LAS float* sc = (LAS float*)F.lds;
#define IDX_B(u) ((F.vcu + 256 * ((u) >> 1)) >> 6)
#define IDX_BLK(u) (((u) & 1) ? 127 - ((F.vcu + 256 * ((u) >> 1)) & 63) : ((F.vcu + 256 * ((u) >> 1)) & 63))
    IdxRegs RA, RB;
    idx_load(RA, P, IDX_B(0), IDX_BLK(0), lane, wid);
#pragma unroll 1
    for (int u = 0; u < 8; u += 2) {
        if (!(skip & 1)) idx_score(RA, P, sc, IDX_B(u), IDX_BLK(u), lane, wid); __syncthreads();
        idx_load(RB, P, IDX_B(u + 1), IDX_BLK(u + 1), lane, wid);
        idx_select(P, sc, IDX_B(u), IDX_BLK(u), tid, lane, wid, skip); __syncthreads();
        if (!(skip & 1)) idx_score(RB, P, sc, IDX_B(u + 1), IDX_BLK(u + 1), lane, wid); __syncthreads();
        { const int un = u + 2 < 8 ? u + 2 : 7; idx_load(RA, P, IDX_B(un), IDX_BLK(un), lane, wid); }
        idx_select(P, sc, IDX_B(u + 1), IDX_BLK(u + 1), tid, lane, wid, skip); __syncthreads();
    }
#undef IDX_B
#undef IDX_BLK
}

__device__ __forceinline__ void a_unit(Frame& F, const Ptrs& P, int b, int h, int qb, float lam, bool pre_first = false, bool next_unit = false) {
    using namespace att; typedef Lds<128> L;
    const bf16_t* AQ = (const bf16_t*)(P.ws + WS_R1); const bf16_t* AK = (const bf16_t*)(P.ws + WS_R1 + 32 * MiB); const bf16_t* AV = (const bf16_t*)(P.ws + WS_R1 + 64 * MiB);
    int tid = threadIdx.x; asm volatile("" : "+v"(tid));
    const int lane = tid & 63, wid = __builtin_amdgcn_readfirstlane(tid >> 6), r32 = lane & 31; const size_t rowbase = (size_t)b * SEQ; const int q0 = qb * 256, qw = q0 + wid * 32, qc = qw >> 6;
    f32x4* stash = (f32x4*)(P.ws + WS_Y) + ((size_t)(blockIdx.x * NWAVES + wid) * 16) * 64 + lane;
    f32x16 o[4];
#pragma unroll 1
    for (int c = 0; c < 2; ++c) {
        const int g = 2 * h + c;
#if A_PORT
        attn128w<ATT_THR>(o, F.lds, AQ + (rowbase + qw) * 512 + g * 64, 512, AK + rowbase * 512 + g * 64, AV + rowbase * 512 + h * 128, (q0 >> 6) + 4, qc + 1,
                          A_PRE && ((c == 1) || pre_first), A_PRE && ((c == 0) || next_unit), c == 0 ? 64 : -64);
#else
        attn_core<128, 0, ATT_THR>(o, F.lds, AQ + (rowbase + qw) * 512 + g * 64, 512, AK + rowbase * 512 + g * 64, 512, AV + rowbase * 512 + h * 128, 512, 0, (q0 >> 6) + 4, 0, qc + 1, nullptr, 0, 0);
#endif
        if (c == 0) {
            f32x4* sp = stash; asm volatile("" : "+v"(sp));
#pragma unroll
            for (int d0 = 0; d0 < 4; ++d0)
#pragma unroll
                for (int rq = 0; rq < 4; ++rq) sp[(d0 * 4 + rq) * 64] = (f32x4){o[d0][4 * rq], o[d0][4 * rq + 1], o[d0][4 * rq + 2], o[d0][4 * rq + 3]};
        }
    }
    {
        const f32x4* sp = stash; asm volatile("" : "+v"(sp));
#pragma unroll
        for (int d0 = 0; d0 < 4; ++d0)
#pragma unroll
            for (int rq = 0; rq < 4; ++rq) { const f32x4 a = sp[(d0 * 4 + rq) * 64];
#pragma unroll
                for (int j = 0; j < 4; ++j) o[d0][4 * rq + j] = a[j] - lam * o[d0][4 * rq + j]; }
    }
    float sl[4];
#pragma unroll
    for (int d0 = 0; d0 < 4; ++d0) sl[d0] = P.esub[32 * d0 + r32] * 0.8f;
#pragma unroll
    for (int r = 0; r < 16; ++r) { float s = 0.f;
#pragma unroll
        for (int d0 = 0; d0 < 4; ++d0) s += o[d0][r] * o[d0][r];
        s = sum32(s);
        const float rstd = 1.0f / sqrtf(s * (1.f / 128.f) + RMS_EPS);
#pragma unroll
        for (int d0 = 0; d0 < 4; ++d0) o[d0][r] *= rstd * sl[d0]; }
    store_o<128>(o, F.lds, (bf16_t*)(P.ws + WS_ATT) + (rowbase + qw) * DM + h * 128, DM);
}
__device__ __forceinline__ void b_unit(Frame& F, const Ptrs& P, int b, int h, int qb, int hotmask, int skip, bool has_next, int nb, int nh, int nqb, int& pre) {
    using namespace att;
    const bf16_t* BQ = (const bf16_t*)(P.ws + WS_R1 + 96 * MiB); const bf16_t* BK = (const bf16_t*)(P.ws + WS_R1 + 128 * MiB); const bf16_t* BV = (const bf16_t*)(P.ws + WS_R1 + 160 * MiB);
    int tid = threadIdx.x; asm volatile("" : "+v"(tid));
    const int lane = tid & 63, wid = __builtin_amdgcn_readfirstlane(tid >> 6), r32 = lane & 31; const size_t rowbase = (size_t)b * SEQ; const int q0 = qb * 256, qw = q0 + wid * 32, qc = qw >> 6;
    const unsigned long long* mbase = (const unsigned long long*)(P.ws + WS_MASK);
    const unsigned long long* mrow = mbase + (rowbase + qw + r32) * 32;
    const size_t nrowbase = (size_t)nb * SEQ; const int nqw = nqb * 256 + wid * 32;
    f32x16 o[2]; int pre_out = 0;
#if B_PORT == 2
    attn64w<1, ATT_THR>(o, F.lds, BQ + (rowbase + qw) * 512 + h * 64, 512, BK + rowbase * 512 + h * 64, BV + rowbase * 512 + h * 64, 0, (q0 >> 6) + 4, 0, qc + 1, mrow, 0,
                        BC_PRE && pre != 0, BC_PRE && has_next, BK + nrowbase * 512 + nh * 64, BV + nrowbase * 512 + nh * 64, mbase + (nrowbase + nqw + r32) * 32, 0);
    pre_out = (BC_PRE && has_next) ? 1 : 0;
#elif B_PORT
    attn64p<B_PORT_MODE, ATT_THR>(o, F.lds, BQ + (rowbase + qw) * 512 + h * 64, 512, BK + rowbase * 512 + h * 64, BV + rowbase * 512 + h * 64, (q0 >> 6) + 4, mrow, qc);
#else
    attn_core<64, 1, ATT_THR>(o, F.lds, BQ + (rowbase + qw) * 512 + h * 64, 512, BK + rowbase * 512 + h * 64, 512, BV + rowbase * 512 + h * 64, 512, 0, (q0 >> 6) + 4, 0, qc + 1, mrow, 0, 0, hotmask, skip,
                        BK + nrowbase * 512 + nh * 64, BV + nrowbase * 512 + nh * 64, mbase + (nrowbase + nqw + r32) * 32, 0, has_next ? (nqb * 4 + 4) : 0, pre, &pre_out);
#endif
    pre = pre_out;
    store_o<64>(o, F.lds, (bf16_t*)(P.ws + WS_ATT) + (rowbase + qw) * DM + 512 + h * 64, DM);
}
__device__ __forceinline__ void c_unit(Frame& F, const Ptrs& P, int b, int h, int qb, bool has_next, int& pre) {
    using namespace att; typedef Lds<64> L;
    const bf16_t* CQ = (const bf16_t*)(P.ws + WS_R1); const bf16_t* CK = (const bf16_t*)(P.ws + WS_R1 + 64 * MiB); const bf16_t* CV = (const bf16_t*)(P.ws + WS_R1 + 128 * MiB);
    int tid = threadIdx.x; asm volatile("" : "+v"(tid));
    const int lane = tid & 63, wid = __builtin_amdgcn_readfirstlane(tid >> 6), r32 = lane & 31; const size_t rowbase = (size_t)b * SEQ; const int q0 = qb * 256, qw = q0 + wid * 32, qc = qw >> 6;
    LAS float* bt = (LAS float*)(F.lds + L::OFF_BT);
#if C_PORT
    if (qb == 0) { for (int i = tid; i < 4 * 640; i += NWAVES * 64) { int k = 639 - ((i % 640) + (i / 640)); k = k < 0 ? 0 : k; bt[(i / 640) * BT_STRIDE + (i % 640)] = P.obias[h * 320 + (k < 319 ? k : 319)] * LOG2E; } }
#else
    if (qb == 0) { for (int i = tid; i < 4 * 640; i += NWAVES * 64) { const int k = (i % 640) + (i / 640); bt[i] = P.obias[h * 320 + (k < 319 ? k : 319)] * LOG2E; } }
#endif
    const int c0 = q0 >> 6, T0 = c0 - 8 > 0 ? c0 - 8 : 0, tw0 = qc - 8 > 0 ? qc - 8 : 0;
    const int nc0 = c0 + 4, nT0 = nc0 - 8 > 0 ? nc0 - 8 : 0;
    f32x16 o[2]; int pre_out = 0;
#if C_PORT
    attn64w<2, ATT_THR>(o, F.lds, CQ + (rowbase + qw) * DM + h * 64, DM, CK + rowbase * DM + h * 64, CV + rowbase * DM + h * 64, T0, c0 + 4, tw0, qc + 1, nullptr, qw + r32,
                        BC_PRE && pre != 0, BC_PRE && has_next, CK + rowbase * DM + h * 64, CV + rowbase * DM + h * 64, nullptr, nT0);
    pre_out = (BC_PRE && has_next) ? 1 : 0;
#else
    attn_core<64, 2, ATT_THR>(o, F.lds, CQ + (rowbase + qw) * DM + h * 64, DM, CK + rowbase * DM + h * 64, DM, CV + rowbase * DM + h * 64, DM, T0, c0 + 4, tw0, qc + 1, nullptr, qw + r32, qc, -1, 0,
                        CK + rowbase * DM + h * 64, CV + rowbase * DM + h * 64, nullptr, nT0, has_next ? (nc0 + 4) : 0, pre, &pre_out);
#endif
    pre = pre_out;
    store_o<64>(o, F.lds, (bf16_t*)(P.ws + WS_ATT) + (rowbase + qw) * DM + h * 64, DM);
}

#ifndef DBG_NO_IDX
#define DBG_NO_IDX 0
#endif
#ifndef DBG_NO_A
#define DBG_NO_A 0
#endif
#ifndef DBG_NO_B
#define DBG_NO_B 0
#endif
#ifndef DBG_STAGES
#define DBG_STAGES 99
#endif
struct Args { const float* in[12]; float* out; unsigned char* ws; };
__global__ void __launch_bounds__(NWAVES * 64, 2) fwd_kernel(Args args) {
    extern __shared__ __attribute__((aligned(16))) unsigned char lds[];
    Frame F;
    F.lds = (LAS unsigned char*)lds; F.MISC = (volatile LAS unsigned*)(F.lds + MISC_OFF);
    F.tid = threadIdx.x; F.lane = F.tid & 63; F.wave = __builtin_amdgcn_readfirstlane(F.tid >> 6);
    F.G = gridDim.x; { const int bx = blockIdx.x; F.vcu = (F.G % 8 == 0) ? (bx % 8) * (F.G / 8) + bx / 8 : bx; }
    Ptrs P; P.x = args.in[0]; P.norm_g = args.in[1]; P.wg = args.in[2]; P.wu = args.in[3]; P.wd = args.in[4]; P.ewin = args.in[5]; P.ewout = args.in[6]; P.elam = args.in[7]; P.esub = args.in[8];
    P.owin = args.in[9]; P.owout = args.in[10]; P.obias = args.in[11]; P.out = args.out; P.ws = args.ws;
    F.ctl = (gu32*)(P.ws + WS_CTL);
    for (int u = F.tid; u < (LDS_BYTES - LDSCTL_OFF) / 4; u += NWAVES * 64) ((LAS unsigned*)(F.lds + LDSCTL_OFF))[u] = 0u;
    __syncthreads();
    XcdBarrier bar = xcd_barrier_post((unsigned*)(F.ctl + CW_BAR), F.MISC + 8);
#define GRID_BAR() xcd_barrier(bar)
    bf16* XB = (bf16*)(P.ws + WS_XB); const float* RS = (const float*)(P.ws + WS_SSQ2); bf16* HID = (bf16*)(P.ws + WS_R1); bf16* Y = (bf16*)(P.ws + WS_Y); const bf16* ATT = (const bf16*)(P.ws + WS_ATT);

#ifdef PROBE_REP_PRO
    for (int rep_ = 1; rep_ < PROBE_REP_PRO; ++rep_) { p0_prologue(F, P); __syncthreads(); }
#endif
    p0_prologue(F, P); GRID_BAR();
#ifdef PROBE_PK
    {
        typedef float f2_ __attribute__((ext_vector_type(2)));
        f2_ a0 = {1.0001f, 0.9999f}, a1 = {1.0002f, 0.9998f}, a2 = {1.0003f, 0.9997f}, a3 = {1.0004f, 0.9996f}; const f2_ m = {0.99999f, 1.00001f}, c = {1e-9f, -1e-9f};
        for (int it_ = 0; it_ < PROBE_PK_N; ++it_) {
#pragma unroll
            for (int k = 0; k < 16; ++k) {
                if (PROBE_PK == 1) { asm volatile("v_pk_fma_f32 %0, %0, %4, %5\n\tv_pk_fma_f32 %1, %1, %4, %5\n\tv_pk_fma_f32 %2, %2, %4, %5\n\tv_pk_fma_f32 %3, %3, %4, %5" : "+v"(a0), "+v"(a1), "+v"(a2), "+v"(a3) : "v"(m), "v"(c)); }
                else if (PROBE_PK == 2) { asm volatile("v_fma_f32 %0, %0, %8, %9\n\tv_fma_f32 %1, %1, %8, %9\n\tv_fma_f32 %2, %2, %8, %9\n\tv_fma_f32 %3, %3, %8, %9\n\tv_fma_f32 %4, %4, %8, %9\n\tv_fma_f32 %5, %5, %8, %9\n\tv_fma_f32 %6, %6, %8, %9\n\tv_fma_f32 %7, %7, %8, %9"
                        : "+v"(a0.x), "+v"(a0.y), "+v"(a1.x), "+v"(a1.y), "+v"(a2.x), "+v"(a2.y), "+v"(a3.x), "+v"(a3.y) : "v"(m.x), "v"(c.x)); }
                else if (PROBE_PK == 3) { asm volatile("v_pk_mul_f32 %0, %0, %4\n\tv_pk_mul_f32 %1, %1, %4\n\tv_pk_mul_f32 %2, %2, %4\n\tv_pk_mul_f32 %3, %3, %4" : "+v"(a0), "+v"(a1), "+v"(a2), "+v"(a3) : "v"(m)); }
                else { asm volatile("v_mul_f32 %0, %0, %8\n\tv_mul_f32 %1, %1, %8\n\tv_mul_f32 %2, %2, %8\n\tv_mul_f32 %3, %3, %8\n\tv_mul_f32 %4, %4, %8\n\tv_mul_f32 %5, %5, %8\n\tv_mul_f32 %6, %6, %8\n\tv_mul_f32 %7, %7, %8"
                        : "+v"(a0.x), "+v"(a0.y), "+v"(a1.x), "+v"(a1.y), "+v"(a2.x), "+v"(a2.y), "+v"(a3.x), "+v"(a3.y) : "v"(m.x)); }
            }
        }
        if (a0.x + a0.y + a1.x + a1.y + a2.x + a2.y + a3.x + a3.y == 123.456f) ((volatile float*)(P.ws + WS_ATT))[threadIdx.x] = a0.x;
        GRID_BAR();
    }
#endif
#ifdef PROBE_ST
    {
        int t_ = threadIdx.x; asm volatile("" : "+v"(t_)); const int ln = t_ & 63, wv = t_ >> 6, fr_ = ln & 15, fq_ = ln >> 4, wr_ = wv >> 2, wc_ = wv & 3;
        unsigned char* base_ = P.ws + WS_ATT;
        for (int it_ = 0; it_ < PROBE_ST_N; ++it_) {
            const epi::u32x4 v_ = {(unsigned)it_, (unsigned)t_, 0u, 0u}; asm volatile("" ::: "memory");
#pragma unroll
            for (int ai = 0; ai < 2; ++ai)
#pragma unroll
                for (int m = 0; m < 4; ++m)
#pragma unroll
                    for (int bj = 0; bj < 2; ++bj) {
                        size_t off_;
                        if (PROBE_ST == 1) off_ = ((size_t)(F.vcu >> 2) * 256 + ai * 128 + wr_ * 64 + m * 16 + fr_) * 2048 + ((F.vcu & 3) * 256 + bj * 128 + wc_ * 32 + 8 * fq_) * 2;
                        else if (PROBE_ST == 2) off_ = (size_t)F.vcu * 131072 + (size_t)wv * 16384 + ((ai * 4 + m) * 2 + bj) * 1024 + ln * 16;
                        else off_ = ((size_t)(F.vcu >> 2) * 256 + ai * 128 + wr_ * 64 + m * 16 + (bj * 8 + (ln >> 3))) * 2048 + ((F.vcu & 3) * 256 + wc_ * 64 + 8 * (ln & 7)) * 2;
                        *(epi::u32x4*)(base_ + off_) = v_;
                    }
        }
        asm volatile("s_waitcnt vmcnt(0)" ::: "memory");
        GRID_BAR();
    }
#endif

#define FUSED_GEMM(Aop, Bop, Kdim, inst, gain, alpha_, LAST_) FUSED_GEMM_X(XB, (float*)(P.ws + WS_SSQ2), Aop, Bop, Kdim, inst, gain, alpha_, LAST_, 0)
#define FUSED_GEMM_X(Xp, SSQ2p, Aop, Bop, Kdim, inst, gain, alpha_, LAST_, PV_) do { \
        pg8::Gemm g{(Aop), (Bop), MROWS, DM, (Kdim)}; \
        epi::EpiRmsRes<LAST_, PV_> E{(Xp), P.out, (gain), (alpha_), (unsigned long long*)(P.ws + WS_GRAN), (unsigned)((inst) + 1), (SSQ2p), (unsigned*)(F.ctl + CW_TMO), F.lds + FUSED_LDS_OFF}; \
        pg8::StaticOrder S; S.init(MROWS, DM, F.G, (int)blockIdx.x); \
        pg8::gemm_phase<epi::EpiRmsRes<LAST_, PV_>, pg8::StaticOrder, true, true>(F.lds, g, S, E); } while (0)
#define FFN_PHASES(l, f, LAST_) do { \
        { pg8::Gemm g{XB, (const bf16*)(P.ws + WS_WGU + (2 * (l) + (f)) * WGU_BYTES), MROWS, NGU, DM}; epi::OrdOrder S; S.base.init(MROWS, NGU, F.G, (int)blockIdx.x); \
          epi::rowstat_table(S, RS, (LAS float*)(F.lds + FUSED_LDS_OFF), 11); \
          if (GU_STAGGER_US > 0 && ((blockIdx.x >> 3) & 1)) { const unsigned long long t0_ = __builtin_amdgcn_s_memrealtime(); while (__builtin_amdgcn_s_memrealtime() - t0_ < 100ull * GU_STAGGER_US) __builtin_amdgcn_s_sleep(16); } \
          epi::EpiSwiGLU E{HID, (const LAS float*)(F.lds + FUSED_LDS_OFF)}; const unsigned long long pc0_ = PROBE_CLK ? __builtin_amdgcn_s_memtime() : 0ull; for (int rep_ = 0; rep_ < PROBE_REP_GU; ++rep_) pg8::gemm_phase<epi::EpiSwiGLU, epi::OrdOrder, (GU_ALIGN != 0), true>(F.lds, g, S, E); \
          if (PROBE_CLK) { const unsigned long long pc1_ = __builtin_amdgcn_s_memtime(); while (__builtin_amdgcn_s_memtime() - pc1_ < pc1_ - pc0_) __builtin_amdgcn_s_sleep(32); } \
          if (PROBE_NULL_GU) { epi::EpiNull EN; for (int rep_ = 0; rep_ < PROBE_NULL_GU; ++rep_) pg8::gemm_phase<epi::EpiNull, epi::OrdOrder, true, true>(F.lds, g, S, EN); } \
          if (PROBE_HOT_GU) { epi::EpiNull EN; epi::HotOrder HS{(PROBE_HOT_GU == 2 && ((blockIdx.x >> 3) & 1)) ? 0 : 11, (int)blockIdx.x}; pg8::gemm_phase<epi::EpiNull, epi::HotOrder, true, true>(F.lds, g, HS, EN); } \
          if (PROBE_NOST_GU) { epi::EpiSwiGLUT<1> EN{HID, (const LAS float*)(F.lds + FUSED_LDS_OFF)}; pg8::gemm_phase<epi::EpiSwiGLUT<1>, epi::OrdOrder, true, true>(F.lds, g, S, EN); } } \
        GRID_BAR(); \
        if (PROBE_FUSED_DN) { FUSED_GEMM_X((bf16*)(P.ws + WS_ATT), (float*)(P.ws + WS_SSQ1), HID, (const bf16*)(P.ws + WS_WD + (2 * (l) + (f)) * WD_BYTES), FF, 6 + 2 * (l) + (f), P.norm_g + ((l) * 6 + 4 * (f) + 1) * DM, 0.5f, false, PROBE_FUSED_VAR); GRID_BAR(); } \
        FUSED_GEMM(HID, (const bf16*)(P.ws + WS_WD + (2 * (l) + (f)) * WD_BYTES), FF, 3 * (l) + 2 * (f), P.norm_g + ((l) * 6 + 4 * (f) + 1) * DM, 0.5f, LAST_); \
        if (!(LAST_)) GRID_BAR(); } while (0)

    FFN_PHASES(0, 0, false);
    if (DBG_STAGES >= 2) {
        { pg8::Gemm g{XB, (const bf16*)(P.ws + WS_WIN0), MROWS, NEV, DM}; epi::OrdOrder S; S.base.init(MROWS, NEV, F.G, (int)blockIdx.x);
          epi::rowstat_table(S, RS, (LAS float*)(F.lds + FUSED_LDS_OFF), NEV / 256 / 2);
          unsigned char* r1 = P.ws + WS_R1;
          epi::EpiProjEven E{(bf16*)r1, (bf16*)(r1 + 192 * MiB), (bf16*)(r1 + 208 * MiB),
                             (float*)(r1 + 210 * MiB), (const LAS float*)(F.lds + FUSED_LDS_OFF), (const unsigned*)(P.ws + WS_C64), (const float*)(P.ws + WS_C32), (const float*)(P.ws + WS_S32)};
          for (int rep_ = 0; rep_ < PROBE_REP_WIN; ++rep_) pg8::gemm_phase<epi::EpiProjEven, epi::OrdOrder, (PROJ_ALIGN != 0), true>(F.lds, g, S, E); }
        GRID_BAR();
#ifdef PROBE_IDX_VAR
        for (int vr_ = 0; vr_ < 4; ++vr_)
        for (int p = F.vcu; p < 1024; p += F.G) { const int b = p >> 6, j = p & 63;
#pragma unroll 1
            for (int k = 0; k < 2; ++k) indexer_unit<PROBE_IDX_VAR>(F, P, b, k ? 127 - j : j); }
#endif
        for (int rep_ = 0; rep_ < PROBE_REP_IDXA * PROBE_REP_IDX; ++rep_) { if (!DBG_NO_IDX) indexer_phase(F, P, (rep_ + 1 < PROBE_REP_IDXA * PROBE_REP_IDX) ? PROBE_IDX_SKIP : 0); }
        {
            float l01 = 0.f, l23 = 0.f;
            for (int i = 0; i < 64; ++i) { l01 += P.elam[i] * P.elam[64 + i]; l23 += P.elam[128 + i] * P.elam[192 + i]; }
            const float lam = expf(l01) - expf(l23) + 0.2f;
            for (int rep_ = 0; rep_ < PROBE_REP_IDXA; ++rep_)
            for (int p = F.vcu; p < 256; p += F.G) { const int bh = p >> 2, s = p & 3;
#pragma unroll 1
                for (int k = 0; k < 2; ++k) { if (!DBG_NO_A) a_unit(F, P, bh >> 2, bh & 3, k ? 7 - s : s, lam, k == 1 && PROBE_REP_IDXA == 1, k == 0 && PROBE_REP_IDXA == 1); } }
        }
        GRID_BAR();
        for (int rep_ = 0; rep_ < PROBE_REP_B; ++rep_) {
            int pre_ = 0;
#pragma unroll 1
            for (int j = 0; j < 4; ++j) { const int p = F.vcu + 256 * (j >> 1), bh = p >> 2, s = p & 3, qb = (j & 1) ? 7 - s : s;
                const int jn = j + 1, pn = F.vcu + 256 * (jn >> 1), bhn = pn >> 2, sn = pn & 3, qbn = (jn & 1) ? 7 - sn : sn;
                if (!DBG_NO_B) b_unit(F, P, bh >> 3, bh & 7, qb, (PROBE_B_HOT && rep_ + 1 < PROBE_REP_B) ? 0 : -1, (rep_ + 1 < PROBE_REP_B) ? PROBE_B_SKIP : 0, jn < 4, bhn >> 3, bhn & 7, qbn, pre_); } }
        GRID_BAR();
        FUSED_GEMM(ATT, (const bf16*)(P.ws + WS_WOUT0), DM, 3 * 0 + 1, P.norm_g + (0 * 6 + 3) * DM, 1.0f, false);
        GRID_BAR();
    }
    if (DBG_STAGES >= 3) FFN_PHASES(0, 1, false);
#ifdef PROBE_XBAR
    for (int i_ = 0; i_ < PROBE_XBAR; ++i_) GRID_BAR();
#endif
#ifdef PROBE_IDLE_CYC
    { const unsigned long long t0_ = __builtin_amdgcn_s_memtime(); while (__builtin_amdgcn_s_memtime() - t0_ < (unsigned long long)PROBE_IDLE_CYC) __builtin_amdgcn_s_sleep(32); }
#endif
#ifdef PROBE_IDLE_US
    { const unsigned long long t0_ = __builtin_amdgcn_s_memrealtime(); while (__builtin_amdgcn_s_memrealtime() - t0_ < 100ull * PROBE_IDLE_US) __builtin_amdgcn_s_sleep(32); }
#endif
    if (DBG_STAGES >= 4) FFN_PHASES(1, 0, false);
    if (DBG_STAGES >= 5) {
        { pg8::Gemm g{XB, (const bf16*)(P.ws + WS_WIN1), MROWS, NOD, DM}; epi::OrdOrder S; S.base.init(MROWS, NOD, F.G, (int)blockIdx.x);
          epi::rowstat_table(S, RS, (LAS float*)(F.lds + FUSED_LDS_OFF), NOD / 256 / 2);
          unsigned char* r1 = P.ws + WS_R1; epi::EpiProjOdd E{(bf16*)r1, (const LAS float*)(F.lds + FUSED_LDS_OFF)};
          pg8::gemm_phase<epi::EpiProjOdd, epi::OrdOrder, (PROJ_ALIGN != 0), true>(F.lds, g, S, E); }
        GRID_BAR();
        for (int rep_ = 0; rep_ < PROBE_REP_C; ++rep_) { const int p = F.vcu, b = p >> 4, h = p & 15; int pre_ = 0;
#pragma unroll 1
            for (int qb = 0; qb < 8; ++qb) c_unit(F, P, b, h, qb, qb < 7, pre_); }
        GRID_BAR();
        FUSED_GEMM(ATT, (const bf16*)(P.ws + WS_WOUT1), DM, 3 * 1 + 1, P.norm_g + (1 * 6 + 3) * DM, 1.0f, false);
        GRID_BAR();
    }
    if (DBG_STAGES >= 6) FFN_PHASES(1, 1, true);
}

extern "C" void kernel_launch(void* const* d_in, const int* in_sizes, int n_in, void* d_out, int out_size, void* d_ws, size_t ws_size, hipStream_t stream) {
    static int grid = 0;
    if (grid == 0) {
        if (n_in != 12 || in_sizes[0] != MROWS * DM || out_size != MROWS * DM || ws_size < WS_END) {
            fprintf(stderr, "kernel_launch: unexpected shapes / workspace (n_in %d, in0 %d, out %d, ws %zu, need %zu); nothing launched\n", n_in, n_in > 0 ? in_sizes[0] : -1, out_size, ws_size, (size_t)WS_END); grid = -1; return; }
        int dev = 0, cus = 0, per_cu = 0;
        if (hipGetDevice(&dev) != hipSuccess || hipDeviceGetAttribute(&cus, hipDeviceAttributeMultiprocessorCount, dev) != hipSuccess) { fprintf(stderr, "kernel_launch: device query failed\n"); grid = -1; return; }
        if (hipFuncSetAttribute((const void*)fwd_kernel, hipFuncAttributeMaxDynamicSharedMemorySize, LDS_BYTES) != hipSuccess) { fprintf(stderr, "kernel_launch: hipFuncSetAttribute failed\n"); grid = -1; return; }
        if (hipOccupancyMaxActiveBlocksPerMultiprocessor(&per_cu, (const void*)fwd_kernel, NWAVES * 64, LDS_BYTES) != hipSuccess || per_cu < 1)
            fprintf(stderr, "kernel_launch: note: occupancy query reports %d workgroups per CU\n", per_cu);
        (void)hipGetLastError();
        grid = cus;
        if (grid != 256) { fprintf(stderr, "kernel_launch: built for a 256-CU device (the fused epilogues pair workgroups by rounds of 256), found %d; nothing launched\n", cus); grid = -1; return; }
    }
    if (grid < 0) return;
    if (hipMemsetAsync((char*)d_ws + WS_CTL, 0, CTL_ZERO_BYTES, stream) != hipSuccess) { fprintf(stderr, "kernel_launch: memset failed\n"); return; }
    Args a{};
    for (int i = 0; i < 12; ++i) a.in[i] = (const float*)d_in[i];
    a.out = (float*)d_out; a.ws = (unsigned char*)d_ws;
    hipLaunchKernelGGL(fwd_kernel, dim3(grid), dim3(NWAVES * 64), LDS_BYTES, stream, a);
    const hipError_t le = hipPeekAtLastError();
    if (le != hipSuccess) fprintf(stderr, "kernel_launch: launch failed: %s\n", hipGetErrorName(le));
}
```
